# Optimizing an MI355X kernel written in HIP

```python
import jax, jax.numpy as jnp
from jax import lax
import numpy as np

D_MODEL = 1024
BATCH = 4
SEQ = 8192
DEPTH = 2

N_GROUPS = 4
MIX_WIDTH = D_MODEL
GROUP_WIDTH = MIX_WIDTH // N_GROUPS
HEAD_DIM = 64
GROUP_HEADS = GROUP_WIDTH // HEAD_DIM
Q_BLOCK = 128
MLA_Q_LORA = 192
MLA_KV_LORA = 128
MLA_NOPE_DIM = 64
MLA_ROPE_DIM = 32
MLA_V_DIM = HEAD_DIM
ROPE_THETA = 10000.0
IDX_HEADS = 4
IDX_DIM = 32
DSA_TOPK = 256
NSA_KV_DIM = HEAD_DIM
CMP_LEN = 32
CMP_STRIDE = 16
SEL_LEN = 64
SEL_TOPN = 16
WINDOW = 512

EPS = 1e-6
NEG_INF = -1e30

kernel_name = "hymba_mla_fox_dsa_nsa_adaln"

SEGMENTS = [
    ("mla_q_lat", MLA_Q_LORA), ("mla_kv_lat", MLA_KV_LORA), ("mla_k_rope", MLA_ROPE_DIM),
    ("fox_q", GROUP_WIDTH), ("fox_k", GROUP_WIDTH), ("fox_v", GROUP_WIDTH), ("fox_f", GROUP_HEADS),
    ("dsa_q", GROUP_WIDTH), ("dsa_k", GROUP_WIDTH), ("dsa_v", GROUP_WIDTH),
    ("idx_q", IDX_HEADS * IDX_DIM), ("idx_k", IDX_DIM), ("idx_w", IDX_HEADS),
    ("nsa_q", GROUP_WIDTH), ("nsa_k_cmp", NSA_KV_DIM), ("nsa_v_cmp", NSA_KV_DIM),
    ("nsa_k_sel", NSA_KV_DIM), ("nsa_v_sel", NSA_KV_DIM), ("nsa_k_win", NSA_KV_DIM),
    ("nsa_v_win", NSA_KV_DIM), ("nsa_gate", GROUP_HEADS * 3),
    ("gate_z", MIX_WIDTH),
]
PROJ_WIDTH = sum(w for _, w in SEGMENTS)


def split_columns(proj):
    out, off = {}, 0
    for name, w in SEGMENTS:
        out[name] = proj[..., off:off + w]
        off += w
    return out


def rms_norm(x, g):
    xf = x.astype(jnp.float32)
    y = xf * lax.rsqrt(jnp.mean(xf * xf, axis=-1, keepdims=True) + EPS)
    return (y * g.astype(jnp.float32)).astype(x.dtype)


def alibi_slopes(n):
    return jnp.asarray(2.0 ** (-8.0 * (np.arange(n) + 1) / n), dtype=jnp.float32)


def masked_softmax(s, mask):
    p = jax.nn.softmax(jnp.where(mask, s, NEG_INF), axis=-1)
    return jnp.where(jnp.any(mask, axis=-1, keepdims=True), p, 0.0)


def merge_blocks(o):
    nb, b, qb, w = o.shape
    return jnp.moveaxis(o, 0, 1).reshape(b, nb * qb, w)


def to_heads(t, n_heads):
    b, s, w = t.shape
    return t.reshape(b, s, n_heads, w // n_heads)


def apply_rope(x, pos):
    half = x.shape[-1] // 2
    inv = ROPE_THETA ** (-jnp.arange(half, dtype=jnp.float32) / half)
    ang = pos.astype(jnp.float32)[:, None] * inv[None, :]
    cos, sin = jnp.cos(ang)[None, :, None, :], jnp.sin(ang)[None, :, None, :]
    xf = x.astype(jnp.float32)
    x1, x2 = xf[..., :half], xf[..., half:]
    return jnp.concatenate([x1 * cos - x2 * sin, x1 * sin + x2 * cos], axis=-1).astype(x.dtype)


def causal_block_attention(q, k, v, scale, bias_fn):
    B, S, H, _ = q.shape
    key_pos = jnp.arange(S)

    def block(i):
        q0 = i * Q_BLOCK
        qb = lax.dynamic_slice_in_dim(q, q0, Q_BLOCK, axis=1)
        t = q0 + jnp.arange(Q_BLOCK)
        s = jnp.einsum('bqhd,bkhd->bhqk', qb, k).astype(jnp.float32) * scale
        if bias_fn is not None:
            s = s + bias_fn(q0)
        p = masked_softmax(s, t[:, None] >= key_pos[None, :])
        o = jnp.einsum('bhqk,bkhd->bqhd', p.astype(v.dtype), v)
        return o.reshape(B, Q_BLOCK, -1)

    return merge_blocks(lax.map(block, jnp.arange(S // Q_BLOCK)))


def mla_mixer(q_lat, kv_lat, k_rope, q_norm, w_uq, kv_norm, w_ukv, pos):
    B, S, _ = q_lat.shape
    q = (rms_norm(q_lat, q_norm) @ w_uq).reshape(B, S, GROUP_HEADS, MLA_NOPE_DIM + MLA_ROPE_DIM)
    kv = (rms_norm(kv_lat, kv_norm) @ w_ukv).reshape(B, S, GROUP_HEADS, MLA_NOPE_DIM + MLA_V_DIM)
    q_nope, q_pe = q[..., :MLA_NOPE_DIM], apply_rope(q[..., MLA_NOPE_DIM:], pos)
    k_nope, v = kv[..., :MLA_NOPE_DIM], kv[..., MLA_NOPE_DIM:]
    k_pe = jnp.broadcast_to(apply_rope(k_rope[:, :, None, :], pos), (B, S, GROUP_HEADS, MLA_ROPE_DIM))
    qf = jnp.concatenate([q_nope, q_pe], axis=-1)
    kf = jnp.concatenate([k_nope, k_pe], axis=-1)
    return causal_block_attention(qf, kf, v, (MLA_NOPE_DIM + MLA_ROPE_DIM) ** -0.5, None)


def fox_mixer(q, k, v, f_logit, b_f):
    log_f = jax.nn.log_sigmoid(f_logit.astype(jnp.float32) + b_f.astype(jnp.float32))
    F = jnp.moveaxis(jnp.cumsum(log_f, axis=1), 2, 1)

    def bias(q0):
        Ft = lax.dynamic_slice_in_dim(F, q0, Q_BLOCK, axis=2)
        return Ft[..., None] - F[:, :, None, :]

    return causal_block_attention(to_heads(q, GROUP_HEADS), to_heads(k, GROUP_HEADS),
                                  to_heads(v, GROUP_HEADS), HEAD_DIM ** -0.5, bias)


def dsa_mixer(q, k, v, q_idx, k_idx, w_idx, slopes):
    B, S, _ = q.shape
    q, k, v = to_heads(q, GROUP_HEADS), to_heads(k, GROUP_HEADS), to_heads(v, GROUP_HEADS)
    q_idx = to_heads(q_idx, IDX_HEADS)
    w_idx = w_idx * (IDX_HEADS ** -0.5)
    topk = min(DSA_TOPK, S // 4)
    key_pos = jnp.arange(S)
    gather = jax.vmap(lambda arr, idx: arr[idx])

    def block(i):
        q0 = i * Q_BLOCK
        t = q0 + jnp.arange(Q_BLOCK)
        qb = lax.dynamic_slice_in_dim(q, q0, Q_BLOCK, axis=1)
        qi = lax.dynamic_slice_in_dim(q_idx, q0, Q_BLOCK, axis=1)
        wi = lax.dynamic_slice_in_dim(w_idx, q0, Q_BLOCK, axis=1)
        idx_score = jnp.einsum('bqh,bqhk->bqk', wi,
                               jax.nn.relu(jnp.einsum('bqhd,bkd->bqhk', qi, k_idx))).astype(jnp.float32)
        idx_score = jnp.where(t[:, None] >= key_pos[None, :], idx_score, NEG_INF)
        _, sel = lax.top_k(idx_score, topk)
        k_sel = gather(k, sel)
        v_sel = gather(v, sel)
        dist = (t[None, :, None] - sel).astype(jnp.float32)[:, None]
        s = jnp.einsum('bqhd,bqkhd->bhqk', qb, k_sel).astype(jnp.float32) * HEAD_DIM ** -0.5
        s = s - slopes[:, None, None] * dist
        p = masked_softmax(s, dist >= 0)
        o = jnp.einsum('bhqk,bqkhd->bqhd', p.astype(v.dtype), v_sel)
        return o.reshape(B, Q_BLOCK, -1)

    return merge_blocks(lax.map(block, jnp.arange(S // Q_BLOCK)))


def nsa_mixer(q, k_cmp, v_cmp, k_sel, v_sel, k_win, v_win, gate_logit, cmp_pos, cmp_w1, cmp_w2, slopes):
    B, S, _ = q.shape
    q = to_heads(q, GROUP_HEADS)
    gates = jax.nn.sigmoid(gate_logit.reshape(B, S, GROUP_HEADS, 3))
    scale = NSA_KV_DIM ** -0.5
    n_cmp = (S - CMP_LEN) // CMP_STRIDE + 1
    cmp_start = jnp.arange(n_cmp) * CMP_STRIDE
    cmp_end = cmp_start + CMP_LEN - 1
    tok = cmp_start[:, None] + jnp.arange(CMP_LEN)[None, :]

    def compress(t_in, pos_emb, w1, w2):
        blk = (t_in[:, tok] + pos_emb).reshape(B, n_cmp, CMP_LEN * NSA_KV_DIM)
        return jax.nn.silu(blk @ w1) @ w2

    kc = compress(k_cmp, cmp_pos[0], cmp_w1[0], cmp_w2[0])
    vc = compress(v_cmp, cmp_pos[1], cmp_w1[1], cmp_w2[1])
    n_sel = S // SEL_LEN
    sel_start = jnp.arange(n_sel) * SEL_LEN
    cmp_to_sel = ((cmp_start[:, None] < sel_start[None, :] + SEL_LEN)
                  & (cmp_end[:, None] >= sel_start[None, :])).astype(jnp.float32)
    top_n = min(SEL_TOPN, n_sel)
    ks_blk = k_sel.reshape(B, n_sel, SEL_LEN, NSA_KV_DIM)
    vs_blk = v_sel.reshape(B, n_sel, SEL_LEN, NSA_KV_DIM)
    kw_pad = jnp.pad(k_win, ((0, 0), (WINDOW, 0), (0, 0)))
    vw_pad = jnp.pad(v_win, ((0, 0), (WINDOW, 0), (0, 0)))
    gather = jax.vmap(lambda arr, idx: arr[idx])
    blk_id = jnp.arange(n_sel)

    def block(i):
        q0 = i * Q_BLOCK
        t = q0 + jnp.arange(Q_BLOCK)
        qb = lax.dynamic_slice_in_dim(q, q0, Q_BLOCK, axis=1)
        s_c = jnp.einsum('bqhd,bnd->bhqn', qb, kc).astype(jnp.float32) * scale
        s_c = s_c - slopes[:, None, None] * (t[:, None] - cmp_end[None, :]).astype(jnp.float32)
        p_c = masked_softmax(s_c, cmp_end[None, :] <= t[:, None])
        o_c = jnp.einsum('bhqn,bnd->bqhd', p_c.astype(vc.dtype), vc)
        imp = jnp.einsum('bhqn,nj->bqj', p_c, cmp_to_sel)
        cur = t // SEL_LEN
        forced = (blk_id[None, :] == cur[:, None]) | (blk_id[None, :] == 0)
        imp = jnp.where(forced, jnp.inf, jnp.where(blk_id[None, :] <= cur[:, None], imp, -jnp.inf))
        _, sel = lax.top_k(imp, top_n)
        ks = gather(ks_blk, sel).reshape(B, Q_BLOCK, top_n * SEL_LEN, NSA_KV_DIM)
        vs = gather(vs_blk, sel).reshape(B, Q_BLOCK, top_n * SEL_LEN, NSA_KV_DIM)
        pos_s = (sel[..., None] * SEL_LEN + jnp.arange(SEL_LEN)).reshape(B, Q_BLOCK, -1)
        dist_s = (t[None, :, None] - pos_s).astype(jnp.float32)[:, None]
        s_s = jnp.einsum('bqhd,bqkd->bhqk', qb, ks).astype(jnp.float32) * scale
        s_s = s_s - slopes[:, None, None] * dist_s
        p_s = masked_softmax(s_s, dist_s >= 0)
        o_s = jnp.einsum('bhqk,bqkd->bqhd', p_s.astype(vs.dtype), vs)
        kw = lax.dynamic_slice_in_dim(kw_pad, q0, WINDOW + Q_BLOCK, axis=1)
        vw = lax.dynamic_slice_in_dim(vw_pad, q0, WINDOW + Q_BLOCK, axis=1)
        pos_w = q0 - WINDOW + jnp.arange(WINDOW + Q_BLOCK)
        dist_w = t[:, None] - pos_w[None, :]
        s_w = jnp.einsum('bqhd,bkd->bhqk', qb, kw).astype(jnp.float32) * scale
        s_w = s_w - slopes[:, None, None] * dist_w.astype(jnp.float32)
        p_w = masked_softmax(s_w, (dist_w >= 0) & (dist_w < WINDOW) & (pos_w[None, :] >= 0))
        o_w = jnp.einsum('bhqk,bkd->bqhd', p_w.astype(vw.dtype), vw)
        g = lax.dynamic_slice_in_dim(gates, q0, Q_BLOCK, axis=1)
        o = g[..., 0:1] * o_c + g[..., 1:2] * o_s + g[..., 2:3] * o_w
        return o.reshape(B, Q_BLOCK, -1)

    return merge_blocks(lax.map(block, jnp.arange(S // Q_BLOCK)))


def hybrid_layer(x, c, rms_g, w_ada, b_ada, w_in, mla_q_norm, mla_w_uq, mla_kv_norm, mla_w_ukv,
                 fox_b_f, nsa_cmp_pos, nsa_cmp_w1, nsa_cmp_w2, out_norm_g, w_out, slopes):
    B, S, _ = x.shape
    pos = jnp.arange(S)
    mod = jax.nn.silu(c) @ w_ada + b_ada
    shift, scale, gate = jnp.split(mod[:, None, :], 3, axis=-1)
    h = rms_norm(x, rms_g) * (1.0 + scale) + shift
    p = split_columns(h @ w_in)
    o_a = mla_mixer(p["mla_q_lat"], p["mla_kv_lat"], p["mla_k_rope"],
                    mla_q_norm, mla_w_uq, mla_kv_norm, mla_w_ukv, pos)
    o_b = fox_mixer(p["fox_q"], p["fox_k"], p["fox_v"], p["fox_f"], fox_b_f)
    o_c = dsa_mixer(p["dsa_q"], p["dsa_k"], p["dsa_v"], p["idx_q"], p["idx_k"], p["idx_w"], slopes)
    o_d = nsa_mixer(p["nsa_q"], p["nsa_k_cmp"], p["nsa_v_cmp"], p["nsa_k_sel"], p["nsa_v_sel"],
                    p["nsa_k_win"], p["nsa_v_win"], p["nsa_gate"],
                    nsa_cmp_pos, nsa_cmp_w1, nsa_cmp_w2, slopes)
    o = jnp.concatenate([o_a, o_b, o_c, o_d], axis=-1).reshape(B, S, N_GROUPS, GROUP_WIDTH)
    o = rms_norm(o, out_norm_g.reshape(N_GROUPS, GROUP_WIDTH)).reshape(B, S, MIX_WIDTH)
    o = o * jax.nn.silu(p["gate_z"])
    return x + gate * (o @ w_out)


def setup_inputs(seed: int = 0) -> dict:
    key = jax.random.key(seed)
    ks = jax.random.split(key, 20)
    f32 = jnp.float32
    nrm = lambda k, shape, s: jax.random.normal(k, shape, f32) * s
    D = D_MODEL
    return {
        "x": nrm(ks[0], (BATCH, SEQ, D), 1.0),
        "c": nrm(ks[1], (BATCH, D), 1.0),
        "rms_g": 1.0 + nrm(ks[2], (DEPTH, D), 0.05),
        "w_ada": nrm(ks[3], (DEPTH, D, 3 * D), 0.5 * D ** -0.5),
        "b_ada": nrm(ks[4], (DEPTH, 3 * D), 0.01),
        "w_in": nrm(ks[5], (DEPTH, D, PROJ_WIDTH), D ** -0.5),
        "mla_q_norm": 1.0 + nrm(ks[6], (DEPTH, MLA_Q_LORA), 0.05),
        "mla_w_uq": nrm(ks[7], (DEPTH, MLA_Q_LORA, GROUP_HEADS * (MLA_NOPE_DIM + MLA_ROPE_DIM)), MLA_Q_LORA ** -0.5),
        "mla_kv_norm": 1.0 + nrm(ks[8], (DEPTH, MLA_KV_LORA), 0.05),
        "mla_w_ukv": nrm(ks[9], (DEPTH, MLA_KV_LORA, GROUP_HEADS * (MLA_NOPE_DIM + MLA_V_DIM)), MLA_KV_LORA ** -0.5),
        "fox_b_f": 3.0 + nrm(ks[10], (DEPTH, GROUP_HEADS), 0.5),
        "nsa_cmp_pos": nrm(ks[11], (DEPTH, 2, CMP_LEN, NSA_KV_DIM), 0.1),
        "nsa_cmp_w1": nrm(ks[12], (DEPTH, 2, CMP_LEN * NSA_KV_DIM, NSA_KV_DIM), (CMP_LEN * NSA_KV_DIM) ** -0.5),
        "nsa_cmp_w2": nrm(ks[13], (DEPTH, 2, NSA_KV_DIM, NSA_KV_DIM), NSA_KV_DIM ** -0.5),
        "out_norm_g": 1.0 + nrm(ks[14], (DEPTH, MIX_WIDTH), 0.05),
        "w_out": nrm(ks[15], (DEPTH, MIX_WIDTH, D), MIX_WIDTH ** -0.5),
        "final_g": 1.0 + nrm(ks[16], (D,), 0.05),
    }


def reference(x, c, rms_g, w_ada, b_ada, w_in, mla_q_norm, mla_w_uq, mla_kv_norm, mla_w_ukv,
              fox_b_f, nsa_cmp_pos, nsa_cmp_w1, nsa_cmp_w2, out_norm_g, w_out, final_g):
    slopes = alibi_slopes(GROUP_HEADS)
    for l in range(DEPTH):
        x = hybrid_layer(x, c, rms_g[l], w_ada[l], b_ada[l], w_in[l], mla_q_norm[l], mla_w_uq[l],
                         mla_kv_norm[l], mla_w_ukv[l], fox_b_f[l], nsa_cmp_pos[l], nsa_cmp_w1[l],
                         nsa_cmp_w2[l], out_norm_g[l], w_out[l], slopes)
    return rms_norm(x, final_g)
```

```cpp
#include <hip/hip_runtime.h>
#include <hip/hip_cooperative_groups.h>
#include <cstdio>
#include <cstdint>
namespace cg = cooperative_groups;

#define LAS __attribute__((address_space(3)))
typedef unsigned short bf16_t;
typedef short bf16x8 __attribute__((ext_vector_type(8)));
typedef short s16x4 __attribute__((ext_vector_type(4)));
typedef float f32x2 __attribute__((ext_vector_type(2)));
typedef float f32x4 __attribute__((ext_vector_type(4)));
typedef float f32x16 __attribute__((ext_vector_type(16)));
typedef unsigned u32x2 __attribute__((ext_vector_type(2)));
typedef unsigned u32x4 __attribute__((ext_vector_type(4)));
typedef __bf16 bf16x2_t __attribute__((ext_vector_type(2)));

constexpr int NB = 4, S = 8192, D = 1024, M = NB * S, NP = 3840, DEPTH = 2;
constexpr int C_QLAT = 0, C_KVLAT = 192, C_KROPE = 320, C_FQ = 352, C_FK = 608, C_FV = 864, C_DQ = 1120, C_DK = 1376, C_DV = 1632,
              C_IQ = 1888, C_IK = 2016, C_NQ = 2048, C_KCMP = 2304, C_VCMP = 2368, C_KSEL = 2432, C_VSEL = 2496, C_KWIN = 2560,
              C_VWIN = 2624, C_GZ = 2688, C_SIDE = 3712;
constexpr float EPS = 1e-6f;
constexpr float LOG2E = 1.4426950408889634f;
constexpr int NTHREADS = 512;
constexpr int LDS_BYTES = 155648;

constexpr size_t MiB = 1u << 20;
constexpr size_t WS_CTL = 0;
constexpr size_t WS_WIN = 1 * MiB;
constexpr size_t WS_WOUT = 16 * MiB;
constexpr size_t WS_WUQ = 20 * MiB;
constexpr size_t WS_WUKV = 20 * MiB + 512 * 1024;
constexpr size_t WS_W1T = 21 * MiB;
constexpr size_t WS_CVEC = 22 * MiB;
constexpr size_t WS_MOD = 22 * MiB + 4096;
constexpr size_t WS_ROPE = 23 * MiB;
constexpr size_t WS_RSTD = 24 * MiB;
constexpr size_t WS_FB = 24 * MiB + 512 * 1024;
constexpr size_t WS_KC = 25 * MiB;
constexpr size_t WS_VC = 25 * MiB + 512 * 1024;
constexpr size_t WS_SIDE = 26 * MiB;
constexpr size_t WS_H = 30 * MiB;
constexpr size_t WS_QMLA = 94 * MiB;
constexpr size_t WS_KMLA = 118 * MiB;
constexpr size_t WS_VMLA = 142 * MiB;
constexpr size_t WS_MASK = 158 * MiB;
constexpr size_t WS_OCAT = 190 * MiB;
constexpr size_t WS_PROJ = 254 * MiB;
constexpr size_t WS_KIDX = ((WS_PROJ + (size_t)(M + 64) * NP * 2 + MiB - 1) / MiB) * MiB;
constexpr size_t WS_END = WS_KIDX + 2 * MiB;

struct Params {
    const float* in[17];
    float* out;
    unsigned char* ws;
    int ph_lo, ph_hi, bar_region, pad;
};

__device__ __forceinline__ unsigned pk2(float lo, float hi) { f32x2 v = {lo, hi}; bf16x2_t b = __builtin_convertvector(v, bf16x2_t); return __builtin_bit_cast(unsigned, b); }
__device__ __forceinline__ float bf2f(unsigned short b) { return __uint_as_float(((unsigned)b) << 16); }
__device__ __forceinline__ float bflo(unsigned u) { return __uint_as_float(u << 16); }
__device__ __forceinline__ float bfhi(unsigned u) { return __uint_as_float(u & 0xffff0000u); }
__device__ __forceinline__ float wave_sum(float v) {
    v += __builtin_bit_cast(float, __builtin_amdgcn_update_dpp(0, __builtin_bit_cast(int, v), 0xB1, 0xf, 0xf, false));
    v += __builtin_bit_cast(float, __builtin_amdgcn_update_dpp(0, __builtin_bit_cast(int, v), 0x4E, 0xf, 0xf, false));
    v += __builtin_bit_cast(float, __builtin_amdgcn_update_dpp(0, __builtin_bit_cast(int, v), 0x141, 0xf, 0xf, false));
    v += __builtin_bit_cast(float, __builtin_amdgcn_update_dpp(0, __builtin_bit_cast(int, v), 0x140, 0xf, 0xf, false));
    const float r0 = __builtin_bit_cast(float, __builtin_amdgcn_readlane(__builtin_bit_cast(int, v), 0)), r1 = __builtin_bit_cast(float, __builtin_amdgcn_readlane(__builtin_bit_cast(int, v), 16));
    const float r2 = __builtin_bit_cast(float, __builtin_amdgcn_readlane(__builtin_bit_cast(int, v), 32)), r3 = __builtin_bit_cast(float, __builtin_amdgcn_readlane(__builtin_bit_cast(int, v), 48));
    return (r0 + r1) + (r2 + r3);
}
__device__ __forceinline__ float silu_f(float x) { return x / (1.0f + __expf(-x)); }
__device__ __forceinline__ float sigmoid_f(float x) { return 1.0f / (1.0f + __expf(-x)); }
__device__ __forceinline__ int crow(int r, int hi) { return (r & 3) + 8 * (r >> 2) + 4 * hi; }
__device__ __forceinline__ int opaque_tid(int wid0) { int t; asm volatile("v_mbcnt_lo_u32_b32 %0, -1, 0\n\tv_mbcnt_hi_u32_b32 %0, -1, %0\n\tv_lshl_add_u32 %0, %1, 6, %0" : "=&v"(t) : "s"(wid0)); return t; }

namespace pg8 {
constexpr int BM = 256, BK = 64, HALF = 128, HTB = HALF * BK * 2, STAGE_BYTES = 8 * HTB, NXCD = 8, WGM = 8;
__host__ __device__ __forceinline__ int lds_byte(int r, int c) { const int st = (r >> 4) * 2 + (c >> 5), rr = r & 15, cc = c & 31, ob = rr * 64 + cc * 2; return st * 1024 + (ob ^ (((ob >> 9) & 1) << 5)); }
__host__ __device__ __forceinline__ void stage_rc(int b, int& R, int& C) { const int st = b / 1024, sb = b % 1024, swz = sb ^ (((sb >> 9) & 1) << 5); R = (st >> 1) * 16 + swz / 64; C = (st & 1) * 32 + (swz % 64) / 2; }
__host__ __device__ __forceinline__ int perm32(int rho) { const int n = rho >> 4, i = rho & 15; return 8 * (i >> 2) + 4 * n + (i & 3); }
struct Unit { int pm, pn; };
struct Gemm { const bf16_t* A; const bf16_t* Bt; int M, N, K, lda, ldb; };
struct StaticOrder {
    int nM, nN, nwg, G, c;
    __device__ void init(int M_, int N_, int G_, int c_) { nM = M_ / BM; nN = N_ / BM; nwg = nM * nN; G = G_; c = c_; }
    __device__ bool next(int i, Unit& u) const {
        const long L = (long)i * G + c; if (L >= nwg) return false;
        int wgid = (int)L; { const int q = nwg / NXCD, r = nwg % NXCD, xcd = wgid % NXCD, off = wgid / NXCD; wgid = (xcd < r ? xcd * (q + 1) : r * (q + 1) + (xcd - r) * q) + off; }
        const int nig = WGM * nN, gid = wgid / nig, fm = gid * WGM, gsz = (nM - fm) < WGM ? (nM - fm) : WGM;
        u.pm = fm + ((wgid % nig) % gsz); u.pn = (wgid % nig) / gsz; return true;
    }
};

template <class Epi, bool ALIGN_EPI>
__device__ __forceinline__ void gemm_phase(LAS unsigned char* lds, const Gemm g, const StaticOrder& S_, const Epi& E, int wid0) {
    const int tid = opaque_tid(wid0), wid = __builtin_amdgcn_readfirstlane(tid >> 6), lane = tid & 63, wr = wid >> 2, wc = wid & 3, fr = lane & 15, fq = lane >> 4;
    const int K = g.K, nt = K / BK;
    unsigned voffA[2], voffB[2];
#pragma unroll
    for (int i = 0; i < 2; ++i) { int R, C; stage_rc(tid * 16 + i * 8192, R, C); const int Rb = ((R & ~31) + perm32(R & 31));
        voffA[i] = (unsigned)(R * g.lda + C) * 2u; voffB[i] = (unsigned)(Rb * g.ldb + C) * 2u; }
    const size_t kstep = (size_t)(BK * 2);
    const size_t hstepA = (size_t)HALF * g.lda * 2, hstepB = (size_t)HALF * g.ldb * 2;
    const size_t tstepA = 2 * hstepA, tstepB = 2 * hstepB;
    const unsigned ldsw = (unsigned)wid * 1024u;
    const int aoff = lds_byte(wr * 64 + fr, fq * 8), boff = lds_byte(wc * 32 + fr, fq * 8);
#define PG8_SA(b, h) (((b) * 2 + (h)) * HTB)
#define PG8_SB(b, h) ((4 + (b) * 2 + (h)) * HTB)
#define PG8_STAGE(bufoff, gbase, voff) do { _Pragma("unroll") for (int _i = 0; _i < 2; ++_i) \
        __builtin_amdgcn_global_load_lds((const unsigned*)((const char*)(gbase) + (voff)[_i]), (LAS unsigned*)(lds + (bufoff) + ldsw + _i * 8192), 16, 0, 0); } while (0)
#define PG8_LDA(dst, b, h) do { _Pragma("unroll") for (int m = 0; m < 4; ++m) _Pragma("unroll") for (int k = 0; k < 2; ++k) dst[m][k] = *(const LAS bf16x8*)(lds + PG8_SA(b, h) + aoff + m * 2048 + k * 1024); } while (0)
#define PG8_LDB(dst, b, h) do { _Pragma("unroll") for (int n = 0; n < 2; ++n) _Pragma("unroll") for (int k = 0; k < 2; ++k) dst[n][k] = *(const LAS bf16x8*)(lds + PG8_SB(b, h) + boff + n * 2048 + k * 1024); } while (0)
#define PG8_MMA(ai, bj, At, Bt) do { __builtin_amdgcn_s_setprio(1); _Pragma("unroll") for (int m = 0; m < 4; ++m) _Pragma("unroll") for (int n = 0; n < 2; ++n) _Pragma("unroll") for (int k = 0; k < 2; ++k) \
        acc[ai][bj][m][n] = __builtin_amdgcn_mfma_f32_16x16x32_bf16(Bt[n][k], At[m][k], acc[ai][bj][m][n], 0, 0, 0); __builtin_amdgcn_s_setprio(0); } while (0)
#define PG8_WAIT_V(n) asm volatile("s_waitcnt vmcnt(" #n ")" ::: "memory")
#define PG8_WAIT_L(n) asm volatile("s_waitcnt lgkmcnt(" #n ")" ::: "memory")
#define PG8_BAR __builtin_amdgcn_s_barrier()
#define PG8_SCHED __builtin_amdgcn_sched_barrier(0)
    Unit cur, nxt; int ui = 0;
    if (!S_.next(0, cur)) return;
    f32x4 acc[2][2][4][2];
#pragma unroll
    for (int a = 0; a < 2; ++a)
#pragma unroll
        for (int b = 0; b < 2; ++b)
#pragma unroll
            for (int m = 0; m < 4; ++m)
#pragma unroll
                for (int n = 0; n < 2; ++n) acc[a][b][m][n] = (f32x4){0.f, 0.f, 0.f, 0.f};
    bf16x8 At[4][2], B0[2][2], B1[2][2];
    const char* cA = (const char*)g.A + (size_t)cur.pm * tstepA; const char* cB = (const char*)g.Bt + (size_t)cur.pn * tstepB;
    PG8_STAGE(PG8_SB(0, 0), cB, voffB); PG8_STAGE(PG8_SB(0, 1), cB + hstepB, voffB); PG8_STAGE(PG8_SA(0, 0), cA, voffA); PG8_STAGE(PG8_SA(0, 1), cA + hstepA, voffA);
    if (wr == 1) PG8_BAR;
    PG8_WAIT_V(2); PG8_BAR;
    PG8_STAGE(PG8_SB(1, 0), cB + kstep, voffB); PG8_STAGE(PG8_SA(1, 0), cA + kstep, voffA); PG8_STAGE(PG8_SB(1, 1), cB + hstepB + kstep, voffB);
    PG8_WAIT_V(6); PG8_BAR;
    for (;;) {
        const bool has_next = S_.next(ui + 1, nxt);
        const char* nA = has_next ? (const char*)g.A + (size_t)nxt.pm * tstepA : cA; const char* nB = has_next ? (const char*)g.Bt + (size_t)nxt.pn * tstepB : cB;
        for (int t = 0; t < nt; t += 2) {
            const bool last = (t == nt - 2);
            const char* a1 = cA + (size_t)(t + 1) * kstep;
            const char* a2 = last ? nA : cA + (size_t)(t + 2) * kstep; const char* b2 = last ? nB : cB + (size_t)(t + 2) * kstep;
            const char* a3 = a2 + kstep; const char* b3 = b2 + kstep;
            PG8_LDB(B0, 0, 0); PG8_LDB(B1, 0, 1); PG8_SCHED; PG8_LDA(At, 0, 0); PG8_STAGE(PG8_SA(1, 1), a1 + hstepA, voffA);
            PG8_WAIT_V(8); PG8_WAIT_L(0); PG8_BAR; PG8_MMA(0, 0, At, B0); PG8_MMA(0, 1, At, B1); PG8_BAR; PG8_SCHED;
            PG8_LDA(At, 0, 1); PG8_STAGE(PG8_SB(0, 0), b2, voffB); PG8_STAGE(PG8_SB(0, 1), b2 + hstepB, voffB); PG8_STAGE(PG8_SA(0, 0), a2, voffA);
            PG8_WAIT_V(8); PG8_WAIT_L(0); PG8_BAR; PG8_MMA(1, 0, At, B0); PG8_MMA(1, 1, At, B1); PG8_BAR; PG8_SCHED;
            PG8_LDB(B0, 1, 0); PG8_LDB(B1, 1, 1); PG8_SCHED; PG8_LDA(At, 1, 0); PG8_STAGE(PG8_SA(0, 1), a2 + hstepA, voffA);
            PG8_WAIT_V(8); PG8_WAIT_L(0); PG8_BAR; PG8_MMA(0, 0, At, B0); PG8_MMA(0, 1, At, B1); PG8_BAR; PG8_SCHED;
            PG8_LDA(At, 1, 1); PG8_STAGE(PG8_SB(1, 0), b3, voffB); PG8_STAGE(PG8_SB(1, 1), b3 + hstepB, voffB); PG8_STAGE(PG8_SA(1, 0), a3, voffA);
            PG8_WAIT_V(8); PG8_WAIT_L(0); PG8_BAR; PG8_MMA(1, 0, At, B0); PG8_MMA(1, 1, At, B1); PG8_BAR; PG8_SCHED;
        }
        if constexpr (ALIGN_EPI) { if (wr == 0) PG8_BAR; }
        E(acc, cur, wr, wc, fr, fq);
        if (!has_next) break;
#pragma unroll
        for (int a = 0; a < 2; ++a)
#pragma unroll
            for (int b = 0; b < 2; ++b)
#pragma unroll
                for (int m = 0; m < 4; ++m)
#pragma unroll
                    for (int n = 0; n < 2; ++n) acc[a][b][m][n] = (f32x4){0.f, 0.f, 0.f, 0.f};
        cur = nxt; cA = nA; cB = nB; ++ui;
        if constexpr (ALIGN_EPI) { if (wr == 1) PG8_BAR; }
    }
    PG8_WAIT_V(0);
    if constexpr (!ALIGN_EPI) { if (wr == 0) PG8_BAR; }
    PG8_BAR;
#undef PG8_SA
#undef PG8_SB
#undef PG8_STAGE
#undef PG8_LDA
#undef PG8_LDB
#undef PG8_MMA
#undef PG8_WAIT_V
#undef PG8_WAIT_L
#undef PG8_BAR
#undef PG8_SCHED
}

struct EpiProj {
    bf16_t* proj; float* side;
    __device__ __forceinline__ void operator()(const f32x4 (&acc)[2][2][4][2], const Unit& u, int wr, int wc, int fr, int fq) const {
        const int row0 = u.pm * BM + wr * 64 + fr, col0 = u.pn * BM + wc * 32 + 8 * fq;
#pragma unroll
        for (int ai = 0; ai < 2; ++ai)
#pragma unroll
            for (int m = 0; m < 4; ++m) { const int row = row0 + ai * HALF + m * 16; bf16_t* rowp = proj + (size_t)row * NP + col0;
#pragma unroll
                for (int bj = 0; bj < 2; ++bj) { const f32x4 v0 = acc[ai][bj][m][0], v1 = acc[ai][bj][m][1];
                    u32x4 w; w.x = pk2(v0[0], v0[1]); w.y = pk2(v0[2], v0[3]); w.z = pk2(v1[0], v1[1]); w.w = pk2(v1[2], v1[3]);
                    *(u32x4*)(rowp + bj * HALF) = w;
                    if (bj == 1 && u.pn == 14 && wc == 0) { float* sp = side + (size_t)row * 32 + 8 * fq; *(f32x4*)sp = v0; *(f32x4*)(sp + 4) = v1; } } }
    }
};
struct EpiQup {
    bf16_t* q; const float* rstd; const float* rope;
    __device__ __forceinline__ void operator()(const f32x4 (&acc)[2][2][4][2], const Unit& u, int wr, int wc, int fr, int fq) const {
        const int row0 = u.pm * BM + wr * 64 + fr;
#pragma unroll
        for (int ai = 0; ai < 2; ++ai)
#pragma unroll
            for (int m = 0; m < 4; ++m) { const int row = row0 + ai * HALF + m * 16; const float rs = rstd[(size_t)row * 2]; const int pos = row & (S - 1);
#pragma unroll
                for (int bj = 0; bj < 2; ++bj) { const int c = u.pn * BM + bj * HALF + wc * 32 + 8 * fq;
                    if (c < 384) { const int w0 = c % 96;
                        f32x4 v0 = acc[ai][bj][m][0] * rs, v1 = acc[ai][bj][m][1] * rs;
                        if (w0 >= 64) { const int i0 = (w0 - 64) >> 1; const float* tp = rope + ((size_t)pos * 16 + i0) * 2;
                            const f32x4 t0 = *(const f32x4*)tp, t1 = *(const f32x4*)(tp + 4);
                            f32x4 a, b;
                            a[0] = v0[0] * t0[0] - v0[1] * t0[1]; a[1] = v0[0] * t0[1] + v0[1] * t0[0];
                            a[2] = v0[2] * t0[2] - v0[3] * t0[3]; a[3] = v0[2] * t0[3] + v0[3] * t0[2];
                            b[0] = v1[0] * t1[0] - v1[1] * t1[1]; b[1] = v1[0] * t1[1] + v1[1] * t1[0];
                            b[2] = v1[2] * t1[2] - v1[3] * t1[3]; b[3] = v1[2] * t1[3] + v1[3] * t1[2];
                            v0 = a; v1 = b; }
                        u32x4 w; w.x = pk2(v0[0], v0[1]); w.y = pk2(v0[2], v0[3]); w.z = pk2(v1[0], v1[1]); w.w = pk2(v1[2], v1[3]);
                        *(u32x4*)(q + (size_t)row * 384 + c) = w; } }
                asm volatile("" ::: "memory"); }
    }
};
struct EpiKVup {
    bf16_t* k; bf16_t* v; const float* rstd;
    __device__ __forceinline__ void operator()(const f32x4 (&acc)[2][2][4][2], const Unit& u, int wr, int wc, int fr, int fq) const {
        const int row0 = u.pm * BM + wr * 64 + fr;
#pragma unroll
        for (int ai = 0; ai < 2; ++ai)
#pragma unroll
            for (int m = 0; m < 4; ++m) { const int row = row0 + ai * HALF + m * 16; const float rs = rstd[(size_t)row * 2 + 1];
#pragma unroll
                for (int bj = 0; bj < 2; ++bj) { const int c = u.pn * BM + bj * HALF + wc * 32 + 8 * fq; const int hd = c >> 7, w0 = c & 127;
                    const f32x4 v0 = acc[ai][bj][m][0] * rs, v1 = acc[ai][bj][m][1] * rs;
                    u32x4 w; w.x = pk2(v0[0], v0[1]); w.y = pk2(v0[2], v0[3]); w.z = pk2(v1[0], v1[1]); w.w = pk2(v1[2], v1[3]);
                    bf16_t* dst = (w0 < 64) ? (k + (size_t)row * 384 + hd * 96 + w0) : (v + (size_t)row * 256 + hd * 64 + (w0 - 64));
                    *(u32x4*)dst = w; }
                asm volatile("" ::: "memory"); }
    }
};
struct EpiOut {
    const float* res; float* out; const float* gate;
    __device__ __forceinline__ void operator()(const f32x4 (&acc)[2][2][4][2], const Unit& u, int wr, int wc, int fr, int fq) const {
        const int row0 = u.pm * BM + wr * 64 + fr; const int b = (u.pm * BM) / S;
#pragma unroll
        for (int bj = 0; bj < 2; ++bj) { const int c = u.pn * BM + bj * HALF + wc * 32 + 8 * fq;
            const f32x4 g0 = *(const f32x4*)(gate + (size_t)b * 3072 + c), g1 = *(const f32x4*)(gate + (size_t)b * 3072 + c + 4);
#pragma unroll
            for (int ai = 0; ai < 2; ++ai)
#pragma unroll
                for (int m = 0; m < 4; ++m) { const int row = row0 + ai * HALF + m * 16; const size_t off = (size_t)row * D + c;
                    const f32x4 r0 = *(const f32x4*)(res + off), r1 = *(const f32x4*)(res + off + 4);
                    *(f32x4*)(out + off) = r0 + g0 * acc[ai][bj][m][0]; *(f32x4*)(out + off + 4) = r1 + g1 * acc[ai][bj][m][1]; } }
    }
};
}

struct MapWin { __device__ __forceinline__ int operator()(int n) const {
    if (n < 1120) return n; if (n < 2048) return n + 4; if (n < 2688) return n + 8; if (n < 3712) return n + 20;
    if (n < 3716) return 1120 + (n - 3712); if (n < 3720) return 2052 + (n - 3716); if (n < 3732) return 2696 + (n - 3720); return -1; } };
struct MapId { int N; __device__ __forceinline__ int operator()(int n) const { return n < N ? n : -1; } };
struct MapUq { __device__ __forceinline__ int operator()(int n) const { if (n >= 384) return -1; const int hd = n / 96, w = n % 96; if (w < 64) return hd * 96 + w;
    const int p = (w - 64) >> 1, which = (w - 64) & 1; return hd * 96 + 64 + (which ? 16 + p : p); } };

template <class ColMap>
__device__ __forceinline__ void tr_tile(const float* src, int lds_src, int Ksrc, const float* kscale, bf16_t* dst, int ldd, int n0, int k0, ColMap cm, LAS float* scr, int wid0) {
    const int tid = opaque_tid(wid0);
#pragma unroll
    for (int i = 0; i < 8; ++i) { const int idx = tid + i * NTHREADS, kk = idx >> 6, nn = idx & 63; const int sc = cm(n0 + nn), k = k0 + kk;
        float v = 0.f; if (sc >= 0 && k < Ksrc) { v = src[(size_t)k * lds_src + sc]; if (kscale) v *= kscale[k]; }
        scr[kk * 65 + nn] = v; }
    __syncthreads();
    { const int nn = tid >> 3, kc = tid & 7; const LAS float* s = scr + (kc * 8) * 65 + nn;
      u32x4 w; w.x = pk2(s[0], s[65]); w.y = pk2(s[2 * 65], s[3 * 65]); w.z = pk2(s[4 * 65], s[5 * 65]); w.w = pk2(s[6 * 65], s[7 * 65]);
      *(u32x4*)(dst + (size_t)(n0 + nn) * ldd + k0 + kc * 8) = w; }
    __syncthreads();
}

__device__ __forceinline__ void phase_prologue(const Params& P, LAS unsigned char* lds, int bid, int G, int wid0) {
    const int tid = opaque_tid(wid0);
    LAS float* scr = (LAS float*)lds;
    const float* w_in = P.in[5]; const float* w_uq = P.in[7]; const float* w_ukv = P.in[9]; const float* w1 = P.in[12]; const float* w_out = P.in[15];
    constexpr int T_WIN = 60 * 16, T_WOUT = 16 * 16, T_UQ = 8 * 4, T_UKV = 8 * 2, T_W1 = 1 * 32 * 2;
    constexpr int T_L = T_WIN + T_WOUT + T_UQ + T_UKV + T_W1;
    for (int it = bid; it < DEPTH * T_L; it += G) {
        const int l = it / T_L; int r = it % T_L;
        if (r < T_WIN) { tr_tile(w_in + (size_t)l * D * 3732, 3732, D, nullptr, (bf16_t*)(P.ws + WS_WIN) + (size_t)l * NP * D, D, (r / 16) * 64, (r % 16) * 64, MapWin{}, scr, wid0); continue; } r -= T_WIN;
        if (r < T_WOUT) { tr_tile(w_out + (size_t)l * D * D, D, D, nullptr, (bf16_t*)(P.ws + WS_WOUT) + (size_t)l * D * D, D, (r / 16) * 64, (r % 16) * 64, MapId{D}, scr, wid0); continue; } r -= T_WOUT;
        if (r < T_UQ) { tr_tile(w_uq + (size_t)l * 192 * 384, 384, 192, P.in[6] + l * 192, (bf16_t*)(P.ws + WS_WUQ) + (size_t)l * 512 * 256, 256, (r / 4) * 64, (r % 4) * 64, MapUq{}, scr, wid0); continue; } r -= T_UQ;
        if (r < T_UKV) { tr_tile(w_ukv + (size_t)l * 128 * 512, 512, 128, P.in[8] + l * 128, (bf16_t*)(P.ws + WS_WUKV) + (size_t)l * 512 * 128, 128, (r / 2) * 64, (r % 2) * 64, MapId{512}, scr, wid0); continue; } r -= T_UKV;
        { const int kv = r / 32, kt = r % 32; tr_tile(w1 + (size_t)(l * 2 + kv) * 2048 * 64, 64, 2048, nullptr, (bf16_t*)(P.ws + WS_W1T) + (size_t)(l * 2 + kv) * 64 * 2048, 2048, 0, kt * 64, MapId{64}, scr, wid0); }
    }
    {
        LAS float* sc = (LAS float*)lds;
        LAS float* red = (LAS float*)(lds + 16384);
        const float* c = P.in[1]; const float* w_ada = P.in[3]; const float* b_ada = P.in[4]; float* mod = (float*)(P.ws + WS_MOD);
        bool loaded = false;
        for (int it = bid; it < DEPTH * 48; it += G) {
            if (!loaded) { for (int i = tid; i < 4096; i += NTHREADS) sc[i] = silu_f(c[i]); loaded = true; __syncthreads(); }
            const int l = it / 48, cb = it % 48, col = tid & 63, ks = tid >> 6;
            const float* wp = w_ada + (size_t)l * D * 3072 + (size_t)(ks * 128) * 3072 + cb * 64 + col;
            float a0 = 0.f, a1 = 0.f, a2 = 0.f, a3 = 0.f;
#pragma unroll 8
            for (int k = 0; k < 128; ++k) { const float w = wp[(size_t)k * 3072]; const int kk = ks * 128 + k;
                a0 += sc[kk] * w; a1 += sc[1024 + kk] * w; a2 += sc[2048 + kk] * w; a3 += sc[3072 + kk] * w; }
            red[(ks * 64 + col) * 4 + 0] = a0; red[(ks * 64 + col) * 4 + 1] = a1; red[(ks * 64 + col) * 4 + 2] = a2; red[(ks * 64 + col) * 4 + 3] = a3;
            __syncthreads();
            if (tid < 256) { const int cc = tid & 63, b = tid >> 6; float s = b_ada[l * 3072 + cb * 64 + cc];
#pragma unroll
                for (int k8 = 0; k8 < 8; ++k8) s += red[(k8 * 64 + cc) * 4 + b];
                mod[(size_t)(l * 4 + b) * 3072 + cb * 64 + cc] = s; }
            __syncthreads();
        }
    }
    {
        float* tab = (float*)(P.ws + WS_ROPE);
        for (int idx = bid * NTHREADS + tid; idx < S * 16; idx += G * NTHREADS) {
            const int pos = idx >> 4, i = idx & 15;
            const double f4[4] = {1.0, 0.5623413251903491, 0.31622776601683794, 0.1778279410038923};
            double inv = (i & 3) == 0 ? f4[0] : ((i & 3) == 1 ? f4[1] : ((i & 3) == 2 ? f4[2] : f4[3]));
            inv *= ((i >> 2) == 0 ? 1.0 : ((i >> 2) == 1 ? 0.1 : ((i >> 2) == 2 ? 0.01 : 0.001)));
            const float invf = (float)inv; const float angf = (float)pos * invf;
            const double rev = (double)angf * 0.15915494309189535; const double fr = rev - __builtin_floor(rev);
            const float f = (float)fr;
            tab[(size_t)idx * 2] = __builtin_amdgcn_cosf(f); tab[(size_t)idx * 2 + 1] = __builtin_amdgcn_sinf(f);
        }
    }
    {
        const float* pos = P.in[11]; float* cvec = (float*)(P.ws + WS_CVEC);
        LAS float* red = (LAS float*)(lds + 65536);
        for (int it = bid; it < DEPTH * 2; it += G) {
            __syncthreads();
            const int col = tid & 63, ks = tid >> 6; float a = 0.f;
            const float* wp = w1 + (size_t)it * 2048 * 64 + (size_t)(ks * 256) * 64 + col; const float* pp = pos + (size_t)it * 2048 + ks * 256;
            for (int k = 0; k < 256; ++k) a += pp[k] * wp[(size_t)k * 64];
            red[ks * 64 + col] = a; __syncthreads();
            if (tid < 64) { float s = 0.f; for (int k8 = 0; k8 < 8; ++k8) s += red[k8 * 64 + tid]; cvec[it * 64 + tid] = s; }
            __syncthreads();
        }
    }
}

__device__ __forceinline__ void phase_hnorm(const float* x, const float* g, const float* mod  , bf16_t* h, int bid, int G, int wid0) {
    const int tid_ = opaque_tid(wid0); const int lane = tid_ & 63, wv = tid_ >> 6;
    for (int row = bid * 8 + wv; row < M; row += G * 8) {
        const f32x4* xr = (const f32x4*)(x + (size_t)row * D) + lane;
        f32x4 v[4]; float s = 0.f;
#pragma unroll
        for (int j = 0; j < 4; ++j) { v[j] = xr[64 * j]; s += (v[j][0] * v[j][0] + v[j][1] * v[j][1]) + (v[j][2] * v[j][2] + v[j][3] * v[j][3]); }
        const float rstd = 1.0f / sqrtf(wave_sum(s) * (1.f / D) + EPS);
        const int b = row / S; const float* sh = mod + (size_t)b * 3072; const float* scl = sh + 1024;
        unsigned long long* o8 = (unsigned long long*)(h + (size_t)row * D) + lane;
#pragma unroll
        for (int j = 0; j < 4; ++j) { const int c = (64 * j + lane) * 4; const f32x4 gg = *(const f32x4*)(g + c), ss = *(const f32x4*)(scl + c), hh = *(const f32x4*)(sh + c);
            f32x4 y;
#pragma unroll
            for (int e = 0; e < 4; ++e) y[e] = v[j][e] * rstd * gg[e] * (1.0f + ss[e]) + hh[e];
            o8[64 * j] = (unsigned long long)pk2(y[0], y[1]) | ((unsigned long long)pk2(y[2], y[3]) << 32); }
    }
}

__device__ __forceinline__ void phase_prep(const Params& P, int l, LAS unsigned char* lds, int bid, int G, int wid0) {
    const int tid = opaque_tid(wid0), lane = tid & 63, wv = tid >> 6;
    const bf16_t* proj = (const bf16_t*)(P.ws + WS_PROJ); const float* side = (const float*)(P.ws + WS_SIDE);
    {
        float* rstd = (float*)(P.ws + WS_RSTD); bf16_t* kmla = (bf16_t*)(P.ws + WS_KMLA); const float* rope = (const float*)(P.ws + WS_ROPE);
        for (int row = bid * 8 + wv; row < M; row += G * 8) {
            const bf16_t* pr = proj + (size_t)row * NP;
            float sq = 0.f, skv = 0.f;
            if (lane < 40) { const u32x4 w = *(const u32x4*)(pr + lane * 8); float s = 0.f;
#pragma unroll
                for (int e = 0; e < 4; ++e) { const float a = bflo(w[e]), b = bfhi(w[e]); s += a * a + b * b; }
                if (lane < 24) sq = s; else skv = s; }
            sq = wave_sum(sq); skv = wave_sum(skv);
            if (lane == 0) { rstd[(size_t)row * 2] = 1.0f / sqrtf(sq * (1.f / 192.f) + EPS); rstd[(size_t)row * 2 + 1] = 1.0f / sqrtf(skv * (1.f / 128.f) + EPS); }
            if (lane >= 48 && lane < 52) *(u32x4*)((bf16_t*)(P.ws + WS_KIDX) + (size_t)row * 32 + (lane - 48) * 8) = *(const u32x4*)(pr + C_IK + (lane - 48) * 8);
            if (lane < 16) { const float x1 = bf2f(pr[C_KROPE + lane]), x2 = bf2f(pr[C_KROPE + 16 + lane]); const int pos = row & (S - 1);
                const float cs = rope[((size_t)pos * 16 + lane) * 2], sn = rope[((size_t)pos * 16 + lane) * 2 + 1];
                const unsigned w = pk2(x1 * cs - x2 * sn, x1 * sn + x2 * cs);
#pragma unroll
                for (int hd = 0; hd < 4; ++hd) *(unsigned*)(kmla + (size_t)row * 384 + hd * 96 + 64 + 2 * lane) = w; }
        }
    }
    {
        float* fb = (float*)(P.ws + WS_FB); const float* b_f = P.in[10] + l * 4; LAS float* wtot = (LAS float*)lds;
        for (int it = bid; it < 16; it += G) {
            const int b = it >> 2, hd = it & 3; const float bf = b_f[hd];
            float ls[16]; float s = 0.f;
#pragma unroll
            for (int i = 0; i < 16; ++i) { const int t = tid * 16 + i; const float v = side[((size_t)b * S + t) * 32 + hd] + bf;
                const float y = fminf(v, 0.f) - log1pf(__expf(-fabsf(v))); ls[i] = y; s += y; }
            float inc = s;
#pragma unroll
            for (int o = 1; o < 64; o <<= 1) { const float t = __shfl_up(inc, o); if (lane >= o) inc += t; }
            __syncthreads();
            if (lane == 63) wtot[wv] = inc;
            __syncthreads();
            float base = 0.f;
            for (int w = 0; w < wv; ++w) base += wtot[w];
            float run = base + inc - s;
#pragma unroll
            for (int i = 0; i < 16; ++i) { run += ls[i]; fb[((size_t)it) * S + tid * 16 + i] = -8.0f * run; }
            __syncthreads();
        }
    }
    {
        const bf16_t* w1t = (const bf16_t*)(P.ws + WS_W1T) + (size_t)l * 2 * 64 * 2048; const float* cvec = (const float*)(P.ws + WS_CVEC) + l * 2 * 64;
        const float* w2 = P.in[13] + (size_t)l * 2 * 64 * 64;
        LAS float* part = (LAS float*)lds;
        LAS float* hb = (LAS float*)(lds + 65536);
        const int r = lane & 31, hi = lane >> 5;
        for (int it = bid; it < 128; it += G) {
            const int b = it >> 5, kv = (it >> 4) & 1, nt = it & 15, n0 = nt * 32;
            const int colbase = kv ? C_VCMP : C_KCMP;
            const bf16_t* w1k = w1t + (size_t)kv * 64 * 2048;
            f32x16 a0 = {}, a1 = {};
#pragma unroll
            for (int j = 0; j < 4; ++j) { const int tok = wv * 4 + j;
                const bf16_t* ap = proj + ((size_t)b * S + 16 * (n0 + r) + tok) * NP + colbase + hi * 8;
#pragma unroll
                for (int s = 0; s < 4; ++s) { const bf16x8 af = *(const bf16x8*)(ap + s * 16);
                    const int kb = tok * 64 + s * 16 + hi * 8;
                    const bf16x8 b0 = *(const bf16x8*)(w1k + (size_t)r * 2048 + kb), b1 = *(const bf16x8*)(w1k + (size_t)(32 + r) * 2048 + kb);
                    a0 = __builtin_amdgcn_mfma_f32_32x32x16_bf16(af, b0, a0, 0, 0, 0); a1 = __builtin_amdgcn_mfma_f32_32x32x16_bf16(af, b1, a1, 0, 0, 0); } }
#pragma unroll
            for (int reg = 0; reg < 16; ++reg) { const int n = crow(reg, hi); part[(wv * 32 + n) * 64 + r] = a0[reg]; part[(wv * 32 + n) * 64 + 32 + r] = a1[reg]; }
            __syncthreads();
            { const int n = tid >> 4, c4 = (tid & 15) * 4;
#pragma unroll
              for (int e = 0; e < 4; ++e) { float s = cvec[kv * 64 + c4 + e];
#pragma unroll
                  for (int w = 0; w < 8; ++w) s += part[(w * 32 + n) * 64 + c4 + e];
                  hb[n * 64 + c4 + e] = silu_f(s); } }
            __syncthreads();
            { const int n = tid >> 4, c4 = (tid & 15) * 4; float o[4] = {0.f, 0.f, 0.f, 0.f}; const float* w2k = w2 + (size_t)kv * 64 * 64;
              for (int k = 0; k < 64; ++k) { const float hv = hb[n * 64 + k]; const f32x4 wv4 = *(const f32x4*)(w2k + k * 64 + c4);
                  o[0] += hv * wv4[0]; o[1] += hv * wv4[1]; o[2] += hv * wv4[2]; o[3] += hv * wv4[3]; }
              bf16_t* dst = (bf16_t*)(P.ws + (kv ? WS_VC : WS_KC)) + ((size_t)b * 512 + n0 + n) * 64 + c4;
              const bool valid = (n0 + n) < 511;
              u32x2 w; w.x = valid ? pk2(o[0], o[1]) : 0u; w.y = valid ? pk2(o[2], o[3]) : 0u; *(u32x2*)dst = w; }
            __syncthreads();
        }
    }
}

constexpr float NEG_BIG = -1e30f;
constexpr int KSTR64 = 144, KSTR96 = 208;
constexpr int ATT_KBUF = 64 * KSTR96;
constexpr int ATT_VBUF = 8192;
constexpr int ATT_K0 = 0, ATT_V0 = 2 * ATT_KBUF, ATT_B0 = ATT_V0 + 2 * ATT_VBUF, ATT_END = ATT_B0 + 2 * 256;
constexpr int ATT_EXTRA = 45056;

struct SoftState { float m, l; f32x16 o0, o1; };

template <int KS>
__device__ __forceinline__ void qk_tile(f32x16& p0, f32x16& p1, const LAS unsigned char* kt, int kstride, const bf16x8 (&qf)[KS], int r, int hi) {
    const LAS unsigned char* k0 = kt + r * kstride + hi * 16; const LAS unsigned char* k1 = k0 + 32 * kstride;
#pragma unroll
    for (int s = 0; s < KS; ++s) { const bf16x8 a0 = *(const LAS bf16x8*)(k0 + s * 32), a1 = *(const LAS bf16x8*)(k1 + s * 32);
        p0 = __builtin_amdgcn_mfma_f32_32x32x16_bf16(a0, qf[s], p0, 0, 0, 0); p1 = __builtin_amdgcn_mfma_f32_32x32x16_bf16(a1, qf[s], p1, 0, 0, 0); }
}
__device__ __forceinline__ float max3f(float a, float b, float c);
__device__ __forceinline__ float tile_max(const f32x16& p0, const f32x16& p1) {
    float a = max3f(p0[0], p0[1], p1[0]), b = max3f(p0[2], p0[3], p1[1]); a = max3f(a, p1[2], p1[3]);
#pragma unroll
    for (int i = 4; i < 16; i += 4) { a = max3f(a, p0[i], p0[i + 1]); b = max3f(b, p0[i + 2], p0[i + 3]); a = max3f(a, p1[i], p1[i + 1]); b = max3f(b, p1[i + 2], p1[i + 3]); }
    a = max3f(a, b, b);
    const auto rr = __builtin_amdgcn_permlane32_swap(__float_as_uint(a), __float_as_uint(a), false, false);
    return fmaxf(__uint_as_float(rr[0]), __uint_as_float(rr[1]));
}
__device__ __forceinline__ bf16x8 vfrag(const LAS unsigned char* p) {
    const s16x4 lo = __builtin_bit_cast(s16x4, __builtin_amdgcn_ds_read_tr16_b64_v4i16((LAS s16x4*)p));
    const s16x4 hi = __builtin_bit_cast(s16x4, __builtin_amdgcn_ds_read_tr16_b64_v4i16((LAS s16x4*)(p + 512)));
    return (bf16x8){lo[0], lo[1], lo[2], lo[3], hi[0], hi[1], hi[2], hi[3]};
}
__device__ __forceinline__ bf16x8 pfrag(const f32x16& p, int b) {
    u32x4 w; w.x = pk2(p[b], p[b + 1]); w.y = pk2(p[b + 2], p[b + 3]); w.z = pk2(p[b + 4], p[b + 5]); w.w = pk2(p[b + 6], p[b + 7]);
    return __builtin_bit_cast(bf16x8, w);
}
__device__ __forceinline__ void pv_frag(f32x16& o0, f32x16& o1, bf16x8 pf0, bf16x8 pf1, bf16x8 pf2, bf16x8 pf3, const LAS unsigned char* vt, int vb) {
    const LAS unsigned char* v = vt + vb;
    o0 = __builtin_amdgcn_mfma_f32_32x32x16_bf16(vfrag(v), pf0, o0, 0, 0, 0);            o1 = __builtin_amdgcn_mfma_f32_32x32x16_bf16(vfrag(v + 4096), pf0, o1, 0, 0, 0);
    o0 = __builtin_amdgcn_mfma_f32_32x32x16_bf16(vfrag(v + 1024), pf1, o0, 0, 0, 0);     o1 = __builtin_amdgcn_mfma_f32_32x32x16_bf16(vfrag(v + 4096 + 1024), pf1, o1, 0, 0, 0);
    o0 = __builtin_amdgcn_mfma_f32_32x32x16_bf16(vfrag(v + 2048), pf2, o0, 0, 0, 0);     o1 = __builtin_amdgcn_mfma_f32_32x32x16_bf16(vfrag(v + 4096 + 2048), pf2, o1, 0, 0, 0);
    o0 = __builtin_amdgcn_mfma_f32_32x32x16_bf16(vfrag(v + 3072), pf3, o0, 0, 0, 0);     o1 = __builtin_amdgcn_mfma_f32_32x32x16_bf16(vfrag(v + 4096 + 3072), pf3, o1, 0, 0, 0);
}
__device__ __forceinline__ void pv_tile(f32x16& o0, f32x16& o1, const f32x16& p0, const f32x16& p1, const LAS unsigned char* vt, int vb) {
    pv_frag(o0, o1, pfrag(p0, 0), pfrag(p0, 8), pfrag(p1, 0), pfrag(p1, 8), vt, vb);
}
__device__ __forceinline__ void softmax_step(SoftState& st, f32x16& p0, f32x16& p1, float c2) {
    const float mx = tile_max(p0, p1);
    const float mn = fmaxf(st.m, mx);
    if (__any(mn > st.m)) { const float al = __builtin_amdgcn_exp2f((st.m - mn) * c2); st.l *= al; st.o0 *= al; st.o1 *= al; st.m = mn; }
    const float mc = st.m * c2; float sum = 0.f;
#pragma unroll
    for (int i = 0; i < 16; ++i) { p0[i] = __builtin_amdgcn_exp2f(__builtin_fmaf(p0[i], c2, -mc)); p1[i] = __builtin_amdgcn_exp2f(__builtin_fmaf(p1[i], c2, -mc)); sum += p0[i] + p1[i]; }
    st.l += sum;
}

__device__ __forceinline__ float max3f(float a, float b, float c) { float r; asm("v_max3_f32 %0, %1, %2, %3" : "=v"(r) : "v"(a), "v"(b), "v"(c)); return r; }
__device__ __forceinline__ float swap32_max(float a) { const auto rr = __builtin_amdgcn_permlane32_swap(__float_as_uint(a), __float_as_uint(a), false, false);
    float r; asm("v_max_f32_e32 %0, %1, %2" : "=v"(r) : "v"(__uint_as_float(rr[0])), "v"(__uint_as_float(rr[1]))); return r; }
__device__ __forceinline__ float quad_xor1(float x) { return __builtin_bit_cast(float, __builtin_amdgcn_update_dpp(0, __builtin_bit_cast(int, x), 0xB1, 0xf, 0xf, false)); }
__device__ __forceinline__ float quad_xor2(float x) { return __builtin_bit_cast(float, __builtin_amdgcn_update_dpp(0, __builtin_bit_cast(int, x), 0x4E, 0xf, 0xf, false)); }
__device__ __forceinline__ float swap32_sum(float a) { const auto rr = __builtin_amdgcn_permlane32_swap(__float_as_uint(a), __float_as_uint(a), false, false); return __uint_as_float(rr[0]) + __uint_as_float(rr[1]); }
constexpr float SM_THR = 8.0f;
__device__ __forceinline__ void softmax_pack(SoftState& st, const f32x16& p0, const f32x16& p1, float c2, bf16x8& pf0, bf16x8& pf1, bf16x8& pf2, bf16x8& pf3) {
    float a = max3f(p0[0], p0[1], p1[0]), b = max3f(p0[2], p0[3], p1[1]); a = max3f(a, p1[2], p1[3]);
#pragma unroll
    for (int i = 4; i < 16; i += 4) { a = max3f(a, p0[i], p0[i + 1]); b = max3f(b, p0[i + 2], p0[i + 3]); a = max3f(a, p1[i], p1[i + 1]); b = max3f(b, p1[i + 2], p1[i + 3]); }
    float mx; asm("v_max_f32_e32 %0, %1, %2" : "=v"(mx) : "v"(a), "v"(b));
    mx = swap32_max(mx);
    if (__any((mx - st.m) * c2 > SM_THR)) { const float mn = fmaxf(st.m, mx); const float al = __builtin_amdgcn_exp2f((st.m - mn) * c2); st.l *= al; st.o0 *= al; st.o1 *= al; st.m = mn; }
    const float mc = -st.m * c2; float s0 = 0.f, s1 = 0.f;
    u32x4 w0, w1, w2, w3;
#define SMP(W, E, P, B) do { const float e0_ = __builtin_amdgcn_exp2f(__builtin_fmaf(P[B], c2, mc)), e1_ = __builtin_amdgcn_exp2f(__builtin_fmaf(P[B + 1], c2, mc)); s0 += e0_; s1 += e1_; W[E] = pk2(e0_, e1_); } while (0)
    SMP(w0, 0, p0, 0); SMP(w0, 1, p0, 2); SMP(w0, 2, p0, 4); SMP(w0, 3, p0, 6);
    SMP(w1, 0, p0, 8); SMP(w1, 1, p0, 10); SMP(w1, 2, p0, 12); SMP(w1, 3, p0, 14);
    SMP(w2, 0, p1, 0); SMP(w2, 1, p1, 2); SMP(w2, 2, p1, 4); SMP(w2, 3, p1, 6);
    SMP(w3, 0, p1, 8); SMP(w3, 1, p1, 10); SMP(w3, 2, p1, 12); SMP(w3, 3, p1, 14);
#undef SMP
    st.l += s0 + s1;
    pf0 = __builtin_bit_cast(bf16x8, w0); pf1 = __builtin_bit_cast(bf16x8, w1); pf2 = __builtin_bit_cast(bf16x8, w2); pf3 = __builtin_bit_cast(bf16x8, w3);
}

__device__ __forceinline__ void sm_exp_pack(SoftState& st, const f32x16& p0, const f32x16& p1, float c2, bf16x8& pf0, bf16x8& pf1, bf16x8& pf2, bf16x8& pf3) {
    const float mc = -st.m * c2; float s0 = 0.f, s1 = 0.f;
    u32x4 w0, w1, w2, w3;
#define SMP(W, E, P, B) do { const float e0_ = __builtin_amdgcn_exp2f(__builtin_fmaf(P[B], c2, mc)), e1_ = __builtin_amdgcn_exp2f(__builtin_fmaf(P[B + 1], c2, mc)); s0 += e0_; s1 += e1_; W[E] = pk2(e0_, e1_); } while (0)
    SMP(w0, 0, p0, 0); SMP(w0, 1, p0, 2); SMP(w0, 2, p0, 4); SMP(w0, 3, p0, 6);
    SMP(w1, 0, p0, 8); SMP(w1, 1, p0, 10); SMP(w1, 2, p0, 12); SMP(w1, 3, p0, 14);
    SMP(w2, 0, p1, 0); SMP(w2, 1, p1, 2); SMP(w2, 2, p1, 4); SMP(w2, 3, p1, 6);
    SMP(w3, 0, p1, 8); SMP(w3, 1, p1, 10); SMP(w3, 2, p1, 12); SMP(w3, 3, p1, 14);
#undef SMP
    st.l += s0 + s1;
    pf0 = __builtin_bit_cast(bf16x8, w0); pf1 = __builtin_bit_cast(bf16x8, w1); pf2 = __builtin_bit_cast(bf16x8, w2); pf3 = __builtin_bit_cast(bf16x8, w3);
}

template <int DK> struct StageRegs { u32x4 k0, k1, v; float b; };
template <int DK>
__device__ __forceinline__ void stage_load(StageRegs<DK>& sr, const bf16_t* K, int ldk, const bf16_t* V, int ldv, const float* bias, int kv0, int wid0) {
    const int tid = opaque_tid(wid0); constexpr int CPR = DK / 8;
    { const int row = tid / CPR, cc = tid % CPR; sr.k0 = *(const u32x4*)(K + (size_t)(kv0 + row) * ldk + cc * 8); }
    if (DK == 96 && tid < 256) { const int c = tid + 512, row = c / CPR, cc = c % CPR; sr.k1 = *(const u32x4*)(K + (size_t)(kv0 + row) * ldk + cc * 8); }
    { const int row = tid >> 3, cc = tid & 7; sr.v = *(const u32x4*)(V + (size_t)(kv0 + row) * ldv + cc * 8); }
    if (bias && tid < 64) sr.b = bias[kv0 + tid];
}
template <int DK>
__device__ __forceinline__ void stage_store(const StageRegs<DK>& sr, LAS unsigned char* lds, int buf, bool has_bias, int wid0) {
    const int tid = opaque_tid(wid0); constexpr int CPR = DK / 8; constexpr int KSTR = (DK == 96) ? KSTR96 : KSTR64;
    LAS unsigned char* kb = lds + ATT_K0 + buf * ATT_KBUF; LAS unsigned char* vb = lds + ATT_V0 + buf * ATT_VBUF;
    { const int row = tid / CPR, cc = tid % CPR; *(LAS u32x4*)(kb + row * KSTR + cc * 16) = sr.k0; }
    if (DK == 96 && tid < 256) { const int c = tid + 512, row = c / CPR, cc = c % CPR; *(LAS u32x4*)(kb + row * KSTR + cc * 16) = sr.k1; }
    { const int row = tid >> 3, cc = tid & 7; *(LAS u32x4*)(vb + (cc >> 2) * 4096 + row * 64 + (cc & 3) * 16) = sr.v; }
    if (has_bias && tid < 64) *(LAS float*)(lds + ATT_B0 + buf * 256 + tid * 4) = sr.b;
}

__device__ __forceinline__ void store_out(bf16_t* dst  , const f32x16& o0, const f32x16& o1, float scale, int hi) {
#pragma unroll
    for (int g = 0; g < 4; ++g) {
        u32x2 w; w.x = pk2(o0[4 * g] * scale, o0[4 * g + 1] * scale); w.y = pk2(o0[4 * g + 2] * scale, o0[4 * g + 3] * scale);
        *(u32x2*)(dst + 8 * g + 4 * hi) = w;
        u32x2 w1; w1.x = pk2(o1[4 * g] * scale, o1[4 * g + 1] * scale); w1.y = pk2(o1[4 * g + 2] * scale, o1[4 * g + 3] * scale);
        *(u32x2*)(dst + 32 + 8 * g + 4 * hi) = w1;
    }
}

constexpr int DA_K0 = 0, DA_V0 = 3 * ATT_KBUF, DA_B0 = DA_V0 + 2 * ATT_VBUF, DA_END = DA_B0 + 3 * 256;
static_assert(DA_END <= LDS_BYTES, "dense attention LDS map");
template <int DK, int MODE>
__device__ __forceinline__ void dense_unit(LAS unsigned char* lds, const bf16_t* Q, int ldq, const bf16_t* K, int ldk, const bf16_t* V, int ldv,
                                           bf16_t* O  , const float* bias, const unsigned long long* maskbits  ,
                                           float alibiA, float c2, int qb, int wid0) {
    constexpr int KS = DK / 16; constexpr int KSTR = (DK == 96) ? KSTR96 : KSTR64; constexpr int CPR = DK / 8;
    const int tid = opaque_tid(wid0), lane = tid & 63, wv = __builtin_amdgcn_readfirstlane(tid >> 6), r = lane & 31, hi = lane >> 5;
    const int q0 = qb * 256, qw0 = q0 + wv * 32, tq = qw0 + r;
    const int NT = (q0 + 256) / 64;
    const int tlast = (qw0 + 31) >> 6;
    bf16x8 qf[KS];
#pragma unroll
    for (int s = 0; s < KS; ++s) qf[s] = *(const bf16x8*)(Q + (size_t)tq * ldq + s * 16 + hi * 8);
    const int vb = ((lane >> 4) & 1) * 32 + (lane & 3) * 8 + (4 * hi + ((lane & 15) >> 2)) * 64;
    const int kb = r * KSTR + hi * 16;
    SoftState st; st.m = NEG_BIG; st.l = 0.f; st.o0 = (f32x16){}; st.o1 = (f32x16){};
    const int krow0 = tid / CPR, kcc0 = tid % CPR, krow1 = (tid + 512) / CPR, kcc1 = (tid + 512) % CPR, vrow = tid >> 3, vcc = tid & 7;
    const bf16_t* kp0 = K + (size_t)krow0 * ldk + kcc0 * 8; const bf16_t* kp1 = K + (size_t)krow1 * ldk + kcc1 * 8; const bf16_t* vp = V + (size_t)vrow * ldv + vcc * 8;
    const int klds0 = krow0 * KSTR + kcc0 * 16, klds1 = krow1 * KSTR + kcc1 * 16, vlds = (vcc >> 2) * 4096 + vrow * 64 + (vcc & 3) * 16;
    u32x4 rk0, rk1, rv; float rbias = 0.f;
#define DA_LOADK(t) do { rk0 = *(const u32x4*)(kp0 + (size_t)(t) * 64 * ldk); if (DK == 96 && tid < 256) rk1 = *(const u32x4*)(kp1 + (size_t)(t) * 64 * ldk); if (MODE == 1 && tid < 64) rbias = bias[(t) * 64 + tid]; } while (0)
#define DA_LOADV(t) do { rv = *(const u32x4*)(vp + (size_t)(t) * 64 * ldv); } while (0)
#define DA_STOREK(slot) do { LAS unsigned char* kb_ = lds + DA_K0 + (slot) * ATT_KBUF; *(LAS u32x4*)(kb_ + klds0) = rk0; if (DK == 96 && tid < 256) *(LAS u32x4*)(kb_ + klds1) = rk1; \
        if (MODE == 1 && tid < 64) *(LAS float*)(lds + DA_B0 + (slot) * 256 + tid * 4) = rbias; } while (0)
#define DA_STOREV(slot) do { *(LAS u32x4*)(lds + DA_V0 + (slot) * ATT_VBUF + vlds) = rv; } while (0)
#define DA_CINIT(P0, P1, t, slot) do { const int kv0_ = (t) * 64; \
        if (MODE == 0) { P0 = (f32x16){}; P1 = (f32x16){}; } \
        else if (MODE == 1) { const LAS float* bl = (const LAS float*)(lds + DA_B0 + (slot) * 256); \
            _Pragma("unroll") for (int g = 0; g < 4; ++g) { const f32x4 b0_ = *(const LAS f32x4*)(bl + 8 * g + 4 * hi), b1_ = *(const LAS f32x4*)(bl + 32 + 8 * g + 4 * hi); \
                _Pragma("unroll") for (int e = 0; e < 4; ++e) { P0[4 * g + e] = b0_[e]; P1[4 * g + e] = b1_[e]; } } } \
        else { const float base_ = alibiA * (float)(kv0_ + 4 * hi); \
            _Pragma("unroll") for (int i = 0; i < 16; ++i) { P0[i] = base_ + alibiA * (float)((i & 3) + 8 * (i >> 2)); P1[i] = P0[i] + alibiA * 32.0f; } } } while (0)
#define DA_MASK(P0, P1, t, mb) do { const int kv0_ = (t) * 64; \
        if (MODE == 2) { const unsigned long long ms_ = (mb) >> (4 * hi); const unsigned lo_ = (unsigned)ms_, hw_ = (unsigned)(ms_ >> 32); \
            _Pragma("unroll") for (int i = 0; i < 16; ++i) { const unsigned bit_ = 1u << ((i & 3) + 8 * (i >> 2)); if (!(lo_ & bit_)) P0[i] = -INFINITY; if (!(hw_ & bit_)) P1[i] = -INFINITY; } } \
        else if (kv0_ + 63 > qw0) { \
            _Pragma("unroll") for (int i = 0; i < 16; ++i) { const int kv_ = kv0_ + crow(i, hi); if (kv_ > tq) P0[i] = -INFINITY; if (kv_ + 32 > tq) P1[i] = -INFINITY; } } } while (0)
#define DA_ROWMAX(MX, P0, P1) do { float a_ = __builtin_fmaxf(__builtin_fmaxf(P0[0], P0[1]), P1[0]), b_ = __builtin_fmaxf(__builtin_fmaxf(P0[2], P0[3]), P1[1]); a_ = __builtin_fmaxf(__builtin_fmaxf(a_, P1[2]), P1[3]); \
        _Pragma("unroll") for (int i = 4; i < 16; i += 4) { a_ = __builtin_fmaxf(__builtin_fmaxf(a_, P0[i]), P0[i + 1]); b_ = __builtin_fmaxf(__builtin_fmaxf(b_, P0[i + 2]), P0[i + 3]); a_ = __builtin_fmaxf(__builtin_fmaxf(a_, P1[i]), P1[i + 1]); b_ = __builtin_fmaxf(__builtin_fmaxf(b_, P1[i + 2]), P1[i + 3]); } \
        a_ = __builtin_fmaxf(a_, b_); const auto rr_ = __builtin_amdgcn_permlane32_swap(__float_as_uint(a_), __float_as_uint(a_), false, false); \
        MX = __builtin_fmaxf(__uint_as_float(rr_[0]), __uint_as_float(rr_[1])); } while (0)
    __syncthreads();
    DA_LOADK(0); DA_LOADV(0); DA_STOREK(0); DA_STOREV(0);
    DA_LOADK(1); DA_STOREK(1);
    DA_LOADK(2); DA_LOADV(1);
    __syncthreads();
    f32x16 pa0, pa1, pb0, pb1;
    unsigned long long mb_nxt = 0ull, mb_nn = 0ull;
    {
        DA_CINIT(pa0, pa1, 0, 0);
        qk_tile<KS>(pa0, pa1, lds + DA_K0, KSTR, qf, r, hi);
        unsigned long long mb0 = 0ull;
        if (MODE == 2) { mb0 = maskbits[(size_t)tq * 128]; if (1 <= tlast) mb_nxt = maskbits[(size_t)tq * 128 + 1]; }
        DA_MASK(pa0, pa1, 0, mb0);
        float mx; DA_ROWMAX(mx, pa0, pa1);
        st.m = __builtin_fmaxf(st.m, mx);
    }
    int ks_next = 1, ks_store = 2, vs_cur = 0;
#define DA_STEP(C0, C1, N0, N1, t) do { \
        if (MODE == 2) { mb_nn = 0ull; if ((t) + 2 <= tlast) mb_nn = maskbits[(size_t)tq * 128 + (t) + 2]; } \
        if ((t) <= tlast) { \
              \
            DA_CINIT(N0, N1, (t) + 1, ks_next); \
            bf16x8 pf0, pf1, pf2, pf3; \
            bf16x8 kf[2 * KS]; { const LAS unsigned char* k_ = lds + DA_K0 + ks_next * ATT_KBUF + kb; \
                _Pragma("unroll") for (int s_ = 0; s_ < KS; ++s_) { kf[2 * s_] = *(const LAS bf16x8*)(k_ + s_ * 32); kf[2 * s_ + 1] = *(const LAS bf16x8*)(k_ + 32 * KSTR + s_ * 32); } } \
            __builtin_amdgcn_sched_barrier(0); \
            _Pragma("unroll") for (int s_ = 0; s_ < KS; ++s_) { N0 = __builtin_amdgcn_mfma_f32_32x32x16_bf16(kf[2 * s_], qf[s_], N0, 0, 0, 0); N1 = __builtin_amdgcn_mfma_f32_32x32x16_bf16(kf[2 * s_ + 1], qf[s_], N1, 0, 0, 0); } \
            sm_exp_pack(st, C0, C1, c2, pf0, pf1, pf2, pf3); \
            _Pragma("unroll") for (int g_ = 0; g_ < 2 * KS; ++g_) { __builtin_amdgcn_sched_group_barrier(0x8, 1, 0); __builtin_amdgcn_sched_group_barrier(0x2, (KS == 6 ? 9 : 14), 0); } \
            __builtin_amdgcn_sched_barrier(0); \
              \
            bf16x8 vf[8]; { const LAS unsigned char* v_ = lds + DA_V0 + vs_cur * ATT_VBUF + vb; \
                _Pragma("unroll") for (int s_ = 0; s_ < 4; ++s_) { vf[2 * s_] = vfrag(v_ + s_ * 1024); vf[2 * s_ + 1] = vfrag(v_ + 4096 + s_ * 1024); } } \
            __builtin_amdgcn_sched_barrier(0); \
            float mx_ = -INFINITY; \
            if ((t) < tlast) { DA_MASK(N0, N1, (t) + 1, mb_nxt); DA_ROWMAX(mx_, N0, N1); } \
            __builtin_amdgcn_sched_barrier(0); \
            st.o0 = __builtin_amdgcn_mfma_f32_32x32x16_bf16(vf[0], pf0, st.o0, 0, 0, 0); st.o1 = __builtin_amdgcn_mfma_f32_32x32x16_bf16(vf[1], pf0, st.o1, 0, 0, 0); \
            st.o0 = __builtin_amdgcn_mfma_f32_32x32x16_bf16(vf[2], pf1, st.o0, 0, 0, 0); st.o1 = __builtin_amdgcn_mfma_f32_32x32x16_bf16(vf[3], pf1, st.o1, 0, 0, 0); \
            st.o0 = __builtin_amdgcn_mfma_f32_32x32x16_bf16(vf[4], pf2, st.o0, 0, 0, 0); st.o1 = __builtin_amdgcn_mfma_f32_32x32x16_bf16(vf[5], pf2, st.o1, 0, 0, 0); \
            st.o0 = __builtin_amdgcn_mfma_f32_32x32x16_bf16(vf[6], pf3, st.o0, 0, 0, 0); st.o1 = __builtin_amdgcn_mfma_f32_32x32x16_bf16(vf[7], pf3, st.o1, 0, 0, 0); \
            __builtin_amdgcn_sched_barrier(0); \
            if (__any((mx_ - st.m) * c2 > SM_THR)) { const float mn_ = __builtin_fmaxf(st.m, mx_); const float al_ = __builtin_amdgcn_exp2f((st.m - mn_) * c2); st.l *= al_; st.o0 *= al_; st.o1 *= al_; st.m = mn_; } \
        } \
        if ((t) + 2 < NT) DA_STOREK(ks_store); \
        if ((t) + 1 < NT) DA_STOREV(vs_cur ^ 1); \
        if ((t) + 3 < NT) DA_LOADK((t) + 3); \
        if ((t) + 2 < NT) DA_LOADV((t) + 2); \
        __syncthreads(); \
        mb_nxt = mb_nn; vs_cur ^= 1; ks_next = (ks_next == 2) ? 0 : ks_next + 1; ks_store = (ks_store == 2) ? 0 : ks_store + 1; } while (0)
    for (int t = 0; t < NT; t += 2) {
        DA_STEP(pa0, pa1, pb0, pb1, t);
        DA_STEP(pb0, pb1, pa0, pa1, t + 1);
    }
#undef DA_LOADK
#undef DA_LOADV
#undef DA_STOREK
#undef DA_STOREV
#undef DA_CINIT
#undef DA_MASK
#undef DA_ROWMAX
#undef DA_STEP
    const float l = swap32_sum(st.l);
    const float inv = l > 0.f ? 1.0f / l : 0.f;
    store_out(O + (size_t)tq * D, st.o0, st.o1, inv, hi);
}

constexpr int DSA_H1 = 0, DSA_H2 = 65536, DSA_INFO = 65536 + 32768;
__device__ __forceinline__ unsigned score_key32(float s) { const unsigned u = __float_as_uint(s); return u ^ ((unsigned)((int)u >> 31) | 0x80000000u); }
__device__ __forceinline__ unsigned score_key16(float s) { return score_key32(s) >> 16; }
__device__ __forceinline__ float relu_f(float x) { const int b_ = __builtin_bit_cast(int, x); return __builtin_bit_cast(float, b_ > 0 ? b_ : 0); }

struct KFrag { bf16x8 a00, a01, a10, a11; };
__device__ __forceinline__ void dsa_kload(KFrag& f, const bf16_t* kix  , int t, int r, int hi) {
    const bf16_t* p = kix + ((size_t)t * 64 + r) * 32 + hi * 8;
    f.a00 = *(const bf16x8*)p; f.a01 = *(const bf16x8*)(p + 16); f.a10 = *(const bf16x8*)(p + 1024); f.a11 = *(const bf16x8*)(p + 1024 + 16);
}
__device__ __forceinline__ void dsa_scores(f32x16& s0, f32x16& s1, const KFrag& f, const bf16x8 (&qi)[4][2], const float (&w)[4]) {
    s0 = (f32x16){}; s1 = (f32x16){};
#pragma unroll
    for (int ih = 0; ih < 4; ++ih) {
        f32x16 a = __builtin_amdgcn_mfma_f32_32x32x16_bf16(f.a00, qi[ih][0], (f32x16){}, 0, 0, 0); a = __builtin_amdgcn_mfma_f32_32x32x16_bf16(f.a01, qi[ih][1], a, 0, 0, 0);
        f32x16 c = __builtin_amdgcn_mfma_f32_32x32x16_bf16(f.a10, qi[ih][0], (f32x16){}, 0, 0, 0); c = __builtin_amdgcn_mfma_f32_32x32x16_bf16(f.a11, qi[ih][1], c, 0, 0, 0);
#pragma unroll
        for (int i = 0; i < 16; ++i) { s0[i] = __builtin_fmaf(w[ih], relu_f(a[i]), s0[i]); s1[i] = __builtin_fmaf(w[ih], relu_f(c[i]), s1[i]); }
    }
}
__device__ __forceinline__ void hist_add(LAS unsigned* hrow, int r, unsigned bin) { atomicAdd((unsigned*)(hrow + ((bin >> 1) ^ (unsigned)r)), 1u << ((bin & 1u) * 16u)); }

__device__ __forceinline__ void dsa_index_unit(LAS unsigned char* lds, const bf16_t* proj, const bf16_t* kidx, const float* side, unsigned long long* maskbits, int b, int qg, int wid0) {
    const int tid = opaque_tid(wid0), lane = tid & 63, wv = __builtin_amdgcn_readfirstlane(tid >> 6), r = lane & 31, hi = lane >> 5;
    const int tq = qg * 32 + r; const size_t rowq = (size_t)b * S + tq;
    const int nt = (qg >> 1) + 1;
    const int per = (nt + 7) >> 3; const int t_lo = wv * per, t_hi = (t_lo + per < nt) ? t_lo + per : nt;
    bf16x8 qi[4][2]; float w[4];
#pragma unroll
    for (int ih = 0; ih < 4; ++ih) { qi[ih][0] = *(const bf16x8*)(proj + rowq * NP + C_IQ + ih * 32 + hi * 8); qi[ih][1] = *(const bf16x8*)(proj + rowq * NP + C_IQ + ih * 32 + 16 + hi * 8);
        w[ih] = side[rowq * 32 + 4 + ih] * 0.5f; }
    LAS unsigned* h1 = (LAS unsigned*)(lds + DSA_H1) + r * 512; LAS unsigned* h2 = (LAS unsigned*)(lds + DSA_H2) + wv * 1024 + r * 32;
    LAS int* info = (LAS int*)(lds + DSA_INFO);
    const bf16_t* kix = kidx + (size_t)b * S * 32;
    const bool sel_all = (qg < 8);
    __syncthreads();
    if (!sel_all) {
        for (int i = tid; i < (DSA_INFO) / 16; i += NTHREADS) ((LAS u32x4*)lds)[i] = (u32x4){0u, 0u, 0u, 0u};
        __syncthreads();
        if (t_lo < t_hi) {
            KFrag cur, nxt; dsa_kload(cur, kix, t_lo, r, hi);
            for (int t = t_lo; t < t_hi; ++t) {
                if (t + 1 < t_hi) dsa_kload(nxt, kix, t + 1, r, hi);
                f32x16 s0, s1; dsa_scores(s0, s1, cur, qi, w);
                const int kv0 = t * 64;
                if (kv0 + 63 <= qg * 32) {
#pragma unroll
                    for (int i = 0; i < 16; ++i) { hist_add(h1, r, score_key32(s0[i]) >> 22); hist_add(h1, r, score_key32(s1[i]) >> 22); }
                } else {
#pragma unroll
                    for (int i = 0; i < 16; ++i) { const int kv = kv0 + crow(i, hi);
                        if (kv <= tq) hist_add(h1, r, score_key32(s0[i]) >> 22);
                        if (kv + 32 <= tq) hist_add(h1, r, score_key32(s1[i]) >> 22); }
                }
                cur = nxt;
            }
        }
        __syncthreads();
        { const int row = tid >> 4, part = tid & 15; const LAS unsigned* hr = (const LAS unsigned*)(lds + DSA_H1) + row * 512; unsigned cs = 0;
#pragma unroll 8
          for (int j = 0; j < 32; ++j) { const unsigned wd = hr[(part * 32 + j) ^ row]; cs += (wd & 0xffffu) + (wd >> 16); }
          unsigned suf = cs;
#pragma unroll
          for (int o = 1; o < 16; o <<= 1) { const unsigned t = __shfl_down(suf, o, 16); if (part + o < 16) suf += t; }
          const unsigned above = suf - cs;
          if (above < 256u && above + cs >= 256u) { unsigned acc = above; int bsel = part * 64; unsigned ab = above;
              for (int j = 31; j >= 0; --j) { const unsigned wd = hr[(part * 32 + j) ^ row]; const unsigned c1 = wd >> 16, c0 = wd & 0xffffu;
                  if (acc + c1 >= 256u) { bsel = part * 64 + 2 * j + 1; ab = acc; break; } acc += c1;
                  if (acc + c0 >= 256u) { bsel = part * 64 + 2 * j; ab = acc; break; } acc += c0; }
              info[row] = bsel; info[32 + row] = 256 - (int)ab; } }
        __syncthreads();
        const unsigned B1 = (unsigned)info[r];
        if (t_lo < t_hi) {
            KFrag cur, nxt; dsa_kload(cur, kix, t_lo, r, hi);
            for (int t = t_lo; t < t_hi; ++t) {
                if (t + 1 < t_hi) dsa_kload(nxt, kix, t + 1, r, hi);
                f32x16 s0, s1; dsa_scores(s0, s1, cur, qi, w);
                const int kv0 = t * 64;
#pragma unroll
                for (int i = 0; i < 16; ++i) { const int kv = kv0 + crow(i, hi);
                    { const unsigned k = score_key32(s0[i]); if (kv <= tq && (k >> 22) == B1) hist_add(h2, r, (k >> 16) & 63u); }
                    { const unsigned k = score_key32(s1[i]); if (kv + 32 <= tq && (k >> 22) == B1) hist_add(h2, r, (k >> 16) & 63u); } }
                cur = nxt;
            }
        }
        __syncthreads();
        { const int row = tid >> 4, part = tid & 15; unsigned cnt[4]; unsigned cs = 0; const unsigned need1 = (unsigned)info[32 + row];
          LAS unsigned* h2a = (LAS unsigned*)(lds + DSA_H2);
#pragma unroll
          for (int j = 0; j < 2; ++j) { unsigned c0 = 0, c1 = 0; const int wi = row * 32 + ((part * 2 + j) ^ row);
#pragma unroll
              for (int ww = 0; ww < 8; ++ww) { const unsigned wd = h2a[ww * 1024 + wi]; c0 += wd & 0xffffu; c1 += wd >> 16; }
              cnt[2 * j] = c0; cnt[2 * j + 1] = c1; cs += c0 + c1; }
          unsigned suf = cs;
#pragma unroll
          for (int o = 1; o < 16; o <<= 1) { const unsigned t = __shfl_down(suf, o, 16); if (part + o < 16) suf += t; }
          const unsigned above = suf - cs;
          if (above < need1 && above + cs >= need1) { unsigned acc = above; int bsel = 0; unsigned ab = above; bool found = false;
#pragma unroll
              for (int j = 3; j >= 0; --j) { if (!found) { if (acc + cnt[j] >= need1) { bsel = part * 4 + j; ab = acc; found = true; } else acc += cnt[j]; } }
              info[64 + row] = (int)(((unsigned)info[row] << 6) | (unsigned)bsel); info[96 + row] = (int)(need1 - ab);
              const int wi = row * 32 + ((bsel >> 1) ^ row); unsigned run = 0;
#pragma unroll
              for (int ww = 0; ww < 8; ++ww) { info[128 + row * 8 + ww] = (int)run; const unsigned wd = h2a[ww * 1024 + wi]; run += (bsel & 1) ? (wd >> 16) : (wd & 0xffffu); } } }
        __syncthreads();
    }
    const unsigned T = sel_all ? 0u : (unsigned)info[64 + r];
    const unsigned need2 = sel_all ? 0x7fffffffu : (unsigned)info[96 + r];
    unsigned tc = sel_all ? 0u : (unsigned)info[128 + r * 8 + wv];
    if (t_lo < t_hi) {
        KFrag cur, nxt; dsa_kload(cur, kix, t_lo, r, hi);
        for (int t = t_lo; t < t_hi; ++t) {
            if (t + 1 < t_hi) dsa_kload(nxt, kix, t + 1, r, hi);
            f32x16 s0, s1; dsa_scores(s0, s1, cur, qi, w);
            const int kv0 = t * 64; unsigned words[2];
#pragma unroll
            for (int half = 0; half < 2; ++half) {
                unsigned gt = 0, eq = 0;
#pragma unroll
                for (int i = 0; i < 16; ++i) { const int kv = kv0 + 32 * half + crow(i, hi); const unsigned k = score_key16(half ? s1[i] : s0[i]);
                    const unsigned v = (kv <= tq) ? 1u : 0u; gt |= ((k > T) ? v : 0u) << i; eq |= ((k == T) ? v : 0u) << i; }
                unsigned sel = gt;
                if (__any(eq != 0u)) {
                    const unsigned a0 = __popc(eq & 0xfu), a1 = __popc(eq & 0xf0u), a2 = __popc(eq & 0xf00u), a3 = __popc(eq & 0xf000u);
                    const unsigned own = a0 | (a1 << 8) | (a2 << 16) | (a3 << 24); const unsigned oth = __shfl_xor(own, 32);
                    const unsigned b0 = oth & 255u, b1 = (oth >> 8) & 255u, b2 = (oth >> 16) & 255u, b3 = oth >> 24;
                    unsigned pre[4]; const unsigned hb = hi ? 1u : 0u;
                    pre[0] = tc + hb * b0; pre[1] = tc + a0 + b0 + hb * b1; pre[2] = tc + a0 + b0 + a1 + b1 + hb * b2; pre[3] = tc + a0 + b0 + a1 + b1 + a2 + b2 + hb * b3;
#pragma unroll
                    for (int g = 0; g < 4; ++g) { unsigned rk = pre[g];
#pragma unroll
                        for (int e = 0; e < 4; ++e) { const unsigned bit = 1u << (4 * g + e); if (eq & bit) { if (rk < need2) sel |= bit; ++rk; } } }
                    tc += a0 + a1 + a2 + a3 + b0 + b1 + b2 + b3;
                }
                unsigned wbits = (sel & 0xfu) | ((sel & 0xf0u) << 4) | ((sel & 0xf00u) << 8) | ((sel & 0xf000u) << 12);
                wbits <<= 4 * hi;
                wbits |= __shfl_xor(wbits, 32);
                words[half] = wbits;
            }
            if (hi == 0) maskbits[(size_t)tq * 128 + t] = (unsigned long long)words[0] | ((unsigned long long)words[1] << 32);
            cur = nxt;
        }
    }
}

constexpr int NSA_IMP = ATT_EXTRA;
constexpr int NSA_SEL = NSA_IMP + 32768;
constexpr int NSA_UNI = NSA_SEL + 1024;
constexpr int NSA_LIST = NSA_UNI + 64;
constexpr int NSA_OT = NSA_LIST + 1024;
static_assert(NSA_OT + 65536 <= LDS_BYTES, "NSA LDS map");

__device__ __forceinline__ void nsa_unit(LAS unsigned char* lds, const bf16_t* proj, const float* side, const bf16_t* kc, const bf16_t* vc, bf16_t* ocat, int b, int q64, int wid0) {
    const int tid = opaque_tid(wid0), lane = tid & 63, wv = __builtin_amdgcn_readfirstlane(tid >> 6), r = lane & 31, hi = lane >> 5;
    const int t0 = q64 * 64, q8 = r >> 2, hd = r & 3, tq = t0 + wv * 8 + q8; const size_t rowq = (size_t)b * S + tq;
    const float c2 = 0.125f * LOG2E;
    const float slope = (hd == 0) ? 0.25f : (hd == 1 ? 0.0625f : (hd == 2 ? 0.015625f : 0.00390625f));
    const float A = 8.0f * slope;
    bf16x8 qf[4];
#pragma unroll
    for (int s = 0; s < 4; ++s) qf[s] = *(const bf16x8*)(proj + rowq * NP + C_NQ + hd * 64 + s * 16 + hi * 8);
    const float g0 = sigmoid_f(side[rowq * 32 + 8 + hd * 3 + 0]), g1 = sigmoid_f(side[rowq * 32 + 8 + hd * 3 + 1]), g2 = sigmoid_f(side[rowq * 32 + 8 + hd * 3 + 2]);
    const int vb = ((lane >> 4) & 1) * 32 + (lane & 3) * 8 + (4 * hi + ((lane & 15) >> 2)) * 64;
    LAS float* imp = (LAS float*)(lds + NSA_IMP) + wv * 1024;
    LAS unsigned* selw = (LAS unsigned*)(lds + NSA_SEL) + wv * 32;
    LAS unsigned* uni = (LAS unsigned*)(lds + NSA_UNI);
    LAS int* list = (LAS int*)(lds + NSA_LIST);
    LAS float* otl = (LAS float*)(lds + NSA_OT) + wv * 2048 + lane;
    StageRegs<64> sr;
    __syncthreads();
    for (int i = lane; i < 1024; i += 64) imp[i] = 0.f;
    if (tid < 4) uni[tid] = 0u;
    const bf16_t* kcb = kc + (size_t)b * 512 * 64; const bf16_t* vcb = vc + (size_t)b * 512 * 64;
    const int ntc = (((t0 + 32) >> 4) >> 6) + 1;
    SoftState st; st.m = NEG_BIG; st.l = 0.f; st.o0 = (f32x16){}; st.o1 = (f32x16){};
    for (int pass = 0; pass < 2; ++pass) {
        stage_load<64>(sr, kcb, 64, vcb, 64, nullptr, 0, wid0);
        __syncthreads();
        stage_store<64>(sr, lds, 0, false, wid0);
        if (1 < ntc) stage_load<64>(sr, kcb, 64, vcb, 64, nullptr, 64, wid0);
        __syncthreads();
        float rl = 0.f;
        if (pass == 1) { const float l = st.l + __shfl_xor(st.l, 32); rl = l > 0.f ? 1.0f / l : 0.f; }
        const float mc = st.m * c2;
        for (int t = 0; t < ntc; ++t) {
            const int buf = t & 1;
            f32x16 p0, p1; const int n0 = t * 64;
            { const float base = A * (float)(16 * (n0 + 4 * hi) + 31);
#pragma unroll
              for (int i = 0; i < 16; ++i) { p0[i] = base + A * 16.0f * (float)((i & 3) + 8 * (i >> 2)); p1[i] = p0[i] + A * 512.0f; } }
            qk_tile<4>(p0, p1, lds + ATT_K0 + buf * ATT_KBUF, KSTR64, qf, r, hi);
#pragma unroll
            for (int i = 0; i < 16; ++i) { const int n = n0 + crow(i, hi); if (16 * n + 31 > tq) p0[i] = -INFINITY; if (16 * (n + 32) + 31 > tq) p1[i] = -INFINITY; }
            if (pass == 0) {
                const float mx = tile_max(p0, p1); const float mn = fmaxf(st.m, mx);
                const float al = __builtin_amdgcn_exp2f((st.m - mn) * c2); st.l *= al; st.m = mn; const float mcc = mn * c2; float sum = 0.f;
#pragma unroll
                for (int i = 0; i < 16; ++i) sum += __builtin_amdgcn_exp2f(__builtin_fmaf(p0[i], c2, -mcc)) + __builtin_amdgcn_exp2f(__builtin_fmaf(p1[i], c2, -mcc));
                st.l += sum;
            } else {
#pragma unroll
                for (int i = 0; i < 16; ++i) { p0[i] = __builtin_amdgcn_exp2f(__builtin_fmaf(p0[i], c2, -mc)) * rl; p1[i] = __builtin_amdgcn_exp2f(__builtin_fmaf(p1[i], c2, -mc)) * rl; }
#pragma unroll
                for (int half = 0; half < 2; ++half)
#pragma unroll
                    for (int g = 0; g < 4; ++g) { const f32x16& pp = half ? p1 : p0;
                        float s4 = (pp[4 * g] + pp[4 * g + 1]) + (pp[4 * g + 2] + pp[4 * g + 3]); float s3 = pp[4 * g + 3];
                        s4 += quad_xor1(s4); s4 += quad_xor2(s4); s3 += quad_xor1(s3); s3 += quad_xor2(s3);
                        const int j1 = 16 * t + 8 * half + 2 * g + hi;
                        if (hd == 0) atomicAdd((float*)(imp + q8 * 128 + j1), s4);
                        if (hd == 0 && j1 + 1 < 128) atomicAdd((float*)(imp + q8 * 128 + j1 + 1), s3); }
                pv_tile(st.o0, st.o1, p0, p1, lds + ATT_V0 + buf * ATT_VBUF, vb);
            }
            if (t + 1 < ntc) stage_store<64>(sr, lds, buf ^ 1, false, wid0);
            if (t + 2 < ntc) stage_load<64>(sr, kcb, 64, vcb, 64, nullptr, (t + 2) * 64, wid0);
            __syncthreads();
        }
    }
#pragma unroll
    for (int i = 0; i < 16; ++i) { otl[i * 64] = st.o0[i] * g0; otl[(16 + i) * 64] = st.o1[i] * g0; }
    {
        const int cur = q64;
        for (int qq = 0; qq < 8; ++qq) {
            float v0 = imp[qq * 128 + lane], v1 = imp[qq * 128 + 64 + lane];
            { const int j0 = lane, j1 = lane + 64;
              if (j0 == 0 || j0 == cur) v0 = INFINITY; else if (j0 > cur) v0 = -INFINITY;
              if (j1 == cur) v1 = INFINITY; else if (j1 > cur) v1 = -INFINITY; }
            int rk0 = 0, rk1 = 0;
#pragma unroll
            for (int i = 0; i < 64; ++i) {
                const float ai = __builtin_bit_cast(float, __builtin_amdgcn_readlane(__builtin_bit_cast(int, v0), i));
                const float bi = __builtin_bit_cast(float, __builtin_amdgcn_readlane(__builtin_bit_cast(int, v1), i));
                rk0 += ((ai > v0) || (ai == v0 && i < lane)) ? 1 : 0;
                rk0 += (bi > v0) ? 1 : 0;
                rk1 += (ai >= v1) ? 1 : 0;
                rk1 += ((bi > v1) || (bi == v1 && i < lane)) ? 1 : 0;
            }
            const unsigned long long slo = __ballot(rk0 < 16 && v0 > -INFINITY), shi = __ballot(rk1 < 16 && v1 > -INFINITY);
            if (lane == 0) { selw[qq * 4 + 0] = (unsigned)slo; selw[qq * 4 + 1] = (unsigned)(slo >> 32); selw[qq * 4 + 2] = (unsigned)shi; selw[qq * 4 + 3] = (unsigned)(shi >> 32);
                atomicOr((unsigned*)(uni + 0), (unsigned)slo); atomicOr((unsigned*)(uni + 1), (unsigned)(slo >> 32)); atomicOr((unsigned*)(uni + 2), (unsigned)shi); atomicOr((unsigned*)(uni + 3), (unsigned)(shi >> 32)); }
        }
    }
    __syncthreads();
    if (tid == 0) { int n = 0; for (int wd = 0; wd < 4; ++wd) { unsigned u = uni[wd]; while (u) { const int j = __ffs(u) - 1; u &= u - 1; list[n++] = wd * 32 + j; } } list[131] = n; }
    __syncthreads();
    {
        const unsigned m0 = selw[q8 * 4 + 0], m1 = selw[q8 * 4 + 1], m2 = selw[q8 * 4 + 2], m3 = selw[q8 * 4 + 3];
        const int nl = list[131];
        const bf16_t* Ks = proj + (size_t)b * S * NP + C_KSEL; const bf16_t* Vs = proj + (size_t)b * S * NP + C_VSEL;
        st.m = NEG_BIG; st.l = 0.f; st.o0 = (f32x16){}; st.o1 = (f32x16){};
        stage_load<64>(sr, Ks, NP, Vs, NP, nullptr, list[0] * 64, wid0);
        stage_store<64>(sr, lds, 0, false, wid0);
        if (1 < nl) stage_load<64>(sr, Ks, NP, Vs, NP, nullptr, list[1] * 64, wid0);
        __syncthreads();
        for (int t = 0; t < nl; ++t) {
            const int buf = t & 1; const int j = list[t];
            const unsigned mw = (j < 32) ? m0 : (j < 64 ? m1 : (j < 96 ? m2 : m3));
            const bool mine = (mw >> (j & 31)) & 1u;
            if (__any(mine)) {
                f32x16 p0, p1; const int kv0 = j * 64;
                { const float base = A * (float)(kv0 + 4 * hi);
#pragma unroll
                  for (int i = 0; i < 16; ++i) { p0[i] = base + A * (float)((i & 3) + 8 * (i >> 2)); p1[i] = p0[i] + A * 32.0f; } }
                qk_tile<4>(p0, p1, lds + ATT_K0 + buf * ATT_KBUF, KSTR64, qf, r, hi);
#pragma unroll
                for (int i = 0; i < 16; ++i) { const int kv = kv0 + crow(i, hi); if (!mine || kv > tq) p0[i] = -INFINITY; if (!mine || kv + 32 > tq) p1[i] = -INFINITY; }
                { bf16x8 f0, f1, f2, f3; softmax_pack(st, p0, p1, c2, f0, f1, f2, f3); pv_frag(st.o0, st.o1, f0, f1, f2, f3, lds + ATT_V0 + buf * ATT_VBUF, vb); }
            }
            if (t + 1 < nl) stage_store<64>(sr, lds, buf ^ 1, false, wid0);
            if (t + 2 < nl) stage_load<64>(sr, Ks, NP, Vs, NP, nullptr, list[t + 2] * 64, wid0);
            __syncthreads();
        }
        const float l = swap32_sum(st.l); const float sc = l > 0.f ? g1 / l : 0.f;
#pragma unroll
        for (int i = 0; i < 16; ++i) { otl[i * 64] += st.o0[i] * sc; otl[(16 + i) * 64] += st.o1[i] * sc; }
    }
    {
        const bf16_t* Kw = proj + (size_t)b * S * NP + C_KWIN; const bf16_t* Vw = proj + (size_t)b * S * NP + C_VWIN;
        const int tw0 = (q64 >= 8) ? q64 - 8 : 0, ntw = q64 - tw0 + 1;
        st.m = NEG_BIG; st.l = 0.f; st.o0 = (f32x16){}; st.o1 = (f32x16){};
        stage_load<64>(sr, Kw, NP, Vw, NP, nullptr, tw0 * 64, wid0);
        stage_store<64>(sr, lds, 0, false, wid0);
        if (1 < ntw) stage_load<64>(sr, Kw, NP, Vw, NP, nullptr, tw0 * 64 + 64, wid0);
        __syncthreads();
        for (int t = 0; t < ntw; ++t) {
            const int buf = t & 1; const int kv0 = (tw0 + t) * 64;
            f32x16 p0, p1;
            { const float base = A * (float)(kv0 + 4 * hi);
#pragma unroll
              for (int i = 0; i < 16; ++i) { p0[i] = base + A * (float)((i & 3) + 8 * (i >> 2)); p1[i] = p0[i] + A * 32.0f; } }
            qk_tile<4>(p0, p1, lds + ATT_K0 + buf * ATT_KBUF, KSTR64, qf, r, hi);
#pragma unroll
            for (int i = 0; i < 16; ++i) { const int kv = kv0 + crow(i, hi); if (kv > tq || kv + 512 <= tq) p0[i] = -INFINITY; if (kv + 32 > tq || kv + 32 + 512 <= tq) p1[i] = -INFINITY; }
            { bf16x8 f0, f1, f2, f3; softmax_pack(st, p0, p1, c2, f0, f1, f2, f3); pv_frag(st.o0, st.o1, f0, f1, f2, f3, lds + ATT_V0 + buf * ATT_VBUF, vb); }
            if (t + 1 < ntw) stage_store<64>(sr, lds, buf ^ 1, false, wid0);
            if (t + 2 < ntw) stage_load<64>(sr, Kw, NP, Vw, NP, nullptr, kv0 + 128, wid0);
            __syncthreads();
        }
        const float l = swap32_sum(st.l); const float sc = l > 0.f ? g2 / l : 0.f;
#pragma unroll
        for (int i = 0; i < 16; ++i) { st.o0[i] = otl[i * 64] + st.o0[i] * sc; st.o1[i] = otl[(16 + i) * 64] + st.o1[i] * sc; }
    }
    store_out(ocat + rowq * D + 768 + hd * 64, st.o0, st.o1, 1.0f, hi);
}

__device__ __forceinline__ void phase_onorm(const bf16_t* ocat, const bf16_t* proj, const float* og, bf16_t* oa, int bid, int G, int wid0) {
    const int tid_ = opaque_tid(wid0); const int lane = tid_ & 63, wv = tid_ >> 6;
    for (int row = bid * 8 + wv; row < M; row += G * 8) {
        const int c = lane * 16;
        const u32x4 a0 = *(const u32x4*)(ocat + (size_t)row * D + c), a1 = *(const u32x4*)(ocat + (size_t)row * D + c + 8);
        const u32x4 z0 = *(const u32x4*)(proj + (size_t)row * NP + C_GZ + c), z1 = *(const u32x4*)(proj + (size_t)row * NP + C_GZ + c + 8);
        float v[16], z[16]; float s = 0.f;
#pragma unroll
        for (int e = 0; e < 4; ++e) { v[2 * e] = bflo(a0[e]); v[2 * e + 1] = bfhi(a0[e]); v[8 + 2 * e] = bflo(a1[e]); v[8 + 2 * e + 1] = bfhi(a1[e]);
            z[2 * e] = bflo(z0[e]); z[2 * e + 1] = bfhi(z0[e]); z[8 + 2 * e] = bflo(z1[e]); z[8 + 2 * e + 1] = bfhi(z1[e]); }
#pragma unroll
        for (int e = 0; e < 16; ++e) s += v[e] * v[e];
        s += __builtin_bit_cast(float, __builtin_amdgcn_update_dpp(0, __builtin_bit_cast(int, s), 0xB1, 0xf, 0xf, false));
        s += __builtin_bit_cast(float, __builtin_amdgcn_update_dpp(0, __builtin_bit_cast(int, s), 0x4E, 0xf, 0xf, false));
        s += __builtin_bit_cast(float, __builtin_amdgcn_update_dpp(0, __builtin_bit_cast(int, s), 0x141, 0xf, 0xf, false));
        s += __builtin_bit_cast(float, __builtin_amdgcn_update_dpp(0, __builtin_bit_cast(int, s), 0x140, 0xf, 0xf, false));
        const float rstd = 1.0f / sqrtf(s * (1.f / 256.f) + EPS);
        float y[16];
#pragma unroll
        for (int e = 0; e < 16; ++e) y[e] = v[e] * rstd * og[c + e] * silu_f(z[e]);
        u32x4 w0, w1;
#pragma unroll
        for (int e = 0; e < 4; ++e) { w0[e] = pk2(y[2 * e], y[2 * e + 1]); w1[e] = pk2(y[8 + 2 * e], y[8 + 2 * e + 1]); }
        *(u32x4*)(oa + (size_t)row * D + c) = w0; *(u32x4*)(oa + (size_t)row * D + c + 8) = w1;
    }
}
__device__ __forceinline__ void phase_final(float* out, const float* g, int bid, int G, int wid0) {
    const int tid_ = opaque_tid(wid0); const int lane = tid_ & 63, wv = tid_ >> 6;
    for (int row = bid * 8 + wv; row < M; row += G * 8) {
        f32x4* xr = (f32x4*)(out + (size_t)row * D) + lane;
        f32x4 v[4]; float s = 0.f;
#pragma unroll
        for (int j = 0; j < 4; ++j) { v[j] = xr[64 * j]; s += (v[j][0] * v[j][0] + v[j][1] * v[j][1]) + (v[j][2] * v[j][2] + v[j][3] * v[j][3]); }
        const float rstd = 1.0f / sqrtf(wave_sum(s) * (1.f / D) + EPS);
#pragma unroll
        for (int j = 0; j < 4; ++j) { const f32x4 gg = *(const f32x4*)(g + (64 * j + lane) * 4); xr[64 * j] = v[j] * rstd * gg; }
    }
}

#define XB_TMO      128
#define XB_XCNT(j)  (256  + 64 * (j))
#define XB_XSUB(j)  (1280 + 64 * (j))
#define XB_XGEN(j)  (2304 + 64 * (j))
#define XB_TOP      3328
#define XB_TOPGEN   3392
#define XCD_BAR_WORDS 3456
#define XB_SPIN_CAP (1u << 22)
__device__ __forceinline__ unsigned xb_ld(unsigned* p)              { return __hip_atomic_load(p, __ATOMIC_RELAXED, __HIP_MEMORY_SCOPE_AGENT); }
__device__ __forceinline__ unsigned xb_add(unsigned* p, unsigned v) { return __hip_atomic_fetch_add(p, v, __ATOMIC_RELAXED, __HIP_MEMORY_SCOPE_AGENT); }
__device__ __forceinline__ unsigned xb_xcc_id() { return (unsigned)__builtin_amdgcn_s_getreg((3 << 11) | 20) & 0xFu; }
#define XB_SPIN(cond, bar) do { unsigned _sp = 0; while (cond) { __builtin_amdgcn_s_sleep(1); \
    if ((++_sp & 255u) == 0u) { if (xb_ld(&(bar)[XB_TMO])) break; if (_sp > XB_SPIN_CAP) { atomicAdd(&(bar)[XB_TMO], 1u); break; } } } } while (0)
__device__ __forceinline__ void xcd_barrier_complete(unsigned* bar, unsigned x, unsigned G, unsigned& nloc, unsigned& nx) {
    unsigned sum, cnt, mine, sp = 0u;
    for (;;) {
        sum = 0u; cnt = 0u; mine = 0u;
#pragma unroll
        for (unsigned j = 0; j < 16; ++j) { const unsigned c = xb_ld(&bar[XB_XCNT(j)]); sum += c; cnt += (c > 0u) ? 1u : 0u; mine = (j == x) ? c : mine; }
        if (sum == G) break;
        __builtin_amdgcn_s_sleep(1);
        if ((++sp & 255u) == 0u) { if (xb_ld(&bar[XB_TMO])) break; if (sp > XB_SPIN_CAP) { atomicAdd(&bar[XB_TMO], 1u); break; } }
    }
    nloc = mine > 0u ? mine : 1u; nx = cnt > 0u ? cnt : 1u;
}
__device__ __forceinline__ void grid_bar(unsigned* bar, volatile LAS unsigned* st, unsigned G, int wid0) {
    const int tid = opaque_tid(wid0);
    asm volatile("s_waitcnt vmcnt(0)" ::: "memory");
    __syncthreads();
    if (tid == 0) {
        const unsigned x = xb_xcc_id();
        unsigned nloc = st[0], nx = st[1];
        if (nloc == 0u) { xcd_barrier_complete(bar, x, G, nloc, nx); st[0] = nloc; st[1] = nx; }
        const unsigned old = xb_add(&bar[XB_XSUB(x)], 1u);
        const unsigned gen = old / nloc;
        if (old + 1u == (gen + 1u) * nloc) {
            __builtin_amdgcn_fence(__ATOMIC_RELEASE, "agent");
            asm volatile("s_waitcnt vmcnt(0)" ::: "memory");
            const unsigned og = xb_add(&bar[XB_TOP], 1u);
            const unsigned tg = og / nx;
            if (og + 1u == (tg + 1u) * nx) xb_add(&bar[XB_TOPGEN], 1u);
            else XB_SPIN(xb_ld(&bar[XB_TOPGEN]) == tg, bar);
            __builtin_amdgcn_fence(__ATOMIC_ACQUIRE, "agent");
            xb_add(&bar[XB_XGEN(x)], 1u);
            asm volatile("s_waitcnt vmcnt(0)" ::: "memory");
        } else {
            XB_SPIN(xb_ld(&bar[XB_XGEN(x)]) == gen, bar);
            __builtin_amdgcn_fence(__ATOMIC_ACQUIRE, "agent");
            asm volatile("s_waitcnt vmcnt(0)" ::: "memory");
        }
    }
    __syncthreads();
}

constexpr int N_PHASES = 16;
__global__ void __launch_bounds__(NTHREADS) hymba_fwd(Params P) {
    extern __shared__ __attribute__((aligned(16))) unsigned char lds_raw[];
    LAS unsigned char* lds = (LAS unsigned char*)lds_raw;
    const int bid = blockIdx.x, G = gridDim.x;
    const int wid0 = __builtin_amdgcn_readfirstlane((int)(threadIdx.x >> 6));
    volatile LAS unsigned* xst = (volatile LAS unsigned*)(lds + LDS_BYTES - 16);
    unsigned* xbar = (unsigned*)(P.ws + WS_CTL) + 4096 + P.bar_region * XCD_BAR_WORDS;
    if (threadIdx.x == 0) { xst[0] = 0u; xst[1] = 0u; (void)xb_add(&xbar[XB_XCNT(xb_xcc_id())], 1u); }
    __syncthreads();
    unsigned char* ws = P.ws;
    bf16_t* proj = (bf16_t*)(ws + WS_PROJ); float* side = (float*)(ws + WS_SIDE);
    bf16_t* hbuf = (bf16_t*)(ws + WS_H); bf16_t* ocat = (bf16_t*)(ws + WS_OCAT);
#define PH(k) (P.ph_lo <= (k) && (k) < P.ph_hi)
#define SYNC(k) do { if (PH(k) && PH((k) + 1)) grid_bar(xbar, xst, (unsigned)G, wid0); } while (0)
    if (PH(0)) phase_prologue(P, lds, bid, G, wid0);
    if (PH(0) && PH(1)) cg::this_grid().sync();
#ifndef ATT_REP
#define ATT_REP 0
#endif
#ifndef PROBE_VAR
#define PROBE_VAR -1
#endif
#define LAYER(l, base) do { \
    const float* mod = (const float*)(ws + WS_MOD) + (size_t)(l) * 4 * 3072; \
    const float* xin = ((l) == 0) ? P.in[0] : P.out; \
    if (PH((base) + 0)) phase_hnorm(xin, P.in[2] + (l) * D, mod, hbuf, bid, G, wid0); \
    SYNC((base) + 0); \
    if (PH((base) + 1)) { pg8::Gemm g{hbuf, (const bf16_t*)(ws + WS_WIN) + (size_t)(l) * NP * D, M, NP, D, D, D}; pg8::StaticOrder so; so.init(M, NP, G, bid); \
        pg8::EpiProj E{proj, side}; pg8::gemm_phase<pg8::EpiProj, true>(lds, g, so, E, wid0); } \
    SYNC((base) + 1); \
    if (PH((base) + 2)) phase_prep(P, (l), lds, bid, G, wid0); \
    SYNC((base) + 2); \
    if (PH((base) + 3)) { \
        { pg8::Gemm g{proj + C_QLAT, (const bf16_t*)(ws + WS_WUQ) + (size_t)(l) * 512 * 256, M, 512, 256, NP, 256}; pg8::StaticOrder so; so.init(M, 512, G, bid); \
          pg8::EpiQup E{(bf16_t*)(ws + WS_QMLA), (const float*)(ws + WS_RSTD), (const float*)(ws + WS_ROPE)}; pg8::gemm_phase<pg8::EpiQup, true>(lds, g, so, E, wid0); } \
        { pg8::Gemm g{proj + C_KVLAT, (const bf16_t*)(ws + WS_WUKV) + (size_t)(l) * 512 * 128, M, 512, 128, NP, 128}; pg8::StaticOrder so; so.init(M, 512, G, bid); \
          pg8::EpiKVup E{(bf16_t*)(ws + WS_KMLA), (bf16_t*)(ws + WS_VMLA), (const float*)(ws + WS_RSTD)}; pg8::gemm_phase<pg8::EpiKVup, true>(lds, g, so, E, wid0); } \
        for (int k = 0; k * G < 1024; ++k) { const int u = (k & 1) ? (k + 1) * G - 1 - bid : k * G + bid; if (u >= 1024 || u < 0) continue; const int qg = 255 - (u >> 2), b = u & 3; \
            dsa_index_unit(lds, proj, (const bf16_t*)(ws + WS_KIDX), side, (unsigned long long*)(ws + WS_MASK) + (size_t)b * S * 128, b, qg, wid0); } } \
    SYNC((base) + 3); \
    if (PH((base) + 4)) { \
        for (int i = bid; i < 512; i += G) { const int ii = i & 255, bh = ii >> 4, qb = (i < 256) ? (ii & 15) : 31 - (ii & 15), b = bh >> 2, hd = bh & 3; const size_t rb = (size_t)b * S; \
            dense_unit<96, 0>(lds, (const bf16_t*)(ws + WS_QMLA) + rb * 384 + hd * 96, 384, (const bf16_t*)(ws + WS_KMLA) + rb * 384 + hd * 96, 384, \
                              (const bf16_t*)(ws + WS_VMLA) + rb * 256 + hd * 64, 256, ocat + rb * D + hd * 64, nullptr, nullptr, 0.f, 0.10206207261596577f * LOG2E, qb, wid0); } \
        for (int rep = 0; rep < (((ATT_REP & 2) && (l) == 0) ? 2 : 1); ++rep) for (int i = bid; i < 512; i += G) { const int ii = i & 255, bh = ii >> 4, qb = (i < 256) ? (ii & 15) : 31 - (ii & 15), b = bh >> 2, hd = bh & 3; const size_t rb = (size_t)b * S; \
            dense_unit<64, 1>(lds, proj + rb * NP + C_FQ + hd * 64, NP, proj + rb * NP + C_FK + hd * 64, NP, proj + rb * NP + C_FV + hd * 64, NP, \
                              ocat + rb * D + 256 + hd * 64, (const float*)(ws + WS_FB) + (size_t)bh * S, nullptr, 0.f, 0.125f * LOG2E, qb, wid0); } \
        for (int rep = 0; rep < (((ATT_REP & 4) && (l) == 0) ? 2 : 1); ++rep) for (int i = bid; i < 512; i += G) { const int ii = i & 255, bh = ii >> 4, qb = (i < 256) ? (ii & 15) : 31 - (ii & 15), b = bh >> 2, hd = bh & 3; const size_t rb = (size_t)b * S; \
            const float slope = (hd == 0) ? 0.25f : (hd == 1 ? 0.0625f : (hd == 2 ? 0.015625f : 0.00390625f)); \
            dense_unit<64, 2>(lds, proj + rb * NP + C_DQ + hd * 64, NP, proj + rb * NP + C_DK + hd * 64, NP, proj + rb * NP + C_DV + hd * 64, NP, \
                              ocat + rb * D + 512 + hd * 64, nullptr, (const unsigned long long*)(ws + WS_MASK) + rb * 128, 8.0f * slope, 0.125f * LOG2E, qb, wid0); } \
        for (int rep = 0; rep < (((ATT_REP & 8) && (l) == 0) ? 2 : 1); ++rep) for (int u = bid; u < 512; u += G) { const int b = u >> 7, q64 = u & 127; \
            nsa_unit(lds, proj, side, (const bf16_t*)(ws + WS_KC), (const bf16_t*)(ws + WS_VC), ocat, b, q64, wid0); } } \
    SYNC((base) + 4); \
    if (PH((base) + 5)) phase_onorm(ocat, proj, P.in[14] + (l) * D, hbuf, bid, G, wid0); \
    SYNC((base) + 5); \
    if (PH((base) + 6)) { pg8::Gemm g{hbuf, (const bf16_t*)(ws + WS_WOUT) + (size_t)(l) * D * D, M, D, D, D, D}; pg8::StaticOrder so; so.init(M, D, G, bid); \
        pg8::EpiOut E{xin, P.out, mod + 2048}; pg8::gemm_phase<pg8::EpiOut, true>(lds, g, so, E, wid0); } \
    SYNC((base) + 6); \
} while (0)
    LAYER(0, 1);
    LAYER(1, 8);
    if (PH(15)) phase_final(P.out, P.in[16], bid, G, wid0);
#undef LAYER
#undef PH
#undef SYNC
}


#ifdef DBG_GROUP
#ifndef DBG_LAYER
#define DBG_LAYER 1
#endif
__device__ __forceinline__ float dbg_bf(const bf16_t* p) { return bf2f(*p); }
__device__ const int dbg_rows[48] = {0, 1, 2, 15, 30, 31, 32, 47, 63, 64, 65, 127, 128, 200, 255, 256, 257, 300, 511, 512, 513, 700, 1000, 1023, 1024, 1025, 1500, 2047, 2048, 3000, 3333, 4095, 4096, 4500, 5000, 5555, 6143, 6144, 7000, 7777, 8000, 8100, 8127, 8128, 8160, 8190, 8191, 4242};
template <class ScoreFn, class VFn>
__device__ __forceinline__ float dbg_attn(int k_lo, int k_hi, ScoreFn score, VFn vload, int lane) {
    float m = -INFINITY, l = 0.f, acc = 0.f;
    for (int kv = k_lo; kv <= k_hi; ++kv) {
        const float sc = score(kv);
        if (sc == -INFINITY) continue;
        const float mn = fmaxf(m, sc); const float al = (m == -INFINITY) ? 0.f : __expf(m - mn); const float p = __expf(sc - mn);
        l = l * al + p; acc = acc * al + p * vload(kv, lane); m = mn;
    }
    return l > 0.f ? acc / l : 0.f;
}
__global__ void __launch_bounds__(64) dbg_check(Params P) {
    const int lane = threadIdx.x, wid = blockIdx.x; const int hd = wid & 3, ri = (wid >> 2) % 48, b = (wid >> 2) / 48; const int t = dbg_rows[ri];
    unsigned char* ws = P.ws; const bf16_t* proj = (const bf16_t*)(ws + WS_PROJ); const float* side = (const float*)(ws + WS_SIDE);
    const bf16_t* ocat = (const bf16_t*)(ws + WS_OCAT); const size_t rowq = (size_t)b * S + t; const size_t rb = (size_t)b * S;
    float* scratch = (float*)(ws + WS_H) + (size_t)wid * 16384;
    float ref = 0.f; int grp = DBG_GROUP % 10;
    const float slope = (hd == 0) ? 0.25f : (hd == 1 ? 0.0625f : (hd == 2 ? 0.015625f : 0.00390625f));
    if (grp == 0) {
        const bf16_t* q = (const bf16_t*)(ws + WS_QMLA) + rowq * 384 + hd * 96; const bf16_t* K = (const bf16_t*)(ws + WS_KMLA) + rb * 384 + hd * 96; const bf16_t* V = (const bf16_t*)(ws + WS_VMLA) + rb * 256 + hd * 64;
        const float q0 = dbg_bf(q + lane), q1 = lane < 32 ? dbg_bf(q + 64 + lane) : 0.f;
        ref = dbg_attn(0, t, [&](int kv) { float pr = q0 * dbg_bf(K + (size_t)kv * 384 + lane) + (lane < 32 ? q1 * dbg_bf(K + (size_t)kv * 384 + 64 + lane) : 0.f); return wave_sum(pr) * 0.10206207261596577f; },
                       [&](int kv, int d) { return dbg_bf(V + (size_t)kv * 256 + d); }, lane);
    } else if (grp == 1) {
        const bf16_t* q = proj + rowq * NP + C_FQ + hd * 64; const bf16_t* K = proj + rb * NP + C_FK + hd * 64; const bf16_t* V = proj + rb * NP + C_FV + hd * 64; const float* fb = (const float*)(ws + WS_FB) + (size_t)(b * 4 + hd) * S;
        const float q0 = dbg_bf(q + lane); const float ft = fb[t];
        ref = dbg_attn(0, t, [&](int kv) { return wave_sum(q0 * dbg_bf(K + (size_t)kv * NP + lane)) * 0.125f + (fb[kv] - ft) * 0.125f; },
                       [&](int kv, int d) { return dbg_bf(V + (size_t)kv * NP + d); }, lane);
    } else if (grp == 2) {
        float* sc = scratch; unsigned char* selb = (unsigned char*)(scratch + 8192);
        const int ih = lane >> 4, dd = (lane & 15) * 2;
        const float qa = dbg_bf(proj + rowq * NP + C_IQ + ih * 32 + dd), qb2 = dbg_bf(proj + rowq * NP + C_IQ + ih * 32 + dd + 1); const float wgt = side[rowq * 32 + 4 + ih] * 0.5f;
        for (int kv = 0; kv <= t; ++kv) { float pr = qa * dbg_bf(proj + (rb + kv) * NP + C_IK + dd) + qb2 * dbg_bf(proj + (rb + kv) * NP + C_IK + dd + 1);
            pr += __shfl_xor(pr, 1); pr += __shfl_xor(pr, 2); pr += __shfl_xor(pr, 4); pr += __shfl_xor(pr, 8);
            float v = wgt * fmaxf(pr, 0.f); v += __shfl_xor(v, 16); v += __shfl_xor(v, 32); if (lane == 0) sc[kv] = v; }
        __threadfence_block();
        if (t + 1 <= 256) { for (int kv = lane; kv <= t; kv += 64) selb[kv] = 1; }
        else {
#ifdef DBG_KEY32
#define DBGKEY(x) ({ const unsigned u_ = __float_as_uint(x); (u_ & 0x80000000u) ? ~u_ : (u_ | 0x80000000u); })
            unsigned lo = 0, hi2 = 0xffffffffu;
#else
#define DBGKEY(x) score_key16(x)
            unsigned lo = 0, hi2 = 0xffffu;
#endif
            while (lo < hi2) { const unsigned mid = lo + ((hi2 - lo) >> 1) + ((hi2 - lo) & 1u); int c = 0; for (int kv = lane; kv <= t; kv += 64) c += (DBGKEY(sc[kv]) >= mid); c = (int)wave_sum((float)c); if (c >= 256) lo = mid; else hi2 = mid - 1; }
            const unsigned T = lo; int cgt = 0; for (int kv = lane; kv <= t; kv += 64) cgt += (DBGKEY(sc[kv]) > T); cgt = (int)wave_sum((float)cgt);
            int need = 256 - cgt; int run = 0;
            for (int k0 = 0; k0 <= t; k0 += 64) { const int kv = k0 + lane; const unsigned k = kv <= t ? DBGKEY(sc[kv]) : 0u; const bool eq = kv <= t && k == T, gt = kv <= t && k > T;
                const unsigned long long bm = __ballot(eq); const int before = __popcll(bm & ((1ull << lane) - 1ull));
                if (kv <= t) selb[kv] = (gt || (eq && run + before < need)) ? 1 : 0; run += __popcll(bm); }
        }
        __threadfence_block();
        const bf16_t* q = proj + rowq * NP + C_DQ + hd * 64; const bf16_t* K = proj + rb * NP + C_DK + hd * 64; const bf16_t* V = proj + rb * NP + C_DV + hd * 64; const float q0 = dbg_bf(q + lane);
        ref = dbg_attn(0, t, [&](int kv) { if (!selb[kv]) return -INFINITY; return wave_sum(q0 * dbg_bf(K + (size_t)kv * NP + lane)) * 0.125f - slope * (float)(t - kv); },
                       [&](int kv, int d) { return dbg_bf(V + (size_t)kv * NP + d); }, lane);
    } else {
        const int sub = DBG_GROUP / 10;
        const bf16_t* q = proj + rowq * NP + C_NQ; const float q0 = dbg_bf(q + hd * 64 + lane);
        const bf16_t* kc = (const bf16_t*)(ws + WS_KC) + (size_t)b * 512 * 64; const bf16_t* vc = (const bf16_t*)(ws + WS_VC) + (size_t)b * 512 * 64;
        float* pc = scratch;
        for (int h2 = 0; h2 < 4; ++h2) { const float qh = dbg_bf(q + h2 * 64 + lane); const float sl = (h2 == 0) ? 0.25f : (h2 == 1 ? 0.0625f : (h2 == 2 ? 0.015625f : 0.00390625f));
            float m = -INFINITY; for (int n = 0; n < 511; ++n) { if (16 * n + 31 > t) break; const float s_ = wave_sum(qh * dbg_bf(kc + n * 64 + lane)) * 0.125f - sl * (float)(t - (16 * n + 31)); if (lane == 0) pc[h2 * 512 + n] = s_; m = fmaxf(m, s_); }
            __threadfence_block(); float l = 0.f; for (int n = 0; n < 511 && 16 * n + 31 <= t; ++n) l += __expf(pc[h2 * 512 + n] - m);
            __threadfence_block(); for (int n = lane; n < 511; n += 64) pc[h2 * 512 + n] = (16 * n + 31 <= t) ? __expf(pc[h2 * 512 + n] - m) / l : 0.f; __threadfence_block(); }
        float oc = 0.f; for (int n = 0; n < 511 && 16 * n + 31 <= t; ++n) oc += pc[hd * 512 + n] * dbg_bf(vc + n * 64 + lane);
        const int cur = t >> 6; float v0, v1;
        { float i0 = 0.f, i1 = 0.f; for (int h2 = 0; h2 < 4; ++h2) for (int e = -1; e <= 3; ++e) { int n0 = 4 * lane + e, n1 = 4 * (lane + 64) + e; if (n0 >= 0 && n0 < 511) i0 += pc[h2 * 512 + n0]; if (n1 < 511) i1 += pc[h2 * 512 + n1]; }
          v0 = (lane == 0 || lane == cur) ? INFINITY : (lane > cur ? -INFINITY : i0); v1 = (lane + 64 == cur) ? INFINITY : (lane + 64 > cur ? -INFINITY : i1); }
        unsigned long long slo = 0, shi = 0;
        for (int it = 0; it < 16; ++it) { float mx = fmaxf(v0, v1); for (int o = 1; o < 64; o <<= 1) mx = fmaxf(mx, __shfl_xor(mx, o)); if (!(mx > -INFINITY)) break;
            const unsigned long long b0 = __ballot(v0 == mx), b1 = __ballot(v1 == mx);
            if (b0) { const int j = __ffsll((long long)b0) - 1; slo |= 1ull << j; if (lane == j) v0 = -INFINITY; } else { const int j = __ffsll((long long)b1) - 1; shi |= 1ull << j; if (lane == j) v1 = -INFINITY; } }
        const bf16_t* Ks = proj + rb * NP + C_KSEL; const bf16_t* Vs = proj + rb * NP + C_VSEL; const bf16_t* Kw = proj + rb * NP + C_KWIN; const bf16_t* Vw = proj + rb * NP + C_VWIN;
        const float os = dbg_attn(0, t, [&](int kv) { const int j = kv >> 6; const bool in = j < 64 ? ((slo >> j) & 1ull) : ((shi >> (j - 64)) & 1ull); if (!in) return -INFINITY;
                                      return wave_sum(q0 * dbg_bf(Ks + (size_t)kv * NP + lane)) * 0.125f - slope * (float)(t - kv); }, [&](int kv, int d) { return dbg_bf(Vs + (size_t)kv * NP + d); }, lane);
        const float ow = dbg_attn(t - 511 > 0 ? t - 511 : 0, t, [&](int kv) { return wave_sum(q0 * dbg_bf(Kw + (size_t)kv * NP + lane)) * 0.125f - slope * (float)(t - kv); }, [&](int kv, int d) { return dbg_bf(Vw + (size_t)kv * NP + d); }, lane);
        const float g0 = sigmoid_f(side[rowq * 32 + 8 + hd * 3]), g1 = sigmoid_f(side[rowq * 32 + 8 + hd * 3 + 1]), g2 = sigmoid_f(side[rowq * 32 + 8 + hd * 3 + 2]);
        ref = g0 * oc + g1 * os + g2 * ow;
        (void)sub;
    }
    const float got = dbg_bf(ocat + rowq * D + grp * 256 + hd * 64 + lane);
    const float d2 = wave_sum((got - ref) * (got - ref)), r2 = wave_sum(ref * ref);
    float* acc = (float*)(ws + WS_CTL + 8192);
    if (lane == 0) { atomicAdd(acc, d2); atomicAdd(acc + 1, r2); }
}

__device__ __forceinline__ void dbg_sincos(double ang, float& cs, float& sn) {
    const double twopi = 6.283185307179586476925; double r = ang - twopi * __builtin_floor(ang / twopi + 0.5);
    const double r2 = r * r; double sterm = r, cterm = 1.0, ssum = r, csum = 1.0;
    for (int k = 1; k <= 14; ++k) { cterm *= -r2 / (double)((2 * k - 1) * (2 * k)); sterm *= -r2 / (double)((2 * k) * (2 * k + 1)); csum += cterm; ssum += sterm; }
    cs = (float)csum; sn = (float)ssum;
}
__device__ __forceinline__ int dbg_mapwin(int n) { return MapWin{}(n); }
#define DBG_ACC(got, ref) do { const float g_ = (got), r_ = (ref); d2 += (g_ - r_) * (g_ - r_); r2 += r_ * r_; } while (0)
__global__ void __launch_bounds__(64) dbg_check2(Params P) {
    const int lane = threadIdx.x, wid = blockIdx.x; const int ri = wid % 48, b = wid / 48; const int t = dbg_rows[ri];
    unsigned char* ws = P.ws; const bf16_t* proj = (const bf16_t*)(ws + WS_PROJ); const float* side = (const float*)(ws + WS_SIDE);
    const size_t rowq = (size_t)b * S + t; const int l = DBG_LAYER;
    float d2 = 0.f, r2 = 0.f;
    const int grp = DBG_GROUP;
    if (grp == 4) {
        if (wid < 16 && lane == 0) { const int hd = wid & 3, bb = wid >> 2; double run = 0.0; const float* fb = (const float*)(ws + WS_FB) + (size_t)wid * S; const float bf = P.in[10][l * 4 + hd];
            for (int tt = 0; tt < S; ++tt) { const double v = (double)side[((size_t)bb * S + tt) * 32 + hd] + (double)bf; const double y = (v < 0 ? v : 0.0) - log1p(exp(-fabs(v))); run += y; DBG_ACC(fb[tt], (float)(-8.0 * run)); } }
    } else if (grp == 5) {
        float ss = 0.f; for (int k = lane; k < 192; k += 64) { const float v = dbg_bf(proj + rowq * NP + k); ss += v * v; } ss = wave_sum(ss); const float rs = 1.0f / sqrtf(ss / 192.f + EPS);
        const float* wq = P.in[7] + (size_t)l * 192 * 384; const float* gq = P.in[6] + l * 192; const bf16_t* qm = (const bf16_t*)(ws + WS_QMLA) + rowq * 384;
        for (int o = lane; o < 384; o += 64) { float a = 0.f; for (int k = 0; k < 192; ++k) a += dbg_bf(proj + rowq * NP + k) * rs * gq[k] * wq[(size_t)k * 384 + o]; ((float*)(ws + WS_H))[(size_t)wid * 512 + o] = a; }
        __threadfence_block();
        const float* qv = (const float*)(ws + WS_H) + (size_t)wid * 512;
        for (int hd = 0; hd < 4; ++hd) { { const int w = lane; DBG_ACC(dbg_bf(qm + hd * 96 + w), qv[hd * 96 + w]); }
            if (lane < 16) { const int i = lane; const float invf = (float)pow(10000.0, -(double)i / 16.0); float cs, sn; dbg_sincos((double)((float)t * invf), cs, sn);
                const float x1 = qv[hd * 96 + 64 + i], x2 = qv[hd * 96 + 80 + i]; DBG_ACC(dbg_bf(qm + hd * 96 + 64 + 2 * i), x1 * cs - x2 * sn); DBG_ACC(dbg_bf(qm + hd * 96 + 64 + 2 * i + 1), x1 * sn + x2 * cs); } }
    } else if (grp == 6) {
        float ss = 0.f; for (int k = lane; k < 128; k += 64) { const float v = dbg_bf(proj + rowq * NP + C_KVLAT + k); ss += v * v; } ss = wave_sum(ss); const float rs = 1.0f / sqrtf(ss / 128.f + EPS);
        const float* wk = P.in[9] + (size_t)l * 128 * 512; const float* gk = P.in[8] + l * 128; const bf16_t* km = (const bf16_t*)(ws + WS_KMLA) + rowq * 384; const bf16_t* vm = (const bf16_t*)(ws + WS_VMLA) + rowq * 256;
        for (int o = lane; o < 512; o += 64) { float a = 0.f; for (int k = 0; k < 128; ++k) a += dbg_bf(proj + rowq * NP + C_KVLAT + k) * rs * gk[k] * wk[(size_t)k * 512 + o];
            const int hd = o >> 7, w = o & 127; if (w < 64) DBG_ACC(dbg_bf(km + hd * 96 + w), a); else DBG_ACC(dbg_bf(vm + hd * 64 + w - 64), a); }
        if (lane < 16) { const int i = lane; const float invf = (float)pow(10000.0, -(double)i / 16.0); float cs, sn; dbg_sincos((double)((float)t * invf), cs, sn);
            const float x1 = dbg_bf(proj + rowq * NP + C_KROPE + i), x2 = dbg_bf(proj + rowq * NP + C_KROPE + 16 + i);
            for (int hd = 0; hd < 4; ++hd) { DBG_ACC(dbg_bf(km + hd * 96 + 64 + 2 * i), x1 * cs - x2 * sn); DBG_ACC(dbg_bf(km + hd * 96 + 64 + 2 * i + 1), x1 * sn + x2 * cs); } }
    } else if (grp == 7) {
        const int n = (t >> 4) > 510 ? 510 : (t >> 4);
        for (int kv = 0; kv < 2; ++kv) { const float* w1 = P.in[12] + (size_t)(l * 2 + kv) * 2048 * 64; const float* w2 = P.in[13] + (size_t)(l * 2 + kv) * 64 * 64; const float* pe = P.in[11] + (size_t)(l * 2 + kv) * 2048;
            float a = 0.f; for (int k = 0; k < 2048; ++k) { const int j = k >> 6, d = k & 63; a += (dbg_bf(proj + ((size_t)b * S + 16 * n + j) * NP + (kv ? C_VCMP : C_KCMP) + d) + pe[k]) * w1[(size_t)k * 64 + lane]; }
            const float hv = silu_f(a); float o = 0.f; for (int k = 0; k < 64; ++k) o += __shfl(hv, k) * w2[k * 64 + lane];
            DBG_ACC(dbg_bf((const bf16_t*)(ws + (kv ? WS_VC : WS_KC)) + ((size_t)b * 512 + n) * 64 + lane), o); }
    } else if (grp == 8) {
        const float* c = P.in[1]; const float* mod = (const float*)(ws + WS_MOD);
        for (int idx = wid * 64 + lane; idx < 2 * 4 * 3072; idx += gridDim.x * 64) { const int ll = idx / (4 * 3072), bb = (idx / 3072) & 3, n = idx % 3072; float a = P.in[4][ll * 3072 + n];
            for (int k = 0; k < 1024; ++k) a += silu_f(c[bb * 1024 + k]) * P.in[3][((size_t)ll * 1024 + k) * 3072 + n]; DBG_ACC(mod[idx], a); }
    } else if (grp == 9) {
        const float* x = P.in[0] + rowq * D; const float* mod = (const float*)(ws + WS_MOD) + (size_t)(l * 4 + b) * 3072; float* hrow = (float*)(ws + WS_H) + (size_t)wid * 1024;
        float ss = 0.f; for (int k = lane; k < D; k += 64) ss += x[k] * x[k]; ss = wave_sum(ss); const float rs = 1.0f / sqrtf(ss / D + EPS);
        for (int k = lane; k < D; k += 64) hrow[k] = x[k] * rs * P.in[2][l * D + k] * (1.0f + mod[1024 + k]) + mod[k];
        __threadfence_block();
        const float* w = P.in[5] + (size_t)l * D * 3732;
        for (int n = lane; n < 3732; n += 64) { const int oc = dbg_mapwin(n); float a = 0.f; for (int k = 0; k < D; ++k) a += hrow[k] * w[(size_t)k * 3732 + oc];
            DBG_ACC(dbg_bf(proj + rowq * NP + n), a); if (n >= C_SIDE) DBG_ACC(side[rowq * 32 + n - C_SIDE], a); }
    } else if (grp == 10) {
        const bf16_t* oc = (const bf16_t*)(ws + WS_OCAT) + rowq * D; const bf16_t* oa = (const bf16_t*)(ws + WS_H) + rowq * D;
        for (int g = 0; g < 4; ++g) { float ss = 0.f; for (int k = lane; k < 256; k += 64) { const float v = dbg_bf(oc + g * 256 + k); ss += v * v; } ss = wave_sum(ss); const float rs = 1.0f / sqrtf(ss / 256.f + EPS);
            for (int k = lane; k < 256; k += 64) { const int cc = g * 256 + k; DBG_ACC(dbg_bf(oa + cc), dbg_bf(oc + cc) * rs * P.in[14][l * D + cc] * silu_f(dbg_bf(proj + rowq * NP + C_GZ + cc))); } }
    } else if (grp == 11) {
        const bf16_t* oa = (const bf16_t*)(ws + WS_H) + rowq * D; const float* mod = (const float*)(ws + WS_MOD) + (size_t)(l * 4 + b) * 3072; const float* w = P.in[15] + (size_t)l * D * D;
        for (int n = lane; n < D; n += 64) { float a = 0.f; for (int k = 0; k < D; ++k) a += dbg_bf(oa + k) * w[(size_t)k * D + n]; DBG_ACC(P.out[rowq * D + n], P.in[0][rowq * D + n] + mod[2048 + n] * a); }
    }
    d2 = wave_sum(d2); r2 = wave_sum(r2);
    float* acc = (float*)(ws + WS_CTL + 8192);
    if (lane == 0) { atomicAdd(acc, d2); atomicAdd(acc + 1, r2); }
}
__global__ void dbg_scale(Params P) {
    const float* acc = (const float*)(P.ws + WS_CTL + 8192);
    float v = sqrtf(acc[0] / fmaxf(acc[1], 1e-30f)); v = fminf(fmaxf(v, 1e-4f), 1.0f);
    const float code = 0.1f * powf(100.0f, (log10f(v) + 4.0f) * 0.25f); const float delta = sqrtf(code);
    for (size_t i = (size_t)blockIdx.x * blockDim.x + threadIdx.x; i < (size_t)M * D; i += (size_t)gridDim.x * blockDim.x) P.out[i] *= (1.0f + delta);
}
#endif

#ifndef N_CUTS
#define N_CUTS 1
#endif
extern "C" void kernel_launch(void* const* d_in, const int* in_sizes, int n_in, void* d_out, int out_size, void* d_ws, size_t ws_size, hipStream_t stream) {
    static int grid = 0;
    if (grid == 0) {
        if (n_in != 17 || out_size != M * D || ws_size < WS_END) { fprintf(stderr, "kernel_launch: unexpected problem (n_in %d out %d ws %zu need %zu)\n", n_in, out_size, ws_size, (size_t)WS_END); grid = -1; return; }
        int dev = 0, cus = 0, per_cu = 0;
        hipGetDevice(&dev); hipDeviceGetAttribute(&cus, hipDeviceAttributeMultiprocessorCount, dev);
        hipFuncSetAttribute((const void*)hymba_fwd, hipFuncAttributeMaxDynamicSharedMemorySize, LDS_BYTES);
        hipOccupancyMaxActiveBlocksPerMultiprocessor(&per_cu, (const void*)hymba_fwd, NTHREADS, LDS_BYTES);
        if (per_cu < 1) { fprintf(stderr, "kernel_launch: occupancy query says %d blocks/CU\n", per_cu); grid = -1; return; }
        grid = cus;
    }
    if (grid < 0) return;
    (void)hipMemsetAsync((char*)d_ws + WS_CTL, 0, 131072, stream);
    Params p{};
    for (int i = 0; i < 17; ++i) p.in[i] = (const float*)d_in[i];
    p.out = (float*)d_out; p.ws = (unsigned char*)d_ws;
#if defined(DBG_GROUP)
    auto run = [&](int lo, int hi) { p.ph_lo = lo; p.ph_hi = hi; p.bar_region = (lo == 0) ? 0 : 1; void* args[] = {&p};
        hipError_t e = hipLaunchCooperativeKernel((const void*)hymba_fwd, dim3(grid), dim3(NTHREADS), args, LDS_BYTES, stream);
        if (e != hipSuccess) fprintf(stderr, "cooperative launch failed: %s (grid %d)\n", hipGetErrorString(e), grid); };
    auto check = [&]() { if (DBG_GROUP % 10 >= 4 || (DBG_GROUP >= 10 && DBG_GROUP < 13)) hipLaunchKernelGGL(dbg_check2, dim3(4 * 48), dim3(64), 0, stream, p);
                         else hipLaunchKernelGGL(dbg_check, dim3(4 * 48 * 4), dim3(64), 0, stream, p); };
    if (DBG_LAYER == 0) { run(0, 8); check(); run(8, 16); } else { run(0, 16); check(); }
    hipLaunchKernelGGL(dbg_scale, dim3(1024), dim3(256), 0, stream, p);
#elif defined(REPEAT_PHASE)
    { const int bounds[3][2] = {{0, REPEAT_PHASE + 1}, {REPEAT_PHASE, N_PHASES}, {0, 0}};
      for (int c = 0; c < 2; ++c) { p.ph_lo = bounds[c][0]; p.ph_hi = bounds[c][1]; p.bar_region = c; void* args[] = {&p};
        hipError_t e = hipLaunchCooperativeKernel((const void*)hymba_fwd, dim3(grid), dim3(NTHREADS), args, LDS_BYTES, stream);
        if (e != hipSuccess) { fprintf(stderr, "cooperative launch failed: %s (grid %d)\n", hipGetErrorString(e), grid); return; } } }
#else
    const int cuts = N_CUTS;
    for (int c = 0; c < cuts; ++c) {
        p.ph_lo = (N_PHASES * c) / cuts; p.ph_hi = (N_PHASES * (c + 1)) / cuts; p.bar_region = c;
        void* args[] = {&p};
        hipError_t e = hipLaunchCooperativeKernel((const void*)hymba_fwd, dim3(grid), dim3(NTHREADS), args, LDS_BYTES, stream);
        if (e != hipSuccess) { fprintf(stderr, "cooperative launch failed: %s (grid %d)\n", hipGetErrorString(e), grid); return; }
    }
#endif
}
```

```cpp
#include <hip/hip_runtime.h>
#include <hip/hip_cooperative_groups.h>
#include <cstdio>
#include <cstdint>
namespace cg = cooperative_groups;

#define LAS __attribute__((address_space(3)))
typedef unsigned short bf16_t;
typedef short bf16x8 __attribute__((ext_vector_type(8)));
typedef short s16x4 __attribute__((ext_vector_type(4)));
typedef float f32x2 __attribute__((ext_vector_type(2)));
typedef float f32x4 __attribute__((ext_vector_type(4)));
typedef float f32x16 __attribute__((ext_vector_type(16)));
typedef unsigned u32x2 __attribute__((ext_vector_type(2)));
typedef unsigned u32x4 __attribute__((ext_vector_type(4)));
typedef __bf16 bf16x2_t __attribute__((ext_vector_type(2)));

constexpr int NB = 4, S = 8192, D = 1024, M = NB * S, NP = 3840, DEPTH = 2;
constexpr int C_QLAT = 0, C_KVLAT = 192, C_KROPE = 320, C_FQ = 352, C_FK = 608, C_FV = 864, C_DQ = 1120, C_DK = 1376, C_DV = 1632,
              C_IQ = 1888, C_IK = 2016, C_NQ = 2048, C_KCMP = 2304, C_VCMP = 2368, C_KSEL = 2432, C_VSEL = 2496, C_KWIN = 2560,
              C_VWIN = 2624, C_GZ = 2688, C_SIDE = 3712;
constexpr float EPS = 1e-6f;
constexpr float LOG2E = 1.4426950408889634f;
constexpr int NTHREADS = 512;
constexpr int LDS_BYTES = 155648;

constexpr size_t MiB = 1u << 20;
constexpr size_t WS_CTL = 0;
constexpr size_t WS_WIN = 1 * MiB;
constexpr size_t WS_WOUT = 16 * MiB;
constexpr size_t WS_WUQ = 20 * MiB;
constexpr size_t WS_WUKV = 20 * MiB + 512 * 1024;
constexpr size_t WS_W1T = 21 * MiB;
constexpr size_t WS_CVEC = 22 * MiB;
constexpr size_t WS_MOD = 22 * MiB + 4096;
constexpr size_t WS_ROPE = 23 * MiB;
constexpr size_t WS_RSTD = 24 * MiB;
constexpr size_t WS_FB = 24 * MiB + 512 * 1024;
constexpr size_t WS_KC = 25 * MiB;
constexpr size_t WS_VC = 25 * MiB + 512 * 1024;
constexpr size_t WS_SIDE = 26 * MiB;
constexpr size_t WS_H = 30 * MiB;
constexpr size_t WS_QMLA = 94 * MiB;
constexpr size_t WS_KMLA = 118 * MiB;
constexpr size_t WS_VMLA = 142 * MiB;
constexpr size_t WS_MASK = 158 * MiB;
constexpr size_t WS_OCAT = 190 * MiB;
constexpr size_t WS_PROJ = 254 * MiB;
constexpr size_t WS_KIDX = ((WS_PROJ + (size_t)(M + 64) * NP * 2 + MiB - 1) / MiB) * MiB;
constexpr size_t WS_END = WS_KIDX + 2 * MiB;

struct Params {
    const float* in[17];
    float* out;
    unsigned char* ws;
    int ph_lo, ph_hi, bar_region, pad;
};

__device__ __forceinline__ unsigned pk2(float lo, float hi) { f32x2 v = {lo, hi}; bf16x2_t b = __builtin_convertvector(v, bf16x2_t); return __builtin_bit_cast(unsigned, b); }
__device__ __forceinline__ float bf2f(unsigned short b) { return __uint_as_float(((unsigned)b) << 16); }
__device__ __forceinline__ float bflo(unsigned u) { return __uint_as_float(u << 16); }
__device__ __forceinline__ float bfhi(unsigned u) { return __uint_as_float(u & 0xffff0000u); }
__device__ __forceinline__ float wave_sum(float v) {
    v += __builtin_bit_cast(float, __builtin_amdgcn_update_dpp(0, __builtin_bit_cast(int, v), 0xB1, 0xf, 0xf, false));
    v += __builtin_bit_cast(float, __builtin_amdgcn_update_dpp(0, __builtin_bit_cast(int, v), 0x4E, 0xf, 0xf, false));
    v += __builtin_bit_cast(float, __builtin_amdgcn_update_dpp(0, __builtin_bit_cast(int, v), 0x141, 0xf, 0xf, false));
    v += __builtin_bit_cast(float, __builtin_amdgcn_update_dpp(0, __builtin_bit_cast(int, v), 0x140, 0xf, 0xf, false));
    const float r0 = __builtin_bit_cast(float, __builtin_amdgcn_readlane(__builtin_bit_cast(int, v), 0)), r1 = __builtin_bit_cast(float, __builtin_amdgcn_readlane(__builtin_bit_cast(int, v), 16));
    const float r2 = __builtin_bit_cast(float, __builtin_amdgcn_readlane(__builtin_bit_cast(int, v), 32)), r3 = __builtin_bit_cast(float, __builtin_amdgcn_readlane(__builtin_bit_cast(int, v), 48));
    return (r0 + r1) + (r2 + r3);
}
__device__ __forceinline__ float silu_f(float x) { return x / (1.0f + __expf(-x)); }
__device__ __forceinline__ float sigmoid_f(float x) { return 1.0f / (1.0f + __expf(-x)); }
__device__ __forceinline__ int crow(int r, int hi) { return (r & 3) + 8 * (r >> 2) + 4 * hi; }
__device__ __forceinline__ int opaque_tid(int wid0) { int t; asm volatile("v_mbcnt_lo_u32_b32 %0, -1, 0\n\tv_mbcnt_hi_u32_b32 %0, -1, %0\n\tv_lshl_add_u32 %0, %1, 6, %0" : "=&v"(t) : "s"(wid0)); return t; }

namespace pg8 {
constexpr int BM = 256, BK = 64, HALF = 128, HTB = HALF * BK * 2, STAGE_BYTES = 8 * HTB, NXCD = 8, WGM = 8;
__host__ __device__ __forceinline__ int lds_byte(int r, int c) { const int st = (r >> 4) * 2 + (c >> 5), rr = r & 15, cc = c & 31, ob = rr * 64 + cc * 2; return st * 1024 + (ob ^ (((ob >> 9) & 1) << 5)); }
__host__ __device__ __forceinline__ void stage_rc(int b, int& R, int& C) { const int st = b / 1024, sb = b % 1024, swz = sb ^ (((sb >> 9) & 1) << 5); R = (st >> 1) * 16 + swz / 64; C = (st & 1) * 32 + (swz % 64) / 2; }
__host__ __device__ __forceinline__ int perm32(int rho) { const int n = rho >> 4, i = rho & 15; return 8 * (i >> 2) + 4 * n + (i & 3); }
struct Unit { int pm, pn; };
struct Gemm { const bf16_t* A; const bf16_t* Bt; int M, N, K, lda, ldb; };
struct StaticOrder {
    int nM, nN, nwg, G, c;
    __device__ void init(int M_, int N_, int G_, int c_) { nM = M_ / BM; nN = N_ / BM; nwg = nM * nN; G = G_; c = c_; }
    __device__ bool next(int i, Unit& u) const {
        const long L = (long)i * G + c; if (L >= nwg) return false;
        int wgid = (int)L; { const int q = nwg / NXCD, r = nwg % NXCD, xcd = wgid % NXCD, off = wgid / NXCD; wgid = (xcd < r ? xcd * (q + 1) : r * (q + 1) + (xcd - r) * q) + off; }
        const int nig = WGM * nN, gid = wgid / nig, fm = gid * WGM, gsz = (nM - fm) < WGM ? (nM - fm) : WGM;
        u.pm = fm + ((wgid % nig) % gsz); u.pn = (wgid % nig) / gsz; return true;
    }
};

template <class Epi, bool ALIGN_EPI>
__device__ __forceinline__ void gemm_phase(LAS unsigned char* lds, const Gemm g, const StaticOrder& S_, const Epi& E, int wid0) {
    const int tid = opaque_tid(wid0), wid = __builtin_amdgcn_readfirstlane(tid >> 6), lane = tid & 63, wr = wid >> 2, wc = wid & 3, fr = lane & 15, fq = lane >> 4;
    const int K = g.K, nt = K / BK;
    unsigned voffA[2], voffB[2];
#pragma unroll
    for (int i = 0; i < 2; ++i) { int R, C; stage_rc(tid * 16 + i * 8192, R, C); const int Rb = ((R & ~31) + perm32(R & 31));
        voffA[i] = (unsigned)(R * g.lda + C) * 2u; voffB[i] = (unsigned)(Rb * g.ldb + C) * 2u; }
    const size_t kstep = (size_t)(BK * 2);
    const size_t hstepA = (size_t)HALF * g.lda * 2, hstepB = (size_t)HALF * g.ldb * 2;
    const size_t tstepA = 2 * hstepA, tstepB = 2 * hstepB;
    const unsigned ldsw = (unsigned)wid * 1024u;
    const int aoff = lds_byte(wr * 64 + fr, fq * 8), boff = lds_byte(wc * 32 + fr, fq * 8);
#define PG8_SA(b, h) (((b) * 2 + (h)) * HTB)
#define PG8_SB(b, h) ((4 + (b) * 2 + (h)) * HTB)
#define PG8_STAGE(bufoff, gbase, voff) do { _Pragma("unroll") for (int _i = 0; _i < 2; ++_i) \
        __builtin_amdgcn_global_load_lds((const unsigned*)((const char*)(gbase) + (voff)[_i]), (LAS unsigned*)(lds + (bufoff) + ldsw + _i * 8192), 16, 0, 0); } while (0)
#define PG8_LDA(dst, b, h) do { _Pragma("unroll") for (int m = 0; m < 4; ++m) _Pragma("unroll") for (int k = 0; k < 2; ++k) dst[m][k] = *(const LAS bf16x8*)(lds + PG8_SA(b, h) + aoff + m * 2048 + k * 1024); } while (0)
#define PG8_LDB(dst, b, h) do { _Pragma("unroll") for (int n = 0; n < 2; ++n) _Pragma("unroll") for (int k = 0; k < 2; ++k) dst[n][k] = *(const LAS bf16x8*)(lds + PG8_SB(b, h) + boff + n * 2048 + k * 1024); } while (0)
#define PG8_MMA(ai, bj, At, Bt) do { __builtin_amdgcn_s_setprio(1); _Pragma("unroll") for (int m = 0; m < 4; ++m) _Pragma("unroll") for (int n = 0; n < 2; ++n) _Pragma("unroll") for (int k = 0; k < 2; ++k) \
        acc[ai][bj][m][n] = __builtin_amdgcn_mfma_f32_16x16x32_bf16(Bt[n][k], At[m][k], acc[ai][bj][m][n], 0, 0, 0); __builtin_amdgcn_s_setprio(0); } while (0)
#define PG8_WAIT_V(n) asm volatile("s_waitcnt vmcnt(" #n ")" ::: "memory")
#define PG8_WAIT_L(n) asm volatile("s_waitcnt lgkmcnt(" #n ")" ::: "memory")
#define PG8_BAR __builtin_amdgcn_s_barrier()
#define PG8_SCHED __builtin_amdgcn_sched_barrier(0)
    Unit cur, nxt; int ui = 0;
    if (!S_.next(0, cur)) return;
    f32x4 acc[2][2][4][2];
#pragma unroll
    for (int a = 0; a < 2; ++a)
#pragma unroll
        for (int b = 0; b < 2; ++b)
#pragma unroll
            for (int m = 0; m < 4; ++m)
#pragma unroll
                for (int n = 0; n < 2; ++n) acc[a][b][m][n] = (f32x4){0.f, 0.f, 0.f, 0.f};
    bf16x8 At[4][2], B0[2][2], B1[2][2];
    const char* cA = (const char*)g.A + (size_t)cur.pm * tstepA; const char* cB = (const char*)g.Bt + (size_t)cur.pn * tstepB;
    PG8_STAGE(PG8_SB(0, 0), cB, voffB); PG8_STAGE(PG8_SB(0, 1), cB + hstepB, voffB); PG8_STAGE(PG8_SA(0, 0), cA, voffA); PG8_STAGE(PG8_SA(0, 1), cA + hstepA, voffA);
    if (wr == 1) PG8_BAR;
    PG8_WAIT_V(2); PG8_BAR;
    PG8_STAGE(PG8_SB(1, 0), cB + kstep, voffB); PG8_STAGE(PG8_SA(1, 0), cA + kstep, voffA); PG8_STAGE(PG8_SB(1, 1), cB + hstepB + kstep, voffB);
    PG8_WAIT_V(6); PG8_BAR;
    for (;;) {
        const bool has_next = S_.next(ui + 1, nxt);
        const char* nA = has_next ? (const char*)g.A + (size_t)nxt.pm * tstepA : cA; const char* nB = has_next ? (const char*)g.Bt + (size_t)nxt.pn * tstepB : cB;
        for (int t = 0; t < nt; t += 2) {
            const bool last = (t == nt - 2);
            const char* a1 = cA + (size_t)(t + 1) * kstep;
            const char* a2 = last ? nA : cA + (size_t)(t + 2) * kstep; const char* b2 = last ? nB : cB + (size_t)(t + 2) * kstep;
            const char* a3 = a2 + kstep; const char* b3 = b2 + kstep;
            PG8_LDB(B0, 0, 0); PG8_LDB(B1, 0, 1); PG8_SCHED; PG8_LDA(At, 0, 0); PG8_STAGE(PG8_SA(1, 1), a1 + hstepA, voffA);
            PG8_WAIT_V(8); PG8_WAIT_L(0); PG8_BAR; PG8_MMA(0, 0, At, B0); PG8_MMA(0, 1, At, B1); PG8_BAR; PG8_SCHED;
            PG8_LDA(At, 0, 1); PG8_STAGE(PG8_SB(0, 0), b2, voffB); PG8_STAGE(PG8_SB(0, 1), b2 + hstepB, voffB); PG8_STAGE(PG8_SA(0, 0), a2, voffA);
            PG8_WAIT_V(8); PG8_WAIT_L(0); PG8_BAR; PG8_MMA(1, 0, At, B0); PG8_MMA(1, 1, At, B1); PG8_BAR; PG8_SCHED;
            PG8_LDB(B0, 1, 0); PG8_LDB(B1, 1, 1); PG8_SCHED; PG8_LDA(At, 1, 0); PG8_STAGE(PG8_SA(0, 1), a2 + hstepA, voffA);
            PG8_WAIT_V(8); PG8_WAIT_L(0); PG8_BAR; PG8_MMA(0, 0, At, B0); PG8_MMA(0, 1, At, B1); PG8_BAR; PG8_SCHED;
            PG8_LDA(At, 1, 1); PG8_STAGE(PG8_SB(1, 0), b3, voffB); PG8_STAGE(PG8_SB(1, 1), b3 + hstepB, voffB); PG8_STAGE(PG8_SA(1, 0), a3, voffA);
            PG8_WAIT_V(8); PG8_WAIT_L(0); PG8_BAR; PG8_MMA(1, 0, At, B0); PG8_MMA(1, 1, At, B1); PG8_BAR; PG8_SCHED;
        }
        if constexpr (ALIGN_EPI) { if (wr == 0) PG8_BAR; }
        E(acc, cur, wr, wc, fr, fq);
        if (!has_next) break;
#pragma unroll
        for (int a = 0; a < 2; ++a)
#pragma unroll
            for (int b = 0; b < 2; ++b)
#pragma unroll
                for (int m = 0; m < 4; ++m)
#pragma unroll
                    for (int n = 0; n < 2; ++n) acc[a][b][m][n] = (f32x4){0.f, 0.f, 0.f, 0.f};
        cur = nxt; cA = nA; cB = nB; ++ui;
        if constexpr (ALIGN_EPI) { if (wr == 1) PG8_BAR; }
    }
    PG8_WAIT_V(0);
    if constexpr (!ALIGN_EPI) { if (wr == 0) PG8_BAR; }
    PG8_BAR;
#undef PG8_SA
#undef PG8_SB
#undef PG8_STAGE
#undef PG8_LDA
#undef PG8_LDB
#undef PG8_MMA
#undef PG8_WAIT_V
#undef PG8_WAIT_L
#undef PG8_BAR
#undef PG8_SCHED
}

struct EpiProj {
    bf16_t* proj; float* side;
    __device__ __forceinline__ void operator()(const f32x4 (&acc)[2][2][4][2], const Unit& u, int wr, int wc, int fr, int fq) const {
        const int row0 = u.pm * BM + wr * 64 + fr, col0 = u.pn * BM + wc * 32 + 8 * fq;
#pragma unroll
        for (int ai = 0; ai < 2; ++ai)
#pragma unroll
            for (int m = 0; m < 4; ++m) { const int row = row0 + ai * HALF + m * 16; bf16_t* rowp = proj + (size_t)row * NP + col0;
#pragma unroll
                for (int bj = 0; bj < 2; ++bj) { const f32x4 v0 = acc[ai][bj][m][0], v1 = acc[ai][bj][m][1];
                    u32x4 w; w.x = pk2(v0[0], v0[1]); w.y = pk2(v0[2], v0[3]); w.z = pk2(v1[0], v1[1]); w.w = pk2(v1[2], v1[3]);
                    *(u32x4*)(rowp + bj * HALF) = w;
                    if (bj == 1 && u.pn == 14 && wc == 0) { float* sp = side + (size_t)row * 32 + 8 * fq; *(f32x4*)sp = v0; *(f32x4*)(sp + 4) = v1; } } }
    }
};
struct EpiQup {
    bf16_t* q; const float* rstd; const float* rope;
    __device__ __forceinline__ void operator()(const f32x4 (&acc)[2][2][4][2], const Unit& u, int wr, int wc, int fr, int fq) const {
        const int row0 = u.pm * BM + wr * 64 + fr;
#pragma unroll
        for (int ai = 0; ai < 2; ++ai)
#pragma unroll
            for (int m = 0; m < 4; ++m) { const int row = row0 + ai * HALF + m * 16; const float rs = rstd[(size_t)row * 2]; const int pos = row & (S - 1);
#pragma unroll
                for (int bj = 0; bj < 2; ++bj) { const int c = u.pn * BM + bj * HALF + wc * 32 + 8 * fq;
                    if (c < 384) { const int w0 = c % 96;
                        f32x4 v0 = acc[ai][bj][m][0] * rs, v1 = acc[ai][bj][m][1] * rs;
                        if (w0 >= 64) { const int i0 = (w0 - 64) >> 1; const float* tp = rope + ((size_t)pos * 16 + i0) * 2;
                            const f32x4 t0 = *(const f32x4*)tp, t1 = *(const f32x4*)(tp + 4);
                            f32x4 a, b;
                            a[0] = v0[0] * t0[0] - v0[1] * t0[1]; a[1] = v0[0] * t0[1] + v0[1] * t0[0];
                            a[2] = v0[2] * t0[2] - v0[3] * t0[3]; a[3] = v0[2] * t0[3] + v0[3] * t0[2];
                            b[0] = v1[0] * t1[0] - v1[1] * t1[1]; b[1] = v1[0] * t1[1] + v1[1] * t1[0];
                            b[2] = v1[2] * t1[2] - v1[3] * t1[3]; b[3] = v1[2] * t1[3] + v1[3] * t1[2];
                            v0 = a; v1 = b; }
                        u32x4 w; w.x = pk2(v0[0], v0[1]); w.y = pk2(v0[2], v0[3]); w.z = pk2(v1[0], v1[1]); w.w = pk2(v1[2], v1[3]);
                        *(u32x4*)(q + (size_t)row * 384 + c) = w; } }
                asm volatile("" ::: "memory"); }
    }
};
struct EpiKVup {
    bf16_t* k; bf16_t* v; const float* rstd;
    __device__ __forceinline__ void operator()(const f32x4 (&acc)[2][2][4][2], const Unit& u, int wr, int wc, int fr, int fq) const {
        const int row0 = u.pm * BM + wr * 64 + fr;
#pragma unroll
        for (int ai = 0; ai < 2; ++ai)
#pragma unroll
            for (int m = 0; m < 4; ++m) { const int row = row0 + ai * HALF + m * 16; const float rs = rstd[(size_t)row * 2 + 1];
#pragma unroll
                for (int bj = 0; bj < 2; ++bj) { const int c = u.pn * BM + bj * HALF + wc * 32 + 8 * fq; const int hd = c >> 7, w0 = c & 127;
                    const f32x4 v0 = acc[ai][bj][m][0] * rs, v1 = acc[ai][bj][m][1] * rs;
                    u32x4 w; w.x = pk2(v0[0], v0[1]); w.y = pk2(v0[2], v0[3]); w.z = pk2(v1[0], v1[1]); w.w = pk2(v1[2], v1[3]);
                    bf16_t* dst = (w0 < 64) ? (k + (size_t)row * 384 + hd * 96 + w0) : (v + (size_t)row * 256 + hd * 64 + (w0 - 64));
                    *(u32x4*)dst = w; }
                asm volatile("" ::: "memory"); }
    }
};
struct EpiOut {
    const float* res; float* out; const float* gate;
    __device__ __forceinline__ void operator()(const f32x4 (&acc)[2][2][4][2], const Unit& u, int wr, int wc, int fr, int fq) const {
        const int row0 = u.pm * BM + wr * 64 + fr; const int b = (u.pm * BM) / S;
#pragma unroll
        for (int bj = 0; bj < 2; ++bj) { const int c = u.pn * BM + bj * HALF + wc * 32 + 8 * fq;
            const f32x4 g0 = *(const f32x4*)(gate + (size_t)b * 3072 + c), g1 = *(const f32x4*)(gate + (size_t)b * 3072 + c + 4);
#pragma unroll
            for (int ai = 0; ai < 2; ++ai)
#pragma unroll
                for (int m = 0; m < 4; ++m) { const int row = row0 + ai * HALF + m * 16; const size_t off = (size_t)row * D + c;
                    const f32x4 r0 = *(const f32x4*)(res + off), r1 = *(const f32x4*)(res + off + 4);
                    *(f32x4*)(out + off) = r0 + g0 * acc[ai][bj][m][0]; *(f32x4*)(out + off + 4) = r1 + g1 * acc[ai][bj][m][1]; } }
    }
};
}

struct MapWin { __device__ __forceinline__ int operator()(int n) const {
    if (n < 1120) return n; if (n < 2048) return n + 4; if (n < 2688) return n + 8; if (n < 3712) return n + 20;
    if (n < 3716) return 1120 + (n - 3712); if (n < 3720) return 2052 + (n - 3716); if (n < 3732) return 2696 + (n - 3720); return -1; } };
struct MapId { int N; __device__ __forceinline__ int operator()(int n) const { return n < N ? n : -1; } };
struct MapUq { __device__ __forceinline__ int operator()(int n) const { if (n >= 384) return -1; const int hd = n / 96, w = n % 96; if (w < 64) return hd * 96 + w;
    const int p = (w - 64) >> 1, which = (w - 64) & 1; return hd * 96 + 64 + (which ? 16 + p : p); } };

template <class ColMap>
__device__ __forceinline__ void tr_tile(const float* src, int lds_src, int Ksrc, const float* kscale, bf16_t* dst, int ldd, int n0, int k0, ColMap cm, LAS float* scr, int wid0) {
    const int tid = opaque_tid(wid0);
#pragma unroll
    for (int i = 0; i < 8; ++i) { const int idx = tid + i * NTHREADS, kk = idx >> 6, nn = idx & 63; const int sc = cm(n0 + nn), k = k0 + kk;
        float v = 0.f; if (sc >= 0 && k < Ksrc) { v = src[(size_t)k * lds_src + sc]; if (kscale) v *= kscale[k]; }
        scr[kk * 65 + nn] = v; }
    __syncthreads();
    { const int nn = tid >> 3, kc = tid & 7; const LAS float* s = scr + (kc * 8) * 65 + nn;
      u32x4 w; w.x = pk2(s[0], s[65]); w.y = pk2(s[2 * 65], s[3 * 65]); w.z = pk2(s[4 * 65], s[5 * 65]); w.w = pk2(s[6 * 65], s[7 * 65]);
      *(u32x4*)(dst + (size_t)(n0 + nn) * ldd + k0 + kc * 8) = w; }
    __syncthreads();
}

__device__ __forceinline__ void phase_prologue(const Params& P, LAS unsigned char* lds, int bid, int G, int wid0) {
    const int tid = opaque_tid(wid0);
    LAS float* scr = (LAS float*)lds;
    const float* w_in = P.in[5]; const float* w_uq = P.in[7]; const float* w_ukv = P.in[9]; const float* w1 = P.in[12]; const float* w_out = P.in[15];
    constexpr int T_WIN = 60 * 16, T_WOUT = 16 * 16, T_UQ = 8 * 4, T_UKV = 8 * 2, T_W1 = 1 * 32 * 2;
    constexpr int T_L = T_WIN + T_WOUT + T_UQ + T_UKV + T_W1;
    for (int it = bid; it < DEPTH * T_L; it += G) {
        const int l = it / T_L; int r = it % T_L;
        if (r < T_WIN) { tr_tile(w_in + (size_t)l * D * 3732, 3732, D, nullptr, (bf16_t*)(P.ws + WS_WIN) + (size_t)l * NP * D, D, (r / 16) * 64, (r % 16) * 64, MapWin{}, scr, wid0); continue; } r -= T_WIN;
        if (r < T_WOUT) { tr_tile(w_out + (size_t)l * D * D, D, D, nullptr, (bf16_t*)(P.ws + WS_WOUT) + (size_t)l * D * D, D, (r / 16) * 64, (r % 16) * 64, MapId{D}, scr, wid0); continue; } r -= T_WOUT;
        if (r < T_UQ) { tr_tile(w_uq + (size_t)l * 192 * 384, 384, 192, P.in[6] + l * 192, (bf16_t*)(P.ws + WS_WUQ) + (size_t)l * 512 * 256, 256, (r / 4) * 64, (r % 4) * 64, MapUq{}, scr, wid0); continue; } r -= T_UQ;
        if (r < T_UKV) { tr_tile(w_ukv + (size_t)l * 128 * 512, 512, 128, P.in[8] + l * 128, (bf16_t*)(P.ws + WS_WUKV) + (size_t)l * 512 * 128, 128, (r / 2) * 64, (r % 2) * 64, MapId{512}, scr, wid0); continue; } r -= T_UKV;
        { const int kv = r / 32, kt = r % 32; tr_tile(w1 + (size_t)(l * 2 + kv) * 2048 * 64, 64, 2048, nullptr, (bf16_t*)(P.ws + WS_W1T) + (size_t)(l * 2 + kv) * 64 * 2048, 2048, 0, kt * 64, MapId{64}, scr, wid0); }
    }
    {
        LAS float* sc = (LAS float*)lds;
        LAS float* red = (LAS float*)(lds + 16384);
        const float* c = P.in[1]; const float* w_ada = P.in[3]; const float* b_ada = P.in[4]; float* mod = (float*)(P.ws + WS_MOD);
        bool loaded = false;
        for (int it = bid; it < DEPTH * 48; it += G) {
            if (!loaded) { for (int i = tid; i < 4096; i += NTHREADS) sc[i] = silu_f(c[i]); loaded = true; __syncthreads(); }
            const int l = it / 48, cb = it % 48, col = tid & 63, ks = tid >> 6;
            const float* wp = w_ada + (size_t)l * D * 3072 + (size_t)(ks * 128) * 3072 + cb * 64 + col;
            float a0 = 0.f, a1 = 0.f, a2 = 0.f, a3 = 0.f;
#pragma unroll 8
            for (int k = 0; k < 128; ++k) { const float w = wp[(size_t)k * 3072]; const int kk = ks * 128 + k;
                a0 += sc[kk] * w; a1 += sc[1024 + kk] * w; a2 += sc[2048 + kk] * w; a3 += sc[3072 + kk] * w; }
            red[(ks * 64 + col) * 4 + 0] = a0; red[(ks * 64 + col) * 4 + 1] = a1; red[(ks * 64 + col) * 4 + 2] = a2; red[(ks * 64 + col) * 4 + 3] = a3;
            __syncthreads();
            if (tid < 256) { const int cc = tid & 63, b = tid >> 6; float s = b_ada[l * 3072 + cb * 64 + cc];
#pragma unroll
                for (int k8 = 0; k8 < 8; ++k8) s += red[(k8 * 64 + cc) * 4 + b];
                mod[(size_t)(l * 4 + b) * 3072 + cb * 64 + cc] = s; }
            __syncthreads();
        }
    }
    {
        float* tab = (float*)(P.ws + WS_ROPE);
        for (int idx = bid * NTHREADS + tid; idx < S * 16; idx += G * NTHREADS) {
            const int pos = idx >> 4, i = idx & 15;
            const double f4[4] = {1.0, 0.5623413251903491, 0.31622776601683794, 0.1778279410038923};
            double inv = (i & 3) == 0 ? f4[0] : ((i & 3) == 1 ? f4[1] : ((i & 3) == 2 ? f4[2] : f4[3]));
            inv *= ((i >> 2) == 0 ? 1.0 : ((i >> 2) == 1 ? 0.1 : ((i >> 2) == 2 ? 0.01 : 0.001)));
            const float invf = (float)inv; const float angf = (float)pos * invf;
            const double rev = (double)angf * 0.15915494309189535; const double fr = rev - __builtin_floor(rev);
            const float f = (float)fr;
            tab[(size_t)idx * 2] = __builtin_amdgcn_cosf(f); tab[(size_t)idx * 2 + 1] = __builtin_amdgcn_sinf(f);
        }
    }
    {
        const float* pos = P.in[11]; float* cvec = (float*)(P.ws + WS_CVEC);
        LAS float* red = (LAS float*)(lds + 65536);
        for (int it = bid; it < DEPTH * 2; it += G) {
            __syncthreads();
            const int col = tid & 63, ks = tid >> 6; float a = 0.f;
            const float* wp = w1 + (size_t)it * 2048 * 64 + (size_t)(ks * 256) * 64 + col; const float* pp = pos + (size_t)it * 2048 + ks * 256;
            for (int k = 0; k < 256; ++k) a += pp[k] * wp[(size_t)k * 64];
            red[ks * 64 + col] = a; __syncthreads();
            if (tid < 64) { float s = 0.f; for (int k8 = 0; k8 < 8; ++k8) s += red[k8 * 64 + tid]; cvec[it * 64 + tid] = s; }
            __syncthreads();
        }
    }
}

__device__ __forceinline__ void phase_hnorm(const float* x, const float* g, const float* mod  , bf16_t* h, int bid, int G, int wid0) {
    const int tid_ = opaque_tid(wid0); const int lane = tid_ & 63, wv = tid_ >> 6;
    for (int row = bid * 8 + wv; row < M; row += G * 8) {
        const f32x4* xr = (const f32x4*)(x + (size_t)row * D) + lane;
        f32x4 v[4]; float s = 0.f;
#pragma unroll
        for (int j = 0; j < 4; ++j) { v[j] = xr[64 * j]; s += (v[j][0] * v[j][0] + v[j][1] * v[j][1]) + (v[j][2] * v[j][2] + v[j][3] * v[j][3]); }
        const float rstd = 1.0f / sqrtf(wave_sum(s) * (1.f / D) + EPS);
        const int b = row / S; const float* sh = mod + (size_t)b * 3072; const float* scl = sh + 1024;
        unsigned long long* o8 = (unsigned long long*)(h + (size_t)row * D) + lane;
#pragma unroll
        for (int j = 0; j < 4; ++j) { const int c = (64 * j + lane) * 4; const f32x4 gg = *(const f32x4*)(g + c), ss = *(const f32x4*)(scl + c), hh = *(const f32x4*)(sh + c);
            f32x4 y;
#pragma unroll
            for (int e = 0; e < 4; ++e) y[e] = v[j][e] * rstd * gg[e] * (1.0f + ss[e]) + hh[e];
            o8[64 * j] = (unsigned long long)pk2(y[0], y[1]) | ((unsigned long long)pk2(y[2], y[3]) << 32); }
    }
}

__device__ __forceinline__ void phase_prep(const Params& P, int l, LAS unsigned char* lds, int bid, int G, int wid0) {
    const int tid = opaque_tid(wid0), lane = tid & 63, wv = tid >> 6;
    const bf16_t* proj = (const bf16_t*)(P.ws + WS_PROJ); const float* side = (const float*)(P.ws + WS_SIDE);
    {
        float* rstd = (float*)(P.ws + WS_RSTD); bf16_t* kmla = (bf16_t*)(P.ws + WS_KMLA); const float* rope = (const float*)(P.ws + WS_ROPE);
        for (int row = bid * 8 + wv; row < M; row += G * 8) {
            const bf16_t* pr = proj + (size_t)row * NP;
            float sq = 0.f, skv = 0.f;
            if (lane < 40) { const u32x4 w = *(const u32x4*)(pr + lane * 8); float s = 0.f;
#pragma unroll
                for (int e = 0; e < 4; ++e) { const float a = bflo(w[e]), b = bfhi(w[e]); s += a * a + b * b; }
                if (lane < 24) sq = s; else skv = s; }
            sq = wave_sum(sq); skv = wave_sum(skv);
            if (lane == 0) { rstd[(size_t)row * 2] = 1.0f / sqrtf(sq * (1.f / 192.f) + EPS); rstd[(size_t)row * 2 + 1] = 1.0f / sqrtf(skv * (1.f / 128.f) + EPS); }
            if (lane >= 48 && lane < 52) *(u32x4*)((bf16_t*)(P.ws + WS_KIDX) + (size_t)row * 32 + (lane - 48) * 8) = *(const u32x4*)(pr + C_IK + (lane - 48) * 8);
            if (lane < 16) { const float x1 = bf2f(pr[C_KROPE + lane]), x2 = bf2f(pr[C_KROPE + 16 + lane]); const int pos = row & (S - 1);
                const float cs = rope[((size_t)pos * 16 + lane) * 2], sn = rope[((size_t)pos * 16 + lane) * 2 + 1];
                const unsigned w = pk2(x1 * cs - x2 * sn, x1 * sn + x2 * cs);
#pragma unroll
                for (int hd = 0; hd < 4; ++hd) *(unsigned*)(kmla + (size_t)row * 384 + hd * 96 + 64 + 2 * lane) = w; }
        }
    }
    {
        float* fb = (float*)(P.ws + WS_FB); const float* b_f = P.in[10] + l * 4; LAS float* wtot = (LAS float*)lds;
        for (int it = bid; it < 16; it += G) {
            const int b = it >> 2, hd = it & 3; const float bf = b_f[hd];
            float ls[16]; float s = 0.f;
#pragma unroll
            for (int i = 0; i < 16; ++i) { const int t = tid * 16 + i; const float v = side[((size_t)b * S + t) * 32 + hd] + bf;
                const float y = fminf(v, 0.f) - log1pf(__expf(-fabsf(v))); ls[i] = y; s += y; }
            float inc = s;
#pragma unroll
            for (int o = 1; o < 64; o <<= 1) { const float t = __shfl_up(inc, o); if (lane >= o) inc += t; }
            __syncthreads();
            if (lane == 63) wtot[wv] = inc;
            __syncthreads();
            float base = 0.f;
            for (int w = 0; w < wv; ++w) base += wtot[w];
            float run = base + inc - s;
#pragma unroll
            for (int i = 0; i < 16; ++i) { run += ls[i]; fb[((size_t)it) * S + tid * 16 + i] = -8.0f * run; }
            __syncthreads();
        }
    }
    {
        const bf16_t* w1t = (const bf16_t*)(P.ws + WS_W1T) + (size_t)l * 2 * 64 * 2048; const float* cvec = (const float*)(P.ws + WS_CVEC) + l * 2 * 64;
        const float* w2 = P.in[13] + (size_t)l * 2 * 64 * 64;
        LAS float* part = (LAS float*)lds;
        LAS float* hb = (LAS float*)(lds + 65536);
        const int r = lane & 31, hi = lane >> 5;
        for (int it = bid; it < 128; it += G) {
            const int b = it >> 5, kv = (it >> 4) & 1, nt = it & 15, n0 = nt * 32;
            const int colbase = kv ? C_VCMP : C_KCMP;
            const bf16_t* w1k = w1t + (size_t)kv * 64 * 2048;
            f32x16 a0 = {}, a1 = {};
#pragma unroll
            for (int j = 0; j < 4; ++j) { const int tok = wv * 4 + j;
                const bf16_t* ap = proj + ((size_t)b * S + 16 * (n0 + r) + tok) * NP + colbase + hi * 8;
#pragma unroll
                for (int s = 0; s < 4; ++s) { const bf16x8 af = *(const bf16x8*)(ap + s * 16);
                    const int kb = tok * 64 + s * 16 + hi * 8;
                    const bf16x8 b0 = *(const bf16x8*)(w1k + (size_t)r * 2048 + kb), b1 = *(const bf16x8*)(w1k + (size_t)(32 + r) * 2048 + kb);
                    a0 = __builtin_amdgcn_mfma_f32_32x32x16_bf16(af, b0, a0, 0, 0, 0); a1 = __builtin_amdgcn_mfma_f32_32x32x16_bf16(af, b1, a1, 0, 0, 0); } }
#pragma unroll
            for (int reg = 0; reg < 16; ++reg) { const int n = crow(reg, hi); part[(wv * 32 + n) * 64 + r] = a0[reg]; part[(wv * 32 + n) * 64 + 32 + r] = a1[reg]; }
            __syncthreads();
            { const int n = tid >> 4, c4 = (tid & 15) * 4;
#pragma unroll
              for (int e = 0; e < 4; ++e) { float s = cvec[kv * 64 + c4 + e];
#pragma unroll
                  for (int w = 0; w < 8; ++w) s += part[(w * 32 + n) * 64 + c4 + e];
                  hb[n * 64 + c4 + e] = silu_f(s); } }
            __syncthreads();
            { const int n = tid >> 4, c4 = (tid & 15) * 4; float o[4] = {0.f, 0.f, 0.f, 0.f}; const float* w2k = w2 + (size_t)kv * 64 * 64;
              for (int k = 0; k < 64; ++k) { const float hv = hb[n * 64 + k]; const f32x4 wv4 = *(const f32x4*)(w2k + k * 64 + c4);
                  o[0] += hv * wv4[0]; o[1] += hv * wv4[1]; o[2] += hv * wv4[2]; o[3] += hv * wv4[3]; }
              bf16_t* dst = (bf16_t*)(P.ws + (kv ? WS_VC : WS_KC)) + ((size_t)b * 512 + n0 + n) * 64 + c4;
              const bool valid = (n0 + n) < 511;
              u32x2 w; w.x = valid ? pk2(o[0], o[1]) : 0u; w.y = valid ? pk2(o[2], o[3]) : 0u; *(u32x2*)dst = w; }
            __syncthreads();
        }
    }
}

constexpr float NEG_BIG = -1e30f;
constexpr int KSTR64 = 144, KSTR96 = 208;
constexpr int ATT_KBUF = 64 * KSTR96;
constexpr int ATT_VBUF = 8192;
constexpr int ATT_K0 = 0, ATT_V0 = 2 * ATT_KBUF, ATT_B0 = ATT_V0 + 2 * ATT_VBUF, ATT_END = ATT_B0 + 2 * 256;
constexpr int ATT_EXTRA = 45056;

struct SoftState { float m, l; f32x16 o0, o1; };

template <int KS>
__device__ __forceinline__ void qk_tile(f32x16& p0, f32x16& p1, const LAS unsigned char* kt, int kstride, const bf16x8 (&qf)[KS], int r, int hi) {
    const LAS unsigned char* k0 = kt + r * kstride + hi * 16; const LAS unsigned char* k1 = k0 + 32 * kstride;
#pragma unroll
    for (int s = 0; s < KS; ++s) { const bf16x8 a0 = *(const LAS bf16x8*)(k0 + s * 32), a1 = *(const LAS bf16x8*)(k1 + s * 32);
        p0 = __builtin_amdgcn_mfma_f32_32x32x16_bf16(a0, qf[s], p0, 0, 0, 0); p1 = __builtin_amdgcn_mfma_f32_32x32x16_bf16(a1, qf[s], p1, 0, 0, 0); }
}
__device__ __forceinline__ float max3f(float a, float b, float c);
__device__ __forceinline__ float tile_max(const f32x16& p0, const f32x16& p1) {
    float a = max3f(p0[0], p0[1], p1[0]), b = max3f(p0[2], p0[3], p1[1]); a = max3f(a, p1[2], p1[3]);
#pragma unroll
    for (int i = 4; i < 16; i += 4) { a = max3f(a, p0[i], p0[i + 1]); b = max3f(b, p0[i + 2], p0[i + 3]); a = max3f(a, p1[i], p1[i + 1]); b = max3f(b, p1[i + 2], p1[i + 3]); }
    a = max3f(a, b, b);
    const auto rr = __builtin_amdgcn_permlane32_swap(__float_as_uint(a), __float_as_uint(a), false, false);
    return fmaxf(__uint_as_float(rr[0]), __uint_as_float(rr[1]));
}
__device__ __forceinline__ bf16x8 vfrag(const LAS unsigned char* p) {
    const s16x4 lo = __builtin_bit_cast(s16x4, __builtin_amdgcn_ds_read_tr16_b64_v4i16((LAS s16x4*)p));
    const s16x4 hi = __builtin_bit_cast(s16x4, __builtin_amdgcn_ds_read_tr16_b64_v4i16((LAS s16x4*)(p + 512)));
    return (bf16x8){lo[0], lo[1], lo[2], lo[3], hi[0], hi[1], hi[2], hi[3]};
}
__device__ __forceinline__ bf16x8 pfrag(const f32x16& p, int b) {
    u32x4 w; w.x = pk2(p[b], p[b + 1]); w.y = pk2(p[b + 2], p[b + 3]); w.z = pk2(p[b + 4], p[b + 5]); w.w = pk2(p[b + 6], p[b + 7]);
    return __builtin_bit_cast(bf16x8, w);
}
__device__ __forceinline__ void pv_frag(f32x16& o0, f32x16& o1, bf16x8 pf0, bf16x8 pf1, bf16x8 pf2, bf16x8 pf3, const LAS unsigned char* vt, int vb) {
    const LAS unsigned char* v = vt + vb;
    o0 = __builtin_amdgcn_mfma_f32_32x32x16_bf16(vfrag(v), pf0, o0, 0, 0, 0);            o1 = __builtin_amdgcn_mfma_f32_32x32x16_bf16(vfrag(v + 4096), pf0, o1, 0, 0, 0);
    o0 = __builtin_amdgcn_mfma_f32_32x32x16_bf16(vfrag(v + 1024), pf1, o0, 0, 0, 0);     o1 = __builtin_amdgcn_mfma_f32_32x32x16_bf16(vfrag(v + 4096 + 1024), pf1, o1, 0, 0, 0);
    o0 = __builtin_amdgcn_mfma_f32_32x32x16_bf16(vfrag(v + 2048), pf2, o0, 0, 0, 0);     o1 = __builtin_amdgcn_mfma_f32_32x32x16_bf16(vfrag(v + 4096 + 2048), pf2, o1, 0, 0, 0);
    o0 = __builtin_amdgcn_mfma_f32_32x32x16_bf16(vfrag(v + 3072), pf3, o0, 0, 0, 0);     o1 = __builtin_amdgcn_mfma_f32_32x32x16_bf16(vfrag(v + 4096 + 3072), pf3, o1, 0, 0, 0);
}
__device__ __forceinline__ void pv_tile(f32x16& o0, f32x16& o1, const f32x16& p0, const f32x16& p1, const LAS unsigned char* vt, int vb) {
    pv_frag(o0, o1, pfrag(p0, 0), pfrag(p0, 8), pfrag(p1, 0), pfrag(p1, 8), vt, vb);
}
__device__ __forceinline__ void softmax_step(SoftState& st, f32x16& p0, f32x16& p1, float c2) {
    const float mx = tile_max(p0, p1);
    const float mn = fmaxf(st.m, mx);
    if (__any(mn > st.m)) { const float al = __builtin_amdgcn_exp2f((st.m - mn) * c2); st.l *= al; st.o0 *= al; st.o1 *= al; st.m = mn; }
    const float mc = st.m * c2; float sum = 0.f;
#pragma unroll
    for (int i = 0; i < 16; ++i) { p0[i] = __builtin_amdgcn_exp2f(__builtin_fmaf(p0[i], c2, -mc)); p1[i] = __builtin_amdgcn_exp2f(__builtin_fmaf(p1[i], c2, -mc)); sum += p0[i] + p1[i]; }
    st.l += sum;
}

__device__ __forceinline__ float max3f(float a, float b, float c) { float r; asm("v_max3_f32 %0, %1, %2, %3" : "=v"(r) : "v"(a), "v"(b), "v"(c)); return r; }
__device__ __forceinline__ float swap32_max(float a) { const auto rr = __builtin_amdgcn_permlane32_swap(__float_as_uint(a), __float_as_uint(a), false, false);
    float r; asm("v_max_f32_e32 %0, %1, %2" : "=v"(r) : "v"(__uint_as_float(rr[0])), "v"(__uint_as_float(rr[1]))); return r; }
__device__ __forceinline__ float quad_xor1(float x) { return __builtin_bit_cast(float, __builtin_amdgcn_update_dpp(0, __builtin_bit_cast(int, x), 0xB1, 0xf, 0xf, false)); }
__device__ __forceinline__ float quad_xor2(float x) { return __builtin_bit_cast(float, __builtin_amdgcn_update_dpp(0, __builtin_bit_cast(int, x), 0x4E, 0xf, 0xf, false)); }
__device__ __forceinline__ float swap32_sum(float a) { const auto rr = __builtin_amdgcn_permlane32_swap(__float_as_uint(a), __float_as_uint(a), false, false); return __uint_as_float(rr[0]) + __uint_as_float(rr[1]); }
constexpr float SM_THR = 8.0f;
__device__ __forceinline__ void softmax_pack(SoftState& st, const f32x16& p0, const f32x16& p1, float c2, bf16x8& pf0, bf16x8& pf1, bf16x8& pf2, bf16x8& pf3) {
    float a = max3f(p0[0], p0[1], p1[0]), b = max3f(p0[2], p0[3], p1[1]); a = max3f(a, p1[2], p1[3]);
#pragma unroll
    for (int i = 4; i < 16; i += 4) { a = max3f(a, p0[i], p0[i + 1]); b = max3f(b, p0[i + 2], p0[i + 3]); a = max3f(a, p1[i], p1[i + 1]); b = max3f(b, p1[i + 2], p1[i + 3]); }
    float mx; asm("v_max_f32_e32 %0, %1, %2" : "=v"(mx) : "v"(a), "v"(b));
    mx = swap32_max(mx);
    if (__any((mx - st.m) * c2 > SM_THR)) { const float mn = fmaxf(st.m, mx); const float al = __builtin_amdgcn_exp2f((st.m - mn) * c2); st.l *= al; st.o0 *= al; st.o1 *= al; st.m = mn; }
    const float mc = -st.m * c2; float s0 = 0.f, s1 = 0.f;
    u32x4 w0, w1, w2, w3;
#define SMP(W, E, P, B) do { const float e0_ = __builtin_amdgcn_exp2f(__builtin_fmaf(P[B], c2, mc)), e1_ = __builtin_amdgcn_exp2f(__builtin_fmaf(P[B + 1], c2, mc)); s0 += e0_; s1 += e1_; W[E] = pk2(e0_, e1_); } while (0)
    SMP(w0, 0, p0, 0); SMP(w0, 1, p0, 2); SMP(w0, 2, p0, 4); SMP(w0, 3, p0, 6);
    SMP(w1, 0, p0, 8); SMP(w1, 1, p0, 10); SMP(w1, 2, p0, 12); SMP(w1, 3, p0, 14);
    SMP(w2, 0, p1, 0); SMP(w2, 1, p1, 2); SMP(w2, 2, p1, 4); SMP(w2, 3, p1, 6);
    SMP(w3, 0, p1, 8); SMP(w3, 1, p1, 10); SMP(w3, 2, p1, 12); SMP(w3, 3, p1, 14);
#undef SMP
    st.l += s0 + s1;
    pf0 = __builtin_bit_cast(bf16x8, w0); pf1 = __builtin_bit_cast(bf16x8, w1); pf2 = __builtin_bit_cast(bf16x8, w2); pf3 = __builtin_bit_cast(bf16x8, w3);
}

__device__ __forceinline__ void sm_exp_pack(SoftState& st, const f32x16& p0, const f32x16& p1, float c2, bf16x8& pf0, bf16x8& pf1, bf16x8& pf2, bf16x8& pf3) {
    const float mc = -st.m * c2; float s0 = 0.f, s1 = 0.f;
    u32x4 w0, w1, w2, w3;
#define SMP(W, E, P, B) do { const float e0_ = __builtin_amdgcn_exp2f(__builtin_fmaf(P[B], c2, mc)), e1_ = __builtin_amdgcn_exp2f(__builtin_fmaf(P[B + 1], c2, mc)); s0 += e0_; s1 += e1_; W[E] = pk2(e0_, e1_); } while (0)
    SMP(w0, 0, p0, 0); SMP(w0, 1, p0, 2); SMP(w0, 2, p0, 4); SMP(w0, 3, p0, 6);
    SMP(w1, 0, p0, 8); SMP(w1, 1, p0, 10); SMP(w1, 2, p0, 12); SMP(w1, 3, p0, 14);
    SMP(w2, 0, p1, 0); SMP(w2, 1, p1, 2); SMP(w2, 2, p1, 4); SMP(w2, 3, p1, 6);
    SMP(w3, 0, p1, 8); SMP(w3, 1, p1, 10); SMP(w3, 2, p1, 12); SMP(w3, 3, p1, 14);
#undef SMP
    st.l += s0 + s1;
    pf0 = __builtin_bit_cast(bf16x8, w0); pf1 = __builtin_bit_cast(bf16x8, w1); pf2 = __builtin_bit_cast(bf16x8, w2); pf3 = __builtin_bit_cast(bf16x8, w3);
}

template <int DK> struct StageRegs { u32x4 k0, k1, v; float b; };
template <int DK>
__device__ __forceinline__ void stage_load(StageRegs<DK>& sr, const bf16_t* K, int ldk, const bf16_t* V, int ldv, const float* bias, int kv0, int wid0) {
    const int tid = opaque_tid(wid0); constexpr int CPR = DK / 8;
    { const int row = tid / CPR, cc = tid % CPR; sr.k0 = *(const u32x4*)(K + (size_t)(kv0 + row) * ldk + cc * 8); }
    if (DK == 96 && tid < 256) { const int c = tid + 512, row = c / CPR, cc = c % CPR; sr.k1 = *(const u32x4*)(K + (size_t)(kv0 + row) * ldk + cc * 8); }
    { const int row = tid >> 3, cc = tid & 7; sr.v = *(const u32x4*)(V + (size_t)(kv0 + row) * ldv + cc * 8); }
    if (bias && tid < 64) sr.b = bias[kv0 + tid];
}
template <int DK>
__device__ __forceinline__ void stage_store(const StageRegs<DK>& sr, LAS unsigned char* lds, int buf, bool has_bias, int wid0) {
    const int tid = opaque_tid(wid0); constexpr int CPR = DK / 8; constexpr int KSTR = (DK == 96) ? KSTR96 : KSTR64;
    LAS unsigned char* kb = lds + ATT_K0 + buf * ATT_KBUF; LAS unsigned char* vb = lds + ATT_V0 + buf * ATT_VBUF;
    { const int row = tid / CPR, cc = tid % CPR; *(LAS u32x4*)(kb + row * KSTR + cc * 16) = sr.k0; }
    if (DK == 96 && tid < 256) { const int c = tid + 512, row = c / CPR, cc = c % CPR; *(LAS u32x4*)(kb + row * KSTR + cc * 16) = sr.k1; }
    { const int row = tid >> 3, cc = tid & 7; *(LAS u32x4*)(vb + (cc >> 2) * 4096 + row * 64 + (cc & 3) * 16) = sr.v; }
    if (has_bias && tid < 64) *(LAS float*)(lds + ATT_B0 + buf * 256 + tid * 4) = sr.b;
}

__device__ __forceinline__ void store_out(bf16_t* dst  , const f32x16& o0, const f32x16& o1, float scale, int hi) {
#pragma unroll
    for (int g = 0; g < 4; ++g) {
        u32x2 w; w.x = pk2(o0[4 * g] * scale, o0[4 * g + 1] * scale); w.y = pk2(o0[4 * g + 2] * scale, o0[4 * g + 3] * scale);
        *(u32x2*)(dst + 8 * g + 4 * hi) = w;
        u32x2 w1; w1.x = pk2(o1[4 * g] * scale, o1[4 * g + 1] * scale); w1.y = pk2(o1[4 * g + 2] * scale, o1[4 * g + 3] * scale);
        *(u32x2*)(dst + 32 + 8 * g + 4 * hi) = w1;
    }
}

constexpr int DA_K0 = 0, DA_V0 = 3 * ATT_KBUF, DA_B0 = DA_V0 + 2 * ATT_VBUF, DA_END = DA_B0 + 3 * 256;
static_assert(DA_END <= LDS_BYTES, "dense attention LDS map");
template <int DK, int MODE>
__device__ __forceinline__ void dense_unit(LAS unsigned char* lds, const bf16_t* Q, int ldq, const bf16_t* K, int ldk, const bf16_t* V, int ldv,
                                           bf16_t* O  , const float* bias, const unsigned long long* maskbits  ,
                                           float alibiA, float c2, int qb, int wid0) {
    constexpr int KS = DK / 16; constexpr int KSTR = (DK == 96) ? KSTR96 : KSTR64; constexpr int CPR = DK / 8;
    const int tid = opaque_tid(wid0), lane = tid & 63, wv = __builtin_amdgcn_readfirstlane(tid >> 6), r = lane & 31, hi = lane >> 5;
    const int q0 = qb * 256, qw0 = q0 + wv * 32, tq = qw0 + r;
    const int NT = (q0 + 256) / 64;
    const int tlast = (qw0 + 31) >> 6;
    bf16x8 qf[KS];
#pragma unroll
    for (int s = 0; s < KS; ++s) qf[s] = *(const bf16x8*)(Q + (size_t)tq * ldq + s * 16 + hi * 8);
    const int vb = ((lane >> 4) & 1) * 32 + (lane & 3) * 8 + (4 * hi + ((lane & 15) >> 2)) * 64;
    const int kb = r * KSTR + hi * 16;
    SoftState st; st.m = NEG_BIG; st.l = 0.f; st.o0 = (f32x16){}; st.o1 = (f32x16){};
    const int krow0 = tid / CPR, kcc0 = tid % CPR, krow1 = (tid + 512) / CPR, kcc1 = (tid + 512) % CPR, vrow = tid >> 3, vcc = tid & 7;
    const bf16_t* kp0 = K + (size_t)krow0 * ldk + kcc0 * 8; const bf16_t* kp1 = K + (size_t)krow1 * ldk + kcc1 * 8; const bf16_t* vp = V + (size_t)vrow * ldv + vcc * 8;
    const int klds0 = krow0 * KSTR + kcc0 * 16, klds1 = krow1 * KSTR + kcc1 * 16, vlds = (vcc >> 2) * 4096 + vrow * 64 + (vcc & 3) * 16;
    u32x4 rk0, rk1, rv; float rbias = 0.f;
#define DA_LOADK(t) do { rk0 = *(const u32x4*)(kp0 + (size_t)(t) * 64 * ldk); if (DK == 96 && tid < 256) rk1 = *(const u32x4*)(kp1 + (size_t)(t) * 64 * ldk); if (MODE == 1 && tid < 64) rbias = bias[(t) * 64 + tid]; } while (0)
#define DA_LOADV(t) do { rv = *(const u32x4*)(vp + (size_t)(t) * 64 * ldv); } while (0)
#define DA_STOREK(slot) do { LAS unsigned char* kb_ = lds + DA_K0 + (slot) * ATT_KBUF; *(LAS u32x4*)(kb_ + klds0) = rk0; if (DK == 96 && tid < 256) *(LAS u32x4*)(kb_ + klds1) = rk1; \
        if (MODE == 1 && tid < 64) *(LAS float*)(lds + DA_B0 + (slot) * 256 + tid * 4) = rbias; } while (0)
#define DA_STOREV(slot) do { *(LAS u32x4*)(lds + DA_V0 + (slot) * ATT_VBUF + vlds) = rv; } while (0)
#define DA_CINIT(P0, P1, t, slot) do { const int kv0_ = (t) * 64; \
        if (MODE == 0) { P0 = (f32x16){}; P1 = (f32x16){}; } \
        else if (MODE == 1) { const LAS float* bl = (const LAS float*)(lds + DA_B0 + (slot) * 256); \
            _Pragma("unroll") for (int g = 0; g < 4; ++g) { const f32x4 b0_ = *(const LAS f32x4*)(bl + 8 * g + 4 * hi), b1_ = *(const LAS f32x4*)(bl + 32 + 8 * g + 4 * hi); \
                _Pragma("unroll") for (int e = 0; e < 4; ++e) { P0[4 * g + e] = b0_[e]; P1[4 * g + e] = b1_[e]; } } } \
        else { const float base_ = alibiA * (float)(kv0_ + 4 * hi); \
            _Pragma("unroll") for (int i = 0; i < 16; ++i) { P0[i] = base_ + alibiA * (float)((i & 3) + 8 * (i >> 2)); P1[i] = P0[i] + alibiA * 32.0f; } } } while (0)
#define DA_MASK(P0, P1, t, mb) do { const int kv0_ = (t) * 64; \
        if (MODE == 2) { const unsigned long long ms_ = (mb) >> (4 * hi); const unsigned lo_ = (unsigned)ms_, hw_ = (unsigned)(ms_ >> 32); \
            _Pragma("unroll") for (int i = 0; i < 16; ++i) { const unsigned bit_ = 1u << ((i & 3) + 8 * (i >> 2)); if (!(lo_ & bit_)) P0[i] = -INFINITY; if (!(hw_ & bit_)) P1[i] = -INFINITY; } } \
        else if (kv0_ + 63 > qw0) { \
            _Pragma("unroll") for (int i = 0; i < 16; ++i) { const int kv_ = kv0_ + crow(i, hi); if (kv_ > tq) P0[i] = -INFINITY; if (kv_ + 32 > tq) P1[i] = -INFINITY; } } } while (0)
#define DA_ROWMAX(MX, P0, P1) do { float a_ = __builtin_fmaxf(__builtin_fmaxf(P0[0], P0[1]), P1[0]), b_ = __builtin_fmaxf(__builtin_fmaxf(P0[2], P0[3]), P1[1]); a_ = __builtin_fmaxf(__builtin_fmaxf(a_, P1[2]), P1[3]); \
        _Pragma("unroll") for (int i = 4; i < 16; i += 4) { a_ = __builtin_fmaxf(__builtin_fmaxf(a_, P0[i]), P0[i + 1]); b_ = __builtin_fmaxf(__builtin_fmaxf(b_, P0[i + 2]), P0[i + 3]); a_ = __builtin_fmaxf(__builtin_fmaxf(a_, P1[i]), P1[i + 1]); b_ = __builtin_fmaxf(__builtin_fmaxf(b_, P1[i + 2]), P1[i + 3]); } \
        a_ = __builtin_fmaxf(a_, b_); const auto rr_ = __builtin_amdgcn_permlane32_swap(__float_as_uint(a_), __float_as_uint(a_), false, false); \
        MX = __builtin_fmaxf(__uint_as_float(rr_[0]), __uint_as_float(rr_[1])); } while (0)
    __syncthreads();
    DA_LOADK(0); DA_LOADV(0); DA_STOREK(0); DA_STOREV(0);
    DA_LOADK(1); DA_STOREK(1);
    DA_LOADK(2); DA_LOADV(1);
    __syncthreads();
    f32x16 pa0, pa1, pb0, pb1;
    unsigned long long mb_nxt = 0ull, mb_nn = 0ull;
    {
        DA_CINIT(pa0, pa1, 0, 0);
        qk_tile<KS>(pa0, pa1, lds + DA_K0, KSTR, qf, r, hi);
        unsigned long long mb0 = 0ull;
        if (MODE == 2) { mb0 = maskbits[(size_t)tq * 128]; if (1 <= tlast) mb_nxt = maskbits[(size_t)tq * 128 + 1]; }
        DA_MASK(pa0, pa1, 0, mb0);
        float mx; DA_ROWMAX(mx, pa0, pa1);
        st.m = __builtin_fmaxf(st.m, mx);
    }
    int ks_next = 1, ks_store = 2, vs_cur = 0;
#define DA_STEP(C0, C1, N0, N1, t) do { \
        if (MODE == 2) { mb_nn = 0ull; if ((t) + 2 <= tlast) mb_nn = maskbits[(size_t)tq * 128 + (t) + 2]; } \
        if ((t) <= tlast) { \
              \
            DA_CINIT(N0, N1, (t) + 1, ks_next); \
            bf16x8 pf0, pf1, pf2, pf3; \
            bf16x8 kf[2 * KS]; { const LAS unsigned char* k_ = lds + DA_K0 + ks_next * ATT_KBUF + kb; \
                _Pragma("unroll") for (int s_ = 0; s_ < KS; ++s_) { kf[2 * s_] = *(const LAS bf16x8*)(k_ + s_ * 32); kf[2 * s_ + 1] = *(const LAS bf16x8*)(k_ + 32 * KSTR + s_ * 32); } } \
            __builtin_amdgcn_sched_barrier(0); \
            _Pragma("unroll") for (int s_ = 0; s_ < KS; ++s_) { N0 = __builtin_amdgcn_mfma_f32_32x32x16_bf16(kf[2 * s_], qf[s_], N0, 0, 0, 0); N1 = __builtin_amdgcn_mfma_f32_32x32x16_bf16(kf[2 * s_ + 1], qf[s_], N1, 0, 0, 0); } \
            sm_exp_pack(st, C0, C1, c2, pf0, pf1, pf2, pf3); \
            _Pragma("unroll") for (int g_ = 0; g_ < 2 * KS; ++g_) { __builtin_amdgcn_sched_group_barrier(0x8, 1, 0); __builtin_amdgcn_sched_group_barrier(0x2, (KS == 6 ? 9 : 14), 0); } \
            __builtin_amdgcn_sched_barrier(0); \
              \
            bf16x8 vf[8]; { const LAS unsigned char* v_ = lds + DA_V0 + vs_cur * ATT_VBUF + vb; \
                _Pragma("unroll") for (int s_ = 0; s_ < 4; ++s_) { vf[2 * s_] = vfrag(v_ + s_ * 1024); vf[2 * s_ + 1] = vfrag(v_ + 4096 + s_ * 1024); } } \
            __builtin_amdgcn_sched_barrier(0); \
            float mx_ = -INFINITY; \
            if ((t) < tlast) { DA_MASK(N0, N1, (t) + 1, mb_nxt); DA_ROWMAX(mx_, N0, N1); } \
            __builtin_amdgcn_sched_barrier(0); \
            st.o0 = __builtin_amdgcn_mfma_f32_32x32x16_bf16(vf[0], pf0, st.o0, 0, 0, 0); st.o1 = __builtin_amdgcn_mfma_f32_32x32x16_bf16(vf[1], pf0, st.o1, 0, 0, 0); \
            st.o0 = __builtin_amdgcn_mfma_f32_32x32x16_bf16(vf[2], pf1, st.o0, 0, 0, 0); st.o1 = __builtin_amdgcn_mfma_f32_32x32x16_bf16(vf[3], pf1, st.o1, 0, 0, 0); \
            st.o0 = __builtin_amdgcn_mfma_f32_32x32x16_bf16(vf[4], pf2, st.o0, 0, 0, 0); st.o1 = __builtin_amdgcn_mfma_f32_32x32x16_bf16(vf[5], pf2, st.o1, 0, 0, 0); \
            st.o0 = __builtin_amdgcn_mfma_f32_32x32x16_bf16(vf[6], pf3, st.o0, 0, 0, 0); st.o1 = __builtin_amdgcn_mfma_f32_32x32x16_bf16(vf[7], pf3, st.o1, 0, 0, 0); \
            __builtin_amdgcn_sched_barrier(0); \
            if (__any((mx_ - st.m) * c2 > SM_THR)) { const float mn_ = __builtin_fmaxf(st.m, mx_); const float al_ = __builtin_amdgcn_exp2f((st.m - mn_) * c2); st.l *= al_; st.o0 *= al_; st.o1 *= al_; st.m = mn_; } \
        } \
        if ((t) + 2 < NT) DA_STOREK(ks_store); \
        if ((t) + 1 < NT) DA_STOREV(vs_cur ^ 1); \
        if ((t) + 3 < NT) DA_LOADK((t) + 3); \
        if ((t) + 2 < NT) DA_LOADV((t) + 2); \
        __syncthreads(); \
        mb_nxt = mb_nn; vs_cur ^= 1; ks_next = (ks_next == 2) ? 0 : ks_next + 1; ks_store = (ks_store == 2) ? 0 : ks_store + 1; } while (0)
    for (int t = 0; t < NT; t += 2) {
        DA_STEP(pa0, pa1, pb0, pb1, t);
        DA_STEP(pb0, pb1, pa0, pa1, t + 1);
    }
#undef DA_LOADK
#undef DA_LOADV
#undef DA_STOREK
#undef DA_STOREV
#undef DA_CINIT
#undef DA_MASK
#undef DA_ROWMAX
#undef DA_STEP
    const float l = swap32_sum(st.l);
    const float inv = l > 0.f ? 1.0f / l : 0.f;
    store_out(O + (size_t)tq * D, st.o0, st.o1, inv, hi);
}

constexpr int DSA_H1 = 0, DSA_H2 = 65536, DSA_INFO = 65536 + 32768;
__device__ __forceinline__ unsigned score_key32(float s) { const unsigned u = __float_as_uint(s); return u ^ ((unsigned)((int)u >> 31) | 0x80000000u); }
__device__ __forceinline__ unsigned score_key16(float s) { return score_key32(s) >> 16; }
__device__ __forceinline__ float relu_f(float x) { const int b_ = __builtin_bit_cast(int, x); return __builtin_bit_cast(float, b_ > 0 ? b_ : 0); }

struct KFrag { bf16x8 a00, a01, a10, a11; };
__device__ __forceinline__ void dsa_kload(KFrag& f, const bf16_t* kix  , int t, int r, int hi) {
    const bf16_t* p = kix + ((size_t)t * 64 + r) * 32 + hi * 8;
    f.a00 = *(const bf16x8*)p; f.a01 = *(const bf16x8*)(p + 16); f.a10 = *(const bf16x8*)(p + 1024); f.a11 = *(const bf16x8*)(p + 1024 + 16);
}
__device__ __forceinline__ void dsa_scores(f32x16& s0, f32x16& s1, const KFrag& f, const bf16x8 (&qi)[4][2], const float (&w)[4]) {
    s0 = (f32x16){}; s1 = (f32x16){};
#pragma unroll
    for (int ih = 0; ih < 4; ++ih) {
        f32x16 a = __builtin_amdgcn_mfma_f32_32x32x16_bf16(f.a00, qi[ih][0], (f32x16){}, 0, 0, 0); a = __builtin_amdgcn_mfma_f32_32x32x16_bf16(f.a01, qi[ih][1], a, 0, 0, 0);
        f32x16 c = __builtin_amdgcn_mfma_f32_32x32x16_bf16(f.a10, qi[ih][0], (f32x16){}, 0, 0, 0); c = __builtin_amdgcn_mfma_f32_32x32x16_bf16(f.a11, qi[ih][1], c, 0, 0, 0);
#pragma unroll
        for (int i = 0; i < 16; ++i) { s0[i] = __builtin_fmaf(w[ih], relu_f(a[i]), s0[i]); s1[i] = __builtin_fmaf(w[ih], relu_f(c[i]), s1[i]); }
    }
}
__device__ __forceinline__ void hist_add(LAS unsigned* hrow, int r, unsigned bin) { atomicAdd((unsigned*)(hrow + ((bin >> 1) ^ (unsigned)r)), 1u << ((bin & 1u) * 16u)); }

__device__ __forceinline__ void dsa_index_unit(LAS unsigned char* lds, const bf16_t* proj, const bf16_t* kidx, const float* side, unsigned long long* maskbits, int b, int qg, int wid0) {
    const int tid = opaque_tid(wid0), lane = tid & 63, wv = __builtin_amdgcn_readfirstlane(tid >> 6), r = lane & 31, hi = lane >> 5;
    const int tq = qg * 32 + r; const size_t rowq = (size_t)b * S + tq;
    const int nt = (qg >> 1) + 1;
    const int per = (nt + 7) >> 3; const int t_lo = wv * per, t_hi = (t_lo + per < nt) ? t_lo + per : nt;
    bf16x8 qi[4][2]; float w[4];
#pragma unroll
    for (int ih = 0; ih < 4; ++ih) { qi[ih][0] = *(const bf16x8*)(proj + rowq * NP + C_IQ + ih * 32 + hi * 8); qi[ih][1] = *(const bf16x8*)(proj + rowq * NP + C_IQ + ih * 32 + 16 + hi * 8);
        w[ih] = side[rowq * 32 + 4 + ih] * 0.5f; }
    LAS unsigned* h1 = (LAS unsigned*)(lds + DSA_H1) + r * 512; LAS unsigned* h2 = (LAS unsigned*)(lds + DSA_H2) + wv * 1024 + r * 32;
    LAS int* info = (LAS int*)(lds + DSA_INFO);
    const bf16_t* kix = kidx + (size_t)b * S * 32;
    const bool sel_all = (qg < 8);
    __syncthreads();
    if (!sel_all) {
        for (int i = tid; i < (DSA_INFO) / 16; i += NTHREADS) ((LAS u32x4*)lds)[i] = (u32x4){0u, 0u, 0u, 0u};
        __syncthreads();
        if (t_lo < t_hi) {
            KFrag cur, nxt; dsa_kload(cur, kix, t_lo, r, hi);
            for (int t = t_lo; t < t_hi; ++t) {
                if (t + 1 < t_hi) dsa_kload(nxt, kix, t + 1, r, hi);
                f32x16 s0, s1; dsa_scores(s0, s1, cur, qi, w);
                const int kv0 = t * 64;
                if (kv0 + 63 <= qg * 32) {
#pragma unroll
                    for (int i = 0; i < 16; ++i) { hist_add(h1, r, score_key32(s0[i]) >> 22); hist_add(h1, r, score_key32(s1[i]) >> 22); }
                } else {
#pragma unroll
                    for (int i = 0; i < 16; ++i) { const int kv = kv0 + crow(i, hi);
                        if (kv <= tq) hist_add(h1, r, score_key32(s0[i]) >> 22);
                        if (kv + 32 <= tq) hist_add(h1, r, score_key32(s1[i]) >> 22); }
                }
                cur = nxt;
            }
        }
        __syncthreads();
        { const int row = tid >> 4, part = tid & 15; const LAS unsigned* hr = (const LAS unsigned*)(lds + DSA_H1) + row * 512; unsigned cs = 0;
#pragma unroll 8
          for (int j = 0; j < 32; ++j) { const unsigned wd = hr[(part * 32 + j) ^ row]; cs += (wd & 0xffffu) + (wd >> 16); }
          unsigned suf = cs;
#pragma unroll
          for (int o = 1; o < 16; o <<= 1) { const unsigned t = __shfl_down(suf, o, 16); if (part + o < 16) suf += t; }
          const unsigned above = suf - cs;
          if (above < 256u && above + cs >= 256u) { unsigned acc = above; int bsel = part * 64; unsigned ab = above;
              for (int j = 31; j >= 0; --j) { const unsigned wd = hr[(part * 32 + j) ^ row]; const unsigned c1 = wd >> 16, c0 = wd & 0xffffu;
                  if (acc + c1 >= 256u) { bsel = part * 64 + 2 * j + 1; ab = acc; break; } acc += c1;
                  if (acc + c0 >= 256u) { bsel = part * 64 + 2 * j; ab = acc; break; } acc += c0; }
              info[row] = bsel; info[32 + row] = 256 - (int)ab; } }
        __syncthreads();
        const unsigned B1 = (unsigned)info[r];
        if (t_lo < t_hi) {
            KFrag cur, nxt; dsa_kload(cur, kix, t_lo, r, hi);
            for (int t = t_lo; t < t_hi; ++t) {
                if (t + 1 < t_hi) dsa_kload(nxt, kix, t + 1, r, hi);
                f32x16 s0, s1; dsa_scores(s0, s1, cur, qi, w);
                const int kv0 = t * 64;
#pragma unroll
                for (int i = 0; i < 16; ++i) { const int kv = kv0 + crow(i, hi);
                    { const unsigned k = score_key32(s0[i]); if (kv <= tq && (k >> 22) == B1) hist_add(h2, r, (k >> 16) & 63u); }
                    { const unsigned k = score_key32(s1[i]); if (kv + 32 <= tq && (k >> 22) == B1) hist_add(h2, r, (k >> 16) & 63u); } }
                cur = nxt;
            }
        }
        __syncthreads();
        { const int row = tid >> 4, part = tid & 15; unsigned cnt[4]; unsigned cs = 0; const unsigned need1 = (unsigned)info[32 + row];
          LAS unsigned* h2a = (LAS unsigned*)(lds + DSA_H2);
#pragma unroll
          for (int j = 0; j < 2; ++j) { unsigned c0 = 0, c1 = 0; const int wi = row * 32 + ((part * 2 + j) ^ row);
#pragma unroll
              for (int ww = 0; ww < 8; ++ww) { const unsigned wd = h2a[ww * 1024 + wi]; c0 += wd & 0xffffu; c1 += wd >> 16; }
              cnt[2 * j] = c0; cnt[2 * j + 1] = c1; cs += c0 + c1; }
          unsigned suf = cs;
#pragma unroll
          for (int o = 1; o < 16; o <<= 1) { const unsigned t = __shfl_down(suf, o, 16); if (part + o < 16) suf += t; }
          const unsigned above = suf - cs;
          if (above < need1 && above + cs >= need1) { unsigned acc = above; int bsel = 0; unsigned ab = above; bool found = false;
#pragma unroll
              for (int j = 3; j >= 0; --j) { if (!found) { if (acc + cnt[j] >= need1) { bsel = part * 4 + j; ab = acc; found = true; } else acc += cnt[j]; } }
              info[64 + row] = (int)(((unsigned)info[row] << 6) | (unsigned)bsel); info[96 + row] = (int)(need1 - ab);
              const int wi = row * 32 + ((bsel >> 1) ^ row); unsigned run = 0;
#pragma unroll
              for (int ww = 0; ww < 8; ++ww) { info[128 + row * 8 + ww] = (int)run; const unsigned wd = h2a[ww * 1024 + wi]; run += (bsel & 1) ? (wd >> 16) : (wd & 0xffffu); } } }
        __syncthreads();
    }
    const unsigned T = sel_all ? 0u : (unsigned)info[64 + r];
    const unsigned need2 = sel_all ? 0x7fffffffu : (unsigned)info[96 + r];
    unsigned tc = sel_all ? 0u : (unsigned)info[128 + r * 8 + wv];
    if (t_lo < t_hi) {
        KFrag cur, nxt; dsa_kload(cur, kix, t_lo, r, hi);
        for (int t = t_lo; t < t_hi; ++t) {
            if (t + 1 < t_hi) dsa_kload(nxt, kix, t + 1, r, hi);
            f32x16 s0, s1; dsa_scores(s0, s1, cur, qi, w);
            const int kv0 = t * 64; unsigned words[2];
#pragma unroll
            for (int half = 0; half < 2; ++half) {
                unsigned gt = 0, eq = 0;
#pragma unroll
                for (int i = 0; i < 16; ++i) { const int kv = kv0 + 32 * half + crow(i, hi); const unsigned k = score_key16(half ? s1[i] : s0[i]);
                    const unsigned v = (kv <= tq) ? 1u : 0u; gt |= ((k > T) ? v : 0u) << i; eq |= ((k == T) ? v : 0u) << i; }
                unsigned sel = gt;
                if (__any(eq != 0u)) {
                    const unsigned a0 = __popc(eq & 0xfu), a1 = __popc(eq & 0xf0u), a2 = __popc(eq & 0xf00u), a3 = __popc(eq & 0xf000u);
                    const unsigned own = a0 | (a1 << 8) | (a2 << 16) | (a3 << 24); const unsigned oth = __shfl_xor(own, 32);
                    const unsigned b0 = oth & 255u, b1 = (oth >> 8) & 255u, b2 = (oth >> 16) & 255u, b3 = oth >> 24;
                    unsigned pre[4]; const unsigned hb = hi ? 1u : 0u;
                    pre[0] = tc + hb * b0; pre[1] = tc + a0 + b0 + hb * b1; pre[2] = tc + a0 + b0 + a1 + b1 + hb * b2; pre[3] = tc + a0 + b0 + a1 + b1 + a2 + b2 + hb * b3;
#pragma unroll
                    for (int g = 0; g < 4; ++g) { unsigned rk = pre[g];
#pragma unroll
                        for (int e = 0; e < 4; ++e) { const unsigned bit = 1u << (4 * g + e); if (eq & bit) { if (rk < need2) sel |= bit; ++rk; } } }
                    tc += a0 + a1 + a2 + a3 + b0 + b1 + b2 + b3;
                }
                unsigned wbits = (sel & 0xfu) | ((sel & 0xf0u) << 4) | ((sel & 0xf00u) << 8) | ((sel & 0xf000u) << 12);
                wbits <<= 4 * hi;
                wbits |= __shfl_xor(wbits, 32);
                words[half] = wbits;
            }
            if (hi == 0) maskbits[(size_t)tq * 128 + t] = (unsigned long long)words[0] | ((unsigned long long)words[1] << 32);
            cur = nxt;
        }
    }
}

constexpr int NSA_IMP = ATT_EXTRA;
constexpr int NSA_SEL = NSA_IMP + 32768;
constexpr int NSA_UNI = NSA_SEL + 1024;
constexpr int NSA_LIST = NSA_UNI + 64;
constexpr int NSA_OT = NSA_LIST + 1024;
static_assert(NSA_OT + 65536 <= LDS_BYTES, "NSA LDS map");

__device__ __forceinline__ void nsa_unit(LAS unsigned char* lds, const bf16_t* proj, const float* side, const bf16_t* kc, const bf16_t* vc, bf16_t* ocat, int b, int q64, int wid0) {
    const int tid = opaque_tid(wid0), lane = tid & 63, wv = __builtin_amdgcn_readfirstlane(tid >> 6), r = lane & 31, hi = lane >> 5;
    const int t0 = q64 * 64, q8 = r >> 2, hd = r & 3, tq = t0 + wv * 8 + q8; const size_t rowq = (size_t)b * S + tq;
    const float c2 = 0.125f * LOG2E;
    const float slope = (hd == 0) ? 0.25f : (hd == 1 ? 0.0625f : (hd == 2 ? 0.015625f : 0.00390625f));
    const float A = 8.0f * slope;
    bf16x8 qf[4];
#pragma unroll
    for (int s = 0; s < 4; ++s) qf[s] = *(const bf16x8*)(proj + rowq * NP + C_NQ + hd * 64 + s * 16 + hi * 8);
    const float g0 = sigmoid_f(side[rowq * 32 + 8 + hd * 3 + 0]), g1 = sigmoid_f(side[rowq * 32 + 8 + hd * 3 + 1]), g2 = sigmoid_f(side[rowq * 32 + 8 + hd * 3 + 2]);
    const int vb = ((lane >> 4) & 1) * 32 + (lane & 3) * 8 + (4 * hi + ((lane & 15) >> 2)) * 64;
    LAS float* imp = (LAS float*)(lds + NSA_IMP) + wv * 1024;
    LAS unsigned* selw = (LAS unsigned*)(lds + NSA_SEL) + wv * 32;
    LAS unsigned* uni = (LAS unsigned*)(lds + NSA_UNI);
    LAS int* list = (LAS int*)(lds + NSA_LIST);
    LAS float* otl = (LAS float*)(lds + NSA_OT) + wv * 2048 + lane;
    StageRegs<64> sr;
    __syncthreads();
    for (int i = lane; i < 1024; i += 64) imp[i] = 0.f;
    if (tid < 4) uni[tid] = 0u;
    const bf16_t* kcb = kc + (size_t)b * 512 * 64; const bf16_t* vcb = vc + (size_t)b * 512 * 64;
    const int ntc = (((t0 + 32) >> 4) >> 6) + 1;
    SoftState st; st.m = NEG_BIG; st.l = 0.f; st.o0 = (f32x16){}; st.o1 = (f32x16){};
    for (int pass = 0; pass < 2; ++pass) {
        stage_load<64>(sr, kcb, 64, vcb, 64, nullptr, 0, wid0);
        __syncthreads();
        stage_store<64>(sr, lds, 0, false, wid0);
        if (1 < ntc) stage_load<64>(sr, kcb, 64, vcb, 64, nullptr, 64, wid0);
        __syncthreads();
        float rl = 0.f;
        if (pass == 1) { const float l = st.l + __shfl_xor(st.l, 32); rl = l > 0.f ? 1.0f / l : 0.f; }
        const float mc = st.m * c2;
        for (int t = 0; t < ntc; ++t) {
            const int buf = t & 1;
            f32x16 p0, p1; const int n0 = t * 64;
            { const float base = A * (float)(16 * (n0 + 4 * hi) + 31);
#pragma unroll
              for (int i = 0; i < 16; ++i) { p0[i] = base + A * 16.0f * (float)((i & 3) + 8 * (i >> 2)); p1[i] = p0[i] + A * 512.0f; } }
            qk_tile<4>(p0, p1, lds + ATT_K0 + buf * ATT_KBUF, KSTR64, qf, r, hi);
#pragma unroll
            for (int i = 0; i < 16; ++i) { const int n = n0 + crow(i, hi); if (16 * n + 31 > tq) p0[i] = -INFINITY; if (16 * (n + 32) + 31 > tq) p1[i] = -INFINITY; }
            if (pass == 0) {
                const float mx = tile_max(p0, p1); const float mn = fmaxf(st.m, mx);
                const float al = __builtin_amdgcn_exp2f((st.m - mn) * c2); st.l *= al; st.m = mn; const float mcc = mn * c2; float sum = 0.f;
#pragma unroll
                for (int i = 0; i < 16; ++i) sum += __builtin_amdgcn_exp2f(__builtin_fmaf(p0[i], c2, -mcc)) + __builtin_amdgcn_exp2f(__builtin_fmaf(p1[i], c2, -mcc));
                st.l += sum;
            } else {
#pragma unroll
                for (int i = 0; i < 16; ++i) { p0[i] = __builtin_amdgcn_exp2f(__builtin_fmaf(p0[i], c2, -mc)) * rl; p1[i] = __builtin_amdgcn_exp2f(__builtin_fmaf(p1[i], c2, -mc)) * rl; }
#pragma unroll
                for (int half = 0; half < 2; ++half)
#pragma unroll
                    for (int g = 0; g < 4; ++g) { const f32x16& pp = half ? p1 : p0;
                        float s4 = (pp[4 * g] + pp[4 * g + 1]) + (pp[4 * g + 2] + pp[4 * g + 3]); float s3 = pp[4 * g + 3];
                        s4 += quad_xor1(s4); s4 += quad_xor2(s4); s3 += quad_xor1(s3); s3 += quad_xor2(s3);
                        const int j1 = 16 * t + 8 * half + 2 * g + hi;
                        if (hd == 0) atomicAdd((float*)(imp + q8 * 128 + j1), s4);
                        if (hd == 0 && j1 + 1 < 128) atomicAdd((float*)(imp + q8 * 128 + j1 + 1), s3); }
                pv_tile(st.o0, st.o1, p0, p1, lds + ATT_V0 + buf * ATT_VBUF, vb);
            }
            if (t + 1 < ntc) stage_store<64>(sr, lds, buf ^ 1, false, wid0);
            if (t + 2 < ntc) stage_load<64>(sr, kcb, 64, vcb, 64, nullptr, (t + 2) * 64, wid0);
            __syncthreads();
        }
    }
#pragma unroll
    for (int i = 0; i < 16; ++i) { otl[i * 64] = st.o0[i] * g0; otl[(16 + i) * 64] = st.o1[i] * g0; }
    {
        const int cur = q64;
        for (int qq = 0; qq < 8; ++qq) {
            float v0 = imp[qq * 128 + lane], v1 = imp[qq * 128 + 64 + lane];
            { const int j0 = lane, j1 = lane + 64;
              if (j0 == 0 || j0 == cur) v0 = INFINITY; else if (j0 > cur) v0 = -INFINITY;
              if (j1 == cur) v1 = INFINITY; else if (j1 > cur) v1 = -INFINITY; }
            int rk0 = 0, rk1 = 0;
#pragma unroll
            for (int i = 0; i < 64; ++i) {
                const float ai = __builtin_bit_cast(float, __builtin_amdgcn_readlane(__builtin_bit_cast(int, v0), i));
                const float bi = __builtin_bit_cast(float, __builtin_amdgcn_readlane(__builtin_bit_cast(int, v1), i));
                rk0 += ((ai > v0) || (ai == v0 && i < lane)) ? 1 : 0;
                rk0 += (bi > v0) ? 1 : 0;
                rk1 += (ai >= v1) ? 1 : 0;
                rk1 += ((bi > v1) || (bi == v1 && i < lane)) ? 1 : 0;
            }
            const unsigned long long slo = __ballot(rk0 < 16 && v0 > -INFINITY), shi = __ballot(rk1 < 16 && v1 > -INFINITY);
            if (lane == 0) { selw[qq * 4 + 0] = (unsigned)slo; selw[qq * 4 + 1] = (unsigned)(slo >> 32); selw[qq * 4 + 2] = (unsigned)shi; selw[qq * 4 + 3] = (unsigned)(shi >> 32);
                atomicOr((unsigned*)(uni + 0), (unsigned)slo); atomicOr((unsigned*)(uni + 1), (unsigned)(slo >> 32)); atomicOr((unsigned*)(uni + 2), (unsigned)shi); atomicOr((unsigned*)(uni + 3), (unsigned)(shi >> 32)); }
        }
    }
    __syncthreads();
    if (tid == 0) { int n = 0; for (int wd = 0; wd < 4; ++wd) { unsigned u = uni[wd]; while (u) { const int j = __ffs(u) - 1; u &= u - 1; list[n++] = wd * 32 + j; } } list[131] = n; }
    __syncthreads();
    {
        const unsigned m0 = selw[q8 * 4 + 0], m1 = selw[q8 * 4 + 1], m2 = selw[q8 * 4 + 2], m3 = selw[q8 * 4 + 3];
        const int nl = list[131];
        const bf16_t* Ks = proj + (size_t)b * S * NP + C_KSEL; const bf16_t* Vs = proj + (size_t)b * S * NP + C_VSEL;
        st.m = NEG_BIG; st.l = 0.f; st.o0 = (f32x16){}; st.o1 = (f32x16){};
        stage_load<64>(sr, Ks, NP, Vs, NP, nullptr, list[0] * 64, wid0);
        stage_store<64>(sr, lds, 0, false, wid0);
        if (1 < nl) stage_load<64>(sr, Ks, NP, Vs, NP, nullptr, list[1] * 64, wid0);
        __syncthreads();
        for (int t = 0; t < nl; ++t) {
            const int buf = t & 1; const int j = list[t];
            const unsigned mw = (j < 32) ? m0 : (j < 64 ? m1 : (j < 96 ? m2 : m3));
            const bool mine = (mw >> (j & 31)) & 1u;
            if (__any(mine)) {
                f32x16 p0, p1; const int kv0 = j * 64;
                { const float base = A * (float)(kv0 + 4 * hi);
#pragma unroll
                  for (int i = 0; i < 16; ++i) { p0[i] = base + A * (float)((i & 3) + 8 * (i >> 2)); p1[i] = p0[i] + A * 32.0f; } }
                qk_tile<4>(p0, p1, lds + ATT_K0 + buf * ATT_KBUF, KSTR64, qf, r, hi);
#pragma unroll
                for (int i = 0; i < 16; ++i) { const int kv = kv0 + crow(i, hi); if (!mine || kv > tq) p0[i] = -INFINITY; if (!mine || kv + 32 > tq) p1[i] = -INFINITY; }
                { bf16x8 f0, f1, f2, f3; softmax_pack(st, p0, p1, c2, f0, f1, f2, f3); pv_frag(st.o0, st.o1, f0, f1, f2, f3, lds + ATT_V0 + buf * ATT_VBUF, vb); }
            }
            if (t + 1 < nl) stage_store<64>(sr, lds, buf ^ 1, false, wid0);
            if (t + 2 < nl) stage_load<64>(sr, Ks, NP, Vs, NP, nullptr, list[t + 2] * 64, wid0);
            __syncthreads();
        }
        const float l = swap32_sum(st.l); const float sc = l > 0.f ? g1 / l : 0.f;
#pragma unroll
        for (int i = 0; i < 16; ++i) { otl[i * 64] += st.o0[i] * sc; otl[(16 + i) * 64] += st.o1[i] * sc; }
    }
    {
        const bf16_t* Kw = proj + (size_t)b * S * NP + C_KWIN; const bf16_t* Vw = proj + (size_t)b * S * NP + C_VWIN;
        const int tw0 = (q64 >= 8) ? q64 - 8 : 0, ntw = q64 - tw0 + 1;
        st.m = NEG_BIG; st.l = 0.f; st.o0 = (f32x16){}; st.o1 = (f32x16){};
        stage_load<64>(sr, Kw, NP, Vw, NP, nullptr, tw0 * 64, wid0);
        stage_store<64>(sr, lds, 0, false, wid0);
        if (1 < ntw) stage_load<64>(sr, Kw, NP, Vw, NP, nullptr, tw0 * 64 + 64, wid0);
        __syncthreads();
        for (int t = 0; t < ntw; ++t) {
            const int buf = t & 1; const int kv0 = (tw0 + t) * 64;
            f32x16 p0, p1;
            { const float base = A * (float)(kv0 + 4 * hi);
#pragma unroll
              for (int i = 0; i < 16; ++i) { p0[i] = base + A * (float)((i & 3) + 8 * (i >> 2)); p1[i] = p0[i] + A * 32.0f; } }
            qk_tile<4>(p0, p1, lds + ATT_K0 + buf * ATT_KBUF, KSTR64, qf, r, hi);
#pragma unroll
            for (int i = 0; i < 16; ++i) { const int kv = kv0 + crow(i, hi); if (kv > tq || kv + 512 <= tq) p0[i] = -INFINITY; if (kv + 32 > tq || kv + 32 + 512 <= tq) p1[i] = -INFINITY; }
            { bf16x8 f0, f1, f2, f3; softmax_pack(st, p0, p1, c2, f0, f1, f2, f3); pv_frag(st.o0, st.o1, f0, f1, f2, f3, lds + ATT_V0 + buf * ATT_VBUF, vb); }
            if (t + 1 < ntw) stage_store<64>(sr, lds, buf ^ 1, false, wid0);
            if (t + 2 < ntw) stage_load<64>(sr, Kw, NP, Vw, NP, nullptr, kv0 + 128, wid0);
            __syncthreads();
        }
        const float l = swap32_sum(st.l); const float sc = l > 0.f ? g2 / l : 0.f;
#pragma unroll
        for (int i = 0; i < 16; ++i) { st.o0[i] = otl[i * 64] + st.o0[i] * sc; st.o1[i] = otl[(16 + i) * 64] + st.o1[i] * sc; }
    }
    store_out(ocat + rowq * D + 768 + hd * 64, st.o0, st.o1, 1.0f, hi);
}

__device__ __forceinline__ void phase_onorm(const bf16_t* ocat, const bf16_t* proj, const float* og, bf16_t* oa, int bid, int G, int wid0) {
    const int tid_ = opaque_tid(wid0); const int lane = tid_ & 63, wv = tid_ >> 6;
    for (int row = bid * 8 + wv; row < M; row += G * 8) {
        const int c = lane * 16;
        const u32x4 a0 = *(const u32x4*)(ocat + (size_t)row * D + c), a1 = *(const u32x4*)(ocat + (size_t)row * D + c + 8);
        const u32x4 z0 = *(const u32x4*)(proj + (size_t)row * NP + C_GZ + c), z1 = *(const u32x4*)(proj + (size_t)row * NP + C_GZ + c + 8);
        float v[16], z[16]; float s = 0.f;
#pragma unroll
        for (int e = 0; e < 4; ++e) { v[2 * e] = bflo(a0[e]); v[2 * e + 1] = bfhi(a0[e]); v[8 + 2 * e] = bflo(a1[e]); v[8 + 2 * e + 1] = bfhi(a1[e]);
            z[2 * e] = bflo(z0[e]); z[2 * e + 1] = bfhi(z0[e]); z[8 + 2 * e] = bflo(z1[e]); z[8 + 2 * e + 1] = bfhi(z1[e]); }
#pragma unroll
        for (int e = 0; e < 16; ++e) s += v[e] * v[e];
        s += __builtin_bit_cast(float, __builtin_amdgcn_update_dpp(0, __builtin_bit_cast(int, s), 0xB1, 0xf, 0xf, false));
        s += __builtin_bit_cast(float, __builtin_amdgcn_update_dpp(0, __builtin_bit_cast(int, s), 0x4E, 0xf, 0xf, false));
        s += __builtin_bit_cast(float, __builtin_amdgcn_update_dpp(0, __builtin_bit_cast(int, s), 0x141, 0xf, 0xf, false));
        s += __builtin_bit_cast(float, __builtin_amdgcn_update_dpp(0, __builtin_bit_cast(int, s), 0x140, 0xf, 0xf, false));
        const float rstd = 1.0f / sqrtf(s * (1.f / 256.f) + EPS);
        float y[16];
#pragma unroll
        for (int e = 0; e < 16; ++e) y[e] = v[e] * rstd * og[c + e] * silu_f(z[e]);
        u32x4 w0, w1;
#pragma unroll
        for (int e = 0; e < 4; ++e) { w0[e] = pk2(y[2 * e], y[2 * e + 1]); w1[e] = pk2(y[8 + 2 * e], y[8 + 2 * e + 1]); }
        *(u32x4*)(oa + (size_t)row * D + c) = w0; *(u32x4*)(oa + (size_t)row * D + c + 8) = w1;
    }
}
__device__ __forceinline__ void phase_final(float* out, const float* g, int bid, int G, int wid0) {
    const int tid_ = opaque_tid(wid0); const int lane = tid_ & 63, wv = tid_ >> 6;
    for (int row = bid * 8 + wv; row < M; row += G * 8) {
        f32x4* xr = (f32x4*)(out + (size_t)row * D) + lane;
        f32x4 v[4]; float s = 0.f;
#pragma unroll
        for (int j = 0; j < 4; ++j) { v[j] = xr[64 * j]; s += (v[j][0] * v[j][0] + v[j][1] * v[j][1]) + (v[j][2] * v[j][2] + v[j][3] * v[j][3]); }
        const float rstd = 1.0f / sqrtf(wave_sum(s) * (1.f / D) + EPS);
#pragma unroll
        for (int j = 0; j < 4; ++j) { const f32x4 gg = *(const f32x4*)(g + (64 * j + lane) * 4); xr[64 * j] = v[j] * rstd * gg; }
    }
}

#define XB_TMO      128
#define XB_XCNT(j)  (256  + 64 * (j))
#define XB_XSUB(j)  (1280 + 64 * (j))
#define XB_XGEN(j)  (2304 + 64 * (j))
#define XB_TOP      3328
#define XB_TOPGEN   3392
#define XCD_BAR_WORDS 3456
#define XB_SPIN_CAP (1u << 22)
__device__ __forceinline__ unsigned xb_ld(unsigned* p)              { return __hip_atomic_load(p, __ATOMIC_RELAXED, __HIP_MEMORY_SCOPE_AGENT); }
__device__ __forceinline__ unsigned xb_add(unsigned* p, unsigned v) { return __hip_atomic_fetch_add(p, v, __ATOMIC_RELAXED, __HIP_MEMORY_SCOPE_AGENT); }
__device__ __forceinline__ unsigned xb_xcc_id() { return (unsigned)__builtin_amdgcn_s_getreg((3 << 11) | 20) & 0xFu; }
#define XB_SPIN(cond, bar) do { unsigned _sp = 0; while (cond) { __builtin_amdgcn_s_sleep(1); \
    if ((++_sp & 255u) == 0u) { if (xb_ld(&(bar)[XB_TMO])) break; if (_sp > XB_SPIN_CAP) { atomicAdd(&(bar)[XB_TMO], 1u); break; } } } } while (0)
__device__ __forceinline__ void xcd_barrier_complete(unsigned* bar, unsigned x, unsigned G, unsigned& nloc, unsigned& nx) {
    unsigned sum, cnt, mine, sp = 0u;
    for (;;) {
        sum = 0u; cnt = 0u; mine = 0u;
#pragma unroll
        for (unsigned j = 0; j < 16; ++j) { const unsigned c = xb_ld(&bar[XB_XCNT(j)]); sum += c; cnt += (c > 0u) ? 1u : 0u; mine = (j == x) ? c : mine; }
        if (sum == G) break;
        __builtin_amdgcn_s_sleep(1);
        if ((++sp & 255u) == 0u) { if (xb_ld(&bar[XB_TMO])) break; if (sp > XB_SPIN_CAP) { atomicAdd(&bar[XB_TMO], 1u); break; } }
    }
    nloc = mine > 0u ? mine : 1u; nx = cnt > 0u ? cnt : 1u;
}
__device__ __forceinline__ void grid_bar(unsigned* bar, volatile LAS unsigned* st, unsigned G, int wid0) {
    const int tid = opaque_tid(wid0);
    asm volatile("s_waitcnt vmcnt(0)" ::: "memory");
    __syncthreads();
    if (tid == 0) {
        const unsigned x = xb_xcc_id();
        unsigned nloc = st[0], nx = st[1];
        if (nloc == 0u) { xcd_barrier_complete(bar, x, G, nloc, nx); st[0] = nloc; st[1] = nx; }
        const unsigned old = xb_add(&bar[XB_XSUB(x)], 1u);
        const unsigned gen = old / nloc;
        if (old + 1u == (gen + 1u) * nloc) {
            __builtin_amdgcn_fence(__ATOMIC_RELEASE, "agent");
            asm volatile("s_waitcnt vmcnt(0)" ::: "memory");
            const unsigned og = xb_add(&bar[XB_TOP], 1u);
            const unsigned tg = og / nx;
            if (og + 1u == (tg + 1u) * nx) xb_add(&bar[XB_TOPGEN], 1u);
            else XB_SPIN(xb_ld(&bar[XB_TOPGEN]) == tg, bar);
            __builtin_amdgcn_fence(__ATOMIC_ACQUIRE, "agent");
            xb_add(&bar[XB_XGEN(x)], 1u);
            asm volatile("s_waitcnt vmcnt(0)" ::: "memory");
        } else {
            XB_SPIN(xb_ld(&bar[XB_XGEN(x)]) == gen, bar);
            __builtin_amdgcn_fence(__ATOMIC_ACQUIRE, "agent");
            asm volatile("s_waitcnt vmcnt(0)" ::: "memory");
        }
    }
    __syncthreads();
}

constexpr int N_PHASES = 16;
__global__ void __launch_bounds__(NTHREADS) hymba_fwd(Params P) {
    extern __shared__ __attribute__((aligned(16))) unsigned char lds_raw[];
    LAS unsigned char* lds = (LAS unsigned char*)lds_raw;
    const int bid = blockIdx.x, G = gridDim.x;
    const int wid0 = __builtin_amdgcn_readfirstlane((int)(threadIdx.x >> 6));
    volatile LAS unsigned* xst = (volatile LAS unsigned*)(lds + LDS_BYTES - 16);
    unsigned* xbar = (unsigned*)(P.ws + WS_CTL) + 4096 + P.bar_region * XCD_BAR_WORDS;
    if (threadIdx.x == 0) { xst[0] = 0u; xst[1] = 0u; (void)xb_add(&xbar[XB_XCNT(xb_xcc_id())], 1u); }
    __syncthreads();
    unsigned char* ws = P.ws;
    bf16_t* proj = (bf16_t*)(ws + WS_PROJ); float* side = (float*)(ws + WS_SIDE);
    bf16_t* hbuf = (bf16_t*)(ws + WS_H); bf16_t* ocat = (bf16_t*)(ws + WS_OCAT);
#define PH(k) (P.ph_lo <= (k) && (k) < P.ph_hi)
#define SYNC(k) do { if (PH(k) && PH((k) + 1)) grid_bar(xbar, xst, (unsigned)G, wid0); } while (0)
    if (PH(0)) phase_prologue(P, lds, bid, G, wid0);
    if (PH(0) && PH(1)) cg::this_grid().sync();
#ifndef ATT_REP
#define ATT_REP 0
#endif
#ifndef PROBE_VAR
#define PROBE_VAR -1
#endif
#define LAYER(l, base) do { \
    const float* mod = (const float*)(ws + WS_MOD) + (size_t)(l) * 4 * 3072; \
    const float* xin = ((l) == 0) ? P.in[0] : P.out; \
    if (PH((base) + 0)) phase_hnorm(xin, P.in[2] + (l) * D, mod, hbuf, bid, G, wid0); \
    SYNC((base) + 0); \
    if (PH((base) + 1)) { pg8::Gemm g{hbuf, (const bf16_t*)(ws + WS_WIN) + (size_t)(l) * NP * D, M, NP, D, D, D}; pg8::StaticOrder so; so.init(M, NP, G, bid); \
        pg8::EpiProj E{proj, side}; pg8::gemm_phase<pg8::EpiProj, true>(lds, g, so, E, wid0); } \
    SYNC((base) + 1); \
    if (PH((base) + 2)) phase_prep(P, (l), lds, bid, G, wid0); \
    SYNC((base) + 2); \
    if (PH((base) + 3)) { \
        { pg8::Gemm g{proj + C_QLAT, (const bf16_t*)(ws + WS_WUQ) + (size_t)(l) * 512 * 256, M, 512, 256, NP, 256}; pg8::StaticOrder so; so.init(M, 512, G, bid); \
          pg8::EpiQup E{(bf16_t*)(ws + WS_QMLA), (const float*)(ws + WS_RSTD), (const float*)(ws + WS_ROPE)}; pg8::gemm_phase<pg8::EpiQup, true>(lds, g, so, E, wid0); } \
        { pg8::Gemm g{proj + C_KVLAT, (const bf16_t*)(ws + WS_WUKV) + (size_t)(l) * 512 * 128, M, 512, 128, NP, 128}; pg8::StaticOrder so; so.init(M, 512, G, bid); \
          pg8::EpiKVup E{(bf16_t*)(ws + WS_KMLA), (bf16_t*)(ws + WS_VMLA), (const float*)(ws + WS_RSTD)}; pg8::gemm_phase<pg8::EpiKVup, true>(lds, g, so, E, wid0); } \
        for (int k = 0; k * G < 1024; ++k) { const int u = (k & 1) ? (k + 1) * G - 1 - bid : k * G + bid; if (u >= 1024 || u < 0) continue; const int qg = 255 - (u >> 2), b = u & 3; \
            dsa_index_unit(lds, proj, (const bf16_t*)(ws + WS_KIDX), side, (unsigned long long*)(ws + WS_MASK) + (size_t)b * S * 128, b, qg, wid0); } } \
    SYNC((base) + 3); \
    if (PH((base) + 4)) { const int vb_ = (G % 8 == 0) ? (bid & 7) * (G >> 3) + (bid >> 3) : bid;     \
        for (int i = vb_; i < 512; i += G) { const int ii = i & 255, bh = ii >> 4, qb = (i < 256) ? (ii & 15) : 31 - (ii & 15), b = bh >> 2, hd = bh & 3; const size_t rb = (size_t)b * S; \
            dense_unit<96, 0>(lds, (const bf16_t*)(ws + WS_QMLA) + rb * 384 + hd * 96, 384, (const bf16_t*)(ws + WS_KMLA) + rb * 384 + hd * 96, 384, \
                              (const bf16_t*)(ws + WS_VMLA) + rb * 256 + hd * 64, 256, ocat + rb * D + hd * 64, nullptr, nullptr, 0.f, 0.10206207261596577f * LOG2E, qb, wid0); } \
        for (int rep = 0; rep < (((ATT_REP & 2) && (l) == 0) ? 2 : 1); ++rep) for (int i = vb_; i < 512; i += G) { const int ii = i & 255, bh = ii >> 4, qb = (i < 256) ? (ii & 15) : 31 - (ii & 15), b = bh >> 2, hd = bh & 3; const size_t rb = (size_t)b * S; \
            dense_unit<64, 1>(lds, proj + rb * NP + C_FQ + hd * 64, NP, proj + rb * NP + C_FK + hd * 64, NP, proj + rb * NP + C_FV + hd * 64, NP, \
                              ocat + rb * D + 256 + hd * 64, (const float*)(ws + WS_FB) + (size_t)bh * S, nullptr, 0.f, 0.125f * LOG2E, qb, wid0); } \
        for (int rep = 0; rep < (((ATT_REP & 4) && (l) == 0) ? 2 : 1); ++rep) for (int i = vb_; i < 512; i += G) { const int ii = i & 255, bh = ii >> 4, qb = (i < 256) ? (ii & 15) : 31 - (ii & 15), b = bh >> 2, hd = bh & 3; const size_t rb = (size_t)b * S; \
            const float slope = (hd == 0) ? 0.25f : (hd == 1 ? 0.0625f : (hd == 2 ? 0.015625f : 0.00390625f)); \
            dense_unit<64, 2>(lds, proj + rb * NP + C_DQ + hd * 64, NP, proj + rb * NP + C_DK + hd * 64, NP, proj + rb * NP + C_DV + hd * 64, NP, \
                              ocat + rb * D + 512 + hd * 64, nullptr, (const unsigned long long*)(ws + WS_MASK) + rb * 128, 8.0f * slope, 0.125f * LOG2E, qb, wid0); } \
        for (int rep = 0; rep < (((ATT_REP & 8) && (l) == 0) ? 2 : 1); ++rep) for (int u = vb_; u < 512; u += G) { const int b = u >> 7, q64 = u & 127; \
            nsa_unit(lds, proj, side, (const bf16_t*)(ws + WS_KC), (const bf16_t*)(ws + WS_VC), ocat, b, q64, wid0); } } \
    SYNC((base) + 4); \
    if (PH((base) + 5)) phase_onorm(ocat, proj, P.in[14] + (l) * D, hbuf, bid, G, wid0); \
    SYNC((base) + 5); \
    if (PH((base) + 6)) { pg8::Gemm g{hbuf, (const bf16_t*)(ws + WS_WOUT) + (size_t)(l) * D * D, M, D, D, D, D}; pg8::StaticOrder so; so.init(M, D, G, bid); \
        pg8::EpiOut E{xin, P.out, mod + 2048}; pg8::gemm_phase<pg8::EpiOut, true>(lds, g, so, E, wid0); } \
    SYNC((base) + 6); \
} while (0)
    LAYER(0, 1);
    LAYER(1, 8);
    if (PH(15)) phase_final(P.out, P.in[16], bid, G, wid0);
#undef LAYER
#undef PH
#undef SYNC
}


#ifdef DBG_GROUP
#ifndef DBG_LAYER
#define DBG_LAYER 1
#endif
__device__ __forceinline__ float dbg_bf(const bf16_t* p) { return bf2f(*p); }
__device__ const int dbg_rows[48] = {0, 1, 2, 15, 30, 31, 32, 47, 63, 64, 65, 127, 128, 200, 255, 256, 257, 300, 511, 512, 513, 700, 1000, 1023, 1024, 1025, 1500, 2047, 2048, 3000, 3333, 4095, 4096, 4500, 5000, 5555, 6143, 6144, 7000, 7777, 8000, 8100, 8127, 8128, 8160, 8190, 8191, 4242};
template <class ScoreFn, class VFn>
__device__ __forceinline__ float dbg_attn(int k_lo, int k_hi, ScoreFn score, VFn vload, int lane) {
    float m = -INFINITY, l = 0.f, acc = 0.f;
    for (int kv = k_lo; kv <= k_hi; ++kv) {
        const float sc = score(kv);
        if (sc == -INFINITY) continue;
        const float mn = fmaxf(m, sc); const float al = (m == -INFINITY) ? 0.f : __expf(m - mn); const float p = __expf(sc - mn);
        l = l * al + p; acc = acc * al + p * vload(kv, lane); m = mn;
    }
    return l > 0.f ? acc / l : 0.f;
}
__global__ void __launch_bounds__(64) dbg_check(Params P) {
    const int lane = threadIdx.x, wid = blockIdx.x; const int hd = wid & 3, ri = (wid >> 2) % 48, b = (wid >> 2) / 48; const int t = dbg_rows[ri];
    unsigned char* ws = P.ws; const bf16_t* proj = (const bf16_t*)(ws + WS_PROJ); const float* side = (const float*)(ws + WS_SIDE);
    const bf16_t* ocat = (const bf16_t*)(ws + WS_OCAT); const size_t rowq = (size_t)b * S + t; const size_t rb = (size_t)b * S;
    float* scratch = (float*)(ws + WS_H) + (size_t)wid * 16384;
    float ref = 0.f; int grp = DBG_GROUP % 10;
    const float slope = (hd == 0) ? 0.25f : (hd == 1 ? 0.0625f : (hd == 2 ? 0.015625f : 0.00390625f));
    if (grp == 0) {
        const bf16_t* q = (const bf16_t*)(ws + WS_QMLA) + rowq * 384 + hd * 96; const bf16_t* K = (const bf16_t*)(ws + WS_KMLA) + rb * 384 + hd * 96; const bf16_t* V = (const bf16_t*)(ws + WS_VMLA) + rb * 256 + hd * 64;
        const float q0 = dbg_bf(q + lane), q1 = lane < 32 ? dbg_bf(q + 64 + lane) : 0.f;
        ref = dbg_attn(0, t, [&](int kv) { float pr = q0 * dbg_bf(K + (size_t)kv * 384 + lane) + (lane < 32 ? q1 * dbg_bf(K + (size_t)kv * 384 + 64 + lane) : 0.f); return wave_sum(pr) * 0.10206207261596577f; },
                       [&](int kv, int d) { return dbg_bf(V + (size_t)kv * 256 + d); }, lane);
    } else if (grp == 1) {
        const bf16_t* q = proj + rowq * NP + C_FQ + hd * 64; const bf16_t* K = proj + rb * NP + C_FK + hd * 64; const bf16_t* V = proj + rb * NP + C_FV + hd * 64; const float* fb = (const float*)(ws + WS_FB) + (size_t)(b * 4 + hd) * S;
        const float q0 = dbg_bf(q + lane); const float ft = fb[t];
        ref = dbg_attn(0, t, [&](int kv) { return wave_sum(q0 * dbg_bf(K + (size_t)kv * NP + lane)) * 0.125f + (fb[kv] - ft) * 0.125f; },
                       [&](int kv, int d) { return dbg_bf(V + (size_t)kv * NP + d); }, lane);
    } else if (grp == 2) {
        float* sc = scratch; unsigned char* selb = (unsigned char*)(scratch + 8192);
        const int ih = lane >> 4, dd = (lane & 15) * 2;
        const float qa = dbg_bf(proj + rowq * NP + C_IQ + ih * 32 + dd), qb2 = dbg_bf(proj + rowq * NP + C_IQ + ih * 32 + dd + 1); const float wgt = side[rowq * 32 + 4 + ih] * 0.5f;
        for (int kv = 0; kv <= t; ++kv) { float pr = qa * dbg_bf(proj + (rb + kv) * NP + C_IK + dd) + qb2 * dbg_bf(proj + (rb + kv) * NP + C_IK + dd + 1);
            pr += __shfl_xor(pr, 1); pr += __shfl_xor(pr, 2); pr += __shfl_xor(pr, 4); pr += __shfl_xor(pr, 8);
            float v = wgt * fmaxf(pr, 0.f); v += __shfl_xor(v, 16); v += __shfl_xor(v, 32); if (lane == 0) sc[kv] = v; }
        __threadfence_block();
        if (t + 1 <= 256) { for (int kv = lane; kv <= t; kv += 64) selb[kv] = 1; }
        else {
#ifdef DBG_KEY32
#define DBGKEY(x) ({ const unsigned u_ = __float_as_uint(x); (u_ & 0x80000000u) ? ~u_ : (u_ | 0x80000000u); })
            unsigned lo = 0, hi2 = 0xffffffffu;
#else
#define DBGKEY(x) score_key16(x)
            unsigned lo = 0, hi2 = 0xffffu;
#endif
            while (lo < hi2) { const unsigned mid = lo + ((hi2 - lo) >> 1) + ((hi2 - lo) & 1u); int c = 0; for (int kv = lane; kv <= t; kv += 64) c += (DBGKEY(sc[kv]) >= mid); c = (int)wave_sum((float)c); if (c >= 256) lo = mid; else hi2 = mid - 1; }
            const unsigned T = lo; int cgt = 0; for (int kv = lane; kv <= t; kv += 64) cgt += (DBGKEY(sc[kv]) > T); cgt = (int)wave_sum((float)cgt);
            int need = 256 - cgt; int run = 0;
            for (int k0 = 0; k0 <= t; k0 += 64) { const int kv = k0 + lane; const unsigned k = kv <= t ? DBGKEY(sc[kv]) : 0u; const bool eq = kv <= t && k == T, gt = kv <= t && k > T;
                const unsigned long long bm = __ballot(eq); const int before = __popcll(bm & ((1ull << lane) - 1ull));
                if (kv <= t) selb[kv] = (gt || (eq && run + before < need)) ? 1 : 0; run += __popcll(bm); }
        }
        __threadfence_block();
        const bf16_t* q = proj + rowq * NP + C_DQ + hd * 64; const bf16_t* K = proj + rb * NP + C_DK + hd * 64; const bf16_t* V = proj + rb * NP + C_DV + hd * 64; const float q0 = dbg_bf(q + lane);
        ref = dbg_attn(0, t, [&](int kv) { if (!selb[kv]) return -INFINITY; return wave_sum(q0 * dbg_bf(K + (size_t)kv * NP + lane)) * 0.125f - slope * (float)(t - kv); },
                       [&](int kv, int d) { return dbg_bf(V + (size_t)kv * NP + d); }, lane);
    } else {
        const int sub = DBG_GROUP / 10;
        const bf16_t* q = proj + rowq * NP + C_NQ; const float q0 = dbg_bf(q + hd * 64 + lane);
        const bf16_t* kc = (const bf16_t*)(ws + WS_KC) + (size_t)b * 512 * 64; const bf16_t* vc = (const bf16_t*)(ws + WS_VC) + (size_t)b * 512 * 64;
        float* pc = scratch;
        for (int h2 = 0; h2 < 4; ++h2) { const float qh = dbg_bf(q + h2 * 64 + lane); const float sl = (h2 == 0) ? 0.25f : (h2 == 1 ? 0.0625f : (h2 == 2 ? 0.015625f : 0.00390625f));
            float m = -INFINITY; for (int n = 0; n < 511; ++n) { if (16 * n + 31 > t) break; const float s_ = wave_sum(qh * dbg_bf(kc + n * 64 + lane)) * 0.125f - sl * (float)(t - (16 * n + 31)); if (lane == 0) pc[h2 * 512 + n] = s_; m = fmaxf(m, s_); }
            __threadfence_block(); float l = 0.f; for (int n = 0; n < 511 && 16 * n + 31 <= t; ++n) l += __expf(pc[h2 * 512 + n] - m);
            __threadfence_block(); for (int n = lane; n < 511; n += 64) pc[h2 * 512 + n] = (16 * n + 31 <= t) ? __expf(pc[h2 * 512 + n] - m) / l : 0.f; __threadfence_block(); }
        float oc = 0.f; for (int n = 0; n < 511 && 16 * n + 31 <= t; ++n) oc += pc[hd * 512 + n] * dbg_bf(vc + n * 64 + lane);
        const int cur = t >> 6; float v0, v1;
        { float i0 = 0.f, i1 = 0.f; for (int h2 = 0; h2 < 4; ++h2) for (int e = -1; e <= 3; ++e) { int n0 = 4 * lane + e, n1 = 4 * (lane + 64) + e; if (n0 >= 0 && n0 < 511) i0 += pc[h2 * 512 + n0]; if (n1 < 511) i1 += pc[h2 * 512 + n1]; }
          v0 = (lane == 0 || lane == cur) ? INFINITY : (lane > cur ? -INFINITY : i0); v1 = (lane + 64 == cur) ? INFINITY : (lane + 64 > cur ? -INFINITY : i1); }
        unsigned long long slo = 0, shi = 0;
        for (int it = 0; it < 16; ++it) { float mx = fmaxf(v0, v1); for (int o = 1; o < 64; o <<= 1) mx = fmaxf(mx, __shfl_xor(mx, o)); if (!(mx > -INFINITY)) break;
            const unsigned long long b0 = __ballot(v0 == mx), b1 = __ballot(v1 == mx);
            if (b0) { const int j = __ffsll((long long)b0) - 1; slo |= 1ull << j; if (lane == j) v0 = -INFINITY; } else { const int j = __ffsll((long long)b1) - 1; shi |= 1ull << j; if (lane == j) v1 = -INFINITY; } }
        const bf16_t* Ks = proj + rb * NP + C_KSEL; const bf16_t* Vs = proj + rb * NP + C_VSEL; const bf16_t* Kw = proj + rb * NP + C_KWIN; const bf16_t* Vw = proj + rb * NP + C_VWIN;
        const float os = dbg_attn(0, t, [&](int kv) { const int j = kv >> 6; const bool in = j < 64 ? ((slo >> j) & 1ull) : ((shi >> (j - 64)) & 1ull); if (!in) return -INFINITY;
                                      return wave_sum(q0 * dbg_bf(Ks + (size_t)kv * NP + lane)) * 0.125f - slope * (float)(t - kv); }, [&](int kv, int d) { return dbg_bf(Vs + (size_t)kv * NP + d); }, lane);
        const float ow = dbg_attn(t - 511 > 0 ? t - 511 : 0, t, [&](int kv) { return wave_sum(q0 * dbg_bf(Kw + (size_t)kv * NP + lane)) * 0.125f - slope * (float)(t - kv); }, [&](int kv, int d) { return dbg_bf(Vw + (size_t)kv * NP + d); }, lane);
        const float g0 = sigmoid_f(side[rowq * 32 + 8 + hd * 3]), g1 = sigmoid_f(side[rowq * 32 + 8 + hd * 3 + 1]), g2 = sigmoid_f(side[rowq * 32 + 8 + hd * 3 + 2]);
        ref = g0 * oc + g1 * os + g2 * ow;
        (void)sub;
    }
    const float got = dbg_bf(ocat + rowq * D + grp * 256 + hd * 64 + lane);
    const float d2 = wave_sum((got - ref) * (got - ref)), r2 = wave_sum(ref * ref);
    float* acc = (float*)(ws + WS_CTL + 8192);
    if (lane == 0) { atomicAdd(acc, d2); atomicAdd(acc + 1, r2); }
}

__device__ __forceinline__ void dbg_sincos(double ang, float& cs, float& sn) {
    const double twopi = 6.283185307179586476925; double r = ang - twopi * __builtin_floor(ang / twopi + 0.5);
    const double r2 = r * r; double sterm = r, cterm = 1.0, ssum = r, csum = 1.0;
    for (int k = 1; k <= 14; ++k) { cterm *= -r2 / (double)((2 * k - 1) * (2 * k)); sterm *= -r2 / (double)((2 * k) * (2 * k + 1)); csum += cterm; ssum += sterm; }
    cs = (float)csum; sn = (float)ssum;
}
__device__ __forceinline__ int dbg_mapwin(int n) { return MapWin{}(n); }
#define DBG_ACC(got, ref) do { const float g_ = (got), r_ = (ref); d2 += (g_ - r_) * (g_ - r_); r2 += r_ * r_; } while (0)
__global__ void __launch_bounds__(64) dbg_check2(Params P) {
    const int lane = threadIdx.x, wid = blockIdx.x; const int ri = wid % 48, b = wid / 48; const int t = dbg_rows[ri];
    unsigned char* ws = P.ws; const bf16_t* proj = (const bf16_t*)(ws + WS_PROJ); const float* side = (const float*)(ws + WS_SIDE);
    const size_t rowq = (size_t)b * S + t; const int l = DBG_LAYER;
    float d2 = 0.f, r2 = 0.f;
    const int grp = DBG_GROUP;
    if (grp == 4) {
        if (wid < 16 && lane == 0) { const int hd = wid & 3, bb = wid >> 2; double run = 0.0; const float* fb = (const float*)(ws + WS_FB) + (size_t)wid * S; const float bf = P.in[10][l * 4 + hd];
            for (int tt = 0; tt < S; ++tt) { const double v = (double)side[((size_t)bb * S + tt) * 32 + hd] + (double)bf; const double y = (v < 0 ? v : 0.0) - log1p(exp(-fabs(v))); run += y; DBG_ACC(fb[tt], (float)(-8.0 * run)); } }
    } else if (grp == 5) {
        float ss = 0.f; for (int k = lane; k < 192; k += 64) { const float v = dbg_bf(proj + rowq * NP + k); ss += v * v; } ss = wave_sum(ss); const float rs = 1.0f / sqrtf(ss / 192.f + EPS);
        const float* wq = P.in[7] + (size_t)l * 192 * 384; const float* gq = P.in[6] + l * 192; const bf16_t* qm = (const bf16_t*)(ws + WS_QMLA) + rowq * 384;
        for (int o = lane; o < 384; o += 64) { float a = 0.f; for (int k = 0; k < 192; ++k) a += dbg_bf(proj + rowq * NP + k) * rs * gq[k] * wq[(size_t)k * 384 + o]; ((float*)(ws + WS_H))[(size_t)wid * 512 + o] = a; }
        __threadfence_block();
        const float* qv = (const float*)(ws + WS_H) + (size_t)wid * 512;
        for (int hd = 0; hd < 4; ++hd) { { const int w = lane; DBG_ACC(dbg_bf(qm + hd * 96 + w), qv[hd * 96 + w]); }
            if (lane < 16) { const int i = lane; const float invf = (float)pow(10000.0, -(double)i / 16.0); float cs, sn; dbg_sincos((double)((float)t * invf), cs, sn);
                const float x1 = qv[hd * 96 + 64 + i], x2 = qv[hd * 96 + 80 + i]; DBG_ACC(dbg_bf(qm + hd * 96 + 64 + 2 * i), x1 * cs - x2 * sn); DBG_ACC(dbg_bf(qm + hd * 96 + 64 + 2 * i + 1), x1 * sn + x2 * cs); } }
    } else if (grp == 6) {
        float ss = 0.f; for (int k = lane; k < 128; k += 64) { const float v = dbg_bf(proj + rowq * NP + C_KVLAT + k); ss += v * v; } ss = wave_sum(ss); const float rs = 1.0f / sqrtf(ss / 128.f + EPS);
        const float* wk = P.in[9] + (size_t)l * 128 * 512; const float* gk = P.in[8] + l * 128; const bf16_t* km = (const bf16_t*)(ws + WS_KMLA) + rowq * 384; const bf16_t* vm = (const bf16_t*)(ws + WS_VMLA) + rowq * 256;
        for (int o = lane; o < 512; o += 64) { float a = 0.f; for (int k = 0; k < 128; ++k) a += dbg_bf(proj + rowq * NP + C_KVLAT + k) * rs * gk[k] * wk[(size_t)k * 512 + o];
            const int hd = o >> 7, w = o & 127; if (w < 64) DBG_ACC(dbg_bf(km + hd * 96 + w), a); else DBG_ACC(dbg_bf(vm + hd * 64 + w - 64), a); }
        if (lane < 16) { const int i = lane; const float invf = (float)pow(10000.0, -(double)i / 16.0); float cs, sn; dbg_sincos((double)((float)t * invf), cs, sn);
            const float x1 = dbg_bf(proj + rowq * NP + C_KROPE + i), x2 = dbg_bf(proj + rowq * NP + C_KROPE + 16 + i);
            for (int hd = 0; hd < 4; ++hd) { DBG_ACC(dbg_bf(km + hd * 96 + 64 + 2 * i), x1 * cs - x2 * sn); DBG_ACC(dbg_bf(km + hd * 96 + 64 + 2 * i + 1), x1 * sn + x2 * cs); } }
    } else if (grp == 7) {
        const int n = (t >> 4) > 510 ? 510 : (t >> 4);
        for (int kv = 0; kv < 2; ++kv) { const float* w1 = P.in[12] + (size_t)(l * 2 + kv) * 2048 * 64; const float* w2 = P.in[13] + (size_t)(l * 2 + kv) * 64 * 64; const float* pe = P.in[11] + (size_t)(l * 2 + kv) * 2048;
            float a = 0.f; for (int k = 0; k < 2048; ++k) { const int j = k >> 6, d = k & 63; a += (dbg_bf(proj + ((size_t)b * S + 16 * n + j) * NP + (kv ? C_VCMP : C_KCMP) + d) + pe[k]) * w1[(size_t)k * 64 + lane]; }
            const float hv = silu_f(a); float o = 0.f; for (int k = 0; k < 64; ++k) o += __shfl(hv, k) * w2[k * 64 + lane];
            DBG_ACC(dbg_bf((const bf16_t*)(ws + (kv ? WS_VC : WS_KC)) + ((size_t)b * 512 + n) * 64 + lane), o); }
    } else if (grp == 8) {
        const float* c = P.in[1]; const float* mod = (const float*)(ws + WS_MOD);
        for (int idx = wid * 64 + lane; idx < 2 * 4 * 3072; idx += gridDim.x * 64) { const int ll = idx / (4 * 3072), bb = (idx / 3072) & 3, n = idx % 3072; float a = P.in[4][ll * 3072 + n];
            for (int k = 0; k < 1024; ++k) a += silu_f(c[bb * 1024 + k]) * P.in[3][((size_t)ll * 1024 + k) * 3072 + n]; DBG_ACC(mod[idx], a); }
    } else if (grp == 9) {
        const float* x = P.in[0] + rowq * D; const float* mod = (const float*)(ws + WS_MOD) + (size_t)(l * 4 + b) * 3072; float* hrow = (float*)(ws + WS_H) + (size_t)wid * 1024;
        float ss = 0.f; for (int k = lane; k < D; k += 64) ss += x[k] * x[k]; ss = wave_sum(ss); const float rs = 1.0f / sqrtf(ss / D + EPS);
        for (int k = lane; k < D; k += 64) hrow[k] = x[k] * rs * P.in[2][l * D + k] * (1.0f + mod[1024 + k]) + mod[k];
        __threadfence_block();
        const float* w = P.in[5] + (size_t)l * D * 3732;
        for (int n = lane; n < 3732; n += 64) { const int oc = dbg_mapwin(n); float a = 0.f; for (int k = 0; k < D; ++k) a += hrow[k] * w[(size_t)k * 3732 + oc];
            DBG_ACC(dbg_bf(proj + rowq * NP + n), a); if (n >= C_SIDE) DBG_ACC(side[rowq * 32 + n - C_SIDE], a); }
    } else if (grp == 10) {
        const bf16_t* oc = (const bf16_t*)(ws + WS_OCAT) + rowq * D; const bf16_t* oa = (const bf16_t*)(ws + WS_H) + rowq * D;
        for (int g = 0; g < 4; ++g) { float ss = 0.f; for (int k = lane; k < 256; k += 64) { const float v = dbg_bf(oc + g * 256 + k); ss += v * v; } ss = wave_sum(ss); const float rs = 1.0f / sqrtf(ss / 256.f + EPS);
            for (int k = lane; k < 256; k += 64) { const int cc = g * 256 + k; DBG_ACC(dbg_bf(oa + cc), dbg_bf(oc + cc) * rs * P.in[14][l * D + cc] * silu_f(dbg_bf(proj + rowq * NP + C_GZ + cc))); } }
    } else if (grp == 11) {
        const bf16_t* oa = (const bf16_t*)(ws + WS_H) + rowq * D; const float* mod = (const float*)(ws + WS_MOD) + (size_t)(l * 4 + b) * 3072; const float* w = P.in[15] + (size_t)l * D * D;
        for (int n = lane; n < D; n += 64) { float a = 0.f; for (int k = 0; k < D; ++k) a += dbg_bf(oa + k) * w[(size_t)k * D + n]; DBG_ACC(P.out[rowq * D + n], P.in[0][rowq * D + n] + mod[2048 + n] * a); }
    }
    d2 = wave_sum(d2); r2 = wave_sum(r2);
    float* acc = (float*)(ws + WS_CTL + 8192);
    if (lane == 0) { atomicAdd(acc, d2); atomicAdd(acc + 1, r2); }
}
__global__ void dbg_scale(Params P) {
    const float* acc = (const float*)(P.ws + WS_CTL + 8192);
    float v = sqrtf(acc[0] / fmaxf(acc[1], 1e-30f)); v = fminf(fmaxf(v, 1e-4f), 1.0f);
    const float code = 0.1f * powf(100.0f, (log10f(v) + 4.0f) * 0.25f); const float delta = sqrtf(code);
    for (size_t i = (size_t)blockIdx.x * blockDim.x + threadIdx.x; i < (size_t)M * D; i += (size_t)gridDim.x * blockDim.x) P.out[i] *= (1.0f + delta);
}
#endif

#ifndef N_CUTS
#define N_CUTS 1
#endif
extern "C" void kernel_launch(void* const* d_in, const int* in_sizes, int n_in, void* d_out, int out_size, void* d_ws, size_t ws_size, hipStream_t stream) {
    static int grid = 0;
    if (grid == 0) {
        if (n_in != 17 || out_size != M * D || ws_size < WS_END) { fprintf(stderr, "kernel_launch: unexpected problem (n_in %d out %d ws %zu need %zu)\n", n_in, out_size, ws_size, (size_t)WS_END); grid = -1; return; }
        int dev = 0, cus = 0, per_cu = 0;
        hipGetDevice(&dev); hipDeviceGetAttribute(&cus, hipDeviceAttributeMultiprocessorCount, dev);
        hipFuncSetAttribute((const void*)hymba_fwd, hipFuncAttributeMaxDynamicSharedMemorySize, LDS_BYTES);
        hipOccupancyMaxActiveBlocksPerMultiprocessor(&per_cu, (const void*)hymba_fwd, NTHREADS, LDS_BYTES);
        if (per_cu < 1) { fprintf(stderr, "kernel_launch: occupancy query says %d blocks/CU\n", per_cu); grid = -1; return; }
        grid = cus;
    }
    if (grid < 0) return;
    (void)hipMemsetAsync((char*)d_ws + WS_CTL, 0, 131072, stream);
    Params p{};
    for (int i = 0; i < 17; ++i) p.in[i] = (const float*)d_in[i];
    p.out = (float*)d_out; p.ws = (unsigned char*)d_ws;
#if defined(DBG_GROUP)
    auto run = [&](int lo, int hi) { p.ph_lo = lo; p.ph_hi = hi; p.bar_region = (lo == 0) ? 0 : 1; void* args[] = {&p};
        hipError_t e = hipLaunchCooperativeKernel((const void*)hymba_fwd, dim3(grid), dim3(NTHREADS), args, LDS_BYTES, stream);
        if (e != hipSuccess) fprintf(stderr, "cooperative launch failed: %s (grid %d)\n", hipGetErrorString(e), grid); };
    auto check = [&]() { if (DBG_GROUP % 10 >= 4 || (DBG_GROUP >= 10 && DBG_GROUP < 13)) hipLaunchKernelGGL(dbg_check2, dim3(4 * 48), dim3(64), 0, stream, p);
                         else hipLaunchKernelGGL(dbg_check, dim3(4 * 48 * 4), dim3(64), 0, stream, p); };
    if (DBG_LAYER == 0) { run(0, 8); check(); run(8, 16); } else { run(0, 16); check(); }
    hipLaunchKernelGGL(dbg_scale, dim3(1024), dim3(256), 0, stream, p);
#elif defined(REPEAT_PHASE)
    { const int bounds[3][2] = {{0, REPEAT_PHASE + 1}, {REPEAT_PHASE, N_PHASES}, {0, 0}};
      for (int c = 0; c < 2; ++c) { p.ph_lo = bounds[c][0]; p.ph_hi = bounds[c][1]; p.bar_region = c; void* args[] = {&p};
        hipError_t e = hipLaunchCooperativeKernel((const void*)hymba_fwd, dim3(grid), dim3(NTHREADS), args, LDS_BYTES, stream);
        if (e != hipSuccess) { fprintf(stderr, "cooperative launch failed: %s (grid %d)\n", hipGetErrorString(e), grid); return; } } }
#else
    const int cuts = N_CUTS;
    for (int c = 0; c < cuts; ++c) {
        p.ph_lo = (N_PHASES * c) / cuts; p.ph_hi = (N_PHASES * (c + 1)) / cuts; p.bar_region = c;
        void* args[] = {&p};
        hipError_t e = hipLaunchCooperativeKernel((const void*)hymba_fwd, dim3(grid), dim3(NTHREADS), args, LDS_BYTES, stream);
        if (e != hipSuccess) { fprintf(stderr, "cooperative launch failed: %s (grid %d)\n", hipGetErrorString(e), grid); return; }
    }
#endif
}
```

```cpp
#include <hip/hip_runtime.h>
#include <hip/hip_cooperative_groups.h>
#include <cstdio>
#include <cstdint>
namespace cg = cooperative_groups;

#define LAS __attribute__((address_space(3)))
typedef unsigned short bf16_t;
typedef short bf16x8 __attribute__((ext_vector_type(8)));
typedef short s16x4 __attribute__((ext_vector_type(4)));
typedef float f32x2 __attribute__((ext_vector_type(2)));
typedef float f32x4 __attribute__((ext_vector_type(4)));
typedef float f32x16 __attribute__((ext_vector_type(16)));
typedef unsigned u32x2 __attribute__((ext_vector_type(2)));
typedef unsigned u32x4 __attribute__((ext_vector_type(4)));
typedef __bf16 bf16x2_t __attribute__((ext_vector_type(2)));

constexpr int NB = 4, S = 8192, D = 1024, M = NB * S, NP = 3840, DEPTH = 2;
constexpr int C_QLAT = 0, C_KVLAT = 192, C_KROPE = 320, C_FQ = 352, C_FK = 608, C_FV = 864, C_DQ = 1120, C_DK = 1376, C_DV = 1632,
              C_IQ = 1888, C_IK = 2016, C_NQ = 2048, C_KCMP = 2304, C_VCMP = 2368, C_KSEL = 2432, C_VSEL = 2496, C_KWIN = 2560,
              C_VWIN = 2624, C_GZ = 2688, C_SIDE = 3712;
constexpr float EPS = 1e-6f;
constexpr float LOG2E = 1.4426950408889634f;
constexpr int NTHREADS = 512;
constexpr int LDS_BYTES = 155648;

constexpr size_t MiB = 1u << 20;
constexpr size_t WS_CTL = 0;
constexpr size_t WS_WIN = 1 * MiB;
constexpr size_t WS_WOUT = 16 * MiB;
constexpr size_t WS_WUQ = 20 * MiB;
constexpr size_t WS_WUKV = 20 * MiB + 512 * 1024;
constexpr size_t WS_W1T = 21 * MiB;
constexpr size_t WS_CVEC = 22 * MiB;
constexpr size_t WS_MOD = 22 * MiB + 4096;
constexpr size_t WS_ROPE = 23 * MiB;
constexpr size_t WS_RSTD = 24 * MiB;
constexpr size_t WS_FB = 24 * MiB + 512 * 1024;
constexpr size_t WS_KC = 25 * MiB;
constexpr size_t WS_VC = 25 * MiB + 512 * 1024;
constexpr size_t WS_SIDE = 26 * MiB;
constexpr size_t WS_H = 30 * MiB;
constexpr size_t WS_QMLA = 94 * MiB;
constexpr size_t WS_KMLA = 118 * MiB;
constexpr size_t WS_VMLA = 142 * MiB;
constexpr size_t WS_MASK = 158 * MiB;
constexpr size_t WS_OCAT = 190 * MiB;
constexpr size_t WS_PROJ = 254 * MiB;
constexpr size_t WS_KIDX = ((WS_PROJ + (size_t)(M + 64) * NP * 2 + MiB - 1) / MiB) * MiB;
constexpr size_t WS_END = WS_KIDX + 2 * MiB;

struct Params {
    const float* in[17];
    float* out;
    unsigned char* ws;
    int ph_lo, ph_hi, bar_region, pad;
};

__device__ __forceinline__ unsigned pk2(float lo, float hi) { f32x2 v = {lo, hi}; bf16x2_t b = __builtin_convertvector(v, bf16x2_t); return __builtin_bit_cast(unsigned, b); }
__device__ __forceinline__ float bf2f(unsigned short b) { return __uint_as_float(((unsigned)b) << 16); }
__device__ __forceinline__ float bflo(unsigned u) { return __uint_as_float(u << 16); }
__device__ __forceinline__ float bfhi(unsigned u) { return __uint_as_float(u & 0xffff0000u); }
__device__ __forceinline__ float wave_sum(float v) {
    v += __builtin_bit_cast(float, __builtin_amdgcn_update_dpp(0, __builtin_bit_cast(int, v), 0xB1, 0xf, 0xf, false));
    v += __builtin_bit_cast(float, __builtin_amdgcn_update_dpp(0, __builtin_bit_cast(int, v), 0x4E, 0xf, 0xf, false));
    v += __builtin_bit_cast(float, __builtin_amdgcn_update_dpp(0, __builtin_bit_cast(int, v), 0x141, 0xf, 0xf, false));
    v += __builtin_bit_cast(float, __builtin_amdgcn_update_dpp(0, __builtin_bit_cast(int, v), 0x140, 0xf, 0xf, false));
    const float r0 = __builtin_bit_cast(float, __builtin_amdgcn_readlane(__builtin_bit_cast(int, v), 0)), r1 = __builtin_bit_cast(float, __builtin_amdgcn_readlane(__builtin_bit_cast(int, v), 16));
    const float r2 = __builtin_bit_cast(float, __builtin_amdgcn_readlane(__builtin_bit_cast(int, v), 32)), r3 = __builtin_bit_cast(float, __builtin_amdgcn_readlane(__builtin_bit_cast(int, v), 48));
    return (r0 + r1) + (r2 + r3);
}
__device__ __forceinline__ float silu_f(float x) { return x / (1.0f + __expf(-x)); }
__device__ __forceinline__ float sigmoid_f(float x) { return 1.0f / (1.0f + __expf(-x)); }
__device__ __forceinline__ int crow(int r, int hi) { return (r & 3) + 8 * (r >> 2) + 4 * hi; }
__device__ __forceinline__ int opaque_tid(int wid0) { int t; asm volatile("v_mbcnt_lo_u32_b32 %0, -1, 0\n\tv_mbcnt_hi_u32_b32 %0, -1, %0\n\tv_lshl_add_u32 %0, %1, 6, %0" : "=&v"(t) : "s"(wid0)); return t; }

namespace pg8 {
constexpr int BM = 256, BK = 64, HALF = 128, HTB = HALF * BK * 2, STAGE_BYTES = 8 * HTB, NXCD = 8, WGM = 8;
__host__ __device__ __forceinline__ int lds_byte(int r, int c) { const int st = (r >> 4) * 2 + (c >> 5), rr = r & 15, cc = c & 31, ob = rr * 64 + cc * 2; return st * 1024 + (ob ^ (((ob >> 9) & 1) << 5)); }
__host__ __device__ __forceinline__ void stage_rc(int b, int& R, int& C) { const int st = b / 1024, sb = b % 1024, swz = sb ^ (((sb >> 9) & 1) << 5); R = (st >> 1) * 16 + swz / 64; C = (st & 1) * 32 + (swz % 64) / 2; }
__host__ __device__ __forceinline__ int perm32(int rho) { const int n = rho >> 4, i = rho & 15; return 8 * (i >> 2) + 4 * n + (i & 3); }
struct Unit { int pm, pn; };
struct Gemm { const bf16_t* A; const bf16_t* Bt; int M, N, K, lda, ldb; };
struct StaticOrder {
    int nM, nN, nwg, G, c;
    __device__ void init(int M_, int N_, int G_, int c_) { nM = M_ / BM; nN = N_ / BM; nwg = nM * nN; G = G_; c = c_; }
    __device__ bool next(int i, Unit& u) const {
        const long L = (long)i * G + c; if (L >= nwg) return false;
        int wgid = (int)L; { const int q = nwg / NXCD, r = nwg % NXCD, xcd = wgid % NXCD, off = wgid / NXCD; wgid = (xcd < r ? xcd * (q + 1) : r * (q + 1) + (xcd - r) * q) + off; }
        const int nig = WGM * nN, gid = wgid / nig, fm = gid * WGM, gsz = (nM - fm) < WGM ? (nM - fm) : WGM;
        u.pm = fm + ((wgid % nig) % gsz); u.pn = (wgid % nig) / gsz; return true;
    }
};

template <class Epi, bool ALIGN_EPI>
__device__ __forceinline__ void gemm_phase(LAS unsigned char* lds, const Gemm g, const StaticOrder& S_, const Epi& E, int wid0) {
    const int tid = opaque_tid(wid0), wid = __builtin_amdgcn_readfirstlane(tid >> 6), lane = tid & 63, wr = wid >> 2, wc = wid & 3, fr = lane & 15, fq = lane >> 4;
    const int K = g.K, nt = K / BK;
    unsigned voffA[2], voffB[2];
#pragma unroll
    for (int i = 0; i < 2; ++i) { int R, C; stage_rc(tid * 16 + i * 8192, R, C); const int Rb = ((R & ~31) + perm32(R & 31));
        voffA[i] = (unsigned)(R * g.lda + C) * 2u; voffB[i] = (unsigned)(Rb * g.ldb + C) * 2u; }
    const size_t kstep = (size_t)(BK * 2);
    const size_t hstepA = (size_t)HALF * g.lda * 2, hstepB = (size_t)HALF * g.ldb * 2;
    const size_t tstepA = 2 * hstepA, tstepB = 2 * hstepB;
    const unsigned ldsw = (unsigned)wid * 1024u;
    const int aoff = lds_byte(wr * 64 + fr, fq * 8), boff = lds_byte(wc * 32 + fr, fq * 8);
#define PG8_SA(b, h) (((b) * 2 + (h)) * HTB)
#define PG8_SB(b, h) ((4 + (b) * 2 + (h)) * HTB)
#define PG8_STAGE(bufoff, gbase, voff) do { _Pragma("unroll") for (int _i = 0; _i < 2; ++_i) \
        __builtin_amdgcn_global_load_lds((const unsigned*)((const char*)(gbase) + (voff)[_i]), (LAS unsigned*)(lds + (bufoff) + ldsw + _i * 8192), 16, 0, 0); } while (0)
#define PG8_LDA(dst, b, h) do { _Pragma("unroll") for (int m = 0; m < 4; ++m) _Pragma("unroll") for (int k = 0; k < 2; ++k) dst[m][k] = *(const LAS bf16x8*)(lds + PG8_SA(b, h) + aoff + m * 2048 + k * 1024); } while (0)
#define PG8_LDB(dst, b, h) do { _Pragma("unroll") for (int n = 0; n < 2; ++n) _Pragma("unroll") for (int k = 0; k < 2; ++k) dst[n][k] = *(const LAS bf16x8*)(lds + PG8_SB(b, h) + boff + n * 2048 + k * 1024); } while (0)
#define PG8_MMA(ai, bj, At, Bt) do { __builtin_amdgcn_s_setprio(1); _Pragma("unroll") for (int m = 0; m < 4; ++m) _Pragma("unroll") for (int n = 0; n < 2; ++n) _Pragma("unroll") for (int k = 0; k < 2; ++k) \
        acc[ai][bj][m][n] = __builtin_amdgcn_mfma_f32_16x16x32_bf16(Bt[n][k], At[m][k], acc[ai][bj][m][n], 0, 0, 0); __builtin_amdgcn_s_setprio(0); } while (0)
#define PG8_WAIT_V(n) asm volatile("s_waitcnt vmcnt(" #n ")" ::: "memory")
#define PG8_WAIT_L(n) asm volatile("s_waitcnt lgkmcnt(" #n ")" ::: "memory")
#define PG8_BAR __builtin_amdgcn_s_barrier()
#define PG8_SCHED __builtin_amdgcn_sched_barrier(0)
    Unit cur, nxt; int ui = 0;
    if (!S_.next(0, cur)) return;
    f32x4 acc[2][2][4][2];
#pragma unroll
    for (int a = 0; a < 2; ++a)
#pragma unroll
        for (int b = 0; b < 2; ++b)
#pragma unroll
            for (int m = 0; m < 4; ++m)
#pragma unroll
                for (int n = 0; n < 2; ++n) acc[a][b][m][n] = (f32x4){0.f, 0.f, 0.f, 0.f};
    bf16x8 At[4][2], B0[2][2], B1[2][2];
    const char* cA = (const char*)g.A + (size_t)cur.pm * tstepA; const char* cB = (const char*)g.Bt + (size_t)cur.pn * tstepB;
    PG8_STAGE(PG8_SB(0, 0), cB, voffB); PG8_STAGE(PG8_SB(0, 1), cB + hstepB, voffB); PG8_STAGE(PG8_SA(0, 0), cA, voffA); PG8_STAGE(PG8_SA(0, 1), cA + hstepA, voffA);
    if (wr == 1) PG8_BAR;
    PG8_WAIT_V(2); PG8_BAR;
    PG8_STAGE(PG8_SB(1, 0), cB + kstep, voffB); PG8_STAGE(PG8_SA(1, 0), cA + kstep, voffA); PG8_STAGE(PG8_SB(1, 1), cB + hstepB + kstep, voffB);
    PG8_WAIT_V(6); PG8_BAR;
    for (;;) {
        const bool has_next = S_.next(ui + 1, nxt);
        const char* nA = has_next ? (const char*)g.A + (size_t)nxt.pm * tstepA : cA; const char* nB = has_next ? (const char*)g.Bt + (size_t)nxt.pn * tstepB : cB;
        for (int t = 0; t < nt; t += 2) {
            const bool last = (t == nt - 2);
            const char* a1 = cA + (size_t)(t + 1) * kstep;
            const char* a2 = last ? nA : cA + (size_t)(t + 2) * kstep; const char* b2 = last ? nB : cB + (size_t)(t + 2) * kstep;
            const char* a3 = a2 + kstep; const char* b3 = b2 + kstep;
            PG8_LDB(B0, 0, 0); PG8_LDB(B1, 0, 1); PG8_SCHED; PG8_LDA(At, 0, 0); PG8_STAGE(PG8_SA(1, 1), a1 + hstepA, voffA);
            PG8_WAIT_V(8); PG8_WAIT_L(0); PG8_BAR; PG8_MMA(0, 0, At, B0); PG8_MMA(0, 1, At, B1); PG8_BAR; PG8_SCHED;
            PG8_LDA(At, 0, 1); PG8_STAGE(PG8_SB(0, 0), b2, voffB); PG8_STAGE(PG8_SB(0, 1), b2 + hstepB, voffB); PG8_STAGE(PG8_SA(0, 0), a2, voffA);
            PG8_WAIT_V(8); PG8_WAIT_L(0); PG8_BAR; PG8_MMA(1, 0, At, B0); PG8_MMA(1, 1, At, B1); PG8_BAR; PG8_SCHED;
            PG8_LDB(B0, 1, 0); PG8_LDB(B1, 1, 1); PG8_SCHED; PG8_LDA(At, 1, 0); PG8_STAGE(PG8_SA(0, 1), a2 + hstepA, voffA);
            PG8_WAIT_V(8); PG8_WAIT_L(0); PG8_BAR; PG8_MMA(0, 0, At, B0); PG8_MMA(0, 1, At, B1); PG8_BAR; PG8_SCHED;
            PG8_LDA(At, 1, 1); PG8_STAGE(PG8_SB(1, 0), b3, voffB); PG8_STAGE(PG8_SB(1, 1), b3 + hstepB, voffB); PG8_STAGE(PG8_SA(1, 0), a3, voffA);
            PG8_WAIT_V(8); PG8_WAIT_L(0); PG8_BAR; PG8_MMA(1, 0, At, B0); PG8_MMA(1, 1, At, B1); PG8_BAR; PG8_SCHED;
        }
        if constexpr (ALIGN_EPI) { if (wr == 0) PG8_BAR; }
        E(acc, cur, wr, wc, fr, fq);
        if (!has_next) break;
#pragma unroll
        for (int a = 0; a < 2; ++a)
#pragma unroll
            for (int b = 0; b < 2; ++b)
#pragma unroll
                for (int m = 0; m < 4; ++m)
#pragma unroll
                    for (int n = 0; n < 2; ++n) acc[a][b][m][n] = (f32x4){0.f, 0.f, 0.f, 0.f};
        cur = nxt; cA = nA; cB = nB; ++ui;
        if constexpr (ALIGN_EPI) { if (wr == 1) PG8_BAR; }
    }
    PG8_WAIT_V(0);
    if constexpr (!ALIGN_EPI) { if (wr == 0) PG8_BAR; }
    PG8_BAR;
#undef PG8_SA
#undef PG8_SB
#undef PG8_STAGE
#undef PG8_LDA
#undef PG8_LDB
#undef PG8_MMA
#undef PG8_WAIT_V
#undef PG8_WAIT_L
#undef PG8_BAR
#undef PG8_SCHED
}

struct EpiProj {
    bf16_t* proj; float* side;
    __device__ __forceinline__ void operator()(const f32x4 (&acc)[2][2][4][2], const Unit& u, int wr, int wc, int fr, int fq) const {
        const int row0 = u.pm * BM + wr * 64 + fr, col0 = u.pn * BM + wc * 32 + 8 * fq;
#pragma unroll
        for (int ai = 0; ai < 2; ++ai)
#pragma unroll
            for (int m = 0; m < 4; ++m) { const int row = row0 + ai * HALF + m * 16; bf16_t* rowp = proj + (size_t)row * NP + col0;
#pragma unroll
                for (int bj = 0; bj < 2; ++bj) { const f32x4 v0 = acc[ai][bj][m][0], v1 = acc[ai][bj][m][1];
                    u32x4 w; w.x = pk2(v0[0], v0[1]); w.y = pk2(v0[2], v0[3]); w.z = pk2(v1[0], v1[1]); w.w = pk2(v1[2], v1[3]);
                    *(u32x4*)(rowp + bj * HALF) = w;
                    if (bj == 1 && u.pn == 14 && wc == 0) { float* sp = side + (size_t)row * 32 + 8 * fq; *(f32x4*)sp = v0; *(f32x4*)(sp + 4) = v1; } } }
    }
};
struct EpiQup {
    bf16_t* q; const float* rstd; const float* rope;
    __device__ __forceinline__ void operator()(const f32x4 (&acc)[2][2][4][2], const Unit& u, int wr, int wc, int fr, int fq) const {
        const int row0 = u.pm * BM + wr * 64 + fr;
#pragma unroll
        for (int ai = 0; ai < 2; ++ai)
#pragma unroll
            for (int m = 0; m < 4; ++m) { const int row = row0 + ai * HALF + m * 16; const float rs = rstd[(size_t)row * 2]; const int pos = row & (S - 1);
#pragma unroll
                for (int bj = 0; bj < 2; ++bj) { const int c = u.pn * BM + bj * HALF + wc * 32 + 8 * fq;
                    if (c < 384) { const int w0 = c % 96;
                        f32x4 v0 = acc[ai][bj][m][0] * rs, v1 = acc[ai][bj][m][1] * rs;
                        if (w0 >= 64) { const int i0 = (w0 - 64) >> 1; const float* tp = rope + ((size_t)pos * 16 + i0) * 2;
                            const f32x4 t0 = *(const f32x4*)tp, t1 = *(const f32x4*)(tp + 4);
                            f32x4 a, b;
                            a[0] = v0[0] * t0[0] - v0[1] * t0[1]; a[1] = v0[0] * t0[1] + v0[1] * t0[0];
                            a[2] = v0[2] * t0[2] - v0[3] * t0[3]; a[3] = v0[2] * t0[3] + v0[3] * t0[2];
                            b[0] = v1[0] * t1[0] - v1[1] * t1[1]; b[1] = v1[0] * t1[1] + v1[1] * t1[0];
                            b[2] = v1[2] * t1[2] - v1[3] * t1[3]; b[3] = v1[2] * t1[3] + v1[3] * t1[2];
                            v0 = a; v1 = b; }
                        u32x4 w; w.x = pk2(v0[0], v0[1]); w.y = pk2(v0[2], v0[3]); w.z = pk2(v1[0], v1[1]); w.w = pk2(v1[2], v1[3]);
                        *(u32x4*)(q + (size_t)row * 384 + c) = w; } }
                asm volatile("" ::: "memory"); }
    }
};
struct EpiKVup {
    bf16_t* k; bf16_t* v; const float* rstd;
    __device__ __forceinline__ void operator()(const f32x4 (&acc)[2][2][4][2], const Unit& u, int wr, int wc, int fr, int fq) const {
        const int row0 = u.pm * BM + wr * 64 + fr;
#pragma unroll
        for (int ai = 0; ai < 2; ++ai)
#pragma unroll
            for (int m = 0; m < 4; ++m) { const int row = row0 + ai * HALF + m * 16; const float rs = rstd[(size_t)row * 2 + 1];
#pragma unroll
                for (int bj = 0; bj < 2; ++bj) { const int c = u.pn * BM + bj * HALF + wc * 32 + 8 * fq; const int hd = c >> 7, w0 = c & 127;
                    const f32x4 v0 = acc[ai][bj][m][0] * rs, v1 = acc[ai][bj][m][1] * rs;
                    u32x4 w; w.x = pk2(v0[0], v0[1]); w.y = pk2(v0[2], v0[3]); w.z = pk2(v1[0], v1[1]); w.w = pk2(v1[2], v1[3]);
                    bf16_t* dst = (w0 < 64) ? (k + (size_t)row * 384 + hd * 96 + w0) : (v + (size_t)row * 256 + hd * 64 + (w0 - 64));
                    *(u32x4*)dst = w; }
                asm volatile("" ::: "memory"); }
    }
};
struct EpiOut {
    const float* res; float* out; const float* gate;
    __device__ __forceinline__ void operator()(const f32x4 (&acc)[2][2][4][2], const Unit& u, int wr, int wc, int fr, int fq) const {
        const int row0 = u.pm * BM + wr * 64 + fr; const int b = (u.pm * BM) / S;
#pragma unroll
        for (int bj = 0; bj < 2; ++bj) { const int c = u.pn * BM + bj * HALF + wc * 32 + 8 * fq;
            const f32x4 g0 = *(const f32x4*)(gate + (size_t)b * 3072 + c), g1 = *(const f32x4*)(gate + (size_t)b * 3072 + c + 4);
#pragma unroll
            for (int ai = 0; ai < 2; ++ai)
#pragma unroll
                for (int m = 0; m < 4; ++m) { const int row = row0 + ai * HALF + m * 16; const size_t off = (size_t)row * D + c;
                    const f32x4 r0 = *(const f32x4*)(res + off), r1 = *(const f32x4*)(res + off + 4);
                    *(f32x4*)(out + off) = r0 + g0 * acc[ai][bj][m][0]; *(f32x4*)(out + off + 4) = r1 + g1 * acc[ai][bj][m][1]; } }
    }
};
}

struct MapWin { __device__ __forceinline__ int operator()(int n) const {
    if (n < 1120) return n; if (n < 2048) return n + 4; if (n < 2688) return n + 8; if (n < 3712) return n + 20;
    if (n < 3716) return 1120 + (n - 3712); if (n < 3720) return 2052 + (n - 3716); if (n < 3732) return 2696 + (n - 3720); return -1; } };
struct MapId { int N; __device__ __forceinline__ int operator()(int n) const { return n < N ? n : -1; } };
struct MapUq { __device__ __forceinline__ int operator()(int n) const { if (n >= 384) return -1; const int hd = n / 96, w = n % 96; if (w < 64) return hd * 96 + w;
    const int p = (w - 64) >> 1, which = (w - 64) & 1; return hd * 96 + 64 + (which ? 16 + p : p); } };

template <class ColMap>
__device__ __forceinline__ void tr_tile(const float* src, int lds_src, int Ksrc, const float* kscale, bf16_t* dst, int ldd, int n0, int k0, ColMap cm, LAS float* scr, int wid0) {
    const int tid = opaque_tid(wid0);
#pragma unroll
    for (int i = 0; i < 8; ++i) { const int idx = tid + i * NTHREADS, kk = idx >> 6, nn = idx & 63; const int sc = cm(n0 + nn), k = k0 + kk;
        float v = 0.f; if (sc >= 0 && k < Ksrc) { v = src[(size_t)k * lds_src + sc]; if (kscale) v *= kscale[k]; }
        scr[kk * 65 + nn] = v; }
    __syncthreads();
    { const int nn = tid >> 3, kc = tid & 7; const LAS float* s = scr + (kc * 8) * 65 + nn;
      u32x4 w; w.x = pk2(s[0], s[65]); w.y = pk2(s[2 * 65], s[3 * 65]); w.z = pk2(s[4 * 65], s[5 * 65]); w.w = pk2(s[6 * 65], s[7 * 65]);
      *(u32x4*)(dst + (size_t)(n0 + nn) * ldd + k0 + kc * 8) = w; }
    __syncthreads();
}

__device__ __forceinline__ void phase_prologue(const Params& P, LAS unsigned char* lds, int bid, int G, int wid0) {
    const int tid = opaque_tid(wid0);
    LAS float* scr = (LAS float*)lds;
    const float* w_in = P.in[5]; const float* w_uq = P.in[7]; const float* w_ukv = P.in[9]; const float* w1 = P.in[12]; const float* w_out = P.in[15];
    constexpr int T_WIN = 60 * 16, T_WOUT = 16 * 16, T_UQ = 8 * 4, T_UKV = 8 * 2, T_W1 = 1 * 32 * 2;
    constexpr int T_L = T_WIN + T_WOUT + T_UQ + T_UKV + T_W1;
    for (int it = bid; it < DEPTH * T_L; it += G) {
        const int l = it / T_L; int r = it % T_L;
        if (r < T_WIN) { tr_tile(w_in + (size_t)l * D * 3732, 3732, D, nullptr, (bf16_t*)(P.ws + WS_WIN) + (size_t)l * NP * D, D, (r / 16) * 64, (r % 16) * 64, MapWin{}, scr, wid0); continue; } r -= T_WIN;
        if (r < T_WOUT) { tr_tile(w_out + (size_t)l * D * D, D, D, nullptr, (bf16_t*)(P.ws + WS_WOUT) + (size_t)l * D * D, D, (r / 16) * 64, (r % 16) * 64, MapId{D}, scr, wid0); continue; } r -= T_WOUT;
        if (r < T_UQ) { tr_tile(w_uq + (size_t)l * 192 * 384, 384, 192, P.in[6] + l * 192, (bf16_t*)(P.ws + WS_WUQ) + (size_t)l * 512 * 256, 256, (r / 4) * 64, (r % 4) * 64, MapUq{}, scr, wid0); continue; } r -= T_UQ;
        if (r < T_UKV) { tr_tile(w_ukv + (size_t)l * 128 * 512, 512, 128, P.in[8] + l * 128, (bf16_t*)(P.ws + WS_WUKV) + (size_t)l * 512 * 128, 128, (r / 2) * 64, (r % 2) * 64, MapId{512}, scr, wid0); continue; } r -= T_UKV;
        { const int kv = r / 32, kt = r % 32; tr_tile(w1 + (size_t)(l * 2 + kv) * 2048 * 64, 64, 2048, nullptr, (bf16_t*)(P.ws + WS_W1T) + (size_t)(l * 2 + kv) * 64 * 2048, 2048, 0, kt * 64, MapId{64}, scr, wid0); }
    }
    {
        LAS float* sc = (LAS float*)lds;
        LAS float* red = (LAS float*)(lds + 16384);
        const float* c = P.in[1]; const float* w_ada = P.in[3]; const float* b_ada = P.in[4]; float* mod = (float*)(P.ws + WS_MOD);
        bool loaded = false;
        for (int it = bid; it < DEPTH * 48; it += G) {
            if (!loaded) { for (int i = tid; i < 4096; i += NTHREADS) sc[i] = silu_f(c[i]); loaded = true; __syncthreads(); }
            const int l = it / 48, cb = it % 48, col = tid & 63, ks = tid >> 6;
            const float* wp = w_ada + (size_t)l * D * 3072 + (size_t)(ks * 128) * 3072 + cb * 64 + col;
            float a0 = 0.f, a1 = 0.f, a2 = 0.f, a3 = 0.f;
#pragma unroll 8
            for (int k = 0; k < 128; ++k) { const float w = wp[(size_t)k * 3072]; const int kk = ks * 128 + k;
                a0 += sc[kk] * w; a1 += sc[1024 + kk] * w; a2 += sc[2048 + kk] * w; a3 += sc[3072 + kk] * w; }
            red[(ks * 64 + col) * 4 + 0] = a0; red[(ks * 64 + col) * 4 + 1] = a1; red[(ks * 64 + col) * 4 + 2] = a2; red[(ks * 64 + col) * 4 + 3] = a3;
            __syncthreads();
            if (tid < 256) { const int cc = tid & 63, b = tid >> 6; float s = b_ada[l * 3072 + cb * 64 + cc];
#pragma unroll
                for (int k8 = 0; k8 < 8; ++k8) s += red[(k8 * 64 + cc) * 4 + b];
                mod[(size_t)(l * 4 + b) * 3072 + cb * 64 + cc] = s; }
            __syncthreads();
        }
    }
    {
        float* tab = (float*)(P.ws + WS_ROPE);
        for (int idx = bid * NTHREADS + tid; idx < S * 16; idx += G * NTHREADS) {
            const int pos = idx >> 4, i = idx & 15;
            const double f4[4] = {1.0, 0.5623413251903491, 0.31622776601683794, 0.1778279410038923};
            double inv = (i & 3) == 0 ? f4[0] : ((i & 3) == 1 ? f4[1] : ((i & 3) == 2 ? f4[2] : f4[3]));
            inv *= ((i >> 2) == 0 ? 1.0 : ((i >> 2) == 1 ? 0.1 : ((i >> 2) == 2 ? 0.01 : 0.001)));
            const float invf = (float)inv; const float angf = (float)pos * invf;
            const double rev = (double)angf * 0.15915494309189535; const double fr = rev - __builtin_floor(rev);
            const float f = (float)fr;
            tab[(size_t)idx * 2] = __builtin_amdgcn_cosf(f); tab[(size_t)idx * 2 + 1] = __builtin_amdgcn_sinf(f);
        }
    }
    {
        const float* pos = P.in[11]; float* cvec = (float*)(P.ws + WS_CVEC);
        LAS float* red = (LAS float*)(lds + 65536);
        for (int it = bid; it < DEPTH * 2; it += G) {
            __syncthreads();
            const int col = tid & 63, ks = tid >> 6; float a = 0.f;
            const float* wp = w1 + (size_t)it * 2048 * 64 + (size_t)(ks * 256) * 64 + col; const float* pp = pos + (size_t)it * 2048 + ks * 256;
            for (int k = 0; k < 256; ++k) a += pp[k] * wp[(size_t)k * 64];
            red[ks * 64 + col] = a; __syncthreads();
            if (tid < 64) { float s = 0.f; for (int k8 = 0; k8 < 8; ++k8) s += red[k8 * 64 + tid]; cvec[it * 64 + tid] = s; }
            __syncthreads();
        }
    }
}

__device__ __forceinline__ void phase_hnorm(const float* x, const float* g, const float* mod  , bf16_t* h, int bid, int G, int wid0) {
    const int tid_ = opaque_tid(wid0); const int lane = tid_ & 63, wv = tid_ >> 6;
    for (int row = bid * 8 + wv; row < M; row += G * 8) {
        const f32x4* xr = (const f32x4*)(x + (size_t)row * D) + lane;
        f32x4 v[4]; float s = 0.f;
#pragma unroll
        for (int j = 0; j < 4; ++j) { v[j] = xr[64 * j]; s += (v[j][0] * v[j][0] + v[j][1] * v[j][1]) + (v[j][2] * v[j][2] + v[j][3] * v[j][3]); }
        const float rstd = 1.0f / sqrtf(wave_sum(s) * (1.f / D) + EPS);
        const int b = row / S; const float* sh = mod + (size_t)b * 3072; const float* scl = sh + 1024;
        unsigned long long* o8 = (unsigned long long*)(h + (size_t)row * D) + lane;
#pragma unroll
        for (int j = 0; j < 4; ++j) { const int c = (64 * j + lane) * 4; const f32x4 gg = *(const f32x4*)(g + c), ss = *(const f32x4*)(scl + c), hh = *(const f32x4*)(sh + c);
            f32x4 y;
#pragma unroll
            for (int e = 0; e < 4; ++e) y[e] = v[j][e] * rstd * gg[e] * (1.0f + ss[e]) + hh[e];
            o8[64 * j] = (unsigned long long)pk2(y[0], y[1]) | ((unsigned long long)pk2(y[2], y[3]) << 32); }
    }
}

__device__ __forceinline__ void phase_prep(const Params& P, int l, LAS unsigned char* lds, int bid, int G, int wid0) {
    const int tid = opaque_tid(wid0), lane = tid & 63, wv = tid >> 6;
    const bf16_t* proj = (const bf16_t*)(P.ws + WS_PROJ); const float* side = (const float*)(P.ws + WS_SIDE);
    {
        float* rstd = (float*)(P.ws + WS_RSTD); bf16_t* kmla = (bf16_t*)(P.ws + WS_KMLA); const float* rope = (const float*)(P.ws + WS_ROPE);
        for (int row = bid * 8 + wv; row < M; row += G * 8) {
            const bf16_t* pr = proj + (size_t)row * NP;
            float sq = 0.f, skv = 0.f;
            if (lane < 40) { const u32x4 w = *(const u32x4*)(pr + lane * 8); float s = 0.f;
#pragma unroll
                for (int e = 0; e < 4; ++e) { const float a = bflo(w[e]), b = bfhi(w[e]); s += a * a + b * b; }
                if (lane < 24) sq = s; else skv = s; }
            sq = wave_sum(sq); skv = wave_sum(skv);
            if (lane == 0) { rstd[(size_t)row * 2] = 1.0f / sqrtf(sq * (1.f / 192.f) + EPS); rstd[(size_t)row * 2 + 1] = 1.0f / sqrtf(skv * (1.f / 128.f) + EPS); }
            if (lane >= 48 && lane < 52) *(u32x4*)((bf16_t*)(P.ws + WS_KIDX) + (size_t)row * 32 + (lane - 48) * 8) = *(const u32x4*)(pr + C_IK + (lane - 48) * 8);
            if (lane < 16) { const float x1 = bf2f(pr[C_KROPE + lane]), x2 = bf2f(pr[C_KROPE + 16 + lane]); const int pos = row & (S - 1);
                const float cs = rope[((size_t)pos * 16 + lane) * 2], sn = rope[((size_t)pos * 16 + lane) * 2 + 1];
                const unsigned w = pk2(x1 * cs - x2 * sn, x1 * sn + x2 * cs);
#pragma unroll
                for (int hd = 0; hd < 4; ++hd) *(unsigned*)(kmla + (size_t)row * 384 + hd * 96 + 64 + 2 * lane) = w; }
        }
    }
    {
        float* fb = (float*)(P.ws + WS_FB); const float* b_f = P.in[10] + l * 4; LAS float* wtot = (LAS float*)lds;
        for (int it = bid; it < 16; it += G) {
            const int b = it >> 2, hd = it & 3; const float bf = b_f[hd];
            float ls[16]; float s = 0.f;
#pragma unroll
            for (int i = 0; i < 16; ++i) { const int t = tid * 16 + i; const float v = side[((size_t)b * S + t) * 32 + hd] + bf;
                const float y = fminf(v, 0.f) - log1pf(__expf(-fabsf(v))); ls[i] = y; s += y; }
            float inc = s;
#pragma unroll
            for (int o = 1; o < 64; o <<= 1) { const float t = __shfl_up(inc, o); if (lane >= o) inc += t; }
            __syncthreads();
            if (lane == 63) wtot[wv] = inc;
            __syncthreads();
            float base = 0.f;
            for (int w = 0; w < wv; ++w) base += wtot[w];
            float run = base + inc - s;
#pragma unroll
            for (int i = 0; i < 16; ++i) { run += ls[i]; fb[((size_t)it) * S + tid * 16 + i] = -8.0f * run; }
            __syncthreads();
        }
    }
    {
        const bf16_t* w1t = (const bf16_t*)(P.ws + WS_W1T) + (size_t)l * 2 * 64 * 2048; const float* cvec = (const float*)(P.ws + WS_CVEC) + l * 2 * 64;
        const float* w2 = P.in[13] + (size_t)l * 2 * 64 * 64;
        LAS float* part = (LAS float*)lds;
        LAS float* hb = (LAS float*)(lds + 65536);
        const int r = lane & 31, hi = lane >> 5;
        for (int it = bid; it < 128; it += G) {
            const int b = it >> 5, kv = (it >> 4) & 1, nt = it & 15, n0 = nt * 32;
            const int colbase = kv ? C_VCMP : C_KCMP;
            const bf16_t* w1k = w1t + (size_t)kv * 64 * 2048;
            f32x16 a0 = {}, a1 = {};
#pragma unroll
            for (int j = 0; j < 4; ++j) { const int tok = wv * 4 + j;
                const bf16_t* ap = proj + ((size_t)b * S + 16 * (n0 + r) + tok) * NP + colbase + hi * 8;
#pragma unroll
                for (int s = 0; s < 4; ++s) { const bf16x8 af = *(const bf16x8*)(ap + s * 16);
                    const int kb = tok * 64 + s * 16 + hi * 8;
                    const bf16x8 b0 = *(const bf16x8*)(w1k + (size_t)r * 2048 + kb), b1 = *(const bf16x8*)(w1k + (size_t)(32 + r) * 2048 + kb);
                    a0 = __builtin_amdgcn_mfma_f32_32x32x16_bf16(af, b0, a0, 0, 0, 0); a1 = __builtin_amdgcn_mfma_f32_32x32x16_bf16(af, b1, a1, 0, 0, 0); } }
#pragma unroll
            for (int reg = 0; reg < 16; ++reg) { const int n = crow(reg, hi); part[(wv * 32 + n) * 64 + r] = a0[reg]; part[(wv * 32 + n) * 64 + 32 + r] = a1[reg]; }
            __syncthreads();
            { const int n = tid >> 4, c4 = (tid & 15) * 4;
#pragma unroll
              for (int e = 0; e < 4; ++e) { float s = cvec[kv * 64 + c4 + e];
#pragma unroll
                  for (int w = 0; w < 8; ++w) s += part[(w * 32 + n) * 64 + c4 + e];
                  hb[n * 64 + c4 + e] = silu_f(s); } }
            __syncthreads();
            { const int n = tid >> 4, c4 = (tid & 15) * 4; float o[4] = {0.f, 0.f, 0.f, 0.f}; const float* w2k = w2 + (size_t)kv * 64 * 64;
              for (int k = 0; k < 64; ++k) { const float hv = hb[n * 64 + k]; const f32x4 wv4 = *(const f32x4*)(w2k + k * 64 + c4);
                  o[0] += hv * wv4[0]; o[1] += hv * wv4[1]; o[2] += hv * wv4[2]; o[3] += hv * wv4[3]; }
              bf16_t* dst = (bf16_t*)(P.ws + (kv ? WS_VC : WS_KC)) + ((size_t)b * 512 + n0 + n) * 64 + c4;
              const bool valid = (n0 + n) < 511;
              u32x2 w; w.x = valid ? pk2(o[0], o[1]) : 0u; w.y = valid ? pk2(o[2], o[3]) : 0u; *(u32x2*)dst = w; }
            __syncthreads();
        }
    }
}

constexpr float NEG_BIG = -1e30f;
constexpr int KSTR64 = 144, KSTR96 = 208;
constexpr int ATT_KBUF = 64 * KSTR96;
constexpr int ATT_VBUF = 8192;
constexpr int ATT_K0 = 0, ATT_V0 = 2 * ATT_KBUF, ATT_B0 = ATT_V0 + 2 * ATT_VBUF, ATT_END = ATT_B0 + 2 * 256;
constexpr int ATT_EXTRA = 45056;

struct SoftState { float m, l; f32x16 o0, o1; };

template <int KS>
__device__ __forceinline__ void qk_tile(f32x16& p0, f32x16& p1, const LAS unsigned char* kt, int kstride, const bf16x8 (&qf)[KS], int r, int hi) {
    const LAS unsigned char* k0 = kt + r * kstride + hi * 16; const LAS unsigned char* k1 = k0 + 32 * kstride;
#pragma unroll
    for (int s = 0; s < KS; ++s) { const bf16x8 a0 = *(const LAS bf16x8*)(k0 + s * 32), a1 = *(const LAS bf16x8*)(k1 + s * 32);
        p0 = __builtin_amdgcn_mfma_f32_32x32x16_bf16(a0, qf[s], p0, 0, 0, 0); p1 = __builtin_amdgcn_mfma_f32_32x32x16_bf16(a1, qf[s], p1, 0, 0, 0); }
}
__device__ __forceinline__ float max3f(float a, float b, float c);
__device__ __forceinline__ float tile_max(const f32x16& p0, const f32x16& p1) {
    float a = max3f(p0[0], p0[1], p1[0]), b = max3f(p0[2], p0[3], p1[1]); a = max3f(a, p1[2], p1[3]);
#pragma unroll
    for (int i = 4; i < 16; i += 4) { a = max3f(a, p0[i], p0[i + 1]); b = max3f(b, p0[i + 2], p0[i + 3]); a = max3f(a, p1[i], p1[i + 1]); b = max3f(b, p1[i + 2], p1[i + 3]); }
    a = max3f(a, b, b);
    const auto rr = __builtin_amdgcn_permlane32_swap(__float_as_uint(a), __float_as_uint(a), false, false);
    return fmaxf(__uint_as_float(rr[0]), __uint_as_float(rr[1]));
}
__device__ __forceinline__ bf16x8 vfrag(const LAS unsigned char* p) {
    const s16x4 lo = __builtin_bit_cast(s16x4, __builtin_amdgcn_ds_read_tr16_b64_v4i16((LAS s16x4*)p));
    const s16x4 hi = __builtin_bit_cast(s16x4, __builtin_amdgcn_ds_read_tr16_b64_v4i16((LAS s16x4*)(p + 512)));
    return (bf16x8){lo[0], lo[1], lo[2], lo[3], hi[0], hi[1], hi[2], hi[3]};
}
__device__ __forceinline__ bf16x8 pfrag(const f32x16& p, int b) {
    u32x4 w; w.x = pk2(p[b], p[b + 1]); w.y = pk2(p[b + 2], p[b + 3]); w.z = pk2(p[b + 4], p[b + 5]); w.w = pk2(p[b + 6], p[b + 7]);
    return __builtin_bit_cast(bf16x8, w);
}
__device__ __forceinline__ void pv_frag(f32x16& o0, f32x16& o1, bf16x8 pf0, bf16x8 pf1, bf16x8 pf2, bf16x8 pf3, const LAS unsigned char* vt, int vb) {
    const LAS unsigned char* v = vt + vb;
    o0 = __builtin_amdgcn_mfma_f32_32x32x16_bf16(vfrag(v), pf0, o0, 0, 0, 0);            o1 = __builtin_amdgcn_mfma_f32_32x32x16_bf16(vfrag(v + 4096), pf0, o1, 0, 0, 0);
    o0 = __builtin_amdgcn_mfma_f32_32x32x16_bf16(vfrag(v + 1024), pf1, o0, 0, 0, 0);     o1 = __builtin_amdgcn_mfma_f32_32x32x16_bf16(vfrag(v + 4096 + 1024), pf1, o1, 0, 0, 0);
    o0 = __builtin_amdgcn_mfma_f32_32x32x16_bf16(vfrag(v + 2048), pf2, o0, 0, 0, 0);     o1 = __builtin_amdgcn_mfma_f32_32x32x16_bf16(vfrag(v + 4096 + 2048), pf2, o1, 0, 0, 0);
    o0 = __builtin_amdgcn_mfma_f32_32x32x16_bf16(vfrag(v + 3072), pf3, o0, 0, 0, 0);     o1 = __builtin_amdgcn_mfma_f32_32x32x16_bf16(vfrag(v + 4096 + 3072), pf3, o1, 0, 0, 0);
}
__device__ __forceinline__ void pv_tile(f32x16& o0, f32x16& o1, const f32x16& p0, const f32x16& p1, const LAS unsigned char* vt, int vb) {
    pv_frag(o0, o1, pfrag(p0, 0), pfrag(p0, 8), pfrag(p1, 0), pfrag(p1, 8), vt, vb);
}
__device__ __forceinline__ void softmax_step(SoftState& st, f32x16& p0, f32x16& p1, float c2) {
    const float mx = tile_max(p0, p1);
    const float mn = fmaxf(st.m, mx);
    if (__any(mn > st.m)) { const float al = __builtin_amdgcn_exp2f((st.m - mn) * c2); st.l *= al; st.o0 *= al; st.o1 *= al; st.m = mn; }
    const float mc = st.m * c2; float sum = 0.f;
#pragma unroll
    for (int i = 0; i < 16; ++i) { p0[i] = __builtin_amdgcn_exp2f(__builtin_fmaf(p0[i], c2, -mc)); p1[i] = __builtin_amdgcn_exp2f(__builtin_fmaf(p1[i], c2, -mc)); sum += p0[i] + p1[i]; }
    st.l += sum;
}

__device__ __forceinline__ float max3f(float a, float b, float c) { float r; asm("v_max3_f32 %0, %1, %2, %3" : "=v"(r) : "v"(a), "v"(b), "v"(c)); return r; }
__device__ __forceinline__ float swap32_max(float a) { const auto rr = __builtin_amdgcn_permlane32_swap(__float_as_uint(a), __float_as_uint(a), false, false);
    float r; asm("v_max_f32_e32 %0, %1, %2" : "=v"(r) : "v"(__uint_as_float(rr[0])), "v"(__uint_as_float(rr[1]))); return r; }
__device__ __forceinline__ float quad_xor1(float x) { return __builtin_bit_cast(float, __builtin_amdgcn_update_dpp(0, __builtin_bit_cast(int, x), 0xB1, 0xf, 0xf, false)); }
__device__ __forceinline__ float quad_xor2(float x) { return __builtin_bit_cast(float, __builtin_amdgcn_update_dpp(0, __builtin_bit_cast(int, x), 0x4E, 0xf, 0xf, false)); }
__device__ __forceinline__ float swap32_sum(float a) { const auto rr = __builtin_amdgcn_permlane32_swap(__float_as_uint(a), __float_as_uint(a), false, false); return __uint_as_float(rr[0]) + __uint_as_float(rr[1]); }
constexpr float SM_THR = 8.0f;
__device__ __forceinline__ void softmax_pack(SoftState& st, const f32x16& p0, const f32x16& p1, float c2, bf16x8& pf0, bf16x8& pf1, bf16x8& pf2, bf16x8& pf3) {
    float a = max3f(p0[0], p0[1], p1[0]), b = max3f(p0[2], p0[3], p1[1]); a = max3f(a, p1[2], p1[3]);
#pragma unroll
    for (int i = 4; i < 16; i += 4) { a = max3f(a, p0[i], p0[i + 1]); b = max3f(b, p0[i + 2], p0[i + 3]); a = max3f(a, p1[i], p1[i + 1]); b = max3f(b, p1[i + 2], p1[i + 3]); }
    float mx; asm("v_max_f32_e32 %0, %1, %2" : "=v"(mx) : "v"(a), "v"(b));
    mx = swap32_max(mx);
    if (__any((mx - st.m) * c2 > SM_THR)) { const float mn = fmaxf(st.m, mx); const float al = __builtin_amdgcn_exp2f((st.m - mn) * c2); st.l *= al; st.o0 *= al; st.o1 *= al; st.m = mn; }
    const float mc = -st.m * c2; float s0 = 0.f, s1 = 0.f;
    u32x4 w0, w1, w2, w3;
#define SMP(W, E, P, B) do { const float e0_ = __builtin_amdgcn_exp2f(__builtin_fmaf(P[B], c2, mc)), e1_ = __builtin_amdgcn_exp2f(__builtin_fmaf(P[B + 1], c2, mc)); s0 += e0_; s1 += e1_; W[E] = pk2(e0_, e1_); } while (0)
    SMP(w0, 0, p0, 0); SMP(w0, 1, p0, 2); SMP(w0, 2, p0, 4); SMP(w0, 3, p0, 6);
    SMP(w1, 0, p0, 8); SMP(w1, 1, p0, 10); SMP(w1, 2, p0, 12); SMP(w1, 3, p0, 14);
    SMP(w2, 0, p1, 0); SMP(w2, 1, p1, 2); SMP(w2, 2, p1, 4); SMP(w2, 3, p1, 6);
    SMP(w3, 0, p1, 8); SMP(w3, 1, p1, 10); SMP(w3, 2, p1, 12); SMP(w3, 3, p1, 14);
#undef SMP
    st.l += s0 + s1;
    pf0 = __builtin_bit_cast(bf16x8, w0); pf1 = __builtin_bit_cast(bf16x8, w1); pf2 = __builtin_bit_cast(bf16x8, w2); pf3 = __builtin_bit_cast(bf16x8, w3);
}

__device__ __forceinline__ void sm_exp_pack(SoftState& st, const f32x16& p0, const f32x16& p1, float c2, bf16x8& pf0, bf16x8& pf1, bf16x8& pf2, bf16x8& pf3) {
    const float mc = -st.m * c2; float s0 = 0.f, s1 = 0.f;
    u32x4 w0, w1, w2, w3;
#define SMP(W, E, P, B) do { const float e0_ = __builtin_amdgcn_exp2f(__builtin_fmaf(P[B], c2, mc)), e1_ = __builtin_amdgcn_exp2f(__builtin_fmaf(P[B + 1], c2, mc)); s0 += e0_; s1 += e1_; W[E] = pk2(e0_, e1_); } while (0)
    SMP(w0, 0, p0, 0); SMP(w0, 1, p0, 2); SMP(w0, 2, p0, 4); SMP(w0, 3, p0, 6);
    SMP(w1, 0, p0, 8); SMP(w1, 1, p0, 10); SMP(w1, 2, p0, 12); SMP(w1, 3, p0, 14);
    SMP(w2, 0, p1, 0); SMP(w2, 1, p1, 2); SMP(w2, 2, p1, 4); SMP(w2, 3, p1, 6);
    SMP(w3, 0, p1, 8); SMP(w3, 1, p1, 10); SMP(w3, 2, p1, 12); SMP(w3, 3, p1, 14);
#undef SMP
    st.l += s0 + s1;
    pf0 = __builtin_bit_cast(bf16x8, w0); pf1 = __builtin_bit_cast(bf16x8, w1); pf2 = __builtin_bit_cast(bf16x8, w2); pf3 = __builtin_bit_cast(bf16x8, w3);
}

template <int DK> struct StageRegs { u32x4 k0, k1, v; float b; };
template <int DK>
__device__ __forceinline__ void stage_load(StageRegs<DK>& sr, const bf16_t* K, int ldk, const bf16_t* V, int ldv, const float* bias, int kv0, int wid0) {
    const int tid = opaque_tid(wid0); constexpr int CPR = DK / 8;
    { const int row = tid / CPR, cc = tid % CPR; sr.k0 = *(const u32x4*)(K + (size_t)(kv0 + row) * ldk + cc * 8); }
    if (DK == 96 && tid < 256) { const int c = tid + 512, row = c / CPR, cc = c % CPR; sr.k1 = *(const u32x4*)(K + (size_t)(kv0 + row) * ldk + cc * 8); }
    { const int row = tid >> 3, cc = tid & 7; sr.v = *(const u32x4*)(V + (size_t)(kv0 + row) * ldv + cc * 8); }
    if (bias && tid < 64) sr.b = bias[kv0 + tid];
}
template <int DK>
__device__ __forceinline__ void stage_store(const StageRegs<DK>& sr, LAS unsigned char* lds, int buf, bool has_bias, int wid0) {
    const int tid = opaque_tid(wid0); constexpr int CPR = DK / 8; constexpr int KSTR = (DK == 96) ? KSTR96 : KSTR64;
    LAS unsigned char* kb = lds + ATT_K0 + buf * ATT_KBUF; LAS unsigned char* vb = lds + ATT_V0 + buf * ATT_VBUF;
    { const int row = tid / CPR, cc = tid % CPR; *(LAS u32x4*)(kb + row * KSTR + cc * 16) = sr.k0; }
    if (DK == 96 && tid < 256) { const int c = tid + 512, row = c / CPR, cc = c % CPR; *(LAS u32x4*)(kb + row * KSTR + cc * 16) = sr.k1; }
    { const int row = tid >> 3, cc = tid & 7; *(LAS u32x4*)(vb + (cc >> 2) * 4096 + row * 64 + (cc & 3) * 16) = sr.v; }
    if (has_bias && tid < 64) *(LAS float*)(lds + ATT_B0 + buf * 256 + tid * 4) = sr.b;
}

__device__ __forceinline__ void store_out(bf16_t* dst  , const f32x16& o0, const f32x16& o1, float scale, int hi) {
#pragma unroll
    for (int g = 0; g < 4; ++g) {
        u32x2 w; w.x = pk2(o0[4 * g] * scale, o0[4 * g + 1] * scale); w.y = pk2(o0[4 * g + 2] * scale, o0[4 * g + 3] * scale);
        *(u32x2*)(dst + 8 * g + 4 * hi) = w;
        u32x2 w1; w1.x = pk2(o1[4 * g] * scale, o1[4 * g + 1] * scale); w1.y = pk2(o1[4 * g + 2] * scale, o1[4 * g + 3] * scale);
        *(u32x2*)(dst + 32 + 8 * g + 4 * hi) = w1;
    }
}

constexpr int DA_K0 = 0, DA_V0 = 3 * ATT_KBUF, DA_B0 = DA_V0 + 2 * ATT_VBUF, DA_END = DA_B0 + 3 * 256;
static_assert(DA_END <= LDS_BYTES, "dense attention LDS map");
template <int DK, int MODE>
__device__ __forceinline__ void dense_unit(LAS unsigned char* lds, const bf16_t* Q, int ldq, const bf16_t* K, int ldk, const bf16_t* V, int ldv,
                                           bf16_t* O  , const float* bias, const unsigned long long* maskbits  ,
                                           float alibiA, float c2, int qb, int wid0) {
    constexpr int KS = DK / 16; constexpr int KSTR = (DK == 96) ? KSTR96 : KSTR64; constexpr int CPR = DK / 8;
    const int tid = opaque_tid(wid0), lane = tid & 63, wv = __builtin_amdgcn_readfirstlane(tid >> 6), r = lane & 31, hi = lane >> 5;
    const int q0 = qb * 256, qw0 = q0 + wv * 32, tq = qw0 + r;
    const int NT = (q0 + 256) / 64;
    const int tlast = (qw0 + 31) >> 6;
    bf16x8 qf[KS];
#pragma unroll
    for (int s = 0; s < KS; ++s) qf[s] = *(const bf16x8*)(Q + (size_t)tq * ldq + s * 16 + hi * 8);
    const int vb = ((lane >> 4) & 1) * 32 + (lane & 3) * 8 + (4 * hi + ((lane & 15) >> 2)) * 64;
    const int kb = r * KSTR + hi * 16;
    SoftState st; st.m = NEG_BIG; st.l = 0.f; st.o0 = (f32x16){}; st.o1 = (f32x16){};
    const int krow0 = tid / CPR, kcc0 = tid % CPR, krow1 = (tid + 512) / CPR, kcc1 = (tid + 512) % CPR, vrow = tid >> 3, vcc = tid & 7;
    const bf16_t* kp0 = K + (size_t)krow0 * ldk + kcc0 * 8; const bf16_t* kp1 = K + (size_t)krow1 * ldk + kcc1 * 8; const bf16_t* vp = V + (size_t)vrow * ldv + vcc * 8;
    const int klds0 = krow0 * KSTR + kcc0 * 16, klds1 = krow1 * KSTR + kcc1 * 16, vlds = (vcc >> 2) * 4096 + vrow * 64 + (vcc & 3) * 16;
    u32x4 rk0, rk1, rv; float rbias = 0.f;
#define DA_LOADK(t) do { rk0 = *(const u32x4*)(kp0 + (size_t)(t) * 64 * ldk); if (DK == 96 && tid < 256) rk1 = *(const u32x4*)(kp1 + (size_t)(t) * 64 * ldk); if (MODE == 1 && tid < 64) rbias = bias[(t) * 64 + tid]; } while (0)
#define DA_LOADV(t) do { rv = *(const u32x4*)(vp + (size_t)(t) * 64 * ldv); } while (0)
#define DA_STOREK(slot) do { LAS unsigned char* kb_ = lds + DA_K0 + (slot) * ATT_KBUF; *(LAS u32x4*)(kb_ + klds0) = rk0; if (DK == 96 && tid < 256) *(LAS u32x4*)(kb_ + klds1) = rk1; \
        if (MODE == 1 && tid < 64) *(LAS float*)(lds + DA_B0 + (slot) * 256 + tid * 4) = rbias; } while (0)
#define DA_STOREV(slot) do { *(LAS u32x4*)(lds + DA_V0 + (slot) * ATT_VBUF + vlds) = rv; } while (0)
#define DA_CINIT(P0, P1, t, slot) do { const int kv0_ = (t) * 64; \
        if (MODE == 0) { P0 = (f32x16){}; P1 = (f32x16){}; } \
        else if (MODE == 1) { const LAS float* bl = (const LAS float*)(lds + DA_B0 + (slot) * 256); \
            _Pragma("unroll") for (int g = 0; g < 4; ++g) { const f32x4 b0_ = *(const LAS f32x4*)(bl + 8 * g + 4 * hi), b1_ = *(const LAS f32x4*)(bl + 32 + 8 * g + 4 * hi); \
                _Pragma("unroll") for (int e = 0; e < 4; ++e) { P0[4 * g + e] = b0_[e]; P1[4 * g + e] = b1_[e]; } } } \
        else { const float base_ = alibiA * (float)(kv0_ + 4 * hi); \
            _Pragma("unroll") for (int i = 0; i < 16; ++i) { P0[i] = base_ + alibiA * (float)((i & 3) + 8 * (i >> 2)); P1[i] = P0[i] + alibiA * 32.0f; } } } while (0)
#define DA_MASK(P0, P1, t, mb) do { const int kv0_ = (t) * 64; \
        if (MODE == 2) { const unsigned long long ms_ = (mb) >> (4 * hi); const unsigned lo_ = (unsigned)ms_, hw_ = (unsigned)(ms_ >> 32); \
            _Pragma("unroll") for (int i = 0; i < 16; ++i) { const unsigned bit_ = 1u << ((i & 3) + 8 * (i >> 2)); if (!(lo_ & bit_)) P0[i] = -INFINITY; if (!(hw_ & bit_)) P1[i] = -INFINITY; } } \
        else if (kv0_ + 63 > qw0) { \
            _Pragma("unroll") for (int i = 0; i < 16; ++i) { const int kv_ = kv0_ + crow(i, hi); if (kv_ > tq) P0[i] = -INFINITY; if (kv_ + 32 > tq) P1[i] = -INFINITY; } } } while (0)
#define DA_ROWMAX(MX, P0, P1) do { float a_ = __builtin_fmaxf(__builtin_fmaxf(P0[0], P0[1]), P1[0]), b_ = __builtin_fmaxf(__builtin_fmaxf(P0[2], P0[3]), P1[1]); a_ = __builtin_fmaxf(__builtin_fmaxf(a_, P1[2]), P1[3]); \
        _Pragma("unroll") for (int i = 4; i < 16; i += 4) { a_ = __builtin_fmaxf(__builtin_fmaxf(a_, P0[i]), P0[i + 1]); b_ = __builtin_fmaxf(__builtin_fmaxf(b_, P0[i + 2]), P0[i + 3]); a_ = __builtin_fmaxf(__builtin_fmaxf(a_, P1[i]), P1[i + 1]); b_ = __builtin_fmaxf(__builtin_fmaxf(b_, P1[i + 2]), P1[i + 3]); } \
        a_ = __builtin_fmaxf(a_, b_); const auto rr_ = __builtin_amdgcn_permlane32_swap(__float_as_uint(a_), __float_as_uint(a_), false, false); \
        MX = __builtin_fmaxf(__uint_as_float(rr_[0]), __uint_as_float(rr_[1])); } while (0)
    __syncthreads();
    DA_LOADK(0); DA_LOADV(0); DA_STOREK(0); DA_STOREV(0);
    DA_LOADK(1); DA_STOREK(1);
    DA_LOADK(2); DA_LOADV(1);
    __syncthreads();
    f32x16 pa0, pa1, pb0, pb1;
    unsigned long long mb_nxt = 0ull, mb_nn = 0ull;
    {
        DA_CINIT(pa0, pa1, 0, 0);
        qk_tile<KS>(pa0, pa1, lds + DA_K0, KSTR, qf, r, hi);
        unsigned long long mb0 = 0ull;
        if (MODE == 2) { mb0 = maskbits[(size_t)tq * 128]; if (1 <= tlast) mb_nxt = maskbits[(size_t)tq * 128 + 1]; }
        DA_MASK(pa0, pa1, 0, mb0);
        float mx; DA_ROWMAX(mx, pa0, pa1);
        st.m = __builtin_fmaxf(st.m, mx);
    }
    int ks_next = 1, ks_store = 2, vs_cur = 0;
#define DA_STEP(C0, C1, N0, N1, t) do { \
        if (MODE == 2) { mb_nn = 0ull; if ((t) + 2 <= tlast) mb_nn = maskbits[(size_t)tq * 128 + (t) + 2]; } \
        if ((t) <= tlast) { \
              \
            DA_CINIT(N0, N1, (t) + 1, ks_next); \
            bf16x8 pf0, pf1, pf2, pf3; \
            bf16x8 kf[2 * KS]; { const LAS unsigned char* k_ = lds + DA_K0 + ks_next * ATT_KBUF + kb; \
                _Pragma("unroll") for (int s_ = 0; s_ < KS; ++s_) { kf[2 * s_] = *(const LAS bf16x8*)(k_ + s_ * 32); kf[2 * s_ + 1] = *(const LAS bf16x8*)(k_ + 32 * KSTR + s_ * 32); } } \
            __builtin_amdgcn_sched_barrier(0); \
            _Pragma("unroll") for (int s_ = 0; s_ < KS; ++s_) { N0 = __builtin_amdgcn_mfma_f32_32x32x16_bf16(kf[2 * s_], qf[s_], N0, 0, 0, 0); N1 = __builtin_amdgcn_mfma_f32_32x32x16_bf16(kf[2 * s_ + 1], qf[s_], N1, 0, 0, 0); } \
            sm_exp_pack(st, C0, C1, c2, pf0, pf1, pf2, pf3); \
            _Pragma("unroll") for (int g_ = 0; g_ < 2 * KS; ++g_) { __builtin_amdgcn_sched_group_barrier(0x8, 1, 0); __builtin_amdgcn_sched_group_barrier(0x2, (KS == 6 ? 9 : 14), 0); } \
            __builtin_amdgcn_sched_barrier(0); \
              \
            bf16x8 vf[8]; { const LAS unsigned char* v_ = lds + DA_V0 + vs_cur * ATT_VBUF + vb; \
                _Pragma("unroll") for (int s_ = 0; s_ < 4; ++s_) { vf[2 * s_] = vfrag(v_ + s_ * 1024); vf[2 * s_ + 1] = vfrag(v_ + 4096 + s_ * 1024); } } \
            __builtin_amdgcn_sched_barrier(0); \
            float mx_ = -INFINITY; \
            if ((t) < tlast) { DA_MASK(N0, N1, (t) + 1, mb_nxt); DA_ROWMAX(mx_, N0, N1); } \
            __builtin_amdgcn_sched_barrier(0); \
            st.o0 = __builtin_amdgcn_mfma_f32_32x32x16_bf16(vf[0], pf0, st.o0, 0, 0, 0); st.o1 = __builtin_amdgcn_mfma_f32_32x32x16_bf16(vf[1], pf0, st.o1, 0, 0, 0); \
            st.o0 = __builtin_amdgcn_mfma_f32_32x32x16_bf16(vf[2], pf1, st.o0, 0, 0, 0); st.o1 = __builtin_amdgcn_mfma_f32_32x32x16_bf16(vf[3], pf1, st.o1, 0, 0, 0); \
            st.o0 = __builtin_amdgcn_mfma_f32_32x32x16_bf16(vf[4], pf2, st.o0, 0, 0, 0); st.o1 = __builtin_amdgcn_mfma_f32_32x32x16_bf16(vf[5], pf2, st.o1, 0, 0, 0); \
            st.o0 = __builtin_amdgcn_mfma_f32_32x32x16_bf16(vf[6], pf3, st.o0, 0, 0, 0); st.o1 = __builtin_amdgcn_mfma_f32_32x32x16_bf16(vf[7], pf3, st.o1, 0, 0, 0); \
            __builtin_amdgcn_sched_barrier(0); \
            if (__any((mx_ - st.m) * c2 > SM_THR)) { const float mn_ = __builtin_fmaxf(st.m, mx_); const float al_ = __builtin_amdgcn_exp2f((st.m - mn_) * c2); st.l *= al_; st.o0 *= al_; st.o1 *= al_; st.m = mn_; } \
        } \
        if ((t) + 2 < NT) DA_STOREK(ks_store); \
        if ((t) + 1 < NT) DA_STOREV(vs_cur ^ 1); \
        if ((t) + 3 < NT) DA_LOADK((t) + 3); \
        if ((t) + 2 < NT) DA_LOADV((t) + 2); \
        __syncthreads(); \
        mb_nxt = mb_nn; vs_cur ^= 1; ks_next = (ks_next == 2) ? 0 : ks_next + 1; ks_store = (ks_store == 2) ? 0 : ks_store + 1; } while (0)
    for (int t = 0; t < NT; t += 2) {
        DA_STEP(pa0, pa1, pb0, pb1, t);
        DA_STEP(pb0, pb1, pa0, pa1, t + 1);
    }
#undef DA_LOADK
#undef DA_LOADV
#undef DA_STOREK
#undef DA_STOREV
#undef DA_CINIT
#undef DA_MASK
#undef DA_ROWMAX
#undef DA_STEP
    const float l = swap32_sum(st.l);
    const float inv = l > 0.f ? 1.0f / l : 0.f;
    store_out(O + (size_t)tq * D, st.o0, st.o1, inv, hi);
}

constexpr int DSA_H1 = 0, DSA_H2 = 65536, DSA_INFO = 65536 + 32768;
__device__ __forceinline__ unsigned score_key32(float s) { const unsigned u = __float_as_uint(s); return u ^ ((unsigned)((int)u >> 31) | 0x80000000u); }
__device__ __forceinline__ unsigned score_key16(float s) { return score_key32(s) >> 16; }
__device__ __forceinline__ float relu_f(float x) { const int b_ = __builtin_bit_cast(int, x); return __builtin_bit_cast(float, b_ > 0 ? b_ : 0); }

struct KFrag { bf16x8 a00, a01, a10, a11; };
__device__ __forceinline__ void dsa_kload(KFrag& f, const bf16_t* kix  , int t, int r, int hi) {
    const bf16_t* p = kix + ((size_t)t * 64 + r) * 32 + hi * 8;
    f.a00 = *(const bf16x8*)p; f.a01 = *(const bf16x8*)(p + 16); f.a10 = *(const bf16x8*)(p + 1024); f.a11 = *(const bf16x8*)(p + 1024 + 16);
}
__device__ __forceinline__ void dsa_scores(f32x16& s0, f32x16& s1, const KFrag& f, const bf16x8 (&qi)[4][2], const float (&w)[4]) {
    s0 = (f32x16){}; s1 = (f32x16){};
#pragma unroll
    for (int ih = 0; ih < 4; ++ih) {
        f32x16 a = __builtin_amdgcn_mfma_f32_32x32x16_bf16(f.a00, qi[ih][0], (f32x16){}, 0, 0, 0); a = __builtin_amdgcn_mfma_f32_32x32x16_bf16(f.a01, qi[ih][1], a, 0, 0, 0);
        f32x16 c = __builtin_amdgcn_mfma_f32_32x32x16_bf16(f.a10, qi[ih][0], (f32x16){}, 0, 0, 0); c = __builtin_amdgcn_mfma_f32_32x32x16_bf16(f.a11, qi[ih][1], c, 0, 0, 0);
#pragma unroll
        for (int i = 0; i < 16; ++i) { s0[i] = __builtin_fmaf(w[ih], relu_f(a[i]), s0[i]); s1[i] = __builtin_fmaf(w[ih], relu_f(c[i]), s1[i]); }
    }
}
__device__ __forceinline__ void hist_add(LAS unsigned* hrow, int r, unsigned bin) { atomicAdd((unsigned*)(hrow + ((bin >> 1) ^ (unsigned)r)), 1u << ((bin & 1u) * 16u)); }

__device__ __forceinline__ void dsa_index_unit(LAS unsigned char* lds, const bf16_t* proj, const bf16_t* kidx, const float* side, unsigned long long* maskbits, int b, int qg, int wid0) {
    const int tid = opaque_tid(wid0), lane = tid & 63, wv = __builtin_amdgcn_readfirstlane(tid >> 6), r = lane & 31, hi = lane >> 5;
    const int tq = qg * 32 + r; const size_t rowq = (size_t)b * S + tq;
    const int nt = (qg >> 1) + 1;
    const int per = (nt + 7) >> 3; const int t_lo = wv * per, t_hi = (t_lo + per < nt) ? t_lo + per : nt;
    bf16x8 qi[4][2]; float w[4];
#pragma unroll
    for (int ih = 0; ih < 4; ++ih) { qi[ih][0] = *(const bf16x8*)(proj + rowq * NP + C_IQ + ih * 32 + hi * 8); qi[ih][1] = *(const bf16x8*)(proj + rowq * NP + C_IQ + ih * 32 + 16 + hi * 8);
        w[ih] = side[rowq * 32 + 4 + ih] * 0.5f; }
    LAS unsigned* h1 = (LAS unsigned*)(lds + DSA_H1) + r * 512; LAS unsigned* h2 = (LAS unsigned*)(lds + DSA_H2) + wv * 1024 + r * 32;
    LAS int* info = (LAS int*)(lds + DSA_INFO);
    const bf16_t* kix = kidx + (size_t)b * S * 32;
    const bool sel_all = (qg < 8);
    __syncthreads();
    if (!sel_all) {
        for (int i = tid; i < (DSA_INFO) / 16; i += NTHREADS) ((LAS u32x4*)lds)[i] = (u32x4){0u, 0u, 0u, 0u};
        __syncthreads();
        if (t_lo < t_hi) {
            KFrag cur, nxt; dsa_kload(cur, kix, t_lo, r, hi);
            for (int t = t_lo; t < t_hi; ++t) {
                if (t + 1 < t_hi) dsa_kload(nxt, kix, t + 1, r, hi);
                f32x16 s0, s1; dsa_scores(s0, s1, cur, qi, w);
                const int kv0 = t * 64;
                if (kv0 + 63 <= qg * 32) {
#pragma unroll
                    for (int i = 0; i < 16; ++i) { hist_add(h1, r, score_key32(s0[i]) >> 22); hist_add(h1, r, score_key32(s1[i]) >> 22); }
                } else {
#pragma unroll
                    for (int i = 0; i < 16; ++i) { const int kv = kv0 + crow(i, hi);
                        if (kv <= tq) hist_add(h1, r, score_key32(s0[i]) >> 22);
                        if (kv + 32 <= tq) hist_add(h1, r, score_key32(s1[i]) >> 22); }
                }
                cur = nxt;
            }
        }
        __syncthreads();
        { const int row = tid >> 4, part = tid & 15; const LAS unsigned* hr = (const LAS unsigned*)(lds + DSA_H1) + row * 512; unsigned cs = 0;
#pragma unroll 8
          for (int j = 0; j < 32; ++j) { const unsigned wd = hr[(part * 32 + j) ^ row]; cs += (wd & 0xffffu) + (wd >> 16); }
          unsigned suf = cs;
#pragma unroll
          for (int o = 1; o < 16; o <<= 1) { const unsigned t = __shfl_down(suf, o, 16); if (part + o < 16) suf += t; }
          const unsigned above = suf - cs;
          if (above < 256u && above + cs >= 256u) { unsigned acc = above; int bsel = part * 64; unsigned ab = above;
              for (int j = 31; j >= 0; --j) { const unsigned wd = hr[(part * 32 + j) ^ row]; const unsigned c1 = wd >> 16, c0 = wd & 0xffffu;
                  if (acc + c1 >= 256u) { bsel = part * 64 + 2 * j + 1; ab = acc; break; } acc += c1;
                  if (acc + c0 >= 256u) { bsel = part * 64 + 2 * j; ab = acc; break; } acc += c0; }
              info[row] = bsel; info[32 + row] = 256 - (int)ab; } }
        __syncthreads();
        const unsigned B1 = (unsigned)info[r];
        if (t_lo < t_hi) {
            KFrag cur, nxt; dsa_kload(cur, kix, t_lo, r, hi);
            for (int t = t_lo; t < t_hi; ++t) {
                if (t + 1 < t_hi) dsa_kload(nxt, kix, t + 1, r, hi);
                f32x16 s0, s1; dsa_scores(s0, s1, cur, qi, w);
                const int kv0 = t * 64;
                if (kv0 + 63 <= qg * 32) {
#pragma unroll
                    for (int i = 0; i < 16; ++i) {
                        { const unsigned k = score_key32(s0[i]); const unsigned inc = ((k >> 22) == B1) ? (1u << ((k >> 12) & 16u)) : 0u; atomicAdd((unsigned*)(h2 + (((k >> 17) & 31u) ^ (unsigned)r)), inc); }
                        { const unsigned k = score_key32(s1[i]); const unsigned inc = ((k >> 22) == B1) ? (1u << ((k >> 12) & 16u)) : 0u; atomicAdd((unsigned*)(h2 + (((k >> 17) & 31u) ^ (unsigned)r)), inc); } }
                } else {
#pragma unroll
                    for (int i = 0; i < 16; ++i) { const int kv = kv0 + crow(i, hi);
                        { const unsigned k = score_key32(s0[i]); if (kv <= tq && (k >> 22) == B1) hist_add(h2, r, (k >> 16) & 63u); }
                        { const unsigned k = score_key32(s1[i]); if (kv + 32 <= tq && (k >> 22) == B1) hist_add(h2, r, (k >> 16) & 63u); } }
                }
                cur = nxt;
            }
        }
        __syncthreads();
        { const int row = tid >> 4, part = tid & 15; unsigned cnt[4]; unsigned cs = 0; const unsigned need1 = (unsigned)info[32 + row];
          LAS unsigned* h2a = (LAS unsigned*)(lds + DSA_H2);
#pragma unroll
          for (int j = 0; j < 2; ++j) { unsigned c0 = 0, c1 = 0; const int wi = row * 32 + ((part * 2 + j) ^ row);
#pragma unroll
              for (int ww = 0; ww < 8; ++ww) { const unsigned wd = h2a[ww * 1024 + wi]; c0 += wd & 0xffffu; c1 += wd >> 16; }
              cnt[2 * j] = c0; cnt[2 * j + 1] = c1; cs += c0 + c1; }
          unsigned suf = cs;
#pragma unroll
          for (int o = 1; o < 16; o <<= 1) { const unsigned t = __shfl_down(suf, o, 16); if (part + o < 16) suf += t; }
          const unsigned above = suf - cs;
          if (above < need1 && above + cs >= need1) { unsigned acc = above; int bsel = 0; unsigned ab = above; bool found = false;
#pragma unroll
              for (int j = 3; j >= 0; --j) { if (!found) { if (acc + cnt[j] >= need1) { bsel = part * 4 + j; ab = acc; found = true; } else acc += cnt[j]; } }
              info[64 + row] = (int)(((unsigned)info[row] << 6) | (unsigned)bsel); info[96 + row] = (int)(need1 - ab);
              const int wi = row * 32 + ((bsel >> 1) ^ row); unsigned run = 0;
#pragma unroll
              for (int ww = 0; ww < 8; ++ww) { info[128 + row * 8 + ww] = (int)run; const unsigned wd = h2a[ww * 1024 + wi]; run += (bsel & 1) ? (wd >> 16) : (wd & 0xffffu); } } }
        __syncthreads();
    }
    const unsigned T = sel_all ? 0u : (unsigned)info[64 + r];
    const unsigned need2 = sel_all ? 0x7fffffffu : (unsigned)info[96 + r];
    unsigned tc = sel_all ? 0u : (unsigned)info[128 + r * 8 + wv];
    if (t_lo < t_hi) {
        KFrag cur, nxt; dsa_kload(cur, kix, t_lo, r, hi);
        for (int t = t_lo; t < t_hi; ++t) {
            if (t + 1 < t_hi) dsa_kload(nxt, kix, t + 1, r, hi);
            f32x16 s0, s1; dsa_scores(s0, s1, cur, qi, w);
            const int kv0 = t * 64; unsigned words[2];
#pragma unroll
            for (int half = 0; half < 2; ++half) {
                unsigned gt = 0, eq = 0;
#pragma unroll
                for (int i = 0; i < 16; ++i) { const int kv = kv0 + 32 * half + crow(i, hi); const unsigned k = score_key16(half ? s1[i] : s0[i]);
                    const unsigned v = (kv <= tq) ? 1u : 0u; gt |= ((k > T) ? v : 0u) << i; eq |= ((k == T) ? v : 0u) << i; }
                unsigned sel = gt;
                if (__any(eq != 0u)) {
                    const unsigned a0 = __popc(eq & 0xfu), a1 = __popc(eq & 0xf0u), a2 = __popc(eq & 0xf00u), a3 = __popc(eq & 0xf000u);
                    const unsigned own = a0 | (a1 << 8) | (a2 << 16) | (a3 << 24); const unsigned oth = __shfl_xor(own, 32);
                    const unsigned b0 = oth & 255u, b1 = (oth >> 8) & 255u, b2 = (oth >> 16) & 255u, b3 = oth >> 24;
                    unsigned pre[4]; const unsigned hb = hi ? 1u : 0u;
                    pre[0] = tc + hb * b0; pre[1] = tc + a0 + b0 + hb * b1; pre[2] = tc + a0 + b0 + a1 + b1 + hb * b2; pre[3] = tc + a0 + b0 + a1 + b1 + a2 + b2 + hb * b3;
#pragma unroll
                    for (int g = 0; g < 4; ++g) { unsigned rk = pre[g];
#pragma unroll
                        for (int e = 0; e < 4; ++e) { const unsigned bit = 1u << (4 * g + e); if (eq & bit) { if (rk < need2) sel |= bit; ++rk; } } }
                    tc += a0 + a1 + a2 + a3 + b0 + b1 + b2 + b3;
                }
                unsigned wbits = (sel & 0xfu) | ((sel & 0xf0u) << 4) | ((sel & 0xf00u) << 8) | ((sel & 0xf000u) << 12);
                wbits <<= 4 * hi;
                wbits |= __shfl_xor(wbits, 32);
                words[half] = wbits;
            }
            if (hi == 0) maskbits[(size_t)tq * 128 + t] = (unsigned long long)words[0] | ((unsigned long long)words[1] << 32);
            cur = nxt;
        }
    }
}

constexpr int NSA_IMP = ATT_EXTRA;
constexpr int NSA_SEL = NSA_IMP + 32768;
constexpr int NSA_UNI = NSA_SEL + 1024;
constexpr int NSA_LIST = NSA_UNI + 64;
constexpr int NSA_OT = NSA_LIST + 1024;
static_assert(NSA_OT + 65536 <= LDS_BYTES, "NSA LDS map");

__device__ __forceinline__ void nsa_unit(LAS unsigned char* lds, const bf16_t* proj, const float* side, const bf16_t* kc, const bf16_t* vc, bf16_t* ocat, int b, int q64, int wid0) {
    const int tid = opaque_tid(wid0), lane = tid & 63, wv = __builtin_amdgcn_readfirstlane(tid >> 6), r = lane & 31, hi = lane >> 5;
    const int t0 = q64 * 64, q8 = r >> 2, hd = r & 3, tq = t0 + wv * 8 + q8; const size_t rowq = (size_t)b * S + tq;
    const float c2 = 0.125f * LOG2E;
    const float slope = (hd == 0) ? 0.25f : (hd == 1 ? 0.0625f : (hd == 2 ? 0.015625f : 0.00390625f));
    const float A = 8.0f * slope;
    bf16x8 qf[4];
#pragma unroll
    for (int s = 0; s < 4; ++s) qf[s] = *(const bf16x8*)(proj + rowq * NP + C_NQ + hd * 64 + s * 16 + hi * 8);
    const float g0 = sigmoid_f(side[rowq * 32 + 8 + hd * 3 + 0]), g1 = sigmoid_f(side[rowq * 32 + 8 + hd * 3 + 1]), g2 = sigmoid_f(side[rowq * 32 + 8 + hd * 3 + 2]);
    const int vb = ((lane >> 4) & 1) * 32 + (lane & 3) * 8 + (4 * hi + ((lane & 15) >> 2)) * 64;
    LAS float* imp = (LAS float*)(lds + NSA_IMP) + wv * 1024;
    LAS unsigned* selw = (LAS unsigned*)(lds + NSA_SEL) + wv * 32;
    LAS unsigned* uni = (LAS unsigned*)(lds + NSA_UNI);
    LAS int* list = (LAS int*)(lds + NSA_LIST);
    LAS float* otl = (LAS float*)(lds + NSA_OT) + wv * 2048 + lane;
    StageRegs<64> sr;
    __syncthreads();
    for (int i = lane; i < 1024; i += 64) imp[i] = 0.f;
    if (tid < 4) uni[tid] = 0u;
    const bf16_t* kcb = kc + (size_t)b * 512 * 64; const bf16_t* vcb = vc + (size_t)b * 512 * 64;
    const int ntc = (((t0 + 32) >> 4) >> 6) + 1;
    SoftState st; st.m = NEG_BIG; st.l = 0.f; st.o0 = (f32x16){}; st.o1 = (f32x16){};
    for (int pass = 0; pass < 2; ++pass) {
        stage_load<64>(sr, kcb, 64, vcb, 64, nullptr, 0, wid0);
        __syncthreads();
        stage_store<64>(sr, lds, 0, false, wid0);
        if (1 < ntc) stage_load<64>(sr, kcb, 64, vcb, 64, nullptr, 64, wid0);
        __syncthreads();
        float rl = 0.f;
        if (pass == 1) { const float l = st.l + __shfl_xor(st.l, 32); rl = l > 0.f ? 1.0f / l : 0.f; }
        const float mc = st.m * c2;
        for (int t = 0; t < ntc; ++t) {
            const int buf = t & 1;
            f32x16 p0, p1; const int n0 = t * 64;
            { const float base = A * (float)(16 * (n0 + 4 * hi) + 31);
#pragma unroll
              for (int i = 0; i < 16; ++i) { p0[i] = base + A * 16.0f * (float)((i & 3) + 8 * (i >> 2)); p1[i] = p0[i] + A * 512.0f; } }
            qk_tile<4>(p0, p1, lds + ATT_K0 + buf * ATT_KBUF, KSTR64, qf, r, hi);
#pragma unroll
            for (int i = 0; i < 16; ++i) { const int n = n0 + crow(i, hi); if (16 * n + 31 > tq) p0[i] = -INFINITY; if (16 * (n + 32) + 31 > tq) p1[i] = -INFINITY; }
            if (pass == 0) {
                const float mx = tile_max(p0, p1); const float mn = fmaxf(st.m, mx);
                const float al = __builtin_amdgcn_exp2f((st.m - mn) * c2); st.l *= al; st.m = mn; const float mcc = mn * c2; float sum = 0.f;
#pragma unroll
                for (int i = 0; i < 16; ++i) sum += __builtin_amdgcn_exp2f(__builtin_fmaf(p0[i], c2, -mcc)) + __builtin_amdgcn_exp2f(__builtin_fmaf(p1[i], c2, -mcc));
                st.l += sum;
            } else {
#pragma unroll
                for (int i = 0; i < 16; ++i) { p0[i] = __builtin_amdgcn_exp2f(__builtin_fmaf(p0[i], c2, -mc)) * rl; p1[i] = __builtin_amdgcn_exp2f(__builtin_fmaf(p1[i], c2, -mc)) * rl; }
#pragma unroll
                for (int half = 0; half < 2; ++half)
#pragma unroll
                    for (int g = 0; g < 4; ++g) { const f32x16& pp = half ? p1 : p0;
                        float s4 = (pp[4 * g] + pp[4 * g + 1]) + (pp[4 * g + 2] + pp[4 * g + 3]); float s3 = pp[4 * g + 3];
                        s4 += quad_xor1(s4); s4 += quad_xor2(s4); s3 += quad_xor1(s3); s3 += quad_xor2(s3);
                        const int j1 = 16 * t + 8 * half + 2 * g + hi;
                        if (hd == 0) atomicAdd((float*)(imp + q8 * 128 + j1), s4);
                        if (hd == 0 && j1 + 1 < 128) atomicAdd((float*)(imp + q8 * 128 + j1 + 1), s3); }
                pv_tile(st.o0, st.o1, p0, p1, lds + ATT_V0 + buf * ATT_VBUF, vb);
            }
            if (t + 1 < ntc) stage_store<64>(sr, lds, buf ^ 1, false, wid0);
            if (t + 2 < ntc) stage_load<64>(sr, kcb, 64, vcb, 64, nullptr, (t + 2) * 64, wid0);
            __syncthreads();
        }
    }
#pragma unroll
    for (int i = 0; i < 16; ++i) { otl[i * 64] = st.o0[i] * g0; otl[(16 + i) * 64] = st.o1[i] * g0; }
    {
        const int cur = q64;
        for (int qq = 0; qq < 8; ++qq) {
            float v0 = imp[qq * 128 + lane], v1 = imp[qq * 128 + 64 + lane];
            { const int j0 = lane, j1 = lane + 64;
              if (j0 == 0 || j0 == cur) v0 = INFINITY; else if (j0 > cur) v0 = -INFINITY;
              if (j1 == cur) v1 = INFINITY; else if (j1 > cur) v1 = -INFINITY; }
            int rk0 = 0, rk1 = 0;
#pragma unroll
            for (int i = 0; i < 64; ++i) {
                const float ai = __builtin_bit_cast(float, __builtin_amdgcn_readlane(__builtin_bit_cast(int, v0), i));
                const float bi = __builtin_bit_cast(float, __builtin_amdgcn_readlane(__builtin_bit_cast(int, v1), i));
                rk0 += ((ai > v0) || (ai == v0 && i < lane)) ? 1 : 0;
                rk0 += (bi > v0) ? 1 : 0;
                rk1 += (ai >= v1) ? 1 : 0;
                rk1 += ((bi > v1) || (bi == v1 && i < lane)) ? 1 : 0;
            }
            const unsigned long long slo = __ballot(rk0 < 16 && v0 > -INFINITY), shi = __ballot(rk1 < 16 && v1 > -INFINITY);
            if (lane == 0) { selw[qq * 4 + 0] = (unsigned)slo; selw[qq * 4 + 1] = (unsigned)(slo >> 32); selw[qq * 4 + 2] = (unsigned)shi; selw[qq * 4 + 3] = (unsigned)(shi >> 32);
                atomicOr((unsigned*)(uni + 0), (unsigned)slo); atomicOr((unsigned*)(uni + 1), (unsigned)(slo >> 32)); atomicOr((unsigned*)(uni + 2), (unsigned)shi); atomicOr((unsigned*)(uni + 3), (unsigned)(shi >> 32)); }
        }
    }
    __syncthreads();
    if (tid == 0) { int n = 0; for (int wd = 0; wd < 4; ++wd) { unsigned u = uni[wd]; while (u) { const int j = __ffs(u) - 1; u &= u - 1; list[n++] = wd * 32 + j; } } list[131] = n; }
    __syncthreads();
    {
        const unsigned m0 = selw[q8 * 4 + 0], m1 = selw[q8 * 4 + 1], m2 = selw[q8 * 4 + 2], m3 = selw[q8 * 4 + 3];
        const int nl = list[131];
        const bf16_t* Ks = proj + (size_t)b * S * NP + C_KSEL; const bf16_t* Vs = proj + (size_t)b * S * NP + C_VSEL;
        st.m = NEG_BIG; st.l = 0.f; st.o0 = (f32x16){}; st.o1 = (f32x16){};
        stage_load<64>(sr, Ks, NP, Vs, NP, nullptr, list[0] * 64, wid0);
        stage_store<64>(sr, lds, 0, false, wid0);
        if (1 < nl) stage_load<64>(sr, Ks, NP, Vs, NP, nullptr, list[1] * 64, wid0);
        __syncthreads();
        for (int t = 0; t < nl; ++t) {
            const int buf = t & 1; const int j = list[t];
            const unsigned mw = (j < 32) ? m0 : (j < 64 ? m1 : (j < 96 ? m2 : m3));
            const bool mine = (mw >> (j & 31)) & 1u;
            if (__any(mine)) {
                f32x16 p0, p1; const int kv0 = j * 64;
                { const float base = A * (float)(kv0 + 4 * hi);
#pragma unroll
                  for (int i = 0; i < 16; ++i) { p0[i] = base + A * (float)((i & 3) + 8 * (i >> 2)); p1[i] = p0[i] + A * 32.0f; } }
                qk_tile<4>(p0, p1, lds + ATT_K0 + buf * ATT_KBUF, KSTR64, qf, r, hi);
#pragma unroll
                for (int i = 0; i < 16; ++i) { const int kv = kv0 + crow(i, hi); if (!mine || kv > tq) p0[i] = -INFINITY; if (!mine || kv + 32 > tq) p1[i] = -INFINITY; }
                { bf16x8 f0, f1, f2, f3; softmax_pack(st, p0, p1, c2, f0, f1, f2, f3); pv_frag(st.o0, st.o1, f0, f1, f2, f3, lds + ATT_V0 + buf * ATT_VBUF, vb); }
            }
            if (t + 1 < nl) stage_store<64>(sr, lds, buf ^ 1, false, wid0);
            if (t + 2 < nl) stage_load<64>(sr, Ks, NP, Vs, NP, nullptr, list[t + 2] * 64, wid0);
            __syncthreads();
        }
        const float l = swap32_sum(st.l); const float sc = l > 0.f ? g1 / l : 0.f;
#pragma unroll
        for (int i = 0; i < 16; ++i) { otl[i * 64] += st.o0[i] * sc; otl[(16 + i) * 64] += st.o1[i] * sc; }
    }
    {
        const bf16_t* Kw = proj + (size_t)b * S * NP + C_KWIN; const bf16_t* Vw = proj + (size_t)b * S * NP + C_VWIN;
        const int tw0 = (q64 >= 8) ? q64 - 8 : 0, ntw = q64 - tw0 + 1;
        st.m = NEG_BIG; st.l = 0.f; st.o0 = (f32x16){}; st.o1 = (f32x16){};
        stage_load<64>(sr, Kw, NP, Vw, NP, nullptr, tw0 * 64, wid0);
        stage_store<64>(sr, lds, 0, false, wid0);
        if (1 < ntw) stage_load<64>(sr, Kw, NP, Vw, NP, nullptr, tw0 * 64 + 64, wid0);
        __syncthreads();
        for (int t = 0; t < ntw; ++t) {
            const int buf = t & 1; const int kv0 = (tw0 + t) * 64;
            f32x16 p0, p1;
            { const float base = A * (float)(kv0 + 4 * hi);
#pragma unroll
              for (int i = 0; i < 16; ++i) { p0[i] = base + A * (float)((i & 3) + 8 * (i >> 2)); p1[i] = p0[i] + A * 32.0f; } }
            qk_tile<4>(p0, p1, lds + ATT_K0 + buf * ATT_KBUF, KSTR64, qf, r, hi);
#pragma unroll
            for (int i = 0; i < 16; ++i) { const int kv = kv0 + crow(i, hi); if (kv > tq || kv + 512 <= tq) p0[i] = -INFINITY; if (kv + 32 > tq || kv + 32 + 512 <= tq) p1[i] = -INFINITY; }
            { bf16x8 f0, f1, f2, f3; softmax_pack(st, p0, p1, c2, f0, f1, f2, f3); pv_frag(st.o0, st.o1, f0, f1, f2, f3, lds + ATT_V0 + buf * ATT_VBUF, vb); }
            if (t + 1 < ntw) stage_store<64>(sr, lds, buf ^ 1, false, wid0);
            if (t + 2 < ntw) stage_load<64>(sr, Kw, NP, Vw, NP, nullptr, kv0 + 128, wid0);
            __syncthreads();
        }
        const float l = swap32_sum(st.l); const float sc = l > 0.f ? g2 / l : 0.f;
#pragma unroll
        for (int i = 0; i < 16; ++i) { st.o0[i] = otl[i * 64] + st.o0[i] * sc; st.o1[i] = otl[(16 + i) * 64] + st.o1[i] * sc; }
    }
    store_out(ocat + rowq * D + 768 + hd * 64, st.o0, st.o1, 1.0f, hi);
}

__device__ __forceinline__ void phase_onorm(const bf16_t* ocat, const bf16_t* proj, const float* og, bf16_t* oa, int bid, int G, int wid0) {
    const int tid_ = opaque_tid(wid0); const int lane = tid_ & 63, wv = tid_ >> 6;
    for (int row = bid * 8 + wv; row < M; row += G * 8) {
        const int c = lane * 16;
        const u32x4 a0 = *(const u32x4*)(ocat + (size_t)row * D + c), a1 = *(const u32x4*)(ocat + (size_t)row * D + c + 8);
        const u32x4 z0 = *(const u32x4*)(proj + (size_t)row * NP + C_GZ + c), z1 = *(const u32x4*)(proj + (size_t)row * NP + C_GZ + c + 8);
        float v[16], z[16]; float s = 0.f;
#pragma unroll
        for (int e = 0; e < 4; ++e) { v[2 * e] = bflo(a0[e]); v[2 * e + 1] = bfhi(a0[e]); v[8 + 2 * e] = bflo(a1[e]); v[8 + 2 * e + 1] = bfhi(a1[e]);
            z[2 * e] = bflo(z0[e]); z[2 * e + 1] = bfhi(z0[e]); z[8 + 2 * e] = bflo(z1[e]); z[8 + 2 * e + 1] = bfhi(z1[e]); }
#pragma unroll
        for (int e = 0; e < 16; ++e) s += v[e] * v[e];
        s += __builtin_bit_cast(float, __builtin_amdgcn_update_dpp(0, __builtin_bit_cast(int, s), 0xB1, 0xf, 0xf, false));
        s += __builtin_bit_cast(float, __builtin_amdgcn_update_dpp(0, __builtin_bit_cast(int, s), 0x4E, 0xf, 0xf, false));
        s += __builtin_bit_cast(float, __builtin_amdgcn_update_dpp(0, __builtin_bit_cast(int, s), 0x141, 0xf, 0xf, false));
        s += __builtin_bit_cast(float, __builtin_amdgcn_update_dpp(0, __builtin_bit_cast(int, s), 0x140, 0xf, 0xf, false));
        const float rstd = 1.0f / sqrtf(s * (1.f / 256.f) + EPS);
        float y[16];
#pragma unroll
        for (int e = 0; e < 16; ++e) y[e] = v[e] * rstd * og[c + e] * silu_f(z[e]);
        u32x4 w0, w1;
#pragma unroll
        for (int e = 0; e < 4; ++e) { w0[e] = pk2(y[2 * e], y[2 * e + 1]); w1[e] = pk2(y[8 + 2 * e], y[8 + 2 * e + 1]); }
        *(u32x4*)(oa + (size_t)row * D + c) = w0; *(u32x4*)(oa + (size_t)row * D + c + 8) = w1;
    }
}
__device__ __forceinline__ void phase_final(float* out, const float* g, int bid, int G, int wid0) {
    const int tid_ = opaque_tid(wid0); const int lane = tid_ & 63, wv = tid_ >> 6;
    for (int row = bid * 8 + wv; row < M; row += G * 8) {
        f32x4* xr = (f32x4*)(out + (size_t)row * D) + lane;
        f32x4 v[4]; float s = 0.f;
#pragma unroll
        for (int j = 0; j < 4; ++j) { v[j] = xr[64 * j]; s += (v[j][0] * v[j][0] + v[j][1] * v[j][1]) + (v[j][2] * v[j][2] + v[j][3] * v[j][3]); }
        const float rstd = 1.0f / sqrtf(wave_sum(s) * (1.f / D) + EPS);
#pragma unroll
        for (int j = 0; j < 4; ++j) { const f32x4 gg = *(const f32x4*)(g + (64 * j + lane) * 4); xr[64 * j] = v[j] * rstd * gg; }
    }
}

#define XB_TMO      128
#define XB_XCNT(j)  (256  + 64 * (j))
#define XB_XSUB(j)  (1280 + 64 * (j))
#define XB_XGEN(j)  (2304 + 64 * (j))
#define XB_TOP      3328
#define XB_TOPGEN   3392
#define XCD_BAR_WORDS 3456
#define XB_SPIN_CAP (1u << 22)
__device__ __forceinline__ unsigned xb_ld(unsigned* p)              { return __hip_atomic_load(p, __ATOMIC_RELAXED, __HIP_MEMORY_SCOPE_AGENT); }
__device__ __forceinline__ unsigned xb_add(unsigned* p, unsigned v) { return __hip_atomic_fetch_add(p, v, __ATOMIC_RELAXED, __HIP_MEMORY_SCOPE_AGENT); }
__device__ __forceinline__ unsigned xb_xcc_id() { return (unsigned)__builtin_amdgcn_s_getreg((3 << 11) | 20) & 0xFu; }
#define XB_SPIN(cond, bar) do { unsigned _sp = 0; while (cond) { __builtin_amdgcn_s_sleep(1); \
    if ((++_sp & 255u) == 0u) { if (xb_ld(&(bar)[XB_TMO])) break; if (_sp > XB_SPIN_CAP) { atomicAdd(&(bar)[XB_TMO], 1u); break; } } } } while (0)
__device__ __forceinline__ void xcd_barrier_complete(unsigned* bar, unsigned x, unsigned G, unsigned& nloc, unsigned& nx) {
    unsigned sum, cnt, mine, sp = 0u;
    for (;;) {
        sum = 0u; cnt = 0u; mine = 0u;
#pragma unroll
        for (unsigned j = 0; j < 16; ++j) { const unsigned c = xb_ld(&bar[XB_XCNT(j)]); sum += c; cnt += (c > 0u) ? 1u : 0u; mine = (j == x) ? c : mine; }
        if (sum == G) break;
        __builtin_amdgcn_s_sleep(1);
        if ((++sp & 255u) == 0u) { if (xb_ld(&bar[XB_TMO])) break; if (sp > XB_SPIN_CAP) { atomicAdd(&bar[XB_TMO], 1u); break; } }
    }
    nloc = mine > 0u ? mine : 1u; nx = cnt > 0u ? cnt : 1u;
}
__device__ __forceinline__ void grid_bar(unsigned* bar, volatile LAS unsigned* st, unsigned G, int wid0) {
    const int tid = opaque_tid(wid0);
    asm volatile("s_waitcnt vmcnt(0)" ::: "memory");
    __syncthreads();
    if (tid == 0) {
        const unsigned x = xb_xcc_id();
        unsigned nloc = st[0], nx = st[1];
        if (nloc == 0u) { xcd_barrier_complete(bar, x, G, nloc, nx); st[0] = nloc; st[1] = nx; }
        const unsigned old = xb_add(&bar[XB_XSUB(x)], 1u);
        const unsigned gen = old / nloc;
        if (old + 1u == (gen + 1u) * nloc) {
            __builtin_amdgcn_fence(__ATOMIC_RELEASE, "agent");
            asm volatile("s_waitcnt vmcnt(0)" ::: "memory");
            const unsigned og = xb_add(&bar[XB_TOP], 1u);
            const unsigned tg = og / nx;
            if (og + 1u == (tg + 1u) * nx) xb_add(&bar[XB_TOPGEN], 1u);
            else XB_SPIN(xb_ld(&bar[XB_TOPGEN]) == tg, bar);
            __builtin_amdgcn_fence(__ATOMIC_ACQUIRE, "agent");
            xb_add(&bar[XB_XGEN(x)], 1u);
            asm volatile("s_waitcnt vmcnt(0)" ::: "memory");
        } else {
            XB_SPIN(xb_ld(&bar[XB_XGEN(x)]) == gen, bar);
            __builtin_amdgcn_fence(__ATOMIC_ACQUIRE, "agent");
            asm volatile("s_waitcnt vmcnt(0)" ::: "memory");
        }
    }
    __syncthreads();
}

constexpr int N_PHASES = 16;
__global__ void __launch_bounds__(NTHREADS) hymba_fwd(Params P) {
    extern __shared__ __attribute__((aligned(16))) unsigned char lds_raw[];
    LAS unsigned char* lds = (LAS unsigned char*)lds_raw;
    const int bid = blockIdx.x, G = gridDim.x;
    const int wid0 = __builtin_amdgcn_readfirstlane((int)(threadIdx.x >> 6));
    volatile LAS unsigned* xst = (volatile LAS unsigned*)(lds + LDS_BYTES - 16);
    unsigned* xbar = (unsigned*)(P.ws + WS_CTL) + 4096 + P.bar_region * XCD_BAR_WORDS;
    if (threadIdx.x == 0) { xst[0] = 0u; xst[1] = 0u; (void)xb_add(&xbar[XB_XCNT(xb_xcc_id())], 1u); }
    __syncthreads();
    unsigned char* ws = P.ws;
    bf16_t* proj = (bf16_t*)(ws + WS_PROJ); float* side = (float*)(ws + WS_SIDE);
    bf16_t* hbuf = (bf16_t*)(ws + WS_H); bf16_t* ocat = (bf16_t*)(ws + WS_OCAT);
#define PH(k) (P.ph_lo <= (k) && (k) < P.ph_hi)
#define SYNC(k) do { if (PH(k) && PH((k) + 1)) grid_bar(xbar, xst, (unsigned)G, wid0); } while (0)
    if (PH(0)) phase_prologue(P, lds, bid, G, wid0);
    if (PH(0) && PH(1)) cg::this_grid().sync();
#ifndef ATT_REP
#define ATT_REP 0
#endif
#ifndef PROBE_VAR
#define PROBE_VAR -1
#endif
#define LAYER(l, base) do { \
    const float* mod = (const float*)(ws + WS_MOD) + (size_t)(l) * 4 * 3072; \
    const float* xin = ((l) == 0) ? P.in[0] : P.out; \
    if (PH((base) + 0)) phase_hnorm(xin, P.in[2] + (l) * D, mod, hbuf, bid, G, wid0); \
    SYNC((base) + 0); \
    if (PH((base) + 1)) { pg8::Gemm g{hbuf, (const bf16_t*)(ws + WS_WIN) + (size_t)(l) * NP * D, M, NP, D, D, D}; pg8::StaticOrder so; so.init(M, NP, G, bid); \
        pg8::EpiProj E{proj, side}; pg8::gemm_phase<pg8::EpiProj, true>(lds, g, so, E, wid0); } \
    SYNC((base) + 1); \
    if (PH((base) + 2)) phase_prep(P, (l), lds, bid, G, wid0); \
    SYNC((base) + 2); \
    if (PH((base) + 3)) { \
        { pg8::Gemm g{proj + C_QLAT, (const bf16_t*)(ws + WS_WUQ) + (size_t)(l) * 512 * 256, M, 512, 256, NP, 256}; pg8::StaticOrder so; so.init(M, 512, G, bid); \
          pg8::EpiQup E{(bf16_t*)(ws + WS_QMLA), (const float*)(ws + WS_RSTD), (const float*)(ws + WS_ROPE)}; pg8::gemm_phase<pg8::EpiQup, true>(lds, g, so, E, wid0); } \
        { pg8::Gemm g{proj + C_KVLAT, (const bf16_t*)(ws + WS_WUKV) + (size_t)(l) * 512 * 128, M, 512, 128, NP, 128}; pg8::StaticOrder so; so.init(M, 512, G, bid); \
          pg8::EpiKVup E{(bf16_t*)(ws + WS_KMLA), (bf16_t*)(ws + WS_VMLA), (const float*)(ws + WS_RSTD)}; pg8::gemm_phase<pg8::EpiKVup, true>(lds, g, so, E, wid0); } \
        for (int k = 0; k * G < 1024; ++k) { const int u = (k & 1) ? (k + 1) * G - 1 - bid : k * G + bid; if (u >= 1024 || u < 0) continue; const int qg = 255 - (u >> 2), b = u & 3; \
            dsa_index_unit(lds, proj, (const bf16_t*)(ws + WS_KIDX), side, (unsigned long long*)(ws + WS_MASK) + (size_t)b * S * 128, b, qg, wid0); } } \
    SYNC((base) + 3); \
    if (PH((base) + 4)) { const int vb_ = (G % 8 == 0) ? (bid & 7) * (G >> 3) + (bid >> 3) : bid;     \
        for (int i = vb_; i < 512; i += G) { const int ii = i & 255, bh = ii >> 4, qb = (i < 256) ? (ii & 15) : 31 - (ii & 15), b = bh >> 2, hd = bh & 3; const size_t rb = (size_t)b * S; \
            dense_unit<96, 0>(lds, (const bf16_t*)(ws + WS_QMLA) + rb * 384 + hd * 96, 384, (const bf16_t*)(ws + WS_KMLA) + rb * 384 + hd * 96, 384, \
                              (const bf16_t*)(ws + WS_VMLA) + rb * 256 + hd * 64, 256, ocat + rb * D + hd * 64, nullptr, nullptr, 0.f, 0.10206207261596577f * LOG2E, qb, wid0); } \
        for (int rep = 0; rep < (((ATT_REP & 2) && (l) == 0) ? 2 : 1); ++rep) for (int i = vb_; i < 512; i += G) { const int ii = i & 255, bh = ii >> 4, qb = (i < 256) ? (ii & 15) : 31 - (ii & 15), b = bh >> 2, hd = bh & 3; const size_t rb = (size_t)b * S; \
            dense_unit<64, 1>(lds, proj + rb * NP + C_FQ + hd * 64, NP, proj + rb * NP + C_FK + hd * 64, NP, proj + rb * NP + C_FV + hd * 64, NP, \
                              ocat + rb * D + 256 + hd * 64, (const float*)(ws + WS_FB) + (size_t)bh * S, nullptr, 0.f, 0.125f * LOG2E, qb, wid0); } \
        for (int rep = 0; rep < (((ATT_REP & 4) && (l) == 0) ? 2 : 1); ++rep) for (int i = vb_; i < 512; i += G) { const int ii = i & 255, bh = ii >> 4, qb = (i < 256) ? (ii & 15) : 31 - (ii & 15), b = bh >> 2, hd = bh & 3; const size_t rb = (size_t)b * S; \
            const float slope = (hd == 0) ? 0.25f : (hd == 1 ? 0.0625f : (hd == 2 ? 0.015625f : 0.00390625f)); \
            dense_unit<64, 2>(lds, proj + rb * NP + C_DQ + hd * 64, NP, proj + rb * NP + C_DK + hd * 64, NP, proj + rb * NP + C_DV + hd * 64, NP, \
                              ocat + rb * D + 512 + hd * 64, nullptr, (const unsigned long long*)(ws + WS_MASK) + rb * 128, 8.0f * slope, 0.125f * LOG2E, qb, wid0); } \
        for (int rep = 0; rep < (((ATT_REP & 8) && (l) == 0) ? 2 : 1); ++rep) for (int u = vb_; u < 512; u += G) { const int b = u >> 7, q64 = u & 127; \
            nsa_unit(lds, proj, side, (const bf16_t*)(ws + WS_KC), (const bf16_t*)(ws + WS_VC), ocat, b, q64, wid0); } } \
    SYNC((base) + 4); \
    if (PH((base) + 5)) phase_onorm(ocat, proj, P.in[14] + (l) * D, hbuf, bid, G, wid0); \
    SYNC((base) + 5); \
    if (PH((base) + 6)) { pg8::Gemm g{hbuf, (const bf16_t*)(ws + WS_WOUT) + (size_t)(l) * D * D, M, D, D, D, D}; pg8::StaticOrder so; so.init(M, D, G, bid); \
        pg8::EpiOut E{xin, P.out, mod + 2048}; pg8::gemm_phase<pg8::EpiOut, true>(lds, g, so, E, wid0); } \
    SYNC((base) + 6); \
} while (0)
    LAYER(0, 1);
    LAYER(1, 8);
    if (PH(15)) phase_final(P.out, P.in[16], bid, G, wid0);
#undef LAYER
#undef PH
#undef SYNC
}


#ifdef DBG_GROUP
#ifndef DBG_LAYER
#define DBG_LAYER 1
#endif
__device__ __forceinline__ float dbg_bf(const bf16_t* p) { return bf2f(*p); }
__device__ const int dbg_rows[48] = {0, 1, 2, 15, 30, 31, 32, 47, 63, 64, 65, 127, 128, 200, 255, 256, 257, 300, 511, 512, 513, 700, 1000, 1023, 1024, 1025, 1500, 2047, 2048, 3000, 3333, 4095, 4096, 4500, 5000, 5555, 6143, 6144, 7000, 7777, 8000, 8100, 8127, 8128, 8160, 8190, 8191, 4242};
template <class ScoreFn, class VFn>
__device__ __forceinline__ float dbg_attn(int k_lo, int k_hi, ScoreFn score, VFn vload, int lane) {
    float m = -INFINITY, l = 0.f, acc = 0.f;
    for (int kv = k_lo; kv <= k_hi; ++kv) {
        const float sc = score(kv);
        if (sc == -INFINITY) continue;
        const float mn = fmaxf(m, sc); const float al = (m == -INFINITY) ? 0.f : __expf(m - mn); const float p = __expf(sc - mn);
        l = l * al + p; acc = acc * al + p * vload(kv, lane); m = mn;
    }
    return l > 0.f ? acc / l : 0.f;
}
__global__ void __launch_bounds__(64) dbg_check(Params P) {
    const int lane = threadIdx.x, wid = blockIdx.x; const int hd = wid & 3, ri = (wid >> 2) % 48, b = (wid >> 2) / 48; const int t = dbg_rows[ri];
    unsigned char* ws = P.ws; const bf16_t* proj = (const bf16_t*)(ws + WS_PROJ); const float* side = (const float*)(ws + WS_SIDE);
    const bf16_t* ocat = (const bf16_t*)(ws + WS_OCAT); const size_t rowq = (size_t)b * S + t; const size_t rb = (size_t)b * S;
    float* scratch = (float*)(ws + WS_H) + (size_t)wid * 16384;
    float ref = 0.f; int grp = DBG_GROUP % 10;
    const float slope = (hd == 0) ? 0.25f : (hd == 1 ? 0.0625f : (hd == 2 ? 0.015625f : 0.00390625f));
    if (grp == 0) {
        const bf16_t* q = (const bf16_t*)(ws + WS_QMLA) + rowq * 384 + hd * 96; const bf16_t* K = (const bf16_t*)(ws + WS_KMLA) + rb * 384 + hd * 96; const bf16_t* V = (const bf16_t*)(ws + WS_VMLA) + rb * 256 + hd * 64;
        const float q0 = dbg_bf(q + lane), q1 = lane < 32 ? dbg_bf(q + 64 + lane) : 0.f;
        ref = dbg_attn(0, t, [&](int kv) { float pr = q0 * dbg_bf(K + (size_t)kv * 384 + lane) + (lane < 32 ? q1 * dbg_bf(K + (size_t)kv * 384 + 64 + lane) : 0.f); return wave_sum(pr) * 0.10206207261596577f; },
                       [&](int kv, int d) { return dbg_bf(V + (size_t)kv * 256 + d); }, lane);
    } else if (grp == 1) {
        const bf16_t* q = proj + rowq * NP + C_FQ + hd * 64; const bf16_t* K = proj + rb * NP + C_FK + hd * 64; const bf16_t* V = proj + rb * NP + C_FV + hd * 64; const float* fb = (const float*)(ws + WS_FB) + (size_t)(b * 4 + hd) * S;
        const float q0 = dbg_bf(q + lane); const float ft = fb[t];
        ref = dbg_attn(0, t, [&](int kv) { return wave_sum(q0 * dbg_bf(K + (size_t)kv * NP + lane)) * 0.125f + (fb[kv] - ft) * 0.125f; },
                       [&](int kv, int d) { return dbg_bf(V + (size_t)kv * NP + d); }, lane);
    } else if (grp == 2) {
        float* sc = scratch; unsigned char* selb = (unsigned char*)(scratch + 8192);
        const int ih = lane >> 4, dd = (lane & 15) * 2;
        const float qa = dbg_bf(proj + rowq * NP + C_IQ + ih * 32 + dd), qb2 = dbg_bf(proj + rowq * NP + C_IQ + ih * 32 + dd + 1); const float wgt = side[rowq * 32 + 4 + ih] * 0.5f;
        for (int kv = 0; kv <= t; ++kv) { float pr = qa * dbg_bf(proj + (rb + kv) * NP + C_IK + dd) + qb2 * dbg_bf(proj + (rb + kv) * NP + C_IK + dd + 1);
            pr += __shfl_xor(pr, 1); pr += __shfl_xor(pr, 2); pr += __shfl_xor(pr, 4); pr += __shfl_xor(pr, 8);
            float v = wgt * fmaxf(pr, 0.f); v += __shfl_xor(v, 16); v += __shfl_xor(v, 32); if (lane == 0) sc[kv] = v; }
        __threadfence_block();
        if (t + 1 <= 256) { for (int kv = lane; kv <= t; kv += 64) selb[kv] = 1; }
        else {
#ifdef DBG_KEY32
#define DBGKEY(x) ({ const unsigned u_ = __float_as_uint(x); (u_ & 0x80000000u) ? ~u_ : (u_ | 0x80000000u); })
            unsigned lo = 0, hi2 = 0xffffffffu;
#else
#define DBGKEY(x) score_key16(x)
            unsigned lo = 0, hi2 = 0xffffu;
#endif
            while (lo < hi2) { const unsigned mid = lo + ((hi2 - lo) >> 1) + ((hi2 - lo) & 1u); int c = 0; for (int kv = lane; kv <= t; kv += 64) c += (DBGKEY(sc[kv]) >= mid); c = (int)wave_sum((float)c); if (c >= 256) lo = mid; else hi2 = mid - 1; }
            const unsigned T = lo; int cgt = 0; for (int kv = lane; kv <= t; kv += 64) cgt += (DBGKEY(sc[kv]) > T); cgt = (int)wave_sum((float)cgt);
            int need = 256 - cgt; int run = 0;
            for (int k0 = 0; k0 <= t; k0 += 64) { const int kv = k0 + lane; const unsigned k = kv <= t ? DBGKEY(sc[kv]) : 0u; const bool eq = kv <= t && k == T, gt = kv <= t && k > T;
                const unsigned long long bm = __ballot(eq); const int before = __popcll(bm & ((1ull << lane) - 1ull));
                if (kv <= t) selb[kv] = (gt || (eq && run + before < need)) ? 1 : 0; run += __popcll(bm); }
        }
        __threadfence_block();
        const bf16_t* q = proj + rowq * NP + C_DQ + hd * 64; const bf16_t* K = proj + rb * NP + C_DK + hd * 64; const bf16_t* V = proj + rb * NP + C_DV + hd * 64; const float q0 = dbg_bf(q + lane);
        ref = dbg_attn(0, t, [&](int kv) { if (!selb[kv]) return -INFINITY; return wave_sum(q0 * dbg_bf(K + (size_t)kv * NP + lane)) * 0.125f - slope * (float)(t - kv); },
                       [&](int kv, int d) { return dbg_bf(V + (size_t)kv * NP + d); }, lane);
    } else {
        const int sub = DBG_GROUP / 10;
        const bf16_t* q = proj + rowq * NP + C_NQ; const float q0 = dbg_bf(q + hd * 64 + lane);
        const bf16_t* kc = (const bf16_t*)(ws + WS_KC) + (size_t)b * 512 * 64; const bf16_t* vc = (const bf16_t*)(ws + WS_VC) + (size_t)b * 512 * 64;
        float* pc = scratch;
        for (int h2 = 0; h2 < 4; ++h2) { const float qh = dbg_bf(q + h2 * 64 + lane); const float sl = (h2 == 0) ? 0.25f : (h2 == 1 ? 0.0625f : (h2 == 2 ? 0.015625f : 0.00390625f));
            float m = -INFINITY; for (int n = 0; n < 511; ++n) { if (16 * n + 31 > t) break; const float s_ = wave_sum(qh * dbg_bf(kc + n * 64 + lane)) * 0.125f - sl * (float)(t - (16 * n + 31)); if (lane == 0) pc[h2 * 512 + n] = s_; m = fmaxf(m, s_); }
            __threadfence_block(); float l = 0.f; for (int n = 0; n < 511 && 16 * n + 31 <= t; ++n) l += __expf(pc[h2 * 512 + n] - m);
            __threadfence_block(); for (int n = lane; n < 511; n += 64) pc[h2 * 512 + n] = (16 * n + 31 <= t) ? __expf(pc[h2 * 512 + n] - m) / l : 0.f; __threadfence_block(); }
        float oc = 0.f; for (int n = 0; n < 511 && 16 * n + 31 <= t; ++n) oc += pc[hd * 512 + n] * dbg_bf(vc + n * 64 + lane);
        const int cur = t >> 6; float v0, v1;
        { float i0 = 0.f, i1 = 0.f; for (int h2 = 0; h2 < 4; ++h2) for (int e = -1; e <= 3; ++e) { int n0 = 4 * lane + e, n1 = 4 * (lane + 64) + e; if (n0 >= 0 && n0 < 511) i0 += pc[h2 * 512 + n0]; if (n1 < 511) i1 += pc[h2 * 512 + n1]; }
          v0 = (lane == 0 || lane == cur) ? INFINITY : (lane > cur ? -INFINITY : i0); v1 = (lane + 64 == cur) ? INFINITY : (lane + 64 > cur ? -INFINITY : i1); }
        unsigned long long slo = 0, shi = 0;
        for (int it = 0; it < 16; ++it) { float mx = fmaxf(v0, v1); for (int o = 1; o < 64; o <<= 1) mx = fmaxf(mx, __shfl_xor(mx, o)); if (!(mx > -INFINITY)) break;
            const unsigned long long b0 = __ballot(v0 == mx), b1 = __ballot(v1 == mx);
            if (b0) { const int j = __ffsll((long long)b0) - 1; slo |= 1ull << j; if (lane == j) v0 = -INFINITY; } else { const int j = __ffsll((long long)b1) - 1; shi |= 1ull << j; if (lane == j) v1 = -INFINITY; } }
        const bf16_t* Ks = proj + rb * NP + C_KSEL; const bf16_t* Vs = proj + rb * NP + C_VSEL; const bf16_t* Kw = proj + rb * NP + C_KWIN; const bf16_t* Vw = proj + rb * NP + C_VWIN;
        const float os = dbg_attn(0, t, [&](int kv) { const int j = kv >> 6; const bool in = j < 64 ? ((slo >> j) & 1ull) : ((shi >> (j - 64)) & 1ull); if (!in) return -INFINITY;
                                      return wave_sum(q0 * dbg_bf(Ks + (size_t)kv * NP + lane)) * 0.125f - slope * (float)(t - kv); }, [&](int kv, int d) { return dbg_bf(Vs + (size_t)kv * NP + d); }, lane);
        const float ow = dbg_attn(t - 511 > 0 ? t - 511 : 0, t, [&](int kv) { return wave_sum(q0 * dbg_bf(Kw + (size_t)kv * NP + lane)) * 0.125f - slope * (float)(t - kv); }, [&](int kv, int d) { return dbg_bf(Vw + (size_t)kv * NP + d); }, lane);
        const float g0 = sigmoid_f(side[rowq * 32 + 8 + hd * 3]), g1 = sigmoid_f(side[rowq * 32 + 8 + hd * 3 + 1]), g2 = sigmoid_f(side[rowq * 32 + 8 + hd * 3 + 2]);
        ref = g0 * oc + g1 * os + g2 * ow;
        (void)sub;
    }
    const float got = dbg_bf(ocat + rowq * D + grp * 256 + hd * 64 + lane);
    const float d2 = wave_sum((got - ref) * (got - ref)), r2 = wave_sum(ref * ref);
    float* acc = (float*)(ws + WS_CTL + 8192);
    if (lane == 0) { atomicAdd(acc, d2); atomicAdd(acc + 1, r2); }
}

__device__ __forceinline__ void dbg_sincos(double ang, float& cs, float& sn) {
    const double twopi = 6.283185307179586476925; double r = ang - twopi * __builtin_floor(ang / twopi + 0.5);
    const double r2 = r * r; double sterm = r, cterm = 1.0, ssum = r, csum = 1.0;
    for (int k = 1; k <= 14; ++k) { cterm *= -r2 / (double)((2 * k - 1) * (2 * k)); sterm *= -r2 / (double)((2 * k) * (2 * k + 1)); csum += cterm; ssum += sterm; }
    cs = (float)csum; sn = (float)ssum;
}
__device__ __forceinline__ int dbg_mapwin(int n) { return MapWin{}(n); }
#define DBG_ACC(got, ref) do { const float g_ = (got), r_ = (ref); d2 += (g_ - r_) * (g_ - r_); r2 += r_ * r_; } while (0)
__global__ void __launch_bounds__(64) dbg_check2(Params P) {
    const int lane = threadIdx.x, wid = blockIdx.x; const int ri = wid % 48, b = wid / 48; const int t = dbg_rows[ri];
    unsigned char* ws = P.ws; const bf16_t* proj = (const bf16_t*)(ws + WS_PROJ); const float* side = (const float*)(ws + WS_SIDE);
    const size_t rowq = (size_t)b * S + t; const int l = DBG_LAYER;
    float d2 = 0.f, r2 = 0.f;
    const int grp = DBG_GROUP;
    if (grp == 4) {
        if (wid < 16 && lane == 0) { const int hd = wid & 3, bb = wid >> 2; double run = 0.0; const float* fb = (const float*)(ws + WS_FB) + (size_t)wid * S; const float bf = P.in[10][l * 4 + hd];
            for (int tt = 0; tt < S; ++tt) { const double v = (double)side[((size_t)bb * S + tt) * 32 + hd] + (double)bf; const double y = (v < 0 ? v : 0.0) - log1p(exp(-fabs(v))); run += y; DBG_ACC(fb[tt], (float)(-8.0 * run)); } }
    } else if (grp == 5) {
        float ss = 0.f; for (int k = lane; k < 192; k += 64) { const float v = dbg_bf(proj + rowq * NP + k); ss += v * v; } ss = wave_sum(ss); const float rs = 1.0f / sqrtf(ss / 192.f + EPS);
        const float* wq = P.in[7] + (size_t)l * 192 * 384; const float* gq = P.in[6] + l * 192; const bf16_t* qm = (const bf16_t*)(ws + WS_QMLA) + rowq * 384;
        for (int o = lane; o < 384; o += 64) { float a = 0.f; for (int k = 0; k < 192; ++k) a += dbg_bf(proj + rowq * NP + k) * rs * gq[k] * wq[(size_t)k * 384 + o]; ((float*)(ws + WS_H))[(size_t)wid * 512 + o] = a; }
        __threadfence_block();
        const float* qv = (const float*)(ws + WS_H) + (size_t)wid * 512;
        for (int hd = 0; hd < 4; ++hd) { { const int w = lane; DBG_ACC(dbg_bf(qm + hd * 96 + w), qv[hd * 96 + w]); }
            if (lane < 16) { const int i = lane; const float invf = (float)pow(10000.0, -(double)i / 16.0); float cs, sn; dbg_sincos((double)((float)t * invf), cs, sn);
                const float x1 = qv[hd * 96 + 64 + i], x2 = qv[hd * 96 + 80 + i]; DBG_ACC(dbg_bf(qm + hd * 96 + 64 + 2 * i), x1 * cs - x2 * sn); DBG_ACC(dbg_bf(qm + hd * 96 + 64 + 2 * i + 1), x1 * sn + x2 * cs); } }
    } else if (grp == 6) {
        float ss = 0.f; for (int k = lane; k < 128; k += 64) { const float v = dbg_bf(proj + rowq * NP + C_KVLAT + k); ss += v * v; } ss = wave_sum(ss); const float rs = 1.0f / sqrtf(ss / 128.f + EPS);
        const float* wk = P.in[9] + (size_t)l * 128 * 512; const float* gk = P.in[8] + l * 128; const bf16_t* km = (const bf16_t*)(ws + WS_KMLA) + rowq * 384; const bf16_t* vm = (const bf16_t*)(ws + WS_VMLA) + rowq * 256;
        for (int o = lane; o < 512; o += 64) { float a = 0.f; for (int k = 0; k < 128; ++k) a += dbg_bf(proj + rowq * NP + C_KVLAT + k) * rs * gk[k] * wk[(size_t)k * 512 + o];
            const int hd = o >> 7, w = o & 127; if (w < 64) DBG_ACC(dbg_bf(km + hd * 96 + w), a); else DBG_ACC(dbg_bf(vm + hd * 64 + w - 64), a); }
        if (lane < 16) { const int i = lane; const float invf = (float)pow(10000.0, -(double)i / 16.0); float cs, sn; dbg_sincos((double)((float)t * invf), cs, sn);
            const float x1 = dbg_bf(proj + rowq * NP + C_KROPE + i), x2 = dbg_bf(proj + rowq * NP + C_KROPE + 16 + i);
            for (int hd = 0; hd < 4; ++hd) { DBG_ACC(dbg_bf(km + hd * 96 + 64 + 2 * i), x1 * cs - x2 * sn); DBG_ACC(dbg_bf(km + hd * 96 + 64 + 2 * i + 1), x1 * sn + x2 * cs); } }
    } else if (grp == 7) {
        const int n = (t >> 4) > 510 ? 510 : (t >> 4);
        for (int kv = 0; kv < 2; ++kv) { const float* w1 = P.in[12] + (size_t)(l * 2 + kv) * 2048 * 64; const float* w2 = P.in[13] + (size_t)(l * 2 + kv) * 64 * 64; const float* pe = P.in[11] + (size_t)(l * 2 + kv) * 2048;
            float a = 0.f; for (int k = 0; k < 2048; ++k) { const int j = k >> 6, d = k & 63; a += (dbg_bf(proj + ((size_t)b * S + 16 * n + j) * NP + (kv ? C_VCMP : C_KCMP) + d) + pe[k]) * w1[(size_t)k * 64 + lane]; }
            const float hv = silu_f(a); float o = 0.f; for (int k = 0; k < 64; ++k) o += __shfl(hv, k) * w2[k * 64 + lane];
            DBG_ACC(dbg_bf((const bf16_t*)(ws + (kv ? WS_VC : WS_KC)) + ((size_t)b * 512 + n) * 64 + lane), o); }
    } else if (grp == 8) {
        const float* c = P.in[1]; const float* mod = (const float*)(ws + WS_MOD);
        for (int idx = wid * 64 + lane; idx < 2 * 4 * 3072; idx += gridDim.x * 64) { const int ll = idx / (4 * 3072), bb = (idx / 3072) & 3, n = idx % 3072; float a = P.in[4][ll * 3072 + n];
            for (int k = 0; k < 1024; ++k) a += silu_f(c[bb * 1024 + k]) * P.in[3][((size_t)ll * 1024 + k) * 3072 + n]; DBG_ACC(mod[idx], a); }
    } else if (grp == 9) {
        const float* x = P.in[0] + rowq * D; const float* mod = (const float*)(ws + WS_MOD) + (size_t)(l * 4 + b) * 3072; float* hrow = (float*)(ws + WS_H) + (size_t)wid * 1024;
        float ss = 0.f; for (int k = lane; k < D; k += 64) ss += x[k] * x[k]; ss = wave_sum(ss); const float rs = 1.0f / sqrtf(ss / D + EPS);
        for (int k = lane; k < D; k += 64) hrow[k] = x[k] * rs * P.in[2][l * D + k] * (1.0f + mod[1024 + k]) + mod[k];
        __threadfence_block();
        const float* w = P.in[5] + (size_t)l * D * 3732;
        for (int n = lane; n < 3732; n += 64) { const int oc = dbg_mapwin(n); float a = 0.f; for (int k = 0; k < D; ++k) a += hrow[k] * w[(size_t)k * 3732 + oc];
            DBG_ACC(dbg_bf(proj + rowq * NP + n), a); if (n >= C_SIDE) DBG_ACC(side[rowq * 32 + n - C_SIDE], a); }
    } else if (grp == 10) {
        const bf16_t* oc = (const bf16_t*)(ws + WS_OCAT) + rowq * D; const bf16_t* oa = (const bf16_t*)(ws + WS_H) + rowq * D;
        for (int g = 0; g < 4; ++g) { float ss = 0.f; for (int k = lane; k < 256; k += 64) { const float v = dbg_bf(oc + g * 256 + k); ss += v * v; } ss = wave_sum(ss); const float rs = 1.0f / sqrtf(ss / 256.f + EPS);
            for (int k = lane; k < 256; k += 64) { const int cc = g * 256 + k; DBG_ACC(dbg_bf(oa + cc), dbg_bf(oc + cc) * rs * P.in[14][l * D + cc] * silu_f(dbg_bf(proj + rowq * NP + C_GZ + cc))); } }
    } else if (grp == 11) {
        const bf16_t* oa = (const bf16_t*)(ws + WS_H) + rowq * D; const float* mod = (const float*)(ws + WS_MOD) + (size_t)(l * 4 + b) * 3072; const float* w = P.in[15] + (size_t)l * D * D;
        for (int n = lane; n < D; n += 64) { float a = 0.f; for (int k = 0; k < D; ++k) a += dbg_bf(oa + k) * w[(size_t)k * D + n]; DBG_ACC(P.out[rowq * D + n], P.in[0][rowq * D + n] + mod[2048 + n] * a); }
    }
    d2 = wave_sum(d2); r2 = wave_sum(r2);
    float* acc = (float*)(ws + WS_CTL + 8192);
    if (lane == 0) { atomicAdd(acc, d2); atomicAdd(acc + 1, r2); }
}
__global__ void dbg_scale(Params P) {
    const float* acc = (const float*)(P.ws + WS_CTL + 8192);
    float v = sqrtf(acc[0] / fmaxf(acc[1], 1e-30f)); v = fminf(fmaxf(v, 1e-4f), 1.0f);
    const float code = 0.1f * powf(100.0f, (log10f(v) + 4.0f) * 0.25f); const float delta = sqrtf(code);
    for (size_t i = (size_t)blockIdx.x * blockDim.x + threadIdx.x; i < (size_t)M * D; i += (size_t)gridDim.x * blockDim.x) P.out[i] *= (1.0f + delta);
}
#endif

#ifndef N_CUTS
#define N_CUTS 1
#endif
extern "C" void kernel_launch(void* const* d_in, const int* in_sizes, int n_in, void* d_out, int out_size, void* d_ws, size_t ws_size, hipStream_t stream) {
    static int grid = 0;
    if (grid == 0) {
        if (n_in != 17 || out_size != M * D || ws_size < WS_END) { fprintf(stderr, "kernel_launch: unexpected problem (n_in %d out %d ws %zu need %zu)\n", n_in, out_size, ws_size, (size_t)WS_END); grid = -1; return; }
        int dev = 0, cus = 0, per_cu = 0;
        hipGetDevice(&dev); hipDeviceGetAttribute(&cus, hipDeviceAttributeMultiprocessorCount, dev);
        hipFuncSetAttribute((const void*)hymba_fwd, hipFuncAttributeMaxDynamicSharedMemorySize, LDS_BYTES);
        hipOccupancyMaxActiveBlocksPerMultiprocessor(&per_cu, (const void*)hymba_fwd, NTHREADS, LDS_BYTES);
        if (per_cu < 1) { fprintf(stderr, "kernel_launch: occupancy query says %d blocks/CU\n", per_cu); grid = -1; return; }
        grid = cus;
    }
    if (grid < 0) return;
    (void)hipMemsetAsync((char*)d_ws + WS_CTL, 0, 131072, stream);
    Params p{};
    for (int i = 0; i < 17; ++i) p.in[i] = (const float*)d_in[i];
    p.out = (float*)d_out; p.ws = (unsigned char*)d_ws;
#if defined(DBG_GROUP)
    auto run = [&](int lo, int hi) { p.ph_lo = lo; p.ph_hi = hi; p.bar_region = (lo == 0) ? 0 : 1; void* args[] = {&p};
        hipError_t e = hipLaunchCooperativeKernel((const void*)hymba_fwd, dim3(grid), dim3(NTHREADS), args, LDS_BYTES, stream);
        if (e != hipSuccess) fprintf(stderr, "cooperative launch failed: %s (grid %d)\n", hipGetErrorString(e), grid); };
    auto check = [&]() { if (DBG_GROUP % 10 >= 4 || (DBG_GROUP >= 10 && DBG_GROUP < 13)) hipLaunchKernelGGL(dbg_check2, dim3(4 * 48), dim3(64), 0, stream, p);
                         else hipLaunchKernelGGL(dbg_check, dim3(4 * 48 * 4), dim3(64), 0, stream, p); };
    if (DBG_LAYER == 0) { run(0, 8); check(); run(8, 16); } else { run(0, 16); check(); }
    hipLaunchKernelGGL(dbg_scale, dim3(1024), dim3(256), 0, stream, p);
#elif defined(REPEAT_PHASE)
    { const int bounds[3][2] = {{0, REPEAT_PHASE + 1}, {REPEAT_PHASE, N_PHASES}, {0, 0}};
      for (int c = 0; c < 2; ++c) { p.ph_lo = bounds[c][0]; p.ph_hi = bounds[c][1]; p.bar_region = c; void* args[] = {&p};
        hipError_t e = hipLaunchCooperativeKernel((const void*)hymba_fwd, dim3(grid), dim3(NTHREADS), args, LDS_BYTES, stream);
        if (e != hipSuccess) { fprintf(stderr, "cooperative launch failed: %s (grid %d)\n", hipGetErrorString(e), grid); return; } } }
#else
    const int cuts = N_CUTS;
    for (int c = 0; c < cuts; ++c) {
        p.ph_lo = (N_PHASES * c) / cuts; p.ph_hi = (N_PHASES * (c + 1)) / cuts; p.bar_region = c;
        void* args[] = {&p};
        hipError_t e = hipLaunchCooperativeKernel((const void*)hymba_fwd, dim3(grid), dim3(NTHREADS), args, LDS_BYTES, stream);
        if (e != hipSuccess) { fprintf(stderr, "cooperative launch failed: %s (grid %d)\n", hipGetErrorString(e), grid); return; }
    }
#endif
}
```

```cpp
#include <hip/hip_runtime.h>
#include <hip/hip_cooperative_groups.h>
#include <cstdio>
#include <cstdint>
namespace cg = cooperative_groups;

#define LAS __attribute__((address_space(3)))
typedef unsigned short bf16_t;
typedef short bf16x8 __attribute__((ext_vector_type(8)));
typedef short s16x4 __attribute__((ext_vector_type(4)));
typedef float f32x2 __attribute__((ext_vector_type(2)));
typedef float f32x4 __attribute__((ext_vector_type(4)));
typedef float f32x16 __attribute__((ext_vector_type(16)));
typedef unsigned u32x2 __attribute__((ext_vector_type(2)));
typedef unsigned u32x4 __attribute__((ext_vector_type(4)));
typedef __bf16 bf16x2_t __attribute__((ext_vector_type(2)));

constexpr int NB = 4, S = 8192, D = 1024, M = NB * S, NP = 3840, DEPTH = 2;
constexpr int C_QLAT = 0, C_KVLAT = 192, C_KROPE = 320, C_FQ = 352, C_FK = 608, C_FV = 864, C_DQ = 1120, C_DK = 1376, C_DV = 1632,
              C_IQ = 1888, C_IK = 2016, C_NQ = 2048, C_KCMP = 2304, C_VCMP = 2368, C_KSEL = 2432, C_VSEL = 2496, C_KWIN = 2560,
              C_VWIN = 2624, C_GZ = 2688, C_SIDE = 3712;
constexpr float EPS = 1e-6f;
constexpr float LOG2E = 1.4426950408889634f;
constexpr int NTHREADS = 512;
constexpr int LDS_BYTES = 155648;

constexpr size_t MiB = 1u << 20;
constexpr size_t WS_CTL = 0;
constexpr size_t WS_WIN = 1 * MiB;
constexpr size_t WS_WOUT = 16 * MiB;
constexpr size_t WS_WUQ = 20 * MiB;
constexpr size_t WS_WUKV = 20 * MiB + 512 * 1024;
constexpr size_t WS_W1T = 21 * MiB;
constexpr size_t WS_CVEC = 22 * MiB;
constexpr size_t WS_MOD = 22 * MiB + 4096;
constexpr size_t WS_ROPE = 23 * MiB;
constexpr size_t WS_RSTD = 24 * MiB;
constexpr size_t WS_FB = 24 * MiB + 512 * 1024;
constexpr size_t WS_KC = 25 * MiB;
constexpr size_t WS_VC = 25 * MiB + 512 * 1024;
constexpr size_t WS_SIDE = 26 * MiB;
constexpr size_t WS_H = 30 * MiB;
constexpr size_t WS_QMLA = 94 * MiB;
constexpr size_t WS_KMLA = 118 * MiB;
constexpr size_t WS_VMLA = 142 * MiB;
constexpr size_t WS_MASK = 158 * MiB;
constexpr size_t WS_OCAT = 190 * MiB;
constexpr size_t WS_PROJ = 254 * MiB;
constexpr size_t WS_KIDX = ((WS_PROJ + (size_t)(M + 64) * NP * 2 + MiB - 1) / MiB) * MiB;
constexpr size_t WS_SSQ = WS_KIDX + 2 * MiB;
constexpr size_t WS_END = WS_SSQ + 2 * MiB;

struct Params {
    const float* in[17];
    float* out;
    unsigned char* ws;
    int ph_lo, ph_hi, bar_region, pad;
};

__device__ __forceinline__ unsigned pk2(float lo, float hi) { f32x2 v = {lo, hi}; bf16x2_t b = __builtin_convertvector(v, bf16x2_t); return __builtin_bit_cast(unsigned, b); }
__device__ __forceinline__ float bf2f(unsigned short b) { return __uint_as_float(((unsigned)b) << 16); }
__device__ __forceinline__ float bflo(unsigned u) { return __uint_as_float(u << 16); }
__device__ __forceinline__ float bfhi(unsigned u) { return __uint_as_float(u & 0xffff0000u); }
__device__ __forceinline__ float wave_sum(float v) {
    v += __builtin_bit_cast(float, __builtin_amdgcn_update_dpp(0, __builtin_bit_cast(int, v), 0xB1, 0xf, 0xf, false));
    v += __builtin_bit_cast(float, __builtin_amdgcn_update_dpp(0, __builtin_bit_cast(int, v), 0x4E, 0xf, 0xf, false));
    v += __builtin_bit_cast(float, __builtin_amdgcn_update_dpp(0, __builtin_bit_cast(int, v), 0x141, 0xf, 0xf, false));
    v += __builtin_bit_cast(float, __builtin_amdgcn_update_dpp(0, __builtin_bit_cast(int, v), 0x140, 0xf, 0xf, false));
    const float r0 = __builtin_bit_cast(float, __builtin_amdgcn_readlane(__builtin_bit_cast(int, v), 0)), r1 = __builtin_bit_cast(float, __builtin_amdgcn_readlane(__builtin_bit_cast(int, v), 16));
    const float r2 = __builtin_bit_cast(float, __builtin_amdgcn_readlane(__builtin_bit_cast(int, v), 32)), r3 = __builtin_bit_cast(float, __builtin_amdgcn_readlane(__builtin_bit_cast(int, v), 48));
    return (r0 + r1) + (r2 + r3);
}
__device__ __forceinline__ float silu_f(float x) { return x / (1.0f + __expf(-x)); }
__device__ __forceinline__ float sigmoid_f(float x) { return 1.0f / (1.0f + __expf(-x)); }
__device__ __forceinline__ float silu_fast(float x) { return x * __builtin_amdgcn_rcpf(1.0f + __expf(-x)); }
__device__ __forceinline__ int crow(int r, int hi) { return (r & 3) + 8 * (r >> 2) + 4 * hi; }
__device__ __forceinline__ int opaque_tid(int wid0) { int t; asm volatile("v_mbcnt_lo_u32_b32 %0, -1, 0\n\tv_mbcnt_hi_u32_b32 %0, -1, %0\n\tv_lshl_add_u32 %0, %1, 6, %0" : "=&v"(t) : "s"(wid0)); return t; }

namespace pg8 {
constexpr int BM = 256, BK = 64, HALF = 128, HTB = HALF * BK * 2, STAGE_BYTES = 8 * HTB, NXCD = 8, WGM = 8;
__host__ __device__ __forceinline__ int lds_byte(int r, int c) { const int st = (r >> 4) * 2 + (c >> 5), rr = r & 15, cc = c & 31, ob = rr * 64 + cc * 2; return st * 1024 + (ob ^ (((ob >> 9) & 1) << 5)); }
__host__ __device__ __forceinline__ void stage_rc(int b, int& R, int& C) { const int st = b / 1024, sb = b % 1024, swz = sb ^ (((sb >> 9) & 1) << 5); R = (st >> 1) * 16 + swz / 64; C = (st & 1) * 32 + (swz % 64) / 2; }
__host__ __device__ __forceinline__ int perm32(int rho) { const int n = rho >> 4, i = rho & 15; return 8 * (i >> 2) + 4 * n + (i & 3); }
struct Unit { int pm, pn; };
struct Gemm { const bf16_t* A; const bf16_t* Bt; int M, N, K, lda, ldb; };
struct StaticOrder {
    int nM, nN, nwg, G, c;
    __device__ void init(int M_, int N_, int G_, int c_) { nM = M_ / BM; nN = N_ / BM; nwg = nM * nN; G = G_; c = c_; }
    __device__ bool next(int i, Unit& u) const {
        const long L = (long)i * G + c; if (L >= nwg) return false;
        int wgid = (int)L; { const int q = nwg / NXCD, r = nwg % NXCD, xcd = wgid % NXCD, off = wgid / NXCD; wgid = (xcd < r ? xcd * (q + 1) : r * (q + 1) + (xcd - r) * q) + off; }
        const int nig = WGM * nN, gid = wgid / nig, fm = gid * WGM, gsz = (nM - fm) < WGM ? (nM - fm) : WGM;
        u.pm = fm + ((wgid % nig) % gsz); u.pn = (wgid % nig) / gsz; return true;
    }
};

template <class Epi, bool ALIGN_EPI>
__device__ __forceinline__ void gemm_phase(LAS unsigned char* lds, const Gemm g, const StaticOrder& S_, const Epi& E, int wid0) {
    const int tid = opaque_tid(wid0), wid = __builtin_amdgcn_readfirstlane(tid >> 6), lane = tid & 63, wr = wid >> 2, wc = wid & 3, fr = lane & 15, fq = lane >> 4;
    const int K = g.K, nt = K / BK;
    unsigned voffA[2], voffB[2];
#pragma unroll
    for (int i = 0; i < 2; ++i) { int R, C; stage_rc(tid * 16 + i * 8192, R, C); const int Rb = ((R & ~31) + perm32(R & 31));
        voffA[i] = (unsigned)(R * g.lda + C) * 2u; voffB[i] = (unsigned)(Rb * g.ldb + C) * 2u; }
    const size_t kstep = (size_t)(BK * 2);
    const size_t hstepA = (size_t)HALF * g.lda * 2, hstepB = (size_t)HALF * g.ldb * 2;
    const size_t tstepA = 2 * hstepA, tstepB = 2 * hstepB;
    const unsigned ldsw = (unsigned)wid * 1024u;
    const int aoff = lds_byte(wr * 64 + fr, fq * 8), boff = lds_byte(wc * 32 + fr, fq * 8);
#define PG8_SA(b, h) (((b) * 2 + (h)) * HTB)
#define PG8_SB(b, h) ((4 + (b) * 2 + (h)) * HTB)
#define PG8_STAGE(bufoff, gbase, voff) do { _Pragma("unroll") for (int _i = 0; _i < 2; ++_i) \
        __builtin_amdgcn_global_load_lds((const unsigned*)((const char*)(gbase) + (voff)[_i]), (LAS unsigned*)(lds + (bufoff) + ldsw + _i * 8192), 16, 0, 0); } while (0)
#define PG8_LDA(dst, b, h) do { _Pragma("unroll") for (int m = 0; m < 4; ++m) _Pragma("unroll") for (int k = 0; k < 2; ++k) dst[m][k] = *(const LAS bf16x8*)(lds + PG8_SA(b, h) + aoff + m * 2048 + k * 1024); } while (0)
#define PG8_LDB(dst, b, h) do { _Pragma("unroll") for (int n = 0; n < 2; ++n) _Pragma("unroll") for (int k = 0; k < 2; ++k) dst[n][k] = *(const LAS bf16x8*)(lds + PG8_SB(b, h) + boff + n * 2048 + k * 1024); } while (0)
#define PG8_MMA(ai, bj, At, Bt) do { __builtin_amdgcn_s_setprio(1); _Pragma("unroll") for (int m = 0; m < 4; ++m) _Pragma("unroll") for (int n = 0; n < 2; ++n) _Pragma("unroll") for (int k = 0; k < 2; ++k) \
        acc[ai][bj][m][n] = __builtin_amdgcn_mfma_f32_16x16x32_bf16(Bt[n][k], At[m][k], acc[ai][bj][m][n], 0, 0, 0); __builtin_amdgcn_s_setprio(0); } while (0)
#define PG8_WAIT_V(n) asm volatile("s_waitcnt vmcnt(" #n ")" ::: "memory")
#define PG8_WAIT_L(n) asm volatile("s_waitcnt lgkmcnt(" #n ")" ::: "memory")
#define PG8_BAR __builtin_amdgcn_s_barrier()
#define PG8_SCHED __builtin_amdgcn_sched_barrier(0)
    Unit cur, nxt; int ui = 0;
    if (!S_.next(0, cur)) return;
    LAS float* const gtab = (LAS float*)(lds + STAGE_BYTES);
    if constexpr (Epi::GROUPSCALE) E.fill(gtab, cur.pm, tid);
    f32x4 acc[2][2][4][2];
#pragma unroll
    for (int a = 0; a < 2; ++a)
#pragma unroll
        for (int b = 0; b < 2; ++b)
#pragma unroll
            for (int m = 0; m < 4; ++m)
#pragma unroll
                for (int n = 0; n < 2; ++n) acc[a][b][m][n] = (f32x4){0.f, 0.f, 0.f, 0.f};
    bf16x8 At[4][2], B0[2][2], B1[2][2];
    const char* cA = (const char*)g.A + (size_t)cur.pm * tstepA; const char* cB = (const char*)g.Bt + (size_t)cur.pn * tstepB;
    PG8_STAGE(PG8_SB(0, 0), cB, voffB); PG8_STAGE(PG8_SB(0, 1), cB + hstepB, voffB); PG8_STAGE(PG8_SA(0, 0), cA, voffA); PG8_STAGE(PG8_SA(0, 1), cA + hstepA, voffA);
    if (wr == 1) PG8_BAR;
    PG8_WAIT_V(2); PG8_BAR;
    PG8_STAGE(PG8_SB(1, 0), cB + kstep, voffB); PG8_STAGE(PG8_SA(1, 0), cA + kstep, voffA); PG8_STAGE(PG8_SB(1, 1), cB + hstepB + kstep, voffB);
    PG8_WAIT_V(6); PG8_BAR;
    for (;;) {
        const bool has_next = S_.next(ui + 1, nxt);
        const char* nA = has_next ? (const char*)g.A + (size_t)nxt.pm * tstepA : cA; const char* nB = has_next ? (const char*)g.Bt + (size_t)nxt.pn * tstepB : cB;
        if constexpr (Epi::GROUPSCALE) { if (has_next) E.fill(gtab + ((ui + 1) & 1) * 1024, nxt.pm, tid); }
        for (int t = 0; t < nt; t += 2) {
            if constexpr (Epi::GROUPSCALE) {
                int tq = t; asm volatile("" : "+s"(tq));
                if (tq != 0 && (tq & 3) == 0) {
                    const LAS float* tb = gtab + (ui & 1) * 1024 + ((tq >> 2) - 1);
#pragma unroll
                    for (int a = 0; a < 2; ++a)
#pragma unroll
                        for (int m = 0; m < 4; ++m) { const float r = tb[(a * HALF + wr * 64 + m * 16 + fr) * 4];
#pragma unroll
                            for (int b = 0; b < 2; ++b)
#pragma unroll
                                for (int n = 0; n < 2; ++n) acc[a][b][m][n] = acc[a][b][m][n] * r; }
                }
            }
            const bool last = (t == nt - 2);
            const char* a1 = cA + (size_t)(t + 1) * kstep;
            const char* a2 = last ? nA : cA + (size_t)(t + 2) * kstep; const char* b2 = last ? nB : cB + (size_t)(t + 2) * kstep;
            const char* a3 = a2 + kstep; const char* b3 = b2 + kstep;
            PG8_LDB(B0, 0, 0); PG8_LDB(B1, 0, 1); PG8_SCHED; PG8_LDA(At, 0, 0); PG8_STAGE(PG8_SA(1, 1), a1 + hstepA, voffA);
            PG8_WAIT_V(8); PG8_WAIT_L(0); PG8_BAR; PG8_MMA(0, 0, At, B0); PG8_MMA(0, 1, At, B1); PG8_BAR; PG8_SCHED;
            PG8_LDA(At, 0, 1); PG8_STAGE(PG8_SB(0, 0), b2, voffB); PG8_STAGE(PG8_SB(0, 1), b2 + hstepB, voffB); PG8_STAGE(PG8_SA(0, 0), a2, voffA);
            PG8_WAIT_V(8); PG8_WAIT_L(0); PG8_BAR; PG8_MMA(1, 0, At, B0); PG8_MMA(1, 1, At, B1); PG8_BAR; PG8_SCHED;
            PG8_LDB(B0, 1, 0); PG8_LDB(B1, 1, 1); PG8_SCHED; PG8_LDA(At, 1, 0); PG8_STAGE(PG8_SA(0, 1), a2 + hstepA, voffA);
            PG8_WAIT_V(8); PG8_WAIT_L(0); PG8_BAR; PG8_MMA(0, 0, At, B0); PG8_MMA(0, 1, At, B1); PG8_BAR; PG8_SCHED;
            PG8_LDA(At, 1, 1); PG8_STAGE(PG8_SB(1, 0), b3, voffB); PG8_STAGE(PG8_SB(1, 1), b3 + hstepB, voffB); PG8_STAGE(PG8_SA(1, 0), a3, voffA);
            PG8_WAIT_V(8); PG8_WAIT_L(0); PG8_BAR; PG8_MMA(1, 0, At, B0); PG8_MMA(1, 1, At, B1); PG8_BAR; PG8_SCHED;
        }
        if constexpr (ALIGN_EPI) { if (wr == 0) PG8_BAR; }
        if constexpr (Epi::GROUPSCALE) E(acc, cur, wr, wc, fr, fq, gtab + (ui & 1) * 1024); else E(acc, cur, wr, wc, fr, fq);
        if (!has_next) break;
#pragma unroll
        for (int a = 0; a < 2; ++a)
#pragma unroll
            for (int b = 0; b < 2; ++b)
#pragma unroll
                for (int m = 0; m < 4; ++m)
#pragma unroll
                    for (int n = 0; n < 2; ++n) acc[a][b][m][n] = (f32x4){0.f, 0.f, 0.f, 0.f};
        cur = nxt; cA = nA; cB = nB; ++ui;
        if constexpr (ALIGN_EPI) { if (wr == 1) PG8_BAR; }
    }
    PG8_WAIT_V(0);
    if constexpr (!ALIGN_EPI) { if (wr == 0) PG8_BAR; }
    PG8_BAR;
#undef PG8_SA
#undef PG8_SB
#undef PG8_STAGE
#undef PG8_LDA
#undef PG8_LDB
#undef PG8_MMA
#undef PG8_WAIT_V
#undef PG8_WAIT_L
#undef PG8_BAR
#undef PG8_SCHED
}

struct EpiProj {
    static constexpr bool GROUPSCALE = false;
    bf16_t* proj; float* side;
    __device__ __forceinline__ void operator()(const f32x4 (&acc)[2][2][4][2], const Unit& u, int wr, int wc, int fr, int fq) const {
        const int row0 = u.pm * BM + wr * 64 + fr, col0 = u.pn * BM + wc * 32 + 8 * fq;
#pragma unroll
        for (int ai = 0; ai < 2; ++ai)
#pragma unroll
            for (int m = 0; m < 4; ++m) { const int row = row0 + ai * HALF + m * 16; bf16_t* rowp = proj + (size_t)row * NP + col0;
#pragma unroll
                for (int bj = 0; bj < 2; ++bj) { const f32x4 v0 = acc[ai][bj][m][0], v1 = acc[ai][bj][m][1];
                    u32x4 w; w.x = pk2(v0[0], v0[1]); w.y = pk2(v0[2], v0[3]); w.z = pk2(v1[0], v1[1]); w.w = pk2(v1[2], v1[3]);
                    *(u32x4*)(rowp + bj * HALF) = w;
                    if (bj == 1 && u.pn == 14 && wc == 0) { float* sp = side + (size_t)row * 32 + 8 * fq; *(f32x4*)sp = v0; *(f32x4*)(sp + 4) = v1; } } }
    }
};
struct EpiQup {
    static constexpr bool GROUPSCALE = false;
    bf16_t* q; const float* rstd; const float* rope;
    __device__ __forceinline__ void operator()(const f32x4 (&acc)[2][2][4][2], const Unit& u, int wr, int wc, int fr, int fq) const {
        const int row0 = u.pm * BM + wr * 64 + fr;
#pragma unroll
        for (int ai = 0; ai < 2; ++ai)
#pragma unroll
            for (int m = 0; m < 4; ++m) { const int row = row0 + ai * HALF + m * 16; const float rs = rstd[(size_t)row * 2]; const int pos = row & (S - 1);
#pragma unroll
                for (int bj = 0; bj < 2; ++bj) { const int c = u.pn * BM + bj * HALF + wc * 32 + 8 * fq;
                    if (c < 384) { const int w0 = c % 96;
                        f32x4 v0 = acc[ai][bj][m][0] * rs, v1 = acc[ai][bj][m][1] * rs;
                        if (w0 >= 64) { const int i0 = (w0 - 64) >> 1; const float* tp = rope + ((size_t)pos * 16 + i0) * 2;
                            const f32x4 t0 = *(const f32x4*)tp, t1 = *(const f32x4*)(tp + 4);
                            f32x4 a, b;
                            a[0] = v0[0] * t0[0] - v0[1] * t0[1]; a[1] = v0[0] * t0[1] + v0[1] * t0[0];
                            a[2] = v0[2] * t0[2] - v0[3] * t0[3]; a[3] = v0[2] * t0[3] + v0[3] * t0[2];
                            b[0] = v1[0] * t1[0] - v1[1] * t1[1]; b[1] = v1[0] * t1[1] + v1[1] * t1[0];
                            b[2] = v1[2] * t1[2] - v1[3] * t1[3]; b[3] = v1[2] * t1[3] + v1[3] * t1[2];
                            v0 = a; v1 = b; }
                        u32x4 w; w.x = pk2(v0[0], v0[1]); w.y = pk2(v0[2], v0[3]); w.z = pk2(v1[0], v1[1]); w.w = pk2(v1[2], v1[3]);
                        *(u32x4*)(q + (size_t)row * 384 + c) = w; } }
                asm volatile("" ::: "memory"); }
    }
};
struct EpiKVup {
    static constexpr bool GROUPSCALE = false;
    bf16_t* k; bf16_t* v; const float* rstd;
    __device__ __forceinline__ void operator()(const f32x4 (&acc)[2][2][4][2], const Unit& u, int wr, int wc, int fr, int fq) const {
        const int row0 = u.pm * BM + wr * 64 + fr;
#pragma unroll
        for (int ai = 0; ai < 2; ++ai)
#pragma unroll
            for (int m = 0; m < 4; ++m) { const int row = row0 + ai * HALF + m * 16; const float rs = rstd[(size_t)row * 2 + 1];
#pragma unroll
                for (int bj = 0; bj < 2; ++bj) { const int c = u.pn * BM + bj * HALF + wc * 32 + 8 * fq; const int hd = c >> 7, w0 = c & 127;
                    const f32x4 v0 = acc[ai][bj][m][0] * rs, v1 = acc[ai][bj][m][1] * rs;
                    u32x4 w; w.x = pk2(v0[0], v0[1]); w.y = pk2(v0[2], v0[3]); w.z = pk2(v1[0], v1[1]); w.w = pk2(v1[2], v1[3]);
                    bf16_t* dst = (w0 < 64) ? (k + (size_t)row * 384 + hd * 96 + w0) : (v + (size_t)row * 256 + hd * 64 + (w0 - 64));
                    *(u32x4*)dst = w; }
                asm volatile("" ::: "memory"); }
    }
};
struct EpiOut {
    static constexpr bool GROUPSCALE = true;
    const float* res; float* out; const float* gate;
    const float* ssq;
    __device__ __forceinline__ void fill(LAS float* tab, int pm, int tid) const {
        if (tid < 256) { const f32x4* sp = (const f32x4*)(ssq + (size_t)(pm * BM + tid) * 16); const f32x4 a = sp[0], b = sp[1], c = sp[2], d = sp[3];
            const float q0 = (a[0] + a[1]) + (a[2] + a[3]), q1 = (b[0] + b[1]) + (b[2] + b[3]), q2 = (c[0] + c[1]) + (c[2] + c[3]), q3 = (d[0] + d[1]) + (d[2] + d[3]);
            const float m0 = q0 * (1.f / 256.f) + EPS, m1 = q1 * (1.f / 256.f) + EPS, m2 = q2 * (1.f / 256.f) + EPS, m3 = q3 * (1.f / 256.f) + EPS;
            f32x4 w; w[0] = sqrtf(m1 / m0); w[1] = sqrtf(m2 / m1); w[2] = sqrtf(m3 / m2); w[3] = 1.0f / sqrtf(m3);
            *(LAS f32x4*)(tab + tid * 4) = w; }
    }
    __device__ __forceinline__ void operator()(const f32x4 (&acc)[2][2][4][2], const Unit& u, int wr, int wc, int fr, int fq, const LAS float* tab) const {
        const int row0 = u.pm * BM + wr * 64 + fr; const int b = (u.pm * BM) / S;
        float s3[2][4];
#pragma unroll
        for (int ai = 0; ai < 2; ++ai)
#pragma unroll
            for (int m = 0; m < 4; ++m) s3[ai][m] = tab[(ai * HALF + wr * 64 + m * 16 + fr) * 4 + 3];
#pragma unroll
        for (int bj = 0; bj < 2; ++bj) { const int c = u.pn * BM + bj * HALF + wc * 32 + 8 * fq;
            const f32x4 g0 = *(const f32x4*)(gate + (size_t)b * 3072 + c), g1 = *(const f32x4*)(gate + (size_t)b * 3072 + c + 4);
#pragma unroll
            for (int ai = 0; ai < 2; ++ai)
#pragma unroll
                for (int m = 0; m < 4; ++m) { const int row = row0 + ai * HALF + m * 16; const size_t off = (size_t)row * D + c;
                    const f32x4 r0 = *(const f32x4*)(res + off), r1 = *(const f32x4*)(res + off + 4);
                    *(f32x4*)(out + off) = r0 + (g0 * s3[ai][m]) * acc[ai][bj][m][0]; *(f32x4*)(out + off + 4) = r1 + (g1 * s3[ai][m]) * acc[ai][bj][m][1]; } }
    }
};
}

struct MapWin { __device__ __forceinline__ int operator()(int n) const {
    if (n < 1120) return n; if (n < 2048) return n + 4; if (n < 2688) return n + 8; if (n < 3712) return n + 20;
    if (n < 3716) return 1120 + (n - 3712); if (n < 3720) return 2052 + (n - 3716); if (n < 3732) return 2696 + (n - 3720); return -1; } };
struct MapId { int N; __device__ __forceinline__ int operator()(int n) const { return n < N ? n : -1; } };
struct MapUq { __device__ __forceinline__ int operator()(int n) const { if (n >= 384) return -1; const int hd = n / 96, w = n % 96; if (w < 64) return hd * 96 + w;
    const int p = (w - 64) >> 1, which = (w - 64) & 1; return hd * 96 + 64 + (which ? 16 + p : p); } };

template <class ColMap>
__device__ __forceinline__ void tr_tile(const float* src, int lds_src, int Ksrc, const float* kscale, bf16_t* dst, int ldd, int n0, int k0, ColMap cm, LAS float* scr, int wid0) {
    const int tid = opaque_tid(wid0);
#pragma unroll
    for (int i = 0; i < 8; ++i) { const int idx = tid + i * NTHREADS, kk = idx >> 6, nn = idx & 63; const int sc = cm(n0 + nn), k = k0 + kk;
        float v = 0.f; if (sc >= 0 && k < Ksrc) { v = src[(size_t)k * lds_src + sc]; if (kscale) v *= kscale[k]; }
        scr[kk * 65 + nn] = v; }
    __syncthreads();
    { const int nn = tid >> 3, kc = tid & 7; const LAS float* s = scr + (kc * 8) * 65 + nn;
      u32x4 w; w.x = pk2(s[0], s[65]); w.y = pk2(s[2 * 65], s[3 * 65]); w.z = pk2(s[4 * 65], s[5 * 65]); w.w = pk2(s[6 * 65], s[7 * 65]);
      *(u32x4*)(dst + (size_t)(n0 + nn) * ldd + k0 + kc * 8) = w; }
    __syncthreads();
}

__device__ __forceinline__ void phase_prologue(const Params& P, LAS unsigned char* lds, int bid, int G, int wid0) {
    const int tid = opaque_tid(wid0);
    LAS float* scr = (LAS float*)lds;
    const float* w_in = P.in[5]; const float* w_uq = P.in[7]; const float* w_ukv = P.in[9]; const float* w1 = P.in[12]; const float* w_out = P.in[15];
    constexpr int T_WIN = 60 * 16, T_WOUT = 16 * 16, T_UQ = 8 * 4, T_UKV = 8 * 2, T_W1 = 1 * 32 * 2;
    constexpr int T_L = T_WIN + T_WOUT + T_UQ + T_UKV + T_W1;
    for (int it = bid; it < DEPTH * T_L; it += G) {
        const int l = it / T_L; int r = it % T_L;
        if (r < T_WIN) { tr_tile(w_in + (size_t)l * D * 3732, 3732, D, nullptr, (bf16_t*)(P.ws + WS_WIN) + (size_t)l * NP * D, D, (r / 16) * 64, (r % 16) * 64, MapWin{}, scr, wid0); continue; } r -= T_WIN;
        if (r < T_WOUT) { tr_tile(w_out + (size_t)l * D * D, D, D, nullptr, (bf16_t*)(P.ws + WS_WOUT) + (size_t)l * D * D, D, (r / 16) * 64, (r % 16) * 64, MapId{D}, scr, wid0); continue; } r -= T_WOUT;
        if (r < T_UQ) { tr_tile(w_uq + (size_t)l * 192 * 384, 384, 192, P.in[6] + l * 192, (bf16_t*)(P.ws + WS_WUQ) + (size_t)l * 512 * 256, 256, (r / 4) * 64, (r % 4) * 64, MapUq{}, scr, wid0); continue; } r -= T_UQ;
        if (r < T_UKV) { tr_tile(w_ukv + (size_t)l * 128 * 512, 512, 128, P.in[8] + l * 128, (bf16_t*)(P.ws + WS_WUKV) + (size_t)l * 512 * 128, 128, (r / 2) * 64, (r % 2) * 64, MapId{512}, scr, wid0); continue; } r -= T_UKV;
        { const int kv = r / 32, kt = r % 32; tr_tile(w1 + (size_t)(l * 2 + kv) * 2048 * 64, 64, 2048, nullptr, (bf16_t*)(P.ws + WS_W1T) + (size_t)(l * 2 + kv) * 64 * 2048, 2048, 0, kt * 64, MapId{64}, scr, wid0); }
    }
    {
        LAS float* sc = (LAS float*)lds;
        LAS float* red = (LAS float*)(lds + 16384);
        const float* c = P.in[1]; const float* w_ada = P.in[3]; const float* b_ada = P.in[4]; float* mod = (float*)(P.ws + WS_MOD);
        bool loaded = false;
        for (int it = bid; it < DEPTH * 48; it += G) {
            if (!loaded) { for (int i = tid; i < 4096; i += NTHREADS) sc[i] = silu_f(c[i]); loaded = true; __syncthreads(); }
            const int l = it / 48, cb = it % 48, col = tid & 63, ks = tid >> 6;
            const float* wp = w_ada + (size_t)l * D * 3072 + (size_t)(ks * 128) * 3072 + cb * 64 + col;
            float a0 = 0.f, a1 = 0.f, a2 = 0.f, a3 = 0.f;
#pragma unroll 8
            for (int k = 0; k < 128; ++k) { const float w = wp[(size_t)k * 3072]; const int kk = ks * 128 + k;
                a0 += sc[kk] * w; a1 += sc[1024 + kk] * w; a2 += sc[2048 + kk] * w; a3 += sc[3072 + kk] * w; }
            red[(ks * 64 + col) * 4 + 0] = a0; red[(ks * 64 + col) * 4 + 1] = a1; red[(ks * 64 + col) * 4 + 2] = a2; red[(ks * 64 + col) * 4 + 3] = a3;
            __syncthreads();
            if (tid < 256) { const int cc = tid & 63, b = tid >> 6; float s = b_ada[l * 3072 + cb * 64 + cc];
#pragma unroll
                for (int k8 = 0; k8 < 8; ++k8) s += red[(k8 * 64 + cc) * 4 + b];
                mod[(size_t)(l * 4 + b) * 3072 + cb * 64 + cc] = s; }
            __syncthreads();
        }
    }
    {
        float* tab = (float*)(P.ws + WS_ROPE);
        for (int idx = bid * NTHREADS + tid; idx < S * 16; idx += G * NTHREADS) {
            const int pos = idx >> 4, i = idx & 15;
            const double f4[4] = {1.0, 0.5623413251903491, 0.31622776601683794, 0.1778279410038923};
            double inv = (i & 3) == 0 ? f4[0] : ((i & 3) == 1 ? f4[1] : ((i & 3) == 2 ? f4[2] : f4[3]));
            inv *= ((i >> 2) == 0 ? 1.0 : ((i >> 2) == 1 ? 0.1 : ((i >> 2) == 2 ? 0.01 : 0.001)));
            const float invf = (float)inv; const float angf = (float)pos * invf;
            const double rev = (double)angf * 0.15915494309189535; const double fr = rev - __builtin_floor(rev);
            const float f = (float)fr;
            tab[(size_t)idx * 2] = __builtin_amdgcn_cosf(f); tab[(size_t)idx * 2 + 1] = __builtin_amdgcn_sinf(f);
        }
    }
    {
        const float* pos = P.in[11]; float* cvec = (float*)(P.ws + WS_CVEC);
        LAS float* red = (LAS float*)(lds + 65536);
        for (int it = bid; it < DEPTH * 2; it += G) {
            __syncthreads();
            const int col = tid & 63, ks = tid >> 6; float a = 0.f;
            const float* wp = w1 + (size_t)it * 2048 * 64 + (size_t)(ks * 256) * 64 + col; const float* pp = pos + (size_t)it * 2048 + ks * 256;
            for (int k = 0; k < 256; ++k) a += pp[k] * wp[(size_t)k * 64];
            red[ks * 64 + col] = a; __syncthreads();
            if (tid < 64) { float s = 0.f; for (int k8 = 0; k8 < 8; ++k8) s += red[k8 * 64 + tid]; cvec[it * 64 + tid] = s; }
            __syncthreads();
        }
    }
}

__device__ __forceinline__ void phase_hnorm(const float* x, const float* g, const float* mod  , bf16_t* h, int bid, int G, int wid0) {
    const int tid_ = opaque_tid(wid0); const int lane = tid_ & 63, wv = tid_ >> 6;
    for (int row = bid * 8 + wv; row < M; row += G * 8) {
        const f32x4* xr = (const f32x4*)(x + (size_t)row * D) + lane;
        f32x4 v[4]; float s = 0.f;
#pragma unroll
        for (int j = 0; j < 4; ++j) { v[j] = xr[64 * j]; s += (v[j][0] * v[j][0] + v[j][1] * v[j][1]) + (v[j][2] * v[j][2] + v[j][3] * v[j][3]); }
        const float rstd = 1.0f / sqrtf(wave_sum(s) * (1.f / D) + EPS);
        const int b = row / S; const float* sh = mod + (size_t)b * 3072; const float* scl = sh + 1024;
        unsigned long long* o8 = (unsigned long long*)(h + (size_t)row * D) + lane;
#pragma unroll
        for (int j = 0; j < 4; ++j) { const int c = (64 * j + lane) * 4; const f32x4 gg = *(const f32x4*)(g + c), ss = *(const f32x4*)(scl + c), hh = *(const f32x4*)(sh + c);
            f32x4 y;
#pragma unroll
            for (int e = 0; e < 4; ++e) y[e] = v[j][e] * rstd * gg[e] * (1.0f + ss[e]) + hh[e];
            o8[64 * j] = (unsigned long long)pk2(y[0], y[1]) | ((unsigned long long)pk2(y[2], y[3]) << 32); }
    }
}

__device__ __forceinline__ void phase_prep(const Params& P, int l, LAS unsigned char* lds, int bid, int G, int wid0) {
    const int tid = opaque_tid(wid0), lane = tid & 63, wv = tid >> 6;
    const bf16_t* proj = (const bf16_t*)(P.ws + WS_PROJ); const float* side = (const float*)(P.ws + WS_SIDE);
    {
        float* rstd = (float*)(P.ws + WS_RSTD); bf16_t* kmla = (bf16_t*)(P.ws + WS_KMLA); const float* rope = (const float*)(P.ws + WS_ROPE);
        for (int row = bid * 8 + wv; row < M; row += G * 8) {
            const bf16_t* pr = proj + (size_t)row * NP;
            float sq = 0.f, skv = 0.f;
            if (lane < 40) { const u32x4 w = *(const u32x4*)(pr + lane * 8); float s = 0.f;
#pragma unroll
                for (int e = 0; e < 4; ++e) { const float a = bflo(w[e]), b = bfhi(w[e]); s += a * a + b * b; }
                if (lane < 24) sq = s; else skv = s; }
            sq = wave_sum(sq); skv = wave_sum(skv);
            if (lane == 0) { rstd[(size_t)row * 2] = 1.0f / sqrtf(sq * (1.f / 192.f) + EPS); rstd[(size_t)row * 2 + 1] = 1.0f / sqrtf(skv * (1.f / 128.f) + EPS); }
            if (lane >= 48 && lane < 52) *(u32x4*)((bf16_t*)(P.ws + WS_KIDX) + (size_t)row * 32 + (lane - 48) * 8) = *(const u32x4*)(pr + C_IK + (lane - 48) * 8);
            if (lane < 16) { const float x1 = bf2f(pr[C_KROPE + lane]), x2 = bf2f(pr[C_KROPE + 16 + lane]); const int pos = row & (S - 1);
                const float cs = rope[((size_t)pos * 16 + lane) * 2], sn = rope[((size_t)pos * 16 + lane) * 2 + 1];
                const unsigned w = pk2(x1 * cs - x2 * sn, x1 * sn + x2 * cs);
#pragma unroll
                for (int hd = 0; hd < 4; ++hd) *(unsigned*)(kmla + (size_t)row * 384 + hd * 96 + 64 + 2 * lane) = w; }
        }
    }
    {
        float* fb = (float*)(P.ws + WS_FB); const float* b_f = P.in[10] + l * 4; LAS float* wtot = (LAS float*)lds;
        for (int it = bid; it < 16; it += G) {
            const int b = it >> 2, hd = it & 3; const float bf = b_f[hd];
            float ls[16]; float s = 0.f;
#pragma unroll
            for (int i = 0; i < 16; ++i) { const int t = tid * 16 + i; const float v = side[((size_t)b * S + t) * 32 + hd] + bf;
                const float y = fminf(v, 0.f) - log1pf(__expf(-fabsf(v))); ls[i] = y; s += y; }
            float inc = s;
#pragma unroll
            for (int o = 1; o < 64; o <<= 1) { const float t = __shfl_up(inc, o); if (lane >= o) inc += t; }
            __syncthreads();
            if (lane == 63) wtot[wv] = inc;
            __syncthreads();
            float base = 0.f;
            for (int w = 0; w < wv; ++w) base += wtot[w];
            float run = base + inc - s;
#pragma unroll
            for (int i = 0; i < 16; ++i) { run += ls[i]; fb[((size_t)it) * S + tid * 16 + i] = -8.0f * run; }
            __syncthreads();
        }
    }
    {
        const bf16_t* w1t = (const bf16_t*)(P.ws + WS_W1T) + (size_t)l * 2 * 64 * 2048; const float* cvec = (const float*)(P.ws + WS_CVEC) + l * 2 * 64;
        const float* w2 = P.in[13] + (size_t)l * 2 * 64 * 64;
        LAS float* part = (LAS float*)lds;
        LAS float* hb = (LAS float*)(lds + 65536);
        const int r = lane & 31, hi = lane >> 5;
        for (int it = bid; it < 128; it += G) {
            const int b = it >> 5, kv = (it >> 4) & 1, nt = it & 15, n0 = nt * 32;
            const int colbase = kv ? C_VCMP : C_KCMP;
            const bf16_t* w1k = w1t + (size_t)kv * 64 * 2048;
            f32x16 a0 = {}, a1 = {};
#pragma unroll
            for (int j = 0; j < 4; ++j) { const int tok = wv * 4 + j;
                const bf16_t* ap = proj + ((size_t)b * S + 16 * (n0 + r) + tok) * NP + colbase + hi * 8;
#pragma unroll
                for (int s = 0; s < 4; ++s) { const bf16x8 af = *(const bf16x8*)(ap + s * 16);
                    const int kb = tok * 64 + s * 16 + hi * 8;
                    const bf16x8 b0 = *(const bf16x8*)(w1k + (size_t)r * 2048 + kb), b1 = *(const bf16x8*)(w1k + (size_t)(32 + r) * 2048 + kb);
                    a0 = __builtin_amdgcn_mfma_f32_32x32x16_bf16(af, b0, a0, 0, 0, 0); a1 = __builtin_amdgcn_mfma_f32_32x32x16_bf16(af, b1, a1, 0, 0, 0); } }
#pragma unroll
            for (int reg = 0; reg < 16; ++reg) { const int n = crow(reg, hi); part[(wv * 32 + n) * 64 + r] = a0[reg]; part[(wv * 32 + n) * 64 + 32 + r] = a1[reg]; }
            __syncthreads();
            { const int n = tid >> 4, c4 = (tid & 15) * 4;
#pragma unroll
              for (int e = 0; e < 4; ++e) { float s = cvec[kv * 64 + c4 + e];
#pragma unroll
                  for (int w = 0; w < 8; ++w) s += part[(w * 32 + n) * 64 + c4 + e];
                  hb[n * 64 + c4 + e] = silu_f(s); } }
            __syncthreads();
            { const int n = tid >> 4, c4 = (tid & 15) * 4; float o[4] = {0.f, 0.f, 0.f, 0.f}; const float* w2k = w2 + (size_t)kv * 64 * 64;
              for (int k = 0; k < 64; ++k) { const float hv = hb[n * 64 + k]; const f32x4 wv4 = *(const f32x4*)(w2k + k * 64 + c4);
                  o[0] += hv * wv4[0]; o[1] += hv * wv4[1]; o[2] += hv * wv4[2]; o[3] += hv * wv4[3]; }
              bf16_t* dst = (bf16_t*)(P.ws + (kv ? WS_VC : WS_KC)) + ((size_t)b * 512 + n0 + n) * 64 + c4;
              const bool valid = (n0 + n) < 511;
              u32x2 w; w.x = valid ? pk2(o[0], o[1]) : 0u; w.y = valid ? pk2(o[2], o[3]) : 0u; *(u32x2*)dst = w; }
            __syncthreads();
        }
    }
}

constexpr float NEG_BIG = -1e30f;
constexpr int KSTR64 = 144, KSTR96 = 208;
constexpr int ATT_KBUF = 64 * KSTR96;
constexpr int ATT_VBUF = 8192;
constexpr int ATT_K0 = 0, ATT_V0 = 2 * ATT_KBUF, ATT_B0 = ATT_V0 + 2 * ATT_VBUF, ATT_END = ATT_B0 + 2 * 256;
constexpr int ATT_EXTRA = 45056;

struct SoftState { float m, l; f32x16 o0, o1; };

template <int KS>
__device__ __forceinline__ void qk_tile(f32x16& p0, f32x16& p1, const LAS unsigned char* kt, int kstride, const bf16x8 (&qf)[KS], int r, int hi) {
    const LAS unsigned char* k0 = kt + r * kstride + hi * 16; const LAS unsigned char* k1 = k0 + 32 * kstride;
#pragma unroll
    for (int s = 0; s < KS; ++s) { const bf16x8 a0 = *(const LAS bf16x8*)(k0 + s * 32), a1 = *(const LAS bf16x8*)(k1 + s * 32);
        p0 = __builtin_amdgcn_mfma_f32_32x32x16_bf16(a0, qf[s], p0, 0, 0, 0); p1 = __builtin_amdgcn_mfma_f32_32x32x16_bf16(a1, qf[s], p1, 0, 0, 0); }
}
__device__ __forceinline__ float max3f(float a, float b, float c);
__device__ __forceinline__ float tile_max(const f32x16& p0, const f32x16& p1) {
    float a = max3f(p0[0], p0[1], p1[0]), b = max3f(p0[2], p0[3], p1[1]); a = max3f(a, p1[2], p1[3]);
#pragma unroll
    for (int i = 4; i < 16; i += 4) { a = max3f(a, p0[i], p0[i + 1]); b = max3f(b, p0[i + 2], p0[i + 3]); a = max3f(a, p1[i], p1[i + 1]); b = max3f(b, p1[i + 2], p1[i + 3]); }
    a = max3f(a, b, b);
    const auto rr = __builtin_amdgcn_permlane32_swap(__float_as_uint(a), __float_as_uint(a), false, false);
    return fmaxf(__uint_as_float(rr[0]), __uint_as_float(rr[1]));
}
__device__ __forceinline__ bf16x8 vfrag(const LAS unsigned char* p) {
    const s16x4 lo = __builtin_bit_cast(s16x4, __builtin_amdgcn_ds_read_tr16_b64_v4i16((LAS s16x4*)p));
    const s16x4 hi = __builtin_bit_cast(s16x4, __builtin_amdgcn_ds_read_tr16_b64_v4i16((LAS s16x4*)(p + 512)));
    return (bf16x8){lo[0], lo[1], lo[2], lo[3], hi[0], hi[1], hi[2], hi[3]};
}
__device__ __forceinline__ bf16x8 pfrag(const f32x16& p, int b) {
    u32x4 w; w.x = pk2(p[b], p[b + 1]); w.y = pk2(p[b + 2], p[b + 3]); w.z = pk2(p[b + 4], p[b + 5]); w.w = pk2(p[b + 6], p[b + 7]);
    return __builtin_bit_cast(bf16x8, w);
}
__device__ __forceinline__ void pv_frag(f32x16& o0, f32x16& o1, bf16x8 pf0, bf16x8 pf1, bf16x8 pf2, bf16x8 pf3, const LAS unsigned char* vt, int vb) {
    const LAS unsigned char* v = vt + vb;
    o0 = __builtin_amdgcn_mfma_f32_32x32x16_bf16(vfrag(v), pf0, o0, 0, 0, 0);            o1 = __builtin_amdgcn_mfma_f32_32x32x16_bf16(vfrag(v + 4096), pf0, o1, 0, 0, 0);
    o0 = __builtin_amdgcn_mfma_f32_32x32x16_bf16(vfrag(v + 1024), pf1, o0, 0, 0, 0);     o1 = __builtin_amdgcn_mfma_f32_32x32x16_bf16(vfrag(v + 4096 + 1024), pf1, o1, 0, 0, 0);
    o0 = __builtin_amdgcn_mfma_f32_32x32x16_bf16(vfrag(v + 2048), pf2, o0, 0, 0, 0);     o1 = __builtin_amdgcn_mfma_f32_32x32x16_bf16(vfrag(v + 4096 + 2048), pf2, o1, 0, 0, 0);
    o0 = __builtin_amdgcn_mfma_f32_32x32x16_bf16(vfrag(v + 3072), pf3, o0, 0, 0, 0);     o1 = __builtin_amdgcn_mfma_f32_32x32x16_bf16(vfrag(v + 4096 + 3072), pf3, o1, 0, 0, 0);
}
__device__ __forceinline__ void pv_tile(f32x16& o0, f32x16& o1, const f32x16& p0, const f32x16& p1, const LAS unsigned char* vt, int vb) {
    pv_frag(o0, o1, pfrag(p0, 0), pfrag(p0, 8), pfrag(p1, 0), pfrag(p1, 8), vt, vb);
}
__device__ __forceinline__ void softmax_step(SoftState& st, f32x16& p0, f32x16& p1, float c2) {
    const float mx = tile_max(p0, p1);
    const float mn = fmaxf(st.m, mx);
    if (__any(mn > st.m)) { const float al = __builtin_amdgcn_exp2f((st.m - mn) * c2); st.l *= al; st.o0 *= al; st.o1 *= al; st.m = mn; }
    const float mc = st.m * c2; float sum = 0.f;
#pragma unroll
    for (int i = 0; i < 16; ++i) { p0[i] = __builtin_amdgcn_exp2f(__builtin_fmaf(p0[i], c2, -mc)); p1[i] = __builtin_amdgcn_exp2f(__builtin_fmaf(p1[i], c2, -mc)); sum += p0[i] + p1[i]; }
    st.l += sum;
}

__device__ __forceinline__ float max3f(float a, float b, float c) { float r; asm("v_max3_f32 %0, %1, %2, %3" : "=v"(r) : "v"(a), "v"(b), "v"(c)); return r; }
__device__ __forceinline__ float swap32_max(float a) { const auto rr = __builtin_amdgcn_permlane32_swap(__float_as_uint(a), __float_as_uint(a), false, false);
    float r; asm("v_max_f32_e32 %0, %1, %2" : "=v"(r) : "v"(__uint_as_float(rr[0])), "v"(__uint_as_float(rr[1]))); return r; }
__device__ __forceinline__ float quad_xor1(float x) { return __builtin_bit_cast(float, __builtin_amdgcn_update_dpp(0, __builtin_bit_cast(int, x), 0xB1, 0xf, 0xf, false)); }
__device__ __forceinline__ float quad_xor2(float x) { return __builtin_bit_cast(float, __builtin_amdgcn_update_dpp(0, __builtin_bit_cast(int, x), 0x4E, 0xf, 0xf, false)); }
__device__ __forceinline__ float swap32_sum(float a) { const auto rr = __builtin_amdgcn_permlane32_swap(__float_as_uint(a), __float_as_uint(a), false, false); return __uint_as_float(rr[0]) + __uint_as_float(rr[1]); }
constexpr float SM_THR = 8.0f;
__device__ __forceinline__ void softmax_pack(SoftState& st, const f32x16& p0, const f32x16& p1, float c2, bf16x8& pf0, bf16x8& pf1, bf16x8& pf2, bf16x8& pf3) {
    float a = max3f(p0[0], p0[1], p1[0]), b = max3f(p0[2], p0[3], p1[1]); a = max3f(a, p1[2], p1[3]);
#pragma unroll
    for (int i = 4; i < 16; i += 4) { a = max3f(a, p0[i], p0[i + 1]); b = max3f(b, p0[i + 2], p0[i + 3]); a = max3f(a, p1[i], p1[i + 1]); b = max3f(b, p1[i + 2], p1[i + 3]); }
    float mx; asm("v_max_f32_e32 %0, %1, %2" : "=v"(mx) : "v"(a), "v"(b));
    mx = swap32_max(mx);
    if (__any((mx - st.m) * c2 > SM_THR)) { const float mn = fmaxf(st.m, mx); const float al = __builtin_amdgcn_exp2f((st.m - mn) * c2); st.l *= al; st.o0 *= al; st.o1 *= al; st.m = mn; }
    const float mc = -st.m * c2; float s0 = 0.f, s1 = 0.f;
    u32x4 w0, w1, w2, w3;
#define SMP(W, E, P, B) do { const float e0_ = __builtin_amdgcn_exp2f(__builtin_fmaf(P[B], c2, mc)), e1_ = __builtin_amdgcn_exp2f(__builtin_fmaf(P[B + 1], c2, mc)); s0 += e0_; s1 += e1_; W[E] = pk2(e0_, e1_); } while (0)
    SMP(w0, 0, p0, 0); SMP(w0, 1, p0, 2); SMP(w0, 2, p0, 4); SMP(w0, 3, p0, 6);
    SMP(w1, 0, p0, 8); SMP(w1, 1, p0, 10); SMP(w1, 2, p0, 12); SMP(w1, 3, p0, 14);
    SMP(w2, 0, p1, 0); SMP(w2, 1, p1, 2); SMP(w2, 2, p1, 4); SMP(w2, 3, p1, 6);
    SMP(w3, 0, p1, 8); SMP(w3, 1, p1, 10); SMP(w3, 2, p1, 12); SMP(w3, 3, p1, 14);
#undef SMP
    st.l += s0 + s1;
    pf0 = __builtin_bit_cast(bf16x8, w0); pf1 = __builtin_bit_cast(bf16x8, w1); pf2 = __builtin_bit_cast(bf16x8, w2); pf3 = __builtin_bit_cast(bf16x8, w3);
}

__device__ __forceinline__ void sm_exp_pack(SoftState& st, const f32x16& p0, const f32x16& p1, float c2, bf16x8& pf0, bf16x8& pf1, bf16x8& pf2, bf16x8& pf3) {
    const float mc = -st.m * c2; float s0 = 0.f, s1 = 0.f;
    u32x4 w0, w1, w2, w3;
#define SMP(W, E, P, B) do { const float e0_ = __builtin_amdgcn_exp2f(__builtin_fmaf(P[B], c2, mc)), e1_ = __builtin_amdgcn_exp2f(__builtin_fmaf(P[B + 1], c2, mc)); s0 += e0_; s1 += e1_; W[E] = pk2(e0_, e1_); } while (0)
    SMP(w0, 0, p0, 0); SMP(w0, 1, p0, 2); SMP(w0, 2, p0, 4); SMP(w0, 3, p0, 6);
    SMP(w1, 0, p0, 8); SMP(w1, 1, p0, 10); SMP(w1, 2, p0, 12); SMP(w1, 3, p0, 14);
    SMP(w2, 0, p1, 0); SMP(w2, 1, p1, 2); SMP(w2, 2, p1, 4); SMP(w2, 3, p1, 6);
    SMP(w3, 0, p1, 8); SMP(w3, 1, p1, 10); SMP(w3, 2, p1, 12); SMP(w3, 3, p1, 14);
#undef SMP
    st.l += s0 + s1;
    pf0 = __builtin_bit_cast(bf16x8, w0); pf1 = __builtin_bit_cast(bf16x8, w1); pf2 = __builtin_bit_cast(bf16x8, w2); pf3 = __builtin_bit_cast(bf16x8, w3);
}

template <int DK> struct StageRegs { u32x4 k0, k1, v; float b; };
template <int DK>
__device__ __forceinline__ void stage_load(StageRegs<DK>& sr, const bf16_t* K, int ldk, const bf16_t* V, int ldv, const float* bias, int kv0, int wid0) {
    const int tid = opaque_tid(wid0); constexpr int CPR = DK / 8;
    { const int row = tid / CPR, cc = tid % CPR; sr.k0 = *(const u32x4*)(K + (size_t)(kv0 + row) * ldk + cc * 8); }
    if (DK == 96 && tid < 256) { const int c = tid + 512, row = c / CPR, cc = c % CPR; sr.k1 = *(const u32x4*)(K + (size_t)(kv0 + row) * ldk + cc * 8); }
    { const int row = tid >> 3, cc = tid & 7; sr.v = *(const u32x4*)(V + (size_t)(kv0 + row) * ldv + cc * 8); }
    if (bias && tid < 64) sr.b = bias[kv0 + tid];
}
template <int DK>
__device__ __forceinline__ void stage_store(const StageRegs<DK>& sr, LAS unsigned char* lds, int buf, bool has_bias, int wid0) {
    const int tid = opaque_tid(wid0); constexpr int CPR = DK / 8; constexpr int KSTR = (DK == 96) ? KSTR96 : KSTR64;
    LAS unsigned char* kb = lds + ATT_K0 + buf * ATT_KBUF; LAS unsigned char* vb = lds + ATT_V0 + buf * ATT_VBUF;
    { const int row = tid / CPR, cc = tid % CPR; *(LAS u32x4*)(kb + row * KSTR + cc * 16) = sr.k0; }
    if (DK == 96 && tid < 256) { const int c = tid + 512, row = c / CPR, cc = c % CPR; *(LAS u32x4*)(kb + row * KSTR + cc * 16) = sr.k1; }
    { const int row = tid >> 3, cc = tid & 7; *(LAS u32x4*)(vb + (cc >> 2) * 4096 + row * 64 + (cc & 3) * 16) = sr.v; }
    if (has_bias && tid < 64) *(LAS float*)(lds + ATT_B0 + buf * 256 + tid * 4) = sr.b;
}

__device__ __forceinline__ void store_out(bf16_t* dst  , const f32x16& o0, const f32x16& o1, float scale, int hi) {
#pragma unroll
    for (int g = 0; g < 4; ++g) {
        u32x2 w; w.x = pk2(o0[4 * g] * scale, o0[4 * g + 1] * scale); w.y = pk2(o0[4 * g + 2] * scale, o0[4 * g + 3] * scale);
        *(u32x2*)(dst + 8 * g + 4 * hi) = w;
        u32x2 w1; w1.x = pk2(o1[4 * g] * scale, o1[4 * g + 1] * scale); w1.y = pk2(o1[4 * g + 2] * scale, o1[4 * g + 3] * scale);
        *(u32x2*)(dst + 32 + 8 * g + 4 * hi) = w1;
    }
}

__device__ __forceinline__ float store_out_fused(bf16_t* dst, const bf16_t* zp, const float* gp, const f32x16& o0, const f32x16& o1, float scale, int hi) {
    float ssq = 0.f;
#pragma unroll
    for (int g = 0; g < 4; ++g) {
#pragma unroll
        for (int d0 = 0; d0 < 2; ++d0) { const int c = 32 * d0 + 8 * g + 4 * hi; const u32x2 zz = *(const u32x2*)(zp + c); const f32x4 gg = *(const f32x4*)(gp + c);
            const float z0 = bflo(zz.x), z1 = bfhi(zz.x), z2 = bflo(zz.y), z3 = bfhi(zz.y);
            const float v0 = (d0 ? o1[4 * g] : o0[4 * g]) * scale, v1 = (d0 ? o1[4 * g + 1] : o0[4 * g + 1]) * scale, v2 = (d0 ? o1[4 * g + 2] : o0[4 * g + 2]) * scale, v3 = (d0 ? o1[4 * g + 3] : o0[4 * g + 3]) * scale;
            ssq += (v0 * v0 + v1 * v1) + (v2 * v2 + v3 * v3);
            u32x2 w; w.x = pk2(v0 * gg[0] * silu_fast(z0), v1 * gg[1] * silu_fast(z1)); w.y = pk2(v2 * gg[2] * silu_fast(z2), v3 * gg[3] * silu_fast(z3));
            *(u32x2*)(dst + c) = w; }
    }
    return ssq;
}

constexpr int DA_K0 = 0, DA_V0 = 3 * ATT_KBUF, DA_B0 = DA_V0 + 2 * ATT_VBUF, DA_END = DA_B0 + 3 * 256;
static_assert(DA_END <= LDS_BYTES, "dense attention LDS map");
template <int DK, int MODE>
__device__ __forceinline__ void dense_unit(LAS unsigned char* lds, const bf16_t* Q, int ldq, const bf16_t* K, int ldk, const bf16_t* V, int ldv,
                                           bf16_t* O  , const float* bias, const unsigned long long* maskbits  ,
                                           float alibiA, float c2, int qb, int wid0, const bf16_t* Zg, const float* Gn, float* ssq  ) {
    constexpr int KS = DK / 16; constexpr int KSTR = (DK == 96) ? KSTR96 : KSTR64; constexpr int CPR = DK / 8;
    const int tid = opaque_tid(wid0), lane = tid & 63, wv = __builtin_amdgcn_readfirstlane(tid >> 6), r = lane & 31, hi = lane >> 5;
    const int q0 = qb * 256, qw0 = q0 + wv * 32, tq = qw0 + r;
    const int NT = (q0 + 256) / 64;
    const int tlast = (qw0 + 31) >> 6;
    bf16x8 qf[KS];
#pragma unroll
    for (int s = 0; s < KS; ++s) qf[s] = *(const bf16x8*)(Q + (size_t)tq * ldq + s * 16 + hi * 8);
    const int vb = ((lane >> 4) & 1) * 32 + (lane & 3) * 8 + (4 * hi + ((lane & 15) >> 2)) * 64;
    const int kb = r * KSTR + hi * 16;
    SoftState st; st.m = NEG_BIG; st.l = 0.f; st.o0 = (f32x16){}; st.o1 = (f32x16){};
    const int krow0 = tid / CPR, kcc0 = tid % CPR, krow1 = (tid + 512) / CPR, kcc1 = (tid + 512) % CPR, vrow = tid >> 3, vcc = tid & 7;
    const bf16_t* kp0 = K + (size_t)krow0 * ldk + kcc0 * 8; const bf16_t* kp1 = K + (size_t)krow1 * ldk + kcc1 * 8; const bf16_t* vp = V + (size_t)vrow * ldv + vcc * 8;
    const int klds0 = krow0 * KSTR + kcc0 * 16, klds1 = krow1 * KSTR + kcc1 * 16, vlds = (vcc >> 2) * 4096 + vrow * 64 + (vcc & 3) * 16;
    u32x4 rk0, rk1, rv; float rbias = 0.f;
#define DA_LOADK(t) do { rk0 = *(const u32x4*)(kp0 + (size_t)(t) * 64 * ldk); if (DK == 96 && tid < 256) rk1 = *(const u32x4*)(kp1 + (size_t)(t) * 64 * ldk); if (MODE == 1 && tid < 64) rbias = bias[(t) * 64 + tid]; } while (0)
#define DA_LOADV(t) do { rv = *(const u32x4*)(vp + (size_t)(t) * 64 * ldv); } while (0)
#define DA_STOREK(slot) do { LAS unsigned char* kb_ = lds + DA_K0 + (slot) * ATT_KBUF; *(LAS u32x4*)(kb_ + klds0) = rk0; if (DK == 96 && tid < 256) *(LAS u32x4*)(kb_ + klds1) = rk1; \
        if (MODE == 1 && tid < 64) *(LAS float*)(lds + DA_B0 + (slot) * 256 + tid * 4) = rbias; } while (0)
#define DA_STOREV(slot) do { *(LAS u32x4*)(lds + DA_V0 + (slot) * ATT_VBUF + vlds) = rv; } while (0)
#define DA_CINIT(P0, P1, t, slot) do { const int kv0_ = (t) * 64; \
        if (MODE == 0) { P0 = (f32x16){}; P1 = (f32x16){}; } \
        else if (MODE == 1) { const LAS float* bl = (const LAS float*)(lds + DA_B0 + (slot) * 256); \
            _Pragma("unroll") for (int g = 0; g < 4; ++g) { const f32x4 b0_ = *(const LAS f32x4*)(bl + 8 * g + 4 * hi), b1_ = *(const LAS f32x4*)(bl + 32 + 8 * g + 4 * hi); \
                _Pragma("unroll") for (int e = 0; e < 4; ++e) { P0[4 * g + e] = b0_[e]; P1[4 * g + e] = b1_[e]; } } } \
        else { const float base_ = alibiA * (float)(kv0_ + 4 * hi); \
            _Pragma("unroll") for (int i = 0; i < 16; ++i) { P0[i] = base_ + alibiA * (float)((i & 3) + 8 * (i >> 2)); P1[i] = P0[i] + alibiA * 32.0f; } } } while (0)
#define DA_MASK(P0, P1, t, mb) do { const int kv0_ = (t) * 64; \
        if (MODE == 2) { const unsigned long long ms_ = (mb) >> (4 * hi); const unsigned lo_ = (unsigned)ms_, hw_ = (unsigned)(ms_ >> 32); \
            _Pragma("unroll") for (int i = 0; i < 16; ++i) { const unsigned bit_ = 1u << ((i & 3) + 8 * (i >> 2)); if (!(lo_ & bit_)) P0[i] = -INFINITY; if (!(hw_ & bit_)) P1[i] = -INFINITY; } } \
        else if (kv0_ + 63 > qw0) { \
            _Pragma("unroll") for (int i = 0; i < 16; ++i) { const int kv_ = kv0_ + crow(i, hi); if (kv_ > tq) P0[i] = -INFINITY; if (kv_ + 32 > tq) P1[i] = -INFINITY; } } } while (0)
#define DA_ROWMAX(MX, P0, P1) do { float a_ = __builtin_fmaxf(__builtin_fmaxf(P0[0], P0[1]), P1[0]), b_ = __builtin_fmaxf(__builtin_fmaxf(P0[2], P0[3]), P1[1]); a_ = __builtin_fmaxf(__builtin_fmaxf(a_, P1[2]), P1[3]); \
        _Pragma("unroll") for (int i = 4; i < 16; i += 4) { a_ = __builtin_fmaxf(__builtin_fmaxf(a_, P0[i]), P0[i + 1]); b_ = __builtin_fmaxf(__builtin_fmaxf(b_, P0[i + 2]), P0[i + 3]); a_ = __builtin_fmaxf(__builtin_fmaxf(a_, P1[i]), P1[i + 1]); b_ = __builtin_fmaxf(__builtin_fmaxf(b_, P1[i + 2]), P1[i + 3]); } \
        a_ = __builtin_fmaxf(a_, b_); const auto rr_ = __builtin_amdgcn_permlane32_swap(__float_as_uint(a_), __float_as_uint(a_), false, false); \
        MX = __builtin_fmaxf(__uint_as_float(rr_[0]), __uint_as_float(rr_[1])); } while (0)
    __syncthreads();
    DA_LOADK(0); DA_LOADV(0); DA_STOREK(0); DA_STOREV(0);
    DA_LOADK(1); DA_STOREK(1);
    DA_LOADK(2); DA_LOADV(1);
    __syncthreads();
    f32x16 pa0, pa1, pb0, pb1;
    unsigned long long mb_nxt = 0ull, mb_nn = 0ull;
    {
        DA_CINIT(pa0, pa1, 0, 0);
        qk_tile<KS>(pa0, pa1, lds + DA_K0, KSTR, qf, r, hi);
        unsigned long long mb0 = 0ull;
        if (MODE == 2) { mb0 = maskbits[(size_t)tq * 128]; if (1 <= tlast) mb_nxt = maskbits[(size_t)tq * 128 + 1]; }
        DA_MASK(pa0, pa1, 0, mb0);
        float mx; DA_ROWMAX(mx, pa0, pa1);
        st.m = __builtin_fmaxf(st.m, mx);
    }
    int ks_next = 1, ks_store = 2, vs_cur = 0;
#define DA_STEP(C0, C1, N0, N1, t) do { \
        if (MODE == 2) { mb_nn = 0ull; if ((t) + 2 <= tlast) mb_nn = maskbits[(size_t)tq * 128 + (t) + 2]; } \
        if ((t) <= tlast) { \
              \
            DA_CINIT(N0, N1, (t) + 1, ks_next); \
            bf16x8 pf0, pf1, pf2, pf3; \
            bf16x8 kf[2 * KS]; { const LAS unsigned char* k_ = lds + DA_K0 + ks_next * ATT_KBUF + kb; \
                _Pragma("unroll") for (int s_ = 0; s_ < KS; ++s_) { kf[2 * s_] = *(const LAS bf16x8*)(k_ + s_ * 32); kf[2 * s_ + 1] = *(const LAS bf16x8*)(k_ + 32 * KSTR + s_ * 32); } } \
            __builtin_amdgcn_sched_barrier(0); \
            _Pragma("unroll") for (int s_ = 0; s_ < KS; ++s_) { N0 = __builtin_amdgcn_mfma_f32_32x32x16_bf16(kf[2 * s_], qf[s_], N0, 0, 0, 0); N1 = __builtin_amdgcn_mfma_f32_32x32x16_bf16(kf[2 * s_ + 1], qf[s_], N1, 0, 0, 0); } \
            sm_exp_pack(st, C0, C1, c2, pf0, pf1, pf2, pf3); \
            _Pragma("unroll") for (int g_ = 0; g_ < 2 * KS; ++g_) { __builtin_amdgcn_sched_group_barrier(0x8, 1, 0); __builtin_amdgcn_sched_group_barrier(0x2, (KS == 6 ? 9 : 14), 0); } \
            __builtin_amdgcn_sched_barrier(0); \
              \
            bf16x8 vf[8]; { const LAS unsigned char* v_ = lds + DA_V0 + vs_cur * ATT_VBUF + vb; \
                _Pragma("unroll") for (int s_ = 0; s_ < 4; ++s_) { vf[2 * s_] = vfrag(v_ + s_ * 1024); vf[2 * s_ + 1] = vfrag(v_ + 4096 + s_ * 1024); } } \
            __builtin_amdgcn_sched_barrier(0); \
            float mx_ = -INFINITY; \
            if ((t) < tlast) { DA_MASK(N0, N1, (t) + 1, mb_nxt); DA_ROWMAX(mx_, N0, N1); } \
            __builtin_amdgcn_sched_barrier(0); \
            st.o0 = __builtin_amdgcn_mfma_f32_32x32x16_bf16(vf[0], pf0, st.o0, 0, 0, 0); st.o1 = __builtin_amdgcn_mfma_f32_32x32x16_bf16(vf[1], pf0, st.o1, 0, 0, 0); \
            st.o0 = __builtin_amdgcn_mfma_f32_32x32x16_bf16(vf[2], pf1, st.o0, 0, 0, 0); st.o1 = __builtin_amdgcn_mfma_f32_32x32x16_bf16(vf[3], pf1, st.o1, 0, 0, 0); \
            st.o0 = __builtin_amdgcn_mfma_f32_32x32x16_bf16(vf[4], pf2, st.o0, 0, 0, 0); st.o1 = __builtin_amdgcn_mfma_f32_32x32x16_bf16(vf[5], pf2, st.o1, 0, 0, 0); \
            st.o0 = __builtin_amdgcn_mfma_f32_32x32x16_bf16(vf[6], pf3, st.o0, 0, 0, 0); st.o1 = __builtin_amdgcn_mfma_f32_32x32x16_bf16(vf[7], pf3, st.o1, 0, 0, 0); \
            __builtin_amdgcn_sched_barrier(0); \
            if (__any((mx_ - st.m) * c2 > SM_THR)) { const float mn_ = __builtin_fmaxf(st.m, mx_); const float al_ = __builtin_amdgcn_exp2f((st.m - mn_) * c2); st.l *= al_; st.o0 *= al_; st.o1 *= al_; st.m = mn_; } \
        } \
        if ((t) + 2 < NT) DA_STOREK(ks_store); \
        if ((t) + 1 < NT) DA_STOREV(vs_cur ^ 1); \
        if ((t) + 3 < NT) DA_LOADK((t) + 3); \
        if ((t) + 2 < NT) DA_LOADV((t) + 2); \
        __syncthreads(); \
        mb_nxt = mb_nn; vs_cur ^= 1; ks_next = (ks_next == 2) ? 0 : ks_next + 1; ks_store = (ks_store == 2) ? 0 : ks_store + 1; } while (0)
    for (int t = 0; t < NT; t += 2) {
        DA_STEP(pa0, pa1, pb0, pb1, t);
        DA_STEP(pb0, pb1, pa0, pa1, t + 1);
    }
#undef DA_LOADK
#undef DA_LOADV
#undef DA_STOREK
#undef DA_STOREV
#undef DA_CINIT
#undef DA_MASK
#undef DA_ROWMAX
#undef DA_STEP
    const float l = swap32_sum(st.l);
    const float inv = l > 0.f ? 1.0f / l : 0.f;
    const float sq = swap32_sum(store_out_fused(O + (size_t)tq * D, Zg + (size_t)tq * NP, Gn, st.o0, st.o1, inv, hi));
    if (hi == 0) ssq[(size_t)tq * 16] = sq;
}

#define A64_SBAR() __builtin_amdgcn_sched_barrier(0)
#define A64_PIN(x) asm volatile("" : "+v"(x))
#define A64_MFMA(a, b, c) __builtin_amdgcn_mfma_f32_32x32x16_bf16(a, b, c, 0, 0, 0)
constexpr int A64_VSLOT = 8192, A64_K = 0, A64_V = 3 * 12288  , A64_WS = A64_V + 3 * A64_VSLOT, A64_OST = A64_WS + 8 * 256, A64_SIDE = A64_OST + 8 * 4096, A64_END = A64_SIDE + 3 * 2048;
static_assert(A64_END <= LDS_BYTES - 16, "attn64 LDS map");
template <int N> __device__ __forceinline__ void a64_wait_bar() { asm volatile("s_waitcnt vmcnt(%0) lgkmcnt(0)\n\ts_barrier" :: "n"(N) : "memory"); }
__device__ __forceinline__ void a64_glds16(const void* g, unsigned lds_base) {
    unsigned sv; asm volatile("s_mov_b32 %0, m0\n\ts_mov_b32 m0, %2\n\ts_nop 0\n\tglobal_load_lds_dwordx4 %1, off\n\ts_mov_b32 m0, %0" : "=&s"(sv) : "v"(g), "s"(lds_base) : "memory"); }
__device__ __forceinline__ void a64_glds4(const void* g, unsigned lds_base) {
    unsigned sv; asm volatile("s_mov_b32 %0, m0\n\ts_mov_b32 m0, %2\n\ts_nop 0\n\tglobal_load_lds_dword %1, off\n\ts_mov_b32 m0, %0" : "=&s"(sv) : "v"(g), "s"(lds_base) : "memory"); }
__device__ __forceinline__ void a64_kload2(bf16x8* kf, const LAS unsigned char* kp, int d0) { kf[2 * d0] = *(const LAS bf16x8*)(kp + d0 * 2048); kf[2 * d0 + 1] = *(const LAS bf16x8*)(kp + d0 * 2048 + 512); }
__device__ __forceinline__ s16x4 a64_vtr(const LAS unsigned char* p) { return __builtin_bit_cast(s16x4, __builtin_amdgcn_ds_read_tr16_b64_v4i16((LAS s16x4*)p)); }
#define A64_MX3(a, b, c) __builtin_fmaxf(__builtin_fmaxf((a), (b)), (c))
__device__ __forceinline__ float a64_max16(const f32x16& p) {
    float a = A64_MX3(p[0], p[1], p[2]), b = A64_MX3(p[3], p[4], p[5]); a = A64_MX3(a, p[6], p[7]); b = A64_MX3(b, p[8], p[9]); a = A64_MX3(a, p[10], p[11]); b = A64_MX3(b, p[12], p[13]);
    return A64_MX3(a, b, __builtin_fmaxf(p[14], p[15])); }
__device__ __forceinline__ float a64_swapmax(float m) { const auto rr = __builtin_amdgcn_permlane32_swap(__float_as_uint(m), __float_as_uint(m), false, false); return __builtin_fmaxf(__uint_as_float(rr[0]), __uint_as_float(rr[1])); }
__device__ __forceinline__ void a64_cmask(f32x16& p0, f32x16& p1, int jb, int qrel, int hi) {
    const int kb = 64 * jb + 4 * hi;
#pragma unroll
    for (int r = 0; r < 16; ++r) { const int kv = kb + (r & 3) + 8 * (r >> 2); if (kv > qrel) p0[r] = -INFINITY; if (kv + 32 > qrel) p1[r] = -INFINITY; } }
__device__ __forceinline__ void a64_dmask(f32x16& p0, f32x16& p1, unsigned long long mw, int hi) {
    const unsigned long long ms = mw >> (4 * hi); const unsigned lo = (unsigned)ms, hw = (unsigned)(ms >> 32);
#pragma unroll
    for (int i = 0; i < 16; ++i) { const unsigned bit = 1u << ((i & 3) + 8 * (i >> 2)); if (!(lo & bit)) p0[i] = -INFINITY; if (!(hw & bit)) p1[i] = -INFINITY; } }

template <int MODE, int DK>
__device__ __forceinline__ void attn64_unit(LAS unsigned char* lds, const bf16_t* Q, int ldq, const bf16_t* K, int ld  , const bf16_t* V, int ldv,
                                            bf16_t* O  , const float* bias  , const unsigned long long* maskbits  ,
                                            float alibiA, float C2  , int qb, int wid0, const bf16_t* Zg, const float* Gn, float* ssq  ) {
    constexpr float THR = 8.0f; constexpr int KS = DK / 16, KSLOT = (DK == 96) ? 12288 : 8192;
    constexpr int KOPS = ((MODE == 0) ? 1 : 2) + ((DK == 96) ? 1 : 0);
    const int tid = opaque_tid(wid0), lane = tid & 63, r32 = lane & 31, hi = lane >> 5; const int wid = __builtin_amdgcn_readfirstlane(tid >> 6);
    const int q0 = qb * 256, NT = (q0 + 256) / 64, qw0 = q0 + wid * 32;
    const bf16_t* Qw = Q + (size_t)qw0 * ldq;
    const unsigned lds0 = (unsigned)(size_t)lds; LAS float* wsf = (LAS float*)(lds + A64_WS) + wid * 64;
    const bf16_t* ksrc = K + (size_t)lane * ld + wid * 8;
    const bf16_t* ksrc2 = K + (size_t)lane * ld + (8 + (wid & 3)) * 8;
    const bf16_t* vsrc = V + (size_t)(16 * (wid & 3) + (lane >> 2)) * ldv + (wid >> 2) * 32 + (lane & 3) * 8;
    const unsigned* ssrc = (MODE == 1) ? (const unsigned*)(bias + lane) : (MODE == 2) ? (const unsigned*)(maskbits + (size_t)(qw0 + (lane >> 1)) * 128) + (lane & 1) : nullptr;
    constexpr int SSTEP = (MODE == 1) ? 64 : 2;
    const unsigned kdst = lds0 + A64_K + wid * 1024, kdst2 = lds0 + A64_K + (8 + (wid & 3)) * 1024, vdst = lds0 + A64_V + wid * 1024, sdst = lds0 + A64_SIDE + wid * 256;
#define A64_DMA_K(t, slot) do { a64_glds16(ksrc + (size_t)(t) * 64 * ld, (unsigned)__builtin_amdgcn_readfirstlane(kdst + (slot) * KSLOT)); \
        if (DK == 96) a64_glds16(ksrc2 + (size_t)(t) * 64 * ld, (unsigned)__builtin_amdgcn_readfirstlane(kdst2 + (slot) * KSLOT)); \
        if (MODE != 0) a64_glds4(ssrc + (size_t)(t) * SSTEP, (unsigned)__builtin_amdgcn_readfirstlane(sdst + (slot) * 2048)); } while (0)
#define A64_DMA_V(t, slot) a64_glds16(vsrc + (size_t)(t) * 64 * ldv, (unsigned)__builtin_amdgcn_readfirstlane(vdst + (slot) * A64_VSLOT))
    const LAS unsigned char* vp0 = lds + A64_V + ((lane >> 4) & 1) * 32 + (lane & 3) * 8 + (4 * hi + ((lane & 15) >> 2)) * 64;
    const LAS unsigned char* kp0 = lds + A64_K + hi * 1024 + r32 * 16;
    const LAS unsigned char* sp0 = lds + A64_SIDE + wid * 256;
    __syncthreads();
    A64_DMA_K(0, 0); A64_DMA_V(0, 0); A64_DMA_K(1, 1);
    bf16x8 qr[KS];
#pragma unroll
    for (int d0 = 0; d0 < KS; ++d0) qr[d0] = *(const bf16x8*)(Qw + (size_t)r32 * ldq + d0 * 16 + hi * 8);
    float mhat = 0.f, l_reg = 0.f; f32x16 o[2]; o[0] = (f32x16){}; o[1] = (f32x16){};
    f32x16 cini = (f32x16){};
    if (MODE == 2) {
#pragma unroll
        for (int i = 0; i < 16; ++i) cini[i] = alibiA * (float)((i & 3) + 8 * (i >> 2) + 4 * hi); }
    if (MODE != 0) A64_PIN(cini);
    const float ea = (MODE == 2) ? alibiA * C2 : 0.f;
    const int qrel = wid * 32 + r32; bool resc = false;
    f32x16 pA0, pA1, pB0, pB1; bf16x8 kf[2 * KS]; s16x4 vlo[8], vhi[8]; u32x4 pw0, pw1, pw2, pw3;
    int sl_prev = 0, sl_cur = 0, sl_next = 1;
#define A64_ROT() do { sl_prev = sl_cur; sl_cur = sl_next; sl_next = (sl_next == 2) ? 0 : sl_next + 1; } while (0)
#define A64_EX(v, NM) __builtin_amdgcn_exp2f(__builtin_fmaf((v), C2, NM))
#define A64_RESC() do { if (resc) { _Pragma("unroll") for (int d_ = 0; d_ < 2; ++d_) _Pragma("unroll") for (int r = 0; r < 16; ++r) o[d_][r] *= wsf[crow(r, hi)]; } } while (0)
#define A64_CINIT(C0, C1, slot) do { if (MODE == 1) { const LAS float* bl_ = (const LAS float*)(sp0 + (slot) * 2048); \
        _Pragma("unroll") for (int g_ = 0; g_ < 4; ++g_) { const f32x4 b0_ = *(const LAS f32x4*)(bl_ + 8 * g_ + 4 * hi), b1_ = *(const LAS f32x4*)(bl_ + 32 + 8 * g_ + 4 * hi); \
            _Pragma("unroll") for (int e_ = 0; e_ < 4; ++e_) { C0[4 * g_ + e_] = b0_[e_]; C1[4 * g_ + e_] = b1_[e_]; } } } \
        else if (MODE == 0) { C0 = (f32x16){}; C1 = (f32x16){}; }     \
        else { C0 = cini; C1 = cini; } } while (0)
#define A64_ROWREF(C0, C1, t) a64_swapmax(__builtin_fmaxf(__builtin_fmaf(a64_max16(C0), C2, ea * (float)(64 * (t))), __builtin_fmaf(a64_max16(C1), C2, ea * (float)(64 * (t) + 32))))
    A64_DMA_K(2, 2);
    a64_wait_bar<2 * KOPS + 1>();
    _Pragma("unroll") for (int d0 = 0; d0 < KS; ++d0) a64_kload2(kf, kp0, d0);
    { unsigned long long mw0 = 0ull; if (MODE == 2) mw0 = *(const LAS unsigned long long*)(sp0 + r32 * 8);
      A64_CINIT(pA0, pA1, 0);
      _Pragma("unroll") for (int d0 = 0; d0 < KS; ++d0) { pA0 = A64_MFMA(kf[2 * d0], qr[d0], pA0); pA1 = A64_MFMA(kf[2 * d0 + 1], qr[d0], pA1); }
      if (MODE == 2) a64_dmask(pA0, pA1, mw0, hi);
      if (NT == 4) a64_cmask(pA0, pA1, 0, qrel, hi); }
    { mhat = __builtin_fmaxf(A64_ROWREF(pA0, pA1, 0), -1e30f); const float nm0 = -mhat, nm1 = ea * 32.0f - mhat;
#pragma unroll
      for (int r = 0; r < 16; ++r) { pA0[r] = A64_EX(pA0[r], nm0); pA1[r] = A64_EX(pA1[r], nm1); } }
    a64_wait_bar<0>();
    A64_DMA_K(3, 0); A64_DMA_V(1, 1); A64_ROT();
    _Pragma("unroll") for (int d0 = 0; d0 < KS; ++d0) a64_kload2(kf, kp0 + sl_cur * KSLOT, d0);
    if (MODE == 1) A64_CINIT(pB0, pB1, sl_cur);
    a64_wait_bar<KOPS + 1>();
#define A64_PKW(P, i) pk2(P[i], P[i + 1])
#define A64_PAF(k) __builtin_bit_cast(bf16x8, pw##k)
#define A64_VFR(i) (bf16x8){vlo[i][0], vlo[i][1], vlo[i][2], vlo[i][3], vhi[i][0], vhi[i][1], vhi[i][2], vhi[i][3]}
#define A64_VRD(i) do { vlo[i] = a64_vtr(vp_ + (((i) >> 2) * 4096 + ((i) & 3) * 1024)); vhi[i] = a64_vtr(vp_ + (((i) >> 2) * 4096 + ((i) & 3) * 1024 + 512)); } while (0)
#define A64_BRD(G, P0, P1, g_) do { if (MODE == 1 && (G)) { const LAS float* bl_ = (const LAS float*)(sp0 + sl_next * 2048); \
        const f32x4 b0_ = *(const LAS f32x4*)(bl_ + 8 * (g_) + 4 * hi), b1_ = *(const LAS f32x4*)(bl_ + 32 + 8 * (g_) + 4 * hi); \
        _Pragma("unroll") for (int e_ = 0; e_ < 4; ++e_) { P0[4 * (g_) + e_] = b0_[e_]; P1[4 * (g_) + e_] = b1_[e_]; } } } while (0)
#define A64_KRD(G, d0) do { if (G) { a64_kload2(kf, kp0 + sl_next * KSLOT, d0); A64_SBAR(); } } while (0)
#define A64_GAPA(MF, a0, a1, a2, a3, W0, W1, PW) do { MF; sacc += a0; sacc += a1; sacc += a2; sacc += a3; W0; W1; A64_PIN(PW); A64_PIN(sacc); A64_SBAR(); } while (0)
#define A64_GAPB(MF, X, i, NM) do { MF; X[i] = A64_EX(X[i], NM); X[i + 1] = A64_EX(X[i + 1], NM); X[i + 2] = A64_EX(X[i + 2], NM); X[i + 3] = A64_EX(X[i + 3], NM); A64_PIN(X); A64_SBAR(); } while (0)
#define A64_STEP(C0, C1, P0, P1, t, MASK, GK, GV, GL) do { A64_SBAR(); \
    unsigned long long mw_ = 0ull; if (MODE == 2) { mw_ = *(const LAS unsigned long long*)(sp0 + sl_cur * 2048 + r32 * 8); } \
    if (MODE != 1) A64_CINIT(C0, C1, sl_cur);     \
    const LAS unsigned char* vp_ = vp0 + sl_prev * A64_VSLOT; \
    A64_VRD(0); A64_SBAR(); float sacc = P0[0] + P0[1]; \
                    A64_GAPA(C0 = A64_MFMA(kf[0], qr[0], C0), P0[2], P0[3], P0[4], P0[5],     pw0[0] = A64_PKW(P0, 0),  pw0[1] = A64_PKW(P0, 2),  pw0); \
    A64_VRD(4); A64_SBAR(); A64_GAPA(C1 = A64_MFMA(kf[1], qr[0], C1), P0[6], P0[7], P0[8], P0[9],     pw0[2] = A64_PKW(P0, 4),  pw0[3] = A64_PKW(P0, 6),  pw0); \
    A64_VRD(1); A64_SBAR(); A64_GAPA(C0 = A64_MFMA(kf[2], qr[1], C0),    P0[10], P0[11], P0[12], P0[13], pw1[0] = A64_PKW(P0, 8),  pw1[1] = A64_PKW(P0, 10), pw1); \
    A64_VRD(5); A64_SBAR(); A64_GAPA(C1 = A64_MFMA(kf[3], qr[1], C1),    P0[14], P0[15], P1[0], P1[1],   pw1[2] = A64_PKW(P0, 12), pw1[3] = A64_PKW(P0, 14), pw1); \
    A64_VRD(2); A64_SBAR(); A64_GAPA(C0 = A64_MFMA(kf[4], qr[2], C0),    P1[2], P1[3], P1[4], P1[5],     pw2[0] = A64_PKW(P1, 0),  pw2[1] = A64_PKW(P1, 2),  pw2); \
    A64_VRD(6); A64_SBAR(); A64_GAPA(C1 = A64_MFMA(kf[5], qr[2], C1),    P1[6], P1[7], P1[8], P1[9],     pw2[2] = A64_PKW(P1, 4),  pw2[3] = A64_PKW(P1, 6),  pw2); \
    A64_VRD(3); A64_SBAR(); A64_GAPA(C0 = A64_MFMA(kf[6], qr[3], C0),    P1[10], P1[11], P1[12], P1[13], pw3[0] = A64_PKW(P1, 8),  pw3[1] = A64_PKW(P1, 10), pw3); \
    A64_VRD(7); A64_SBAR(); A64_GAPA(C1 = A64_MFMA(kf[7], qr[3], C1),    P1[14], P1[15], 0.f, 0.f,       pw3[2] = A64_PKW(P1, 12), pw3[3] = A64_PKW(P1, 14), pw3); \
    if (KS == 6) { C0 = A64_MFMA(kf[8], qr[4], C0); C1 = A64_MFMA(kf[9], qr[4], C1); C0 = A64_MFMA(kf[10], qr[5], C0); C1 = A64_MFMA(kf[11], qr[5], C1); A64_SBAR(); } \
    l_reg += sacc; \
    if (MODE == 2) { unsigned ml_ = (unsigned)mw_, mh_ = (unsigned)(mw_ >> 32); A64_PIN(ml_); A64_PIN(mh_); mw_ = ((unsigned long long)mh_ << 32) | ml_; }     \
    if (GK) A64_DMA_K((t) + 3, sl_cur); if (GV) A64_DMA_V((t) + 1, sl_next); \
    if (MODE == 2) a64_dmask(C0, C1, mw_, hi); \
    if (MASK) a64_cmask(C0, C1, (t) - (NT - 4), qrel, hi); \
    { const float rs_ = A64_ROWREF(C0, C1, t); resc = false; \
      if (__builtin_expect(__any(rs_ - mhat > THR), 0)) { const float mn_ = __builtin_fmaxf(mhat, rs_); const float f_ = __builtin_amdgcn_exp2f(mhat - mn_); mhat = mn_; \
          l_reg *= f_; if (hi == 0) wsf[r32] = f_; resc = true; } } \
    const float nm0_ = ea * (float)(64 * (t)) - mhat, nm1_ = ea * (float)(64 * (t) + 32) - mhat; A64_SBAR(); \
    A64_GAPB(o[0] = A64_MFMA(A64_PAF(0), A64_VFR(0), o[0]), C0, 0, nm0_);              A64_GAPB(o[1] = A64_MFMA(A64_PAF(0), A64_VFR(4), o[1]), C0, 4, nm0_); \
    A64_KRD(GL, 0); A64_BRD(GL, P0, P1, 0); A64_GAPB(o[0] = A64_MFMA(A64_PAF(1), A64_VFR(1), o[0]), C0, 8, nm0_);  A64_KRD(GL, 1); A64_BRD(GL, P0, P1, 1); A64_GAPB(o[1] = A64_MFMA(A64_PAF(1), A64_VFR(5), o[1]), C0, 12, nm0_); \
    A64_KRD(GL, 2); A64_BRD(GL, P0, P1, 2); A64_GAPB(o[0] = A64_MFMA(A64_PAF(2), A64_VFR(2), o[0]), C1, 0, nm1_);  A64_KRD(GL, 3); A64_BRD(GL, P0, P1, 3); A64_GAPB(o[1] = A64_MFMA(A64_PAF(2), A64_VFR(6), o[1]), C1, 4, nm1_); \
    if (KS == 6) A64_KRD(GL, 4); A64_GAPB(o[0] = A64_MFMA(A64_PAF(3), A64_VFR(3), o[0]), C1, 8, nm1_);  if (KS == 6) A64_KRD(GL, 5); A64_GAPB(o[1] = A64_MFMA(A64_PAF(3), A64_VFR(7), o[1]), C1, 12, nm1_); \
    } while (0)
    int t = 1;
    for (; t + 5 < NT; t += 2) {
        A64_STEP(pB0, pB1, pA0, pA1, t, false, true, true, true);     a64_wait_bar<KOPS + 1>(); A64_RESC(); A64_ROT();
        A64_STEP(pA0, pA1, pB0, pB1, t + 1, false, true, true, true); a64_wait_bar<KOPS + 1>(); A64_RESC(); A64_ROT();
    }
#define A64_ENDW(tt) do { if ((tt) + 3 < NT) { a64_wait_bar<KOPS + 1>(); } else if ((tt) + 2 < NT) { a64_wait_bar<1>(); } else { a64_wait_bar<0>(); } } while (0)
    for (; t + 1 < NT; t += 2) {
        A64_STEP(pB0, pB1, pA0, pA1, t, true, (t + 3 < NT), (t + 1 < NT), (t + 1 < NT));         A64_ENDW(t);     A64_RESC(); A64_ROT();
        A64_STEP(pA0, pA1, pB0, pB1, t + 1, true, (t + 4 < NT), (t + 2 < NT), (t + 2 < NT));     A64_ENDW(t + 1); A64_RESC(); A64_ROT();
    }
    A64_STEP(pB0, pB1, pA0, pA1, NT - 1, true, false, false, false); A64_RESC();
    { float sacc = pB0[0] + pB0[1];
#pragma unroll
      for (int r = 2; r < 16; ++r) sacc += pB0[r];
#pragma unroll
      for (int r = 0; r < 16; ++r) sacc += pB1[r];
      l_reg += sacc;
      pw0 = (u32x4){A64_PKW(pB0, 0), A64_PKW(pB0, 2), A64_PKW(pB0, 4), A64_PKW(pB0, 6)}; pw1 = (u32x4){A64_PKW(pB0, 8), A64_PKW(pB0, 10), A64_PKW(pB0, 12), A64_PKW(pB0, 14)};
      pw2 = (u32x4){A64_PKW(pB1, 0), A64_PKW(pB1, 2), A64_PKW(pB1, 4), A64_PKW(pB1, 6)}; pw3 = (u32x4){A64_PKW(pB1, 8), A64_PKW(pB1, 10), A64_PKW(pB1, 12), A64_PKW(pB1, 14)};
      const LAS unsigned char* vp_ = vp0 + sl_cur * A64_VSLOT; _Pragma("unroll") for (int i = 0; i < 8; ++i) A64_VRD(i);
      o[0] = A64_MFMA(A64_PAF(0), A64_VFR(0), o[0]); o[1] = A64_MFMA(A64_PAF(0), A64_VFR(4), o[1]); o[0] = A64_MFMA(A64_PAF(1), A64_VFR(1), o[0]); o[1] = A64_MFMA(A64_PAF(1), A64_VFR(5), o[1]);
      o[0] = A64_MFMA(A64_PAF(2), A64_VFR(2), o[0]); o[1] = A64_MFMA(A64_PAF(2), A64_VFR(6), o[1]); o[0] = A64_MFMA(A64_PAF(3), A64_VFR(3), o[0]); o[1] = A64_MFMA(A64_PAF(3), A64_VFR(7), o[1]); }
    l_reg = swap32_sum(l_reg);
    if (hi == 0) wsf[32 + r32] = l_reg; asm volatile("s_waitcnt lgkmcnt(0)" ::: "memory");
    float rli[16];
#pragma unroll
    for (int r = 0; r < 16; ++r) rli[r] = __builtin_amdgcn_rcpf(wsf[32 + crow(r, hi)]);
    LAS bf16_t* stg = (LAS bf16_t*)(lds + A64_OST) + wid * 2048;
#pragma unroll
    for (int r = 0; r < 16; ++r) { const int orow = crow(r, hi);
#pragma unroll
        for (int d0 = 0; d0 < 2; ++d0) stg[orow * 64 + d0 * 32 + r32] = (bf16_t)pk2(o[d0][r] * rli[r], 0.f); }
    asm volatile("s_waitcnt lgkmcnt(0)" ::: "memory");
#pragma unroll
    for (int i = 0; i < 4; ++i) { const int row = i * 8 + (lane >> 3), ch = lane & 7; const size_t grow = (size_t)(qw0 + row);
        const u32x4 vv = *(const LAS u32x4*)(stg + row * 64 + ch * 8); const u32x4 zz = *(const u32x4*)(Zg + grow * NP + ch * 8);
        const f32x4 g0 = *(const f32x4*)(Gn + ch * 8), g1 = *(const f32x4*)(Gn + ch * 8 + 4);
        float sq = 0.f; u32x4 w;
#pragma unroll
        for (int e = 0; e < 4; ++e) { const float va = bflo(vv[e]), vb_ = bfhi(vv[e]); sq += va * va + vb_ * vb_;
            const float ga = (e < 2) ? g0[2 * e] : g1[2 * e - 4], gb = (e < 2) ? g0[2 * e + 1] : g1[2 * e - 3];
            w[e] = pk2(va * ga * silu_fast(bflo(zz[e])), vb_ * gb * silu_fast(bfhi(zz[e]))); }
        *(u32x4*)(O + grow * D + ch * 8) = w;
        sq += quad_xor1(sq); sq += quad_xor2(sq);
        sq += __builtin_bit_cast(float, __builtin_amdgcn_update_dpp(0, __builtin_bit_cast(int, sq), 0x141, 0xf, 0xf, false));
        if (ch == 0) ssq[grow * 16] = sq; }
    asm volatile("s_waitcnt lgkmcnt(0)\n\ts_barrier" ::: "memory");
#undef A64_DMA_K
#undef A64_DMA_V
#undef A64_ROT
#undef A64_EX
#undef A64_RESC
#undef A64_CINIT
#undef A64_ROWREF
#undef A64_PKW
#undef A64_PAF
#undef A64_VFR
#undef A64_VRD
#undef A64_KRD
#undef A64_BRD
#undef A64_ENDW
#undef A64_GAPA
#undef A64_GAPB
#undef A64_STEP
}

constexpr int DSA_H1 = 0, DSA_H2 = 65536, DSA_INFO = 65536 + 32768;
__device__ __forceinline__ unsigned score_key32(float s) { const unsigned u = __float_as_uint(s); return u ^ ((unsigned)((int)u >> 31) | 0x80000000u); }
__device__ __forceinline__ unsigned score_key16(float s) { return score_key32(s) >> 16; }
__device__ __forceinline__ float key32_to_float(unsigned k) { return __uint_as_float((k & 0x80000000u) ? (k ^ 0x80000000u) : ~k); }
__device__ __forceinline__ float relu_f(float x) { const int b_ = __builtin_bit_cast(int, x); return __builtin_bit_cast(float, b_ > 0 ? b_ : 0); }

struct KFrag { bf16x8 a00, a01, a10, a11; };
__device__ __forceinline__ void dsa_kload(KFrag& f, const bf16_t* kix  , int t, int r, int hi) {
    const bf16_t* p = kix + ((size_t)t * 64 + r) * 32 + hi * 8;
    f.a00 = *(const bf16x8*)p; f.a01 = *(const bf16x8*)(p + 16); f.a10 = *(const bf16x8*)(p + 1024); f.a11 = *(const bf16x8*)(p + 1024 + 16);
}
__device__ __forceinline__ void dsa_scores(f32x16& s0, f32x16& s1, const KFrag& f, const bf16x8 (&qi)[4][2], const float (&w)[4]) {
    s0 = (f32x16){}; s1 = (f32x16){};
#pragma unroll
    for (int ih = 0; ih < 4; ++ih) {
        f32x16 a = __builtin_amdgcn_mfma_f32_32x32x16_bf16(f.a00, qi[ih][0], (f32x16){}, 0, 0, 0); a = __builtin_amdgcn_mfma_f32_32x32x16_bf16(f.a01, qi[ih][1], a, 0, 0, 0);
        f32x16 c = __builtin_amdgcn_mfma_f32_32x32x16_bf16(f.a10, qi[ih][0], (f32x16){}, 0, 0, 0); c = __builtin_amdgcn_mfma_f32_32x32x16_bf16(f.a11, qi[ih][1], c, 0, 0, 0);
#pragma unroll
        for (int i = 0; i < 16; ++i) { s0[i] = __builtin_fmaf(w[ih], relu_f(a[i]), s0[i]); s1[i] = __builtin_fmaf(w[ih], relu_f(c[i]), s1[i]); }
    }
}
__device__ __forceinline__ void hist_add(LAS unsigned* hrow, int r, unsigned bin) { atomicAdd((unsigned*)(hrow + ((bin >> 1) ^ (unsigned)r)), 1u << ((bin & 1u) * 16u)); }

__device__ __forceinline__ void dsa_index_unit(LAS unsigned char* lds, const bf16_t* proj, const bf16_t* kidx, const float* side, unsigned long long* maskbits, int b, int qg, int wid0) {
    const int tid = opaque_tid(wid0), lane = tid & 63, wv = __builtin_amdgcn_readfirstlane(tid >> 6), r = lane & 31, hi = lane >> 5;
    const int tq = qg * 32 + r; const size_t rowq = (size_t)b * S + tq;
    const int nt = (qg >> 1) + 1;
    const int per = (nt + 7) >> 3; const int t_lo = wv * per, t_hi = (t_lo + per < nt) ? t_lo + per : nt;
    bf16x8 qi[4][2]; float w[4];
#pragma unroll
    for (int ih = 0; ih < 4; ++ih) { qi[ih][0] = *(const bf16x8*)(proj + rowq * NP + C_IQ + ih * 32 + hi * 8); qi[ih][1] = *(const bf16x8*)(proj + rowq * NP + C_IQ + ih * 32 + 16 + hi * 8);
        w[ih] = side[rowq * 32 + 4 + ih] * 0.5f; }
    LAS unsigned* h1 = (LAS unsigned*)(lds + DSA_H1) + r * 512; LAS unsigned* h2 = (LAS unsigned*)(lds + DSA_H2) + wv * 1024 + r * 32;
    LAS int* info = (LAS int*)(lds + DSA_INFO);
    const bf16_t* kix = kidx + (size_t)b * S * 32;
    const bool sel_all = (qg < 8);
    __syncthreads();
    if (!sel_all) {
        for (int i = tid; i < (DSA_INFO) / 16; i += NTHREADS) ((LAS u32x4*)lds)[i] = (u32x4){0u, 0u, 0u, 0u};
        __syncthreads();
        if (t_lo < t_hi) {
            KFrag cur, nxt; dsa_kload(cur, kix, t_lo, r, hi);
            for (int t = t_lo; t < t_hi; ++t) {
                if (t + 1 < t_hi) dsa_kload(nxt, kix, t + 1, r, hi);
                f32x16 s0, s1; dsa_scores(s0, s1, cur, qi, w);
                const int kv0 = t * 64;
                if (kv0 + 63 <= qg * 32) {
#pragma unroll
                    for (int i = 0; i < 16; ++i) { hist_add(h1, r, score_key32(s0[i]) >> 22); hist_add(h1, r, score_key32(s1[i]) >> 22); }
                } else {
#pragma unroll
                    for (int i = 0; i < 16; ++i) { const int kv = kv0 + crow(i, hi);
                        if (kv <= tq) hist_add(h1, r, score_key32(s0[i]) >> 22);
                        if (kv + 32 <= tq) hist_add(h1, r, score_key32(s1[i]) >> 22); }
                }
                cur = nxt;
            }
        }
        __syncthreads();
        { const int row = tid >> 4, part = tid & 15; const LAS unsigned* hr = (const LAS unsigned*)(lds + DSA_H1) + row * 512; unsigned cs = 0;
#pragma unroll 8
          for (int j = 0; j < 32; ++j) { const unsigned wd = hr[(part * 32 + j) ^ row]; cs += (wd & 0xffffu) + (wd >> 16); }
          unsigned suf = cs;
#pragma unroll
          for (int o = 1; o < 16; o <<= 1) { const unsigned t = __shfl_down(suf, o, 16); if (part + o < 16) suf += t; }
          const unsigned above = suf - cs;
          if (above < 256u && above + cs >= 256u) { unsigned acc = above; int bsel = part * 64; unsigned ab = above;
              for (int j = 31; j >= 0; --j) { const unsigned wd = hr[(part * 32 + j) ^ row]; const unsigned c1 = wd >> 16, c0 = wd & 0xffffu;
                  if (acc + c1 >= 256u) { bsel = part * 64 + 2 * j + 1; ab = acc; break; } acc += c1;
                  if (acc + c0 >= 256u) { bsel = part * 64 + 2 * j; ab = acc; break; } acc += c0; }
              info[row] = bsel; info[32 + row] = 256 - (int)ab; } }
        __syncthreads();
        const unsigned B1 = (unsigned)info[r];
        const float blo = key32_to_float(B1 << 22), bhi = (B1 >= 1023u) ? INFINITY : key32_to_float((B1 + 1u) << 22);
        if (t_lo < t_hi) {
            KFrag cur, nxt; dsa_kload(cur, kix, t_lo, r, hi);
            for (int t = t_lo; t < t_hi; ++t) {
                if (t + 1 < t_hi) dsa_kload(nxt, kix, t + 1, r, hi);
                f32x16 s0, s1; dsa_scores(s0, s1, cur, qi, w);
                const int kv0 = t * 64;
                if (kv0 + 63 <= qg * 32) {
#pragma unroll
                    for (int i = 0; i < 16; ++i) {
                        if (s0[i] >= blo && s0[i] < bhi) hist_add(h2, r, (score_key32(s0[i]) >> 16) & 63u);
                        if (s1[i] >= blo && s1[i] < bhi) hist_add(h2, r, (score_key32(s1[i]) >> 16) & 63u); }
                } else {
#pragma unroll
                    for (int i = 0; i < 16; ++i) { const int kv = kv0 + crow(i, hi);
                        if (kv <= tq && s0[i] >= blo && s0[i] < bhi) hist_add(h2, r, (score_key32(s0[i]) >> 16) & 63u);
                        if (kv + 32 <= tq && s1[i] >= blo && s1[i] < bhi) hist_add(h2, r, (score_key32(s1[i]) >> 16) & 63u); }
                }
                cur = nxt;
            }
        }
        __syncthreads();
        { const int row = tid >> 4, part = tid & 15; unsigned cnt[4]; unsigned cs = 0; const unsigned need1 = (unsigned)info[32 + row];
          LAS unsigned* h2a = (LAS unsigned*)(lds + DSA_H2);
#pragma unroll
          for (int j = 0; j < 2; ++j) { unsigned c0 = 0, c1 = 0; const int wi = row * 32 + ((part * 2 + j) ^ row);
#pragma unroll
              for (int ww = 0; ww < 8; ++ww) { const unsigned wd = h2a[ww * 1024 + wi]; c0 += wd & 0xffffu; c1 += wd >> 16; }
              cnt[2 * j] = c0; cnt[2 * j + 1] = c1; cs += c0 + c1; }
          unsigned suf = cs;
#pragma unroll
          for (int o = 1; o < 16; o <<= 1) { const unsigned t = __shfl_down(suf, o, 16); if (part + o < 16) suf += t; }
          const unsigned above = suf - cs;
          if (above < need1 && above + cs >= need1) { unsigned acc = above; int bsel = 0; unsigned ab = above; bool found = false;
#pragma unroll
              for (int j = 3; j >= 0; --j) { if (!found) { if (acc + cnt[j] >= need1) { bsel = part * 4 + j; ab = acc; found = true; } else acc += cnt[j]; } }
              info[64 + row] = (int)(((unsigned)info[row] << 6) | (unsigned)bsel); info[96 + row] = (int)(need1 - ab);
              const int wi = row * 32 + ((bsel >> 1) ^ row); unsigned run = 0;
#pragma unroll
              for (int ww = 0; ww < 8; ++ww) { info[128 + row * 8 + ww] = (int)run; const unsigned wd = h2a[ww * 1024 + wi]; run += (bsel & 1) ? (wd >> 16) : (wd & 0xffffu); } } }
        __syncthreads();
    }
    const unsigned T = sel_all ? 0u : (unsigned)info[64 + r];
    const unsigned need2 = sel_all ? 0x7fffffffu : (unsigned)info[96 + r];
    unsigned tc = sel_all ? 0u : (unsigned)info[128 + r * 8 + wv];
    const float f_lo = sel_all ? -INFINITY : key32_to_float(T << 16), f_hi = sel_all ? -INFINITY : ((T >= 0xffffu) ? INFINITY : key32_to_float((T + 1u) << 16));
    if (t_lo < t_hi) {
        KFrag cur, nxt; dsa_kload(cur, kix, t_lo, r, hi);
        for (int t = t_lo; t < t_hi; ++t) {
            if (t + 1 < t_hi) dsa_kload(nxt, kix, t + 1, r, hi);
            f32x16 s0, s1; dsa_scores(s0, s1, cur, qi, w);
            const int kv0 = t * 64; unsigned words[2];
#pragma unroll
            for (int half = 0; half < 2; ++half) {
                unsigned gt = 0, eq = 0;
                if (kv0 + 63 <= qg * 32) {
                    unsigned ge = 0;
#pragma unroll
                    for (int i = 15; i >= 0; --i) { const float sv = half ? s1[i] : s0[i];
                        asm("v_cmp_ge_f32 vcc, %1, %2\n\tv_addc_co_u32 %0, vcc, %0, %0, vcc" : "+v"(gt) : "v"(sv), "v"(f_hi) : "vcc");
                        asm("v_cmp_ge_f32 vcc, %1, %2\n\tv_addc_co_u32 %0, vcc, %0, %0, vcc" : "+v"(ge) : "v"(sv), "v"(f_lo) : "vcc"); }
                    eq = ge & ~gt;
                } else {
#pragma unroll
                    for (int i = 0; i < 16; ++i) { const int kv = kv0 + 32 * half + crow(i, hi); const unsigned k = score_key16(half ? s1[i] : s0[i]);
                        const unsigned v = (kv <= tq) ? 1u : 0u; gt |= ((k > T) ? v : 0u) << i; eq |= ((k == T) ? v : 0u) << i; }
                }
                unsigned sel = gt;
                if (__any(eq != 0u)) {
                    const unsigned a0 = __popc(eq & 0xfu), a1 = __popc(eq & 0xf0u), a2 = __popc(eq & 0xf00u), a3 = __popc(eq & 0xf000u);
                    const unsigned own = a0 | (a1 << 8) | (a2 << 16) | (a3 << 24); unsigned oth; { const auto rr_ = __builtin_amdgcn_permlane32_swap(own, own, false, false); oth = rr_[0] + rr_[1] - own; }
                    const unsigned b0 = oth & 255u, b1 = (oth >> 8) & 255u, b2 = (oth >> 16) & 255u, b3 = oth >> 24;
                    unsigned pre[4]; const unsigned hb = hi ? 1u : 0u;
                    pre[0] = tc + hb * b0; pre[1] = tc + a0 + b0 + hb * b1; pre[2] = tc + a0 + b0 + a1 + b1 + hb * b2; pre[3] = tc + a0 + b0 + a1 + b1 + a2 + b2 + hb * b3;
#pragma unroll
                    for (int g = 0; g < 4; ++g) { unsigned rk = pre[g];
#pragma unroll
                        for (int e = 0; e < 4; ++e) { const unsigned bit = 1u << (4 * g + e); if (eq & bit) { if (rk < need2) sel |= bit; ++rk; } } }
                    tc += a0 + a1 + a2 + a3 + b0 + b1 + b2 + b3;
                }
                unsigned wbits = (sel & 0xfu) | ((sel & 0xf0u) << 4) | ((sel & 0xf00u) << 8) | ((sel & 0xf000u) << 12);
                wbits <<= 4 * hi;
                { const auto rr_ = __builtin_amdgcn_permlane32_swap(wbits, wbits, false, false); wbits = rr_[0] | rr_[1]; }
                words[half] = wbits;
            }
            if (hi == 0) maskbits[(size_t)tq * 128 + t] = (unsigned long long)words[0] | ((unsigned long long)words[1] << 32);
            cur = nxt;
        }
    }
}

constexpr int NSA_IMP = ATT_EXTRA;
constexpr int NSA_SEL = NSA_IMP + 32768;
constexpr int NSA_UNI = NSA_SEL + 1024;
constexpr int NSA_LIST = NSA_UNI + 64;
constexpr int NSA_OT = NSA_LIST + 1024;
static_assert(NSA_OT + 65536 <= LDS_BYTES, "NSA LDS map");

__device__ __forceinline__ void nsa_unit(LAS unsigned char* lds, const bf16_t* proj, const float* side, const bf16_t* kc, const bf16_t* vc, bf16_t* ocat, int b, int q64, int wid0, const float* gn  , float* ssq  ) {
    const int tid = opaque_tid(wid0), lane = tid & 63, wv = __builtin_amdgcn_readfirstlane(tid >> 6), r = lane & 31, hi = lane >> 5;
    const int t0 = q64 * 64, q8 = r >> 2, hd = r & 3, tq = t0 + wv * 8 + q8; const size_t rowq = (size_t)b * S + tq;
    const float c2 = 0.125f * LOG2E;
    const float slope = (hd == 0) ? 0.25f : (hd == 1 ? 0.0625f : (hd == 2 ? 0.015625f : 0.00390625f));
    const float A = 8.0f * slope;
    bf16x8 qf[4];
#pragma unroll
    for (int s = 0; s < 4; ++s) qf[s] = *(const bf16x8*)(proj + rowq * NP + C_NQ + hd * 64 + s * 16 + hi * 8);
    const float g0 = sigmoid_f(side[rowq * 32 + 8 + hd * 3 + 0]), g1 = sigmoid_f(side[rowq * 32 + 8 + hd * 3 + 1]), g2 = sigmoid_f(side[rowq * 32 + 8 + hd * 3 + 2]);
    const int vb = ((lane >> 4) & 1) * 32 + (lane & 3) * 8 + (4 * hi + ((lane & 15) >> 2)) * 64;
    LAS float* imp = (LAS float*)(lds + NSA_IMP) + wv * 1024;
    LAS unsigned* selw = (LAS unsigned*)(lds + NSA_SEL) + wv * 32;
    LAS unsigned* uni = (LAS unsigned*)(lds + NSA_UNI);
    LAS int* list = (LAS int*)(lds + NSA_LIST);
    LAS float* otl = (LAS float*)(lds + NSA_OT) + wv * 2048 + lane;
    StageRegs<64> sr;
    __syncthreads();
    for (int i = lane; i < 1024; i += 64) imp[i] = 0.f;
    if (tid < 4) uni[tid] = 0u;
    const bf16_t* kcb = kc + (size_t)b * 512 * 64; const bf16_t* vcb = vc + (size_t)b * 512 * 64;
    const int ntc = (((t0 + 32) >> 4) >> 6) + 1;
    SoftState st; st.m = NEG_BIG; st.l = 0.f; st.o0 = (f32x16){}; st.o1 = (f32x16){};
    for (int pass = 0; pass < 2; ++pass) {
        stage_load<64>(sr, kcb, 64, vcb, 64, nullptr, 0, wid0);
        __syncthreads();
        stage_store<64>(sr, lds, 0, false, wid0);
        if (1 < ntc) stage_load<64>(sr, kcb, 64, vcb, 64, nullptr, 64, wid0);
        __syncthreads();
        float rl = 0.f;
        if (pass == 1) { const float l = st.l + __shfl_xor(st.l, 32); rl = l > 0.f ? 1.0f / l : 0.f; }
        const float mc = st.m * c2;
        for (int t = 0; t < ntc; ++t) {
            const int buf = t & 1;
            f32x16 p0, p1; const int n0 = t * 64;
            { const float base = A * (float)(16 * (n0 + 4 * hi) + 31);
#pragma unroll
              for (int i = 0; i < 16; ++i) { p0[i] = base + A * 16.0f * (float)((i & 3) + 8 * (i >> 2)); p1[i] = p0[i] + A * 512.0f; } }
            qk_tile<4>(p0, p1, lds + ATT_K0 + buf * ATT_KBUF, KSTR64, qf, r, hi);
#pragma unroll
            for (int i = 0; i < 16; ++i) { const int n = n0 + crow(i, hi); if (16 * n + 31 > tq) p0[i] = -INFINITY; if (16 * (n + 32) + 31 > tq) p1[i] = -INFINITY; }
            if (pass == 0) {
                const float mx = tile_max(p0, p1); const float mn = fmaxf(st.m, mx);
                const float al = __builtin_amdgcn_exp2f((st.m - mn) * c2); st.l *= al; st.m = mn; const float mcc = mn * c2; float sum = 0.f;
#pragma unroll
                for (int i = 0; i < 16; ++i) sum += __builtin_amdgcn_exp2f(__builtin_fmaf(p0[i], c2, -mcc)) + __builtin_amdgcn_exp2f(__builtin_fmaf(p1[i], c2, -mcc));
                st.l += sum;
            } else {
#pragma unroll
                for (int i = 0; i < 16; ++i) { p0[i] = __builtin_amdgcn_exp2f(__builtin_fmaf(p0[i], c2, -mc)) * rl; p1[i] = __builtin_amdgcn_exp2f(__builtin_fmaf(p1[i], c2, -mc)) * rl; }
#pragma unroll
                for (int half = 0; half < 2; ++half)
#pragma unroll
                    for (int g = 0; g < 4; ++g) { const f32x16& pp = half ? p1 : p0;
                        float s4 = (pp[4 * g] + pp[4 * g + 1]) + (pp[4 * g + 2] + pp[4 * g + 3]); float s3 = pp[4 * g + 3];
                        s4 += quad_xor1(s4); s4 += quad_xor2(s4); s3 += quad_xor1(s3); s3 += quad_xor2(s3);
                        const int j1 = 16 * t + 8 * half + 2 * g + hi;
                        if (hd == 0) atomicAdd((float*)(imp + q8 * 128 + j1), s4);
                        if (hd == 0 && j1 + 1 < 128) atomicAdd((float*)(imp + q8 * 128 + j1 + 1), s3); }
                pv_tile(st.o0, st.o1, p0, p1, lds + ATT_V0 + buf * ATT_VBUF, vb);
            }
            if (t + 1 < ntc) stage_store<64>(sr, lds, buf ^ 1, false, wid0);
            if (t + 2 < ntc) stage_load<64>(sr, kcb, 64, vcb, 64, nullptr, (t + 2) * 64, wid0);
            __syncthreads();
        }
    }
#pragma unroll
    for (int i = 0; i < 16; ++i) { otl[i * 64] = st.o0[i] * g0; otl[(16 + i) * 64] = st.o1[i] * g0; }
    {
        const int cur = q64;
        for (int qq = 0; qq < 8; ++qq) {
            float v0 = imp[qq * 128 + lane], v1 = imp[qq * 128 + 64 + lane];
            bool ok0 = true, ok1 = true;
            { const int j0 = lane, j1 = lane + 64;
              if (j0 == 0 || j0 == cur) v0 = INFINITY; else if (j0 > cur) ok0 = false;
              if (j1 == cur) v1 = INFINITY; else if (j1 > cur) ok1 = false; }
            const unsigned k0 = __float_as_uint(v0), k1 = __float_as_uint(v1);
            unsigned T = 0u;
            for (int bit = 30; bit >= 0; --bit) { const unsigned cand = T | (1u << bit);
                const int cnt = __popcll(__ballot(ok0 && k0 >= cand)) + __popcll(__ballot(ok1 && k1 >= cand));
                if (cnt >= 16) T = cand; }
            const unsigned long long gt0 = __ballot(ok0 && k0 > T), gt1 = __ballot(ok1 && k1 > T), eq0 = __ballot(ok0 && k0 == T), eq1 = __ballot(ok1 && k1 == T);
            const int need = 16 - (__popcll(gt0) + __popcll(gt1));
            const int r0 = (int)__builtin_amdgcn_mbcnt_hi((unsigned)(eq0 >> 32), __builtin_amdgcn_mbcnt_lo((unsigned)eq0, 0u));
            const int r1 = __popcll(eq0) + (int)__builtin_amdgcn_mbcnt_hi((unsigned)(eq1 >> 32), __builtin_amdgcn_mbcnt_lo((unsigned)eq1, 0u));
            const unsigned long long slo = __ballot(ok0 && (k0 > T || (k0 == T && r0 < need))), shi = __ballot(ok1 && (k1 > T || (k1 == T && r1 < need)));
            if (lane == 0) { selw[qq * 4 + 0] = (unsigned)slo; selw[qq * 4 + 1] = (unsigned)(slo >> 32); selw[qq * 4 + 2] = (unsigned)shi; selw[qq * 4 + 3] = (unsigned)(shi >> 32);
                atomicOr((unsigned*)(uni + 0), (unsigned)slo); atomicOr((unsigned*)(uni + 1), (unsigned)(slo >> 32)); atomicOr((unsigned*)(uni + 2), (unsigned)shi); atomicOr((unsigned*)(uni + 3), (unsigned)(shi >> 32)); }
        }
    }
    __syncthreads();
    if (tid == 0) { int n = 0; for (int wd = 0; wd < 4; ++wd) { unsigned u = uni[wd]; while (u) { const int j = __ffs(u) - 1; u &= u - 1; list[n++] = wd * 32 + j; } } list[131] = n; }
    __syncthreads();
    {
        const unsigned m0 = selw[q8 * 4 + 0], m1 = selw[q8 * 4 + 1], m2 = selw[q8 * 4 + 2], m3 = selw[q8 * 4 + 3];
        const int nl = list[131];
        const bf16_t* Ks = proj + (size_t)b * S * NP + C_KSEL; const bf16_t* Vs = proj + (size_t)b * S * NP + C_VSEL;
        st.m = NEG_BIG; st.l = 0.f; st.o0 = (f32x16){}; st.o1 = (f32x16){};
        stage_load<64>(sr, Ks, NP, Vs, NP, nullptr, list[0] * 64, wid0);
        stage_store<64>(sr, lds, 0, false, wid0);
        if (1 < nl) stage_load<64>(sr, Ks, NP, Vs, NP, nullptr, list[1] * 64, wid0);
        __syncthreads();
        for (int t = 0; t < nl; ++t) {
            const int buf = t & 1; const int j = list[t];
            const unsigned mw = (j < 32) ? m0 : (j < 64 ? m1 : (j < 96 ? m2 : m3));
            const bool mine = (mw >> (j & 31)) & 1u;
            if (__any(mine)) {
                f32x16 p0, p1; const int kv0 = j * 64;
                { const float base = A * (float)(kv0 + 4 * hi);
#pragma unroll
                  for (int i = 0; i < 16; ++i) { p0[i] = base + A * (float)((i & 3) + 8 * (i >> 2)); p1[i] = p0[i] + A * 32.0f; } }
                qk_tile<4>(p0, p1, lds + ATT_K0 + buf * ATT_KBUF, KSTR64, qf, r, hi);
#pragma unroll
                for (int i = 0; i < 16; ++i) { const int kv = kv0 + crow(i, hi); if (!mine || (j == q64 && kv > tq)) p0[i] = -INFINITY; if (!mine || (j == q64 && kv + 32 > tq)) p1[i] = -INFINITY; }
                { bf16x8 f0, f1, f2, f3; softmax_pack(st, p0, p1, c2, f0, f1, f2, f3); pv_frag(st.o0, st.o1, f0, f1, f2, f3, lds + ATT_V0 + buf * ATT_VBUF, vb); }
            }
            if (t + 1 < nl) stage_store<64>(sr, lds, buf ^ 1, false, wid0);
            if (t + 2 < nl) stage_load<64>(sr, Ks, NP, Vs, NP, nullptr, list[t + 2] * 64, wid0);
            __syncthreads();
        }
        const float l = swap32_sum(st.l); const float sc = l > 0.f ? g1 / l : 0.f;
#pragma unroll
        for (int i = 0; i < 16; ++i) { otl[i * 64] += st.o0[i] * sc; otl[(16 + i) * 64] += st.o1[i] * sc; }
    }
    {
        const bf16_t* Kw = proj + (size_t)b * S * NP + C_KWIN; const bf16_t* Vw = proj + (size_t)b * S * NP + C_VWIN;
        const int tw0 = (q64 >= 8) ? q64 - 8 : 0, ntw = q64 - tw0 + 1;
        st.m = NEG_BIG; st.l = 0.f; st.o0 = (f32x16){}; st.o1 = (f32x16){};
        stage_load<64>(sr, Kw, NP, Vw, NP, nullptr, tw0 * 64, wid0);
        stage_store<64>(sr, lds, 0, false, wid0);
        if (1 < ntw) stage_load<64>(sr, Kw, NP, Vw, NP, nullptr, tw0 * 64 + 64, wid0);
        __syncthreads();
        for (int t = 0; t < ntw; ++t) {
            const int buf = t & 1; const int kv0 = (tw0 + t) * 64;
            f32x16 p0, p1;
            { const float base = A * (float)(kv0 + 4 * hi);
#pragma unroll
              for (int i = 0; i < 16; ++i) { p0[i] = base + A * (float)((i & 3) + 8 * (i >> 2)); p1[i] = p0[i] + A * 32.0f; } }
            qk_tile<4>(p0, p1, lds + ATT_K0 + buf * ATT_KBUF, KSTR64, qf, r, hi);
            if (t == 0 || t == ntw - 1) {
#pragma unroll
                for (int i = 0; i < 16; ++i) { const int kv = kv0 + crow(i, hi); if (kv > tq || kv + 512 <= tq) p0[i] = -INFINITY; if (kv + 32 > tq || kv + 32 + 512 <= tq) p1[i] = -INFINITY; } }
            { bf16x8 f0, f1, f2, f3; softmax_pack(st, p0, p1, c2, f0, f1, f2, f3); pv_frag(st.o0, st.o1, f0, f1, f2, f3, lds + ATT_V0 + buf * ATT_VBUF, vb); }
            if (t + 1 < ntw) stage_store<64>(sr, lds, buf ^ 1, false, wid0);
            if (t + 2 < ntw) stage_load<64>(sr, Kw, NP, Vw, NP, nullptr, kv0 + 128, wid0);
            __syncthreads();
        }
        const float l = swap32_sum(st.l); const float sc = l > 0.f ? g2 / l : 0.f;
#pragma unroll
        for (int i = 0; i < 16; ++i) { st.o0[i] = otl[i * 64] + st.o0[i] * sc; st.o1[i] = otl[(16 + i) * 64] + st.o1[i] * sc; }
    }
    { const float sq = swap32_sum(store_out_fused(ocat + rowq * D + 768 + hd * 64, proj + rowq * NP + C_GZ + 768 + hd * 64, gn + 768 + hd * 64, st.o0, st.o1, 1.0f, hi));
      if (hi == 0) ssq[rowq * 16 + 12 + hd] = sq; }
}

__device__ __forceinline__ void phase_onorm(const bf16_t* ocat, const bf16_t* proj, const float* og, bf16_t* oa, int bid, int G, int wid0) {
    const int tid_ = opaque_tid(wid0); const int lane = tid_ & 63, wv = tid_ >> 6;
    for (int row = bid * 8 + wv; row < M; row += G * 8) {
        const int c = lane * 16;
        const u32x4 a0 = *(const u32x4*)(ocat + (size_t)row * D + c), a1 = *(const u32x4*)(ocat + (size_t)row * D + c + 8);
        const u32x4 z0 = *(const u32x4*)(proj + (size_t)row * NP + C_GZ + c), z1 = *(const u32x4*)(proj + (size_t)row * NP + C_GZ + c + 8);
        float v[16], z[16]; float s = 0.f;
#pragma unroll
        for (int e = 0; e < 4; ++e) { v[2 * e] = bflo(a0[e]); v[2 * e + 1] = bfhi(a0[e]); v[8 + 2 * e] = bflo(a1[e]); v[8 + 2 * e + 1] = bfhi(a1[e]);
            z[2 * e] = bflo(z0[e]); z[2 * e + 1] = bfhi(z0[e]); z[8 + 2 * e] = bflo(z1[e]); z[8 + 2 * e + 1] = bfhi(z1[e]); }
#pragma unroll
        for (int e = 0; e < 16; ++e) s += v[e] * v[e];
        s += __builtin_bit_cast(float, __builtin_amdgcn_update_dpp(0, __builtin_bit_cast(int, s), 0xB1, 0xf, 0xf, false));
        s += __builtin_bit_cast(float, __builtin_amdgcn_update_dpp(0, __builtin_bit_cast(int, s), 0x4E, 0xf, 0xf, false));
        s += __builtin_bit_cast(float, __builtin_amdgcn_update_dpp(0, __builtin_bit_cast(int, s), 0x141, 0xf, 0xf, false));
        s += __builtin_bit_cast(float, __builtin_amdgcn_update_dpp(0, __builtin_bit_cast(int, s), 0x140, 0xf, 0xf, false));
        const float rstd = 1.0f / sqrtf(s * (1.f / 256.f) + EPS);
        float y[16];
#pragma unroll
        for (int e = 0; e < 16; ++e) y[e] = v[e] * rstd * og[c + e] * silu_f(z[e]);
        u32x4 w0, w1;
#pragma unroll
        for (int e = 0; e < 4; ++e) { w0[e] = pk2(y[2 * e], y[2 * e + 1]); w1[e] = pk2(y[8 + 2 * e], y[8 + 2 * e + 1]); }
        *(u32x4*)(oa + (size_t)row * D + c) = w0; *(u32x4*)(oa + (size_t)row * D + c + 8) = w1;
    }
}
__device__ __forceinline__ void phase_final(float* out, const float* g, int bid, int G, int wid0) {
    const int tid_ = opaque_tid(wid0); const int lane = tid_ & 63, wv = tid_ >> 6;
    for (int row = bid * 8 + wv; row < M; row += G * 8) {
        f32x4* xr = (f32x4*)(out + (size_t)row * D) + lane;
        f32x4 v[4]; float s = 0.f;
#pragma unroll
        for (int j = 0; j < 4; ++j) { v[j] = xr[64 * j]; s += (v[j][0] * v[j][0] + v[j][1] * v[j][1]) + (v[j][2] * v[j][2] + v[j][3] * v[j][3]); }
        const float rstd = 1.0f / sqrtf(wave_sum(s) * (1.f / D) + EPS);
#pragma unroll
        for (int j = 0; j < 4; ++j) { const f32x4 gg = *(const f32x4*)(g + (64 * j + lane) * 4); xr[64 * j] = v[j] * rstd * gg; }
    }
}

#define XB_TMO      128
#define XB_XCNT(j)  (256  + 64 * (j))
#define XB_XSUB(j)  (1280 + 64 * (j))
#define XB_XGEN(j)  (2304 + 64 * (j))
#define XB_TOP      3328
#define XB_TOPGEN   3392
#define XCD_BAR_WORDS 3456
#define XB_SPIN_CAP (1u << 22)
__device__ __forceinline__ unsigned xb_ld(unsigned* p)              { return __hip_atomic_load(p, __ATOMIC_RELAXED, __HIP_MEMORY_SCOPE_AGENT); }
__device__ __forceinline__ unsigned xb_add(unsigned* p, unsigned v) { return __hip_atomic_fetch_add(p, v, __ATOMIC_RELAXED, __HIP_MEMORY_SCOPE_AGENT); }
__device__ __forceinline__ unsigned xb_xcc_id() { return (unsigned)__builtin_amdgcn_s_getreg((3 << 11) | 20) & 0xFu; }
#define XB_SPIN(cond, bar) do { unsigned _sp = 0; while (cond) { __builtin_amdgcn_s_sleep(1); \
    if ((++_sp & 255u) == 0u) { if (xb_ld(&(bar)[XB_TMO])) break; if (_sp > XB_SPIN_CAP) { atomicAdd(&(bar)[XB_TMO], 1u); break; } } } } while (0)
__device__ __forceinline__ void xcd_barrier_complete(unsigned* bar, unsigned x, unsigned G, unsigned& nloc, unsigned& nx) {
    unsigned sum, cnt, mine, sp = 0u;
    for (;;) {
        sum = 0u; cnt = 0u; mine = 0u;
#pragma unroll
        for (unsigned j = 0; j < 16; ++j) { const unsigned c = xb_ld(&bar[XB_XCNT(j)]); sum += c; cnt += (c > 0u) ? 1u : 0u; mine = (j == x) ? c : mine; }
        if (sum == G) break;
        __builtin_amdgcn_s_sleep(1);
        if ((++sp & 255u) == 0u) { if (xb_ld(&bar[XB_TMO])) break; if (sp > XB_SPIN_CAP) { atomicAdd(&bar[XB_TMO], 1u); break; } }
    }
    nloc = mine > 0u ? mine : 1u; nx = cnt > 0u ? cnt : 1u;
}
__device__ __forceinline__ void grid_bar(unsigned* bar, volatile LAS unsigned* st, unsigned G, int wid0) {
    const int tid = opaque_tid(wid0);
    asm volatile("s_waitcnt vmcnt(0)" ::: "memory");
    __syncthreads();
    if (tid == 0) {
        const unsigned x = xb_xcc_id();
        unsigned nloc = st[0], nx = st[1];
        if (nloc == 0u) { xcd_barrier_complete(bar, x, G, nloc, nx); st[0] = nloc; st[1] = nx; }
        const unsigned old = xb_add(&bar[XB_XSUB(x)], 1u);
        const unsigned gen = old / nloc;
        if (old + 1u == (gen + 1u) * nloc) {
            __builtin_amdgcn_fence(__ATOMIC_RELEASE, "agent");
            asm volatile("s_waitcnt vmcnt(0)" ::: "memory");
            const unsigned og = xb_add(&bar[XB_TOP], 1u);
            const unsigned tg = og / nx;
            if (og + 1u == (tg + 1u) * nx) xb_add(&bar[XB_TOPGEN], 1u);
            else XB_SPIN(xb_ld(&bar[XB_TOPGEN]) == tg, bar);
            __builtin_amdgcn_fence(__ATOMIC_ACQUIRE, "agent");
            xb_add(&bar[XB_XGEN(x)], 1u);
            asm volatile("s_waitcnt vmcnt(0)" ::: "memory");
        } else {
            XB_SPIN(xb_ld(&bar[XB_XGEN(x)]) == gen, bar);
            __builtin_amdgcn_fence(__ATOMIC_ACQUIRE, "agent");
            asm volatile("s_waitcnt vmcnt(0)" ::: "memory");
        }
    }
    __syncthreads();
}

constexpr int N_PHASES = 16;
__global__ void __launch_bounds__(NTHREADS) hymba_fwd(Params P) {
    extern __shared__ __attribute__((aligned(16))) unsigned char lds_raw[];
    LAS unsigned char* lds = (LAS unsigned char*)lds_raw;
    const int bid = blockIdx.x, G = gridDim.x;
    const int wid0 = __builtin_amdgcn_readfirstlane((int)(threadIdx.x >> 6));
    volatile LAS unsigned* xst = (volatile LAS unsigned*)(lds + LDS_BYTES - 16);
    unsigned* xbar = (unsigned*)(P.ws + WS_CTL) + 4096 + P.bar_region * XCD_BAR_WORDS;
    if (threadIdx.x == 0) { xst[0] = 0u; xst[1] = 0u; (void)xb_add(&xbar[XB_XCNT(xb_xcc_id())], 1u); }
    __syncthreads();
    unsigned char* ws = P.ws;
    bf16_t* proj = (bf16_t*)(ws + WS_PROJ); float* side = (float*)(ws + WS_SIDE);
    bf16_t* hbuf = (bf16_t*)(ws + WS_H); bf16_t* ocat = (bf16_t*)(ws + WS_OCAT);
#define PH(k) (P.ph_lo <= (k) && (k) < P.ph_hi)
#define SYNC(k) do { if (PH(k) && PH((k) + 1)) grid_bar(xbar, xst, (unsigned)G, wid0); } while (0)
    if (PH(0)) phase_prologue(P, lds, bid, G, wid0);
    if (PH(0) && PH(1)) cg::this_grid().sync();
#ifndef ATT_REP
#define ATT_REP 0
#endif
#ifndef PROBE_VAR
#define PROBE_VAR -1
#endif
#define LAYER(l, base) do { \
    const float* mod = (const float*)(ws + WS_MOD) + (size_t)(l) * 4 * 3072; \
    const float* xin = ((l) == 0) ? P.in[0] : P.out; \
    if (PH((base) + 0)) phase_hnorm(xin, P.in[2] + (l) * D, mod, hbuf, bid, G, wid0); \
    SYNC((base) + 0); \
    if (PH((base) + 1)) { pg8::Gemm g{hbuf, (const bf16_t*)(ws + WS_WIN) + (size_t)(l) * NP * D, M, NP, D, D, D}; pg8::StaticOrder so; so.init(M, NP, G, bid); \
        pg8::EpiProj E{proj, side}; pg8::gemm_phase<pg8::EpiProj, true>(lds, g, so, E, wid0); } \
    SYNC((base) + 1); \
    if (PH((base) + 2)) phase_prep(P, (l), lds, bid, G, wid0); \
    SYNC((base) + 2); \
    if (PH((base) + 3)) { \
        { pg8::Gemm g{proj + C_QLAT, (const bf16_t*)(ws + WS_WUQ) + (size_t)(l) * 512 * 256, M, 512, 256, NP, 256}; pg8::StaticOrder so; so.init(M, 512, G, bid); \
          pg8::EpiQup E{(bf16_t*)(ws + WS_QMLA), (const float*)(ws + WS_RSTD), (const float*)(ws + WS_ROPE)}; pg8::gemm_phase<pg8::EpiQup, true>(lds, g, so, E, wid0); } \
        { pg8::Gemm g{proj + C_KVLAT, (const bf16_t*)(ws + WS_WUKV) + (size_t)(l) * 512 * 128, M, 512, 128, NP, 128}; pg8::StaticOrder so; so.init(M, 512, G, bid); \
          pg8::EpiKVup E{(bf16_t*)(ws + WS_KMLA), (bf16_t*)(ws + WS_VMLA), (const float*)(ws + WS_RSTD)}; pg8::gemm_phase<pg8::EpiKVup, true>(lds, g, so, E, wid0); } \
        for (int k = 0; k * G < 1024; ++k) { const int u = (k & 1) ? (k + 1) * G - 1 - bid : k * G + bid; if (u >= 1024 || u < 0) continue; const int qg = 255 - (u >> 2), b = u & 3; \
            dsa_index_unit(lds, proj, (const bf16_t*)(ws + WS_KIDX), side, (unsigned long long*)(ws + WS_MASK) + (size_t)b * S * 128, b, qg, wid0); } } \
    SYNC((base) + 3); \
    if (PH((base) + 4)) { const int vb_ = (G % 8 == 0) ? (bid & 7) * (G >> 3) + (bid >> 3) : bid;     \
        if (G == 256) {   \
          const int tw_ = opaque_tid(wid0); const int b_ = (bid & 7) >> 1; \
          if (tw_ < 128) { const int pg_ = (bid >> 3) * 128 + tw_;     \
              const unsigned char* a_ = (pg_ < 1536) ? ws + WS_QMLA + (size_t)b_ * S * 768 + (size_t)pg_ * 4096 : (pg_ < 3072) ? ws + WS_KMLA + (size_t)b_ * S * 768 + (size_t)(pg_ - 1536) * 4096 \
                                                      : ws + WS_VMLA + (size_t)b_ * S * 512 + (size_t)(pg_ - 3072) * 4096; \
              const unsigned v_ = *(const volatile unsigned*)a_; if (v_ == 0x12345677u) *(volatile unsigned*)(ws + WS_CTL + 8192 + 512) = v_; } } \
        for (int i = vb_; i < 512; i += G) { const int ii = i & 255, bh = ii >> 4, qb = (i < 256) ? (ii & 15) : 31 - (ii & 15), b = bh >> 2, hd = bh & 3; const size_t rb = (size_t)b * S; \
            attn64_unit<0, 96>(lds, (const bf16_t*)(ws + WS_QMLA) + rb * 384 + hd * 96, 384, (const bf16_t*)(ws + WS_KMLA) + rb * 384 + hd * 96, 384, \
                              (const bf16_t*)(ws + WS_VMLA) + rb * 256 + hd * 64, 256, ocat + rb * D + hd * 64, nullptr, nullptr, 0.f, 0.10206207261596577f * LOG2E, qb, wid0, proj + rb * NP + C_GZ + hd * 64, P.in[14] + (l) * D + hd * 64, (float*)(ws + WS_SSQ) + rb * 16 + hd); } \
        for (int rep = 0; rep < (((ATT_REP & 2) && (l) == 0) ? 2 : 1); ++rep) for (int i = vb_; i < 512; i += G) { const int ii = i & 255, bh = ii >> 4, qb = (i < 256) ? (ii & 15) : 31 - (ii & 15), b = bh >> 2, hd = bh & 3; const size_t rb = (size_t)b * S; \
            attn64_unit<1, 64>(lds, proj + rb * NP + C_FQ + hd * 64, NP, proj + rb * NP + C_FK + hd * 64, NP, proj + rb * NP + C_FV + hd * 64, NP, \
                              ocat + rb * D + 256 + hd * 64, (const float*)(ws + WS_FB) + (size_t)bh * S, nullptr, 0.f, 0.125f * LOG2E, qb, wid0, proj + rb * NP + C_GZ + 256 + hd * 64, P.in[14] + (l) * D + 256 + hd * 64, (float*)(ws + WS_SSQ) + rb * 16 + 4 + hd); } \
        for (int rep = 0; rep < (((ATT_REP & 4) && (l) == 0) ? 2 : 1); ++rep) for (int i = vb_; i < 512; i += G) { const int ii = i & 255, bh = ii >> 4, qb = (i < 256) ? (ii & 15) : 31 - (ii & 15), b = bh >> 2, hd = bh & 3; const size_t rb = (size_t)b * S; \
            const float slope = (hd == 0) ? 0.25f : (hd == 1 ? 0.0625f : (hd == 2 ? 0.015625f : 0.00390625f)); \
            attn64_unit<2, 64>(lds, proj + rb * NP + C_DQ + hd * 64, NP, proj + rb * NP + C_DK + hd * 64, NP, proj + rb * NP + C_DV + hd * 64, NP, \
                              ocat + rb * D + 512 + hd * 64, nullptr, (const unsigned long long*)(ws + WS_MASK) + rb * 128, 8.0f * slope, 0.125f * LOG2E, qb, wid0, proj + rb * NP + C_GZ + 512 + hd * 64, P.in[14] + (l) * D + 512 + hd * 64, (float*)(ws + WS_SSQ) + rb * 16 + 8 + hd); } \
        for (int rep = 0; rep < (((ATT_REP & 8) && (l) == 0) ? 2 : 1); ++rep) for (int u = vb_; u < 512; u += G) { const int b = u >> 7, q64 = u & 127; \
            nsa_unit(lds, proj, side, (const bf16_t*)(ws + WS_KC), (const bf16_t*)(ws + WS_VC), ocat, b, q64, wid0, P.in[14] + (l) * D, (float*)(ws + WS_SSQ)); } } \
    SYNC((base) + 4); \
      \
    if (PH((base) + 6)) { pg8::Gemm g{ocat, (const bf16_t*)(ws + WS_WOUT) + (size_t)(l) * D * D, M, D, D, D, D}; pg8::StaticOrder so; so.init(M, D, G, bid); \
        pg8::EpiOut E{xin, P.out, mod + 2048, (const float*)(ws + WS_SSQ)}; pg8::gemm_phase<pg8::EpiOut, true>(lds, g, so, E, wid0); } \
    SYNC((base) + 6); \
} while (0)
    LAYER(0, 1);
    LAYER(1, 8);
    if (PH(15)) phase_final(P.out, P.in[16], bid, G, wid0);
#undef LAYER
#undef PH
#undef SYNC
}


#ifdef DBG_GROUP
#ifndef DBG_LAYER
#define DBG_LAYER 1
#endif
__device__ __forceinline__ float dbg_bf(const bf16_t* p) { return bf2f(*p); }
__device__ const int dbg_rows[48] = {0, 1, 2, 15, 30, 31, 32, 47, 63, 64, 65, 127, 128, 200, 255, 256, 257, 300, 511, 512, 513, 700, 1000, 1023, 1024, 1025, 1500, 2047, 2048, 3000, 3333, 4095, 4096, 4500, 5000, 5555, 6143, 6144, 7000, 7777, 8000, 8100, 8127, 8128, 8160, 8190, 8191, 4242};
template <class ScoreFn, class VFn>
__device__ __forceinline__ float dbg_attn(int k_lo, int k_hi, ScoreFn score, VFn vload, int lane) {
    float m = -INFINITY, l = 0.f, acc = 0.f;
    for (int kv = k_lo; kv <= k_hi; ++kv) {
        const float sc = score(kv);
        if (sc == -INFINITY) continue;
        const float mn = fmaxf(m, sc); const float al = (m == -INFINITY) ? 0.f : __expf(m - mn); const float p = __expf(sc - mn);
        l = l * al + p; acc = acc * al + p * vload(kv, lane); m = mn;
    }
    return l > 0.f ? acc / l : 0.f;
}
__global__ void __launch_bounds__(64) dbg_check(Params P) {
    const int lane = threadIdx.x, wid = blockIdx.x; const int hd = wid & 3, ri = (wid >> 2) % 48, b = (wid >> 2) / 48; const int t = dbg_rows[ri];
    unsigned char* ws = P.ws; const bf16_t* proj = (const bf16_t*)(ws + WS_PROJ); const float* side = (const float*)(ws + WS_SIDE);
    const bf16_t* ocat = (const bf16_t*)(ws + WS_OCAT); const size_t rowq = (size_t)b * S + t; const size_t rb = (size_t)b * S;
    float* scratch = (float*)(ws + WS_H) + (size_t)wid * 16384;
    float ref = 0.f; int grp = DBG_GROUP % 10;
    const float slope = (hd == 0) ? 0.25f : (hd == 1 ? 0.0625f : (hd == 2 ? 0.015625f : 0.00390625f));
    if (grp == 0) {
        const bf16_t* q = (const bf16_t*)(ws + WS_QMLA) + rowq * 384 + hd * 96; const bf16_t* K = (const bf16_t*)(ws + WS_KMLA) + rb * 384 + hd * 96; const bf16_t* V = (const bf16_t*)(ws + WS_VMLA) + rb * 256 + hd * 64;
        const float q0 = dbg_bf(q + lane), q1 = lane < 32 ? dbg_bf(q + 64 + lane) : 0.f;
        ref = dbg_attn(0, t, [&](int kv) { float pr = q0 * dbg_bf(K + (size_t)kv * 384 + lane) + (lane < 32 ? q1 * dbg_bf(K + (size_t)kv * 384 + 64 + lane) : 0.f); return wave_sum(pr) * 0.10206207261596577f; },
                       [&](int kv, int d) { return dbg_bf(V + (size_t)kv * 256 + d); }, lane);
    } else if (grp == 1) {
        const bf16_t* q = proj + rowq * NP + C_FQ + hd * 64; const bf16_t* K = proj + rb * NP + C_FK + hd * 64; const bf16_t* V = proj + rb * NP + C_FV + hd * 64; const float* fb = (const float*)(ws + WS_FB) + (size_t)(b * 4 + hd) * S;
        const float q0 = dbg_bf(q + lane); const float ft = fb[t];
        ref = dbg_attn(0, t, [&](int kv) { return wave_sum(q0 * dbg_bf(K + (size_t)kv * NP + lane)) * 0.125f + (fb[kv] - ft) * 0.125f; },
                       [&](int kv, int d) { return dbg_bf(V + (size_t)kv * NP + d); }, lane);
    } else if (grp == 2) {
        float* sc = scratch; unsigned char* selb = (unsigned char*)(scratch + 8192);
        const int ih = lane >> 4, dd = (lane & 15) * 2;
        const float qa = dbg_bf(proj + rowq * NP + C_IQ + ih * 32 + dd), qb2 = dbg_bf(proj + rowq * NP + C_IQ + ih * 32 + dd + 1); const float wgt = side[rowq * 32 + 4 + ih] * 0.5f;
        for (int kv = 0; kv <= t; ++kv) { float pr = qa * dbg_bf(proj + (rb + kv) * NP + C_IK + dd) + qb2 * dbg_bf(proj + (rb + kv) * NP + C_IK + dd + 1);
            pr += __shfl_xor(pr, 1); pr += __shfl_xor(pr, 2); pr += __shfl_xor(pr, 4); pr += __shfl_xor(pr, 8);
            float v = wgt * fmaxf(pr, 0.f); v += __shfl_xor(v, 16); v += __shfl_xor(v, 32); if (lane == 0) sc[kv] = v; }
        __threadfence_block();
        if (t + 1 <= 256) { for (int kv = lane; kv <= t; kv += 64) selb[kv] = 1; }
        else {
#ifdef DBG_KEY32
#define DBGKEY(x) ({ const unsigned u_ = __float_as_uint(x); (u_ & 0x80000000u) ? ~u_ : (u_ | 0x80000000u); })
            unsigned lo = 0, hi2 = 0xffffffffu;
#else
#define DBGKEY(x) score_key16(x)
            unsigned lo = 0, hi2 = 0xffffu;
#endif
            while (lo < hi2) { const unsigned mid = lo + ((hi2 - lo) >> 1) + ((hi2 - lo) & 1u); int c = 0; for (int kv = lane; kv <= t; kv += 64) c += (DBGKEY(sc[kv]) >= mid); c = (int)wave_sum((float)c); if (c >= 256) lo = mid; else hi2 = mid - 1; }
            const unsigned T = lo; int cgt = 0; for (int kv = lane; kv <= t; kv += 64) cgt += (DBGKEY(sc[kv]) > T); cgt = (int)wave_sum((float)cgt);
            int need = 256 - cgt; int run = 0;
            for (int k0 = 0; k0 <= t; k0 += 64) { const int kv = k0 + lane; const unsigned k = kv <= t ? DBGKEY(sc[kv]) : 0u; const bool eq = kv <= t && k == T, gt = kv <= t && k > T;
                const unsigned long long bm = __ballot(eq); const int before = __popcll(bm & ((1ull << lane) - 1ull));
                if (kv <= t) selb[kv] = (gt || (eq && run + before < need)) ? 1 : 0; run += __popcll(bm); }
        }
        __threadfence_block();
        const bf16_t* q = proj + rowq * NP + C_DQ + hd * 64; const bf16_t* K = proj + rb * NP + C_DK + hd * 64; const bf16_t* V = proj + rb * NP + C_DV + hd * 64; const float q0 = dbg_bf(q + lane);
        ref = dbg_attn(0, t, [&](int kv) { if (!selb[kv]) return -INFINITY; return wave_sum(q0 * dbg_bf(K + (size_t)kv * NP + lane)) * 0.125f - slope * (float)(t - kv); },
                       [&](int kv, int d) { return dbg_bf(V + (size_t)kv * NP + d); }, lane);
    } else {
        const int sub = DBG_GROUP / 10;
        const bf16_t* q = proj + rowq * NP + C_NQ; const float q0 = dbg_bf(q + hd * 64 + lane);
        const bf16_t* kc = (const bf16_t*)(ws + WS_KC) + (size_t)b * 512 * 64; const bf16_t* vc = (const bf16_t*)(ws + WS_VC) + (size_t)b * 512 * 64;
        float* pc = scratch;
        for (int h2 = 0; h2 < 4; ++h2) { const float qh = dbg_bf(q + h2 * 64 + lane); const float sl = (h2 == 0) ? 0.25f : (h2 == 1 ? 0.0625f : (h2 == 2 ? 0.015625f : 0.00390625f));
            float m = -INFINITY; for (int n = 0; n < 511; ++n) { if (16 * n + 31 > t) break; const float s_ = wave_sum(qh * dbg_bf(kc + n * 64 + lane)) * 0.125f - sl * (float)(t - (16 * n + 31)); if (lane == 0) pc[h2 * 512 + n] = s_; m = fmaxf(m, s_); }
            __threadfence_block(); float l = 0.f; for (int n = 0; n < 511 && 16 * n + 31 <= t; ++n) l += __expf(pc[h2 * 512 + n] - m);
            __threadfence_block(); for (int n = lane; n < 511; n += 64) pc[h2 * 512 + n] = (16 * n + 31 <= t) ? __expf(pc[h2 * 512 + n] - m) / l : 0.f; __threadfence_block(); }
        float oc = 0.f; for (int n = 0; n < 511 && 16 * n + 31 <= t; ++n) oc += pc[hd * 512 + n] * dbg_bf(vc + n * 64 + lane);
        const int cur = t >> 6; float v0, v1;
        { float i0 = 0.f, i1 = 0.f; for (int h2 = 0; h2 < 4; ++h2) for (int e = -1; e <= 3; ++e) { int n0 = 4 * lane + e, n1 = 4 * (lane + 64) + e; if (n0 >= 0 && n0 < 511) i0 += pc[h2 * 512 + n0]; if (n1 < 511) i1 += pc[h2 * 512 + n1]; }
          v0 = (lane == 0 || lane == cur) ? INFINITY : (lane > cur ? -INFINITY : i0); v1 = (lane + 64 == cur) ? INFINITY : (lane + 64 > cur ? -INFINITY : i1); }
        unsigned long long slo = 0, shi = 0;
        for (int it = 0; it < 16; ++it) { float mx = fmaxf(v0, v1); for (int o = 1; o < 64; o <<= 1) mx = fmaxf(mx, __shfl_xor(mx, o)); if (!(mx > -INFINITY)) break;
            const unsigned long long b0 = __ballot(v0 == mx), b1 = __ballot(v1 == mx);
            if (b0) { const int j = __ffsll((long long)b0) - 1; slo |= 1ull << j; if (lane == j) v0 = -INFINITY; } else { const int j = __ffsll((long long)b1) - 1; shi |= 1ull << j; if (lane == j) v1 = -INFINITY; } }
        const bf16_t* Ks = proj + rb * NP + C_KSEL; const bf16_t* Vs = proj + rb * NP + C_VSEL; const bf16_t* Kw = proj + rb * NP + C_KWIN; const bf16_t* Vw = proj + rb * NP + C_VWIN;
        const float os = dbg_attn(0, t, [&](int kv) { const int j = kv >> 6; const bool in = j < 64 ? ((slo >> j) & 1ull) : ((shi >> (j - 64)) & 1ull); if (!in) return -INFINITY;
                                      return wave_sum(q0 * dbg_bf(Ks + (size_t)kv * NP + lane)) * 0.125f - slope * (float)(t - kv); }, [&](int kv, int d) { return dbg_bf(Vs + (size_t)kv * NP + d); }, lane);
        const float ow = dbg_attn(t - 511 > 0 ? t - 511 : 0, t, [&](int kv) { return wave_sum(q0 * dbg_bf(Kw + (size_t)kv * NP + lane)) * 0.125f - slope * (float)(t - kv); }, [&](int kv, int d) { return dbg_bf(Vw + (size_t)kv * NP + d); }, lane);
        const float g0 = sigmoid_f(side[rowq * 32 + 8 + hd * 3]), g1 = sigmoid_f(side[rowq * 32 + 8 + hd * 3 + 1]), g2 = sigmoid_f(side[rowq * 32 + 8 + hd * 3 + 2]);
        ref = g0 * oc + g1 * os + g2 * ow;
        (void)sub;
    }
    const float got = dbg_bf(ocat + rowq * D + grp * 256 + hd * 64 + lane);
    const float d2 = wave_sum((got - ref) * (got - ref)), r2 = wave_sum(ref * ref);
    float* acc = (float*)(ws + WS_CTL + 8192);
    if (lane == 0) { atomicAdd(acc, d2); atomicAdd(acc + 1, r2); }
}

__device__ __forceinline__ void dbg_sincos(double ang, float& cs, float& sn) {
    const double twopi = 6.283185307179586476925; double r = ang - twopi * __builtin_floor(ang / twopi + 0.5);
    const double r2 = r * r; double sterm = r, cterm = 1.0, ssum = r, csum = 1.0;
    for (int k = 1; k <= 14; ++k) { cterm *= -r2 / (double)((2 * k - 1) * (2 * k)); sterm *= -r2 / (double)((2 * k) * (2 * k + 1)); csum += cterm; ssum += sterm; }
    cs = (float)csum; sn = (float)ssum;
}
__device__ __forceinline__ int dbg_mapwin(int n) { return MapWin{}(n); }
#define DBG_ACC(got, ref) do { const float g_ = (got), r_ = (ref); d2 += (g_ - r_) * (g_ - r_); r2 += r_ * r_; } while (0)
__global__ void __launch_bounds__(64) dbg_check2(Params P) {
    const int lane = threadIdx.x, wid = blockIdx.x; const int ri = wid % 48, b = wid / 48; const int t = dbg_rows[ri];
    unsigned char* ws = P.ws; const bf16_t* proj = (const bf16_t*)(ws + WS_PROJ); const float* side = (const float*)(ws + WS_SIDE);
    const size_t rowq = (size_t)b * S + t; const int l = DBG_LAYER;
    float d2 = 0.f, r2 = 0.f;
    const int grp = DBG_GROUP;
    if (grp == 4) {
        if (wid < 16 && lane == 0) { const int hd = wid & 3, bb = wid >> 2; double run = 0.0; const float* fb = (const float*)(ws + WS_FB) + (size_t)wid * S; const float bf = P.in[10][l * 4 + hd];
            for (int tt = 0; tt < S; ++tt) { const double v = (double)side[((size_t)bb * S + tt) * 32 + hd] + (double)bf; const double y = (v < 0 ? v : 0.0) - log1p(exp(-fabs(v))); run += y; DBG_ACC(fb[tt], (float)(-8.0 * run)); } }
    } else if (grp == 5) {
        float ss = 0.f; for (int k = lane; k < 192; k += 64) { const float v = dbg_bf(proj + rowq * NP + k); ss += v * v; } ss = wave_sum(ss); const float rs = 1.0f / sqrtf(ss / 192.f + EPS);
        const float* wq = P.in[7] + (size_t)l * 192 * 384; const float* gq = P.in[6] + l * 192; const bf16_t* qm = (const bf16_t*)(ws + WS_QMLA) + rowq * 384;
        for (int o = lane; o < 384; o += 64) { float a = 0.f; for (int k = 0; k < 192; ++k) a += dbg_bf(proj + rowq * NP + k) * rs * gq[k] * wq[(size_t)k * 384 + o]; ((float*)(ws + WS_H))[(size_t)wid * 512 + o] = a; }
        __threadfence_block();
        const float* qv = (const float*)(ws + WS_H) + (size_t)wid * 512;
        for (int hd = 0; hd < 4; ++hd) { { const int w = lane; DBG_ACC(dbg_bf(qm + hd * 96 + w), qv[hd * 96 + w]); }
            if (lane < 16) { const int i = lane; const float invf = (float)pow(10000.0, -(double)i / 16.0); float cs, sn; dbg_sincos((double)((float)t * invf), cs, sn);
                const float x1 = qv[hd * 96 + 64 + i], x2 = qv[hd * 96 + 80 + i]; DBG_ACC(dbg_bf(qm + hd * 96 + 64 + 2 * i), x1 * cs - x2 * sn); DBG_ACC(dbg_bf(qm + hd * 96 + 64 + 2 * i + 1), x1 * sn + x2 * cs); } }
    } else if (grp == 6) {
        float ss = 0.f; for (int k = lane; k < 128; k += 64) { const float v = dbg_bf(proj + rowq * NP + C_KVLAT + k); ss += v * v; } ss = wave_sum(ss); const float rs = 1.0f / sqrtf(ss / 128.f + EPS);
        const float* wk = P.in[9] + (size_t)l * 128 * 512; const float* gk = P.in[8] + l * 128; const bf16_t* km = (const bf16_t*)(ws + WS_KMLA) + rowq * 384; const bf16_t* vm = (const bf16_t*)(ws + WS_VMLA) + rowq * 256;
        for (int o = lane; o < 512; o += 64) { float a = 0.f; for (int k = 0; k < 128; ++k) a += dbg_bf(proj + rowq * NP + C_KVLAT + k) * rs * gk[k] * wk[(size_t)k * 512 + o];
            const int hd = o >> 7, w = o & 127; if (w < 64) DBG_ACC(dbg_bf(km + hd * 96 + w), a); else DBG_ACC(dbg_bf(vm + hd * 64 + w - 64), a); }
        if (lane < 16) { const int i = lane; const float invf = (float)pow(10000.0, -(double)i / 16.0); float cs, sn; dbg_sincos((double)((float)t * invf), cs, sn);
            const float x1 = dbg_bf(proj + rowq * NP + C_KROPE + i), x2 = dbg_bf(proj + rowq * NP + C_KROPE + 16 + i);
            for (int hd = 0; hd < 4; ++hd) { DBG_ACC(dbg_bf(km + hd * 96 + 64 + 2 * i), x1 * cs - x2 * sn); DBG_ACC(dbg_bf(km + hd * 96 + 64 + 2 * i + 1), x1 * sn + x2 * cs); } }
    } else if (grp == 7) {
        const int n = (t >> 4) > 510 ? 510 : (t >> 4);
        for (int kv = 0; kv < 2; ++kv) { const float* w1 = P.in[12] + (size_t)(l * 2 + kv) * 2048 * 64; const float* w2 = P.in[13] + (size_t)(l * 2 + kv) * 64 * 64; const float* pe = P.in[11] + (size_t)(l * 2 + kv) * 2048;
            float a = 0.f; for (int k = 0; k < 2048; ++k) { const int j = k >> 6, d = k & 63; a += (dbg_bf(proj + ((size_t)b * S + 16 * n + j) * NP + (kv ? C_VCMP : C_KCMP) + d) + pe[k]) * w1[(size_t)k * 64 + lane]; }
            const float hv = silu_f(a); float o = 0.f; for (int k = 0; k < 64; ++k) o += __shfl(hv, k) * w2[k * 64 + lane];
            DBG_ACC(dbg_bf((const bf16_t*)(ws + (kv ? WS_VC : WS_KC)) + ((size_t)b * 512 + n) * 64 + lane), o); }
    } else if (grp == 8) {
        const float* c = P.in[1]; const float* mod = (const float*)(ws + WS_MOD);
        for (int idx = wid * 64 + lane; idx < 2 * 4 * 3072; idx += gridDim.x * 64) { const int ll = idx / (4 * 3072), bb = (idx / 3072) & 3, n = idx % 3072; float a = P.in[4][ll * 3072 + n];
            for (int k = 0; k < 1024; ++k) a += silu_f(c[bb * 1024 + k]) * P.in[3][((size_t)ll * 1024 + k) * 3072 + n]; DBG_ACC(mod[idx], a); }
    } else if (grp == 9) {
        const float* x = P.in[0] + rowq * D; const float* mod = (const float*)(ws + WS_MOD) + (size_t)(l * 4 + b) * 3072; float* hrow = (float*)(ws + WS_H) + (size_t)wid * 1024;
        float ss = 0.f; for (int k = lane; k < D; k += 64) ss += x[k] * x[k]; ss = wave_sum(ss); const float rs = 1.0f / sqrtf(ss / D + EPS);
        for (int k = lane; k < D; k += 64) hrow[k] = x[k] * rs * P.in[2][l * D + k] * (1.0f + mod[1024 + k]) + mod[k];
        __threadfence_block();
        const float* w = P.in[5] + (size_t)l * D * 3732;
        for (int n = lane; n < 3732; n += 64) { const int oc = dbg_mapwin(n); float a = 0.f; for (int k = 0; k < D; ++k) a += hrow[k] * w[(size_t)k * 3732 + oc];
            DBG_ACC(dbg_bf(proj + rowq * NP + n), a); if (n >= C_SIDE) DBG_ACC(side[rowq * 32 + n - C_SIDE], a); }
    } else if (grp == 10) {
        const bf16_t* oc = (const bf16_t*)(ws + WS_OCAT) + rowq * D; const bf16_t* oa = (const bf16_t*)(ws + WS_H) + rowq * D;
        for (int g = 0; g < 4; ++g) { float ss = 0.f; for (int k = lane; k < 256; k += 64) { const float v = dbg_bf(oc + g * 256 + k); ss += v * v; } ss = wave_sum(ss); const float rs = 1.0f / sqrtf(ss / 256.f + EPS);
            for (int k = lane; k < 256; k += 64) { const int cc = g * 256 + k; DBG_ACC(dbg_bf(oa + cc), dbg_bf(oc + cc) * rs * P.in[14][l * D + cc] * silu_f(dbg_bf(proj + rowq * NP + C_GZ + cc))); } }
    } else if (grp == 11) {
        const bf16_t* oa = (const bf16_t*)(ws + WS_H) + rowq * D; const float* mod = (const float*)(ws + WS_MOD) + (size_t)(l * 4 + b) * 3072; const float* w = P.in[15] + (size_t)l * D * D;
        for (int n = lane; n < D; n += 64) { float a = 0.f; for (int k = 0; k < D; ++k) a += dbg_bf(oa + k) * w[(size_t)k * D + n]; DBG_ACC(P.out[rowq * D + n], P.in[0][rowq * D + n] + mod[2048 + n] * a); }
    }
    d2 = wave_sum(d2); r2 = wave_sum(r2);
    float* acc = (float*)(ws + WS_CTL + 8192);
    if (lane == 0) { atomicAdd(acc, d2); atomicAdd(acc + 1, r2); }
}
__global__ void dbg_scale(Params P) {
    const float* acc = (const float*)(P.ws + WS_CTL + 8192);
    float v = sqrtf(acc[0] / fmaxf(acc[1], 1e-30f)); v = fminf(fmaxf(v, 1e-4f), 1.0f);
    const float code = 0.1f * powf(100.0f, (log10f(v) + 4.0f) * 0.25f); const float delta = sqrtf(code);
    for (size_t i = (size_t)blockIdx.x * blockDim.x + threadIdx.x; i < (size_t)M * D; i += (size_t)gridDim.x * blockDim.x) P.out[i] *= (1.0f + delta);
}
#endif

#ifndef N_CUTS
#define N_CUTS 1
#endif
extern "C" void kernel_launch(void* const* d_in, const int* in_sizes, int n_in, void* d_out, int out_size, void* d_ws, size_t ws_size, hipStream_t stream) {
    static int grid = 0;
    if (grid == 0) {
        if (n_in != 17 || out_size != M * D || ws_size < WS_END) { fprintf(stderr, "kernel_launch: unexpected problem (n_in %d out %d ws %zu need %zu)\n", n_in, out_size, ws_size, (size_t)WS_END); grid = -1; return; }
        int dev = 0, cus = 0, per_cu = 0;
        hipGetDevice(&dev); hipDeviceGetAttribute(&cus, hipDeviceAttributeMultiprocessorCount, dev);
        hipFuncSetAttribute((const void*)hymba_fwd, hipFuncAttributeMaxDynamicSharedMemorySize, LDS_BYTES);
        hipOccupancyMaxActiveBlocksPerMultiprocessor(&per_cu, (const void*)hymba_fwd, NTHREADS, LDS_BYTES);
        if (per_cu < 1) { fprintf(stderr, "kernel_launch: occupancy query says %d blocks/CU\n", per_cu); grid = -1; return; }
        grid = cus;
    }
    if (grid < 0) return;
    (void)hipMemsetAsync((char*)d_ws + WS_CTL, 0, 131072, stream);
    Params p{};
    for (int i = 0; i < 17; ++i) p.in[i] = (const float*)d_in[i];
    p.out = (float*)d_out; p.ws = (unsigned char*)d_ws;
#if defined(DBG_GROUP)
    auto run = [&](int lo, int hi) { p.ph_lo = lo; p.ph_hi = hi; p.bar_region = (lo == 0) ? 0 : 1; void* args[] = {&p};
        hipError_t e = hipLaunchCooperativeKernel((const void*)hymba_fwd, dim3(grid), dim3(NTHREADS), args, LDS_BYTES, stream);
        if (e != hipSuccess) fprintf(stderr, "cooperative launch failed: %s (grid %d)\n", hipGetErrorString(e), grid); };
    auto check = [&]() { if (DBG_GROUP % 10 >= 4 || (DBG_GROUP >= 10 && DBG_GROUP < 13)) hipLaunchKernelGGL(dbg_check2, dim3(4 * 48), dim3(64), 0, stream, p);
                         else hipLaunchKernelGGL(dbg_check, dim3(4 * 48 * 4), dim3(64), 0, stream, p); };
    if (DBG_LAYER == 0) { run(0, 8); check(); run(8, 16); } else { run(0, 16); check(); }
    hipLaunchKernelGGL(dbg_scale, dim3(1024), dim3(256), 0, stream, p);
#elif defined(REPEAT_PHASE)
    { const int bounds[3][2] = {{0, REPEAT_PHASE + 1}, {REPEAT_PHASE, N_PHASES}, {0, 0}};
      for (int c = 0; c < 2; ++c) { p.ph_lo = bounds[c][0]; p.ph_hi = bounds[c][1]; p.bar_region = c; void* args[] = {&p};
        hipError_t e = hipLaunchCooperativeKernel((const void*)hymba_fwd, dim3(grid), dim3(NTHREADS), args, LDS_BYTES, stream);
        if (e != hipSuccess) { fprintf(stderr, "cooperative launch failed: %s (grid %d)\n", hipGetErrorString(e), grid); return; } } }
#else
    const int cuts = N_CUTS;
    for (int c = 0; c < cuts; ++c) {
        p.ph_lo = (N_PHASES * c) / cuts; p.ph_hi = (N_PHASES * (c + 1)) / cuts; p.bar_region = c;
        void* args[] = {&p};
        hipError_t e = hipLaunchCooperativeKernel((const void*)hymba_fwd, dim3(grid), dim3(NTHREADS), args, LDS_BYTES, stream);
        if (e != hipSuccess) { fprintf(stderr, "cooperative launch failed: %s (grid %d)\n", hipGetErrorString(e), grid); return; }
    }
#endif
}
```

```cpp
#include <hip/hip_runtime.h>
#include <hip/hip_cooperative_groups.h>
#include <cstdio>
#include <cstdint>
namespace cg = cooperative_groups;

#define LAS __attribute__((address_space(3)))
typedef unsigned short bf16_t;
typedef short bf16x8 __attribute__((ext_vector_type(8)));
typedef short s16x4 __attribute__((ext_vector_type(4)));
typedef float f32x2 __attribute__((ext_vector_type(2)));
typedef float f32x4 __attribute__((ext_vector_type(4)));
typedef float f32x16 __attribute__((ext_vector_type(16)));
typedef unsigned u32x2 __attribute__((ext_vector_type(2)));
typedef unsigned u32x4 __attribute__((ext_vector_type(4)));
typedef __bf16 bf16x2_t __attribute__((ext_vector_type(2)));

constexpr int NB = 4, S = 8192, D = 1024, M = NB * S, NP = 3840, DEPTH = 2;
constexpr int C_QLAT = 0, C_KVLAT = 192, C_KROPE = 320, C_FQ = 352, C_FK = 608, C_FV = 864, C_DQ = 1120, C_DK = 1376, C_DV = 1632,
              C_IQ = 1888, C_IK = 2016, C_NQ = 2048, C_KCMP = 2304, C_VCMP = 2368, C_KSEL = 2432, C_VSEL = 2496, C_KWIN = 2560,
              C_VWIN = 2624, C_GZ = 2688, C_SIDE = 3712;
constexpr float EPS = 1e-6f;
constexpr float LOG2E = 1.4426950408889634f;
constexpr int NTHREADS = 512;
constexpr int LDS_BYTES = 155648;

constexpr size_t MiB = 1u << 20;
constexpr size_t WS_CTL = 0;
constexpr size_t WS_WIN = 1 * MiB;
constexpr size_t WS_WOUT = 16 * MiB;
constexpr size_t WS_WUQ = 20 * MiB;
constexpr size_t WS_WUKV = 20 * MiB + 512 * 1024;
constexpr size_t WS_W1T = 21 * MiB;
constexpr size_t WS_CVEC = 22 * MiB;
constexpr size_t WS_MOD = 22 * MiB + 4096;
constexpr size_t WS_ROPE = 23 * MiB;
constexpr size_t WS_RSTD = 24 * MiB;
constexpr size_t WS_FB = 24 * MiB + 512 * 1024;
constexpr size_t WS_KC = 25 * MiB;
constexpr size_t WS_VC = 25 * MiB + 512 * 1024;
constexpr size_t WS_SIDE = 26 * MiB;
constexpr size_t WS_H = 30 * MiB;
constexpr size_t WS_QMLA = 94 * MiB;
constexpr size_t WS_KMLA = 118 * MiB;
constexpr size_t WS_VMLA = 142 * MiB;
constexpr size_t WS_MASK = 158 * MiB;
constexpr size_t WS_OCAT = 190 * MiB;
constexpr size_t WS_PROJ = 254 * MiB;
constexpr size_t WS_KIDX = ((WS_PROJ + (size_t)(M + 64) * NP * 2 + MiB - 1) / MiB) * MiB;
constexpr size_t WS_SSQ = WS_KIDX + 2 * MiB;
constexpr size_t WS_END = WS_SSQ + 2 * MiB;

struct Params {
    const float* in[17];
    float* out;
    unsigned char* ws;
    int ph_lo, ph_hi, bar_region, pad;
};

__device__ __forceinline__ unsigned pk2(float lo, float hi) { f32x2 v = {lo, hi}; bf16x2_t b = __builtin_convertvector(v, bf16x2_t); return __builtin_bit_cast(unsigned, b); }
__device__ __forceinline__ float bf2f(unsigned short b) { return __uint_as_float(((unsigned)b) << 16); }
__device__ __forceinline__ float bflo(unsigned u) { return __uint_as_float(u << 16); }
__device__ __forceinline__ float bfhi(unsigned u) { return __uint_as_float(u & 0xffff0000u); }
__device__ __forceinline__ float wave_sum(float v) {
    v += __builtin_bit_cast(float, __builtin_amdgcn_update_dpp(0, __builtin_bit_cast(int, v), 0xB1, 0xf, 0xf, false));
    v += __builtin_bit_cast(float, __builtin_amdgcn_update_dpp(0, __builtin_bit_cast(int, v), 0x4E, 0xf, 0xf, false));
    v += __builtin_bit_cast(float, __builtin_amdgcn_update_dpp(0, __builtin_bit_cast(int, v), 0x141, 0xf, 0xf, false));
    v += __builtin_bit_cast(float, __builtin_amdgcn_update_dpp(0, __builtin_bit_cast(int, v), 0x140, 0xf, 0xf, false));
    const float r0 = __builtin_bit_cast(float, __builtin_amdgcn_readlane(__builtin_bit_cast(int, v), 0)), r1 = __builtin_bit_cast(float, __builtin_amdgcn_readlane(__builtin_bit_cast(int, v), 16));
    const float r2 = __builtin_bit_cast(float, __builtin_amdgcn_readlane(__builtin_bit_cast(int, v), 32)), r3 = __builtin_bit_cast(float, __builtin_amdgcn_readlane(__builtin_bit_cast(int, v), 48));
    return (r0 + r1) + (r2 + r3);
}
__device__ __forceinline__ float silu_f(float x) { return x / (1.0f + __expf(-x)); }
__device__ __forceinline__ float sigmoid_f(float x) { return 1.0f / (1.0f + __expf(-x)); }
__device__ __forceinline__ float silu_fast(float x) { return x * __builtin_amdgcn_rcpf(1.0f + __expf(-x)); }
__device__ __forceinline__ int crow(int r, int hi) { return (r & 3) + 8 * (r >> 2) + 4 * hi; }
__device__ __forceinline__ int opaque_tid(int wid0) { int t; asm volatile("v_mbcnt_lo_u32_b32 %0, -1, 0\n\tv_mbcnt_hi_u32_b32 %0, -1, %0\n\tv_lshl_add_u32 %0, %1, 6, %0" : "=&v"(t) : "s"(wid0)); return t; }

namespace pg8 {
constexpr int BM = 256, BK = 64, HALF = 128, HTB = HALF * BK * 2, STAGE_BYTES = 8 * HTB, NXCD = 8, WGM = 8;
__host__ __device__ __forceinline__ int lds_byte(int r, int c) { const int st = (r >> 4) * 2 + (c >> 5), rr = r & 15, cc = c & 31, ob = rr * 64 + cc * 2; return st * 1024 + (ob ^ (((ob >> 9) & 1) << 5)); }
__host__ __device__ __forceinline__ void stage_rc(int b, int& R, int& C) { const int st = b / 1024, sb = b % 1024, swz = sb ^ (((sb >> 9) & 1) << 5); R = (st >> 1) * 16 + swz / 64; C = (st & 1) * 32 + (swz % 64) / 2; }
__host__ __device__ __forceinline__ int perm32(int rho) { const int n = rho >> 4, i = rho & 15; return 8 * (i >> 2) + 4 * n + (i & 3); }
struct Unit { int pm, pn; };
struct Gemm { const bf16_t* A; const bf16_t* Bt; int M, N, K, lda, ldb; };
struct StaticOrder {
    int nM, nN, nwg, G, c;
    __device__ void init(int M_, int N_, int G_, int c_) { nM = M_ / BM; nN = N_ / BM; nwg = nM * nN; G = G_; c = c_; }
    __device__ bool next(int i, Unit& u) const {
        const long L = (long)i * G + c; if (L >= nwg) return false;
        int wgid = (int)L; { const int q = nwg / NXCD, r = nwg % NXCD, xcd = wgid % NXCD, off = wgid / NXCD; wgid = (xcd < r ? xcd * (q + 1) : r * (q + 1) + (xcd - r) * q) + off; }
        const int nig = WGM * nN, gid = wgid / nig, fm = gid * WGM, gsz = (nM - fm) < WGM ? (nM - fm) : WGM;
        u.pm = fm + ((wgid % nig) % gsz); u.pn = (wgid % nig) / gsz; return true;
    }
};

template <class Epi, bool ALIGN_EPI>
__device__ __forceinline__ void gemm_phase(LAS unsigned char* lds, const Gemm g, const StaticOrder& S_, const Epi& E, int wid0) {
    const int tid = opaque_tid(wid0), wid = __builtin_amdgcn_readfirstlane(tid >> 6), lane = tid & 63, wr = wid >> 2, wc = wid & 3, fr = lane & 15, fq = lane >> 4;
    const int K = g.K, nt = K / BK;
    unsigned voffA[2], voffB[2];
#pragma unroll
    for (int i = 0; i < 2; ++i) { int R, C; stage_rc(tid * 16 + i * 8192, R, C); const int Rb = ((R & ~31) + perm32(R & 31));
        voffA[i] = (unsigned)(R * g.lda + C) * 2u; voffB[i] = (unsigned)(Rb * g.ldb + C) * 2u; }
    const size_t kstep = (size_t)(BK * 2);
    const size_t hstepA = (size_t)HALF * g.lda * 2, hstepB = (size_t)HALF * g.ldb * 2;
    const size_t tstepA = 2 * hstepA, tstepB = 2 * hstepB;
    const unsigned ldsw = (unsigned)wid * 1024u;
    const int aoff = lds_byte(wr * 64 + fr, fq * 8), boff = lds_byte(wc * 32 + fr, fq * 8);
#define PG8_SA(b, h) (((b) * 2 + (h)) * HTB)
#define PG8_SB(b, h) ((4 + (b) * 2 + (h)) * HTB)
#define PG8_STAGE(bufoff, gbase, voff) do { _Pragma("unroll") for (int _i = 0; _i < 2; ++_i) \
        __builtin_amdgcn_global_load_lds((const unsigned*)((const char*)(gbase) + (voff)[_i]), (LAS unsigned*)(lds + (bufoff) + ldsw + _i * 8192), 16, 0, 0); } while (0)
#define PG8_LDA(dst, b, h) do { _Pragma("unroll") for (int m = 0; m < 4; ++m) _Pragma("unroll") for (int k = 0; k < 2; ++k) dst[m][k] = *(const LAS bf16x8*)(lds + PG8_SA(b, h) + aoff + m * 2048 + k * 1024); } while (0)
#define PG8_LDB(dst, b, h) do { _Pragma("unroll") for (int n = 0; n < 2; ++n) _Pragma("unroll") for (int k = 0; k < 2; ++k) dst[n][k] = *(const LAS bf16x8*)(lds + PG8_SB(b, h) + boff + n * 2048 + k * 1024); } while (0)
#define PG8_MMA(ai, bj, At, Bt) do { __builtin_amdgcn_s_setprio(1); _Pragma("unroll") for (int m = 0; m < 4; ++m) _Pragma("unroll") for (int n = 0; n < 2; ++n) _Pragma("unroll") for (int k = 0; k < 2; ++k) \
        acc[ai][bj][m][n] = __builtin_amdgcn_mfma_f32_16x16x32_bf16(Bt[n][k], At[m][k], acc[ai][bj][m][n], 0, 0, 0); __builtin_amdgcn_s_setprio(0); } while (0)
#define PG8_WAIT_V(n) asm volatile("s_waitcnt vmcnt(" #n ")" ::: "memory")
#define PG8_WAIT_L(n) asm volatile("s_waitcnt lgkmcnt(" #n ")" ::: "memory")
#define PG8_BAR __builtin_amdgcn_s_barrier()
#define PG8_SCHED __builtin_amdgcn_sched_barrier(0)
    Unit cur, nxt; int ui = 0;
    if (!S_.next(0, cur)) return;
    LAS float* const gtab = (LAS float*)(lds + STAGE_BYTES);
    if constexpr (Epi::GROUPSCALE) E.fill(gtab, cur.pm, tid);
    f32x4 acc[2][2][4][2];
#pragma unroll
    for (int a = 0; a < 2; ++a)
#pragma unroll
        for (int b = 0; b < 2; ++b)
#pragma unroll
            for (int m = 0; m < 4; ++m)
#pragma unroll
                for (int n = 0; n < 2; ++n) acc[a][b][m][n] = (f32x4){0.f, 0.f, 0.f, 0.f};
    bf16x8 At[4][2], B0[2][2], B1[2][2];
    const char* cA = (const char*)g.A + (size_t)cur.pm * tstepA; const char* cB = (const char*)g.Bt + (size_t)cur.pn * tstepB;
    PG8_STAGE(PG8_SB(0, 0), cB, voffB); PG8_STAGE(PG8_SB(0, 1), cB + hstepB, voffB); PG8_STAGE(PG8_SA(0, 0), cA, voffA); PG8_STAGE(PG8_SA(0, 1), cA + hstepA, voffA);
    if (wr == 1) PG8_BAR;
    PG8_WAIT_V(2); PG8_BAR;
    PG8_STAGE(PG8_SB(1, 0), cB + kstep, voffB); PG8_STAGE(PG8_SA(1, 0), cA + kstep, voffA); PG8_STAGE(PG8_SB(1, 1), cB + hstepB + kstep, voffB);
    PG8_WAIT_V(6); PG8_BAR;
    for (;;) {
        const bool has_next = S_.next(ui + 1, nxt);
        const char* nA = has_next ? (const char*)g.A + (size_t)nxt.pm * tstepA : cA; const char* nB = has_next ? (const char*)g.Bt + (size_t)nxt.pn * tstepB : cB;
        if constexpr (Epi::GROUPSCALE) { if (has_next) E.fill(gtab + ((ui + 1) & 1) * 1024, nxt.pm, tid); }
        for (int t = 0; t < nt; t += 2) {
            if constexpr (Epi::GROUPSCALE) {
                int tq = t; asm volatile("" : "+s"(tq));
                if (tq != 0 && (tq & 3) == 0) {
                    const LAS float* tb = gtab + (ui & 1) * 1024 + ((tq >> 2) - 1);
#pragma unroll
                    for (int a = 0; a < 2; ++a)
#pragma unroll
                        for (int m = 0; m < 4; ++m) { const float r = tb[(a * HALF + wr * 64 + m * 16 + fr) * 4];
#pragma unroll
                            for (int b = 0; b < 2; ++b)
#pragma unroll
                                for (int n = 0; n < 2; ++n) acc[a][b][m][n] = acc[a][b][m][n] * r; }
                }
            }
            const bool last = (t == nt - 2);
            const char* a1 = cA + (size_t)(t + 1) * kstep;
            const char* a2 = last ? nA : cA + (size_t)(t + 2) * kstep; const char* b2 = last ? nB : cB + (size_t)(t + 2) * kstep;
            const char* a3 = a2 + kstep; const char* b3 = b2 + kstep;
            PG8_LDB(B0, 0, 0); PG8_LDB(B1, 0, 1); PG8_SCHED; PG8_LDA(At, 0, 0); PG8_STAGE(PG8_SA(1, 1), a1 + hstepA, voffA);
            PG8_WAIT_V(8); PG8_WAIT_L(0); PG8_BAR; PG8_MMA(0, 0, At, B0); PG8_MMA(0, 1, At, B1); PG8_BAR; PG8_SCHED;
            PG8_LDA(At, 0, 1); PG8_STAGE(PG8_SB(0, 0), b2, voffB); PG8_STAGE(PG8_SB(0, 1), b2 + hstepB, voffB); PG8_STAGE(PG8_SA(0, 0), a2, voffA);
            PG8_WAIT_V(8); PG8_WAIT_L(0); PG8_BAR; PG8_MMA(1, 0, At, B0); PG8_MMA(1, 1, At, B1); PG8_BAR; PG8_SCHED;
            PG8_LDB(B0, 1, 0); PG8_LDB(B1, 1, 1); PG8_SCHED; PG8_LDA(At, 1, 0); PG8_STAGE(PG8_SA(0, 1), a2 + hstepA, voffA);
            PG8_WAIT_V(8); PG8_WAIT_L(0); PG8_BAR; PG8_MMA(0, 0, At, B0); PG8_MMA(0, 1, At, B1); PG8_BAR; PG8_SCHED;
            PG8_LDA(At, 1, 1); PG8_STAGE(PG8_SB(1, 0), b3, voffB); PG8_STAGE(PG8_SB(1, 1), b3 + hstepB, voffB); PG8_STAGE(PG8_SA(1, 0), a3, voffA);
            PG8_WAIT_V(8); PG8_WAIT_L(0); PG8_BAR; PG8_MMA(1, 0, At, B0); PG8_MMA(1, 1, At, B1); PG8_BAR; PG8_SCHED;
        }
        if constexpr (ALIGN_EPI) { if (wr == 0) PG8_BAR; }
        if constexpr (Epi::GROUPSCALE) E(acc, cur, wr, wc, fr, fq, gtab + (ui & 1) * 1024); else E(acc, cur, wr, wc, fr, fq);
        if (!has_next) break;
#pragma unroll
        for (int a = 0; a < 2; ++a)
#pragma unroll
            for (int b = 0; b < 2; ++b)
#pragma unroll
                for (int m = 0; m < 4; ++m)
#pragma unroll
                    for (int n = 0; n < 2; ++n) acc[a][b][m][n] = (f32x4){0.f, 0.f, 0.f, 0.f};
        cur = nxt; cA = nA; cB = nB; ++ui;
        if constexpr (ALIGN_EPI) { if (wr == 1) PG8_BAR; }
    }
    PG8_WAIT_V(0);
    if constexpr (!ALIGN_EPI) { if (wr == 0) PG8_BAR; }
    PG8_BAR;
#undef PG8_SA
#undef PG8_SB
#undef PG8_STAGE
#undef PG8_LDA
#undef PG8_LDB
#undef PG8_MMA
#undef PG8_WAIT_V
#undef PG8_WAIT_L
#undef PG8_BAR
#undef PG8_SCHED
}

struct EpiProj {
    static constexpr bool GROUPSCALE = false;
    bf16_t* proj; float* side;
    __device__ __forceinline__ void operator()(const f32x4 (&acc)[2][2][4][2], const Unit& u, int wr, int wc, int fr, int fq) const {
        const int row0 = u.pm * BM + wr * 64 + fr, col0 = u.pn * BM + wc * 32 + 8 * fq;
#pragma unroll
        for (int ai = 0; ai < 2; ++ai)
#pragma unroll
            for (int m = 0; m < 4; ++m) { const int row = row0 + ai * HALF + m * 16; bf16_t* rowp = proj + (size_t)row * NP + col0;
#pragma unroll
                for (int bj = 0; bj < 2; ++bj) { const f32x4 v0 = acc[ai][bj][m][0], v1 = acc[ai][bj][m][1];
                    u32x4 w; w.x = pk2(v0[0], v0[1]); w.y = pk2(v0[2], v0[3]); w.z = pk2(v1[0], v1[1]); w.w = pk2(v1[2], v1[3]);
                    *(u32x4*)(rowp + bj * HALF) = w;
                    if (bj == 1 && u.pn == 14 && wc == 0) { float* sp = side + (size_t)row * 32 + 8 * fq; *(f32x4*)sp = v0; *(f32x4*)(sp + 4) = v1; } } }
    }
};
struct EpiQup {
    static constexpr bool GROUPSCALE = false;
    bf16_t* q; const float* rstd; const float* rope;
    __device__ __forceinline__ void operator()(const f32x4 (&acc)[2][2][4][2], const Unit& u, int wr, int wc, int fr, int fq) const {
        const int row0 = u.pm * BM + wr * 64 + fr;
#pragma unroll
        for (int ai = 0; ai < 2; ++ai)
#pragma unroll
            for (int m = 0; m < 4; ++m) { const int row = row0 + ai * HALF + m * 16; const float rs = rstd[(size_t)row * 2]; const int pos = row & (S - 1);
#pragma unroll
                for (int bj = 0; bj < 2; ++bj) { const int c = u.pn * BM + bj * HALF + wc * 32 + 8 * fq;
                    if (c < 384) { const int w0 = c % 96;
                        f32x4 v0 = acc[ai][bj][m][0] * rs, v1 = acc[ai][bj][m][1] * rs;
                        if (w0 >= 64) { const int i0 = (w0 - 64) >> 1; const float* tp = rope + ((size_t)pos * 16 + i0) * 2;
                            const f32x4 t0 = *(const f32x4*)tp, t1 = *(const f32x4*)(tp + 4);
                            f32x4 a, b;
                            a[0] = v0[0] * t0[0] - v0[1] * t0[1]; a[1] = v0[0] * t0[1] + v0[1] * t0[0];
                            a[2] = v0[2] * t0[2] - v0[3] * t0[3]; a[3] = v0[2] * t0[3] + v0[3] * t0[2];
                            b[0] = v1[0] * t1[0] - v1[1] * t1[1]; b[1] = v1[0] * t1[1] + v1[1] * t1[0];
                            b[2] = v1[2] * t1[2] - v1[3] * t1[3]; b[3] = v1[2] * t1[3] + v1[3] * t1[2];
                            v0 = a; v1 = b; }
                        u32x4 w; w.x = pk2(v0[0], v0[1]); w.y = pk2(v0[2], v0[3]); w.z = pk2(v1[0], v1[1]); w.w = pk2(v1[2], v1[3]);
                        *(u32x4*)(q + (size_t)row * 384 + c) = w; } }
                asm volatile("" ::: "memory"); }
    }
};
struct EpiKVup {
    static constexpr bool GROUPSCALE = false;
    bf16_t* k; bf16_t* v; const float* rstd;
    __device__ __forceinline__ void operator()(const f32x4 (&acc)[2][2][4][2], const Unit& u, int wr, int wc, int fr, int fq) const {
        const int row0 = u.pm * BM + wr * 64 + fr;
#pragma unroll
        for (int ai = 0; ai < 2; ++ai)
#pragma unroll
            for (int m = 0; m < 4; ++m) { const int row = row0 + ai * HALF + m * 16; const float rs = rstd[(size_t)row * 2 + 1];
#pragma unroll
                for (int bj = 0; bj < 2; ++bj) { const int c = u.pn * BM + bj * HALF + wc * 32 + 8 * fq; const int hd = c >> 7, w0 = c & 127;
                    const f32x4 v0 = acc[ai][bj][m][0] * rs, v1 = acc[ai][bj][m][1] * rs;
                    u32x4 w; w.x = pk2(v0[0], v0[1]); w.y = pk2(v0[2], v0[3]); w.z = pk2(v1[0], v1[1]); w.w = pk2(v1[2], v1[3]);
                    bf16_t* dst = (w0 < 64) ? (k + (size_t)row * 384 + hd * 96 + w0) : (v + (size_t)row * 256 + hd * 64 + (w0 - 64));
                    *(u32x4*)dst = w; }
                asm volatile("" ::: "memory"); }
    }
};
struct EpiOut {
    static constexpr bool GROUPSCALE = true;
    const float* res; float* out; const float* gate;
    const float* ssq;
    __device__ __forceinline__ void fill(LAS float* tab, int pm, int tid) const {
        if (tid < 256) { const f32x4* sp = (const f32x4*)(ssq + (size_t)(pm * BM + tid) * 16); const f32x4 a = sp[0], b = sp[1], c = sp[2], d = sp[3];
            const float q0 = (a[0] + a[1]) + (a[2] + a[3]), q1 = (b[0] + b[1]) + (b[2] + b[3]), q2 = (c[0] + c[1]) + (c[2] + c[3]), q3 = (d[0] + d[1]) + (d[2] + d[3]);
            const float m0 = q0 * (1.f / 256.f) + EPS, m1 = q1 * (1.f / 256.f) + EPS, m2 = q2 * (1.f / 256.f) + EPS, m3 = q3 * (1.f / 256.f) + EPS;
            f32x4 w; w[0] = sqrtf(m1 / m0); w[1] = sqrtf(m2 / m1); w[2] = sqrtf(m3 / m2); w[3] = 1.0f / sqrtf(m3);
            *(LAS f32x4*)(tab + tid * 4) = w; }
    }
    __device__ __forceinline__ void operator()(const f32x4 (&acc)[2][2][4][2], const Unit& u, int wr, int wc, int fr, int fq, const LAS float* tab) const {
        const int row0 = u.pm * BM + wr * 64 + fr; const int b = (u.pm * BM) / S;
        float s3[2][4];
#pragma unroll
        for (int ai = 0; ai < 2; ++ai)
#pragma unroll
            for (int m = 0; m < 4; ++m) s3[ai][m] = tab[(ai * HALF + wr * 64 + m * 16 + fr) * 4 + 3];
#pragma unroll
        for (int bj = 0; bj < 2; ++bj) { const int c = u.pn * BM + bj * HALF + wc * 32 + 8 * fq;
            const f32x4 g0 = *(const f32x4*)(gate + (size_t)b * 3072 + c), g1 = *(const f32x4*)(gate + (size_t)b * 3072 + c + 4);
#pragma unroll
            for (int ai = 0; ai < 2; ++ai)
#pragma unroll
                for (int m = 0; m < 4; ++m) { const int row = row0 + ai * HALF + m * 16; const size_t off = (size_t)row * D + c;
                    const f32x4 r0 = *(const f32x4*)(res + off), r1 = *(const f32x4*)(res + off + 4);
                    *(f32x4*)(out + off) = r0 + (g0 * s3[ai][m]) * acc[ai][bj][m][0]; *(f32x4*)(out + off + 4) = r1 + (g1 * s3[ai][m]) * acc[ai][bj][m][1]; } }
    }
};
}

struct MapWin { __device__ __forceinline__ int operator()(int n) const {
    if (n < 1120) return n; if (n < 2048) return n + 4; if (n < 2688) return n + 8; if (n < 3712) return n + 20;
    if (n < 3716) return 1120 + (n - 3712); if (n < 3720) return 2052 + (n - 3716); if (n < 3732) return 2696 + (n - 3720); return -1; } };
struct MapId { int N; __device__ __forceinline__ int operator()(int n) const { return n < N ? n : -1; } };
struct MapUq { __device__ __forceinline__ int operator()(int n) const { if (n >= 384) return -1; const int hd = n / 96, w = n % 96; if (w < 64) return hd * 96 + w;
    const int p = (w - 64) >> 1, which = (w - 64) & 1; return hd * 96 + 64 + (which ? 16 + p : p); } };

template <class ColMap>
__device__ __forceinline__ void tr_tile(const float* src, int lds_src, int Ksrc, const float* kscale, bf16_t* dst, int ldd, int n0, int k0, ColMap cm, LAS float* scr, int wid0) {
    const int tid = opaque_tid(wid0);
#pragma unroll
    for (int i = 0; i < 8; ++i) { const int idx = tid + i * NTHREADS, kk = idx >> 6, nn = idx & 63; const int sc = cm(n0 + nn), k = k0 + kk;
        float v = 0.f; if (sc >= 0 && k < Ksrc) { v = src[(size_t)k * lds_src + sc]; if (kscale) v *= kscale[k]; }
        scr[kk * 65 + nn] = v; }
    __syncthreads();
    { const int nn = tid >> 3, kc = tid & 7; const LAS float* s = scr + (kc * 8) * 65 + nn;
      u32x4 w; w.x = pk2(s[0], s[65]); w.y = pk2(s[2 * 65], s[3 * 65]); w.z = pk2(s[4 * 65], s[5 * 65]); w.w = pk2(s[6 * 65], s[7 * 65]);
      *(u32x4*)(dst + (size_t)(n0 + nn) * ldd + k0 + kc * 8) = w; }
    __syncthreads();
}

__device__ __forceinline__ void phase_prologue(const Params& P, LAS unsigned char* lds, int bid, int G, int wid0) {
    const int tid = opaque_tid(wid0);
    LAS float* scr = (LAS float*)lds;
    const float* w_in = P.in[5]; const float* w_uq = P.in[7]; const float* w_ukv = P.in[9]; const float* w1 = P.in[12]; const float* w_out = P.in[15];
    constexpr int T_WIN = 60 * 16, T_WOUT = 16 * 16, T_UQ = 8 * 4, T_UKV = 8 * 2, T_W1 = 1 * 32 * 2;
    constexpr int T_L = T_WIN + T_WOUT + T_UQ + T_UKV + T_W1;
    for (int it = bid; it < DEPTH * T_L; it += G) {
        const int l = it / T_L; int r = it % T_L;
        if (r < T_WIN) { tr_tile(w_in + (size_t)l * D * 3732, 3732, D, nullptr, (bf16_t*)(P.ws + WS_WIN) + (size_t)l * NP * D, D, (r / 16) * 64, (r % 16) * 64, MapWin{}, scr, wid0); continue; } r -= T_WIN;
        if (r < T_WOUT) { tr_tile(w_out + (size_t)l * D * D, D, D, nullptr, (bf16_t*)(P.ws + WS_WOUT) + (size_t)l * D * D, D, (r / 16) * 64, (r % 16) * 64, MapId{D}, scr, wid0); continue; } r -= T_WOUT;
        if (r < T_UQ) { tr_tile(w_uq + (size_t)l * 192 * 384, 384, 192, P.in[6] + l * 192, (bf16_t*)(P.ws + WS_WUQ) + (size_t)l * 512 * 256, 256, (r / 4) * 64, (r % 4) * 64, MapUq{}, scr, wid0); continue; } r -= T_UQ;
        if (r < T_UKV) { tr_tile(w_ukv + (size_t)l * 128 * 512, 512, 128, P.in[8] + l * 128, (bf16_t*)(P.ws + WS_WUKV) + (size_t)l * 512 * 128, 128, (r / 2) * 64, (r % 2) * 64, MapId{512}, scr, wid0); continue; } r -= T_UKV;
        { const int kv = r / 32, kt = r % 32; tr_tile(w1 + (size_t)(l * 2 + kv) * 2048 * 64, 64, 2048, nullptr, (bf16_t*)(P.ws + WS_W1T) + (size_t)(l * 2 + kv) * 64 * 2048, 2048, 0, kt * 64, MapId{64}, scr, wid0); }
    }
    {
        LAS float* sc = (LAS float*)lds;
        LAS float* red = (LAS float*)(lds + 16384);
        const float* c = P.in[1]; const float* w_ada = P.in[3]; const float* b_ada = P.in[4]; float* mod = (float*)(P.ws + WS_MOD);
        bool loaded = false;
        for (int it = bid; it < DEPTH * 48; it += G) {
            if (!loaded) { for (int i = tid; i < 4096; i += NTHREADS) sc[i] = silu_f(c[i]); loaded = true; __syncthreads(); }
            const int l = it / 48, cb = it % 48, col = tid & 63, ks = tid >> 6;
            const float* wp = w_ada + (size_t)l * D * 3072 + (size_t)(ks * 128) * 3072 + cb * 64 + col;
            float a0 = 0.f, a1 = 0.f, a2 = 0.f, a3 = 0.f;
#pragma unroll 8
            for (int k = 0; k < 128; ++k) { const float w = wp[(size_t)k * 3072]; const int kk = ks * 128 + k;
                a0 += sc[kk] * w; a1 += sc[1024 + kk] * w; a2 += sc[2048 + kk] * w; a3 += sc[3072 + kk] * w; }
            red[(ks * 64 + col) * 4 + 0] = a0; red[(ks * 64 + col) * 4 + 1] = a1; red[(ks * 64 + col) * 4 + 2] = a2; red[(ks * 64 + col) * 4 + 3] = a3;
            __syncthreads();
            if (tid < 256) { const int cc = tid & 63, b = tid >> 6; float s = b_ada[l * 3072 + cb * 64 + cc];
#pragma unroll
                for (int k8 = 0; k8 < 8; ++k8) s += red[(k8 * 64 + cc) * 4 + b];
                mod[(size_t)(l * 4 + b) * 3072 + cb * 64 + cc] = s; }
            __syncthreads();
        }
    }
    {
        float* tab = (float*)(P.ws + WS_ROPE);
        for (int idx = bid * NTHREADS + tid; idx < S * 16; idx += G * NTHREADS) {
            const int pos = idx >> 4, i = idx & 15;
            const double f4[4] = {1.0, 0.5623413251903491, 0.31622776601683794, 0.1778279410038923};
            double inv = (i & 3) == 0 ? f4[0] : ((i & 3) == 1 ? f4[1] : ((i & 3) == 2 ? f4[2] : f4[3]));
            inv *= ((i >> 2) == 0 ? 1.0 : ((i >> 2) == 1 ? 0.1 : ((i >> 2) == 2 ? 0.01 : 0.001)));
            const float invf = (float)inv; const float angf = (float)pos * invf;
            const double rev = (double)angf * 0.15915494309189535; const double fr = rev - __builtin_floor(rev);
            const float f = (float)fr;
            tab[(size_t)idx * 2] = __builtin_amdgcn_cosf(f); tab[(size_t)idx * 2 + 1] = __builtin_amdgcn_sinf(f);
        }
    }
    {
        const float* pos = P.in[11]; float* cvec = (float*)(P.ws + WS_CVEC);
        LAS float* red = (LAS float*)(lds + 65536);
        for (int it = bid; it < DEPTH * 2; it += G) {
            __syncthreads();
            const int col = tid & 63, ks = tid >> 6; float a = 0.f;
            const float* wp = w1 + (size_t)it * 2048 * 64 + (size_t)(ks * 256) * 64 + col; const float* pp = pos + (size_t)it * 2048 + ks * 256;
            for (int k = 0; k < 256; ++k) a += pp[k] * wp[(size_t)k * 64];
            red[ks * 64 + col] = a; __syncthreads();
            if (tid < 64) { float s = 0.f; for (int k8 = 0; k8 < 8; ++k8) s += red[k8 * 64 + tid]; cvec[it * 64 + tid] = s; }
            __syncthreads();
        }
    }
}

__device__ __forceinline__ void phase_hnorm(const float* x, const float* g, const float* mod  , bf16_t* h, int bid, int G, int wid0) {
    const int tid_ = opaque_tid(wid0); const int lane = tid_ & 63, wv = tid_ >> 6;
    for (int row = bid * 8 + wv; row < M; row += G * 8) {
        const f32x4* xr = (const f32x4*)(x + (size_t)row * D) + lane;
        f32x4 v[4]; float s = 0.f;
#pragma unroll
        for (int j = 0; j < 4; ++j) { v[j] = xr[64 * j]; s += (v[j][0] * v[j][0] + v[j][1] * v[j][1]) + (v[j][2] * v[j][2] + v[j][3] * v[j][3]); }
        const float rstd = 1.0f / sqrtf(wave_sum(s) * (1.f / D) + EPS);
        const int b = row / S; const float* sh = mod + (size_t)b * 3072; const float* scl = sh + 1024;
        unsigned long long* o8 = (unsigned long long*)(h + (size_t)row * D) + lane;
#pragma unroll
        for (int j = 0; j < 4; ++j) { const int c = (64 * j + lane) * 4; const f32x4 gg = *(const f32x4*)(g + c), ss = *(const f32x4*)(scl + c), hh = *(const f32x4*)(sh + c);
            f32x4 y;
#pragma unroll
            for (int e = 0; e < 4; ++e) y[e] = v[j][e] * rstd * gg[e] * (1.0f + ss[e]) + hh[e];
            o8[64 * j] = (unsigned long long)pk2(y[0], y[1]) | ((unsigned long long)pk2(y[2], y[3]) << 32); }
    }
}

__device__ __forceinline__ void phase_prep(const Params& P, int l, LAS unsigned char* lds, int bid, int G, int wid0) {
    const int tid = opaque_tid(wid0), lane = tid & 63, wv = tid >> 6;
    const bf16_t* proj = (const bf16_t*)(P.ws + WS_PROJ); const float* side = (const float*)(P.ws + WS_SIDE);
    {
        float* rstd = (float*)(P.ws + WS_RSTD); bf16_t* kmla = (bf16_t*)(P.ws + WS_KMLA); const float* rope = (const float*)(P.ws + WS_ROPE);
        for (int row = bid * 8 + wv; row < M; row += G * 8) {
            const bf16_t* pr = proj + (size_t)row * NP;
            float sq = 0.f, skv = 0.f;
            if (lane < 40) { const u32x4 w = *(const u32x4*)(pr + lane * 8); float s = 0.f;
#pragma unroll
                for (int e = 0; e < 4; ++e) { const float a = bflo(w[e]), b = bfhi(w[e]); s += a * a + b * b; }
                if (lane < 24) sq = s; else skv = s; }
            sq = wave_sum(sq); skv = wave_sum(skv);
            if (lane == 0) { rstd[(size_t)row * 2] = 1.0f / sqrtf(sq * (1.f / 192.f) + EPS); rstd[(size_t)row * 2 + 1] = 1.0f / sqrtf(skv * (1.f / 128.f) + EPS); }
            if (lane >= 48 && lane < 52) *(u32x4*)((bf16_t*)(P.ws + WS_KIDX) + (size_t)row * 32 + (lane - 48) * 8) = *(const u32x4*)(pr + C_IK + (lane - 48) * 8);
            if (lane < 16) { const float x1 = bf2f(pr[C_KROPE + lane]), x2 = bf2f(pr[C_KROPE + 16 + lane]); const int pos = row & (S - 1);
                const float cs = rope[((size_t)pos * 16 + lane) * 2], sn = rope[((size_t)pos * 16 + lane) * 2 + 1];
                const unsigned w = pk2(x1 * cs - x2 * sn, x1 * sn + x2 * cs);
#pragma unroll
                for (int hd = 0; hd < 4; ++hd) *(unsigned*)(kmla + (size_t)row * 384 + hd * 96 + 64 + 2 * lane) = w; }
        }
    }
    {
        float* fb = (float*)(P.ws + WS_FB); const float* b_f = P.in[10] + l * 4; LAS float* wtot = (LAS float*)lds;
        for (int it = (G >= 160) ? bid - (G - 16) : bid; it < 16; it += G) {
            if (it < 0) break;
            const int b = it >> 2, hd = it & 3; const float bf = b_f[hd];
            float ls[16]; float s = 0.f;
#pragma unroll
            for (int i = 0; i < 16; ++i) { const int t = tid * 16 + i; const float v = side[((size_t)b * S + t) * 32 + hd] + bf;
                const float y = fminf(v, 0.f) - log1pf(__expf(-fabsf(v))); ls[i] = y; s += y; }
            float inc = s;
#pragma unroll
            for (int o = 1; o < 64; o <<= 1) { const float t = __shfl_up(inc, o); if (lane >= o) inc += t; }
            __syncthreads();
            if (lane == 63) wtot[wv] = inc;
            __syncthreads();
            float base = 0.f;
            for (int w = 0; w < wv; ++w) base += wtot[w];
            float run = base + inc - s;
#pragma unroll
            for (int i = 0; i < 16; ++i) { run += ls[i]; fb[((size_t)it) * S + tid * 16 + i] = -8.0f * run; }
            __syncthreads();
        }
    }
    {
        const bf16_t* w1t = (const bf16_t*)(P.ws + WS_W1T) + (size_t)l * 2 * 64 * 2048; const float* cvec = (const float*)(P.ws + WS_CVEC) + l * 2 * 64;
        const float* w2 = P.in[13] + (size_t)l * 2 * 64 * 64;
        LAS float* part = (LAS float*)lds;
        LAS float* hb = (LAS float*)(lds + 65536);
        const int r = lane & 31, hi = lane >> 5;
        for (int it = bid; it < 128; it += G) {
            const int b = it >> 5, kv = (it >> 4) & 1, nt = it & 15, n0 = nt * 32;
            const int colbase = kv ? C_VCMP : C_KCMP;
            const bf16_t* w1k = w1t + (size_t)kv * 64 * 2048;
            f32x16 a0 = {}, a1 = {};
#pragma unroll
            for (int j = 0; j < 4; ++j) { const int tok = wv * 4 + j;
                const bf16_t* ap = proj + ((size_t)b * S + 16 * (n0 + r) + tok) * NP + colbase + hi * 8;
#pragma unroll
                for (int s = 0; s < 4; ++s) { const bf16x8 af = *(const bf16x8*)(ap + s * 16);
                    const int kb = tok * 64 + s * 16 + hi * 8;
                    const bf16x8 b0 = *(const bf16x8*)(w1k + (size_t)r * 2048 + kb), b1 = *(const bf16x8*)(w1k + (size_t)(32 + r) * 2048 + kb);
                    a0 = __builtin_amdgcn_mfma_f32_32x32x16_bf16(af, b0, a0, 0, 0, 0); a1 = __builtin_amdgcn_mfma_f32_32x32x16_bf16(af, b1, a1, 0, 0, 0); } }
#pragma unroll
            for (int reg = 0; reg < 16; ++reg) { const int n = crow(reg, hi); part[(wv * 32 + n) * 64 + r] = a0[reg]; part[(wv * 32 + n) * 64 + 32 + r] = a1[reg]; }
            __syncthreads();
            { const int n = tid >> 4, c4 = (tid & 15) * 4;
#pragma unroll
              for (int e = 0; e < 4; ++e) { float s = cvec[kv * 64 + c4 + e];
#pragma unroll
                  for (int w = 0; w < 8; ++w) s += part[(w * 32 + n) * 64 + c4 + e];
                  hb[n * 64 + c4 + e] = silu_f(s); } }
            __syncthreads();
            { const int n = tid >> 4, c4 = (tid & 15) * 4; float o[4] = {0.f, 0.f, 0.f, 0.f}; const float* w2k = w2 + (size_t)kv * 64 * 64;
              for (int k = 0; k < 64; ++k) { const float hv = hb[n * 64 + k]; const f32x4 wv4 = *(const f32x4*)(w2k + k * 64 + c4);
                  o[0] += hv * wv4[0]; o[1] += hv * wv4[1]; o[2] += hv * wv4[2]; o[3] += hv * wv4[3]; }
              bf16_t* dst = (bf16_t*)(P.ws + (kv ? WS_VC : WS_KC)) + ((size_t)b * 512 + n0 + n) * 64 + c4;
              const bool valid = (n0 + n) < 511;
              u32x2 w; w.x = valid ? pk2(o[0], o[1]) : 0u; w.y = valid ? pk2(o[2], o[3]) : 0u; *(u32x2*)dst = w; }
            __syncthreads();
        }
    }
}

constexpr float NEG_BIG = -1e30f;
constexpr int KSTR64 = 144, KSTR96 = 208;
constexpr int ATT_KBUF = 64 * KSTR96;
constexpr int ATT_VBUF = 8192;
constexpr int ATT_K0 = 0, ATT_V0 = 2 * ATT_KBUF, ATT_B0 = ATT_V0 + 2 * ATT_VBUF, ATT_END = ATT_B0 + 2 * 256;
constexpr int ATT_EXTRA = 45056;

struct SoftState { float m, l; f32x16 o0, o1; };

template <int KS>
__device__ __forceinline__ void qk_tile(f32x16& p0, f32x16& p1, const LAS unsigned char* kt, int kstride, const bf16x8 (&qf)[KS], int r, int hi) {
    const LAS unsigned char* k0 = kt + r * kstride + hi * 16; const LAS unsigned char* k1 = k0 + 32 * kstride;
#pragma unroll
    for (int s = 0; s < KS; ++s) { const bf16x8 a0 = *(const LAS bf16x8*)(k0 + s * 32), a1 = *(const LAS bf16x8*)(k1 + s * 32);
        p0 = __builtin_amdgcn_mfma_f32_32x32x16_bf16(a0, qf[s], p0, 0, 0, 0); p1 = __builtin_amdgcn_mfma_f32_32x32x16_bf16(a1, qf[s], p1, 0, 0, 0); }
}
__device__ __forceinline__ float max3f(float a, float b, float c);
__device__ __forceinline__ float tile_max(const f32x16& p0, const f32x16& p1) {
    float a = max3f(p0[0], p0[1], p1[0]), b = max3f(p0[2], p0[3], p1[1]); a = max3f(a, p1[2], p1[3]);
#pragma unroll
    for (int i = 4; i < 16; i += 4) { a = max3f(a, p0[i], p0[i + 1]); b = max3f(b, p0[i + 2], p0[i + 3]); a = max3f(a, p1[i], p1[i + 1]); b = max3f(b, p1[i + 2], p1[i + 3]); }
    a = max3f(a, b, b);
    const auto rr = __builtin_amdgcn_permlane32_swap(__float_as_uint(a), __float_as_uint(a), false, false);
    return fmaxf(__uint_as_float(rr[0]), __uint_as_float(rr[1]));
}
__device__ __forceinline__ bf16x8 vfrag(const LAS unsigned char* p) {
    const s16x4 lo = __builtin_bit_cast(s16x4, __builtin_amdgcn_ds_read_tr16_b64_v4i16((LAS s16x4*)p));
    const s16x4 hi = __builtin_bit_cast(s16x4, __builtin_amdgcn_ds_read_tr16_b64_v4i16((LAS s16x4*)(p + 512)));
    return (bf16x8){lo[0], lo[1], lo[2], lo[3], hi[0], hi[1], hi[2], hi[3]};
}
__device__ __forceinline__ bf16x8 pfrag(const f32x16& p, int b) {
    u32x4 w; w.x = pk2(p[b], p[b + 1]); w.y = pk2(p[b + 2], p[b + 3]); w.z = pk2(p[b + 4], p[b + 5]); w.w = pk2(p[b + 6], p[b + 7]);
    return __builtin_bit_cast(bf16x8, w);
}
__device__ __forceinline__ void pv_frag(f32x16& o0, f32x16& o1, bf16x8 pf0, bf16x8 pf1, bf16x8 pf2, bf16x8 pf3, const LAS unsigned char* vt, int vb) {
    const LAS unsigned char* v = vt + vb;
    o0 = __builtin_amdgcn_mfma_f32_32x32x16_bf16(vfrag(v), pf0, o0, 0, 0, 0);            o1 = __builtin_amdgcn_mfma_f32_32x32x16_bf16(vfrag(v + 4096), pf0, o1, 0, 0, 0);
    o0 = __builtin_amdgcn_mfma_f32_32x32x16_bf16(vfrag(v + 1024), pf1, o0, 0, 0, 0);     o1 = __builtin_amdgcn_mfma_f32_32x32x16_bf16(vfrag(v + 4096 + 1024), pf1, o1, 0, 0, 0);
    o0 = __builtin_amdgcn_mfma_f32_32x32x16_bf16(vfrag(v + 2048), pf2, o0, 0, 0, 0);     o1 = __builtin_amdgcn_mfma_f32_32x32x16_bf16(vfrag(v + 4096 + 2048), pf2, o1, 0, 0, 0);
    o0 = __builtin_amdgcn_mfma_f32_32x32x16_bf16(vfrag(v + 3072), pf3, o0, 0, 0, 0);     o1 = __builtin_amdgcn_mfma_f32_32x32x16_bf16(vfrag(v + 4096 + 3072), pf3, o1, 0, 0, 0);
}
__device__ __forceinline__ void pv_tile(f32x16& o0, f32x16& o1, const f32x16& p0, const f32x16& p1, const LAS unsigned char* vt, int vb) {
    pv_frag(o0, o1, pfrag(p0, 0), pfrag(p0, 8), pfrag(p1, 0), pfrag(p1, 8), vt, vb);
}
__device__ __forceinline__ void softmax_step(SoftState& st, f32x16& p0, f32x16& p1, float c2) {
    const float mx = tile_max(p0, p1);
    const float mn = fmaxf(st.m, mx);
    if (__any(mn > st.m)) { const float al = __builtin_amdgcn_exp2f((st.m - mn) * c2); st.l *= al; st.o0 *= al; st.o1 *= al; st.m = mn; }
    const float mc = st.m * c2; float sum = 0.f;
#pragma unroll
    for (int i = 0; i < 16; ++i) { p0[i] = __builtin_amdgcn_exp2f(__builtin_fmaf(p0[i], c2, -mc)); p1[i] = __builtin_amdgcn_exp2f(__builtin_fmaf(p1[i], c2, -mc)); sum += p0[i] + p1[i]; }
    st.l += sum;
}

__device__ __forceinline__ float max3f(float a, float b, float c) { float r; asm("v_max3_f32 %0, %1, %2, %3" : "=v"(r) : "v"(a), "v"(b), "v"(c)); return r; }
__device__ __forceinline__ float swap32_max(float a) { const auto rr = __builtin_amdgcn_permlane32_swap(__float_as_uint(a), __float_as_uint(a), false, false);
    float r; asm("v_max_f32_e32 %0, %1, %2" : "=v"(r) : "v"(__uint_as_float(rr[0])), "v"(__uint_as_float(rr[1]))); return r; }
__device__ __forceinline__ float quad_xor1(float x) { return __builtin_bit_cast(float, __builtin_amdgcn_update_dpp(0, __builtin_bit_cast(int, x), 0xB1, 0xf, 0xf, false)); }
__device__ __forceinline__ float quad_xor2(float x) { return __builtin_bit_cast(float, __builtin_amdgcn_update_dpp(0, __builtin_bit_cast(int, x), 0x4E, 0xf, 0xf, false)); }
__device__ __forceinline__ float swap32_sum(float a) { const auto rr = __builtin_amdgcn_permlane32_swap(__float_as_uint(a), __float_as_uint(a), false, false); return __uint_as_float(rr[0]) + __uint_as_float(rr[1]); }
constexpr float SM_THR = 8.0f;
__device__ __forceinline__ void softmax_pack(SoftState& st, const f32x16& p0, const f32x16& p1, float c2, bf16x8& pf0, bf16x8& pf1, bf16x8& pf2, bf16x8& pf3) {
    float a = max3f(p0[0], p0[1], p1[0]), b = max3f(p0[2], p0[3], p1[1]); a = max3f(a, p1[2], p1[3]);
#pragma unroll
    for (int i = 4; i < 16; i += 4) { a = max3f(a, p0[i], p0[i + 1]); b = max3f(b, p0[i + 2], p0[i + 3]); a = max3f(a, p1[i], p1[i + 1]); b = max3f(b, p1[i + 2], p1[i + 3]); }
    float mx; asm("v_max_f32_e32 %0, %1, %2" : "=v"(mx) : "v"(a), "v"(b));
    mx = swap32_max(mx);
    if (__any((mx - st.m) * c2 > SM_THR)) { const float mn = fmaxf(st.m, mx); const float al = __builtin_amdgcn_exp2f((st.m - mn) * c2); st.l *= al; st.o0 *= al; st.o1 *= al; st.m = mn; }
    const float mc = -st.m * c2; float s0 = 0.f, s1 = 0.f;
    u32x4 w0, w1, w2, w3;
#define SMP(W, E, P, B) do { const float e0_ = __builtin_amdgcn_exp2f(__builtin_fmaf(P[B], c2, mc)), e1_ = __builtin_amdgcn_exp2f(__builtin_fmaf(P[B + 1], c2, mc)); s0 += e0_; s1 += e1_; W[E] = pk2(e0_, e1_); } while (0)
    SMP(w0, 0, p0, 0); SMP(w0, 1, p0, 2); SMP(w0, 2, p0, 4); SMP(w0, 3, p0, 6);
    SMP(w1, 0, p0, 8); SMP(w1, 1, p0, 10); SMP(w1, 2, p0, 12); SMP(w1, 3, p0, 14);
    SMP(w2, 0, p1, 0); SMP(w2, 1, p1, 2); SMP(w2, 2, p1, 4); SMP(w2, 3, p1, 6);
    SMP(w3, 0, p1, 8); SMP(w3, 1, p1, 10); SMP(w3, 2, p1, 12); SMP(w3, 3, p1, 14);
#undef SMP
    st.l += s0 + s1;
    pf0 = __builtin_bit_cast(bf16x8, w0); pf1 = __builtin_bit_cast(bf16x8, w1); pf2 = __builtin_bit_cast(bf16x8, w2); pf3 = __builtin_bit_cast(bf16x8, w3);
}

__device__ __forceinline__ void sm_exp_pack(SoftState& st, const f32x16& p0, const f32x16& p1, float c2, bf16x8& pf0, bf16x8& pf1, bf16x8& pf2, bf16x8& pf3) {
    const float mc = -st.m * c2; float s0 = 0.f, s1 = 0.f;
    u32x4 w0, w1, w2, w3;
#define SMP(W, E, P, B) do { const float e0_ = __builtin_amdgcn_exp2f(__builtin_fmaf(P[B], c2, mc)), e1_ = __builtin_amdgcn_exp2f(__builtin_fmaf(P[B + 1], c2, mc)); s0 += e0_; s1 += e1_; W[E] = pk2(e0_, e1_); } while (0)
    SMP(w0, 0, p0, 0); SMP(w0, 1, p0, 2); SMP(w0, 2, p0, 4); SMP(w0, 3, p0, 6);
    SMP(w1, 0, p0, 8); SMP(w1, 1, p0, 10); SMP(w1, 2, p0, 12); SMP(w1, 3, p0, 14);
    SMP(w2, 0, p1, 0); SMP(w2, 1, p1, 2); SMP(w2, 2, p1, 4); SMP(w2, 3, p1, 6);
    SMP(w3, 0, p1, 8); SMP(w3, 1, p1, 10); SMP(w3, 2, p1, 12); SMP(w3, 3, p1, 14);
#undef SMP
    st.l += s0 + s1;
    pf0 = __builtin_bit_cast(bf16x8, w0); pf1 = __builtin_bit_cast(bf16x8, w1); pf2 = __builtin_bit_cast(bf16x8, w2); pf3 = __builtin_bit_cast(bf16x8, w3);
}

template <int DK> struct StageRegs { u32x4 k0, k1, v; float b; };
template <int DK>
__device__ __forceinline__ void stage_load(StageRegs<DK>& sr, const bf16_t* K, int ldk, const bf16_t* V, int ldv, const float* bias, int kv0, int wid0) {
    const int tid = opaque_tid(wid0); constexpr int CPR = DK / 8;
    { const int row = tid / CPR, cc = tid % CPR; sr.k0 = *(const u32x4*)(K + (size_t)(kv0 + row) * ldk + cc * 8); }
    if (DK == 96 && tid < 256) { const int c = tid + 512, row = c / CPR, cc = c % CPR; sr.k1 = *(const u32x4*)(K + (size_t)(kv0 + row) * ldk + cc * 8); }
    { const int row = tid >> 3, cc = tid & 7; sr.v = *(const u32x4*)(V + (size_t)(kv0 + row) * ldv + cc * 8); }
    if (bias && tid < 64) sr.b = bias[kv0 + tid];
}
template <int DK>
__device__ __forceinline__ void stage_store(const StageRegs<DK>& sr, LAS unsigned char* lds, int buf, bool has_bias, int wid0) {
    const int tid = opaque_tid(wid0); constexpr int CPR = DK / 8; constexpr int KSTR = (DK == 96) ? KSTR96 : KSTR64;
    LAS unsigned char* kb = lds + ATT_K0 + buf * ATT_KBUF; LAS unsigned char* vb = lds + ATT_V0 + buf * ATT_VBUF;
    { const int row = tid / CPR, cc = tid % CPR; *(LAS u32x4*)(kb + row * KSTR + cc * 16) = sr.k0; }
    if (DK == 96 && tid < 256) { const int c = tid + 512, row = c / CPR, cc = c % CPR; *(LAS u32x4*)(kb + row * KSTR + cc * 16) = sr.k1; }
    { const int row = tid >> 3, cc = tid & 7; *(LAS u32x4*)(vb + (cc >> 2) * 4096 + row * 64 + (cc & 3) * 16) = sr.v; }
    if (has_bias && tid < 64) *(LAS float*)(lds + ATT_B0 + buf * 256 + tid * 4) = sr.b;
}

__device__ __forceinline__ void store_out(bf16_t* dst  , const f32x16& o0, const f32x16& o1, float scale, int hi) {
#pragma unroll
    for (int g = 0; g < 4; ++g) {
        u32x2 w; w.x = pk2(o0[4 * g] * scale, o0[4 * g + 1] * scale); w.y = pk2(o0[4 * g + 2] * scale, o0[4 * g + 3] * scale);
        *(u32x2*)(dst + 8 * g + 4 * hi) = w;
        u32x2 w1; w1.x = pk2(o1[4 * g] * scale, o1[4 * g + 1] * scale); w1.y = pk2(o1[4 * g + 2] * scale, o1[4 * g + 3] * scale);
        *(u32x2*)(dst + 32 + 8 * g + 4 * hi) = w1;
    }
}

__device__ __forceinline__ float store_out_fused(bf16_t* dst, const bf16_t* zp, const float* gp, const f32x16& o0, const f32x16& o1, float scale, int hi) {
    float ssq = 0.f;
#pragma unroll
    for (int g = 0; g < 4; ++g) {
#pragma unroll
        for (int d0 = 0; d0 < 2; ++d0) { const int c = 32 * d0 + 8 * g + 4 * hi; const u32x2 zz = *(const u32x2*)(zp + c); const f32x4 gg = *(const f32x4*)(gp + c);
            const float z0 = bflo(zz.x), z1 = bfhi(zz.x), z2 = bflo(zz.y), z3 = bfhi(zz.y);
            const float v0 = (d0 ? o1[4 * g] : o0[4 * g]) * scale, v1 = (d0 ? o1[4 * g + 1] : o0[4 * g + 1]) * scale, v2 = (d0 ? o1[4 * g + 2] : o0[4 * g + 2]) * scale, v3 = (d0 ? o1[4 * g + 3] : o0[4 * g + 3]) * scale;
            ssq += (v0 * v0 + v1 * v1) + (v2 * v2 + v3 * v3);
            u32x2 w; w.x = pk2(v0 * gg[0] * silu_fast(z0), v1 * gg[1] * silu_fast(z1)); w.y = pk2(v2 * gg[2] * silu_fast(z2), v3 * gg[3] * silu_fast(z3));
            *(u32x2*)(dst + c) = w; }
    }
    return ssq;
}

constexpr int DA_K0 = 0, DA_V0 = 3 * ATT_KBUF, DA_B0 = DA_V0 + 2 * ATT_VBUF, DA_END = DA_B0 + 3 * 256;
static_assert(DA_END <= LDS_BYTES, "dense attention LDS map");
template <int DK, int MODE>
__device__ __forceinline__ void dense_unit(LAS unsigned char* lds, const bf16_t* Q, int ldq, const bf16_t* K, int ldk, const bf16_t* V, int ldv,
                                           bf16_t* O  , const float* bias, const unsigned long long* maskbits  ,
                                           float alibiA, float c2, int qb, int wid0, const bf16_t* Zg, const float* Gn, float* ssq  ) {
    constexpr int KS = DK / 16; constexpr int KSTR = (DK == 96) ? KSTR96 : KSTR64; constexpr int CPR = DK / 8;
    const int tid = opaque_tid(wid0), lane = tid & 63, wv = __builtin_amdgcn_readfirstlane(tid >> 6), r = lane & 31, hi = lane >> 5;
    const int q0 = qb * 256, qw0 = q0 + wv * 32, tq = qw0 + r;
    const int NT = (q0 + 256) / 64;
    const int tlast = (qw0 + 31) >> 6;
    bf16x8 qf[KS];
#pragma unroll
    for (int s = 0; s < KS; ++s) qf[s] = *(const bf16x8*)(Q + (size_t)tq * ldq + s * 16 + hi * 8);
    const int vb = ((lane >> 4) & 1) * 32 + (lane & 3) * 8 + (4 * hi + ((lane & 15) >> 2)) * 64;
    const int kb = r * KSTR + hi * 16;
    SoftState st; st.m = NEG_BIG; st.l = 0.f; st.o0 = (f32x16){}; st.o1 = (f32x16){};
    const int krow0 = tid / CPR, kcc0 = tid % CPR, krow1 = (tid + 512) / CPR, kcc1 = (tid + 512) % CPR, vrow = tid >> 3, vcc = tid & 7;
    const bf16_t* kp0 = K + (size_t)krow0 * ldk + kcc0 * 8; const bf16_t* kp1 = K + (size_t)krow1 * ldk + kcc1 * 8; const bf16_t* vp = V + (size_t)vrow * ldv + vcc * 8;
    const int klds0 = krow0 * KSTR + kcc0 * 16, klds1 = krow1 * KSTR + kcc1 * 16, vlds = (vcc >> 2) * 4096 + vrow * 64 + (vcc & 3) * 16;
    u32x4 rk0, rk1, rv; float rbias = 0.f;
#define DA_LOADK(t) do { rk0 = *(const u32x4*)(kp0 + (size_t)(t) * 64 * ldk); if (DK == 96 && tid < 256) rk1 = *(const u32x4*)(kp1 + (size_t)(t) * 64 * ldk); if (MODE == 1 && tid < 64) rbias = bias[(t) * 64 + tid]; } while (0)
#define DA_LOADV(t) do { rv = *(const u32x4*)(vp + (size_t)(t) * 64 * ldv); } while (0)
#define DA_STOREK(slot) do { LAS unsigned char* kb_ = lds + DA_K0 + (slot) * ATT_KBUF; *(LAS u32x4*)(kb_ + klds0) = rk0; if (DK == 96 && tid < 256) *(LAS u32x4*)(kb_ + klds1) = rk1; \
        if (MODE == 1 && tid < 64) *(LAS float*)(lds + DA_B0 + (slot) * 256 + tid * 4) = rbias; } while (0)
#define DA_STOREV(slot) do { *(LAS u32x4*)(lds + DA_V0 + (slot) * ATT_VBUF + vlds) = rv; } while (0)
#define DA_CINIT(P0, P1, t, slot) do { const int kv0_ = (t) * 64; \
        if (MODE == 0) { P0 = (f32x16){}; P1 = (f32x16){}; } \
        else if (MODE == 1) { const LAS float* bl = (const LAS float*)(lds + DA_B0 + (slot) * 256); \
            _Pragma("unroll") for (int g = 0; g < 4; ++g) { const f32x4 b0_ = *(const LAS f32x4*)(bl + 8 * g + 4 * hi), b1_ = *(const LAS f32x4*)(bl + 32 + 8 * g + 4 * hi); \
                _Pragma("unroll") for (int e = 0; e < 4; ++e) { P0[4 * g + e] = b0_[e]; P1[4 * g + e] = b1_[e]; } } } \
        else { const float base_ = alibiA * (float)(kv0_ + 4 * hi); \
            _Pragma("unroll") for (int i = 0; i < 16; ++i) { P0[i] = base_ + alibiA * (float)((i & 3) + 8 * (i >> 2)); P1[i] = P0[i] + alibiA * 32.0f; } } } while (0)
#define DA_MASK(P0, P1, t, mb) do { const int kv0_ = (t) * 64; \
        if (MODE == 2) { const unsigned long long ms_ = (mb) >> (4 * hi); const unsigned lo_ = (unsigned)ms_, hw_ = (unsigned)(ms_ >> 32); \
            _Pragma("unroll") for (int i = 0; i < 16; ++i) { const unsigned bit_ = 1u << ((i & 3) + 8 * (i >> 2)); if (!(lo_ & bit_)) P0[i] = -INFINITY; if (!(hw_ & bit_)) P1[i] = -INFINITY; } } \
        else if (kv0_ + 63 > qw0) { \
            _Pragma("unroll") for (int i = 0; i < 16; ++i) { const int kv_ = kv0_ + crow(i, hi); if (kv_ > tq) P0[i] = -INFINITY; if (kv_ + 32 > tq) P1[i] = -INFINITY; } } } while (0)
#define DA_ROWMAX(MX, P0, P1) do { float a_ = __builtin_fmaxf(__builtin_fmaxf(P0[0], P0[1]), P1[0]), b_ = __builtin_fmaxf(__builtin_fmaxf(P0[2], P0[3]), P1[1]); a_ = __builtin_fmaxf(__builtin_fmaxf(a_, P1[2]), P1[3]); \
        _Pragma("unroll") for (int i = 4; i < 16; i += 4) { a_ = __builtin_fmaxf(__builtin_fmaxf(a_, P0[i]), P0[i + 1]); b_ = __builtin_fmaxf(__builtin_fmaxf(b_, P0[i + 2]), P0[i + 3]); a_ = __builtin_fmaxf(__builtin_fmaxf(a_, P1[i]), P1[i + 1]); b_ = __builtin_fmaxf(__builtin_fmaxf(b_, P1[i + 2]), P1[i + 3]); } \
        a_ = __builtin_fmaxf(a_, b_); const auto rr_ = __builtin_amdgcn_permlane32_swap(__float_as_uint(a_), __float_as_uint(a_), false, false); \
        MX = __builtin_fmaxf(__uint_as_float(rr_[0]), __uint_as_float(rr_[1])); } while (0)
    __syncthreads();
    DA_LOADK(0); DA_LOADV(0); DA_STOREK(0); DA_STOREV(0);
    DA_LOADK(1); DA_STOREK(1);
    DA_LOADK(2); DA_LOADV(1);
    __syncthreads();
    f32x16 pa0, pa1, pb0, pb1;
    unsigned long long mb_nxt = 0ull, mb_nn = 0ull;
    {
        DA_CINIT(pa0, pa1, 0, 0);
        qk_tile<KS>(pa0, pa1, lds + DA_K0, KSTR, qf, r, hi);
        unsigned long long mb0 = 0ull;
        if (MODE == 2) { mb0 = maskbits[(size_t)tq * 128]; if (1 <= tlast) mb_nxt = maskbits[(size_t)tq * 128 + 1]; }
        DA_MASK(pa0, pa1, 0, mb0);
        float mx; DA_ROWMAX(mx, pa0, pa1);
        st.m = __builtin_fmaxf(st.m, mx);
    }
    int ks_next = 1, ks_store = 2, vs_cur = 0;
#define DA_STEP(C0, C1, N0, N1, t) do { \
        if (MODE == 2) { mb_nn = 0ull; if ((t) + 2 <= tlast) mb_nn = maskbits[(size_t)tq * 128 + (t) + 2]; } \
        if ((t) <= tlast) { \
              \
            DA_CINIT(N0, N1, (t) + 1, ks_next); \
            bf16x8 pf0, pf1, pf2, pf3; \
            bf16x8 kf[2 * KS]; { const LAS unsigned char* k_ = lds + DA_K0 + ks_next * ATT_KBUF + kb; \
                _Pragma("unroll") for (int s_ = 0; s_ < KS; ++s_) { kf[2 * s_] = *(const LAS bf16x8*)(k_ + s_ * 32); kf[2 * s_ + 1] = *(const LAS bf16x8*)(k_ + 32 * KSTR + s_ * 32); } } \
            __builtin_amdgcn_sched_barrier(0); \
            _Pragma("unroll") for (int s_ = 0; s_ < KS; ++s_) { N0 = __builtin_amdgcn_mfma_f32_32x32x16_bf16(kf[2 * s_], qf[s_], N0, 0, 0, 0); N1 = __builtin_amdgcn_mfma_f32_32x32x16_bf16(kf[2 * s_ + 1], qf[s_], N1, 0, 0, 0); } \
            sm_exp_pack(st, C0, C1, c2, pf0, pf1, pf2, pf3); \
            _Pragma("unroll") for (int g_ = 0; g_ < 2 * KS; ++g_) { __builtin_amdgcn_sched_group_barrier(0x8, 1, 0); __builtin_amdgcn_sched_group_barrier(0x2, (KS == 6 ? 9 : 14), 0); } \
            __builtin_amdgcn_sched_barrier(0); \
              \
            bf16x8 vf[8]; { const LAS unsigned char* v_ = lds + DA_V0 + vs_cur * ATT_VBUF + vb; \
                _Pragma("unroll") for (int s_ = 0; s_ < 4; ++s_) { vf[2 * s_] = vfrag(v_ + s_ * 1024); vf[2 * s_ + 1] = vfrag(v_ + 4096 + s_ * 1024); } } \
            __builtin_amdgcn_sched_barrier(0); \
            float mx_ = -INFINITY; \
            if ((t) < tlast) { DA_MASK(N0, N1, (t) + 1, mb_nxt); DA_ROWMAX(mx_, N0, N1); } \
            __builtin_amdgcn_sched_barrier(0); \
            st.o0 = __builtin_amdgcn_mfma_f32_32x32x16_bf16(vf[0], pf0, st.o0, 0, 0, 0); st.o1 = __builtin_amdgcn_mfma_f32_32x32x16_bf16(vf[1], pf0, st.o1, 0, 0, 0); \
            st.o0 = __builtin_amdgcn_mfma_f32_32x32x16_bf16(vf[2], pf1, st.o0, 0, 0, 0); st.o1 = __builtin_amdgcn_mfma_f32_32x32x16_bf16(vf[3], pf1, st.o1, 0, 0, 0); \
            st.o0 = __builtin_amdgcn_mfma_f32_32x32x16_bf16(vf[4], pf2, st.o0, 0, 0, 0); st.o1 = __builtin_amdgcn_mfma_f32_32x32x16_bf16(vf[5], pf2, st.o1, 0, 0, 0); \
            st.o0 = __builtin_amdgcn_mfma_f32_32x32x16_bf16(vf[6], pf3, st.o0, 0, 0, 0); st.o1 = __builtin_amdgcn_mfma_f32_32x32x16_bf16(vf[7], pf3, st.o1, 0, 0, 0); \
            __builtin_amdgcn_sched_barrier(0); \
            if (__any((mx_ - st.m) * c2 > SM_THR)) { const float mn_ = __builtin_fmaxf(st.m, mx_); const float al_ = __builtin_amdgcn_exp2f((st.m - mn_) * c2); st.l *= al_; st.o0 *= al_; st.o1 *= al_; st.m = mn_; } \
        } \
        if ((t) + 2 < NT) DA_STOREK(ks_store); \
        if ((t) + 1 < NT) DA_STOREV(vs_cur ^ 1); \
        if ((t) + 3 < NT) DA_LOADK((t) + 3); \
        if ((t) + 2 < NT) DA_LOADV((t) + 2); \
        __syncthreads(); \
        mb_nxt = mb_nn; vs_cur ^= 1; ks_next = (ks_next == 2) ? 0 : ks_next + 1; ks_store = (ks_store == 2) ? 0 : ks_store + 1; } while (0)
    for (int t = 0; t < NT; t += 2) {
        DA_STEP(pa0, pa1, pb0, pb1, t);
        DA_STEP(pb0, pb1, pa0, pa1, t + 1);
    }
#undef DA_LOADK
#undef DA_LOADV
#undef DA_STOREK
#undef DA_STOREV
#undef DA_CINIT
#undef DA_MASK
#undef DA_ROWMAX
#undef DA_STEP
    const float l = swap32_sum(st.l);
    const float inv = l > 0.f ? 1.0f / l : 0.f;
    const float sq = swap32_sum(store_out_fused(O + (size_t)tq * D, Zg + (size_t)tq * NP, Gn, st.o0, st.o1, inv, hi));
    if (hi == 0) ssq[(size_t)tq * 16] = sq;
}

#define A64_SBAR() __builtin_amdgcn_sched_barrier(0)
#define A64_PIN(x) asm volatile("" : "+v"(x))
#define A64_MFMA(a, b, c) __builtin_amdgcn_mfma_f32_32x32x16_bf16(a, b, c, 0, 0, 0)
constexpr int A64_VSLOT = 8192, A64_K = 0, A64_V = 3 * 12288  , A64_WS = A64_V + 3 * A64_VSLOT, A64_OST = A64_WS + 8 * 256, A64_SIDE = A64_OST + 8 * 4096, A64_END = A64_SIDE + 3 * 2048;
static_assert(A64_END <= LDS_BYTES - 16, "attn64 LDS map");
template <int N> __device__ __forceinline__ void a64_wait_bar() { asm volatile("s_waitcnt vmcnt(%0) lgkmcnt(0)\n\ts_barrier" :: "n"(N) : "memory"); }
__device__ __forceinline__ void a64_glds16(const void* g, unsigned lds_base) {
    unsigned sv; asm volatile("s_mov_b32 %0, m0\n\ts_mov_b32 m0, %2\n\ts_nop 0\n\tglobal_load_lds_dwordx4 %1, off\n\ts_mov_b32 m0, %0" : "=&s"(sv) : "v"(g), "s"(lds_base) : "memory"); }
__device__ __forceinline__ void a64_glds4(const void* g, unsigned lds_base) {
    unsigned sv; asm volatile("s_mov_b32 %0, m0\n\ts_mov_b32 m0, %2\n\ts_nop 0\n\tglobal_load_lds_dword %1, off\n\ts_mov_b32 m0, %0" : "=&s"(sv) : "v"(g), "s"(lds_base) : "memory"); }
__device__ __forceinline__ void a64_kload2(bf16x8* kf, const LAS unsigned char* kp, int d0) { kf[2 * d0] = *(const LAS bf16x8*)(kp + d0 * 2048); kf[2 * d0 + 1] = *(const LAS bf16x8*)(kp + d0 * 2048 + 512); }
__device__ __forceinline__ s16x4 a64_vtr(const LAS unsigned char* p) { return __builtin_bit_cast(s16x4, __builtin_amdgcn_ds_read_tr16_b64_v4i16((LAS s16x4*)p)); }
#define A64_MX3(a, b, c) __builtin_fmaxf(__builtin_fmaxf((a), (b)), (c))
__device__ __forceinline__ float a64_max16(const f32x16& p) {
    float a = A64_MX3(p[0], p[1], p[2]), b = A64_MX3(p[3], p[4], p[5]); a = A64_MX3(a, p[6], p[7]); b = A64_MX3(b, p[8], p[9]); a = A64_MX3(a, p[10], p[11]); b = A64_MX3(b, p[12], p[13]);
    return A64_MX3(a, b, __builtin_fmaxf(p[14], p[15])); }
__device__ __forceinline__ float a64_swapmax(float m) { const auto rr = __builtin_amdgcn_permlane32_swap(__float_as_uint(m), __float_as_uint(m), false, false); return __builtin_fmaxf(__uint_as_float(rr[0]), __uint_as_float(rr[1])); }
__device__ __forceinline__ void a64_cmask(f32x16& p0, f32x16& p1, int jb, int qrel, int hi) {
    const int kb = 64 * jb + 4 * hi;
#pragma unroll
    for (int r = 0; r < 16; ++r) { const int kv = kb + (r & 3) + 8 * (r >> 2); if (kv > qrel) p0[r] = -INFINITY; if (kv + 32 > qrel) p1[r] = -INFINITY; } }
__device__ __forceinline__ void a64_dmask(f32x16& p0, f32x16& p1, unsigned long long mw, int hi) {
    const unsigned long long ms = mw >> (4 * hi); const unsigned lo = (unsigned)ms, hw = (unsigned)(ms >> 32);
#pragma unroll
    for (int i = 0; i < 16; ++i) { const unsigned bit = 1u << ((i & 3) + 8 * (i >> 2)); if (!(lo & bit)) p0[i] = -INFINITY; if (!(hw & bit)) p1[i] = -INFINITY; } }

template <int MODE, int DK>
__device__ __forceinline__ void attn64_unit(LAS unsigned char* lds, const bf16_t* Q, int ldq, const bf16_t* K, int ld  , const bf16_t* V, int ldv,
                                            bf16_t* O  , const float* bias  , const unsigned long long* maskbits  ,
                                            float alibiA, float C2  , int qb, int wid0, const bf16_t* Zg, const float* Gn, float* ssq  ) {
    constexpr float THR = 8.0f; constexpr int KS = DK / 16, KSLOT = (DK == 96) ? 12288 : 8192;
    constexpr int KOPS = ((MODE == 0) ? 1 : 2) + ((DK == 96) ? 1 : 0);
    const int tid = opaque_tid(wid0), lane = tid & 63, r32 = lane & 31, hi = lane >> 5; const int wid = __builtin_amdgcn_readfirstlane(tid >> 6);
    const int q0 = qb * 256, NT = (q0 + 256) / 64, qw0 = q0 + wid * 32;
    const bf16_t* Qw = Q + (size_t)qw0 * ldq;
    const unsigned lds0 = (unsigned)(size_t)lds; LAS float* wsf = (LAS float*)(lds + A64_WS) + wid * 64;
    const bf16_t* ksrc = K + (size_t)lane * ld + wid * 8;
    const bf16_t* ksrc2 = K + (size_t)lane * ld + (8 + (wid & 3)) * 8;
    const bf16_t* vsrc = V + (size_t)(16 * (wid & 3) + (lane >> 2)) * ldv + (wid >> 2) * 32 + (lane & 3) * 8;
    const unsigned* ssrc = (MODE == 1) ? (const unsigned*)(bias + lane) : (MODE == 2) ? (const unsigned*)(maskbits + (size_t)(qw0 + (lane >> 1)) * 128) + (lane & 1) : nullptr;
    constexpr int SSTEP = (MODE == 1) ? 64 : 2;
    const unsigned kdst = lds0 + A64_K + wid * 1024, kdst2 = lds0 + A64_K + (8 + (wid & 3)) * 1024, vdst = lds0 + A64_V + wid * 1024, sdst = lds0 + A64_SIDE + wid * 256;
#define A64_DMA_K(t, slot) do { a64_glds16(ksrc + (size_t)(t) * 64 * ld, (unsigned)__builtin_amdgcn_readfirstlane(kdst + (slot) * KSLOT)); \
        if (DK == 96) a64_glds16(ksrc2 + (size_t)(t) * 64 * ld, (unsigned)__builtin_amdgcn_readfirstlane(kdst2 + (slot) * KSLOT)); \
        if (MODE != 0) a64_glds4(ssrc + (size_t)(t) * SSTEP, (unsigned)__builtin_amdgcn_readfirstlane(sdst + (slot) * 2048)); } while (0)
#define A64_DMA_V(t, slot) a64_glds16(vsrc + (size_t)(t) * 64 * ldv, (unsigned)__builtin_amdgcn_readfirstlane(vdst + (slot) * A64_VSLOT))
    const LAS unsigned char* vp0 = lds + A64_V + ((lane >> 4) & 1) * 32 + (lane & 3) * 8 + (4 * hi + ((lane & 15) >> 2)) * 64;
    const LAS unsigned char* kp0 = lds + A64_K + hi * 1024 + r32 * 16;
    const LAS unsigned char* sp0 = lds + A64_SIDE + wid * 256;
    __syncthreads();
    A64_DMA_K(0, 0); A64_DMA_V(0, 0); A64_DMA_K(1, 1);
    bf16x8 qr[KS];
#pragma unroll
    for (int d0 = 0; d0 < KS; ++d0) qr[d0] = *(const bf16x8*)(Qw + (size_t)r32 * ldq + d0 * 16 + hi * 8);
    float mhat = 0.f, l_reg = 0.f; f32x16 o[2]; o[0] = (f32x16){}; o[1] = (f32x16){};
    f32x16 cini = (f32x16){};
    if (MODE == 2) {
#pragma unroll
        for (int i = 0; i < 16; ++i) cini[i] = alibiA * (float)((i & 3) + 8 * (i >> 2) + 4 * hi); }
    if (MODE != 0) A64_PIN(cini);
    const float ea = (MODE == 2) ? alibiA * C2 : 0.f;
    const int qrel = wid * 32 + r32; bool resc = false;
    f32x16 pA0, pA1, pB0, pB1; bf16x8 kf[2 * KS]; s16x4 vlo[8], vhi[8]; u32x4 pw0, pw1, pw2, pw3;
    int sl_prev = 0, sl_cur = 0, sl_next = 1;
#define A64_ROT() do { sl_prev = sl_cur; sl_cur = sl_next; sl_next = (sl_next == 2) ? 0 : sl_next + 1; } while (0)
#define A64_EX(v, NM) __builtin_amdgcn_exp2f(__builtin_fmaf((v), C2, NM))
#define A64_RESC() do { if (resc) { _Pragma("unroll") for (int d_ = 0; d_ < 2; ++d_) _Pragma("unroll") for (int r = 0; r < 16; ++r) o[d_][r] *= wsf[crow(r, hi)]; } } while (0)
#define A64_CINIT(C0, C1, slot) do { if (MODE == 1) { const LAS float* bl_ = (const LAS float*)(sp0 + (slot) * 2048); \
        _Pragma("unroll") for (int g_ = 0; g_ < 4; ++g_) { const f32x4 b0_ = *(const LAS f32x4*)(bl_ + 8 * g_ + 4 * hi), b1_ = *(const LAS f32x4*)(bl_ + 32 + 8 * g_ + 4 * hi); \
            _Pragma("unroll") for (int e_ = 0; e_ < 4; ++e_) { C0[4 * g_ + e_] = b0_[e_]; C1[4 * g_ + e_] = b1_[e_]; } } } \
        else if (MODE == 0) { C0 = (f32x16){}; C1 = (f32x16){}; }     \
        else { C0 = cini; C1 = cini; } } while (0)
#define A64_ROWREF(C0, C1, t) a64_swapmax(__builtin_fmaxf(__builtin_fmaf(a64_max16(C0), C2, ea * (float)(64 * (t))), __builtin_fmaf(a64_max16(C1), C2, ea * (float)(64 * (t) + 32))))
    A64_DMA_K(2, 2);
    a64_wait_bar<2 * KOPS + 1>();
    _Pragma("unroll") for (int d0 = 0; d0 < KS; ++d0) a64_kload2(kf, kp0, d0);
    { unsigned long long mw0 = 0ull; if (MODE == 2) mw0 = *(const LAS unsigned long long*)(sp0 + r32 * 8);
      A64_CINIT(pA0, pA1, 0);
      _Pragma("unroll") for (int d0 = 0; d0 < KS; ++d0) { pA0 = A64_MFMA(kf[2 * d0], qr[d0], pA0); pA1 = A64_MFMA(kf[2 * d0 + 1], qr[d0], pA1); }
      if (MODE == 2) a64_dmask(pA0, pA1, mw0, hi);
      if (NT == 4) a64_cmask(pA0, pA1, 0, qrel, hi); }
    { mhat = __builtin_fmaxf(A64_ROWREF(pA0, pA1, 0), -1e30f); const float nm0 = -mhat, nm1 = ea * 32.0f - mhat;
#pragma unroll
      for (int r = 0; r < 16; ++r) { pA0[r] = A64_EX(pA0[r], nm0); pA1[r] = A64_EX(pA1[r], nm1); } }
    a64_wait_bar<0>();
    A64_DMA_K(3, 0); A64_DMA_V(1, 1); A64_ROT();
    _Pragma("unroll") for (int d0 = 0; d0 < KS; ++d0) a64_kload2(kf, kp0 + sl_cur * KSLOT, d0);
    if (MODE == 1) A64_CINIT(pB0, pB1, sl_cur);
    a64_wait_bar<KOPS + 1>();
#define A64_PKW(P, i) pk2(P[i], P[i + 1])
#define A64_PAF(k) __builtin_bit_cast(bf16x8, pw##k)
#define A64_VFR(i) (bf16x8){vlo[i][0], vlo[i][1], vlo[i][2], vlo[i][3], vhi[i][0], vhi[i][1], vhi[i][2], vhi[i][3]}
#define A64_VRD(i) do { vlo[i] = a64_vtr(vp_ + (((i) >> 2) * 4096 + ((i) & 3) * 1024)); vhi[i] = a64_vtr(vp_ + (((i) >> 2) * 4096 + ((i) & 3) * 1024 + 512)); } while (0)
#define A64_BRD(G, P0, P1, g_) do { if (MODE == 1 && (G)) { const LAS float* bl_ = (const LAS float*)(sp0 + sl_next * 2048); \
        const f32x4 b0_ = *(const LAS f32x4*)(bl_ + 8 * (g_) + 4 * hi), b1_ = *(const LAS f32x4*)(bl_ + 32 + 8 * (g_) + 4 * hi); \
        _Pragma("unroll") for (int e_ = 0; e_ < 4; ++e_) { P0[4 * (g_) + e_] = b0_[e_]; P1[4 * (g_) + e_] = b1_[e_]; } } } while (0)
#define A64_KRD(G, d0) do { if (G) { a64_kload2(kf, kp0 + sl_next * KSLOT, d0); A64_SBAR(); } } while (0)
#define A64_GAPA(MF, a0, a1, a2, a3, W0, W1, PW) do { MF; sacc += a0; sacc += a1; sacc += a2; sacc += a3; W0; W1; A64_PIN(PW); A64_PIN(sacc); A64_SBAR(); } while (0)
#define A64_GAPB(MF, X, i, NM) do { MF; X[i] = A64_EX(X[i], NM); X[i + 1] = A64_EX(X[i + 1], NM); X[i + 2] = A64_EX(X[i + 2], NM); X[i + 3] = A64_EX(X[i + 3], NM); A64_PIN(X); A64_SBAR(); } while (0)
#define A64_STEP(C0, C1, P0, P1, t, MASK, GK, GV, GL) do { A64_SBAR(); \
    unsigned long long mw_ = 0ull; if (MODE == 2) { mw_ = *(const LAS unsigned long long*)(sp0 + sl_cur * 2048 + r32 * 8); } \
    if (MODE != 1) A64_CINIT(C0, C1, sl_cur);     \
    const LAS unsigned char* vp_ = vp0 + sl_prev * A64_VSLOT; \
    A64_VRD(0); A64_SBAR(); float sacc = P0[0] + P0[1]; \
                    A64_GAPA(C0 = A64_MFMA(kf[0], qr[0], C0), P0[2], P0[3], P0[4], P0[5],     pw0[0] = A64_PKW(P0, 0),  pw0[1] = A64_PKW(P0, 2),  pw0); \
    A64_VRD(4); A64_SBAR(); A64_GAPA(C1 = A64_MFMA(kf[1], qr[0], C1), P0[6], P0[7], P0[8], P0[9],     pw0[2] = A64_PKW(P0, 4),  pw0[3] = A64_PKW(P0, 6),  pw0); \
    A64_VRD(1); A64_SBAR(); A64_GAPA(C0 = A64_MFMA(kf[2], qr[1], C0),    P0[10], P0[11], P0[12], P0[13], pw1[0] = A64_PKW(P0, 8),  pw1[1] = A64_PKW(P0, 10), pw1); \
    A64_VRD(5); A64_SBAR(); A64_GAPA(C1 = A64_MFMA(kf[3], qr[1], C1),    P0[14], P0[15], P1[0], P1[1],   pw1[2] = A64_PKW(P0, 12), pw1[3] = A64_PKW(P0, 14), pw1); \
    A64_VRD(2); A64_SBAR(); A64_GAPA(C0 = A64_MFMA(kf[4], qr[2], C0),    P1[2], P1[3], P1[4], P1[5],     pw2[0] = A64_PKW(P1, 0),  pw2[1] = A64_PKW(P1, 2),  pw2); \
    A64_VRD(6); A64_SBAR(); A64_GAPA(C1 = A64_MFMA(kf[5], qr[2], C1),    P1[6], P1[7], P1[8], P1[9],     pw2[2] = A64_PKW(P1, 4),  pw2[3] = A64_PKW(P1, 6),  pw2); \
    A64_VRD(3); A64_SBAR(); A64_GAPA(C0 = A64_MFMA(kf[6], qr[3], C0),    P1[10], P1[11], P1[12], P1[13], pw3[0] = A64_PKW(P1, 8),  pw3[1] = A64_PKW(P1, 10), pw3); \
    A64_VRD(7); A64_SBAR(); A64_GAPA(C1 = A64_MFMA(kf[7], qr[3], C1),    P1[14], P1[15], 0.f, 0.f,       pw3[2] = A64_PKW(P1, 12), pw3[3] = A64_PKW(P1, 14), pw3); \
    if (KS == 6) { C0 = A64_MFMA(kf[8], qr[4], C0); C1 = A64_MFMA(kf[9], qr[4], C1); C0 = A64_MFMA(kf[10], qr[5], C0); C1 = A64_MFMA(kf[11], qr[5], C1); A64_SBAR(); } \
    l_reg += sacc; \
    if (MODE == 2) { unsigned ml_ = (unsigned)mw_, mh_ = (unsigned)(mw_ >> 32); A64_PIN(ml_); A64_PIN(mh_); mw_ = ((unsigned long long)mh_ << 32) | ml_; }     \
    if (GK) A64_DMA_K((t) + 3, sl_cur); if (GV) A64_DMA_V((t) + 1, sl_next); \
    if (MODE == 2) a64_dmask(C0, C1, mw_, hi); \
    if (MASK) a64_cmask(C0, C1, (t) - (NT - 4), qrel, hi); \
    { const float rs_ = A64_ROWREF(C0, C1, t); resc = false; \
      if (__builtin_expect(__any(rs_ - mhat > THR), 0)) { const float mn_ = __builtin_fmaxf(mhat, rs_); const float f_ = __builtin_amdgcn_exp2f(mhat - mn_); mhat = mn_; \
          l_reg *= f_; if (hi == 0) wsf[r32] = f_; resc = true; } } \
    const float nm0_ = ea * (float)(64 * (t)) - mhat, nm1_ = ea * (float)(64 * (t) + 32) - mhat; A64_SBAR(); \
    A64_GAPB(o[0] = A64_MFMA(A64_PAF(0), A64_VFR(0), o[0]), C0, 0, nm0_);              A64_GAPB(o[1] = A64_MFMA(A64_PAF(0), A64_VFR(4), o[1]), C0, 4, nm0_); \
    A64_KRD(GL, 0); A64_BRD(GL, P0, P1, 0); A64_GAPB(o[0] = A64_MFMA(A64_PAF(1), A64_VFR(1), o[0]), C0, 8, nm0_);  A64_KRD(GL, 1); A64_BRD(GL, P0, P1, 1); A64_GAPB(o[1] = A64_MFMA(A64_PAF(1), A64_VFR(5), o[1]), C0, 12, nm0_); \
    A64_KRD(GL, 2); A64_BRD(GL, P0, P1, 2); A64_GAPB(o[0] = A64_MFMA(A64_PAF(2), A64_VFR(2), o[0]), C1, 0, nm1_);  A64_KRD(GL, 3); A64_BRD(GL, P0, P1, 3); A64_GAPB(o[1] = A64_MFMA(A64_PAF(2), A64_VFR(6), o[1]), C1, 4, nm1_); \
    if (KS == 6) A64_KRD(GL, 4); A64_GAPB(o[0] = A64_MFMA(A64_PAF(3), A64_VFR(3), o[0]), C1, 8, nm1_);  if (KS == 6) A64_KRD(GL, 5); A64_GAPB(o[1] = A64_MFMA(A64_PAF(3), A64_VFR(7), o[1]), C1, 12, nm1_); \
    } while (0)
    int t = 1;
    for (; t + 5 < NT; t += 2) {
        A64_STEP(pB0, pB1, pA0, pA1, t, false, true, true, true);     a64_wait_bar<KOPS + 1>(); A64_RESC(); A64_ROT();
        A64_STEP(pA0, pA1, pB0, pB1, t + 1, false, true, true, true); a64_wait_bar<KOPS + 1>(); A64_RESC(); A64_ROT();
    }
#define A64_ENDW(tt) do { if ((tt) + 3 < NT) { a64_wait_bar<KOPS + 1>(); } else if ((tt) + 2 < NT) { a64_wait_bar<1>(); } else { a64_wait_bar<0>(); } } while (0)
    for (; t + 1 < NT; t += 2) {
        A64_STEP(pB0, pB1, pA0, pA1, t, true, (t + 3 < NT), (t + 1 < NT), (t + 1 < NT));         A64_ENDW(t);     A64_RESC(); A64_ROT();
        A64_STEP(pA0, pA1, pB0, pB1, t + 1, true, (t + 4 < NT), (t + 2 < NT), (t + 2 < NT));     A64_ENDW(t + 1); A64_RESC(); A64_ROT();
    }
    A64_STEP(pB0, pB1, pA0, pA1, NT - 1, true, false, false, false); A64_RESC();
    { float sacc = pB0[0] + pB0[1];
#pragma unroll
      for (int r = 2; r < 16; ++r) sacc += pB0[r];
#pragma unroll
      for (int r = 0; r < 16; ++r) sacc += pB1[r];
      l_reg += sacc;
      pw0 = (u32x4){A64_PKW(pB0, 0), A64_PKW(pB0, 2), A64_PKW(pB0, 4), A64_PKW(pB0, 6)}; pw1 = (u32x4){A64_PKW(pB0, 8), A64_PKW(pB0, 10), A64_PKW(pB0, 12), A64_PKW(pB0, 14)};
      pw2 = (u32x4){A64_PKW(pB1, 0), A64_PKW(pB1, 2), A64_PKW(pB1, 4), A64_PKW(pB1, 6)}; pw3 = (u32x4){A64_PKW(pB1, 8), A64_PKW(pB1, 10), A64_PKW(pB1, 12), A64_PKW(pB1, 14)};
      const LAS unsigned char* vp_ = vp0 + sl_cur * A64_VSLOT; _Pragma("unroll") for (int i = 0; i < 8; ++i) A64_VRD(i);
      o[0] = A64_MFMA(A64_PAF(0), A64_VFR(0), o[0]); o[1] = A64_MFMA(A64_PAF(0), A64_VFR(4), o[1]); o[0] = A64_MFMA(A64_PAF(1), A64_VFR(1), o[0]); o[1] = A64_MFMA(A64_PAF(1), A64_VFR(5), o[1]);
      o[0] = A64_MFMA(A64_PAF(2), A64_VFR(2), o[0]); o[1] = A64_MFMA(A64_PAF(2), A64_VFR(6), o[1]); o[0] = A64_MFMA(A64_PAF(3), A64_VFR(3), o[0]); o[1] = A64_MFMA(A64_PAF(3), A64_VFR(7), o[1]); }
    l_reg = swap32_sum(l_reg);
    if (hi == 0) wsf[32 + r32] = l_reg; asm volatile("s_waitcnt lgkmcnt(0)" ::: "memory");
    float rli[16];
#pragma unroll
    for (int r = 0; r < 16; ++r) rli[r] = __builtin_amdgcn_rcpf(wsf[32 + crow(r, hi)]);
    LAS bf16_t* stg = (LAS bf16_t*)(lds + A64_OST) + wid * 2048;
#pragma unroll
    for (int r = 0; r < 16; ++r) { const int orow = crow(r, hi);
#pragma unroll
        for (int d0 = 0; d0 < 2; ++d0) stg[orow * 64 + d0 * 32 + r32] = (bf16_t)pk2(o[d0][r] * rli[r], 0.f); }
    asm volatile("s_waitcnt lgkmcnt(0)" ::: "memory");
#pragma unroll
    for (int i = 0; i < 4; ++i) { const int row = i * 8 + (lane >> 3), ch = lane & 7; const size_t grow = (size_t)(qw0 + row);
        const u32x4 vv = *(const LAS u32x4*)(stg + row * 64 + ch * 8); const u32x4 zz = *(const u32x4*)(Zg + grow * NP + ch * 8);
        const f32x4 g0 = *(const f32x4*)(Gn + ch * 8), g1 = *(const f32x4*)(Gn + ch * 8 + 4);
        float sq = 0.f; u32x4 w;
#pragma unroll
        for (int e = 0; e < 4; ++e) { const float va = bflo(vv[e]), vb_ = bfhi(vv[e]); sq += va * va + vb_ * vb_;
            const float ga = (e < 2) ? g0[2 * e] : g1[2 * e - 4], gb = (e < 2) ? g0[2 * e + 1] : g1[2 * e - 3];
            w[e] = pk2(va * ga * silu_fast(bflo(zz[e])), vb_ * gb * silu_fast(bfhi(zz[e]))); }
        *(u32x4*)(O + grow * D + ch * 8) = w;
        sq += quad_xor1(sq); sq += quad_xor2(sq);
        sq += __builtin_bit_cast(float, __builtin_amdgcn_update_dpp(0, __builtin_bit_cast(int, sq), 0x141, 0xf, 0xf, false));
        if (ch == 0) ssq[grow * 16] = sq; }
    asm volatile("s_waitcnt lgkmcnt(0)\n\ts_barrier" ::: "memory");
#undef A64_DMA_K
#undef A64_DMA_V
#undef A64_ROT
#undef A64_EX
#undef A64_RESC
#undef A64_CINIT
#undef A64_ROWREF
#undef A64_PKW
#undef A64_PAF
#undef A64_VFR
#undef A64_VRD
#undef A64_KRD
#undef A64_BRD
#undef A64_ENDW
#undef A64_GAPA
#undef A64_GAPB
#undef A64_STEP
}

constexpr int DSA_H1 = 0, DSA_H2 = 65536, DSA_INFO = 65536 + 32768;
__device__ __forceinline__ unsigned score_key32(float s) { const unsigned u = __float_as_uint(s); return u ^ ((unsigned)((int)u >> 31) | 0x80000000u); }
__device__ __forceinline__ unsigned score_key16(float s) { return score_key32(s) >> 16; }
__device__ __forceinline__ float key32_to_float(unsigned k) { return __uint_as_float((k & 0x80000000u) ? (k ^ 0x80000000u) : ~k); }
__device__ __forceinline__ float relu_f(float x) { const int b_ = __builtin_bit_cast(int, x); return __builtin_bit_cast(float, b_ > 0 ? b_ : 0); }

struct KFrag { bf16x8 a00, a01, a10, a11; };
__device__ __forceinline__ void dsa_kload(KFrag& f, const bf16_t* kix  , int t, int r, int hi) {
    const bf16_t* p = kix + ((size_t)t * 64 + r) * 32 + hi * 8;
    f.a00 = *(const bf16x8*)p; f.a01 = *(const bf16x8*)(p + 16); f.a10 = *(const bf16x8*)(p + 1024); f.a11 = *(const bf16x8*)(p + 1024 + 16);
}
__device__ __forceinline__ void dsa_scores(f32x16& s0, f32x16& s1, const KFrag& f, const bf16x8 (&qi)[4][2], const float (&w)[4]) {
    s0 = (f32x16){}; s1 = (f32x16){};
#pragma unroll
    for (int ih = 0; ih < 4; ++ih) {
        f32x16 a = __builtin_amdgcn_mfma_f32_32x32x16_bf16(f.a00, qi[ih][0], (f32x16){}, 0, 0, 0); a = __builtin_amdgcn_mfma_f32_32x32x16_bf16(f.a01, qi[ih][1], a, 0, 0, 0);
        f32x16 c = __builtin_amdgcn_mfma_f32_32x32x16_bf16(f.a10, qi[ih][0], (f32x16){}, 0, 0, 0); c = __builtin_amdgcn_mfma_f32_32x32x16_bf16(f.a11, qi[ih][1], c, 0, 0, 0);
#pragma unroll
        for (int i = 0; i < 16; ++i) { s0[i] = __builtin_fmaf(w[ih], relu_f(a[i]), s0[i]); s1[i] = __builtin_fmaf(w[ih], relu_f(c[i]), s1[i]); }
    }
}
__device__ __forceinline__ void hist_add(LAS unsigned* hrow, int r, unsigned bin) { atomicAdd((unsigned*)(hrow + ((bin >> 1) ^ (unsigned)r)), 1u << ((bin & 1u) * 16u)); }

__device__ __forceinline__ void dsa_index_unit(LAS unsigned char* lds, const bf16_t* proj, const bf16_t* kidx, const float* side, unsigned long long* maskbits, int b, int qg, int wid0) {
    const int tid = opaque_tid(wid0), lane = tid & 63, wv = __builtin_amdgcn_readfirstlane(tid >> 6), r = lane & 31, hi = lane >> 5;
    const int tq = qg * 32 + r; const size_t rowq = (size_t)b * S + tq;
    const int nt = (qg >> 1) + 1;
    const int per = (nt + 7) >> 3; const int t_lo = wv * per, t_hi = (t_lo + per < nt) ? t_lo + per : nt;
    bf16x8 qi[4][2]; float w[4];
#pragma unroll
    for (int ih = 0; ih < 4; ++ih) { qi[ih][0] = *(const bf16x8*)(proj + rowq * NP + C_IQ + ih * 32 + hi * 8); qi[ih][1] = *(const bf16x8*)(proj + rowq * NP + C_IQ + ih * 32 + 16 + hi * 8);
        w[ih] = side[rowq * 32 + 4 + ih] * 0.5f; }
    LAS unsigned* h1 = (LAS unsigned*)(lds + DSA_H1) + r * 512; LAS unsigned* h2 = (LAS unsigned*)(lds + DSA_H2) + wv * 1024 + r * 32;
    LAS int* info = (LAS int*)(lds + DSA_INFO);
    const bf16_t* kix = kidx + (size_t)b * S * 32;
    const bool sel_all = (qg < 8);
    __syncthreads();
    if (!sel_all) {
        for (int i = tid; i < (DSA_INFO) / 16; i += NTHREADS) ((LAS u32x4*)lds)[i] = (u32x4){0u, 0u, 0u, 0u};
        __syncthreads();
        if (t_lo < t_hi) {
            KFrag cur, nxt; dsa_kload(cur, kix, t_lo, r, hi);
            for (int t = t_lo; t < t_hi; ++t) {
                if (t + 1 < t_hi) dsa_kload(nxt, kix, t + 1, r, hi);
                f32x16 s0, s1; dsa_scores(s0, s1, cur, qi, w);
                const int kv0 = t * 64;
                if (kv0 + 63 <= qg * 32) {
#pragma unroll
                    for (int i = 0; i < 16; ++i) { hist_add(h1, r, score_key32(s0[i]) >> 22); hist_add(h1, r, score_key32(s1[i]) >> 22); }
                } else {
#pragma unroll
                    for (int i = 0; i < 16; ++i) { const int kv = kv0 + crow(i, hi);
                        if (kv <= tq) hist_add(h1, r, score_key32(s0[i]) >> 22);
                        if (kv + 32 <= tq) hist_add(h1, r, score_key32(s1[i]) >> 22); }
                }
                cur = nxt;
            }
        }
        __syncthreads();
        { const int row = tid >> 4, part = tid & 15; const LAS unsigned* hr = (const LAS unsigned*)(lds + DSA_H1) + row * 512; unsigned cs = 0;
#pragma unroll 8
          for (int j = 0; j < 32; ++j) { const unsigned wd = hr[(part * 32 + j) ^ row]; cs += (wd & 0xffffu) + (wd >> 16); }
          unsigned suf = cs;
#pragma unroll
          for (int o = 1; o < 16; o <<= 1) { const unsigned t = __shfl_down(suf, o, 16); if (part + o < 16) suf += t; }
          const unsigned above = suf - cs;
          if (above < 256u && above + cs >= 256u) { unsigned acc = above; int bsel = part * 64; unsigned ab = above;
              for (int j = 31; j >= 0; --j) { const unsigned wd = hr[(part * 32 + j) ^ row]; const unsigned c1 = wd >> 16, c0 = wd & 0xffffu;
                  if (acc + c1 >= 256u) { bsel = part * 64 + 2 * j + 1; ab = acc; break; } acc += c1;
                  if (acc + c0 >= 256u) { bsel = part * 64 + 2 * j; ab = acc; break; } acc += c0; }
              info[row] = bsel; info[32 + row] = 256 - (int)ab; } }
        __syncthreads();
        const unsigned B1 = (unsigned)info[r];
        const float blo = key32_to_float(B1 << 22), bhi = (B1 >= 1023u) ? INFINITY : key32_to_float((B1 + 1u) << 22);
        if (t_lo < t_hi) {
            KFrag cur, nxt; dsa_kload(cur, kix, t_lo, r, hi);
            for (int t = t_lo; t < t_hi; ++t) {
                if (t + 1 < t_hi) dsa_kload(nxt, kix, t + 1, r, hi);
                f32x16 s0, s1; dsa_scores(s0, s1, cur, qi, w);
                const int kv0 = t * 64;
                if (kv0 + 63 <= qg * 32) {
#pragma unroll
                    for (int i = 0; i < 16; ++i) {
                        if (s0[i] >= blo && s0[i] < bhi) hist_add(h2, r, (score_key32(s0[i]) >> 16) & 63u);
                        if (s1[i] >= blo && s1[i] < bhi) hist_add(h2, r, (score_key32(s1[i]) >> 16) & 63u); }
                } else {
#pragma unroll
                    for (int i = 0; i < 16; ++i) { const int kv = kv0 + crow(i, hi);
                        if (kv <= tq && s0[i] >= blo && s0[i] < bhi) hist_add(h2, r, (score_key32(s0[i]) >> 16) & 63u);
                        if (kv + 32 <= tq && s1[i] >= blo && s1[i] < bhi) hist_add(h2, r, (score_key32(s1[i]) >> 16) & 63u); }
                }
                cur = nxt;
            }
        }
        __syncthreads();
        { const int row = tid >> 4, part = tid & 15; unsigned cnt[4]; unsigned cs = 0; const unsigned need1 = (unsigned)info[32 + row];
          LAS unsigned* h2a = (LAS unsigned*)(lds + DSA_H2);
#pragma unroll
          for (int j = 0; j < 2; ++j) { unsigned c0 = 0, c1 = 0; const int wi = row * 32 + ((part * 2 + j) ^ row);
#pragma unroll
              for (int ww = 0; ww < 8; ++ww) { const unsigned wd = h2a[ww * 1024 + wi]; c0 += wd & 0xffffu; c1 += wd >> 16; }
              cnt[2 * j] = c0; cnt[2 * j + 1] = c1; cs += c0 + c1; }
          unsigned suf = cs;
#pragma unroll
          for (int o = 1; o < 16; o <<= 1) { const unsigned t = __shfl_down(suf, o, 16); if (part + o < 16) suf += t; }
          const unsigned above = suf - cs;
          if (above < need1 && above + cs >= need1) { unsigned acc = above; int bsel = 0; unsigned ab = above; bool found = false;
#pragma unroll
              for (int j = 3; j >= 0; --j) { if (!found) { if (acc + cnt[j] >= need1) { bsel = part * 4 + j; ab = acc; found = true; } else acc += cnt[j]; } }
              info[64 + row] = (int)(((unsigned)info[row] << 6) | (unsigned)bsel); info[96 + row] = (int)(need1 - ab);
              const int wi = row * 32 + ((bsel >> 1) ^ row); unsigned run = 0;
#pragma unroll
              for (int ww = 0; ww < 8; ++ww) { info[128 + row * 8 + ww] = (int)run; const unsigned wd = h2a[ww * 1024 + wi]; run += (bsel & 1) ? (wd >> 16) : (wd & 0xffffu); } } }
        __syncthreads();
    }
    const unsigned T = sel_all ? 0u : (unsigned)info[64 + r];
    const unsigned need2 = sel_all ? 0x7fffffffu : (unsigned)info[96 + r];
    unsigned tc = sel_all ? 0u : (unsigned)info[128 + r * 8 + wv];
    const float f_lo = sel_all ? -INFINITY : key32_to_float(T << 16), f_hi = sel_all ? -INFINITY : ((T >= 0xffffu) ? INFINITY : key32_to_float((T + 1u) << 16));
    if (t_lo < t_hi) {
        KFrag cur, nxt; dsa_kload(cur, kix, t_lo, r, hi);
        for (int t = t_lo; t < t_hi; ++t) {
            if (t + 1 < t_hi) dsa_kload(nxt, kix, t + 1, r, hi);
            f32x16 s0, s1; dsa_scores(s0, s1, cur, qi, w);
            const int kv0 = t * 64; unsigned words[2];
#pragma unroll
            for (int half = 0; half < 2; ++half) {
                unsigned gt = 0, eq = 0;
                if (kv0 + 63 <= qg * 32) {
                    unsigned ge = 0;
#pragma unroll
                    for (int i = 15; i >= 0; --i) { const float sv = half ? s1[i] : s0[i];
                        asm("v_cmp_ge_f32 vcc, %1, %2\n\tv_addc_co_u32 %0, vcc, %0, %0, vcc" : "+v"(gt) : "v"(sv), "v"(f_hi) : "vcc");
                        asm("v_cmp_ge_f32 vcc, %1, %2\n\tv_addc_co_u32 %0, vcc, %0, %0, vcc" : "+v"(ge) : "v"(sv), "v"(f_lo) : "vcc"); }
                    eq = ge & ~gt;
                } else {
#pragma unroll
                    for (int i = 0; i < 16; ++i) { const int kv = kv0 + 32 * half + crow(i, hi); const unsigned k = score_key16(half ? s1[i] : s0[i]);
                        const unsigned v = (kv <= tq) ? 1u : 0u; gt |= ((k > T) ? v : 0u) << i; eq |= ((k == T) ? v : 0u) << i; }
                }
                unsigned sel = gt;
                if (__any(eq != 0u)) {
                    const unsigned a0 = __popc(eq & 0xfu), a1 = __popc(eq & 0xf0u), a2 = __popc(eq & 0xf00u), a3 = __popc(eq & 0xf000u);
                    const unsigned own = a0 | (a1 << 8) | (a2 << 16) | (a3 << 24); unsigned oth; { const auto rr_ = __builtin_amdgcn_permlane32_swap(own, own, false, false); oth = rr_[0] + rr_[1] - own; }
                    const unsigned b0 = oth & 255u, b1 = (oth >> 8) & 255u, b2 = (oth >> 16) & 255u, b3 = oth >> 24;
                    unsigned pre[4]; const unsigned hb = hi ? 1u : 0u;
                    pre[0] = tc + hb * b0; pre[1] = tc + a0 + b0 + hb * b1; pre[2] = tc + a0 + b0 + a1 + b1 + hb * b2; pre[3] = tc + a0 + b0 + a1 + b1 + a2 + b2 + hb * b3;
#pragma unroll
                    for (int g = 0; g < 4; ++g) { unsigned rk = pre[g];
#pragma unroll
                        for (int e = 0; e < 4; ++e) { const unsigned bit = 1u << (4 * g + e); if (eq & bit) { if (rk < need2) sel |= bit; ++rk; } } }
                    tc += a0 + a1 + a2 + a3 + b0 + b1 + b2 + b3;
                }
                unsigned wbits = (sel & 0xfu) | ((sel & 0xf0u) << 4) | ((sel & 0xf00u) << 8) | ((sel & 0xf000u) << 12);
                wbits <<= 4 * hi;
                { const auto rr_ = __builtin_amdgcn_permlane32_swap(wbits, wbits, false, false); wbits = rr_[0] | rr_[1]; }
                words[half] = wbits;
            }
            if (hi == 0) maskbits[(size_t)tq * 128 + t] = (unsigned long long)words[0] | ((unsigned long long)words[1] << 32);
            cur = nxt;
        }
    }
}

constexpr int NSA_IMP = ATT_EXTRA;
constexpr int NSA_SEL = NSA_IMP + 32768;
constexpr int NSA_UNI = NSA_SEL + 1024;
constexpr int NSA_LIST = NSA_UNI + 64;
constexpr int NSA_OT = NSA_LIST + 1024;
static_assert(NSA_OT + 65536 <= LDS_BYTES, "NSA LDS map");

__device__ __forceinline__ void nsa_unit(LAS unsigned char* lds, const bf16_t* proj, const float* side, const bf16_t* kc, const bf16_t* vc, bf16_t* ocat, int b, int q64, int wid0, const float* gn  , float* ssq  ) {
    const int tid = opaque_tid(wid0), lane = tid & 63, wv = __builtin_amdgcn_readfirstlane(tid >> 6), r = lane & 31, hi = lane >> 5;
    const int t0 = q64 * 64, q8 = r >> 2, hd = r & 3, tq = t0 + wv * 8 + q8; const size_t rowq = (size_t)b * S + tq;
    const float c2 = 0.125f * LOG2E;
    const float slope = (hd == 0) ? 0.25f : (hd == 1 ? 0.0625f : (hd == 2 ? 0.015625f : 0.00390625f));
    const float A = 8.0f * slope;
    bf16x8 qf[4];
#pragma unroll
    for (int s = 0; s < 4; ++s) qf[s] = *(const bf16x8*)(proj + rowq * NP + C_NQ + hd * 64 + s * 16 + hi * 8);
    const float g0 = sigmoid_f(side[rowq * 32 + 8 + hd * 3 + 0]), g1 = sigmoid_f(side[rowq * 32 + 8 + hd * 3 + 1]), g2 = sigmoid_f(side[rowq * 32 + 8 + hd * 3 + 2]);
    const int vb = ((lane >> 4) & 1) * 32 + (lane & 3) * 8 + (4 * hi + ((lane & 15) >> 2)) * 64;
    LAS float* imp = (LAS float*)(lds + NSA_IMP) + wv * 1024;
    LAS unsigned* selw = (LAS unsigned*)(lds + NSA_SEL) + wv * 32;
    LAS unsigned* uni = (LAS unsigned*)(lds + NSA_UNI);
    LAS int* list = (LAS int*)(lds + NSA_LIST);
    LAS float* otl = (LAS float*)(lds + NSA_OT) + wv * 2048 + lane;
    StageRegs<64> sr;
    __syncthreads();
    for (int i = lane; i < 1024; i += 64) imp[i] = 0.f;
    if (tid < 4) uni[tid] = 0u;
    const bf16_t* kcb = kc + (size_t)b * 512 * 64; const bf16_t* vcb = vc + (size_t)b * 512 * 64;
    const int ntc = (((t0 + 32) >> 4) >> 6) + 1;
    SoftState st; st.m = NEG_BIG; st.l = 0.f; st.o0 = (f32x16){}; st.o1 = (f32x16){};
    for (int pass = 0; pass < 2; ++pass) {
        stage_load<64>(sr, kcb, 64, vcb, 64, nullptr, 0, wid0);
        __syncthreads();
        stage_store<64>(sr, lds, 0, false, wid0);
        if (1 < ntc) stage_load<64>(sr, kcb, 64, vcb, 64, nullptr, 64, wid0);
        __syncthreads();
        float rl = 0.f;
        if (pass == 1) { const float l = st.l + __shfl_xor(st.l, 32); rl = l > 0.f ? 1.0f / l : 0.f; }
        const float mc = st.m * c2;
        for (int t = 0; t < ntc; ++t) {
            const int buf = t & 1;
            f32x16 p0, p1; const int n0 = t * 64;
            { const float base = A * (float)(16 * (n0 + 4 * hi) + 31);
#pragma unroll
              for (int i = 0; i < 16; ++i) { p0[i] = base + A * 16.0f * (float)((i & 3) + 8 * (i >> 2)); p1[i] = p0[i] + A * 512.0f; } }
            qk_tile<4>(p0, p1, lds + ATT_K0 + buf * ATT_KBUF, KSTR64, qf, r, hi);
#pragma unroll
            for (int i = 0; i < 16; ++i) { const int n = n0 + crow(i, hi); if (16 * n + 31 > tq) p0[i] = -INFINITY; if (16 * (n + 32) + 31 > tq) p1[i] = -INFINITY; }
            if (pass == 0) {
                const float mx = tile_max(p0, p1); const float mn = fmaxf(st.m, mx);
                const float al = __builtin_amdgcn_exp2f((st.m - mn) * c2); st.l *= al; st.m = mn; const float mcc = mn * c2; float sum = 0.f;
#pragma unroll
                for (int i = 0; i < 16; ++i) sum += __builtin_amdgcn_exp2f(__builtin_fmaf(p0[i], c2, -mcc)) + __builtin_amdgcn_exp2f(__builtin_fmaf(p1[i], c2, -mcc));
                st.l += sum;
            } else {
#pragma unroll
                for (int i = 0; i < 16; ++i) { p0[i] = __builtin_amdgcn_exp2f(__builtin_fmaf(p0[i], c2, -mc)) * rl; p1[i] = __builtin_amdgcn_exp2f(__builtin_fmaf(p1[i], c2, -mc)) * rl; }
#pragma unroll
                for (int half = 0; half < 2; ++half)
#pragma unroll
                    for (int g = 0; g < 4; ++g) { const f32x16& pp = half ? p1 : p0;
                        float s4 = (pp[4 * g] + pp[4 * g + 1]) + (pp[4 * g + 2] + pp[4 * g + 3]); float s3 = pp[4 * g + 3];
                        s4 += quad_xor1(s4); s4 += quad_xor2(s4); s3 += quad_xor1(s3); s3 += quad_xor2(s3);
                        const int j1 = 16 * t + 8 * half + 2 * g + hi;
                        if (hd == 0) atomicAdd((float*)(imp + q8 * 128 + j1), s4);
                        if (hd == 0 && j1 + 1 < 128) atomicAdd((float*)(imp + q8 * 128 + j1 + 1), s3); }
                pv_tile(st.o0, st.o1, p0, p1, lds + ATT_V0 + buf * ATT_VBUF, vb);
            }
            if (t + 1 < ntc) stage_store<64>(sr, lds, buf ^ 1, false, wid0);
            if (t + 2 < ntc) stage_load<64>(sr, kcb, 64, vcb, 64, nullptr, (t + 2) * 64, wid0);
            __syncthreads();
        }
    }
#pragma unroll
    for (int i = 0; i < 16; ++i) { otl[i * 64] = st.o0[i] * g0; otl[(16 + i) * 64] = st.o1[i] * g0; }
    {
        const int cur = q64;
        for (int qq = 0; qq < 8; ++qq) {
            float v0 = imp[qq * 128 + lane], v1 = imp[qq * 128 + 64 + lane];
            bool ok0 = true, ok1 = true;
            { const int j0 = lane, j1 = lane + 64;
              if (j0 == 0 || j0 == cur) v0 = INFINITY; else if (j0 > cur) ok0 = false;
              if (j1 == cur) v1 = INFINITY; else if (j1 > cur) ok1 = false; }
            const unsigned k0 = __float_as_uint(v0), k1 = __float_as_uint(v1);
            unsigned T = 0u;
            for (int bit = 30; bit >= 0; --bit) { const unsigned cand = T | (1u << bit);
                const int cnt = __popcll(__ballot(ok0 && k0 >= cand)) + __popcll(__ballot(ok1 && k1 >= cand));
                if (cnt >= 16) T = cand; }
            const unsigned long long gt0 = __ballot(ok0 && k0 > T), gt1 = __ballot(ok1 && k1 > T), eq0 = __ballot(ok0 && k0 == T), eq1 = __ballot(ok1 && k1 == T);
            const int need = 16 - (__popcll(gt0) + __popcll(gt1));
            const int r0 = (int)__builtin_amdgcn_mbcnt_hi((unsigned)(eq0 >> 32), __builtin_amdgcn_mbcnt_lo((unsigned)eq0, 0u));
            const int r1 = __popcll(eq0) + (int)__builtin_amdgcn_mbcnt_hi((unsigned)(eq1 >> 32), __builtin_amdgcn_mbcnt_lo((unsigned)eq1, 0u));
            const unsigned long long slo = __ballot(ok0 && (k0 > T || (k0 == T && r0 < need))), shi = __ballot(ok1 && (k1 > T || (k1 == T && r1 < need)));
            if (lane == 0) { selw[qq * 4 + 0] = (unsigned)slo; selw[qq * 4 + 1] = (unsigned)(slo >> 32); selw[qq * 4 + 2] = (unsigned)shi; selw[qq * 4 + 3] = (unsigned)(shi >> 32);
                atomicOr((unsigned*)(uni + 0), (unsigned)slo); atomicOr((unsigned*)(uni + 1), (unsigned)(slo >> 32)); atomicOr((unsigned*)(uni + 2), (unsigned)shi); atomicOr((unsigned*)(uni + 3), (unsigned)(shi >> 32)); }
        }
    }
    __syncthreads();
    if (tid == 0) { int n = 0; for (int wd = 0; wd < 4; ++wd) { unsigned u = uni[wd]; while (u) { const int j = __ffs(u) - 1; u &= u - 1; list[n++] = wd * 32 + j; } } list[131] = n; }
    __syncthreads();
    {
        const unsigned m0 = selw[q8 * 4 + 0], m1 = selw[q8 * 4 + 1], m2 = selw[q8 * 4 + 2], m3 = selw[q8 * 4 + 3];
        const int nl = list[131];
        const bf16_t* Ks = proj + (size_t)b * S * NP + C_KSEL; const bf16_t* Vs = proj + (size_t)b * S * NP + C_VSEL;
        st.m = NEG_BIG; st.l = 0.f; st.o0 = (f32x16){}; st.o1 = (f32x16){};
        stage_load<64>(sr, Ks, NP, Vs, NP, nullptr, list[0] * 64, wid0);
        stage_store<64>(sr, lds, 0, false, wid0);
        if (1 < nl) stage_load<64>(sr, Ks, NP, Vs, NP, nullptr, list[1] * 64, wid0);
        __syncthreads();
        for (int t = 0; t < nl; ++t) {
            const int buf = t & 1; const int j = list[t];
            const unsigned mw = (j < 32) ? m0 : (j < 64 ? m1 : (j < 96 ? m2 : m3));
            const bool mine = (mw >> (j & 31)) & 1u;
            if (__any(mine)) {
                f32x16 p0, p1; const int kv0 = j * 64;
                { const float base = A * (float)(kv0 + 4 * hi);
#pragma unroll
                  for (int i = 0; i < 16; ++i) { p0[i] = base + A * (float)((i & 3) + 8 * (i >> 2)); p1[i] = p0[i] + A * 32.0f; } }
                qk_tile<4>(p0, p1, lds + ATT_K0 + buf * ATT_KBUF, KSTR64, qf, r, hi);
#pragma unroll
                for (int i = 0; i < 16; ++i) { const int kv = kv0 + crow(i, hi); if (!mine || (j == q64 && kv > tq)) p0[i] = -INFINITY; if (!mine || (j == q64 && kv + 32 > tq)) p1[i] = -INFINITY; }
                { bf16x8 f0, f1, f2, f3; softmax_pack(st, p0, p1, c2, f0, f1, f2, f3); pv_frag(st.o0, st.o1, f0, f1, f2, f3, lds + ATT_V0 + buf * ATT_VBUF, vb); }
            }
            if (t + 1 < nl) stage_store<64>(sr, lds, buf ^ 1, false, wid0);
            if (t + 2 < nl) stage_load<64>(sr, Ks, NP, Vs, NP, nullptr, list[t + 2] * 64, wid0);
            __syncthreads();
        }
        const float l = swap32_sum(st.l); const float sc = l > 0.f ? g1 / l : 0.f;
#pragma unroll
        for (int i = 0; i < 16; ++i) { otl[i * 64] += st.o0[i] * sc; otl[(16 + i) * 64] += st.o1[i] * sc; }
    }
    {
        const bf16_t* Kw = proj + (size_t)b * S * NP + C_KWIN; const bf16_t* Vw = proj + (size_t)b * S * NP + C_VWIN;
        const int tw0 = (q64 >= 8) ? q64 - 8 : 0, ntw = q64 - tw0 + 1;
        st.m = NEG_BIG; st.l = 0.f; st.o0 = (f32x16){}; st.o1 = (f32x16){};
        stage_load<64>(sr, Kw, NP, Vw, NP, nullptr, tw0 * 64, wid0);
        stage_store<64>(sr, lds, 0, false, wid0);
        if (1 < ntw) stage_load<64>(sr, Kw, NP, Vw, NP, nullptr, tw0 * 64 + 64, wid0);
        __syncthreads();
        for (int t = 0; t < ntw; ++t) {
            const int buf = t & 1; const int kv0 = (tw0 + t) * 64;
            f32x16 p0, p1;
            { const float base = A * (float)(kv0 + 4 * hi);
#pragma unroll
              for (int i = 0; i < 16; ++i) { p0[i] = base + A * (float)((i & 3) + 8 * (i >> 2)); p1[i] = p0[i] + A * 32.0f; } }
            qk_tile<4>(p0, p1, lds + ATT_K0 + buf * ATT_KBUF, KSTR64, qf, r, hi);
            if (t == 0 || t == ntw - 1) {
#pragma unroll
                for (int i = 0; i < 16; ++i) { const int kv = kv0 + crow(i, hi); if (kv > tq || kv + 512 <= tq) p0[i] = -INFINITY; if (kv + 32 > tq || kv + 32 + 512 <= tq) p1[i] = -INFINITY; } }
            { bf16x8 f0, f1, f2, f3; softmax_pack(st, p0, p1, c2, f0, f1, f2, f3); pv_frag(st.o0, st.o1, f0, f1, f2, f3, lds + ATT_V0 + buf * ATT_VBUF, vb); }
            if (t + 1 < ntw) stage_store<64>(sr, lds, buf ^ 1, false, wid0);
            if (t + 2 < ntw) stage_load<64>(sr, Kw, NP, Vw, NP, nullptr, kv0 + 128, wid0);
            __syncthreads();
        }
        const float l = swap32_sum(st.l); const float sc = l > 0.f ? g2 / l : 0.f;
#pragma unroll
        for (int i = 0; i < 16; ++i) { st.o0[i] = otl[i * 64] + st.o0[i] * sc; st.o1[i] = otl[(16 + i) * 64] + st.o1[i] * sc; }
    }
    { const float sq = swap32_sum(store_out_fused(ocat + rowq * D + 768 + hd * 64, proj + rowq * NP + C_GZ + 768 + hd * 64, gn + 768 + hd * 64, st.o0, st.o1, 1.0f, hi));
      if (hi == 0) ssq[rowq * 16 + 12 + hd] = sq; }
}

__device__ __forceinline__ void phase_onorm(const bf16_t* ocat, const bf16_t* proj, const float* og, bf16_t* oa, int bid, int G, int wid0) {
    const int tid_ = opaque_tid(wid0); const int lane = tid_ & 63, wv = tid_ >> 6;
    for (int row = bid * 8 + wv; row < M; row += G * 8) {
        const int c = lane * 16;
        const u32x4 a0 = *(const u32x4*)(ocat + (size_t)row * D + c), a1 = *(const u32x4*)(ocat + (size_t)row * D + c + 8);
        const u32x4 z0 = *(const u32x4*)(proj + (size_t)row * NP + C_GZ + c), z1 = *(const u32x4*)(proj + (size_t)row * NP + C_GZ + c + 8);
        float v[16], z[16]; float s = 0.f;
#pragma unroll
        for (int e = 0; e < 4; ++e) { v[2 * e] = bflo(a0[e]); v[2 * e + 1] = bfhi(a0[e]); v[8 + 2 * e] = bflo(a1[e]); v[8 + 2 * e + 1] = bfhi(a1[e]);
            z[2 * e] = bflo(z0[e]); z[2 * e + 1] = bfhi(z0[e]); z[8 + 2 * e] = bflo(z1[e]); z[8 + 2 * e + 1] = bfhi(z1[e]); }
#pragma unroll
        for (int e = 0; e < 16; ++e) s += v[e] * v[e];
        s += __builtin_bit_cast(float, __builtin_amdgcn_update_dpp(0, __builtin_bit_cast(int, s), 0xB1, 0xf, 0xf, false));
        s += __builtin_bit_cast(float, __builtin_amdgcn_update_dpp(0, __builtin_bit_cast(int, s), 0x4E, 0xf, 0xf, false));
        s += __builtin_bit_cast(float, __builtin_amdgcn_update_dpp(0, __builtin_bit_cast(int, s), 0x141, 0xf, 0xf, false));
        s += __builtin_bit_cast(float, __builtin_amdgcn_update_dpp(0, __builtin_bit_cast(int, s), 0x140, 0xf, 0xf, false));
        const float rstd = 1.0f / sqrtf(s * (1.f / 256.f) + EPS);
        float y[16];
#pragma unroll
        for (int e = 0; e < 16; ++e) y[e] = v[e] * rstd * og[c + e] * silu_f(z[e]);
        u32x4 w0, w1;
#pragma unroll
        for (int e = 0; e < 4; ++e) { w0[e] = pk2(y[2 * e], y[2 * e + 1]); w1[e] = pk2(y[8 + 2 * e], y[8 + 2 * e + 1]); }
        *(u32x4*)(oa + (size_t)row * D + c) = w0; *(u32x4*)(oa + (size_t)row * D + c + 8) = w1;
    }
}
__device__ __forceinline__ void phase_final(float* out, const float* g, int bid, int G, int wid0) {
    const int tid_ = opaque_tid(wid0); const int lane = tid_ & 63, wv = tid_ >> 6;
    for (int row = bid * 8 + wv; row < M; row += G * 8) {
        f32x4* xr = (f32x4*)(out + (size_t)row * D) + lane;
        f32x4 v[4]; float s = 0.f;
#pragma unroll
        for (int j = 0; j < 4; ++j) { v[j] = xr[64 * j]; s += (v[j][0] * v[j][0] + v[j][1] * v[j][1]) + (v[j][2] * v[j][2] + v[j][3] * v[j][3]); }
        const float rstd = 1.0f / sqrtf(wave_sum(s) * (1.f / D) + EPS);
#pragma unroll
        for (int j = 0; j < 4; ++j) { const f32x4 gg = *(const f32x4*)(g + (64 * j + lane) * 4); xr[64 * j] = v[j] * rstd * gg; }
    }
}

#define XB_TMO      128
#define XB_XCNT(j)  (256  + 64 * (j))
#define XB_XSUB(j)  (1280 + 64 * (j))
#define XB_XGEN(j)  (2304 + 64 * (j))
#define XB_TOP      3328
#define XB_TOPGEN   3392
#define XCD_BAR_WORDS 3456
#define XB_SPIN_CAP (1u << 22)
__device__ __forceinline__ unsigned xb_ld(unsigned* p)              { return __hip_atomic_load(p, __ATOMIC_RELAXED, __HIP_MEMORY_SCOPE_AGENT); }
__device__ __forceinline__ unsigned xb_add(unsigned* p, unsigned v) { return __hip_atomic_fetch_add(p, v, __ATOMIC_RELAXED, __HIP_MEMORY_SCOPE_AGENT); }
__device__ __forceinline__ unsigned xb_xcc_id() { return (unsigned)__builtin_amdgcn_s_getreg((3 << 11) | 20) & 0xFu; }
#define XB_SPIN(cond, bar) do { unsigned _sp = 0; while (cond) { __builtin_amdgcn_s_sleep(1); \
    if ((++_sp & 255u) == 0u) { if (xb_ld(&(bar)[XB_TMO])) break; if (_sp > XB_SPIN_CAP) { atomicAdd(&(bar)[XB_TMO], 1u); break; } } } } while (0)
__device__ __forceinline__ void xcd_barrier_complete(unsigned* bar, unsigned x, unsigned G, unsigned& nloc, unsigned& nx) {
    unsigned sum, cnt, mine, sp = 0u;
    for (;;) {
        sum = 0u; cnt = 0u; mine = 0u;
#pragma unroll
        for (unsigned j = 0; j < 16; ++j) { const unsigned c = xb_ld(&bar[XB_XCNT(j)]); sum += c; cnt += (c > 0u) ? 1u : 0u; mine = (j == x) ? c : mine; }
        if (sum == G) break;
        __builtin_amdgcn_s_sleep(1);
        if ((++sp & 255u) == 0u) { if (xb_ld(&bar[XB_TMO])) break; if (sp > XB_SPIN_CAP) { atomicAdd(&bar[XB_TMO], 1u); break; } }
    }
    nloc = mine > 0u ? mine : 1u; nx = cnt > 0u ? cnt : 1u;
}
__device__ __forceinline__ void grid_bar(unsigned* bar, volatile LAS unsigned* st, unsigned G, int wid0) {
    const int tid = opaque_tid(wid0);
    asm volatile("s_waitcnt vmcnt(0)" ::: "memory");
    __syncthreads();
    if (tid == 0) {
        const unsigned x = xb_xcc_id();
        unsigned nloc = st[0], nx = st[1];
        if (nloc == 0u) { xcd_barrier_complete(bar, x, G, nloc, nx); st[0] = nloc; st[1] = nx; }
        const unsigned old = xb_add(&bar[XB_XSUB(x)], 1u);
        const unsigned gen = old / nloc;
        if (old + 1u == (gen + 1u) * nloc) {
            __builtin_amdgcn_fence(__ATOMIC_RELEASE, "agent");
            asm volatile("s_waitcnt vmcnt(0)" ::: "memory");
            const unsigned og = xb_add(&bar[XB_TOP], 1u);
            const unsigned tg = og / nx;
            if (og + 1u == (tg + 1u) * nx) xb_add(&bar[XB_TOPGEN], 1u);
            else XB_SPIN(xb_ld(&bar[XB_TOPGEN]) == tg, bar);
            __builtin_amdgcn_fence(__ATOMIC_ACQUIRE, "agent");
            xb_add(&bar[XB_XGEN(x)], 1u);
            asm volatile("s_waitcnt vmcnt(0)" ::: "memory");
        } else {
            XB_SPIN(xb_ld(&bar[XB_XGEN(x)]) == gen, bar);
            __builtin_amdgcn_fence(__ATOMIC_ACQUIRE, "agent");
            asm volatile("s_waitcnt vmcnt(0)" ::: "memory");
        }
    }
    __syncthreads();
}

constexpr int N_PHASES = 16;
__global__ void __launch_bounds__(NTHREADS) hymba_fwd(Params P) {
    extern __shared__ __attribute__((aligned(16))) unsigned char lds_raw[];
    LAS unsigned char* lds = (LAS unsigned char*)lds_raw;
    const int bid = blockIdx.x, G = gridDim.x;
    const int wid0 = __builtin_amdgcn_readfirstlane((int)(threadIdx.x >> 6));
    volatile LAS unsigned* xst = (volatile LAS unsigned*)(lds + LDS_BYTES - 16);
    unsigned* xbar = (unsigned*)(P.ws + WS_CTL) + 4096 + P.bar_region * XCD_BAR_WORDS;
    if (threadIdx.x == 0) { xst[0] = 0u; xst[1] = 0u; (void)xb_add(&xbar[XB_XCNT(xb_xcc_id())], 1u); }
    __syncthreads();
    unsigned char* ws = P.ws;
    bf16_t* proj = (bf16_t*)(ws + WS_PROJ); float* side = (float*)(ws + WS_SIDE);
    bf16_t* hbuf = (bf16_t*)(ws + WS_H); bf16_t* ocat = (bf16_t*)(ws + WS_OCAT);
#define PH(k) (P.ph_lo <= (k) && (k) < P.ph_hi)
#define SYNC(k) do { if (PH(k) && PH((k) + 1)) grid_bar(xbar, xst, (unsigned)G, wid0); } while (0)
    if (PH(0)) phase_prologue(P, lds, bid, G, wid0);
    if (PH(0) && PH(1)) cg::this_grid().sync();
#ifndef ATT_REP
#define ATT_REP 0
#endif
#ifndef PROBE_VAR
#define PROBE_VAR -1
#endif
#define LAYER(l, base) do { \
    const float* mod = (const float*)(ws + WS_MOD) + (size_t)(l) * 4 * 3072; \
    const float* xin = ((l) == 0) ? P.in[0] : P.out; \
    if (PH((base) + 0)) phase_hnorm(xin, P.in[2] + (l) * D, mod, hbuf, bid, G, wid0); \
    SYNC((base) + 0); \
    if (PH((base) + 1)) { pg8::Gemm g{hbuf, (const bf16_t*)(ws + WS_WIN) + (size_t)(l) * NP * D, M, NP, D, D, D}; pg8::StaticOrder so; so.init(M, NP, G, bid); \
        pg8::EpiProj E{proj, side}; pg8::gemm_phase<pg8::EpiProj, true>(lds, g, so, E, wid0); } \
    SYNC((base) + 1); \
    if (PH((base) + 2)) phase_prep(P, (l), lds, bid, G, wid0); \
    SYNC((base) + 2); \
    if (PH((base) + 3)) { \
        { pg8::Gemm g{proj + C_QLAT, (const bf16_t*)(ws + WS_WUQ) + (size_t)(l) * 512 * 256, M, 512, 256, NP, 256}; pg8::StaticOrder so; so.init(M, 512, G, bid); \
          pg8::EpiQup E{(bf16_t*)(ws + WS_QMLA), (const float*)(ws + WS_RSTD), (const float*)(ws + WS_ROPE)}; pg8::gemm_phase<pg8::EpiQup, true>(lds, g, so, E, wid0); } \
        { pg8::Gemm g{proj + C_KVLAT, (const bf16_t*)(ws + WS_WUKV) + (size_t)(l) * 512 * 128, M, 512, 128, NP, 128}; pg8::StaticOrder so; so.init(M, 512, G, bid); \
          pg8::EpiKVup E{(bf16_t*)(ws + WS_KMLA), (bf16_t*)(ws + WS_VMLA), (const float*)(ws + WS_RSTD)}; pg8::gemm_phase<pg8::EpiKVup, true>(lds, g, so, E, wid0); } \
        for (int k = 0; k * G < 1024; ++k) { const int u = (k & 1) ? (k + 1) * G - 1 - bid : k * G + bid; if (u >= 1024 || u < 0) continue; const int qg = 255 - (u >> 2), b = u & 3; \
            dsa_index_unit(lds, proj, (const bf16_t*)(ws + WS_KIDX), side, (unsigned long long*)(ws + WS_MASK) + (size_t)b * S * 128, b, qg, wid0); } } \
    SYNC((base) + 3); \
    if (PH((base) + 4)) { const int vb_ = (G % 8 == 0) ? (bid & 7) * (G >> 3) + (bid >> 3) : bid;     \
        if (G == 256) {   \
          const int tw_ = opaque_tid(wid0); const int b_ = (bid & 7) >> 1; \
          if (tw_ < 128) { const int pg_ = (bid >> 3) * 128 + tw_;     \
              const unsigned char* a_ = (pg_ < 1536) ? ws + WS_QMLA + (size_t)b_ * S * 768 + (size_t)pg_ * 4096 : (pg_ < 3072) ? ws + WS_KMLA + (size_t)b_ * S * 768 + (size_t)(pg_ - 1536) * 4096 \
                                                      : ws + WS_VMLA + (size_t)b_ * S * 512 + (size_t)(pg_ - 3072) * 4096; \
              const unsigned v_ = *(const volatile unsigned*)a_; if (v_ == 0x12345677u) *(volatile unsigned*)(ws + WS_CTL + 8192 + 512) = v_; } } \
        for (int i = vb_; i < 512; i += G) { const int ii = i & 255, bh = ii >> 4, qb = (i < 256) ? (ii & 15) : 31 - (ii & 15), b = bh >> 2, hd = bh & 3; const size_t rb = (size_t)b * S; \
            attn64_unit<0, 96>(lds, (const bf16_t*)(ws + WS_QMLA) + rb * 384 + hd * 96, 384, (const bf16_t*)(ws + WS_KMLA) + rb * 384 + hd * 96, 384, \
                              (const bf16_t*)(ws + WS_VMLA) + rb * 256 + hd * 64, 256, ocat + rb * D + hd * 64, nullptr, nullptr, 0.f, 0.10206207261596577f * LOG2E, qb, wid0, proj + rb * NP + C_GZ + hd * 64, P.in[14] + (l) * D + hd * 64, (float*)(ws + WS_SSQ) + rb * 16 + hd); } \
        for (int rep = 0; rep < (((ATT_REP & 2) && (l) == 0) ? 2 : 1); ++rep) for (int i = vb_; i < 512; i += G) { const int ii = i & 255, bh = ii >> 4, qb = (i < 256) ? (ii & 15) : 31 - (ii & 15), b = bh >> 2, hd = bh & 3; const size_t rb = (size_t)b * S; \
            attn64_unit<1, 64>(lds, proj + rb * NP + C_FQ + hd * 64, NP, proj + rb * NP + C_FK + hd * 64, NP, proj + rb * NP + C_FV + hd * 64, NP, \
                              ocat + rb * D + 256 + hd * 64, (const float*)(ws + WS_FB) + (size_t)bh * S, nullptr, 0.f, 0.125f * LOG2E, qb, wid0, proj + rb * NP + C_GZ + 256 + hd * 64, P.in[14] + (l) * D + 256 + hd * 64, (float*)(ws + WS_SSQ) + rb * 16 + 4 + hd); } \
        for (int rep = 0; rep < (((ATT_REP & 4) && (l) == 0) ? 2 : 1); ++rep) for (int i = vb_; i < 512; i += G) { const int ii = i & 255, bh = ii >> 4, qb = (i < 256) ? (ii & 15) : 31 - (ii & 15), b = bh >> 2, hd = bh & 3; const size_t rb = (size_t)b * S; \
            const float slope = (hd == 0) ? 0.25f : (hd == 1 ? 0.0625f : (hd == 2 ? 0.015625f : 0.00390625f)); \
            attn64_unit<2, 64>(lds, proj + rb * NP + C_DQ + hd * 64, NP, proj + rb * NP + C_DK + hd * 64, NP, proj + rb * NP + C_DV + hd * 64, NP, \
                              ocat + rb * D + 512 + hd * 64, nullptr, (const unsigned long long*)(ws + WS_MASK) + rb * 128, 8.0f * slope, 0.125f * LOG2E, qb, wid0, proj + rb * NP + C_GZ + 512 + hd * 64, P.in[14] + (l) * D + 512 + hd * 64, (float*)(ws + WS_SSQ) + rb * 16 + 8 + hd); } \
        for (int rep = 0; rep < (((ATT_REP & 8) && (l) == 0) ? 2 : 1); ++rep) for (int u = vb_; u < 512; u += G) { const int b = u >> 7, q64 = u & 127; \
            nsa_unit(lds, proj, side, (const bf16_t*)(ws + WS_KC), (const bf16_t*)(ws + WS_VC), ocat, b, q64, wid0, P.in[14] + (l) * D, (float*)(ws + WS_SSQ)); } } \
    SYNC((base) + 4); \
      \
    if (PH((base) + 6)) { pg8::Gemm g{ocat, (const bf16_t*)(ws + WS_WOUT) + (size_t)(l) * D * D, M, D, D, D, D}; pg8::StaticOrder so; so.init(M, D, G, bid); \
        pg8::EpiOut E{xin, P.out, mod + 2048, (const float*)(ws + WS_SSQ)}; pg8::gemm_phase<pg8::EpiOut, true>(lds, g, so, E, wid0); } \
    SYNC((base) + 6); \
} while (0)
    LAYER(0, 1);
    LAYER(1, 8);
    if (PH(15)) phase_final(P.out, P.in[16], bid, G, wid0);
#undef LAYER
#undef PH
#undef SYNC
}


#ifdef DBG_GROUP
#ifndef DBG_LAYER
#define DBG_LAYER 1
#endif
__device__ __forceinline__ float dbg_bf(const bf16_t* p) { return bf2f(*p); }
__device__ const int dbg_rows[48] = {0, 1, 2, 15, 30, 31, 32, 47, 63, 64, 65, 127, 128, 200, 255, 256, 257, 300, 511, 512, 513, 700, 1000, 1023, 1024, 1025, 1500, 2047, 2048, 3000, 3333, 4095, 4096, 4500, 5000, 5555, 6143, 6144, 7000, 7777, 8000, 8100, 8127, 8128, 8160, 8190, 8191, 4242};
template <class ScoreFn, class VFn>
__device__ __forceinline__ float dbg_attn(int k_lo, int k_hi, ScoreFn score, VFn vload, int lane) {
    float m = -INFINITY, l = 0.f, acc = 0.f;
    for (int kv = k_lo; kv <= k_hi; ++kv) {
        const float sc = score(kv);
        if (sc == -INFINITY) continue;
        const float mn = fmaxf(m, sc); const float al = (m == -INFINITY) ? 0.f : __expf(m - mn); const float p = __expf(sc - mn);
        l = l * al + p; acc = acc * al + p * vload(kv, lane); m = mn;
    }
    return l > 0.f ? acc / l : 0.f;
}
__global__ void __launch_bounds__(64) dbg_check(Params P) {
    const int lane = threadIdx.x, wid = blockIdx.x; const int hd = wid & 3, ri = (wid >> 2) % 48, b = (wid >> 2) / 48; const int t = dbg_rows[ri];
    unsigned char* ws = P.ws; const bf16_t* proj = (const bf16_t*)(ws + WS_PROJ); const float* side = (const float*)(ws + WS_SIDE);
    const bf16_t* ocat = (const bf16_t*)(ws + WS_OCAT); const size_t rowq = (size_t)b * S + t; const size_t rb = (size_t)b * S;
    float* scratch = (float*)(ws + WS_H) + (size_t)wid * 16384;
    float ref = 0.f; int grp = DBG_GROUP % 10;
    const float slope = (hd == 0) ? 0.25f : (hd == 1 ? 0.0625f : (hd == 2 ? 0.015625f : 0.00390625f));
    if (grp == 0) {
        const bf16_t* q = (const bf16_t*)(ws + WS_QMLA) + rowq * 384 + hd * 96; const bf16_t* K = (const bf16_t*)(ws + WS_KMLA) + rb * 384 + hd * 96; const bf16_t* V = (const bf16_t*)(ws + WS_VMLA) + rb * 256 + hd * 64;
        const float q0 = dbg_bf(q + lane), q1 = lane < 32 ? dbg_bf(q + 64 + lane) : 0.f;
        ref = dbg_attn(0, t, [&](int kv) { float pr = q0 * dbg_bf(K + (size_t)kv * 384 + lane) + (lane < 32 ? q1 * dbg_bf(K + (size_t)kv * 384 + 64 + lane) : 0.f); return wave_sum(pr) * 0.10206207261596577f; },
                       [&](int kv, int d) { return dbg_bf(V + (size_t)kv * 256 + d); }, lane);
    } else if (grp == 1) {
        const bf16_t* q = proj + rowq * NP + C_FQ + hd * 64; const bf16_t* K = proj + rb * NP + C_FK + hd * 64; const bf16_t* V = proj + rb * NP + C_FV + hd * 64; const float* fb = (const float*)(ws + WS_FB) + (size_t)(b * 4 + hd) * S;
        const float q0 = dbg_bf(q + lane); const float ft = fb[t];
        ref = dbg_attn(0, t, [&](int kv) { return wave_sum(q0 * dbg_bf(K + (size_t)kv * NP + lane)) * 0.125f + (fb[kv] - ft) * 0.125f; },
                       [&](int kv, int d) { return dbg_bf(V + (size_t)kv * NP + d); }, lane);
    } else if (grp == 2) {
        float* sc = scratch; unsigned char* selb = (unsigned char*)(scratch + 8192);
        const int ih = lane >> 4, dd = (lane & 15) * 2;
        const float qa = dbg_bf(proj + rowq * NP + C_IQ + ih * 32 + dd), qb2 = dbg_bf(proj + rowq * NP + C_IQ + ih * 32 + dd + 1); const float wgt = side[rowq * 32 + 4 + ih] * 0.5f;
        for (int kv = 0; kv <= t; ++kv) { float pr = qa * dbg_bf(proj + (rb + kv) * NP + C_IK + dd) + qb2 * dbg_bf(proj + (rb + kv) * NP + C_IK + dd + 1);
            pr += __shfl_xor(pr, 1); pr += __shfl_xor(pr, 2); pr += __shfl_xor(pr, 4); pr += __shfl_xor(pr, 8);
            float v = wgt * fmaxf(pr, 0.f); v += __shfl_xor(v, 16); v += __shfl_xor(v, 32); if (lane == 0) sc[kv] = v; }
        __threadfence_block();
        if (t + 1 <= 256) { for (int kv = lane; kv <= t; kv += 64) selb[kv] = 1; }
        else {
#ifdef DBG_KEY32
#define DBGKEY(x) ({ const unsigned u_ = __float_as_uint(x); (u_ & 0x80000000u) ? ~u_ : (u_ | 0x80000000u); })
            unsigned lo = 0, hi2 = 0xffffffffu;
#else
#define DBGKEY(x) score_key16(x)
            unsigned lo = 0, hi2 = 0xffffu;
#endif
            while (lo < hi2) { const unsigned mid = lo + ((hi2 - lo) >> 1) + ((hi2 - lo) & 1u); int c = 0; for (int kv = lane; kv <= t; kv += 64) c += (DBGKEY(sc[kv]) >= mid); c = (int)wave_sum((float)c); if (c >= 256) lo = mid; else hi2 = mid - 1; }
            const unsigned T = lo; int cgt = 0; for (int kv = lane; kv <= t; kv += 64) cgt += (DBGKEY(sc[kv]) > T); cgt = (int)wave_sum((float)cgt);
            int need = 256 - cgt; int run = 0;
            for (int k0 = 0; k0 <= t; k0 += 64) { const int kv = k0 + lane; const unsigned k = kv <= t ? DBGKEY(sc[kv]) : 0u; const bool eq = kv <= t && k == T, gt = kv <= t && k > T;
                const unsigned long long bm = __ballot(eq); const int before = __popcll(bm & ((1ull << lane) - 1ull));
                if (kv <= t) selb[kv] = (gt || (eq && run + before < need)) ? 1 : 0; run += __popcll(bm); }
        }
        __threadfence_block();
        const bf16_t* q = proj + rowq * NP + C_DQ + hd * 64; const bf16_t* K = proj + rb * NP + C_DK + hd * 64; const bf16_t* V = proj + rb * NP + C_DV + hd * 64; const float q0 = dbg_bf(q + lane);
        ref = dbg_attn(0, t, [&](int kv) { if (!selb[kv]) return -INFINITY; return wave_sum(q0 * dbg_bf(K + (size_t)kv * NP + lane)) * 0.125f - slope * (float)(t - kv); },
                       [&](int kv, int d) { return dbg_bf(V + (size_t)kv * NP + d); }, lane);
    } else {
        const int sub = DBG_GROUP / 10;
        const bf16_t* q = proj + rowq * NP + C_NQ; const float q0 = dbg_bf(q + hd * 64 + lane);
        const bf16_t* kc = (const bf16_t*)(ws + WS_KC) + (size_t)b * 512 * 64; const bf16_t* vc = (const bf16_t*)(ws + WS_VC) + (size_t)b * 512 * 64;
        float* pc = scratch;
        for (int h2 = 0; h2 < 4; ++h2) { const float qh = dbg_bf(q + h2 * 64 + lane); const float sl = (h2 == 0) ? 0.25f : (h2 == 1 ? 0.0625f : (h2 == 2 ? 0.015625f : 0.00390625f));
            float m = -INFINITY; for (int n = 0; n < 511; ++n) { if (16 * n + 31 > t) break; const float s_ = wave_sum(qh * dbg_bf(kc + n * 64 + lane)) * 0.125f - sl * (float)(t - (16 * n + 31)); if (lane == 0) pc[h2 * 512 + n] = s_; m = fmaxf(m, s_); }
            __threadfence_block(); float l = 0.f; for (int n = 0; n < 511 && 16 * n + 31 <= t; ++n) l += __expf(pc[h2 * 512 + n] - m);
            __threadfence_block(); for (int n = lane; n < 511; n += 64) pc[h2 * 512 + n] = (16 * n + 31 <= t) ? __expf(pc[h2 * 512 + n] - m) / l : 0.f; __threadfence_block(); }
        float oc = 0.f; for (int n = 0; n < 511 && 16 * n + 31 <= t; ++n) oc += pc[hd * 512 + n] * dbg_bf(vc + n * 64 + lane);
        const int cur = t >> 6; float v0, v1;
        { float i0 = 0.f, i1 = 0.f; for (int h2 = 0; h2 < 4; ++h2) for (int e = -1; e <= 3; ++e) { int n0 = 4 * lane + e, n1 = 4 * (lane + 64) + e; if (n0 >= 0 && n0 < 511) i0 += pc[h2 * 512 + n0]; if (n1 < 511) i1 += pc[h2 * 512 + n1]; }
          v0 = (lane == 0 || lane == cur) ? INFINITY : (lane > cur ? -INFINITY : i0); v1 = (lane + 64 == cur) ? INFINITY : (lane + 64 > cur ? -INFINITY : i1); }
        unsigned long long slo = 0, shi = 0;
        for (int it = 0; it < 16; ++it) { float mx = fmaxf(v0, v1); for (int o = 1; o < 64; o <<= 1) mx = fmaxf(mx, __shfl_xor(mx, o)); if (!(mx > -INFINITY)) break;
            const unsigned long long b0 = __ballot(v0 == mx), b1 = __ballot(v1 == mx);
            if (b0) { const int j = __ffsll((long long)b0) - 1; slo |= 1ull << j; if (lane == j) v0 = -INFINITY; } else { const int j = __ffsll((long long)b1) - 1; shi |= 1ull << j; if (lane == j) v1 = -INFINITY; } }
        const bf16_t* Ks = proj + rb * NP + C_KSEL; const bf16_t* Vs = proj + rb * NP + C_VSEL; const bf16_t* Kw = proj + rb * NP + C_KWIN; const bf16_t* Vw = proj + rb * NP + C_VWIN;
        const float os = dbg_attn(0, t, [&](int kv) { const int j = kv >> 6; const bool in = j < 64 ? ((slo >> j) & 1ull) : ((shi >> (j - 64)) & 1ull); if (!in) return -INFINITY;
                                      return wave_sum(q0 * dbg_bf(Ks + (size_t)kv * NP + lane)) * 0.125f - slope * (float)(t - kv); }, [&](int kv, int d) { return dbg_bf(Vs + (size_t)kv * NP + d); }, lane);
        const float ow = dbg_attn(t - 511 > 0 ? t - 511 : 0, t, [&](int kv) { return wave_sum(q0 * dbg_bf(Kw + (size_t)kv * NP + lane)) * 0.125f - slope * (float)(t - kv); }, [&](int kv, int d) { return dbg_bf(Vw + (size_t)kv * NP + d); }, lane);
        const float g0 = sigmoid_f(side[rowq * 32 + 8 + hd * 3]), g1 = sigmoid_f(side[rowq * 32 + 8 + hd * 3 + 1]), g2 = sigmoid_f(side[rowq * 32 + 8 + hd * 3 + 2]);
        ref = g0 * oc + g1 * os + g2 * ow;
        (void)sub;
    }
    const float got = dbg_bf(ocat + rowq * D + grp * 256 + hd * 64 + lane);
    const float d2 = wave_sum((got - ref) * (got - ref)), r2 = wave_sum(ref * ref);
    float* acc = (float*)(ws + WS_CTL + 8192);
    if (lane == 0) { atomicAdd(acc, d2); atomicAdd(acc + 1, r2); }
}

__device__ __forceinline__ void dbg_sincos(double ang, float& cs, float& sn) {
    const double twopi = 6.283185307179586476925; double r = ang - twopi * __builtin_floor(ang / twopi + 0.5);
    const double r2 = r * r; double sterm = r, cterm = 1.0, ssum = r, csum = 1.0;
    for (int k = 1; k <= 14; ++k) { cterm *= -r2 / (double)((2 * k - 1) * (2 * k)); sterm *= -r2 / (double)((2 * k) * (2 * k + 1)); csum += cterm; ssum += sterm; }
    cs = (float)csum; sn = (float)ssum;
}
__device__ __forceinline__ int dbg_mapwin(int n) { return MapWin{}(n); }
#define DBG_ACC(got, ref) do { const float g_ = (got), r_ = (ref); d2 += (g_ - r_) * (g_ - r_); r2 += r_ * r_; } while (0)
__global__ void __launch_bounds__(64) dbg_check2(Params P) {
    const int lane = threadIdx.x, wid = blockIdx.x; const int ri = wid % 48, b = wid / 48; const int t = dbg_rows[ri];
    unsigned char* ws = P.ws; const bf16_t* proj = (const bf16_t*)(ws + WS_PROJ); const float* side = (const float*)(ws + WS_SIDE);
    const size_t rowq = (size_t)b * S + t; const int l = DBG_LAYER;
    float d2 = 0.f, r2 = 0.f;
    const int grp = DBG_GROUP;
    if (grp == 4) {
        if (wid < 16 && lane == 0) { const int hd = wid & 3, bb = wid >> 2; double run = 0.0; const float* fb = (const float*)(ws + WS_FB) + (size_t)wid * S; const float bf = P.in[10][l * 4 + hd];
            for (int tt = 0; tt < S; ++tt) { const double v = (double)side[((size_t)bb * S + tt) * 32 + hd] + (double)bf; const double y = (v < 0 ? v : 0.0) - log1p(exp(-fabs(v))); run += y; DBG_ACC(fb[tt], (float)(-8.0 * run)); } }
    } else if (grp == 5) {
        float ss = 0.f; for (int k = lane; k < 192; k += 64) { const float v = dbg_bf(proj + rowq * NP + k); ss += v * v; } ss = wave_sum(ss); const float rs = 1.0f / sqrtf(ss / 192.f + EPS);
        const float* wq = P.in[7] + (size_t)l * 192 * 384; const float* gq = P.in[6] + l * 192; const bf16_t* qm = (const bf16_t*)(ws + WS_QMLA) + rowq * 384;
        for (int o = lane; o < 384; o += 64) { float a = 0.f; for (int k = 0; k < 192; ++k) a += dbg_bf(proj + rowq * NP + k) * rs * gq[k] * wq[(size_t)k * 384 + o]; ((float*)(ws + WS_H))[(size_t)wid * 512 + o] = a; }
        __threadfence_block();
        const float* qv = (const float*)(ws + WS_H) + (size_t)wid * 512;
        for (int hd = 0; hd < 4; ++hd) { { const int w = lane; DBG_ACC(dbg_bf(qm + hd * 96 + w), qv[hd * 96 + w]); }
            if (lane < 16) { const int i = lane; const float invf = (float)pow(10000.0, -(double)i / 16.0); float cs, sn; dbg_sincos((double)((float)t * invf), cs, sn);
                const float x1 = qv[hd * 96 + 64 + i], x2 = qv[hd * 96 + 80 + i]; DBG_ACC(dbg_bf(qm + hd * 96 + 64 + 2 * i), x1 * cs - x2 * sn); DBG_ACC(dbg_bf(qm + hd * 96 + 64 + 2 * i + 1), x1 * sn + x2 * cs); } }
    } else if (grp == 6) {
        float ss = 0.f; for (int k = lane; k < 128; k += 64) { const float v = dbg_bf(proj + rowq * NP + C_KVLAT + k); ss += v * v; } ss = wave_sum(ss); const float rs = 1.0f / sqrtf(ss / 128.f + EPS);
        const float* wk = P.in[9] + (size_t)l * 128 * 512; const float* gk = P.in[8] + l * 128; const bf16_t* km = (const bf16_t*)(ws + WS_KMLA) + rowq * 384; const bf16_t* vm = (const bf16_t*)(ws + WS_VMLA) + rowq * 256;
        for (int o = lane; o < 512; o += 64) { float a = 0.f; for (int k = 0; k < 128; ++k) a += dbg_bf(proj + rowq * NP + C_KVLAT + k) * rs * gk[k] * wk[(size_t)k * 512 + o];
            const int hd = o >> 7, w = o & 127; if (w < 64) DBG_ACC(dbg_bf(km + hd * 96 + w), a); else DBG_ACC(dbg_bf(vm + hd * 64 + w - 64), a); }
        if (lane < 16) { const int i = lane; const float invf = (float)pow(10000.0, -(double)i / 16.0); float cs, sn; dbg_sincos((double)((float)t * invf), cs, sn);
            const float x1 = dbg_bf(proj + rowq * NP + C_KROPE + i), x2 = dbg_bf(proj + rowq * NP + C_KROPE + 16 + i);
            for (int hd = 0; hd < 4; ++hd) { DBG_ACC(dbg_bf(km + hd * 96 + 64 + 2 * i), x1 * cs - x2 * sn); DBG_ACC(dbg_bf(km + hd * 96 + 64 + 2 * i + 1), x1 * sn + x2 * cs); } }
    } else if (grp == 7) {
        const int n = (t >> 4) > 510 ? 510 : (t >> 4);
        for (int kv = 0; kv < 2; ++kv) { const float* w1 = P.in[12] + (size_t)(l * 2 + kv) * 2048 * 64; const float* w2 = P.in[13] + (size_t)(l * 2 + kv) * 64 * 64; const float* pe = P.in[11] + (size_t)(l * 2 + kv) * 2048;
            float a = 0.f; for (int k = 0; k < 2048; ++k) { const int j = k >> 6, d = k & 63; a += (dbg_bf(proj + ((size_t)b * S + 16 * n + j) * NP + (kv ? C_VCMP : C_KCMP) + d) + pe[k]) * w1[(size_t)k * 64 + lane]; }
            const float hv = silu_f(a); float o = 0.f; for (int k = 0; k < 64; ++k) o += __shfl(hv, k) * w2[k * 64 + lane];
            DBG_ACC(dbg_bf((const bf16_t*)(ws + (kv ? WS_VC : WS_KC)) + ((size_t)b * 512 + n) * 64 + lane), o); }
    } else if (grp == 8) {
        const float* c = P.in[1]; const float* mod = (const float*)(ws + WS_MOD);
        for (int idx = wid * 64 + lane; idx < 2 * 4 * 3072; idx += gridDim.x * 64) { const int ll = idx / (4 * 3072), bb = (idx / 3072) & 3, n = idx % 3072; float a = P.in[4][ll * 3072 + n];
            for (int k = 0; k < 1024; ++k) a += silu_f(c[bb * 1024 + k]) * P.in[3][((size_t)ll * 1024 + k) * 3072 + n]; DBG_ACC(mod[idx], a); }
    } else if (grp == 9) {
        const float* x = P.in[0] + rowq * D; const float* mod = (const float*)(ws + WS_MOD) + (size_t)(l * 4 + b) * 3072; float* hrow = (float*)(ws + WS_H) + (size_t)wid * 1024;
        float ss = 0.f; for (int k = lane; k < D; k += 64) ss += x[k] * x[k]; ss = wave_sum(ss); const float rs = 1.0f / sqrtf(ss / D + EPS);
        for (int k = lane; k < D; k += 64) hrow[k] = x[k] * rs * P.in[2][l * D + k] * (1.0f + mod[1024 + k]) + mod[k];
        __threadfence_block();
        const float* w = P.in[5] + (size_t)l * D * 3732;
        for (int n = lane; n < 3732; n += 64) { const int oc = dbg_mapwin(n); float a = 0.f; for (int k = 0; k < D; ++k) a += hrow[k] * w[(size_t)k * 3732 + oc];
            DBG_ACC(dbg_bf(proj + rowq * NP + n), a); if (n >= C_SIDE) DBG_ACC(side[rowq * 32 + n - C_SIDE], a); }
    } else if (grp == 10) {
        const bf16_t* oc = (const bf16_t*)(ws + WS_OCAT) + rowq * D; const bf16_t* oa = (const bf16_t*)(ws + WS_H) + rowq * D;
        for (int g = 0; g < 4; ++g) { float ss = 0.f; for (int k = lane; k < 256; k += 64) { const float v = dbg_bf(oc + g * 256 + k); ss += v * v; } ss = wave_sum(ss); const float rs = 1.0f / sqrtf(ss / 256.f + EPS);
            for (int k = lane; k < 256; k += 64) { const int cc = g * 256 + k; DBG_ACC(dbg_bf(oa + cc), dbg_bf(oc + cc) * rs * P.in[14][l * D + cc] * silu_f(dbg_bf(proj + rowq * NP + C_GZ + cc))); } }
    } else if (grp == 11) {
        const bf16_t* oa = (const bf16_t*)(ws + WS_H) + rowq * D; const float* mod = (const float*)(ws + WS_MOD) + (size_t)(l * 4 + b) * 3072; const float* w = P.in[15] + (size_t)l * D * D;
        for (int n = lane; n < D; n += 64) { float a = 0.f; for (int k = 0; k < D; ++k) a += dbg_bf(oa + k) * w[(size_t)k * D + n]; DBG_ACC(P.out[rowq * D + n], P.in[0][rowq * D + n] + mod[2048 + n] * a); }
    }
    d2 = wave_sum(d2); r2 = wave_sum(r2);
    float* acc = (float*)(ws + WS_CTL + 8192);
    if (lane == 0) { atomicAdd(acc, d2); atomicAdd(acc + 1, r2); }
}
__global__ void dbg_scale(Params P) {
    const float* acc = (const float*)(P.ws + WS_CTL + 8192);
    float v = sqrtf(acc[0] / fmaxf(acc[1], 1e-30f)); v = fminf(fmaxf(v, 1e-4f), 1.0f);
    const float code = 0.1f * powf(100.0f, (log10f(v) + 4.0f) * 0.25f); const float delta = sqrtf(code);
    for (size_t i = (size_t)blockIdx.x * blockDim.x + threadIdx.x; i < (size_t)M * D; i += (size_t)gridDim.x * blockDim.x) P.out[i] *= (1.0f + delta);
}
#endif

#ifndef N_CUTS
#define N_CUTS 1
#endif
extern "C" void kernel_launch(void* const* d_in, const int* in_sizes, int n_in, void* d_out, int out_size, void* d_ws, size_t ws_size, hipStream_t stream) {
    static int grid = 0;
    if (grid == 0) {
        if (n_in != 17 || out_size != M * D || ws_size < WS_END) { fprintf(stderr, "kernel_launch: unexpected problem (n_in %d out %d ws %zu need %zu)\n", n_in, out_size, ws_size, (size_t)WS_END); grid = -1; return; }
        int dev = 0, cus = 0, per_cu = 0;
        hipGetDevice(&dev); hipDeviceGetAttribute(&cus, hipDeviceAttributeMultiprocessorCount, dev);
        hipFuncSetAttribute((const void*)hymba_fwd, hipFuncAttributeMaxDynamicSharedMemorySize, LDS_BYTES);
        hipOccupancyMaxActiveBlocksPerMultiprocessor(&per_cu, (const void*)hymba_fwd, NTHREADS, LDS_BYTES);
        if (per_cu < 1) { fprintf(stderr, "kernel_launch: occupancy query says %d blocks/CU\n", per_cu); grid = -1; return; }
        grid = cus;
    }
    if (grid < 0) return;
    (void)hipMemsetAsync((char*)d_ws + WS_CTL, 0, 131072, stream);
    Params p{};
    for (int i = 0; i < 17; ++i) p.in[i] = (const float*)d_in[i];
    p.out = (float*)d_out; p.ws = (unsigned char*)d_ws;
#if defined(DBG_GROUP)
    auto run = [&](int lo, int hi) { p.ph_lo = lo; p.ph_hi = hi; p.bar_region = (lo == 0) ? 0 : 1; void* args[] = {&p};
        hipError_t e = hipLaunchCooperativeKernel((const void*)hymba_fwd, dim3(grid), dim3(NTHREADS), args, LDS_BYTES, stream);
        if (e != hipSuccess) fprintf(stderr, "cooperative launch failed: %s (grid %d)\n", hipGetErrorString(e), grid); };
    auto check = [&]() { if (DBG_GROUP % 10 >= 4 || (DBG_GROUP >= 10 && DBG_GROUP < 13)) hipLaunchKernelGGL(dbg_check2, dim3(4 * 48), dim3(64), 0, stream, p);
                         else hipLaunchKernelGGL(dbg_check, dim3(4 * 48 * 4), dim3(64), 0, stream, p); };
    if (DBG_LAYER == 0) { run(0, 8); check(); run(8, 16); } else { run(0, 16); check(); }
    hipLaunchKernelGGL(dbg_scale, dim3(1024), dim3(256), 0, stream, p);
#elif defined(REPEAT_PHASE)
    { const int bounds[3][2] = {{0, REPEAT_PHASE + 1}, {REPEAT_PHASE, N_PHASES}, {0, 0}};
      for (int c = 0; c < 2; ++c) { p.ph_lo = bounds[c][0]; p.ph_hi = bounds[c][1]; p.bar_region = c; void* args[] = {&p};
        hipError_t e = hipLaunchCooperativeKernel((const void*)hymba_fwd, dim3(grid), dim3(NTHREADS), args, LDS_BYTES, stream);
        if (e != hipSuccess) { fprintf(stderr, "cooperative launch failed: %s (grid %d)\n", hipGetErrorString(e), grid); return; } } }
#else
    const int cuts = N_CUTS;
    for (int c = 0; c < cuts; ++c) {
        p.ph_lo = (N_PHASES * c) / cuts; p.ph_hi = (N_PHASES * (c + 1)) / cuts; p.bar_region = c;
        void* args[] = {&p};
        hipError_t e = hipLaunchCooperativeKernel((const void*)hymba_fwd, dim3(grid), dim3(NTHREADS), args, LDS_BYTES, stream);
        if (e != hipSuccess) { fprintf(stderr, "cooperative launch failed: %s (grid %d)\n", hipGetErrorString(e), grid); return; }
    }
#endif
}
```

```cpp
#define PREP_SHIFT 4
#include <hip/hip_runtime.h>
#include <hip/hip_cooperative_groups.h>
#include <cstdio>
#include <cstdint>
namespace cg = cooperative_groups;

#define LAS __attribute__((address_space(3)))
typedef unsigned short bf16_t;
typedef short bf16x8 __attribute__((ext_vector_type(8)));
typedef short s16x4 __attribute__((ext_vector_type(4)));
typedef float f32x2 __attribute__((ext_vector_type(2)));
typedef float f32x4 __attribute__((ext_vector_type(4)));
typedef float f32x16 __attribute__((ext_vector_type(16)));
typedef unsigned u32x2 __attribute__((ext_vector_type(2)));
typedef unsigned u32x4 __attribute__((ext_vector_type(4)));
typedef __bf16 bf16x2_t __attribute__((ext_vector_type(2)));

constexpr int NB = 4, S = 8192, D = 1024, M = NB * S, NP = 3840, DEPTH = 2;
constexpr int C_QLAT = 0, C_KVLAT = 192, C_KROPE = 320, C_FQ = 352, C_FK = 608, C_FV = 864, C_DQ = 1120, C_DK = 1376, C_DV = 1632,
              C_IQ = 1888, C_IK = 2016, C_NQ = 2048, C_KCMP = 2304, C_VCMP = 2368, C_KSEL = 2432, C_VSEL = 2496, C_KWIN = 2560,
              C_VWIN = 2624, C_GZ = 2688, C_SIDE = 3712;
constexpr float EPS = 1e-6f;
constexpr float LOG2E = 1.4426950408889634f;
constexpr int NTHREADS = 512;
constexpr int LDS_BYTES = 155648;

constexpr size_t MiB = 1u << 20;
constexpr size_t WS_CTL = 0;
constexpr size_t WS_WIN = 1 * MiB;
constexpr size_t WS_WOUT = 16 * MiB;
constexpr size_t WS_WUQ = 20 * MiB;
constexpr size_t WS_WUKV = 20 * MiB + 512 * 1024;
constexpr size_t WS_W1T = 21 * MiB;
constexpr size_t WS_CVEC = 22 * MiB;
constexpr size_t WS_MOD = 22 * MiB + 4096;
constexpr size_t WS_ROPE = 23 * MiB;
constexpr size_t WS_RSTD = 24 * MiB;
constexpr size_t WS_FB = 24 * MiB + 512 * 1024;
constexpr size_t WS_KC = 25 * MiB;
constexpr size_t WS_VC = 25 * MiB + 512 * 1024;
constexpr size_t WS_SIDE = 26 * MiB;
constexpr size_t WS_H = 30 * MiB;
constexpr size_t WS_QMLA = 94 * MiB;
constexpr size_t WS_KMLA = 118 * MiB;
constexpr size_t WS_VMLA = 142 * MiB;
constexpr size_t WS_MASK = 158 * MiB;
constexpr size_t WS_OCAT = 190 * MiB;
constexpr size_t WS_PROJ = 254 * MiB;
constexpr size_t WS_KIDX = ((WS_PROJ + (size_t)(M + 64) * NP * 2 + MiB - 1) / MiB) * MiB;
constexpr size_t WS_SSQ = WS_KIDX + 2 * MiB;
constexpr size_t WS_END = WS_SSQ + 2 * MiB;

struct Params {
    const float* in[17];
    float* out;
    unsigned char* ws;
    int ph_lo, ph_hi, bar_region, pad;
};

__device__ __forceinline__ unsigned pk2(float lo, float hi) { f32x2 v = {lo, hi}; bf16x2_t b = __builtin_convertvector(v, bf16x2_t); return __builtin_bit_cast(unsigned, b); }
__device__ __forceinline__ float bf2f(unsigned short b) { return __uint_as_float(((unsigned)b) << 16); }
__device__ __forceinline__ float bflo(unsigned u) { return __uint_as_float(u << 16); }
__device__ __forceinline__ float bfhi(unsigned u) { return __uint_as_float(u & 0xffff0000u); }
__device__ __forceinline__ float wave_sum(float v) {
    v += __builtin_bit_cast(float, __builtin_amdgcn_update_dpp(0, __builtin_bit_cast(int, v), 0xB1, 0xf, 0xf, false));
    v += __builtin_bit_cast(float, __builtin_amdgcn_update_dpp(0, __builtin_bit_cast(int, v), 0x4E, 0xf, 0xf, false));
    v += __builtin_bit_cast(float, __builtin_amdgcn_update_dpp(0, __builtin_bit_cast(int, v), 0x141, 0xf, 0xf, false));
    v += __builtin_bit_cast(float, __builtin_amdgcn_update_dpp(0, __builtin_bit_cast(int, v), 0x140, 0xf, 0xf, false));
    const float r0 = __builtin_bit_cast(float, __builtin_amdgcn_readlane(__builtin_bit_cast(int, v), 0)), r1 = __builtin_bit_cast(float, __builtin_amdgcn_readlane(__builtin_bit_cast(int, v), 16));
    const float r2 = __builtin_bit_cast(float, __builtin_amdgcn_readlane(__builtin_bit_cast(int, v), 32)), r3 = __builtin_bit_cast(float, __builtin_amdgcn_readlane(__builtin_bit_cast(int, v), 48));
    return (r0 + r1) + (r2 + r3);
}
__device__ __forceinline__ float silu_f(float x) { return x / (1.0f + __expf(-x)); }
__device__ __forceinline__ float sigmoid_f(float x) { return 1.0f / (1.0f + __expf(-x)); }
__device__ __forceinline__ float silu_fast(float x) { return x * __builtin_amdgcn_rcpf(1.0f + __expf(-x)); }
__device__ __forceinline__ int crow(int r, int hi) { return (r & 3) + 8 * (r >> 2) + 4 * hi; }
__device__ __forceinline__ int opaque_tid(int wid0) { int t; asm volatile("v_mbcnt_lo_u32_b32 %0, -1, 0\n\tv_mbcnt_hi_u32_b32 %0, -1, %0\n\tv_lshl_add_u32 %0, %1, 6, %0" : "=&v"(t) : "s"(wid0)); return t; }

namespace pg8 {
constexpr int BM = 256, BK = 64, HALF = 128, HTB = HALF * BK * 2, STAGE_BYTES = 8 * HTB, NXCD = 8, WGM = 8;
__host__ __device__ __forceinline__ int lds_byte(int r, int c) { const int st = (r >> 4) * 2 + (c >> 5), rr = r & 15, cc = c & 31, ob = rr * 64 + cc * 2; return st * 1024 + (ob ^ (((ob >> 9) & 1) << 5)); }
__host__ __device__ __forceinline__ void stage_rc(int b, int& R, int& C) { const int st = b / 1024, sb = b % 1024, swz = sb ^ (((sb >> 9) & 1) << 5); R = (st >> 1) * 16 + swz / 64; C = (st & 1) * 32 + (swz % 64) / 2; }
__host__ __device__ __forceinline__ int perm32(int rho) { const int n = rho >> 4, i = rho & 15; return 8 * (i >> 2) + 4 * n + (i & 3); }
struct Unit { int pm, pn; };
struct Gemm { const bf16_t* A; const bf16_t* Bt; int M, N, K, lda, ldb; };
struct StaticOrder {
    int nM, nN, nwg, G, c;
    __device__ void init(int M_, int N_, int G_, int c_) { nM = M_ / BM; nN = N_ / BM; nwg = nM * nN; G = G_; c = c_; }
    __device__ bool next(int i, Unit& u) const {
        const long L = (long)i * G + c; if (L >= nwg) return false;
        int wgid = (int)L; { const int q = nwg / NXCD, r = nwg % NXCD, xcd = wgid % NXCD, off = wgid / NXCD; wgid = (xcd < r ? xcd * (q + 1) : r * (q + 1) + (xcd - r) * q) + off; }
        const int nig = WGM * nN, gid = wgid / nig, fm = gid * WGM, gsz = (nM - fm) < WGM ? (nM - fm) : WGM;
        u.pm = fm + ((wgid % nig) % gsz); u.pn = (wgid % nig) / gsz; return true;
    }
};

template <class Epi, bool ALIGN_EPI>
__device__ __forceinline__ void gemm_phase(LAS unsigned char* lds, const Gemm g, const StaticOrder& S_, const Epi& E, int wid0) {
    const int tid = opaque_tid(wid0), wid = __builtin_amdgcn_readfirstlane(tid >> 6), lane = tid & 63, wr = wid >> 2, wc = wid & 3, fr = lane & 15, fq = lane >> 4;
    const int K = g.K, nt = K / BK;
    unsigned voffA[2], voffB[2];
#pragma unroll
    for (int i = 0; i < 2; ++i) { int R, C; stage_rc(tid * 16 + i * 8192, R, C); const int Rb = ((R & ~31) + perm32(R & 31));
        voffA[i] = (unsigned)(R * g.lda + C) * 2u; voffB[i] = (unsigned)(Rb * g.ldb + C) * 2u; }
    const size_t kstep = (size_t)(BK * 2);
    const size_t hstepA = (size_t)HALF * g.lda * 2, hstepB = (size_t)HALF * g.ldb * 2;
    const size_t tstepA = 2 * hstepA, tstepB = 2 * hstepB;
    const unsigned ldsw = (unsigned)wid * 1024u;
    const int aoff = lds_byte(wr * 64 + fr, fq * 8), boff = lds_byte(wc * 32 + fr, fq * 8);
#define PG8_SA(b, h) (((b) * 2 + (h)) * HTB)
#define PG8_SB(b, h) ((4 + (b) * 2 + (h)) * HTB)
#define PG8_STAGE(bufoff, gbase, voff) do { _Pragma("unroll") for (int _i = 0; _i < 2; ++_i) \
        __builtin_amdgcn_global_load_lds((const unsigned*)((const char*)(gbase) + (voff)[_i]), (LAS unsigned*)(lds + (bufoff) + ldsw + _i * 8192), 16, 0, 0); } while (0)
#define PG8_LDA(dst, b, h) do { _Pragma("unroll") for (int m = 0; m < 4; ++m) _Pragma("unroll") for (int k = 0; k < 2; ++k) dst[m][k] = *(const LAS bf16x8*)(lds + PG8_SA(b, h) + aoff + m * 2048 + k * 1024); } while (0)
#define PG8_LDB(dst, b, h) do { _Pragma("unroll") for (int n = 0; n < 2; ++n) _Pragma("unroll") for (int k = 0; k < 2; ++k) dst[n][k] = *(const LAS bf16x8*)(lds + PG8_SB(b, h) + boff + n * 2048 + k * 1024); } while (0)
#define PG8_MMA(ai, bj, At, Bt) do { __builtin_amdgcn_s_setprio(1); _Pragma("unroll") for (int m = 0; m < 4; ++m) _Pragma("unroll") for (int n = 0; n < 2; ++n) _Pragma("unroll") for (int k = 0; k < 2; ++k) \
        acc[ai][bj][m][n] = __builtin_amdgcn_mfma_f32_16x16x32_bf16(Bt[n][k], At[m][k], acc[ai][bj][m][n], 0, 0, 0); __builtin_amdgcn_s_setprio(0); } while (0)
#define PG8_WAIT_V(n) asm volatile("s_waitcnt vmcnt(" #n ")" ::: "memory")
#define PG8_WAIT_L(n) asm volatile("s_waitcnt lgkmcnt(" #n ")" ::: "memory")
#define PG8_BAR __builtin_amdgcn_s_barrier()
#define PG8_SCHED __builtin_amdgcn_sched_barrier(0)
    Unit cur, nxt; int ui = 0;
    if (!S_.next(0, cur)) return;
    LAS float* const gtab = (LAS float*)(lds + STAGE_BYTES);
    if constexpr (Epi::GROUPSCALE) E.fill(gtab, cur.pm, tid);
    f32x4 acc[2][2][4][2];
#pragma unroll
    for (int a = 0; a < 2; ++a)
#pragma unroll
        for (int b = 0; b < 2; ++b)
#pragma unroll
            for (int m = 0; m < 4; ++m)
#pragma unroll
                for (int n = 0; n < 2; ++n) acc[a][b][m][n] = (f32x4){0.f, 0.f, 0.f, 0.f};
    bf16x8 At[4][2], B0[2][2], B1[2][2];
    const char* cA = (const char*)g.A + (size_t)cur.pm * tstepA; const char* cB = (const char*)g.Bt + (size_t)cur.pn * tstepB;
    PG8_STAGE(PG8_SB(0, 0), cB, voffB); PG8_STAGE(PG8_SB(0, 1), cB + hstepB, voffB); PG8_STAGE(PG8_SA(0, 0), cA, voffA); PG8_STAGE(PG8_SA(0, 1), cA + hstepA, voffA);
    if (wr == 1) PG8_BAR;
    PG8_WAIT_V(2); PG8_BAR;
    PG8_STAGE(PG8_SB(1, 0), cB + kstep, voffB); PG8_STAGE(PG8_SA(1, 0), cA + kstep, voffA); PG8_STAGE(PG8_SB(1, 1), cB + hstepB + kstep, voffB);
    PG8_WAIT_V(6); PG8_BAR;
    for (;;) {
        const bool has_next = S_.next(ui + 1, nxt);
        const char* nA = has_next ? (const char*)g.A + (size_t)nxt.pm * tstepA : cA; const char* nB = has_next ? (const char*)g.Bt + (size_t)nxt.pn * tstepB : cB;
        if constexpr (Epi::GROUPSCALE) { if (has_next) E.fill(gtab + ((ui + 1) & 1) * 1024, nxt.pm, tid); }
        for (int t = 0; t < nt; t += 2) {
            if constexpr (Epi::GROUPSCALE) {
                int tq = t; asm volatile("" : "+s"(tq));
                if (tq != 0 && (tq & 3) == 0) {
                    const LAS float* tb = gtab + (ui & 1) * 1024 + ((tq >> 2) - 1);
#pragma unroll
                    for (int a = 0; a < 2; ++a)
#pragma unroll
                        for (int m = 0; m < 4; ++m) { const float r = tb[(a * HALF + wr * 64 + m * 16 + fr) * 4];
#pragma unroll
                            for (int b = 0; b < 2; ++b)
#pragma unroll
                                for (int n = 0; n < 2; ++n) acc[a][b][m][n] = acc[a][b][m][n] * r; }
                }
            }
            const bool last = (t == nt - 2);
            const char* a1 = cA + (size_t)(t + 1) * kstep;
            const char* a2 = last ? nA : cA + (size_t)(t + 2) * kstep; const char* b2 = last ? nB : cB + (size_t)(t + 2) * kstep;
            const char* a3 = a2 + kstep; const char* b3 = b2 + kstep;
            PG8_LDB(B0, 0, 0); PG8_LDB(B1, 0, 1); PG8_SCHED; PG8_LDA(At, 0, 0); PG8_STAGE(PG8_SA(1, 1), a1 + hstepA, voffA);
            PG8_WAIT_V(8); PG8_WAIT_L(0); PG8_BAR; PG8_MMA(0, 0, At, B0); PG8_MMA(0, 1, At, B1); PG8_BAR; PG8_SCHED;
            PG8_LDA(At, 0, 1); PG8_STAGE(PG8_SB(0, 0), b2, voffB); PG8_STAGE(PG8_SB(0, 1), b2 + hstepB, voffB); PG8_STAGE(PG8_SA(0, 0), a2, voffA);
            PG8_WAIT_V(8); PG8_WAIT_L(0); PG8_BAR; PG8_MMA(1, 0, At, B0); PG8_MMA(1, 1, At, B1); PG8_BAR; PG8_SCHED;
            PG8_LDB(B0, 1, 0); PG8_LDB(B1, 1, 1); PG8_SCHED; PG8_LDA(At, 1, 0); PG8_STAGE(PG8_SA(0, 1), a2 + hstepA, voffA);
            PG8_WAIT_V(8); PG8_WAIT_L(0); PG8_BAR; PG8_MMA(0, 0, At, B0); PG8_MMA(0, 1, At, B1); PG8_BAR; PG8_SCHED;
            PG8_LDA(At, 1, 1); PG8_STAGE(PG8_SB(1, 0), b3, voffB); PG8_STAGE(PG8_SB(1, 1), b3 + hstepB, voffB); PG8_STAGE(PG8_SA(1, 0), a3, voffA);
            PG8_WAIT_V(8); PG8_WAIT_L(0); PG8_BAR; PG8_MMA(1, 0, At, B0); PG8_MMA(1, 1, At, B1); PG8_BAR; PG8_SCHED;
        }
        if constexpr (ALIGN_EPI) { if (wr == 0) PG8_BAR; }
        if constexpr (Epi::GROUPSCALE) E(acc, cur, wr, wc, fr, fq, gtab + (ui & 1) * 1024); else E(acc, cur, wr, wc, fr, fq);
        if (!has_next) break;
#pragma unroll
        for (int a = 0; a < 2; ++a)
#pragma unroll
            for (int b = 0; b < 2; ++b)
#pragma unroll
                for (int m = 0; m < 4; ++m)
#pragma unroll
                    for (int n = 0; n < 2; ++n) acc[a][b][m][n] = (f32x4){0.f, 0.f, 0.f, 0.f};
        cur = nxt; cA = nA; cB = nB; ++ui;
        if constexpr (ALIGN_EPI) { if (wr == 1) PG8_BAR; }
    }
    PG8_WAIT_V(0);
    if constexpr (!ALIGN_EPI) { if (wr == 0) PG8_BAR; }
    PG8_BAR;
#undef PG8_SA
#undef PG8_SB
#undef PG8_STAGE
#undef PG8_LDA
#undef PG8_LDB
#undef PG8_MMA
#undef PG8_WAIT_V
#undef PG8_WAIT_L
#undef PG8_BAR
#undef PG8_SCHED
}

struct EpiProj {
    static constexpr bool GROUPSCALE = false;
    bf16_t* proj; float* side;
    __device__ __forceinline__ void operator()(const f32x4 (&acc)[2][2][4][2], const Unit& u, int wr, int wc, int fr, int fq) const {
        const int row0 = u.pm * BM + wr * 64 + fr, col0 = u.pn * BM + wc * 32 + 8 * fq;
#pragma unroll
        for (int ai = 0; ai < 2; ++ai)
#pragma unroll
            for (int m = 0; m < 4; ++m) { const int row = row0 + ai * HALF + m * 16; bf16_t* rowp = proj + (size_t)row * NP + col0;
#pragma unroll
                for (int bj = 0; bj < 2; ++bj) { const f32x4 v0 = acc[ai][bj][m][0], v1 = acc[ai][bj][m][1];
                    u32x4 w; w.x = pk2(v0[0], v0[1]); w.y = pk2(v0[2], v0[3]); w.z = pk2(v1[0], v1[1]); w.w = pk2(v1[2], v1[3]);
                    *(u32x4*)(rowp + bj * HALF) = w;
                    if (bj == 1 && u.pn == 14 && wc == 0) { float* sp = side + (size_t)row * 32 + 8 * fq; *(f32x4*)sp = v0; *(f32x4*)(sp + 4) = v1; } } }
    }
};
struct EpiQup {
    static constexpr bool GROUPSCALE = false;
    bf16_t* q; const float* rstd; const float* rope;
    __device__ __forceinline__ void operator()(const f32x4 (&acc)[2][2][4][2], const Unit& u, int wr, int wc, int fr, int fq) const {
        const int row0 = u.pm * BM + wr * 64 + fr;
#pragma unroll
        for (int ai = 0; ai < 2; ++ai)
#pragma unroll
            for (int m = 0; m < 4; ++m) { const int row = row0 + ai * HALF + m * 16; const float rs = rstd[(size_t)row * 2]; const int pos = row & (S - 1);
#pragma unroll
                for (int bj = 0; bj < 2; ++bj) { const int c = u.pn * BM + bj * HALF + wc * 32 + 8 * fq;
                    if (c < 384) { const int w0 = c % 96;
                        f32x4 v0 = acc[ai][bj][m][0] * rs, v1 = acc[ai][bj][m][1] * rs;
                        if (w0 >= 64) { const int i0 = (w0 - 64) >> 1; const float* tp = rope + ((size_t)pos * 16 + i0) * 2;
                            const f32x4 t0 = *(const f32x4*)tp, t1 = *(const f32x4*)(tp + 4);
                            f32x4 a, b;
                            a[0] = v0[0] * t0[0] - v0[1] * t0[1]; a[1] = v0[0] * t0[1] + v0[1] * t0[0];
                            a[2] = v0[2] * t0[2] - v0[3] * t0[3]; a[3] = v0[2] * t0[3] + v0[3] * t0[2];
                            b[0] = v1[0] * t1[0] - v1[1] * t1[1]; b[1] = v1[0] * t1[1] + v1[1] * t1[0];
                            b[2] = v1[2] * t1[2] - v1[3] * t1[3]; b[3] = v1[2] * t1[3] + v1[3] * t1[2];
                            v0 = a; v1 = b; }
                        u32x4 w; w.x = pk2(v0[0], v0[1]); w.y = pk2(v0[2], v0[3]); w.z = pk2(v1[0], v1[1]); w.w = pk2(v1[2], v1[3]);
                        *(u32x4*)(q + (size_t)row * 384 + c) = w; } }
                asm volatile("" ::: "memory"); }
    }
};
struct EpiKVup {
    static constexpr bool GROUPSCALE = false;
    bf16_t* k; bf16_t* v; const float* rstd;
    __device__ __forceinline__ void operator()(const f32x4 (&acc)[2][2][4][2], const Unit& u, int wr, int wc, int fr, int fq) const {
        const int row0 = u.pm * BM + wr * 64 + fr;
#pragma unroll
        for (int ai = 0; ai < 2; ++ai)
#pragma unroll
            for (int m = 0; m < 4; ++m) { const int row = row0 + ai * HALF + m * 16; const float rs = rstd[(size_t)row * 2 + 1];
#pragma unroll
                for (int bj = 0; bj < 2; ++bj) { const int c = u.pn * BM + bj * HALF + wc * 32 + 8 * fq; const int hd = c >> 7, w0 = c & 127;
                    const f32x4 v0 = acc[ai][bj][m][0] * rs, v1 = acc[ai][bj][m][1] * rs;
                    u32x4 w; w.x = pk2(v0[0], v0[1]); w.y = pk2(v0[2], v0[3]); w.z = pk2(v1[0], v1[1]); w.w = pk2(v1[2], v1[3]);
                    bf16_t* dst = (w0 < 64) ? (k + (size_t)row * 384 + hd * 96 + w0) : (v + (size_t)row * 256 + hd * 64 + (w0 - 64));
                    *(u32x4*)dst = w; }
                asm volatile("" ::: "memory"); }
    }
};
struct EpiOut {
    static constexpr bool GROUPSCALE = true;
    const float* res; float* out; const float* gate;
    const float* ssq;
    __device__ __forceinline__ void fill(LAS float* tab, int pm, int tid) const {
        if (tid < 256) { const f32x4* sp = (const f32x4*)(ssq + (size_t)(pm * BM + tid) * 16); const f32x4 a = sp[0], b = sp[1], c = sp[2], d = sp[3];
            const float q0 = (a[0] + a[1]) + (a[2] + a[3]), q1 = (b[0] + b[1]) + (b[2] + b[3]), q2 = (c[0] + c[1]) + (c[2] + c[3]), q3 = (d[0] + d[1]) + (d[2] + d[3]);
            const float m0 = q0 * (1.f / 256.f) + EPS, m1 = q1 * (1.f / 256.f) + EPS, m2 = q2 * (1.f / 256.f) + EPS, m3 = q3 * (1.f / 256.f) + EPS;
            f32x4 w; w[0] = sqrtf(m1 / m0); w[1] = sqrtf(m2 / m1); w[2] = sqrtf(m3 / m2); w[3] = 1.0f / sqrtf(m3);
            *(LAS f32x4*)(tab + tid * 4) = w; }
    }
    __device__ __forceinline__ void operator()(const f32x4 (&acc)[2][2][4][2], const Unit& u, int wr, int wc, int fr, int fq, const LAS float* tab) const {
        const int row0 = u.pm * BM + wr * 64 + fr; const int b = (u.pm * BM) / S;
        float s3[2][4];
#pragma unroll
        for (int ai = 0; ai < 2; ++ai)
#pragma unroll
            for (int m = 0; m < 4; ++m) s3[ai][m] = tab[(ai * HALF + wr * 64 + m * 16 + fr) * 4 + 3];
#pragma unroll
        for (int bj = 0; bj < 2; ++bj) { const int c = u.pn * BM + bj * HALF + wc * 32 + 8 * fq;
            const f32x4 g0 = *(const f32x4*)(gate + (size_t)b * 3072 + c), g1 = *(const f32x4*)(gate + (size_t)b * 3072 + c + 4);
#pragma unroll
            for (int ai = 0; ai < 2; ++ai)
#pragma unroll
                for (int m = 0; m < 4; ++m) { const int row = row0 + ai * HALF + m * 16; const size_t off = (size_t)row * D + c;
                    const f32x4 r0 = *(const f32x4*)(res + off), r1 = *(const f32x4*)(res + off + 4);
                    *(f32x4*)(out + off) = r0 + (g0 * s3[ai][m]) * acc[ai][bj][m][0]; *(f32x4*)(out + off + 4) = r1 + (g1 * s3[ai][m]) * acc[ai][bj][m][1]; } }
    }
};
}

struct MapWin { __device__ __forceinline__ int operator()(int n) const {
    if (n < 1120) return n; if (n < 2048) return n + 4; if (n < 2688) return n + 8; if (n < 3712) return n + 20;
    if (n < 3716) return 1120 + (n - 3712); if (n < 3720) return 2052 + (n - 3716); if (n < 3732) return 2696 + (n - 3720); return -1; } };
struct MapId { int N; __device__ __forceinline__ int operator()(int n) const { return n < N ? n : -1; } };
struct MapUq { __device__ __forceinline__ int operator()(int n) const { if (n >= 384) return -1; const int hd = n / 96, w = n % 96; if (w < 64) return hd * 96 + w;
    const int p = (w - 64) >> 1, which = (w - 64) & 1; return hd * 96 + 64 + (which ? 16 + p : p); } };

template <class ColMap>
__device__ __forceinline__ void tr_tile(const float* src, int lds_src, int Ksrc, const float* kscale, bf16_t* dst, int ldd, int n0, int k0, ColMap cm, LAS float* scr, int wid0) {
    const int tid = opaque_tid(wid0);
#pragma unroll
    for (int i = 0; i < 8; ++i) { const int idx = tid + i * NTHREADS, kk = idx >> 6, nn = idx & 63; const int sc = cm(n0 + nn), k = k0 + kk;
        float v = 0.f; if (sc >= 0 && k < Ksrc) { v = src[(size_t)k * lds_src + sc]; if (kscale) v *= kscale[k]; }
        scr[kk * 65 + nn] = v; }
    __syncthreads();
    { const int nn = tid >> 3, kc = tid & 7; const LAS float* s = scr + (kc * 8) * 65 + nn;
      u32x4 w; w.x = pk2(s[0], s[65]); w.y = pk2(s[2 * 65], s[3 * 65]); w.z = pk2(s[4 * 65], s[5 * 65]); w.w = pk2(s[6 * 65], s[7 * 65]);
      *(u32x4*)(dst + (size_t)(n0 + nn) * ldd + k0 + kc * 8) = w; }
    __syncthreads();
}

__device__ __forceinline__ void phase_prologue(const Params& P, LAS unsigned char* lds, int bid, int G, int wid0) {
    const int tid = opaque_tid(wid0);
    LAS float* scr = (LAS float*)lds;
    const float* w_in = P.in[5]; const float* w_uq = P.in[7]; const float* w_ukv = P.in[9]; const float* w1 = P.in[12]; const float* w_out = P.in[15];
    constexpr int T_WIN = 60 * 16, T_WOUT = 16 * 16, T_UQ = 8 * 4, T_UKV = 8 * 2, T_W1 = 1 * 32 * 2;
    constexpr int T_L = T_WIN + T_WOUT + T_UQ + T_UKV + T_W1;
    for (int it = bid; it < DEPTH * T_L; it += G) {
        const int l = it / T_L; int r = it % T_L;
        if (r < T_WIN) { tr_tile(w_in + (size_t)l * D * 3732, 3732, D, nullptr, (bf16_t*)(P.ws + WS_WIN) + (size_t)l * NP * D, D, (r / 16) * 64, (r % 16) * 64, MapWin{}, scr, wid0); continue; } r -= T_WIN;
        if (r < T_WOUT) { tr_tile(w_out + (size_t)l * D * D, D, D, nullptr, (bf16_t*)(P.ws + WS_WOUT) + (size_t)l * D * D, D, (r / 16) * 64, (r % 16) * 64, MapId{D}, scr, wid0); continue; } r -= T_WOUT;
        if (r < T_UQ) { tr_tile(w_uq + (size_t)l * 192 * 384, 384, 192, P.in[6] + l * 192, (bf16_t*)(P.ws + WS_WUQ) + (size_t)l * 512 * 256, 256, (r / 4) * 64, (r % 4) * 64, MapUq{}, scr, wid0); continue; } r -= T_UQ;
        if (r < T_UKV) { tr_tile(w_ukv + (size_t)l * 128 * 512, 512, 128, P.in[8] + l * 128, (bf16_t*)(P.ws + WS_WUKV) + (size_t)l * 512 * 128, 128, (r / 2) * 64, (r % 2) * 64, MapId{512}, scr, wid0); continue; } r -= T_UKV;
        { const int kv = r / 32, kt = r % 32; tr_tile(w1 + (size_t)(l * 2 + kv) * 2048 * 64, 64, 2048, nullptr, (bf16_t*)(P.ws + WS_W1T) + (size_t)(l * 2 + kv) * 64 * 2048, 2048, 0, kt * 64, MapId{64}, scr, wid0); }
    }
    {
        LAS float* sc = (LAS float*)lds;
        LAS float* red = (LAS float*)(lds + 16384);
        const float* c = P.in[1]; const float* w_ada = P.in[3]; const float* b_ada = P.in[4]; float* mod = (float*)(P.ws + WS_MOD);
        bool loaded = false;
        for (int it = bid; it < DEPTH * 48; it += G) {
            if (!loaded) { for (int i = tid; i < 4096; i += NTHREADS) sc[i] = silu_f(c[i]); loaded = true; __syncthreads(); }
            const int l = it / 48, cb = it % 48, col = tid & 63, ks = tid >> 6;
            const float* wp = w_ada + (size_t)l * D * 3072 + (size_t)(ks * 128) * 3072 + cb * 64 + col;
            float a0 = 0.f, a1 = 0.f, a2 = 0.f, a3 = 0.f;
#pragma unroll 8
            for (int k = 0; k < 128; ++k) { const float w = wp[(size_t)k * 3072]; const int kk = ks * 128 + k;
                a0 += sc[kk] * w; a1 += sc[1024 + kk] * w; a2 += sc[2048 + kk] * w; a3 += sc[3072 + kk] * w; }
            red[(ks * 64 + col) * 4 + 0] = a0; red[(ks * 64 + col) * 4 + 1] = a1; red[(ks * 64 + col) * 4 + 2] = a2; red[(ks * 64 + col) * 4 + 3] = a3;
            __syncthreads();
            if (tid < 256) { const int cc = tid & 63, b = tid >> 6; float s = b_ada[l * 3072 + cb * 64 + cc];
#pragma unroll
                for (int k8 = 0; k8 < 8; ++k8) s += red[(k8 * 64 + cc) * 4 + b];
                mod[(size_t)(l * 4 + b) * 3072 + cb * 64 + cc] = s; }
            __syncthreads();
        }
    }
    {
        float* tab = (float*)(P.ws + WS_ROPE);
        for (int idx = bid * NTHREADS + tid; idx < S * 16; idx += G * NTHREADS) {
            const int pos = idx >> 4, i = idx & 15;
            const double f4[4] = {1.0, 0.5623413251903491, 0.31622776601683794, 0.1778279410038923};
            double inv = (i & 3) == 0 ? f4[0] : ((i & 3) == 1 ? f4[1] : ((i & 3) == 2 ? f4[2] : f4[3]));
            inv *= ((i >> 2) == 0 ? 1.0 : ((i >> 2) == 1 ? 0.1 : ((i >> 2) == 2 ? 0.01 : 0.001)));
            const float invf = (float)inv; const float angf = (float)pos * invf;
            const double rev = (double)angf * 0.15915494309189535; const double fr = rev - __builtin_floor(rev);
            const float f = (float)fr;
            tab[(size_t)idx * 2] = __builtin_amdgcn_cosf(f); tab[(size_t)idx * 2 + 1] = __builtin_amdgcn_sinf(f);
        }
    }
    {
        const float* pos = P.in[11]; float* cvec = (float*)(P.ws + WS_CVEC);
        LAS float* red = (LAS float*)(lds + 65536);
        for (int it = bid; it < DEPTH * 2; it += G) {
            __syncthreads();
            const int col = tid & 63, ks = tid >> 6; float a = 0.f;
            const float* wp = w1 + (size_t)it * 2048 * 64 + (size_t)(ks * 256) * 64 + col; const float* pp = pos + (size_t)it * 2048 + ks * 256;
            for (int k = 0; k < 256; ++k) a += pp[k] * wp[(size_t)k * 64];
            red[ks * 64 + col] = a; __syncthreads();
            if (tid < 64) { float s = 0.f; for (int k8 = 0; k8 < 8; ++k8) s += red[k8 * 64 + tid]; cvec[it * 64 + tid] = s; }
            __syncthreads();
        }
    }
}

__device__ __forceinline__ void phase_hnorm(const float* x, const float* g, const float* mod  , bf16_t* h, int bid, int G, int wid0) {
    const int tid_ = opaque_tid(wid0); const int lane = tid_ & 63, wv = tid_ >> 6;
    for (int row = bid * 8 + wv; row < M; row += G * 8) {
        const f32x4* xr = (const f32x4*)(x + (size_t)row * D) + lane;
        f32x4 v[4]; float s = 0.f;
#pragma unroll
        for (int j = 0; j < 4; ++j) { v[j] = xr[64 * j]; s += (v[j][0] * v[j][0] + v[j][1] * v[j][1]) + (v[j][2] * v[j][2] + v[j][3] * v[j][3]); }
        const float rstd = 1.0f / sqrtf(wave_sum(s) * (1.f / D) + EPS);
        const int b = row / S; const float* sh = mod + (size_t)b * 3072; const float* scl = sh + 1024;
        unsigned long long* o8 = (unsigned long long*)(h + (size_t)row * D) + lane;
#pragma unroll
        for (int j = 0; j < 4; ++j) { const int c = (64 * j + lane) * 4; const f32x4 gg = *(const f32x4*)(g + c), ss = *(const f32x4*)(scl + c), hh = *(const f32x4*)(sh + c);
            f32x4 y;
#pragma unroll
            for (int e = 0; e < 4; ++e) y[e] = v[j][e] * rstd * gg[e] * (1.0f + ss[e]) + hh[e];
            o8[64 * j] = (unsigned long long)pk2(y[0], y[1]) | ((unsigned long long)pk2(y[2], y[3]) << 32); }
    }
}

__device__ __forceinline__ void phase_prep(const Params& P, int l, LAS unsigned char* lds, int bid, int G, int wid0) {
    const int tid = opaque_tid(wid0), lane = tid & 63, wv = tid >> 6;
    const bf16_t* proj = (const bf16_t*)(P.ws + WS_PROJ); const float* side = (const float*)(P.ws + WS_SIDE);
    {
        float* rstd = (float*)(P.ws + WS_RSTD); bf16_t* kmla = (bf16_t*)(P.ws + WS_KMLA); const float* rope = (const float*)(P.ws + WS_ROPE);
        const bool shift_ = (G == 256 && M == 32768);
        const int nk_ = shift_ ? ((bid < 128) ? 16 - PREP_SHIFT : 16 + PREP_SHIFT) : (M + G * 8 - 1) / (G * 8);
        for (int k_ = 0; k_ < nk_; ++k_) {
            const int row = (shift_ && k_ >= 16) ? (bid - 128) * 8 + wv + (16 - PREP_SHIFT + (k_ - 16)) * G * 8 : bid * 8 + wv + k_ * G * 8;
            if (row >= M) break;
            const bf16_t* pr = proj + (size_t)row * NP;
            float sq = 0.f, skv = 0.f;
            if (lane < 40) { const u32x4 w = *(const u32x4*)(pr + lane * 8); float s = 0.f;
#pragma unroll
                for (int e = 0; e < 4; ++e) { const float a = bflo(w[e]), b = bfhi(w[e]); s += a * a + b * b; }
                if (lane < 24) sq = s; else skv = s; }
            sq = wave_sum(sq); skv = wave_sum(skv);
            if (lane == 0) { rstd[(size_t)row * 2] = 1.0f / sqrtf(sq * (1.f / 192.f) + EPS); rstd[(size_t)row * 2 + 1] = 1.0f / sqrtf(skv * (1.f / 128.f) + EPS); }
            if (lane >= 48 && lane < 52) *(u32x4*)((bf16_t*)(P.ws + WS_KIDX) + (size_t)row * 32 + (lane - 48) * 8) = *(const u32x4*)(pr + C_IK + (lane - 48) * 8);
            if (lane < 16) { const float x1 = bf2f(pr[C_KROPE + lane]), x2 = bf2f(pr[C_KROPE + 16 + lane]); const int pos = row & (S - 1);
                const float cs = rope[((size_t)pos * 16 + lane) * 2], sn = rope[((size_t)pos * 16 + lane) * 2 + 1];
                const unsigned w = pk2(x1 * cs - x2 * sn, x1 * sn + x2 * cs);
#pragma unroll
                for (int hd = 0; hd < 4; ++hd) *(unsigned*)(kmla + (size_t)row * 384 + hd * 96 + 64 + 2 * lane) = w; }
        }
    }
    {
        float* fb = (float*)(P.ws + WS_FB); const float* b_f = P.in[10] + l * 4; LAS float* wtot = (LAS float*)lds;
        for (int it = (G >= 160) ? bid - (G - 16) : bid; it < 16; it += G) {
            if (it < 0) break;
            const int b = it >> 2, hd = it & 3; const float bf = b_f[hd];
            float ls[16]; float s = 0.f;
#pragma unroll
            for (int i = 0; i < 16; ++i) { const int t = tid * 16 + i; const float v = side[((size_t)b * S + t) * 32 + hd] + bf;
                const float y = fminf(v, 0.f) - log1pf(__expf(-fabsf(v))); ls[i] = y; s += y; }
            float inc = s;
#pragma unroll
            for (int o = 1; o < 64; o <<= 1) { const float t = __shfl_up(inc, o); if (lane >= o) inc += t; }
            __syncthreads();
            if (lane == 63) wtot[wv] = inc;
            __syncthreads();
            float base = 0.f;
            for (int w = 0; w < wv; ++w) base += wtot[w];
            float run = base + inc - s;
#pragma unroll
            for (int i = 0; i < 16; ++i) { run += ls[i]; fb[((size_t)it) * S + tid * 16 + i] = -8.0f * run; }
            __syncthreads();
        }
    }
    {
        const bf16_t* w1t = (const bf16_t*)(P.ws + WS_W1T) + (size_t)l * 2 * 64 * 2048; const float* cvec = (const float*)(P.ws + WS_CVEC) + l * 2 * 64;
        const float* w2 = P.in[13] + (size_t)l * 2 * 64 * 64;
        LAS float* part = (LAS float*)lds;
        LAS float* hb = (LAS float*)(lds + 65536);
        const int r = lane & 31, hi = lane >> 5;
        for (int it = bid; it < 128; it += G) {
            const int b = it >> 5, kv = (it >> 4) & 1, nt = it & 15, n0 = nt * 32;
            const int colbase = kv ? C_VCMP : C_KCMP;
            const bf16_t* w1k = w1t + (size_t)kv * 64 * 2048;
            f32x16 a0 = {}, a1 = {};
#pragma unroll
            for (int j = 0; j < 4; ++j) { const int tok = wv * 4 + j;
                const bf16_t* ap = proj + ((size_t)b * S + 16 * (n0 + r) + tok) * NP + colbase + hi * 8;
#pragma unroll
                for (int s = 0; s < 4; ++s) { const bf16x8 af = *(const bf16x8*)(ap + s * 16);
                    const int kb = tok * 64 + s * 16 + hi * 8;
                    const bf16x8 b0 = *(const bf16x8*)(w1k + (size_t)r * 2048 + kb), b1 = *(const bf16x8*)(w1k + (size_t)(32 + r) * 2048 + kb);
                    a0 = __builtin_amdgcn_mfma_f32_32x32x16_bf16(af, b0, a0, 0, 0, 0); a1 = __builtin_amdgcn_mfma_f32_32x32x16_bf16(af, b1, a1, 0, 0, 0); } }
#pragma unroll
            for (int reg = 0; reg < 16; ++reg) { const int n = crow(reg, hi); part[(wv * 32 + n) * 64 + r] = a0[reg]; part[(wv * 32 + n) * 64 + 32 + r] = a1[reg]; }
            __syncthreads();
            { const int n = tid >> 4, c4 = (tid & 15) * 4;
#pragma unroll
              for (int e = 0; e < 4; ++e) { float s = cvec[kv * 64 + c4 + e];
#pragma unroll
                  for (int w = 0; w < 8; ++w) s += part[(w * 32 + n) * 64 + c4 + e];
                  hb[n * 64 + c4 + e] = silu_f(s); } }
            __syncthreads();
            { const int n = tid >> 4, c4 = (tid & 15) * 4; float o[4] = {0.f, 0.f, 0.f, 0.f}; const float* w2k = w2 + (size_t)kv * 64 * 64;
              for (int k = 0; k < 64; ++k) { const float hv = hb[n * 64 + k]; const f32x4 wv4 = *(const f32x4*)(w2k + k * 64 + c4);
                  o[0] += hv * wv4[0]; o[1] += hv * wv4[1]; o[2] += hv * wv4[2]; o[3] += hv * wv4[3]; }
              bf16_t* dst = (bf16_t*)(P.ws + (kv ? WS_VC : WS_KC)) + ((size_t)b * 512 + n0 + n) * 64 + c4;
              const bool valid = (n0 + n) < 511;
              u32x2 w; w.x = valid ? pk2(o[0], o[1]) : 0u; w.y = valid ? pk2(o[2], o[3]) : 0u; *(u32x2*)dst = w; }
            __syncthreads();
        }
    }
}

constexpr float NEG_BIG = -1e30f;
constexpr int KSTR64 = 144, KSTR96 = 208;
constexpr int ATT_KBUF = 64 * KSTR96;
constexpr int ATT_VBUF = 8192;
constexpr int ATT_K0 = 0, ATT_V0 = 2 * ATT_KBUF, ATT_B0 = ATT_V0 + 2 * ATT_VBUF, ATT_END = ATT_B0 + 2 * 256;
constexpr int ATT_EXTRA = 45056;

struct SoftState { float m, l; f32x16 o0, o1; };

template <int KS>
__device__ __forceinline__ void qk_tile(f32x16& p0, f32x16& p1, const LAS unsigned char* kt, int kstride, const bf16x8 (&qf)[KS], int r, int hi) {
    const LAS unsigned char* k0 = kt + r * kstride + hi * 16; const LAS unsigned char* k1 = k0 + 32 * kstride;
#pragma unroll
    for (int s = 0; s < KS; ++s) { const bf16x8 a0 = *(const LAS bf16x8*)(k0 + s * 32), a1 = *(const LAS bf16x8*)(k1 + s * 32);
        p0 = __builtin_amdgcn_mfma_f32_32x32x16_bf16(a0, qf[s], p0, 0, 0, 0); p1 = __builtin_amdgcn_mfma_f32_32x32x16_bf16(a1, qf[s], p1, 0, 0, 0); }
}
__device__ __forceinline__ float max3f(float a, float b, float c);
__device__ __forceinline__ float tile_max(const f32x16& p0, const f32x16& p1) {
    float a = max3f(p0[0], p0[1], p1[0]), b = max3f(p0[2], p0[3], p1[1]); a = max3f(a, p1[2], p1[3]);
#pragma unroll
    for (int i = 4; i < 16; i += 4) { a = max3f(a, p0[i], p0[i + 1]); b = max3f(b, p0[i + 2], p0[i + 3]); a = max3f(a, p1[i], p1[i + 1]); b = max3f(b, p1[i + 2], p1[i + 3]); }
    a = max3f(a, b, b);
    const auto rr = __builtin_amdgcn_permlane32_swap(__float_as_uint(a), __float_as_uint(a), false, false);
    return fmaxf(__uint_as_float(rr[0]), __uint_as_float(rr[1]));
}
__device__ __forceinline__ bf16x8 vfrag(const LAS unsigned char* p) {
    const s16x4 lo = __builtin_bit_cast(s16x4, __builtin_amdgcn_ds_read_tr16_b64_v4i16((LAS s16x4*)p));
    const s16x4 hi = __builtin_bit_cast(s16x4, __builtin_amdgcn_ds_read_tr16_b64_v4i16((LAS s16x4*)(p + 512)));
    return (bf16x8){lo[0], lo[1], lo[2], lo[3], hi[0], hi[1], hi[2], hi[3]};
}
__device__ __forceinline__ bf16x8 pfrag(const f32x16& p, int b) {
    u32x4 w; w.x = pk2(p[b], p[b + 1]); w.y = pk2(p[b + 2], p[b + 3]); w.z = pk2(p[b + 4], p[b + 5]); w.w = pk2(p[b + 6], p[b + 7]);
    return __builtin_bit_cast(bf16x8, w);
}
__device__ __forceinline__ void pv_frag(f32x16& o0, f32x16& o1, bf16x8 pf0, bf16x8 pf1, bf16x8 pf2, bf16x8 pf3, const LAS unsigned char* vt, int vb) {
    const LAS unsigned char* v = vt + vb;
    o0 = __builtin_amdgcn_mfma_f32_32x32x16_bf16(vfrag(v), pf0, o0, 0, 0, 0);            o1 = __builtin_amdgcn_mfma_f32_32x32x16_bf16(vfrag(v + 4096), pf0, o1, 0, 0, 0);
    o0 = __builtin_amdgcn_mfma_f32_32x32x16_bf16(vfrag(v + 1024), pf1, o0, 0, 0, 0);     o1 = __builtin_amdgcn_mfma_f32_32x32x16_bf16(vfrag(v + 4096 + 1024), pf1, o1, 0, 0, 0);
    o0 = __builtin_amdgcn_mfma_f32_32x32x16_bf16(vfrag(v + 2048), pf2, o0, 0, 0, 0);     o1 = __builtin_amdgcn_mfma_f32_32x32x16_bf16(vfrag(v + 4096 + 2048), pf2, o1, 0, 0, 0);
    o0 = __builtin_amdgcn_mfma_f32_32x32x16_bf16(vfrag(v + 3072), pf3, o0, 0, 0, 0);     o1 = __builtin_amdgcn_mfma_f32_32x32x16_bf16(vfrag(v + 4096 + 3072), pf3, o1, 0, 0, 0);
}
__device__ __forceinline__ void pv_tile(f32x16& o0, f32x16& o1, const f32x16& p0, const f32x16& p1, const LAS unsigned char* vt, int vb) {
    pv_frag(o0, o1, pfrag(p0, 0), pfrag(p0, 8), pfrag(p1, 0), pfrag(p1, 8), vt, vb);
}
__device__ __forceinline__ void softmax_step(SoftState& st, f32x16& p0, f32x16& p1, float c2) {
    const float mx = tile_max(p0, p1);
    const float mn = fmaxf(st.m, mx);
    if (__any(mn > st.m)) { const float al = __builtin_amdgcn_exp2f((st.m - mn) * c2); st.l *= al; st.o0 *= al; st.o1 *= al; st.m = mn; }
    const float mc = st.m * c2; float sum = 0.f;
#pragma unroll
    for (int i = 0; i < 16; ++i) { p0[i] = __builtin_amdgcn_exp2f(__builtin_fmaf(p0[i], c2, -mc)); p1[i] = __builtin_amdgcn_exp2f(__builtin_fmaf(p1[i], c2, -mc)); sum += p0[i] + p1[i]; }
    st.l += sum;
}

__device__ __forceinline__ float max3f(float a, float b, float c) { float r; asm("v_max3_f32 %0, %1, %2, %3" : "=v"(r) : "v"(a), "v"(b), "v"(c)); return r; }
__device__ __forceinline__ float swap32_max(float a) { const auto rr = __builtin_amdgcn_permlane32_swap(__float_as_uint(a), __float_as_uint(a), false, false);
    float r; asm("v_max_f32_e32 %0, %1, %2" : "=v"(r) : "v"(__uint_as_float(rr[0])), "v"(__uint_as_float(rr[1]))); return r; }
__device__ __forceinline__ float quad_xor1(float x) { return __builtin_bit_cast(float, __builtin_amdgcn_update_dpp(0, __builtin_bit_cast(int, x), 0xB1, 0xf, 0xf, false)); }
__device__ __forceinline__ float quad_xor2(float x) { return __builtin_bit_cast(float, __builtin_amdgcn_update_dpp(0, __builtin_bit_cast(int, x), 0x4E, 0xf, 0xf, false)); }
__device__ __forceinline__ float swap32_sum(float a) { const auto rr = __builtin_amdgcn_permlane32_swap(__float_as_uint(a), __float_as_uint(a), false, false); return __uint_as_float(rr[0]) + __uint_as_float(rr[1]); }
constexpr float SM_THR = 8.0f;
__device__ __forceinline__ void softmax_pack(SoftState& st, const f32x16& p0, const f32x16& p1, float c2, bf16x8& pf0, bf16x8& pf1, bf16x8& pf2, bf16x8& pf3) {
    float a = max3f(p0[0], p0[1], p1[0]), b = max3f(p0[2], p0[3], p1[1]); a = max3f(a, p1[2], p1[3]);
#pragma unroll
    for (int i = 4; i < 16; i += 4) { a = max3f(a, p0[i], p0[i + 1]); b = max3f(b, p0[i + 2], p0[i + 3]); a = max3f(a, p1[i], p1[i + 1]); b = max3f(b, p1[i + 2], p1[i + 3]); }
    float mx; asm("v_max_f32_e32 %0, %1, %2" : "=v"(mx) : "v"(a), "v"(b));
    mx = swap32_max(mx);
    if (__any((mx - st.m) * c2 > SM_THR)) { const float mn = fmaxf(st.m, mx); const float al = __builtin_amdgcn_exp2f((st.m - mn) * c2); st.l *= al; st.o0 *= al; st.o1 *= al; st.m = mn; }
    const float mc = -st.m * c2; float s0 = 0.f, s1 = 0.f;
    u32x4 w0, w1, w2, w3;
#define SMP(W, E, P, B) do { const float e0_ = __builtin_amdgcn_exp2f(__builtin_fmaf(P[B], c2, mc)), e1_ = __builtin_amdgcn_exp2f(__builtin_fmaf(P[B + 1], c2, mc)); s0 += e0_; s1 += e1_; W[E] = pk2(e0_, e1_); } while (0)
    SMP(w0, 0, p0, 0); SMP(w0, 1, p0, 2); SMP(w0, 2, p0, 4); SMP(w0, 3, p0, 6);
    SMP(w1, 0, p0, 8); SMP(w1, 1, p0, 10); SMP(w1, 2, p0, 12); SMP(w1, 3, p0, 14);
    SMP(w2, 0, p1, 0); SMP(w2, 1, p1, 2); SMP(w2, 2, p1, 4); SMP(w2, 3, p1, 6);
    SMP(w3, 0, p1, 8); SMP(w3, 1, p1, 10); SMP(w3, 2, p1, 12); SMP(w3, 3, p1, 14);
#undef SMP
    st.l += s0 + s1;
    pf0 = __builtin_bit_cast(bf16x8, w0); pf1 = __builtin_bit_cast(bf16x8, w1); pf2 = __builtin_bit_cast(bf16x8, w2); pf3 = __builtin_bit_cast(bf16x8, w3);
}

__device__ __forceinline__ void sm_exp_pack(SoftState& st, const f32x16& p0, const f32x16& p1, float c2, bf16x8& pf0, bf16x8& pf1, bf16x8& pf2, bf16x8& pf3) {
    const float mc = -st.m * c2; float s0 = 0.f, s1 = 0.f;
    u32x4 w0, w1, w2, w3;
#define SMP(W, E, P, B) do { const float e0_ = __builtin_amdgcn_exp2f(__builtin_fmaf(P[B], c2, mc)), e1_ = __builtin_amdgcn_exp2f(__builtin_fmaf(P[B + 1], c2, mc)); s0 += e0_; s1 += e1_; W[E] = pk2(e0_, e1_); } while (0)
    SMP(w0, 0, p0, 0); SMP(w0, 1, p0, 2); SMP(w0, 2, p0, 4); SMP(w0, 3, p0, 6);
    SMP(w1, 0, p0, 8); SMP(w1, 1, p0, 10); SMP(w1, 2, p0, 12); SMP(w1, 3, p0, 14);
    SMP(w2, 0, p1, 0); SMP(w2, 1, p1, 2); SMP(w2, 2, p1, 4); SMP(w2, 3, p1, 6);
    SMP(w3, 0, p1, 8); SMP(w3, 1, p1, 10); SMP(w3, 2, p1, 12); SMP(w3, 3, p1, 14);
#undef SMP
    st.l += s0 + s1;
    pf0 = __builtin_bit_cast(bf16x8, w0); pf1 = __builtin_bit_cast(bf16x8, w1); pf2 = __builtin_bit_cast(bf16x8, w2); pf3 = __builtin_bit_cast(bf16x8, w3);
}

template <int DK> struct StageRegs { u32x4 k0, k1, v; float b; };
template <int DK>
__device__ __forceinline__ void stage_load(StageRegs<DK>& sr, const bf16_t* K, int ldk, const bf16_t* V, int ldv, const float* bias, int kv0, int wid0) {
    const int tid = opaque_tid(wid0); constexpr int CPR = DK / 8;
    { const int row = tid / CPR, cc = tid % CPR; sr.k0 = *(const u32x4*)(K + (size_t)(kv0 + row) * ldk + cc * 8); }
    if (DK == 96 && tid < 256) { const int c = tid + 512, row = c / CPR, cc = c % CPR; sr.k1 = *(const u32x4*)(K + (size_t)(kv0 + row) * ldk + cc * 8); }
    { const int row = tid >> 3, cc = tid & 7; sr.v = *(const u32x4*)(V + (size_t)(kv0 + row) * ldv + cc * 8); }
    if (bias && tid < 64) sr.b = bias[kv0 + tid];
}
template <int DK>
__device__ __forceinline__ void stage_store(const StageRegs<DK>& sr, LAS unsigned char* lds, int buf, bool has_bias, int wid0) {
    const int tid = opaque_tid(wid0); constexpr int CPR = DK / 8; constexpr int KSTR = (DK == 96) ? KSTR96 : KSTR64;
    LAS unsigned char* kb = lds + ATT_K0 + buf * ATT_KBUF; LAS unsigned char* vb = lds + ATT_V0 + buf * ATT_VBUF;
    { const int row = tid / CPR, cc = tid % CPR; *(LAS u32x4*)(kb + row * KSTR + cc * 16) = sr.k0; }
    if (DK == 96 && tid < 256) { const int c = tid + 512, row = c / CPR, cc = c % CPR; *(LAS u32x4*)(kb + row * KSTR + cc * 16) = sr.k1; }
    { const int row = tid >> 3, cc = tid & 7; *(LAS u32x4*)(vb + (cc >> 2) * 4096 + row * 64 + (cc & 3) * 16) = sr.v; }
    if (has_bias && tid < 64) *(LAS float*)(lds + ATT_B0 + buf * 256 + tid * 4) = sr.b;
}

__device__ __forceinline__ void store_out(bf16_t* dst  , const f32x16& o0, const f32x16& o1, float scale, int hi) {
#pragma unroll
    for (int g = 0; g < 4; ++g) {
        u32x2 w; w.x = pk2(o0[4 * g] * scale, o0[4 * g + 1] * scale); w.y = pk2(o0[4 * g + 2] * scale, o0[4 * g + 3] * scale);
        *(u32x2*)(dst + 8 * g + 4 * hi) = w;
        u32x2 w1; w1.x = pk2(o1[4 * g] * scale, o1[4 * g + 1] * scale); w1.y = pk2(o1[4 * g + 2] * scale, o1[4 * g + 3] * scale);
        *(u32x2*)(dst + 32 + 8 * g + 4 * hi) = w1;
    }
}

__device__ __forceinline__ float store_out_fused(bf16_t* dst, const bf16_t* zp, const float* gp, const f32x16& o0, const f32x16& o1, float scale, int hi) {
    float ssq = 0.f;
#pragma unroll
    for (int g = 0; g < 4; ++g) {
#pragma unroll
        for (int d0 = 0; d0 < 2; ++d0) { const int c = 32 * d0 + 8 * g + 4 * hi; const u32x2 zz = *(const u32x2*)(zp + c); const f32x4 gg = *(const f32x4*)(gp + c);
            const float z0 = bflo(zz.x), z1 = bfhi(zz.x), z2 = bflo(zz.y), z3 = bfhi(zz.y);
            const float v0 = (d0 ? o1[4 * g] : o0[4 * g]) * scale, v1 = (d0 ? o1[4 * g + 1] : o0[4 * g + 1]) * scale, v2 = (d0 ? o1[4 * g + 2] : o0[4 * g + 2]) * scale, v3 = (d0 ? o1[4 * g + 3] : o0[4 * g + 3]) * scale;
            ssq += (v0 * v0 + v1 * v1) + (v2 * v2 + v3 * v3);
            u32x2 w; w.x = pk2(v0 * gg[0] * silu_fast(z0), v1 * gg[1] * silu_fast(z1)); w.y = pk2(v2 * gg[2] * silu_fast(z2), v3 * gg[3] * silu_fast(z3));
            *(u32x2*)(dst + c) = w; }
    }
    return ssq;
}

constexpr int DA_K0 = 0, DA_V0 = 3 * ATT_KBUF, DA_B0 = DA_V0 + 2 * ATT_VBUF, DA_END = DA_B0 + 3 * 256;
static_assert(DA_END <= LDS_BYTES, "dense attention LDS map");
template <int DK, int MODE>
__device__ __forceinline__ void dense_unit(LAS unsigned char* lds, const bf16_t* Q, int ldq, const bf16_t* K, int ldk, const bf16_t* V, int ldv,
                                           bf16_t* O  , const float* bias, const unsigned long long* maskbits  ,
                                           float alibiA, float c2, int qb, int wid0, const bf16_t* Zg, const float* Gn, float* ssq  ) {
    constexpr int KS = DK / 16; constexpr int KSTR = (DK == 96) ? KSTR96 : KSTR64; constexpr int CPR = DK / 8;
    const int tid = opaque_tid(wid0), lane = tid & 63, wv = __builtin_amdgcn_readfirstlane(tid >> 6), r = lane & 31, hi = lane >> 5;
    const int q0 = qb * 256, qw0 = q0 + wv * 32, tq = qw0 + r;
    const int NT = (q0 + 256) / 64;
    const int tlast = (qw0 + 31) >> 6;
    bf16x8 qf[KS];
#pragma unroll
    for (int s = 0; s < KS; ++s) qf[s] = *(const bf16x8*)(Q + (size_t)tq * ldq + s * 16 + hi * 8);
    const int vb = ((lane >> 4) & 1) * 32 + (lane & 3) * 8 + (4 * hi + ((lane & 15) >> 2)) * 64;
    const int kb = r * KSTR + hi * 16;
    SoftState st; st.m = NEG_BIG; st.l = 0.f; st.o0 = (f32x16){}; st.o1 = (f32x16){};
    const int krow0 = tid / CPR, kcc0 = tid % CPR, krow1 = (tid + 512) / CPR, kcc1 = (tid + 512) % CPR, vrow = tid >> 3, vcc = tid & 7;
    const bf16_t* kp0 = K + (size_t)krow0 * ldk + kcc0 * 8; const bf16_t* kp1 = K + (size_t)krow1 * ldk + kcc1 * 8; const bf16_t* vp = V + (size_t)vrow * ldv + vcc * 8;
    const int klds0 = krow0 * KSTR + kcc0 * 16, klds1 = krow1 * KSTR + kcc1 * 16, vlds = (vcc >> 2) * 4096 + vrow * 64 + (vcc & 3) * 16;
    u32x4 rk0, rk1, rv; float rbias = 0.f;
#define DA_LOADK(t) do { rk0 = *(const u32x4*)(kp0 + (size_t)(t) * 64 * ldk); if (DK == 96 && tid < 256) rk1 = *(const u32x4*)(kp1 + (size_t)(t) * 64 * ldk); if (MODE == 1 && tid < 64) rbias = bias[(t) * 64 + tid]; } while (0)
#define DA_LOADV(t) do { rv = *(const u32x4*)(vp + (size_t)(t) * 64 * ldv); } while (0)
#define DA_STOREK(slot) do { LAS unsigned char* kb_ = lds + DA_K0 + (slot) * ATT_KBUF; *(LAS u32x4*)(kb_ + klds0) = rk0; if (DK == 96 && tid < 256) *(LAS u32x4*)(kb_ + klds1) = rk1; \
        if (MODE == 1 && tid < 64) *(LAS float*)(lds + DA_B0 + (slot) * 256 + tid * 4) = rbias; } while (0)
#define DA_STOREV(slot) do { *(LAS u32x4*)(lds + DA_V0 + (slot) * ATT_VBUF + vlds) = rv; } while (0)
#define DA_CINIT(P0, P1, t, slot) do { const int kv0_ = (t) * 64; \
        if (MODE == 0) { P0 = (f32x16){}; P1 = (f32x16){}; } \
        else if (MODE == 1) { const LAS float* bl = (const LAS float*)(lds + DA_B0 + (slot) * 256); \
            _Pragma("unroll") for (int g = 0; g < 4; ++g) { const f32x4 b0_ = *(const LAS f32x4*)(bl + 8 * g + 4 * hi), b1_ = *(const LAS f32x4*)(bl + 32 + 8 * g + 4 * hi); \
                _Pragma("unroll") for (int e = 0; e < 4; ++e) { P0[4 * g + e] = b0_[e]; P1[4 * g + e] = b1_[e]; } } } \
        else { const float base_ = alibiA * (float)(kv0_ + 4 * hi); \
            _Pragma("unroll") for (int i = 0; i < 16; ++i) { P0[i] = base_ + alibiA * (float)((i & 3) + 8 * (i >> 2)); P1[i] = P0[i] + alibiA * 32.0f; } } } while (0)
#define DA_MASK(P0, P1, t, mb) do { const int kv0_ = (t) * 64; \
        if (MODE == 2) { const unsigned long long ms_ = (mb) >> (4 * hi); const unsigned lo_ = (unsigned)ms_, hw_ = (unsigned)(ms_ >> 32); \
            _Pragma("unroll") for (int i = 0; i < 16; ++i) { const unsigned bit_ = 1u << ((i & 3) + 8 * (i >> 2)); if (!(lo_ & bit_)) P0[i] = -INFINITY; if (!(hw_ & bit_)) P1[i] = -INFINITY; } } \
        else if (kv0_ + 63 > qw0) { \
            _Pragma("unroll") for (int i = 0; i < 16; ++i) { const int kv_ = kv0_ + crow(i, hi); if (kv_ > tq) P0[i] = -INFINITY; if (kv_ + 32 > tq) P1[i] = -INFINITY; } } } while (0)
#define DA_ROWMAX(MX, P0, P1) do { float a_ = __builtin_fmaxf(__builtin_fmaxf(P0[0], P0[1]), P1[0]), b_ = __builtin_fmaxf(__builtin_fmaxf(P0[2], P0[3]), P1[1]); a_ = __builtin_fmaxf(__builtin_fmaxf(a_, P1[2]), P1[3]); \
        _Pragma("unroll") for (int i = 4; i < 16; i += 4) { a_ = __builtin_fmaxf(__builtin_fmaxf(a_, P0[i]), P0[i + 1]); b_ = __builtin_fmaxf(__builtin_fmaxf(b_, P0[i + 2]), P0[i + 3]); a_ = __builtin_fmaxf(__builtin_fmaxf(a_, P1[i]), P1[i + 1]); b_ = __builtin_fmaxf(__builtin_fmaxf(b_, P1[i + 2]), P1[i + 3]); } \
        a_ = __builtin_fmaxf(a_, b_); const auto rr_ = __builtin_amdgcn_permlane32_swap(__float_as_uint(a_), __float_as_uint(a_), false, false); \
        MX = __builtin_fmaxf(__uint_as_float(rr_[0]), __uint_as_float(rr_[1])); } while (0)
    __syncthreads();
    DA_LOADK(0); DA_LOADV(0); DA_STOREK(0); DA_STOREV(0);
    DA_LOADK(1); DA_STOREK(1);
    DA_LOADK(2); DA_LOADV(1);
    __syncthreads();
    f32x16 pa0, pa1, pb0, pb1;
    unsigned long long mb_nxt = 0ull, mb_nn = 0ull;
    {
        DA_CINIT(pa0, pa1, 0, 0);
        qk_tile<KS>(pa0, pa1, lds + DA_K0, KSTR, qf, r, hi);
        unsigned long long mb0 = 0ull;
        if (MODE == 2) { mb0 = maskbits[(size_t)tq * 128]; if (1 <= tlast) mb_nxt = maskbits[(size_t)tq * 128 + 1]; }
        DA_MASK(pa0, pa1, 0, mb0);
        float mx; DA_ROWMAX(mx, pa0, pa1);
        st.m = __builtin_fmaxf(st.m, mx);
    }
    int ks_next = 1, ks_store = 2, vs_cur = 0;
#define DA_STEP(C0, C1, N0, N1, t) do { \
        if (MODE == 2) { mb_nn = 0ull; if ((t) + 2 <= tlast) mb_nn = maskbits[(size_t)tq * 128 + (t) + 2]; } \
        if ((t) <= tlast) { \
              \
            DA_CINIT(N0, N1, (t) + 1, ks_next); \
            bf16x8 pf0, pf1, pf2, pf3; \
            bf16x8 kf[2 * KS]; { const LAS unsigned char* k_ = lds + DA_K0 + ks_next * ATT_KBUF + kb; \
                _Pragma("unroll") for (int s_ = 0; s_ < KS; ++s_) { kf[2 * s_] = *(const LAS bf16x8*)(k_ + s_ * 32); kf[2 * s_ + 1] = *(const LAS bf16x8*)(k_ + 32 * KSTR + s_ * 32); } } \
            __builtin_amdgcn_sched_barrier(0); \
            _Pragma("unroll") for (int s_ = 0; s_ < KS; ++s_) { N0 = __builtin_amdgcn_mfma_f32_32x32x16_bf16(kf[2 * s_], qf[s_], N0, 0, 0, 0); N1 = __builtin_amdgcn_mfma_f32_32x32x16_bf16(kf[2 * s_ + 1], qf[s_], N1, 0, 0, 0); } \
            sm_exp_pack(st, C0, C1, c2, pf0, pf1, pf2, pf3); \
            _Pragma("unroll") for (int g_ = 0; g_ < 2 * KS; ++g_) { __builtin_amdgcn_sched_group_barrier(0x8, 1, 0); __builtin_amdgcn_sched_group_barrier(0x2, (KS == 6 ? 9 : 14), 0); } \
            __builtin_amdgcn_sched_barrier(0); \
              \
            bf16x8 vf[8]; { const LAS unsigned char* v_ = lds + DA_V0 + vs_cur * ATT_VBUF + vb; \
                _Pragma("unroll") for (int s_ = 0; s_ < 4; ++s_) { vf[2 * s_] = vfrag(v_ + s_ * 1024); vf[2 * s_ + 1] = vfrag(v_ + 4096 + s_ * 1024); } } \
            __builtin_amdgcn_sched_barrier(0); \
            float mx_ = -INFINITY; \
            if ((t) < tlast) { DA_MASK(N0, N1, (t) + 1, mb_nxt); DA_ROWMAX(mx_, N0, N1); } \
            __builtin_amdgcn_sched_barrier(0); \
            st.o0 = __builtin_amdgcn_mfma_f32_32x32x16_bf16(vf[0], pf0, st.o0, 0, 0, 0); st.o1 = __builtin_amdgcn_mfma_f32_32x32x16_bf16(vf[1], pf0, st.o1, 0, 0, 0); \
            st.o0 = __builtin_amdgcn_mfma_f32_32x32x16_bf16(vf[2], pf1, st.o0, 0, 0, 0); st.o1 = __builtin_amdgcn_mfma_f32_32x32x16_bf16(vf[3], pf1, st.o1, 0, 0, 0); \
            st.o0 = __builtin_amdgcn_mfma_f32_32x32x16_bf16(vf[4], pf2, st.o0, 0, 0, 0); st.o1 = __builtin_amdgcn_mfma_f32_32x32x16_bf16(vf[5], pf2, st.o1, 0, 0, 0); \
            st.o0 = __builtin_amdgcn_mfma_f32_32x32x16_bf16(vf[6], pf3, st.o0, 0, 0, 0); st.o1 = __builtin_amdgcn_mfma_f32_32x32x16_bf16(vf[7], pf3, st.o1, 0, 0, 0); \
            __builtin_amdgcn_sched_barrier(0); \
            if (__any((mx_ - st.m) * c2 > SM_THR)) { const float mn_ = __builtin_fmaxf(st.m, mx_); const float al_ = __builtin_amdgcn_exp2f((st.m - mn_) * c2); st.l *= al_; st.o0 *= al_; st.o1 *= al_; st.m = mn_; } \
        } \
        if ((t) + 2 < NT) DA_STOREK(ks_store); \
        if ((t) + 1 < NT) DA_STOREV(vs_cur ^ 1); \
        if ((t) + 3 < NT) DA_LOADK((t) + 3); \
        if ((t) + 2 < NT) DA_LOADV((t) + 2); \
        __syncthreads(); \
        mb_nxt = mb_nn; vs_cur ^= 1; ks_next = (ks_next == 2) ? 0 : ks_next + 1; ks_store = (ks_store == 2) ? 0 : ks_store + 1; } while (0)
    for (int t = 0; t < NT; t += 2) {
        DA_STEP(pa0, pa1, pb0, pb1, t);
        DA_STEP(pb0, pb1, pa0, pa1, t + 1);
    }
#undef DA_LOADK
#undef DA_LOADV
#undef DA_STOREK
#undef DA_STOREV
#undef DA_CINIT
#undef DA_MASK
#undef DA_ROWMAX
#undef DA_STEP
    const float l = swap32_sum(st.l);
    const float inv = l > 0.f ? 1.0f / l : 0.f;
    const float sq = swap32_sum(store_out_fused(O + (size_t)tq * D, Zg + (size_t)tq * NP, Gn, st.o0, st.o1, inv, hi));
    if (hi == 0) ssq[(size_t)tq * 16] = sq;
}

#define A64_SBAR() __builtin_amdgcn_sched_barrier(0)
#define A64_PIN(x) asm volatile("" : "+v"(x))
#define A64_MFMA(a, b, c) __builtin_amdgcn_mfma_f32_32x32x16_bf16(a, b, c, 0, 0, 0)
constexpr int A64_VSLOT = 8192, A64_K = 0, A64_V = 3 * 12288  , A64_WS = A64_V + 3 * A64_VSLOT, A64_OST = A64_WS + 8 * 256, A64_SIDE = A64_OST + 8 * 4096, A64_END = A64_SIDE + 3 * 2048;
static_assert(A64_END <= LDS_BYTES - 16, "attn64 LDS map");
template <int N> __device__ __forceinline__ void a64_wait_bar() { asm volatile("s_waitcnt vmcnt(%0) lgkmcnt(0)\n\ts_barrier" :: "n"(N) : "memory"); }
__device__ __forceinline__ void a64_glds16(const void* g, unsigned lds_base) {
    unsigned sv; asm volatile("s_mov_b32 %0, m0\n\ts_mov_b32 m0, %2\n\ts_nop 0\n\tglobal_load_lds_dwordx4 %1, off\n\ts_mov_b32 m0, %0" : "=&s"(sv) : "v"(g), "s"(lds_base) : "memory"); }
__device__ __forceinline__ void a64_glds4(const void* g, unsigned lds_base) {
    unsigned sv; asm volatile("s_mov_b32 %0, m0\n\ts_mov_b32 m0, %2\n\ts_nop 0\n\tglobal_load_lds_dword %1, off\n\ts_mov_b32 m0, %0" : "=&s"(sv) : "v"(g), "s"(lds_base) : "memory"); }
__device__ __forceinline__ void a64_kload2(bf16x8* kf, const LAS unsigned char* kp, int d0) { kf[2 * d0] = *(const LAS bf16x8*)(kp + d0 * 2048); kf[2 * d0 + 1] = *(const LAS bf16x8*)(kp + d0 * 2048 + 512); }
__device__ __forceinline__ s16x4 a64_vtr(const LAS unsigned char* p) { return __builtin_bit_cast(s16x4, __builtin_amdgcn_ds_read_tr16_b64_v4i16((LAS s16x4*)p)); }
#define A64_MX3(a, b, c) __builtin_fmaxf(__builtin_fmaxf((a), (b)), (c))
__device__ __forceinline__ float a64_max16(const f32x16& p) {
    float a = A64_MX3(p[0], p[1], p[2]), b = A64_MX3(p[3], p[4], p[5]); a = A64_MX3(a, p[6], p[7]); b = A64_MX3(b, p[8], p[9]); a = A64_MX3(a, p[10], p[11]); b = A64_MX3(b, p[12], p[13]);
    return A64_MX3(a, b, __builtin_fmaxf(p[14], p[15])); }
__device__ __forceinline__ float a64_swapmax(float m) { const auto rr = __builtin_amdgcn_permlane32_swap(__float_as_uint(m), __float_as_uint(m), false, false); return __builtin_fmaxf(__uint_as_float(rr[0]), __uint_as_float(rr[1])); }
__device__ __forceinline__ void a64_cmask(f32x16& p0, f32x16& p1, int jb, int qrel, int hi) {
    const int kb = 64 * jb + 4 * hi;
#pragma unroll
    for (int r = 0; r < 16; ++r) { const int kv = kb + (r & 3) + 8 * (r >> 2); if (kv > qrel) p0[r] = -INFINITY; if (kv + 32 > qrel) p1[r] = -INFINITY; } }
__device__ __forceinline__ void a64_dmask(f32x16& p0, f32x16& p1, unsigned long long mw, int hi) {
    const unsigned long long ms = mw >> (4 * hi); const unsigned lo = (unsigned)ms, hw = (unsigned)(ms >> 32);
#pragma unroll
    for (int i = 0; i < 16; ++i) { const unsigned bit = 1u << ((i & 3) + 8 * (i >> 2)); if (!(lo & bit)) p0[i] = -INFINITY; if (!(hw & bit)) p1[i] = -INFINITY; } }

template <int MODE, int DK>
__device__ __forceinline__ void attn64_unit(LAS unsigned char* lds, const bf16_t* Q, int ldq, const bf16_t* K, int ld  , const bf16_t* V, int ldv,
                                            bf16_t* O  , const float* bias  , const unsigned long long* maskbits  ,
                                            float alibiA, float C2  , int qb, int wid0, const bf16_t* Zg, const float* Gn, float* ssq  ) {
    constexpr float THR = 8.0f; constexpr int KS = DK / 16, KSLOT = (DK == 96) ? 12288 : 8192;
    constexpr int KOPS = ((MODE == 0) ? 1 : 2) + ((DK == 96) ? 1 : 0);
    const int tid = opaque_tid(wid0), lane = tid & 63, r32 = lane & 31, hi = lane >> 5; const int wid = __builtin_amdgcn_readfirstlane(tid >> 6);
    const int q0 = qb * 256, NT = (q0 + 256) / 64, qw0 = q0 + wid * 32;
    const bf16_t* Qw = Q + (size_t)qw0 * ldq;
    const unsigned lds0 = (unsigned)(size_t)lds; LAS float* wsf = (LAS float*)(lds + A64_WS) + wid * 64;
    const bf16_t* ksrc = K + (size_t)lane * ld + wid * 8;
    const bf16_t* ksrc2 = K + (size_t)lane * ld + (8 + (wid & 3)) * 8;
    const bf16_t* vsrc = V + (size_t)(16 * (wid & 3) + (lane >> 2)) * ldv + (wid >> 2) * 32 + (lane & 3) * 8;
    const unsigned* ssrc = (MODE == 1) ? (const unsigned*)(bias + lane) : (MODE == 2) ? (const unsigned*)(maskbits + (size_t)(qw0 + (lane >> 1)) * 128) + (lane & 1) : nullptr;
    constexpr int SSTEP = (MODE == 1) ? 64 : 2;
    const unsigned kdst = lds0 + A64_K + wid * 1024, kdst2 = lds0 + A64_K + (8 + (wid & 3)) * 1024, vdst = lds0 + A64_V + wid * 1024, sdst = lds0 + A64_SIDE + wid * 256;
#define A64_DMA_K(t, slot) do { a64_glds16(ksrc + (size_t)(t) * 64 * ld, (unsigned)__builtin_amdgcn_readfirstlane(kdst + (slot) * KSLOT)); \
        if (DK == 96) a64_glds16(ksrc2 + (size_t)(t) * 64 * ld, (unsigned)__builtin_amdgcn_readfirstlane(kdst2 + (slot) * KSLOT)); \
        if (MODE != 0) a64_glds4(ssrc + (size_t)(t) * SSTEP, (unsigned)__builtin_amdgcn_readfirstlane(sdst + (slot) * 2048)); } while (0)
#define A64_DMA_V(t, slot) a64_glds16(vsrc + (size_t)(t) * 64 * ldv, (unsigned)__builtin_amdgcn_readfirstlane(vdst + (slot) * A64_VSLOT))
    const LAS unsigned char* vp0 = lds + A64_V + ((lane >> 4) & 1) * 32 + (lane & 3) * 8 + (4 * hi + ((lane & 15) >> 2)) * 64;
    const LAS unsigned char* kp0 = lds + A64_K + hi * 1024 + r32 * 16;
    const LAS unsigned char* sp0 = lds + A64_SIDE + wid * 256;
    __syncthreads();
    A64_DMA_K(0, 0); A64_DMA_V(0, 0); A64_DMA_K(1, 1);
    bf16x8 qr[KS];
#pragma unroll
    for (int d0 = 0; d0 < KS; ++d0) qr[d0] = *(const bf16x8*)(Qw + (size_t)r32 * ldq + d0 * 16 + hi * 8);
    float mhat = 0.f, l_reg = 0.f; f32x16 o[2]; o[0] = (f32x16){}; o[1] = (f32x16){};
    f32x16 cini = (f32x16){};
    if (MODE == 2) {
#pragma unroll
        for (int i = 0; i < 16; ++i) cini[i] = alibiA * (float)((i & 3) + 8 * (i >> 2) + 4 * hi); }
    if (MODE != 0) A64_PIN(cini);
    const float ea = (MODE == 2) ? alibiA * C2 : 0.f;
    const int qrel = wid * 32 + r32; bool resc = false;
    f32x16 pA0, pA1, pB0, pB1; bf16x8 kf[2 * KS]; s16x4 vlo[8], vhi[8]; u32x4 pw0, pw1, pw2, pw3;
    int sl_prev = 0, sl_cur = 0, sl_next = 1;
#define A64_ROT() do { sl_prev = sl_cur; sl_cur = sl_next; sl_next = (sl_next == 2) ? 0 : sl_next + 1; } while (0)
#define A64_EX(v, NM) __builtin_amdgcn_exp2f(__builtin_fmaf((v), C2, NM))
#define A64_RESC() do { if (resc) { _Pragma("unroll") for (int d_ = 0; d_ < 2; ++d_) _Pragma("unroll") for (int r = 0; r < 16; ++r) o[d_][r] *= wsf[crow(r, hi)]; } } while (0)
#define A64_CINIT(C0, C1, slot) do { if (MODE == 1) { const LAS float* bl_ = (const LAS float*)(sp0 + (slot) * 2048); \
        _Pragma("unroll") for (int g_ = 0; g_ < 4; ++g_) { const f32x4 b0_ = *(const LAS f32x4*)(bl_ + 8 * g_ + 4 * hi), b1_ = *(const LAS f32x4*)(bl_ + 32 + 8 * g_ + 4 * hi); \
            _Pragma("unroll") for (int e_ = 0; e_ < 4; ++e_) { C0[4 * g_ + e_] = b0_[e_]; C1[4 * g_ + e_] = b1_[e_]; } } } \
        else if (MODE == 0) { C0 = (f32x16){}; C1 = (f32x16){}; }     \
        else { C0 = cini; C1 = cini; } } while (0)
#define A64_ROWREF(C0, C1, t) a64_swapmax(__builtin_fmaxf(__builtin_fmaf(a64_max16(C0), C2, ea * (float)(64 * (t))), __builtin_fmaf(a64_max16(C1), C2, ea * (float)(64 * (t) + 32))))
    A64_DMA_K(2, 2);
    a64_wait_bar<2 * KOPS + 1>();
    _Pragma("unroll") for (int d0 = 0; d0 < KS; ++d0) a64_kload2(kf, kp0, d0);
    { unsigned long long mw0 = 0ull; if (MODE == 2) mw0 = *(const LAS unsigned long long*)(sp0 + r32 * 8);
      A64_CINIT(pA0, pA1, 0);
      _Pragma("unroll") for (int d0 = 0; d0 < KS; ++d0) { pA0 = A64_MFMA(kf[2 * d0], qr[d0], pA0); pA1 = A64_MFMA(kf[2 * d0 + 1], qr[d0], pA1); }
      if (MODE == 2) a64_dmask(pA0, pA1, mw0, hi);
      if (NT == 4) a64_cmask(pA0, pA1, 0, qrel, hi); }
    { mhat = __builtin_fmaxf(A64_ROWREF(pA0, pA1, 0), -1e30f); const float nm0 = -mhat, nm1 = ea * 32.0f - mhat;
#pragma unroll
      for (int r = 0; r < 16; ++r) { pA0[r] = A64_EX(pA0[r], nm0); pA1[r] = A64_EX(pA1[r], nm1); } }
    a64_wait_bar<0>();
    A64_DMA_K(3, 0); A64_DMA_V(1, 1); A64_ROT();
    _Pragma("unroll") for (int d0 = 0; d0 < KS; ++d0) a64_kload2(kf, kp0 + sl_cur * KSLOT, d0);
    if (MODE == 1) A64_CINIT(pB0, pB1, sl_cur);
    a64_wait_bar<KOPS + 1>();
#define A64_PKW(P, i) pk2(P[i], P[i + 1])
#define A64_PAF(k) __builtin_bit_cast(bf16x8, pw##k)
#define A64_VFR(i) (bf16x8){vlo[i][0], vlo[i][1], vlo[i][2], vlo[i][3], vhi[i][0], vhi[i][1], vhi[i][2], vhi[i][3]}
#define A64_VRD(i) do { vlo[i] = a64_vtr(vp_ + (((i) >> 2) * 4096 + ((i) & 3) * 1024)); vhi[i] = a64_vtr(vp_ + (((i) >> 2) * 4096 + ((i) & 3) * 1024 + 512)); } while (0)
#define A64_BRD(G, P0, P1, g_) do { if (MODE == 1 && (G)) { const LAS float* bl_ = (const LAS float*)(sp0 + sl_next * 2048); \
        const f32x4 b0_ = *(const LAS f32x4*)(bl_ + 8 * (g_) + 4 * hi), b1_ = *(const LAS f32x4*)(bl_ + 32 + 8 * (g_) + 4 * hi); \
        _Pragma("unroll") for (int e_ = 0; e_ < 4; ++e_) { P0[4 * (g_) + e_] = b0_[e_]; P1[4 * (g_) + e_] = b1_[e_]; } } } while (0)
#define A64_KRD(G, d0) do { if (G) { a64_kload2(kf, kp0 + sl_next * KSLOT, d0); A64_SBAR(); } } while (0)
#define A64_GAPA(MF, a0, a1, a2, a3, W0, W1, PW) do { MF; sacc += a0; sacc += a1; sacc += a2; sacc += a3; W0; W1; A64_PIN(PW); A64_PIN(sacc); A64_SBAR(); } while (0)
#define A64_GAPB(MF, X, i, NM) do { MF; X[i] = A64_EX(X[i], NM); X[i + 1] = A64_EX(X[i + 1], NM); X[i + 2] = A64_EX(X[i + 2], NM); X[i + 3] = A64_EX(X[i + 3], NM); A64_PIN(X); A64_SBAR(); } while (0)
#define A64_STEP(C0, C1, P0, P1, t, MASK, GK, GV, GL) do { A64_SBAR(); \
    unsigned long long mw_ = 0ull; if (MODE == 2) { mw_ = *(const LAS unsigned long long*)(sp0 + sl_cur * 2048 + r32 * 8); } \
    if (MODE != 1) A64_CINIT(C0, C1, sl_cur);     \
    const LAS unsigned char* vp_ = vp0 + sl_prev * A64_VSLOT; \
    A64_VRD(0); A64_SBAR(); float sacc = P0[0] + P0[1]; \
                    A64_GAPA(C0 = A64_MFMA(kf[0], qr[0], C0), P0[2], P0[3], P0[4], P0[5],     pw0[0] = A64_PKW(P0, 0),  pw0[1] = A64_PKW(P0, 2),  pw0); \
    A64_VRD(4); A64_SBAR(); A64_GAPA(C1 = A64_MFMA(kf[1], qr[0], C1), P0[6], P0[7], P0[8], P0[9],     pw0[2] = A64_PKW(P0, 4),  pw0[3] = A64_PKW(P0, 6),  pw0); \
    A64_VRD(1); A64_SBAR(); A64_GAPA(C0 = A64_MFMA(kf[2], qr[1], C0),    P0[10], P0[11], P0[12], P0[13], pw1[0] = A64_PKW(P0, 8),  pw1[1] = A64_PKW(P0, 10), pw1); \
    A64_VRD(5); A64_SBAR(); A64_GAPA(C1 = A64_MFMA(kf[3], qr[1], C1),    P0[14], P0[15], P1[0], P1[1],   pw1[2] = A64_PKW(P0, 12), pw1[3] = A64_PKW(P0, 14), pw1); \
    A64_VRD(2); A64_SBAR(); A64_GAPA(C0 = A64_MFMA(kf[4], qr[2], C0),    P1[2], P1[3], P1[4], P1[5],     pw2[0] = A64_PKW(P1, 0),  pw2[1] = A64_PKW(P1, 2),  pw2); \
    A64_VRD(6); A64_SBAR(); A64_GAPA(C1 = A64_MFMA(kf[5], qr[2], C1),    P1[6], P1[7], P1[8], P1[9],     pw2[2] = A64_PKW(P1, 4),  pw2[3] = A64_PKW(P1, 6),  pw2); \
    A64_VRD(3); A64_SBAR(); A64_GAPA(C0 = A64_MFMA(kf[6], qr[3], C0),    P1[10], P1[11], P1[12], P1[13], pw3[0] = A64_PKW(P1, 8),  pw3[1] = A64_PKW(P1, 10), pw3); \
    A64_VRD(7); A64_SBAR(); A64_GAPA(C1 = A64_MFMA(kf[7], qr[3], C1),    P1[14], P1[15], 0.f, 0.f,       pw3[2] = A64_PKW(P1, 12), pw3[3] = A64_PKW(P1, 14), pw3); \
    if (KS == 6) { C0 = A64_MFMA(kf[8], qr[4], C0); C1 = A64_MFMA(kf[9], qr[4], C1); C0 = A64_MFMA(kf[10], qr[5], C0); C1 = A64_MFMA(kf[11], qr[5], C1); A64_SBAR(); } \
    l_reg += sacc; \
    if (MODE == 2) { unsigned ml_ = (unsigned)mw_, mh_ = (unsigned)(mw_ >> 32); A64_PIN(ml_); A64_PIN(mh_); mw_ = ((unsigned long long)mh_ << 32) | ml_; }     \
    if (GK) A64_DMA_K((t) + 3, sl_cur); if (GV) A64_DMA_V((t) + 1, sl_next); \
    if (MODE == 2) a64_dmask(C0, C1, mw_, hi); \
    if (MASK) a64_cmask(C0, C1, (t) - (NT - 4), qrel, hi); \
    { const float rs_ = A64_ROWREF(C0, C1, t); resc = false; \
      if (__builtin_expect(__any(rs_ - mhat > THR), 0)) { const float mn_ = __builtin_fmaxf(mhat, rs_); const float f_ = __builtin_amdgcn_exp2f(mhat - mn_); mhat = mn_; \
          l_reg *= f_; if (hi == 0) wsf[r32] = f_; resc = true; } } \
    const float nm0_ = ea * (float)(64 * (t)) - mhat, nm1_ = ea * (float)(64 * (t) + 32) - mhat; A64_SBAR(); \
    A64_GAPB(o[0] = A64_MFMA(A64_PAF(0), A64_VFR(0), o[0]), C0, 0, nm0_);              A64_GAPB(o[1] = A64_MFMA(A64_PAF(0), A64_VFR(4), o[1]), C0, 4, nm0_); \
    A64_KRD(GL, 0); A64_BRD(GL, P0, P1, 0); A64_GAPB(o[0] = A64_MFMA(A64_PAF(1), A64_VFR(1), o[0]), C0, 8, nm0_);  A64_KRD(GL, 1); A64_BRD(GL, P0, P1, 1); A64_GAPB(o[1] = A64_MFMA(A64_PAF(1), A64_VFR(5), o[1]), C0, 12, nm0_); \
    A64_KRD(GL, 2); A64_BRD(GL, P0, P1, 2); A64_GAPB(o[0] = A64_MFMA(A64_PAF(2), A64_VFR(2), o[0]), C1, 0, nm1_);  A64_KRD(GL, 3); A64_BRD(GL, P0, P1, 3); A64_GAPB(o[1] = A64_MFMA(A64_PAF(2), A64_VFR(6), o[1]), C1, 4, nm1_); \
    if (KS == 6) A64_KRD(GL, 4); A64_GAPB(o[0] = A64_MFMA(A64_PAF(3), A64_VFR(3), o[0]), C1, 8, nm1_);  if (KS == 6) A64_KRD(GL, 5); A64_GAPB(o[1] = A64_MFMA(A64_PAF(3), A64_VFR(7), o[1]), C1, 12, nm1_); \
    } while (0)
    int t = 1;
    for (; t + 5 < NT; t += 2) {
        A64_STEP(pB0, pB1, pA0, pA1, t, false, true, true, true);     a64_wait_bar<KOPS + 1>(); A64_RESC(); A64_ROT();
        A64_STEP(pA0, pA1, pB0, pB1, t + 1, false, true, true, true); a64_wait_bar<KOPS + 1>(); A64_RESC(); A64_ROT();
    }
#define A64_ENDW(tt) do { if ((tt) + 3 < NT) { a64_wait_bar<KOPS + 1>(); } else if ((tt) + 2 < NT) { a64_wait_bar<1>(); } else { a64_wait_bar<0>(); } } while (0)
    for (; t + 1 < NT; t += 2) {
        A64_STEP(pB0, pB1, pA0, pA1, t, true, (t + 3 < NT), (t + 1 < NT), (t + 1 < NT));         A64_ENDW(t);     A64_RESC(); A64_ROT();
        A64_STEP(pA0, pA1, pB0, pB1, t + 1, true, (t + 4 < NT), (t + 2 < NT), (t + 2 < NT));     A64_ENDW(t + 1); A64_RESC(); A64_ROT();
    }
    A64_STEP(pB0, pB1, pA0, pA1, NT - 1, true, false, false, false); A64_RESC();
    { float sacc = pB0[0] + pB0[1];
#pragma unroll
      for (int r = 2; r < 16; ++r) sacc += pB0[r];
#pragma unroll
      for (int r = 0; r < 16; ++r) sacc += pB1[r];
      l_reg += sacc;
      pw0 = (u32x4){A64_PKW(pB0, 0), A64_PKW(pB0, 2), A64_PKW(pB0, 4), A64_PKW(pB0, 6)}; pw1 = (u32x4){A64_PKW(pB0, 8), A64_PKW(pB0, 10), A64_PKW(pB0, 12), A64_PKW(pB0, 14)};
      pw2 = (u32x4){A64_PKW(pB1, 0), A64_PKW(pB1, 2), A64_PKW(pB1, 4), A64_PKW(pB1, 6)}; pw3 = (u32x4){A64_PKW(pB1, 8), A64_PKW(pB1, 10), A64_PKW(pB1, 12), A64_PKW(pB1, 14)};
      const LAS unsigned char* vp_ = vp0 + sl_cur * A64_VSLOT; _Pragma("unroll") for (int i = 0; i < 8; ++i) A64_VRD(i);
      o[0] = A64_MFMA(A64_PAF(0), A64_VFR(0), o[0]); o[1] = A64_MFMA(A64_PAF(0), A64_VFR(4), o[1]); o[0] = A64_MFMA(A64_PAF(1), A64_VFR(1), o[0]); o[1] = A64_MFMA(A64_PAF(1), A64_VFR(5), o[1]);
      o[0] = A64_MFMA(A64_PAF(2), A64_VFR(2), o[0]); o[1] = A64_MFMA(A64_PAF(2), A64_VFR(6), o[1]); o[0] = A64_MFMA(A64_PAF(3), A64_VFR(3), o[0]); o[1] = A64_MFMA(A64_PAF(3), A64_VFR(7), o[1]); }
    l_reg = swap32_sum(l_reg);
    if (hi == 0) wsf[32 + r32] = l_reg; asm volatile("s_waitcnt lgkmcnt(0)" ::: "memory");
    float rli[16];
#pragma unroll
    for (int r = 0; r < 16; ++r) rli[r] = __builtin_amdgcn_rcpf(wsf[32 + crow(r, hi)]);
    LAS bf16_t* stg = (LAS bf16_t*)(lds + A64_OST) + wid * 2048;
#pragma unroll
    for (int r = 0; r < 16; ++r) { const int orow = crow(r, hi);
#pragma unroll
        for (int d0 = 0; d0 < 2; ++d0) stg[orow * 64 + d0 * 32 + r32] = (bf16_t)pk2(o[d0][r] * rli[r], 0.f); }
    asm volatile("s_waitcnt lgkmcnt(0)" ::: "memory");
#pragma unroll
    for (int i = 0; i < 4; ++i) { const int row = i * 8 + (lane >> 3), ch = lane & 7; const size_t grow = (size_t)(qw0 + row);
        const u32x4 vv = *(const LAS u32x4*)(stg + row * 64 + ch * 8); const u32x4 zz = *(const u32x4*)(Zg + grow * NP + ch * 8);
        const f32x4 g0 = *(const f32x4*)(Gn + ch * 8), g1 = *(const f32x4*)(Gn + ch * 8 + 4);
        float sq = 0.f; u32x4 w;
#pragma unroll
        for (int e = 0; e < 4; ++e) { const float va = bflo(vv[e]), vb_ = bfhi(vv[e]); sq += va * va + vb_ * vb_;
            const float ga = (e < 2) ? g0[2 * e] : g1[2 * e - 4], gb = (e < 2) ? g0[2 * e + 1] : g1[2 * e - 3];
            w[e] = pk2(va * ga * silu_fast(bflo(zz[e])), vb_ * gb * silu_fast(bfhi(zz[e]))); }
        *(u32x4*)(O + grow * D + ch * 8) = w;
        sq += quad_xor1(sq); sq += quad_xor2(sq);
        sq += __builtin_bit_cast(float, __builtin_amdgcn_update_dpp(0, __builtin_bit_cast(int, sq), 0x141, 0xf, 0xf, false));
        if (ch == 0) ssq[grow * 16] = sq; }
    asm volatile("s_waitcnt lgkmcnt(0)\n\ts_barrier" ::: "memory");
#undef A64_DMA_K
#undef A64_DMA_V
#undef A64_ROT
#undef A64_EX
#undef A64_RESC
#undef A64_CINIT
#undef A64_ROWREF
#undef A64_PKW
#undef A64_PAF
#undef A64_VFR
#undef A64_VRD
#undef A64_KRD
#undef A64_BRD
#undef A64_ENDW
#undef A64_GAPA
#undef A64_GAPB
#undef A64_STEP
}

constexpr int DSA_H1 = 0, DSA_H2 = 65536, DSA_INFO = 65536 + 32768;
__device__ __forceinline__ unsigned score_key32(float s) { const unsigned u = __float_as_uint(s); return u ^ ((unsigned)((int)u >> 31) | 0x80000000u); }
__device__ __forceinline__ unsigned score_key16(float s) { return score_key32(s) >> 16; }
__device__ __forceinline__ float key32_to_float(unsigned k) { return __uint_as_float((k & 0x80000000u) ? (k ^ 0x80000000u) : ~k); }
__device__ __forceinline__ float relu_f(float x) { const int b_ = __builtin_bit_cast(int, x); return __builtin_bit_cast(float, b_ > 0 ? b_ : 0); }

struct KFrag { bf16x8 a00, a01, a10, a11; };
__device__ __forceinline__ void dsa_kload(KFrag& f, const bf16_t* kix  , int t, int r, int hi) {
    const bf16_t* p = kix + ((size_t)t * 64 + r) * 32 + hi * 8;
    f.a00 = *(const bf16x8*)p; f.a01 = *(const bf16x8*)(p + 16); f.a10 = *(const bf16x8*)(p + 1024); f.a11 = *(const bf16x8*)(p + 1024 + 16);
}
__device__ __forceinline__ void dsa_scores(f32x16& s0, f32x16& s1, const KFrag& f, const bf16x8 (&qi)[4][2], const float (&w)[4]) {
    s0 = (f32x16){}; s1 = (f32x16){};
#pragma unroll
    for (int ih = 0; ih < 4; ++ih) {
        f32x16 a = __builtin_amdgcn_mfma_f32_32x32x16_bf16(f.a00, qi[ih][0], (f32x16){}, 0, 0, 0); a = __builtin_amdgcn_mfma_f32_32x32x16_bf16(f.a01, qi[ih][1], a, 0, 0, 0);
        f32x16 c = __builtin_amdgcn_mfma_f32_32x32x16_bf16(f.a10, qi[ih][0], (f32x16){}, 0, 0, 0); c = __builtin_amdgcn_mfma_f32_32x32x16_bf16(f.a11, qi[ih][1], c, 0, 0, 0);
#pragma unroll
        for (int i = 0; i < 16; ++i) { s0[i] = __builtin_fmaf(w[ih], relu_f(a[i]), s0[i]); s1[i] = __builtin_fmaf(w[ih], relu_f(c[i]), s1[i]); }
    }
}
__device__ __forceinline__ void hist_add(LAS unsigned* hrow, int r, unsigned bin) { atomicAdd((unsigned*)(hrow + ((bin >> 1) ^ (unsigned)r)), 1u << ((bin & 1u) * 16u)); }

__device__ __forceinline__ void dsa_index_unit(LAS unsigned char* lds, const bf16_t* proj, const bf16_t* kidx, const float* side, unsigned long long* maskbits, int b, int qg, int wid0) {
    const int tid = opaque_tid(wid0), lane = tid & 63, wv = __builtin_amdgcn_readfirstlane(tid >> 6), r = lane & 31, hi = lane >> 5;
    const int tq = qg * 32 + r; const size_t rowq = (size_t)b * S + tq;
    const int nt = (qg >> 1) + 1;
    const int per = (nt + 7) >> 3; const int t_lo = wv * per, t_hi = (t_lo + per < nt) ? t_lo + per : nt;
    bf16x8 qi[4][2]; float w[4];
#pragma unroll
    for (int ih = 0; ih < 4; ++ih) { qi[ih][0] = *(const bf16x8*)(proj + rowq * NP + C_IQ + ih * 32 + hi * 8); qi[ih][1] = *(const bf16x8*)(proj + rowq * NP + C_IQ + ih * 32 + 16 + hi * 8);
        w[ih] = side[rowq * 32 + 4 + ih] * 0.5f; }
    LAS unsigned* h1 = (LAS unsigned*)(lds + DSA_H1) + r * 512; LAS unsigned* h2 = (LAS unsigned*)(lds + DSA_H2) + wv * 1024 + r * 32;
    LAS int* info = (LAS int*)(lds + DSA_INFO);
    const bf16_t* kix = kidx + (size_t)b * S * 32;
    const bool sel_all = (qg < 8);
    __syncthreads();
    if (!sel_all) {
        for (int i = tid; i < (DSA_INFO) / 16; i += NTHREADS) ((LAS u32x4*)lds)[i] = (u32x4){0u, 0u, 0u, 0u};
        __syncthreads();
        if (t_lo < t_hi) {
            KFrag cur, nxt; dsa_kload(cur, kix, t_lo, r, hi);
            for (int t = t_lo; t < t_hi; ++t) {
                if (t + 1 < t_hi) dsa_kload(nxt, kix, t + 1, r, hi);
                f32x16 s0, s1; dsa_scores(s0, s1, cur, qi, w);
                const int kv0 = t * 64;
                if (kv0 + 63 <= qg * 32) {
#pragma unroll
                    for (int i = 0; i < 16; ++i) { hist_add(h1, r, score_key32(s0[i]) >> 22); hist_add(h1, r, score_key32(s1[i]) >> 22); }
                } else {
#pragma unroll
                    for (int i = 0; i < 16; ++i) { const int kv = kv0 + crow(i, hi);
                        if (kv <= tq) hist_add(h1, r, score_key32(s0[i]) >> 22);
                        if (kv + 32 <= tq) hist_add(h1, r, score_key32(s1[i]) >> 22); }
                }
                cur = nxt;
            }
        }
        __syncthreads();
        { const int row = tid >> 4, part = tid & 15; const LAS unsigned* hr = (const LAS unsigned*)(lds + DSA_H1) + row * 512; unsigned cs = 0;
#pragma unroll 8
          for (int j = 0; j < 32; ++j) { const unsigned wd = hr[(part * 32 + j) ^ row]; cs += (wd & 0xffffu) + (wd >> 16); }
          unsigned suf = cs;
#pragma unroll
          for (int o = 1; o < 16; o <<= 1) { const unsigned t = __shfl_down(suf, o, 16); if (part + o < 16) suf += t; }
          const unsigned above = suf - cs;
          if (above < 256u && above + cs >= 256u) { unsigned acc = above; int bsel = part * 64; unsigned ab = above;
              for (int j = 31; j >= 0; --j) { const unsigned wd = hr[(part * 32 + j) ^ row]; const unsigned c1 = wd >> 16, c0 = wd & 0xffffu;
                  if (acc + c1 >= 256u) { bsel = part * 64 + 2 * j + 1; ab = acc; break; } acc += c1;
                  if (acc + c0 >= 256u) { bsel = part * 64 + 2 * j; ab = acc; break; } acc += c0; }
              info[row] = bsel; info[32 + row] = 256 - (int)ab; } }
        __syncthreads();
        const unsigned B1 = (unsigned)info[r];
        const float blo = key32_to_float(B1 << 22), bhi = (B1 >= 1023u) ? INFINITY : key32_to_float((B1 + 1u) << 22);
        if (t_lo < t_hi) {
            KFrag cur, nxt; dsa_kload(cur, kix, t_lo, r, hi);
            for (int t = t_lo; t < t_hi; ++t) {
                if (t + 1 < t_hi) dsa_kload(nxt, kix, t + 1, r, hi);
                f32x16 s0, s1; dsa_scores(s0, s1, cur, qi, w);
                const int kv0 = t * 64;
                if (kv0 + 63 <= qg * 32) {
#pragma unroll
                    for (int i = 0; i < 16; ++i) {
                        if (s0[i] >= blo && s0[i] < bhi) hist_add(h2, r, (score_key32(s0[i]) >> 16) & 63u);
                        if (s1[i] >= blo && s1[i] < bhi) hist_add(h2, r, (score_key32(s1[i]) >> 16) & 63u); }
                } else {
#pragma unroll
                    for (int i = 0; i < 16; ++i) { const int kv = kv0 + crow(i, hi);
                        if (kv <= tq && s0[i] >= blo && s0[i] < bhi) hist_add(h2, r, (score_key32(s0[i]) >> 16) & 63u);
                        if (kv + 32 <= tq && s1[i] >= blo && s1[i] < bhi) hist_add(h2, r, (score_key32(s1[i]) >> 16) & 63u); }
                }
                cur = nxt;
            }
        }
        __syncthreads();
        { const int row = tid >> 4, part = tid & 15; unsigned cnt[4]; unsigned cs = 0; const unsigned need1 = (unsigned)info[32 + row];
          LAS unsigned* h2a = (LAS unsigned*)(lds + DSA_H2);
#pragma unroll
          for (int j = 0; j < 2; ++j) { unsigned c0 = 0, c1 = 0; const int wi = row * 32 + ((part * 2 + j) ^ row);
#pragma unroll
              for (int ww = 0; ww < 8; ++ww) { const unsigned wd = h2a[ww * 1024 + wi]; c0 += wd & 0xffffu; c1 += wd >> 16; }
              cnt[2 * j] = c0; cnt[2 * j + 1] = c1; cs += c0 + c1; }
          unsigned suf = cs;
#pragma unroll
          for (int o = 1; o < 16; o <<= 1) { const unsigned t = __shfl_down(suf, o, 16); if (part + o < 16) suf += t; }
          const unsigned above = suf - cs;
          if (above < need1 && above + cs >= need1) { unsigned acc = above; int bsel = 0; unsigned ab = above; bool found = false;
#pragma unroll
              for (int j = 3; j >= 0; --j) { if (!found) { if (acc + cnt[j] >= need1) { bsel = part * 4 + j; ab = acc; found = true; } else acc += cnt[j]; } }
              info[64 + row] = (int)(((unsigned)info[row] << 6) | (unsigned)bsel); info[96 + row] = (int)(need1 - ab);
              const int wi = row * 32 + ((bsel >> 1) ^ row); unsigned run = 0;
#pragma unroll
              for (int ww = 0; ww < 8; ++ww) { info[128 + row * 8 + ww] = (int)run; const unsigned wd = h2a[ww * 1024 + wi]; run += (bsel & 1) ? (wd >> 16) : (wd & 0xffffu); } } }
        __syncthreads();
    }
    const unsigned T = sel_all ? 0u : (unsigned)info[64 + r];
    const unsigned need2 = sel_all ? 0x7fffffffu : (unsigned)info[96 + r];
    unsigned tc = sel_all ? 0u : (unsigned)info[128 + r * 8 + wv];
    const float f_lo = sel_all ? -INFINITY : key32_to_float(T << 16), f_hi = sel_all ? -INFINITY : ((T >= 0xffffu) ? INFINITY : key32_to_float((T + 1u) << 16));
    if (t_lo < t_hi) {
        KFrag cur, nxt; dsa_kload(cur, kix, t_lo, r, hi);
        for (int t = t_lo; t < t_hi; ++t) {
            if (t + 1 < t_hi) dsa_kload(nxt, kix, t + 1, r, hi);
            f32x16 s0, s1; dsa_scores(s0, s1, cur, qi, w);
            const int kv0 = t * 64; unsigned words[2];
#pragma unroll
            for (int half = 0; half < 2; ++half) {
                unsigned gt = 0, eq = 0;
                if (kv0 + 63 <= qg * 32) {
                    unsigned ge = 0;
#pragma unroll
                    for (int i = 15; i >= 0; --i) { const float sv = half ? s1[i] : s0[i];
                        asm("v_cmp_ge_f32 vcc, %1, %2\n\tv_addc_co_u32 %0, vcc, %0, %0, vcc" : "+v"(gt) : "v"(sv), "v"(f_hi) : "vcc");
                        asm("v_cmp_ge_f32 vcc, %1, %2\n\tv_addc_co_u32 %0, vcc, %0, %0, vcc" : "+v"(ge) : "v"(sv), "v"(f_lo) : "vcc"); }
                    eq = ge & ~gt;
                } else {
#pragma unroll
                    for (int i = 0; i < 16; ++i) { const int kv = kv0 + 32 * half + crow(i, hi); const unsigned k = score_key16(half ? s1[i] : s0[i]);
                        const unsigned v = (kv <= tq) ? 1u : 0u; gt |= ((k > T) ? v : 0u) << i; eq |= ((k == T) ? v : 0u) << i; }
                }
                unsigned sel = gt;
                if (__any(eq != 0u)) {
                    const unsigned a0 = __popc(eq & 0xfu), a1 = __popc(eq & 0xf0u), a2 = __popc(eq & 0xf00u), a3 = __popc(eq & 0xf000u);
                    const unsigned own = a0 | (a1 << 8) | (a2 << 16) | (a3 << 24); unsigned oth; { const auto rr_ = __builtin_amdgcn_permlane32_swap(own, own, false, false); oth = rr_[0] + rr_[1] - own; }
                    const unsigned b0 = oth & 255u, b1 = (oth >> 8) & 255u, b2 = (oth >> 16) & 255u, b3 = oth >> 24;
                    unsigned pre[4]; const unsigned hb = hi ? 1u : 0u;
                    pre[0] = tc + hb * b0; pre[1] = tc + a0 + b0 + hb * b1; pre[2] = tc + a0 + b0 + a1 + b1 + hb * b2; pre[3] = tc + a0 + b0 + a1 + b1 + a2 + b2 + hb * b3;
#pragma unroll
                    for (int g = 0; g < 4; ++g) { unsigned rk = pre[g];
#pragma unroll
                        for (int e = 0; e < 4; ++e) { const unsigned bit = 1u << (4 * g + e); if (eq & bit) { if (rk < need2) sel |= bit; ++rk; } } }
                    tc += a0 + a1 + a2 + a3 + b0 + b1 + b2 + b3;
                }
                unsigned wbits = (sel & 0xfu) | ((sel & 0xf0u) << 4) | ((sel & 0xf00u) << 8) | ((sel & 0xf000u) << 12);
                wbits <<= 4 * hi;
                { const auto rr_ = __builtin_amdgcn_permlane32_swap(wbits, wbits, false, false); wbits = rr_[0] | rr_[1]; }
                words[half] = wbits;
            }
            if (hi == 0) maskbits[(size_t)tq * 128 + t] = (unsigned long long)words[0] | ((unsigned long long)words[1] << 32);
            cur = nxt;
        }
    }
}

constexpr int NSA_IMP = ATT_EXTRA;
constexpr int NSA_SEL = NSA_IMP + 32768;
constexpr int NSA_UNI = NSA_SEL + 1024;
constexpr int NSA_LIST = NSA_UNI + 64;
constexpr int NSA_OT = NSA_LIST + 1024;
static_assert(NSA_OT + 65536 <= LDS_BYTES, "NSA LDS map");

__device__ __forceinline__ void nsa_unit(LAS unsigned char* lds, const bf16_t* proj, const float* side, const bf16_t* kc, const bf16_t* vc, bf16_t* ocat, int b, int q64, int wid0, const float* gn  , float* ssq  ) {
    const int tid = opaque_tid(wid0), lane = tid & 63, wv = __builtin_amdgcn_readfirstlane(tid >> 6), r = lane & 31, hi = lane >> 5;
    const int t0 = q64 * 64, q8 = r >> 2, hd = r & 3, tq = t0 + wv * 8 + q8; const size_t rowq = (size_t)b * S + tq;
    const float c2 = 0.125f * LOG2E;
    const float slope = (hd == 0) ? 0.25f : (hd == 1 ? 0.0625f : (hd == 2 ? 0.015625f : 0.00390625f));
    const float A = 8.0f * slope;
    bf16x8 qf[4];
#pragma unroll
    for (int s = 0; s < 4; ++s) qf[s] = *(const bf16x8*)(proj + rowq * NP + C_NQ + hd * 64 + s * 16 + hi * 8);
    const float g0 = sigmoid_f(side[rowq * 32 + 8 + hd * 3 + 0]), g1 = sigmoid_f(side[rowq * 32 + 8 + hd * 3 + 1]), g2 = sigmoid_f(side[rowq * 32 + 8 + hd * 3 + 2]);
    const int vb = ((lane >> 4) & 1) * 32 + (lane & 3) * 8 + (4 * hi + ((lane & 15) >> 2)) * 64;
    LAS float* imp = (LAS float*)(lds + NSA_IMP) + wv * 1024;
    LAS unsigned* selw = (LAS unsigned*)(lds + NSA_SEL) + wv * 32;
    LAS unsigned* uni = (LAS unsigned*)(lds + NSA_UNI);
    LAS int* list = (LAS int*)(lds + NSA_LIST);
    LAS float* otl = (LAS float*)(lds + NSA_OT) + wv * 2048 + lane;
    StageRegs<64> sr;
    __syncthreads();
    for (int i = lane; i < 1024; i += 64) imp[i] = 0.f;
    if (tid < 4) uni[tid] = 0u;
    const bf16_t* kcb = kc + (size_t)b * 512 * 64; const bf16_t* vcb = vc + (size_t)b * 512 * 64;
    const int ntc = (((t0 + 32) >> 4) >> 6) + 1;
    SoftState st; st.m = NEG_BIG; st.l = 0.f; st.o0 = (f32x16){}; st.o1 = (f32x16){};
    for (int pass = 0; pass < 2; ++pass) {
        stage_load<64>(sr, kcb, 64, vcb, 64, nullptr, 0, wid0);
        __syncthreads();
        stage_store<64>(sr, lds, 0, false, wid0);
        if (1 < ntc) stage_load<64>(sr, kcb, 64, vcb, 64, nullptr, 64, wid0);
        __syncthreads();
        float rl = 0.f;
        if (pass == 1) { const float l = st.l + __shfl_xor(st.l, 32); rl = l > 0.f ? 1.0f / l : 0.f; }
        const float mc = st.m * c2;
        for (int t = 0; t < ntc; ++t) {
            const int buf = t & 1;
            f32x16 p0, p1; const int n0 = t * 64;
            { const float base = A * (float)(16 * (n0 + 4 * hi) + 31);
#pragma unroll
              for (int i = 0; i < 16; ++i) { p0[i] = base + A * 16.0f * (float)((i & 3) + 8 * (i >> 2)); p1[i] = p0[i] + A * 512.0f; } }
            qk_tile<4>(p0, p1, lds + ATT_K0 + buf * ATT_KBUF, KSTR64, qf, r, hi);
#pragma unroll
            for (int i = 0; i < 16; ++i) { const int n = n0 + crow(i, hi); if (16 * n + 31 > tq) p0[i] = -INFINITY; if (16 * (n + 32) + 31 > tq) p1[i] = -INFINITY; }
            if (pass == 0) {
                const float mx = tile_max(p0, p1); const float mn = fmaxf(st.m, mx);
                const float al = __builtin_amdgcn_exp2f((st.m - mn) * c2); st.l *= al; st.m = mn; const float mcc = mn * c2; float sum = 0.f;
#pragma unroll
                for (int i = 0; i < 16; ++i) sum += __builtin_amdgcn_exp2f(__builtin_fmaf(p0[i], c2, -mcc)) + __builtin_amdgcn_exp2f(__builtin_fmaf(p1[i], c2, -mcc));
                st.l += sum;
            } else {
#pragma unroll
                for (int i = 0; i < 16; ++i) { p0[i] = __builtin_amdgcn_exp2f(__builtin_fmaf(p0[i], c2, -mc)) * rl; p1[i] = __builtin_amdgcn_exp2f(__builtin_fmaf(p1[i], c2, -mc)) * rl; }
#pragma unroll
                for (int half = 0; half < 2; ++half)
#pragma unroll
                    for (int g = 0; g < 4; ++g) { const f32x16& pp = half ? p1 : p0;
                        float s4 = (pp[4 * g] + pp[4 * g + 1]) + (pp[4 * g + 2] + pp[4 * g + 3]); float s3 = pp[4 * g + 3];
                        s4 += quad_xor1(s4); s4 += quad_xor2(s4); s3 += quad_xor1(s3); s3 += quad_xor2(s3);
                        const int j1 = 16 * t + 8 * half + 2 * g + hi;
                        if (hd == 0) atomicAdd((float*)(imp + q8 * 128 + j1), s4);
                        if (hd == 0 && j1 + 1 < 128) atomicAdd((float*)(imp + q8 * 128 + j1 + 1), s3); }
                pv_tile(st.o0, st.o1, p0, p1, lds + ATT_V0 + buf * ATT_VBUF, vb);
            }
            if (t + 1 < ntc) stage_store<64>(sr, lds, buf ^ 1, false, wid0);
            if (t + 2 < ntc) stage_load<64>(sr, kcb, 64, vcb, 64, nullptr, (t + 2) * 64, wid0);
            __syncthreads();
        }
    }
#pragma unroll
    for (int i = 0; i < 16; ++i) { otl[i * 64] = st.o0[i] * g0; otl[(16 + i) * 64] = st.o1[i] * g0; }
    {
        const int cur = q64;
        for (int qq = 0; qq < 8; ++qq) {
            float v0 = imp[qq * 128 + lane], v1 = imp[qq * 128 + 64 + lane];
            bool ok0 = true, ok1 = true;
            { const int j0 = lane, j1 = lane + 64;
              if (j0 == 0 || j0 == cur) v0 = INFINITY; else if (j0 > cur) ok0 = false;
              if (j1 == cur) v1 = INFINITY; else if (j1 > cur) ok1 = false; }
            const unsigned k0 = __float_as_uint(v0), k1 = __float_as_uint(v1);
            unsigned T = 0u;
            for (int bit = 30; bit >= 0; --bit) { const unsigned cand = T | (1u << bit);
                const int cnt = __popcll(__ballot(ok0 && k0 >= cand)) + __popcll(__ballot(ok1 && k1 >= cand));
                if (cnt >= 16) T = cand; }
            const unsigned long long gt0 = __ballot(ok0 && k0 > T), gt1 = __ballot(ok1 && k1 > T), eq0 = __ballot(ok0 && k0 == T), eq1 = __ballot(ok1 && k1 == T);
            const int need = 16 - (__popcll(gt0) + __popcll(gt1));
            const int r0 = (int)__builtin_amdgcn_mbcnt_hi((unsigned)(eq0 >> 32), __builtin_amdgcn_mbcnt_lo((unsigned)eq0, 0u));
            const int r1 = __popcll(eq0) + (int)__builtin_amdgcn_mbcnt_hi((unsigned)(eq1 >> 32), __builtin_amdgcn_mbcnt_lo((unsigned)eq1, 0u));
            const unsigned long long slo = __ballot(ok0 && (k0 > T || (k0 == T && r0 < need))), shi = __ballot(ok1 && (k1 > T || (k1 == T && r1 < need)));
            if (lane == 0) { selw[qq * 4 + 0] = (unsigned)slo; selw[qq * 4 + 1] = (unsigned)(slo >> 32); selw[qq * 4 + 2] = (unsigned)shi; selw[qq * 4 + 3] = (unsigned)(shi >> 32);
                atomicOr((unsigned*)(uni + 0), (unsigned)slo); atomicOr((unsigned*)(uni + 1), (unsigned)(slo >> 32)); atomicOr((unsigned*)(uni + 2), (unsigned)shi); atomicOr((unsigned*)(uni + 3), (unsigned)(shi >> 32)); }
        }
    }
    __syncthreads();
    if (tid == 0) { int n = 0; for (int wd = 0; wd < 4; ++wd) { unsigned u = uni[wd]; while (u) { const int j = __ffs(u) - 1; u &= u - 1; list[n++] = wd * 32 + j; } } list[131] = n; }
    __syncthreads();
    {
        const unsigned m0 = selw[q8 * 4 + 0], m1 = selw[q8 * 4 + 1], m2 = selw[q8 * 4 + 2], m3 = selw[q8 * 4 + 3];
        const int nl = list[131];
        const bf16_t* Ks = proj + (size_t)b * S * NP + C_KSEL; const bf16_t* Vs = proj + (size_t)b * S * NP + C_VSEL;
        st.m = NEG_BIG; st.l = 0.f; st.o0 = (f32x16){}; st.o1 = (f32x16){};
        stage_load<64>(sr, Ks, NP, Vs, NP, nullptr, list[0] * 64, wid0);
        stage_store<64>(sr, lds, 0, false, wid0);
        if (1 < nl) stage_load<64>(sr, Ks, NP, Vs, NP, nullptr, list[1] * 64, wid0);
        __syncthreads();
        for (int t = 0; t < nl; ++t) {
            const int buf = t & 1; const int j = list[t];
            const unsigned mw = (j < 32) ? m0 : (j < 64 ? m1 : (j < 96 ? m2 : m3));
            const bool mine = (mw >> (j & 31)) & 1u;
            if (__any(mine)) {
                f32x16 p0, p1; const int kv0 = j * 64;
                { const float base = A * (float)(kv0 + 4 * hi);
#pragma unroll
                  for (int i = 0; i < 16; ++i) { p0[i] = base + A * (float)((i & 3) + 8 * (i >> 2)); p1[i] = p0[i] + A * 32.0f; } }
                qk_tile<4>(p0, p1, lds + ATT_K0 + buf * ATT_KBUF, KSTR64, qf, r, hi);
#pragma unroll
                for (int i = 0; i < 16; ++i) { const int kv = kv0 + crow(i, hi); if (!mine || (j == q64 && kv > tq)) p0[i] = -INFINITY; if (!mine || (j == q64 && kv + 32 > tq)) p1[i] = -INFINITY; }
                { bf16x8 f0, f1, f2, f3; softmax_pack(st, p0, p1, c2, f0, f1, f2, f3); pv_frag(st.o0, st.o1, f0, f1, f2, f3, lds + ATT_V0 + buf * ATT_VBUF, vb); }
            }
            if (t + 1 < nl) stage_store<64>(sr, lds, buf ^ 1, false, wid0);
            if (t + 2 < nl) stage_load<64>(sr, Ks, NP, Vs, NP, nullptr, list[t + 2] * 64, wid0);
            __syncthreads();
        }
        const float l = swap32_sum(st.l); const float sc = l > 0.f ? g1 / l : 0.f;
#pragma unroll
        for (int i = 0; i < 16; ++i) { otl[i * 64] += st.o0[i] * sc; otl[(16 + i) * 64] += st.o1[i] * sc; }
    }
    {
        const bf16_t* Kw = proj + (size_t)b * S * NP + C_KWIN; const bf16_t* Vw = proj + (size_t)b * S * NP + C_VWIN;
        const int tw0 = (q64 >= 8) ? q64 - 8 : 0, ntw = q64 - tw0 + 1;
        st.m = NEG_BIG; st.l = 0.f; st.o0 = (f32x16){}; st.o1 = (f32x16){};
        stage_load<64>(sr, Kw, NP, Vw, NP, nullptr, tw0 * 64, wid0);
        stage_store<64>(sr, lds, 0, false, wid0);
        if (1 < ntw) stage_load<64>(sr, Kw, NP, Vw, NP, nullptr, tw0 * 64 + 64, wid0);
        __syncthreads();
        for (int t = 0; t < ntw; ++t) {
            const int buf = t & 1; const int kv0 = (tw0 + t) * 64;
            f32x16 p0, p1;
            { const float base = A * (float)(kv0 + 4 * hi);
#pragma unroll
              for (int i = 0; i < 16; ++i) { p0[i] = base + A * (float)((i & 3) + 8 * (i >> 2)); p1[i] = p0[i] + A * 32.0f; } }
            qk_tile<4>(p0, p1, lds + ATT_K0 + buf * ATT_KBUF, KSTR64, qf, r, hi);
            if (t == 0 || t == ntw - 1) {
#pragma unroll
                for (int i = 0; i < 16; ++i) { const int kv = kv0 + crow(i, hi); if (kv > tq || kv + 512 <= tq) p0[i] = -INFINITY; if (kv + 32 > tq || kv + 32 + 512 <= tq) p1[i] = -INFINITY; } }
            { bf16x8 f0, f1, f2, f3; softmax_pack(st, p0, p1, c2, f0, f1, f2, f3); pv_frag(st.o0, st.o1, f0, f1, f2, f3, lds + ATT_V0 + buf * ATT_VBUF, vb); }
            if (t + 1 < ntw) stage_store<64>(sr, lds, buf ^ 1, false, wid0);
            if (t + 2 < ntw) stage_load<64>(sr, Kw, NP, Vw, NP, nullptr, kv0 + 128, wid0);
            __syncthreads();
        }
        const float l = swap32_sum(st.l); const float sc = l > 0.f ? g2 / l : 0.f;
#pragma unroll
        for (int i = 0; i < 16; ++i) { st.o0[i] = otl[i * 64] + st.o0[i] * sc; st.o1[i] = otl[(16 + i) * 64] + st.o1[i] * sc; }
    }
    { const float sq = swap32_sum(store_out_fused(ocat + rowq * D + 768 + hd * 64, proj + rowq * NP + C_GZ + 768 + hd * 64, gn + 768 + hd * 64, st.o0, st.o1, 1.0f, hi));
      if (hi == 0) ssq[rowq * 16 + 12 + hd] = sq; }
}

__device__ __forceinline__ void phase_onorm(const bf16_t* ocat, const bf16_t* proj, const float* og, bf16_t* oa, int bid, int G, int wid0) {
    const int tid_ = opaque_tid(wid0); const int lane = tid_ & 63, wv = tid_ >> 6;
    for (int row = bid * 8 + wv; row < M; row += G * 8) {
        const int c = lane * 16;
        const u32x4 a0 = *(const u32x4*)(ocat + (size_t)row * D + c), a1 = *(const u32x4*)(ocat + (size_t)row * D + c + 8);
        const u32x4 z0 = *(const u32x4*)(proj + (size_t)row * NP + C_GZ + c), z1 = *(const u32x4*)(proj + (size_t)row * NP + C_GZ + c + 8);
        float v[16], z[16]; float s = 0.f;
#pragma unroll
        for (int e = 0; e < 4; ++e) { v[2 * e] = bflo(a0[e]); v[2 * e + 1] = bfhi(a0[e]); v[8 + 2 * e] = bflo(a1[e]); v[8 + 2 * e + 1] = bfhi(a1[e]);
            z[2 * e] = bflo(z0[e]); z[2 * e + 1] = bfhi(z0[e]); z[8 + 2 * e] = bflo(z1[e]); z[8 + 2 * e + 1] = bfhi(z1[e]); }
#pragma unroll
        for (int e = 0; e < 16; ++e) s += v[e] * v[e];
        s += __builtin_bit_cast(float, __builtin_amdgcn_update_dpp(0, __builtin_bit_cast(int, s), 0xB1, 0xf, 0xf, false));
        s += __builtin_bit_cast(float, __builtin_amdgcn_update_dpp(0, __builtin_bit_cast(int, s), 0x4E, 0xf, 0xf, false));
        s += __builtin_bit_cast(float, __builtin_amdgcn_update_dpp(0, __builtin_bit_cast(int, s), 0x141, 0xf, 0xf, false));
        s += __builtin_bit_cast(float, __builtin_amdgcn_update_dpp(0, __builtin_bit_cast(int, s), 0x140, 0xf, 0xf, false));
        const float rstd = 1.0f / sqrtf(s * (1.f / 256.f) + EPS);
        float y[16];
#pragma unroll
        for (int e = 0; e < 16; ++e) y[e] = v[e] * rstd * og[c + e] * silu_f(z[e]);
        u32x4 w0, w1;
#pragma unroll
        for (int e = 0; e < 4; ++e) { w0[e] = pk2(y[2 * e], y[2 * e + 1]); w1[e] = pk2(y[8 + 2 * e], y[8 + 2 * e + 1]); }
        *(u32x4*)(oa + (size_t)row * D + c) = w0; *(u32x4*)(oa + (size_t)row * D + c + 8) = w1;
    }
}
__device__ __forceinline__ void phase_final(float* out, const float* g, int bid, int G, int wid0) {
    const int tid_ = opaque_tid(wid0); const int lane = tid_ & 63, wv = tid_ >> 6;
    for (int row = bid * 8 + wv; row < M; row += G * 8) {
        f32x4* xr = (f32x4*)(out + (size_t)row * D) + lane;
        f32x4 v[4]; float s = 0.f;
#pragma unroll
        for (int j = 0; j < 4; ++j) { v[j] = xr[64 * j]; s += (v[j][0] * v[j][0] + v[j][1] * v[j][1]) + (v[j][2] * v[j][2] + v[j][3] * v[j][3]); }
        const float rstd = 1.0f / sqrtf(wave_sum(s) * (1.f / D) + EPS);
#pragma unroll
        for (int j = 0; j < 4; ++j) { const f32x4 gg = *(const f32x4*)(g + (64 * j + lane) * 4); xr[64 * j] = v[j] * rstd * gg; }
    }
}

#define XB_TMO      128
#define XB_XCNT(j)  (256  + 64 * (j))
#define XB_XSUB(j)  (1280 + 64 * (j))
#define XB_XGEN(j)  (2304 + 64 * (j))
#define XB_TOP      3328
#define XB_TOPGEN   3392
#define XCD_BAR_WORDS 3456
#define XB_SPIN_CAP (1u << 22)
__device__ __forceinline__ unsigned xb_ld(unsigned* p)              { return __hip_atomic_load(p, __ATOMIC_RELAXED, __HIP_MEMORY_SCOPE_AGENT); }
__device__ __forceinline__ unsigned xb_add(unsigned* p, unsigned v) { return __hip_atomic_fetch_add(p, v, __ATOMIC_RELAXED, __HIP_MEMORY_SCOPE_AGENT); }
__device__ __forceinline__ unsigned xb_xcc_id() { return (unsigned)__builtin_amdgcn_s_getreg((3 << 11) | 20) & 0xFu; }
#define XB_SPIN(cond, bar) do { unsigned _sp = 0; while (cond) { __builtin_amdgcn_s_sleep(1); \
    if ((++_sp & 255u) == 0u) { if (xb_ld(&(bar)[XB_TMO])) break; if (_sp > XB_SPIN_CAP) { atomicAdd(&(bar)[XB_TMO], 1u); break; } } } } while (0)
__device__ __forceinline__ void xcd_barrier_complete(unsigned* bar, unsigned x, unsigned G, unsigned& nloc, unsigned& nx) {
    unsigned sum, cnt, mine, sp = 0u;
    for (;;) {
        sum = 0u; cnt = 0u; mine = 0u;
#pragma unroll
        for (unsigned j = 0; j < 16; ++j) { const unsigned c = xb_ld(&bar[XB_XCNT(j)]); sum += c; cnt += (c > 0u) ? 1u : 0u; mine = (j == x) ? c : mine; }
        if (sum == G) break;
        __builtin_amdgcn_s_sleep(1);
        if ((++sp & 255u) == 0u) { if (xb_ld(&bar[XB_TMO])) break; if (sp > XB_SPIN_CAP) { atomicAdd(&bar[XB_TMO], 1u); break; } }
    }
    nloc = mine > 0u ? mine : 1u; nx = cnt > 0u ? cnt : 1u;
}
__device__ __forceinline__ void grid_bar(unsigned* bar, volatile LAS unsigned* st, unsigned G, int wid0) {
    const int tid = opaque_tid(wid0);
    asm volatile("s_waitcnt vmcnt(0)" ::: "memory");
    __syncthreads();
    if (tid == 0) {
        const unsigned x = xb_xcc_id();
        unsigned nloc = st[0], nx = st[1];
        if (nloc == 0u) { xcd_barrier_complete(bar, x, G, nloc, nx); st[0] = nloc; st[1] = nx; }
        const unsigned old = xb_add(&bar[XB_XSUB(x)], 1u);
        const unsigned gen = old / nloc;
        if (old + 1u == (gen + 1u) * nloc) {
            __builtin_amdgcn_fence(__ATOMIC_RELEASE, "agent");
            asm volatile("s_waitcnt vmcnt(0)" ::: "memory");
            const unsigned og = xb_add(&bar[XB_TOP], 1u);
            const unsigned tg = og / nx;
            if (og + 1u == (tg + 1u) * nx) xb_add(&bar[XB_TOPGEN], 1u);
            else XB_SPIN(xb_ld(&bar[XB_TOPGEN]) == tg, bar);
            __builtin_amdgcn_fence(__ATOMIC_ACQUIRE, "agent");
            xb_add(&bar[XB_XGEN(x)], 1u);
            asm volatile("s_waitcnt vmcnt(0)" ::: "memory");
        } else {
            XB_SPIN(xb_ld(&bar[XB_XGEN(x)]) == gen, bar);
            __builtin_amdgcn_fence(__ATOMIC_ACQUIRE, "agent");
            asm volatile("s_waitcnt vmcnt(0)" ::: "memory");
        }
    }
    __syncthreads();
}

constexpr int N_PHASES = 16;
__global__ void __launch_bounds__(NTHREADS) hymba_fwd(Params P) {
    extern __shared__ __attribute__((aligned(16))) unsigned char lds_raw[];
    LAS unsigned char* lds = (LAS unsigned char*)lds_raw;
    const int bid = blockIdx.x, G = gridDim.x;
    const int wid0 = __builtin_amdgcn_readfirstlane((int)(threadIdx.x >> 6));
    volatile LAS unsigned* xst = (volatile LAS unsigned*)(lds + LDS_BYTES - 16);
    unsigned* xbar = (unsigned*)(P.ws + WS_CTL) + 4096 + P.bar_region * XCD_BAR_WORDS;
    if (threadIdx.x == 0) { xst[0] = 0u; xst[1] = 0u; (void)xb_add(&xbar[XB_XCNT(xb_xcc_id())], 1u); }
    __syncthreads();
    unsigned char* ws = P.ws;
    bf16_t* proj = (bf16_t*)(ws + WS_PROJ); float* side = (float*)(ws + WS_SIDE);
    bf16_t* hbuf = (bf16_t*)(ws + WS_H); bf16_t* ocat = (bf16_t*)(ws + WS_OCAT);
#define PH(k) (P.ph_lo <= (k) && (k) < P.ph_hi)
#define SYNC(k) do { if (PH(k) && PH((k) + 1)) grid_bar(xbar, xst, (unsigned)G, wid0); } while (0)
    if (PH(0)) phase_prologue(P, lds, bid, G, wid0);
    if (PH(0) && PH(1)) cg::this_grid().sync();
#ifndef PREP_SHIFT
#define PREP_SHIFT 4
#endif
#ifndef ATT_REP
#define ATT_REP 0
#endif
#ifndef PROBE_VAR
#define PROBE_VAR -1
#endif
#define LAYER(l, base) do { \
    const float* mod = (const float*)(ws + WS_MOD) + (size_t)(l) * 4 * 3072; \
    const float* xin = ((l) == 0) ? P.in[0] : P.out; \
    if (PH((base) + 0)) phase_hnorm(xin, P.in[2] + (l) * D, mod, hbuf, bid, G, wid0); \
    SYNC((base) + 0); \
    if (PH((base) + 1)) { pg8::Gemm g{hbuf, (const bf16_t*)(ws + WS_WIN) + (size_t)(l) * NP * D, M, NP, D, D, D}; pg8::StaticOrder so; so.init(M, NP, G, bid); \
        pg8::EpiProj E{proj, side}; pg8::gemm_phase<pg8::EpiProj, true>(lds, g, so, E, wid0); } \
    SYNC((base) + 1); \
    if (PH((base) + 2)) phase_prep(P, (l), lds, bid, G, wid0); \
    SYNC((base) + 2); \
    if (PH((base) + 3)) { \
        { pg8::Gemm g{proj + C_QLAT, (const bf16_t*)(ws + WS_WUQ) + (size_t)(l) * 512 * 256, M, 512, 256, NP, 256}; pg8::StaticOrder so; so.init(M, 512, G, bid); \
          pg8::EpiQup E{(bf16_t*)(ws + WS_QMLA), (const float*)(ws + WS_RSTD), (const float*)(ws + WS_ROPE)}; pg8::gemm_phase<pg8::EpiQup, true>(lds, g, so, E, wid0); } \
        { pg8::Gemm g{proj + C_KVLAT, (const bf16_t*)(ws + WS_WUKV) + (size_t)(l) * 512 * 128, M, 512, 128, NP, 128}; pg8::StaticOrder so; so.init(M, 512, G, bid); \
          pg8::EpiKVup E{(bf16_t*)(ws + WS_KMLA), (bf16_t*)(ws + WS_VMLA), (const float*)(ws + WS_RSTD)}; pg8::gemm_phase<pg8::EpiKVup, true>(lds, g, so, E, wid0); } \
        for (int k = 0; k * G < 1024; ++k) { const int u = (k & 1) ? (k + 1) * G - 1 - bid : k * G + bid; if (u >= 1024 || u < 0) continue; const int qg = 255 - (u >> 2), b = u & 3; \
            dsa_index_unit(lds, proj, (const bf16_t*)(ws + WS_KIDX), side, (unsigned long long*)(ws + WS_MASK) + (size_t)b * S * 128, b, qg, wid0); } } \
    SYNC((base) + 3); \
    if (PH((base) + 4)) { const int vb_ = (G % 8 == 0) ? (bid & 7) * (G >> 3) + (bid >> 3) : bid;     \
        if (G == 256) {   \
          const int tw_ = opaque_tid(wid0); const int b_ = (bid & 7) >> 1; \
          if (tw_ < 128) { const int pg_ = (bid >> 3) * 128 + tw_;     \
              const unsigned char* a_ = (pg_ < 1536) ? ws + WS_QMLA + (size_t)b_ * S * 768 + (size_t)pg_ * 4096 : (pg_ < 3072) ? ws + WS_KMLA + (size_t)b_ * S * 768 + (size_t)(pg_ - 1536) * 4096 \
                                                      : ws + WS_VMLA + (size_t)b_ * S * 512 + (size_t)(pg_ - 3072) * 4096; \
              const unsigned v_ = *(const volatile unsigned*)a_; if (v_ == 0x12345677u) *(volatile unsigned*)(ws + WS_CTL + 8192 + 512) = v_; } } \
        for (int i = vb_; i < 512; i += G) { const int ii = i & 255, bh = ii >> 4, qb = (i < 256) ? (ii & 15) : 31 - (ii & 15), b = bh >> 2, hd = bh & 3; const size_t rb = (size_t)b * S; \
            attn64_unit<0, 96>(lds, (const bf16_t*)(ws + WS_QMLA) + rb * 384 + hd * 96, 384, (const bf16_t*)(ws + WS_KMLA) + rb * 384 + hd * 96, 384, \
                              (const bf16_t*)(ws + WS_VMLA) + rb * 256 + hd * 64, 256, ocat + rb * D + hd * 64, nullptr, nullptr, 0.f, 0.10206207261596577f * LOG2E, qb, wid0, proj + rb * NP + C_GZ + hd * 64, P.in[14] + (l) * D + hd * 64, (float*)(ws + WS_SSQ) + rb * 16 + hd); } \
        for (int rep = 0; rep < (((ATT_REP & 2) && (l) == 0) ? 2 : 1); ++rep) for (int i = vb_; i < 512; i += G) { const int ii = i & 255, bh = ii >> 4, qb = (i < 256) ? (ii & 15) : 31 - (ii & 15), b = bh >> 2, hd = bh & 3; const size_t rb = (size_t)b * S; \
            attn64_unit<1, 64>(lds, proj + rb * NP + C_FQ + hd * 64, NP, proj + rb * NP + C_FK + hd * 64, NP, proj + rb * NP + C_FV + hd * 64, NP, \
                              ocat + rb * D + 256 + hd * 64, (const float*)(ws + WS_FB) + (size_t)bh * S, nullptr, 0.f, 0.125f * LOG2E, qb, wid0, proj + rb * NP + C_GZ + 256 + hd * 64, P.in[14] + (l) * D + 256 + hd * 64, (float*)(ws + WS_SSQ) + rb * 16 + 4 + hd); } \
        for (int rep = 0; rep < (((ATT_REP & 4) && (l) == 0) ? 2 : 1); ++rep) for (int i = vb_; i < 512; i += G) { const int ii = i & 255, bh = ii >> 4, qb = (i < 256) ? (ii & 15) : 31 - (ii & 15), b = bh >> 2, hd = bh & 3; const size_t rb = (size_t)b * S; \
            const float slope = (hd == 0) ? 0.25f : (hd == 1 ? 0.0625f : (hd == 2 ? 0.015625f : 0.00390625f)); \
            attn64_unit<2, 64>(lds, proj + rb * NP + C_DQ + hd * 64, NP, proj + rb * NP + C_DK + hd * 64, NP, proj + rb * NP + C_DV + hd * 64, NP, \
                              ocat + rb * D + 512 + hd * 64, nullptr, (const unsigned long long*)(ws + WS_MASK) + rb * 128, 8.0f * slope, 0.125f * LOG2E, qb, wid0, proj + rb * NP + C_GZ + 512 + hd * 64, P.in[14] + (l) * D + 512 + hd * 64, (float*)(ws + WS_SSQ) + rb * 16 + 8 + hd); } \
        for (int rep = 0; rep < (((ATT_REP & 8) && (l) == 0) ? 2 : 1); ++rep) for (int u = vb_; u < 512; u += G) { const int b = u >> 7, q64 = u & 127; \
            nsa_unit(lds, proj, side, (const bf16_t*)(ws + WS_KC), (const bf16_t*)(ws + WS_VC), ocat, b, q64, wid0, P.in[14] + (l) * D, (float*)(ws + WS_SSQ)); } } \
    SYNC((base) + 4); \
      \
    if (PH((base) + 6)) { pg8::Gemm g{ocat, (const bf16_t*)(ws + WS_WOUT) + (size_t)(l) * D * D, M, D, D, D, D}; pg8::StaticOrder so; so.init(M, D, G, bid); \
        pg8::EpiOut E{xin, P.out, mod + 2048, (const float*)(ws + WS_SSQ)}; pg8::gemm_phase<pg8::EpiOut, true>(lds, g, so, E, wid0); } \
    SYNC((base) + 6); \
} while (0)
    LAYER(0, 1);
    LAYER(1, 8);
    if (PH(15)) phase_final(P.out, P.in[16], bid, G, wid0);
#undef LAYER
#undef PH
#undef SYNC
}


#ifdef DBG_GROUP
#ifndef DBG_LAYER
#define DBG_LAYER 1
#endif
__device__ __forceinline__ float dbg_bf(const bf16_t* p) { return bf2f(*p); }
__device__ const int dbg_rows[48] = {0, 1, 2, 15, 30, 31, 32, 47, 63, 64, 65, 127, 128, 200, 255, 256, 257, 300, 511, 512, 513, 700, 1000, 1023, 1024, 1025, 1500, 2047, 2048, 3000, 3333, 4095, 4096, 4500, 5000, 5555, 6143, 6144, 7000, 7777, 8000, 8100, 8127, 8128, 8160, 8190, 8191, 4242};
template <class ScoreFn, class VFn>
__device__ __forceinline__ float dbg_attn(int k_lo, int k_hi, ScoreFn score, VFn vload, int lane) {
    float m = -INFINITY, l = 0.f, acc = 0.f;
    for (int kv = k_lo; kv <= k_hi; ++kv) {
        const float sc = score(kv);
        if (sc == -INFINITY) continue;
        const float mn = fmaxf(m, sc); const float al = (m == -INFINITY) ? 0.f : __expf(m - mn); const float p = __expf(sc - mn);
        l = l * al + p; acc = acc * al + p * vload(kv, lane); m = mn;
    }
    return l > 0.f ? acc / l : 0.f;
}
__global__ void __launch_bounds__(64) dbg_check(Params P) {
    const int lane = threadIdx.x, wid = blockIdx.x; const int hd = wid & 3, ri = (wid >> 2) % 48, b = (wid >> 2) / 48; const int t = dbg_rows[ri];
    unsigned char* ws = P.ws; const bf16_t* proj = (const bf16_t*)(ws + WS_PROJ); const float* side = (const float*)(ws + WS_SIDE);
    const bf16_t* ocat = (const bf16_t*)(ws + WS_OCAT); const size_t rowq = (size_t)b * S + t; const size_t rb = (size_t)b * S;
    float* scratch = (float*)(ws + WS_H) + (size_t)wid * 16384;
    float ref = 0.f; int grp = DBG_GROUP % 10;
    const float slope = (hd == 0) ? 0.25f : (hd == 1 ? 0.0625f : (hd == 2 ? 0.015625f : 0.00390625f));
    if (grp == 0) {
        const bf16_t* q = (const bf16_t*)(ws + WS_QMLA) + rowq * 384 + hd * 96; const bf16_t* K = (const bf16_t*)(ws + WS_KMLA) + rb * 384 + hd * 96; const bf16_t* V = (const bf16_t*)(ws + WS_VMLA) + rb * 256 + hd * 64;
        const float q0 = dbg_bf(q + lane), q1 = lane < 32 ? dbg_bf(q + 64 + lane) : 0.f;
        ref = dbg_attn(0, t, [&](int kv) { float pr = q0 * dbg_bf(K + (size_t)kv * 384 + lane) + (lane < 32 ? q1 * dbg_bf(K + (size_t)kv * 384 + 64 + lane) : 0.f); return wave_sum(pr) * 0.10206207261596577f; },
                       [&](int kv, int d) { return dbg_bf(V + (size_t)kv * 256 + d); }, lane);
    } else if (grp == 1) {
        const bf16_t* q = proj + rowq * NP + C_FQ + hd * 64; const bf16_t* K = proj + rb * NP + C_FK + hd * 64; const bf16_t* V = proj + rb * NP + C_FV + hd * 64; const float* fb = (const float*)(ws + WS_FB) + (size_t)(b * 4 + hd) * S;
        const float q0 = dbg_bf(q + lane); const float ft = fb[t];
        ref = dbg_attn(0, t, [&](int kv) { return wave_sum(q0 * dbg_bf(K + (size_t)kv * NP + lane)) * 0.125f + (fb[kv] - ft) * 0.125f; },
                       [&](int kv, int d) { return dbg_bf(V + (size_t)kv * NP + d); }, lane);
    } else if (grp == 2) {
        float* sc = scratch; unsigned char* selb = (unsigned char*)(scratch + 8192);
        const int ih = lane >> 4, dd = (lane & 15) * 2;
        const float qa = dbg_bf(proj + rowq * NP + C_IQ + ih * 32 + dd), qb2 = dbg_bf(proj + rowq * NP + C_IQ + ih * 32 + dd + 1); const float wgt = side[rowq * 32 + 4 + ih] * 0.5f;
        for (int kv = 0; kv <= t; ++kv) { float pr = qa * dbg_bf(proj + (rb + kv) * NP + C_IK + dd) + qb2 * dbg_bf(proj + (rb + kv) * NP + C_IK + dd + 1);
            pr += __shfl_xor(pr, 1); pr += __shfl_xor(pr, 2); pr += __shfl_xor(pr, 4); pr += __shfl_xor(pr, 8);
            float v = wgt * fmaxf(pr, 0.f); v += __shfl_xor(v, 16); v += __shfl_xor(v, 32); if (lane == 0) sc[kv] = v; }
        __threadfence_block();
        if (t + 1 <= 256) { for (int kv = lane; kv <= t; kv += 64) selb[kv] = 1; }
        else {
#ifdef DBG_KEY32
#define DBGKEY(x) ({ const unsigned u_ = __float_as_uint(x); (u_ & 0x80000000u) ? ~u_ : (u_ | 0x80000000u); })
            unsigned lo = 0, hi2 = 0xffffffffu;
#else
#define DBGKEY(x) score_key16(x)
            unsigned lo = 0, hi2 = 0xffffu;
#endif
            while (lo < hi2) { const unsigned mid = lo + ((hi2 - lo) >> 1) + ((hi2 - lo) & 1u); int c = 0; for (int kv = lane; kv <= t; kv += 64) c += (DBGKEY(sc[kv]) >= mid); c = (int)wave_sum((float)c); if (c >= 256) lo = mid; else hi2 = mid - 1; }
            const unsigned T = lo; int cgt = 0; for (int kv = lane; kv <= t; kv += 64) cgt += (DBGKEY(sc[kv]) > T); cgt = (int)wave_sum((float)cgt);
            int need = 256 - cgt; int run = 0;
            for (int k0 = 0; k0 <= t; k0 += 64) { const int kv = k0 + lane; const unsigned k = kv <= t ? DBGKEY(sc[kv]) : 0u; const bool eq = kv <= t && k == T, gt = kv <= t && k > T;
                const unsigned long long bm = __ballot(eq); const int before = __popcll(bm & ((1ull << lane) - 1ull));
                if (kv <= t) selb[kv] = (gt || (eq && run + before < need)) ? 1 : 0; run += __popcll(bm); }
        }
        __threadfence_block();
        const bf16_t* q = proj + rowq * NP + C_DQ + hd * 64; const bf16_t* K = proj + rb * NP + C_DK + hd * 64; const bf16_t* V = proj + rb * NP + C_DV + hd * 64; const float q0 = dbg_bf(q + lane);
        ref = dbg_attn(0, t, [&](int kv) { if (!selb[kv]) return -INFINITY; return wave_sum(q0 * dbg_bf(K + (size_t)kv * NP + lane)) * 0.125f - slope * (float)(t - kv); },
                       [&](int kv, int d) { return dbg_bf(V + (size_t)kv * NP + d); }, lane);
    } else {
        const int sub = DBG_GROUP / 10;
        const bf16_t* q = proj + rowq * NP + C_NQ; const float q0 = dbg_bf(q + hd * 64 + lane);
        const bf16_t* kc = (const bf16_t*)(ws + WS_KC) + (size_t)b * 512 * 64; const bf16_t* vc = (const bf16_t*)(ws + WS_VC) + (size_t)b * 512 * 64;
        float* pc = scratch;
        for (int h2 = 0; h2 < 4; ++h2) { const float qh = dbg_bf(q + h2 * 64 + lane); const float sl = (h2 == 0) ? 0.25f : (h2 == 1 ? 0.0625f : (h2 == 2 ? 0.015625f : 0.00390625f));
            float m = -INFINITY; for (int n = 0; n < 511; ++n) { if (16 * n + 31 > t) break; const float s_ = wave_sum(qh * dbg_bf(kc + n * 64 + lane)) * 0.125f - sl * (float)(t - (16 * n + 31)); if (lane == 0) pc[h2 * 512 + n] = s_; m = fmaxf(m, s_); }
            __threadfence_block(); float l = 0.f; for (int n = 0; n < 511 && 16 * n + 31 <= t; ++n) l += __expf(pc[h2 * 512 + n] - m);
            __threadfence_block(); for (int n = lane; n < 511; n += 64) pc[h2 * 512 + n] = (16 * n + 31 <= t) ? __expf(pc[h2 * 512 + n] - m) / l : 0.f; __threadfence_block(); }
        float oc = 0.f; for (int n = 0; n < 511 && 16 * n + 31 <= t; ++n) oc += pc[hd * 512 + n] * dbg_bf(vc + n * 64 + lane);
        const int cur = t >> 6; float v0, v1;
        { float i0 = 0.f, i1 = 0.f; for (int h2 = 0; h2 < 4; ++h2) for (int e = -1; e <= 3; ++e) { int n0 = 4 * lane + e, n1 = 4 * (lane + 64) + e; if (n0 >= 0 && n0 < 511) i0 += pc[h2 * 512 + n0]; if (n1 < 511) i1 += pc[h2 * 512 + n1]; }
          v0 = (lane == 0 || lane == cur) ? INFINITY : (lane > cur ? -INFINITY : i0); v1 = (lane + 64 == cur) ? INFINITY : (lane + 64 > cur ? -INFINITY : i1); }
        unsigned long long slo = 0, shi = 0;
        for (int it = 0; it < 16; ++it) { float mx = fmaxf(v0, v1); for (int o = 1; o < 64; o <<= 1) mx = fmaxf(mx, __shfl_xor(mx, o)); if (!(mx > -INFINITY)) break;
            const unsigned long long b0 = __ballot(v0 == mx), b1 = __ballot(v1 == mx);
            if (b0) { const int j = __ffsll((long long)b0) - 1; slo |= 1ull << j; if (lane == j) v0 = -INFINITY; } else { const int j = __ffsll((long long)b1) - 1; shi |= 1ull << j; if (lane == j) v1 = -INFINITY; } }
        const bf16_t* Ks = proj + rb * NP + C_KSEL; const bf16_t* Vs = proj + rb * NP + C_VSEL; const bf16_t* Kw = proj + rb * NP + C_KWIN; const bf16_t* Vw = proj + rb * NP + C_VWIN;
        const float os = dbg_attn(0, t, [&](int kv) { const int j = kv >> 6; const bool in = j < 64 ? ((slo >> j) & 1ull) : ((shi >> (j - 64)) & 1ull); if (!in) return -INFINITY;
                                      return wave_sum(q0 * dbg_bf(Ks + (size_t)kv * NP + lane)) * 0.125f - slope * (float)(t - kv); }, [&](int kv, int d) { return dbg_bf(Vs + (size_t)kv * NP + d); }, lane);
        const float ow = dbg_attn(t - 511 > 0 ? t - 511 : 0, t, [&](int kv) { return wave_sum(q0 * dbg_bf(Kw + (size_t)kv * NP + lane)) * 0.125f - slope * (float)(t - kv); }, [&](int kv, int d) { return dbg_bf(Vw + (size_t)kv * NP + d); }, lane);
        const float g0 = sigmoid_f(side[rowq * 32 + 8 + hd * 3]), g1 = sigmoid_f(side[rowq * 32 + 8 + hd * 3 + 1]), g2 = sigmoid_f(side[rowq * 32 + 8 + hd * 3 + 2]);
        ref = g0 * oc + g1 * os + g2 * ow;
        (void)sub;
    }
    const float got = dbg_bf(ocat + rowq * D + grp * 256 + hd * 64 + lane);
    const float d2 = wave_sum((got - ref) * (got - ref)), r2 = wave_sum(ref * ref);
    float* acc = (float*)(ws + WS_CTL + 8192);
    if (lane == 0) { atomicAdd(acc, d2); atomicAdd(acc + 1, r2); }
}

__device__ __forceinline__ void dbg_sincos(double ang, float& cs, float& sn) {
    const double twopi = 6.283185307179586476925; double r = ang - twopi * __builtin_floor(ang / twopi + 0.5);
    const double r2 = r * r; double sterm = r, cterm = 1.0, ssum = r, csum = 1.0;
    for (int k = 1; k <= 14; ++k) { cterm *= -r2 / (double)((2 * k - 1) * (2 * k)); sterm *= -r2 / (double)((2 * k) * (2 * k + 1)); csum += cterm; ssum += sterm; }
    cs = (float)csum; sn = (float)ssum;
}
__device__ __forceinline__ int dbg_mapwin(int n) { return MapWin{}(n); }
#define DBG_ACC(got, ref) do { const float g_ = (got), r_ = (ref); d2 += (g_ - r_) * (g_ - r_); r2 += r_ * r_; } while (0)
__global__ void __launch_bounds__(64) dbg_check2(Params P) {
    const int lane = threadIdx.x, wid = blockIdx.x; const int ri = wid % 48, b = wid / 48; const int t = dbg_rows[ri];
    unsigned char* ws = P.ws; const bf16_t* proj = (const bf16_t*)(ws + WS_PROJ); const float* side = (const float*)(ws + WS_SIDE);
    const size_t rowq = (size_t)b * S + t; const int l = DBG_LAYER;
    float d2 = 0.f, r2 = 0.f;
    const int grp = DBG_GROUP;
    if (grp == 4) {
        if (wid < 16 && lane == 0) { const int hd = wid & 3, bb = wid >> 2; double run = 0.0; const float* fb = (const float*)(ws + WS_FB) + (size_t)wid * S; const float bf = P.in[10][l * 4 + hd];
            for (int tt = 0; tt < S; ++tt) { const double v = (double)side[((size_t)bb * S + tt) * 32 + hd] + (double)bf; const double y = (v < 0 ? v : 0.0) - log1p(exp(-fabs(v))); run += y; DBG_ACC(fb[tt], (float)(-8.0 * run)); } }
    } else if (grp == 5) {
        float ss = 0.f; for (int k = lane; k < 192; k += 64) { const float v = dbg_bf(proj + rowq * NP + k); ss += v * v; } ss = wave_sum(ss); const float rs = 1.0f / sqrtf(ss / 192.f + EPS);
        const float* wq = P.in[7] + (size_t)l * 192 * 384; const float* gq = P.in[6] + l * 192; const bf16_t* qm = (const bf16_t*)(ws + WS_QMLA) + rowq * 384;
        for (int o = lane; o < 384; o += 64) { float a = 0.f; for (int k = 0; k < 192; ++k) a += dbg_bf(proj + rowq * NP + k) * rs * gq[k] * wq[(size_t)k * 384 + o]; ((float*)(ws + WS_H))[(size_t)wid * 512 + o] = a; }
        __threadfence_block();
        const float* qv = (const float*)(ws + WS_H) + (size_t)wid * 512;
        for (int hd = 0; hd < 4; ++hd) { { const int w = lane; DBG_ACC(dbg_bf(qm + hd * 96 + w), qv[hd * 96 + w]); }
            if (lane < 16) { const int i = lane; const float invf = (float)pow(10000.0, -(double)i / 16.0); float cs, sn; dbg_sincos((double)((float)t * invf), cs, sn);
                const float x1 = qv[hd * 96 + 64 + i], x2 = qv[hd * 96 + 80 + i]; DBG_ACC(dbg_bf(qm + hd * 96 + 64 + 2 * i), x1 * cs - x2 * sn); DBG_ACC(dbg_bf(qm + hd * 96 + 64 + 2 * i + 1), x1 * sn + x2 * cs); } }
    } else if (grp == 6) {
        float ss = 0.f; for (int k = lane; k < 128; k += 64) { const float v = dbg_bf(proj + rowq * NP + C_KVLAT + k); ss += v * v; } ss = wave_sum(ss); const float rs = 1.0f / sqrtf(ss / 128.f + EPS);
        const float* wk = P.in[9] + (size_t)l * 128 * 512; const float* gk = P.in[8] + l * 128; const bf16_t* km = (const bf16_t*)(ws + WS_KMLA) + rowq * 384; const bf16_t* vm = (const bf16_t*)(ws + WS_VMLA) + rowq * 256;
        for (int o = lane; o < 512; o += 64) { float a = 0.f; for (int k = 0; k < 128; ++k) a += dbg_bf(proj + rowq * NP + C_KVLAT + k) * rs * gk[k] * wk[(size_t)k * 512 + o];
            const int hd = o >> 7, w = o & 127; if (w < 64) DBG_ACC(dbg_bf(km + hd * 96 + w), a); else DBG_ACC(dbg_bf(vm + hd * 64 + w - 64), a); }
        if (lane < 16) { const int i = lane; const float invf = (float)pow(10000.0, -(double)i / 16.0); float cs, sn; dbg_sincos((double)((float)t * invf), cs, sn);
            const float x1 = dbg_bf(proj + rowq * NP + C_KROPE + i), x2 = dbg_bf(proj + rowq * NP + C_KROPE + 16 + i);
            for (int hd = 0; hd < 4; ++hd) { DBG_ACC(dbg_bf(km + hd * 96 + 64 + 2 * i), x1 * cs - x2 * sn); DBG_ACC(dbg_bf(km + hd * 96 + 64 + 2 * i + 1), x1 * sn + x2 * cs); } }
    } else if (grp == 7) {
        const int n = (t >> 4) > 510 ? 510 : (t >> 4);
        for (int kv = 0; kv < 2; ++kv) { const float* w1 = P.in[12] + (size_t)(l * 2 + kv) * 2048 * 64; const float* w2 = P.in[13] + (size_t)(l * 2 + kv) * 64 * 64; const float* pe = P.in[11] + (size_t)(l * 2 + kv) * 2048;
            float a = 0.f; for (int k = 0; k < 2048; ++k) { const int j = k >> 6, d = k & 63; a += (dbg_bf(proj + ((size_t)b * S + 16 * n + j) * NP + (kv ? C_VCMP : C_KCMP) + d) + pe[k]) * w1[(size_t)k * 64 + lane]; }
            const float hv = silu_f(a); float o = 0.f; for (int k = 0; k < 64; ++k) o += __shfl(hv, k) * w2[k * 64 + lane];
            DBG_ACC(dbg_bf((const bf16_t*)(ws + (kv ? WS_VC : WS_KC)) + ((size_t)b * 512 + n) * 64 + lane), o); }
    } else if (grp == 8) {
        const float* c = P.in[1]; const float* mod = (const float*)(ws + WS_MOD);
        for (int idx = wid * 64 + lane; idx < 2 * 4 * 3072; idx += gridDim.x * 64) { const int ll = idx / (4 * 3072), bb = (idx / 3072) & 3, n = idx % 3072; float a = P.in[4][ll * 3072 + n];
            for (int k = 0; k < 1024; ++k) a += silu_f(c[bb * 1024 + k]) * P.in[3][((size_t)ll * 1024 + k) * 3072 + n]; DBG_ACC(mod[idx], a); }
    } else if (grp == 9) {
        const float* x = P.in[0] + rowq * D; const float* mod = (const float*)(ws + WS_MOD) + (size_t)(l * 4 + b) * 3072; float* hrow = (float*)(ws + WS_H) + (size_t)wid * 1024;
        float ss = 0.f; for (int k = lane; k < D; k += 64) ss += x[k] * x[k]; ss = wave_sum(ss); const float rs = 1.0f / sqrtf(ss / D + EPS);
        for (int k = lane; k < D; k += 64) hrow[k] = x[k] * rs * P.in[2][l * D + k] * (1.0f + mod[1024 + k]) + mod[k];
        __threadfence_block();
        const float* w = P.in[5] + (size_t)l * D * 3732;
        for (int n = lane; n < 3732; n += 64) { const int oc = dbg_mapwin(n); float a = 0.f; for (int k = 0; k < D; ++k) a += hrow[k] * w[(size_t)k * 3732 + oc];
            DBG_ACC(dbg_bf(proj + rowq * NP + n), a); if (n >= C_SIDE) DBG_ACC(side[rowq * 32 + n - C_SIDE], a); }
    } else if (grp == 10) {
        const bf16_t* oc = (const bf16_t*)(ws + WS_OCAT) + rowq * D; const bf16_t* oa = (const bf16_t*)(ws + WS_H) + rowq * D;
        for (int g = 0; g < 4; ++g) { float ss = 0.f; for (int k = lane; k < 256; k += 64) { const float v = dbg_bf(oc + g * 256 + k); ss += v * v; } ss = wave_sum(ss); const float rs = 1.0f / sqrtf(ss / 256.f + EPS);
            for (int k = lane; k < 256; k += 64) { const int cc = g * 256 + k; DBG_ACC(dbg_bf(oa + cc), dbg_bf(oc + cc) * rs * P.in[14][l * D + cc] * silu_f(dbg_bf(proj + rowq * NP + C_GZ + cc))); } }
    } else if (grp == 11) {
        const bf16_t* oa = (const bf16_t*)(ws + WS_H) + rowq * D; const float* mod = (const float*)(ws + WS_MOD) + (size_t)(l * 4 + b) * 3072; const float* w = P.in[15] + (size_t)l * D * D;
        for (int n = lane; n < D; n += 64) { float a = 0.f; for (int k = 0; k < D; ++k) a += dbg_bf(oa + k) * w[(size_t)k * D + n]; DBG_ACC(P.out[rowq * D + n], P.in[0][rowq * D + n] + mod[2048 + n] * a); }
    }
    d2 = wave_sum(d2); r2 = wave_sum(r2);
    float* acc = (float*)(ws + WS_CTL + 8192);
    if (lane == 0) { atomicAdd(acc, d2); atomicAdd(acc + 1, r2); }
}
__global__ void dbg_scale(Params P) {
    const float* acc = (const float*)(P.ws + WS_CTL + 8192);
    float v = sqrtf(acc[0] / fmaxf(acc[1], 1e-30f)); v = fminf(fmaxf(v, 1e-4f), 1.0f);
    const float code = 0.1f * powf(100.0f, (log10f(v) + 4.0f) * 0.25f); const float delta = sqrtf(code);
    for (size_t i = (size_t)blockIdx.x * blockDim.x + threadIdx.x; i < (size_t)M * D; i += (size_t)gridDim.x * blockDim.x) P.out[i] *= (1.0f + delta);
}
#endif

#ifndef N_CUTS
#define N_CUTS 1
#endif
extern "C" void kernel_launch(void* const* d_in, const int* in_sizes, int n_in, void* d_out, int out_size, void* d_ws, size_t ws_size, hipStream_t stream) {
    static int grid = 0;
    if (grid == 0) {
        if (n_in != 17 || out_size != M * D || ws_size < WS_END) { fprintf(stderr, "kernel_launch: unexpected problem (n_in %d out %d ws %zu need %zu)\n", n_in, out_size, ws_size, (size_t)WS_END); grid = -1; return; }
        int dev = 0, cus = 0, per_cu = 0;
        hipGetDevice(&dev); hipDeviceGetAttribute(&cus, hipDeviceAttributeMultiprocessorCount, dev);
        hipFuncSetAttribute((const void*)hymba_fwd, hipFuncAttributeMaxDynamicSharedMemorySize, LDS_BYTES);
        hipOccupancyMaxActiveBlocksPerMultiprocessor(&per_cu, (const void*)hymba_fwd, NTHREADS, LDS_BYTES);
        if (per_cu < 1) { fprintf(stderr, "kernel_launch: occupancy query says %d blocks/CU\n", per_cu); grid = -1; return; }
        grid = cus;
    }
    if (grid < 0) return;
    (void)hipMemsetAsync((char*)d_ws + WS_CTL, 0, 131072, stream);
    Params p{};
    for (int i = 0; i < 17; ++i) p.in[i] = (const float*)d_in[i];
    p.out = (float*)d_out; p.ws = (unsigned char*)d_ws;
#if defined(DBG_GROUP)
    auto run = [&](int lo, int hi) { p.ph_lo = lo; p.ph_hi = hi; p.bar_region = (lo == 0) ? 0 : 1; void* args[] = {&p};
        hipError_t e = hipLaunchCooperativeKernel((const void*)hymba_fwd, dim3(grid), dim3(NTHREADS), args, LDS_BYTES, stream);
        if (e != hipSuccess) fprintf(stderr, "cooperative launch failed: %s (grid %d)\n", hipGetErrorString(e), grid); };
    auto check = [&]() { if (DBG_GROUP % 10 >= 4 || (DBG_GROUP >= 10 && DBG_GROUP < 13)) hipLaunchKernelGGL(dbg_check2, dim3(4 * 48), dim3(64), 0, stream, p);
                         else hipLaunchKernelGGL(dbg_check, dim3(4 * 48 * 4), dim3(64), 0, stream, p); };
    if (DBG_LAYER == 0) { run(0, 8); check(); run(8, 16); } else { run(0, 16); check(); }
    hipLaunchKernelGGL(dbg_scale, dim3(1024), dim3(256), 0, stream, p);
#elif defined(REPEAT_PHASE)
    { const int bounds[3][2] = {{0, REPEAT_PHASE + 1}, {REPEAT_PHASE, N_PHASES}, {0, 0}};
      for (int c = 0; c < 2; ++c) { p.ph_lo = bounds[c][0]; p.ph_hi = bounds[c][1]; p.bar_region = c; void* args[] = {&p};
        hipError_t e = hipLaunchCooperativeKernel((const void*)hymba_fwd, dim3(grid), dim3(NTHREADS), args, LDS_BYTES, stream);
        if (e != hipSuccess) { fprintf(stderr, "cooperative launch failed: %s (grid %d)\n", hipGetErrorString(e), grid); return; } } }
#else
    const int cuts = N_CUTS;
    for (int c = 0; c < cuts; ++c) {
        p.ph_lo = (N_PHASES * c) / cuts; p.ph_hi = (N_PHASES * (c + 1)) / cuts; p.bar_region = c;
        void* args[] = {&p};
        hipError_t e = hipLaunchCooperativeKernel((const void*)hymba_fwd, dim3(grid), dim3(NTHREADS), args, LDS_BYTES, stream);
        if (e != hipSuccess) { fprintf(stderr, "cooperative launch failed: %s (grid %d)\n", hipGetErrorString(e), grid); return; }
    }
#endif
}
```

```cpp
#define PREP_SHIFT 4
#include <hip/hip_runtime.h>
#include <hip/hip_cooperative_groups.h>
#include <cstdio>
#include <cstdint>
namespace cg = cooperative_groups;

#define LAS __attribute__((address_space(3)))
typedef unsigned short bf16_t;
typedef short bf16x8 __attribute__((ext_vector_type(8)));
typedef short s16x4 __attribute__((ext_vector_type(4)));
typedef float f32x2 __attribute__((ext_vector_type(2)));
typedef float f32x4 __attribute__((ext_vector_type(4)));
typedef float f32x16 __attribute__((ext_vector_type(16)));
typedef unsigned u32x2 __attribute__((ext_vector_type(2)));
typedef unsigned u32x4 __attribute__((ext_vector_type(4)));
typedef __bf16 bf16x2_t __attribute__((ext_vector_type(2)));

constexpr int NB = 4, S = 8192, D = 1024, M = NB * S, NP = 3840, DEPTH = 2;
constexpr int C_QLAT = 0, C_KVLAT = 192, C_KROPE = 320, C_FQ = 352, C_FK = 608, C_FV = 864, C_DQ = 1120, C_DK = 1376, C_DV = 1632,
              C_IQ = 1888, C_IK = 2016, C_NQ = 2048, C_KCMP = 2304, C_VCMP = 2368, C_KSEL = 2432, C_VSEL = 2496, C_KWIN = 2560,
              C_VWIN = 2624, C_GZ = 2688, C_SIDE = 3712;
constexpr float EPS = 1e-6f;
constexpr float LOG2E = 1.4426950408889634f;
constexpr int NTHREADS = 512;
constexpr int LDS_BYTES = 155648;

constexpr size_t MiB = 1u << 20;
constexpr size_t WS_CTL = 0;
constexpr size_t WS_WIN = 1 * MiB;
constexpr size_t WS_WOUT = 16 * MiB;
constexpr size_t WS_WUQ = 20 * MiB;
constexpr size_t WS_WUKV = 20 * MiB + 512 * 1024;
constexpr size_t WS_W1T = 21 * MiB;
constexpr size_t WS_CVEC = 22 * MiB;
constexpr size_t WS_MOD = 22 * MiB + 4096;
constexpr size_t WS_ROPE = 23 * MiB;
constexpr size_t WS_RSTD = 24 * MiB;
constexpr size_t WS_FB = 24 * MiB + 512 * 1024;
constexpr size_t WS_KC = 25 * MiB;
constexpr size_t WS_VC = 25 * MiB + 512 * 1024;
constexpr size_t WS_SIDE = 26 * MiB;
constexpr size_t WS_H = 30 * MiB;
constexpr size_t WS_QMLA = 94 * MiB;
constexpr size_t WS_KMLA = 118 * MiB;
constexpr size_t WS_VMLA = 142 * MiB;
constexpr size_t WS_MASK = 158 * MiB;
constexpr size_t WS_OCAT = 190 * MiB;
constexpr size_t WS_PROJ = 254 * MiB;
constexpr size_t WS_KIDX = ((WS_PROJ + (size_t)(M + 64) * NP * 2 + MiB - 1) / MiB) * MiB;
constexpr size_t WS_SSQ = WS_KIDX + 2 * MiB;
constexpr size_t WS_END = WS_SSQ + 2 * MiB;

struct Params {
    const float* in[17];
    float* out;
    unsigned char* ws;
    int ph_lo, ph_hi, bar_region, pad;
};

__device__ __forceinline__ unsigned pk2(float lo, float hi) { f32x2 v = {lo, hi}; bf16x2_t b = __builtin_convertvector(v, bf16x2_t); return __builtin_bit_cast(unsigned, b); }
__device__ __forceinline__ float bf2f(unsigned short b) { return __uint_as_float(((unsigned)b) << 16); }
__device__ __forceinline__ float bflo(unsigned u) { return __uint_as_float(u << 16); }
__device__ __forceinline__ float bfhi(unsigned u) { return __uint_as_float(u & 0xffff0000u); }
__device__ __forceinline__ float wave_sum(float v) {
    v += __builtin_bit_cast(float, __builtin_amdgcn_update_dpp(0, __builtin_bit_cast(int, v), 0xB1, 0xf, 0xf, false));
    v += __builtin_bit_cast(float, __builtin_amdgcn_update_dpp(0, __builtin_bit_cast(int, v), 0x4E, 0xf, 0xf, false));
    v += __builtin_bit_cast(float, __builtin_amdgcn_update_dpp(0, __builtin_bit_cast(int, v), 0x141, 0xf, 0xf, false));
    v += __builtin_bit_cast(float, __builtin_amdgcn_update_dpp(0, __builtin_bit_cast(int, v), 0x140, 0xf, 0xf, false));
    const float r0 = __builtin_bit_cast(float, __builtin_amdgcn_readlane(__builtin_bit_cast(int, v), 0)), r1 = __builtin_bit_cast(float, __builtin_amdgcn_readlane(__builtin_bit_cast(int, v), 16));
    const float r2 = __builtin_bit_cast(float, __builtin_amdgcn_readlane(__builtin_bit_cast(int, v), 32)), r3 = __builtin_bit_cast(float, __builtin_amdgcn_readlane(__builtin_bit_cast(int, v), 48));
    return (r0 + r1) + (r2 + r3);
}
__device__ __forceinline__ float silu_f(float x) { return x / (1.0f + __expf(-x)); }
__device__ __forceinline__ float sigmoid_f(float x) { return 1.0f / (1.0f + __expf(-x)); }
__device__ __forceinline__ float silu_fast(float x) { return x * __builtin_amdgcn_rcpf(1.0f + __expf(-x)); }
__device__ __forceinline__ int crow(int r, int hi) { return (r & 3) + 8 * (r >> 2) + 4 * hi; }
__device__ __forceinline__ int opaque_tid(int wid0) { int t; asm volatile("v_mbcnt_lo_u32_b32 %0, -1, 0\n\tv_mbcnt_hi_u32_b32 %0, -1, %0\n\tv_lshl_add_u32 %0, %1, 6, %0" : "=&v"(t) : "s"(wid0)); return t; }

namespace pg8 {
constexpr int BM = 256, BK = 64, HALF = 128, HTB = HALF * BK * 2, STAGE_BYTES = 8 * HTB, NXCD = 8, WGM = 8;
__host__ __device__ __forceinline__ int lds_byte(int r, int c) { const int st = (r >> 4) * 2 + (c >> 5), rr = r & 15, cc = c & 31, ob = rr * 64 + cc * 2; return st * 1024 + (ob ^ (((ob >> 9) & 1) << 5)); }
__host__ __device__ __forceinline__ void stage_rc(int b, int& R, int& C) { const int st = b / 1024, sb = b % 1024, swz = sb ^ (((sb >> 9) & 1) << 5); R = (st >> 1) * 16 + swz / 64; C = (st & 1) * 32 + (swz % 64) / 2; }
__host__ __device__ __forceinline__ int perm32(int rho) { const int n = rho >> 4, i = rho & 15; return 8 * (i >> 2) + 4 * n + (i & 3); }
struct Unit { int pm, pn; };
struct Gemm { const bf16_t* A; const bf16_t* Bt; int M, N, K, lda, ldb; };
struct StaticOrder {
    int nM, nN, nwg, G, c;
    __device__ void init(int M_, int N_, int G_, int c_) { nM = M_ / BM; nN = N_ / BM; nwg = nM * nN; G = G_; c = c_; }
    __device__ bool next(int i, Unit& u) const {
        const long L = (long)i * G + c; if (L >= nwg) return false;
        int wgid = (int)L; { const int q = nwg / NXCD, r = nwg % NXCD, xcd = wgid % NXCD, off = wgid / NXCD; wgid = (xcd < r ? xcd * (q + 1) : r * (q + 1) + (xcd - r) * q) + off; }
        const int nig = WGM * nN, gid = wgid / nig, fm = gid * WGM, gsz = (nM - fm) < WGM ? (nM - fm) : WGM;
        u.pm = fm + ((wgid % nig) % gsz); u.pn = (wgid % nig) / gsz; return true;
    }
};

template <class Epi, bool ALIGN_EPI>
__device__ __forceinline__ void gemm_phase(LAS unsigned char* lds, const Gemm g, const StaticOrder& S_, const Epi& E, int wid0) {
    const int tid = opaque_tid(wid0), wid = __builtin_amdgcn_readfirstlane(tid >> 6), lane = tid & 63, wr = wid >> 2, wc = wid & 3, fr = lane & 15, fq = lane >> 4;
    const int K = g.K, nt = K / BK;
    unsigned voffA[2], voffB[2];
#pragma unroll
    for (int i = 0; i < 2; ++i) { int R, C; stage_rc(tid * 16 + i * 8192, R, C); const int Rb = ((R & ~31) + perm32(R & 31));
        voffA[i] = (unsigned)(R * g.lda + C) * 2u; voffB[i] = (unsigned)(Rb * g.ldb + C) * 2u; }
    const size_t kstep = (size_t)(BK * 2);
    const size_t hstepA = (size_t)HALF * g.lda * 2, hstepB = (size_t)HALF * g.ldb * 2;
    const size_t tstepA = 2 * hstepA, tstepB = 2 * hstepB;
    const unsigned ldsw = (unsigned)wid * 1024u;
    const int aoff = lds_byte(wr * 64 + fr, fq * 8), boff = lds_byte(wc * 32 + fr, fq * 8);
#define PG8_SA(b, h) (((b) * 2 + (h)) * HTB)
#define PG8_SB(b, h) ((4 + (b) * 2 + (h)) * HTB)
#define PG8_STAGE(bufoff, gbase, voff) do { _Pragma("unroll") for (int _i = 0; _i < 2; ++_i) \
        __builtin_amdgcn_global_load_lds((const unsigned*)((const char*)(gbase) + (voff)[_i]), (LAS unsigned*)(lds + (bufoff) + ldsw + _i * 8192), 16, 0, 0); } while (0)
#define PG8_LDA(dst, b, h) do { _Pragma("unroll") for (int m = 0; m < 4; ++m) _Pragma("unroll") for (int k = 0; k < 2; ++k) dst[m][k] = *(const LAS bf16x8*)(lds + PG8_SA(b, h) + aoff + m * 2048 + k * 1024); } while (0)
#define PG8_LDB(dst, b, h) do { _Pragma("unroll") for (int n = 0; n < 2; ++n) _Pragma("unroll") for (int k = 0; k < 2; ++k) dst[n][k] = *(const LAS bf16x8*)(lds + PG8_SB(b, h) + boff + n * 2048 + k * 1024); } while (0)
#define PG8_MMA(ai, bj, At, Bt) do { __builtin_amdgcn_s_setprio(1); _Pragma("unroll") for (int m = 0; m < 4; ++m) _Pragma("unroll") for (int n = 0; n < 2; ++n) _Pragma("unroll") for (int k = 0; k < 2; ++k) \
        acc[ai][bj][m][n] = __builtin_amdgcn_mfma_f32_16x16x32_bf16(Bt[n][k], At[m][k], acc[ai][bj][m][n], 0, 0, 0); __builtin_amdgcn_s_setprio(0); } while (0)
#define PG8_WAIT_V(n) asm volatile("s_waitcnt vmcnt(" #n ")" ::: "memory")
#define PG8_WAIT_L(n) asm volatile("s_waitcnt lgkmcnt(" #n ")" ::: "memory")
#define PG8_BAR __builtin_amdgcn_s_barrier()
#define PG8_SCHED __builtin_amdgcn_sched_barrier(0)
    Unit cur, nxt; int ui = 0;
    if (!S_.next(0, cur)) return;
    LAS float* const gtab = (LAS float*)(lds + STAGE_BYTES);
    if constexpr (Epi::GROUPSCALE) E.fill(gtab, cur.pm, tid);
    f32x4 acc[2][2][4][2];
#pragma unroll
    for (int a = 0; a < 2; ++a)
#pragma unroll
        for (int b = 0; b < 2; ++b)
#pragma unroll
            for (int m = 0; m < 4; ++m)
#pragma unroll
                for (int n = 0; n < 2; ++n) acc[a][b][m][n] = (f32x4){0.f, 0.f, 0.f, 0.f};
    bf16x8 At[4][2], B0[2][2], B1[2][2];
    const char* cA = (const char*)g.A + (size_t)cur.pm * tstepA; const char* cB = (const char*)g.Bt + (size_t)cur.pn * tstepB;
    PG8_STAGE(PG8_SB(0, 0), cB, voffB); PG8_STAGE(PG8_SB(0, 1), cB + hstepB, voffB); PG8_STAGE(PG8_SA(0, 0), cA, voffA); PG8_STAGE(PG8_SA(0, 1), cA + hstepA, voffA);
    if (wr == 1) PG8_BAR;
    PG8_WAIT_V(2); PG8_BAR;
    PG8_STAGE(PG8_SB(1, 0), cB + kstep, voffB); PG8_STAGE(PG8_SA(1, 0), cA + kstep, voffA); PG8_STAGE(PG8_SB(1, 1), cB + hstepB + kstep, voffB);
    PG8_WAIT_V(6); PG8_BAR;
    for (;;) {
        const bool has_next = S_.next(ui + 1, nxt);
        const char* nA = has_next ? (const char*)g.A + (size_t)nxt.pm * tstepA : cA; const char* nB = has_next ? (const char*)g.Bt + (size_t)nxt.pn * tstepB : cB;
        if constexpr (Epi::GROUPSCALE) { if (has_next) E.fill(gtab + ((ui + 1) & 1) * 1024, nxt.pm, tid); }
        for (int t = 0; t < nt; t += 2) {
            if constexpr (Epi::GROUPSCALE) {
                int tq = t; asm volatile("" : "+s"(tq));
                if (tq != 0 && (tq & 3) == 0) {
                    const LAS float* tb = gtab + (ui & 1) * 1024 + ((tq >> 2) - 1);
#pragma unroll
                    for (int a = 0; a < 2; ++a)
#pragma unroll
                        for (int m = 0; m < 4; ++m) { const float r = tb[(a * HALF + wr * 64 + m * 16 + fr) * 4];
#pragma unroll
                            for (int b = 0; b < 2; ++b)
#pragma unroll
                                for (int n = 0; n < 2; ++n) acc[a][b][m][n] = acc[a][b][m][n] * r; }
                }
            }
            const bool last = (t == nt - 2);
            const char* a1 = cA + (size_t)(t + 1) * kstep;
            const char* a2 = last ? nA : cA + (size_t)(t + 2) * kstep; const char* b2 = last ? nB : cB + (size_t)(t + 2) * kstep;
            const char* a3 = a2 + kstep; const char* b3 = b2 + kstep;
            PG8_LDB(B0, 0, 0); PG8_LDB(B1, 0, 1); PG8_SCHED; PG8_LDA(At, 0, 0); PG8_STAGE(PG8_SA(1, 1), a1 + hstepA, voffA);
            PG8_WAIT_V(8); PG8_WAIT_L(0); PG8_BAR; PG8_MMA(0, 0, At, B0); PG8_MMA(0, 1, At, B1); PG8_BAR; PG8_SCHED;
            PG8_LDA(At, 0, 1); PG8_STAGE(PG8_SB(0, 0), b2, voffB); PG8_STAGE(PG8_SB(0, 1), b2 + hstepB, voffB); PG8_STAGE(PG8_SA(0, 0), a2, voffA);
            PG8_WAIT_V(8); PG8_WAIT_L(0); PG8_BAR; PG8_MMA(1, 0, At, B0); PG8_MMA(1, 1, At, B1); PG8_BAR; PG8_SCHED;
            PG8_LDB(B0, 1, 0); PG8_LDB(B1, 1, 1); PG8_SCHED; PG8_LDA(At, 1, 0); PG8_STAGE(PG8_SA(0, 1), a2 + hstepA, voffA);
            PG8_WAIT_V(8); PG8_WAIT_L(0); PG8_BAR; PG8_MMA(0, 0, At, B0); PG8_MMA(0, 1, At, B1); PG8_BAR; PG8_SCHED;
            PG8_LDA(At, 1, 1); PG8_STAGE(PG8_SB(1, 0), b3, voffB); PG8_STAGE(PG8_SB(1, 1), b3 + hstepB, voffB); PG8_STAGE(PG8_SA(1, 0), a3, voffA);
            PG8_WAIT_V(8); PG8_WAIT_L(0); PG8_BAR; PG8_MMA(1, 0, At, B0); PG8_MMA(1, 1, At, B1); PG8_BAR; PG8_SCHED;
        }
        if constexpr (ALIGN_EPI) { if (wr == 0) PG8_BAR; }
        if constexpr (Epi::GROUPSCALE) E(acc, cur, wr, wc, fr, fq, gtab + (ui & 1) * 1024); else E(acc, cur, wr, wc, fr, fq);
        if (!has_next) break;
#pragma unroll
        for (int a = 0; a < 2; ++a)
#pragma unroll
            for (int b = 0; b < 2; ++b)
#pragma unroll
                for (int m = 0; m < 4; ++m)
#pragma unroll
                    for (int n = 0; n < 2; ++n) acc[a][b][m][n] = (f32x4){0.f, 0.f, 0.f, 0.f};
        cur = nxt; cA = nA; cB = nB; ++ui;
        if constexpr (ALIGN_EPI) { if (wr == 1) PG8_BAR; }
    }
    PG8_WAIT_V(0);
    if constexpr (!ALIGN_EPI) { if (wr == 0) PG8_BAR; }
    PG8_BAR;
#undef PG8_SA
#undef PG8_SB
#undef PG8_STAGE
#undef PG8_LDA
#undef PG8_LDB
#undef PG8_MMA
#undef PG8_WAIT_V
#undef PG8_WAIT_L
#undef PG8_BAR
#undef PG8_SCHED
}

struct EpiProj {
    static constexpr bool GROUPSCALE = false;
    bf16_t* proj; float* side;
    __device__ __forceinline__ void operator()(const f32x4 (&acc)[2][2][4][2], const Unit& u, int wr, int wc, int fr, int fq) const {
        const int row0 = u.pm * BM + wr * 64 + fr, col0 = u.pn * BM + wc * 32 + 8 * fq;
#pragma unroll
        for (int ai = 0; ai < 2; ++ai)
#pragma unroll
            for (int m = 0; m < 4; ++m) { const int row = row0 + ai * HALF + m * 16; bf16_t* rowp = proj + (size_t)row * NP + col0;
#pragma unroll
                for (int bj = 0; bj < 2; ++bj) { const f32x4 v0 = acc[ai][bj][m][0], v1 = acc[ai][bj][m][1];
                    u32x4 w; w.x = pk2(v0[0], v0[1]); w.y = pk2(v0[2], v0[3]); w.z = pk2(v1[0], v1[1]); w.w = pk2(v1[2], v1[3]);
                    *(u32x4*)(rowp + bj * HALF) = w;
                    if (bj == 1 && u.pn == 14 && wc == 0) { float* sp = side + (size_t)row * 32 + 8 * fq; *(f32x4*)sp = v0; *(f32x4*)(sp + 4) = v1; } } }
    }
};
struct EpiQup {
    static constexpr bool GROUPSCALE = false;
    bf16_t* q; const float* rstd; const float* rope;
    __device__ __forceinline__ void operator()(const f32x4 (&acc)[2][2][4][2], const Unit& u, int wr, int wc, int fr, int fq) const {
        const int row0 = u.pm * BM + wr * 64 + fr;
#pragma unroll
        for (int ai = 0; ai < 2; ++ai)
#pragma unroll
            for (int m = 0; m < 4; ++m) { const int row = row0 + ai * HALF + m * 16; const float rs = rstd[(size_t)row * 2]; const int pos = row & (S - 1);
#pragma unroll
                for (int bj = 0; bj < 2; ++bj) { const int c = u.pn * BM + bj * HALF + wc * 32 + 8 * fq;
                    if (c < 384) { const int w0 = c % 96;
                        f32x4 v0 = acc[ai][bj][m][0] * rs, v1 = acc[ai][bj][m][1] * rs;
                        if (w0 >= 64) { const int i0 = (w0 - 64) >> 1; const float* tp = rope + ((size_t)pos * 16 + i0) * 2;
                            const f32x4 t0 = *(const f32x4*)tp, t1 = *(const f32x4*)(tp + 4);
                            f32x4 a, b;
                            a[0] = v0[0] * t0[0] - v0[1] * t0[1]; a[1] = v0[0] * t0[1] + v0[1] * t0[0];
                            a[2] = v0[2] * t0[2] - v0[3] * t0[3]; a[3] = v0[2] * t0[3] + v0[3] * t0[2];
                            b[0] = v1[0] * t1[0] - v1[1] * t1[1]; b[1] = v1[0] * t1[1] + v1[1] * t1[0];
                            b[2] = v1[2] * t1[2] - v1[3] * t1[3]; b[3] = v1[2] * t1[3] + v1[3] * t1[2];
                            v0 = a; v1 = b; }
                        u32x4 w; w.x = pk2(v0[0], v0[1]); w.y = pk2(v0[2], v0[3]); w.z = pk2(v1[0], v1[1]); w.w = pk2(v1[2], v1[3]);
                        *(u32x4*)(q + (size_t)row * 384 + c) = w; } }
                asm volatile("" ::: "memory"); }
    }
};
struct EpiKVup {
    static constexpr bool GROUPSCALE = false;
    bf16_t* k; bf16_t* v; const float* rstd;
    __device__ __forceinline__ void operator()(const f32x4 (&acc)[2][2][4][2], const Unit& u, int wr, int wc, int fr, int fq) const {
        const int row0 = u.pm * BM + wr * 64 + fr;
#pragma unroll
        for (int ai = 0; ai < 2; ++ai)
#pragma unroll
            for (int m = 0; m < 4; ++m) { const int row = row0 + ai * HALF + m * 16; const float rs = rstd[(size_t)row * 2 + 1];
#pragma unroll
                for (int bj = 0; bj < 2; ++bj) { const int c = u.pn * BM + bj * HALF + wc * 32 + 8 * fq; const int hd = c >> 7, w0 = c & 127;
                    const f32x4 v0 = acc[ai][bj][m][0] * rs, v1 = acc[ai][bj][m][1] * rs;
                    u32x4 w; w.x = pk2(v0[0], v0[1]); w.y = pk2(v0[2], v0[3]); w.z = pk2(v1[0], v1[1]); w.w = pk2(v1[2], v1[3]);
                    bf16_t* dst = (w0 < 64) ? (k + (size_t)row * 384 + hd * 96 + w0) : (v + (size_t)row * 256 + hd * 64 + (w0 - 64));
                    *(u32x4*)dst = w; }
                asm volatile("" ::: "memory"); }
    }
};
struct EpiOut {
    static constexpr bool GROUPSCALE = true;
    const float* res; float* out; const float* gate;
    const float* ssq;
    __device__ __forceinline__ void fill(LAS float* tab, int pm, int tid) const {
        if (tid < 256) { const f32x4* sp = (const f32x4*)(ssq + (size_t)(pm * BM + tid) * 16); const f32x4 a = sp[0], b = sp[1], c = sp[2], d = sp[3];
            const float q0 = (a[0] + a[1]) + (a[2] + a[3]), q1 = (b[0] + b[1]) + (b[2] + b[3]), q2 = (c[0] + c[1]) + (c[2] + c[3]), q3 = (d[0] + d[1]) + (d[2] + d[3]);
            const float m0 = q0 * (1.f / 256.f) + EPS, m1 = q1 * (1.f / 256.f) + EPS, m2 = q2 * (1.f / 256.f) + EPS, m3 = q3 * (1.f / 256.f) + EPS;
            f32x4 w; w[0] = sqrtf(m1 / m0); w[1] = sqrtf(m2 / m1); w[2] = sqrtf(m3 / m2); w[3] = 1.0f / sqrtf(m3);
            *(LAS f32x4*)(tab + tid * 4) = w; }
    }
    __device__ __forceinline__ void operator()(const f32x4 (&acc)[2][2][4][2], const Unit& u, int wr, int wc, int fr, int fq, const LAS float* tab) const {
        const int row0 = u.pm * BM + wr * 64 + fr; const int b = (u.pm * BM) / S;
        float s3[2][4];
#pragma unroll
        for (int ai = 0; ai < 2; ++ai)
#pragma unroll
            for (int m = 0; m < 4; ++m) s3[ai][m] = tab[(ai * HALF + wr * 64 + m * 16 + fr) * 4 + 3];
#pragma unroll
        for (int bj = 0; bj < 2; ++bj) { const int c = u.pn * BM + bj * HALF + wc * 32 + 8 * fq;
            const f32x4 g0 = *(const f32x4*)(gate + (size_t)b * 3072 + c), g1 = *(const f32x4*)(gate + (size_t)b * 3072 + c + 4);
#pragma unroll
            for (int ai = 0; ai < 2; ++ai)
#pragma unroll
                for (int m = 0; m < 4; ++m) { const int row = row0 + ai * HALF + m * 16; const size_t off = (size_t)row * D + c;
                    const f32x4 r0 = *(const f32x4*)(res + off), r1 = *(const f32x4*)(res + off + 4);
                    *(f32x4*)(out + off) = r0 + (g0 * s3[ai][m]) * acc[ai][bj][m][0]; *(f32x4*)(out + off + 4) = r1 + (g1 * s3[ai][m]) * acc[ai][bj][m][1]; } }
    }
};
}

struct MapWin { __device__ __forceinline__ int operator()(int n) const {
    if (n < 1120) return n; if (n < 2048) return n + 4; if (n < 2688) return n + 8; if (n < 3712) return n + 20;
    if (n < 3716) return 1120 + (n - 3712); if (n < 3720) return 2052 + (n - 3716); if (n < 3732) return 2696 + (n - 3720); return -1; } };
struct MapId { int N; __device__ __forceinline__ int operator()(int n) const { return n < N ? n : -1; } };
struct MapUq { __device__ __forceinline__ int operator()(int n) const { if (n >= 384) return -1; const int hd = n / 96, w = n % 96; if (w < 64) return hd * 96 + w;
    const int p = (w - 64) >> 1, which = (w - 64) & 1; return hd * 96 + 64 + (which ? 16 + p : p); } };

template <class ColMap>
__device__ __forceinline__ void tr_tile(const float* src, int lds_src, int Ksrc, const float* kscale, bf16_t* dst, int ldd, int n0, int k0, ColMap cm, LAS float* scr, int wid0) {
    const int tid = opaque_tid(wid0);
#pragma unroll
    for (int i = 0; i < 8; ++i) { const int idx = tid + i * NTHREADS, kk = idx >> 6, nn = idx & 63; const int sc = cm(n0 + nn), k = k0 + kk;
        float v = 0.f; if (sc >= 0 && k < Ksrc) { v = src[(size_t)k * lds_src + sc]; if (kscale) v *= kscale[k]; }
        scr[kk * 65 + nn] = v; }
    __syncthreads();
    { const int nn = tid >> 3, kc = tid & 7; const LAS float* s = scr + (kc * 8) * 65 + nn;
      u32x4 w; w.x = pk2(s[0], s[65]); w.y = pk2(s[2 * 65], s[3 * 65]); w.z = pk2(s[4 * 65], s[5 * 65]); w.w = pk2(s[6 * 65], s[7 * 65]);
      *(u32x4*)(dst + (size_t)(n0 + nn) * ldd + k0 + kc * 8) = w; }
    __syncthreads();
}

__device__ __forceinline__ void phase_prologue(const Params& P, LAS unsigned char* lds, int bid, int G, int wid0) {
    const int tid = opaque_tid(wid0);
    LAS float* scr = (LAS float*)lds;
    const float* w_in = P.in[5]; const float* w_uq = P.in[7]; const float* w_ukv = P.in[9]; const float* w1 = P.in[12]; const float* w_out = P.in[15];
    constexpr int T_WIN = 60 * 16, T_WOUT = 16 * 16, T_UQ = 8 * 4, T_UKV = 8 * 2, T_W1 = 1 * 32 * 2;
    constexpr int T_L = T_WIN + T_WOUT + T_UQ + T_UKV + T_W1;
    for (int it = bid; it < DEPTH * T_L; it += G) {
        const int l = it / T_L; int r = it % T_L;
        if (r < T_WIN) { tr_tile(w_in + (size_t)l * D * 3732, 3732, D, nullptr, (bf16_t*)(P.ws + WS_WIN) + (size_t)l * NP * D, D, (r / 16) * 64, (r % 16) * 64, MapWin{}, scr, wid0); continue; } r -= T_WIN;
        if (r < T_WOUT) { tr_tile(w_out + (size_t)l * D * D, D, D, nullptr, (bf16_t*)(P.ws + WS_WOUT) + (size_t)l * D * D, D, (r / 16) * 64, (r % 16) * 64, MapId{D}, scr, wid0); continue; } r -= T_WOUT;
        if (r < T_UQ) { tr_tile(w_uq + (size_t)l * 192 * 384, 384, 192, P.in[6] + l * 192, (bf16_t*)(P.ws + WS_WUQ) + (size_t)l * 512 * 256, 256, (r / 4) * 64, (r % 4) * 64, MapUq{}, scr, wid0); continue; } r -= T_UQ;
        if (r < T_UKV) { tr_tile(w_ukv + (size_t)l * 128 * 512, 512, 128, P.in[8] + l * 128, (bf16_t*)(P.ws + WS_WUKV) + (size_t)l * 512 * 128, 128, (r / 2) * 64, (r % 2) * 64, MapId{512}, scr, wid0); continue; } r -= T_UKV;
        { const int kv = r / 32, kt = r % 32; tr_tile(w1 + (size_t)(l * 2 + kv) * 2048 * 64, 64, 2048, nullptr, (bf16_t*)(P.ws + WS_W1T) + (size_t)(l * 2 + kv) * 64 * 2048, 2048, 0, kt * 64, MapId{64}, scr, wid0); }
    }
    {
        LAS float* sc = (LAS float*)lds;
        LAS float* red = (LAS float*)(lds + 16384);
        const float* c = P.in[1]; const float* w_ada = P.in[3]; const float* b_ada = P.in[4]; float* mod = (float*)(P.ws + WS_MOD);
        bool loaded = false;
        for (int it = bid; it < DEPTH * 48; it += G) {
            if (!loaded) { for (int i = tid; i < 4096; i += NTHREADS) sc[i] = silu_f(c[i]); loaded = true; __syncthreads(); }
            const int l = it / 48, cb = it % 48, col = tid & 63, ks = tid >> 6;
            const float* wp = w_ada + (size_t)l * D * 3072 + (size_t)(ks * 128) * 3072 + cb * 64 + col;
            float a0 = 0.f, a1 = 0.f, a2 = 0.f, a3 = 0.f;
#pragma unroll 8
            for (int k = 0; k < 128; ++k) { const float w = wp[(size_t)k * 3072]; const int kk = ks * 128 + k;
                a0 += sc[kk] * w; a1 += sc[1024 + kk] * w; a2 += sc[2048 + kk] * w; a3 += sc[3072 + kk] * w; }
            red[(ks * 64 + col) * 4 + 0] = a0; red[(ks * 64 + col) * 4 + 1] = a1; red[(ks * 64 + col) * 4 + 2] = a2; red[(ks * 64 + col) * 4 + 3] = a3;
            __syncthreads();
            if (tid < 256) { const int cc = tid & 63, b = tid >> 6; float s = b_ada[l * 3072 + cb * 64 + cc];
#pragma unroll
                for (int k8 = 0; k8 < 8; ++k8) s += red[(k8 * 64 + cc) * 4 + b];
                mod[(size_t)(l * 4 + b) * 3072 + cb * 64 + cc] = s; }
            __syncthreads();
        }
    }
    {
        float* tab = (float*)(P.ws + WS_ROPE);
        for (int idx = bid * NTHREADS + tid; idx < S * 16; idx += G * NTHREADS) {
            const int pos = idx >> 4, i = idx & 15;
            const double f4[4] = {1.0, 0.5623413251903491, 0.31622776601683794, 0.1778279410038923};
            double inv = (i & 3) == 0 ? f4[0] : ((i & 3) == 1 ? f4[1] : ((i & 3) == 2 ? f4[2] : f4[3]));
            inv *= ((i >> 2) == 0 ? 1.0 : ((i >> 2) == 1 ? 0.1 : ((i >> 2) == 2 ? 0.01 : 0.001)));
            const float invf = (float)inv; const float angf = (float)pos * invf;
            const double rev = (double)angf * 0.15915494309189535; const double fr = rev - __builtin_floor(rev);
            const float f = (float)fr;
            tab[(size_t)idx * 2] = __builtin_amdgcn_cosf(f); tab[(size_t)idx * 2 + 1] = __builtin_amdgcn_sinf(f);
        }
    }
    {
        const float* pos = P.in[11]; float* cvec = (float*)(P.ws + WS_CVEC);
        LAS float* red = (LAS float*)(lds + 65536);
        for (int it = bid; it < DEPTH * 2; it += G) {
            __syncthreads();
            const int col = tid & 63, ks = tid >> 6; float a = 0.f;
            const float* wp = w1 + (size_t)it * 2048 * 64 + (size_t)(ks * 256) * 64 + col; const float* pp = pos + (size_t)it * 2048 + ks * 256;
            for (int k = 0; k < 256; ++k) a += pp[k] * wp[(size_t)k * 64];
            red[ks * 64 + col] = a; __syncthreads();
            if (tid < 64) { float s = 0.f; for (int k8 = 0; k8 < 8; ++k8) s += red[k8 * 64 + tid]; cvec[it * 64 + tid] = s; }
            __syncthreads();
        }
    }
}

__device__ __forceinline__ void phase_hnorm(const float* x, const float* g, const float* mod  , bf16_t* h, int bid, int G, int wid0) {
    const int tid_ = opaque_tid(wid0); const int lane = tid_ & 63, wv = tid_ >> 6;
    for (int row = bid * 8 + wv; row < M; row += G * 8) {
        const f32x4* xr = (const f32x4*)(x + (size_t)row * D) + lane;
        f32x4 v[4]; float s = 0.f;
#pragma unroll
        for (int j = 0; j < 4; ++j) { v[j] = xr[64 * j]; s += (v[j][0] * v[j][0] + v[j][1] * v[j][1]) + (v[j][2] * v[j][2] + v[j][3] * v[j][3]); }
        const float rstd = 1.0f / sqrtf(wave_sum(s) * (1.f / D) + EPS);
        const int b = row / S; const float* sh = mod + (size_t)b * 3072; const float* scl = sh + 1024;
        unsigned long long* o8 = (unsigned long long*)(h + (size_t)row * D) + lane;
#pragma unroll
        for (int j = 0; j < 4; ++j) { const int c = (64 * j + lane) * 4; const f32x4 gg = *(const f32x4*)(g + c), ss = *(const f32x4*)(scl + c), hh = *(const f32x4*)(sh + c);
            f32x4 y;
#pragma unroll
            for (int e = 0; e < 4; ++e) y[e] = v[j][e] * rstd * gg[e] * (1.0f + ss[e]) + hh[e];
            o8[64 * j] = (unsigned long long)pk2(y[0], y[1]) | ((unsigned long long)pk2(y[2], y[3]) << 32); }
    }
}

__device__ __forceinline__ void phase_prep(const Params& P, int l, LAS unsigned char* lds, int bid, int G, int wid0) {
    const int tid = opaque_tid(wid0), lane = tid & 63, wv = tid >> 6;
    const bf16_t* proj = (const bf16_t*)(P.ws + WS_PROJ); const float* side = (const float*)(P.ws + WS_SIDE);
    {
        float* rstd = (float*)(P.ws + WS_RSTD); bf16_t* kmla = (bf16_t*)(P.ws + WS_KMLA); const float* rope = (const float*)(P.ws + WS_ROPE);
        const bool shift_ = (G == 256 && M == 32768);
        const int nk_ = shift_ ? ((bid < 128) ? 16 - PREP_SHIFT : 16 + PREP_SHIFT) : (M + G * 8 - 1) / (G * 8);
        for (int k_ = 0; k_ < nk_; ++k_) {
            const int row = (shift_ && k_ >= 16) ? (bid - 128) * 8 + wv + (16 - PREP_SHIFT + (k_ - 16)) * G * 8 : bid * 8 + wv + k_ * G * 8;
            if (row >= M) break;
            const bf16_t* pr = proj + (size_t)row * NP;
            float sq = 0.f, skv = 0.f;
            if (lane < 40) { const u32x4 w = *(const u32x4*)(pr + lane * 8); float s = 0.f;
#pragma unroll
                for (int e = 0; e < 4; ++e) { const float a = bflo(w[e]), b = bfhi(w[e]); s += a * a + b * b; }
                if (lane < 24) sq = s; else skv = s; }
            sq = wave_sum(sq); skv = wave_sum(skv);
            if (lane == 0) { rstd[(size_t)row * 2] = 1.0f / sqrtf(sq * (1.f / 192.f) + EPS); rstd[(size_t)row * 2 + 1] = 1.0f / sqrtf(skv * (1.f / 128.f) + EPS); }
            if (lane >= 48 && lane < 52) *(u32x4*)((bf16_t*)(P.ws + WS_KIDX) + (size_t)row * 32 + (lane - 48) * 8) = *(const u32x4*)(pr + C_IK + (lane - 48) * 8);
            if (lane < 16) { const float x1 = bf2f(pr[C_KROPE + lane]), x2 = bf2f(pr[C_KROPE + 16 + lane]); const int pos = row & (S - 1);
                const float cs = rope[((size_t)pos * 16 + lane) * 2], sn = rope[((size_t)pos * 16 + lane) * 2 + 1];
                const unsigned w = pk2(x1 * cs - x2 * sn, x1 * sn + x2 * cs);
#pragma unroll
                for (int hd = 0; hd < 4; ++hd) *(unsigned*)(kmla + (size_t)row * 384 + hd * 96 + 64 + 2 * lane) = w; }
        }
    }
    {
        float* fb = (float*)(P.ws + WS_FB); const float* b_f = P.in[10] + l * 4; LAS float* wtot = (LAS float*)lds;
        for (int it = (G >= 160) ? bid - (G - 16) : bid; it < 16; it += G) {
            if (it < 0) break;
            const int b = it >> 2, hd = it & 3; const float bf = b_f[hd];
            float ls[16]; float s = 0.f;
#pragma unroll
            for (int i = 0; i < 16; ++i) { const int t = tid * 16 + i; const float v = side[((size_t)b * S + t) * 32 + hd] + bf;
                const float y = fminf(v, 0.f) - log1pf(__expf(-fabsf(v))); ls[i] = y; s += y; }
            float inc = s;
#pragma unroll
            for (int o = 1; o < 64; o <<= 1) { const float t = __shfl_up(inc, o); if (lane >= o) inc += t; }
            __syncthreads();
            if (lane == 63) wtot[wv] = inc;
            __syncthreads();
            float base = 0.f;
            for (int w = 0; w < wv; ++w) base += wtot[w];
            float run = base + inc - s;
#pragma unroll
            for (int i = 0; i < 16; ++i) { run += ls[i]; fb[((size_t)it) * S + tid * 16 + i] = -8.0f * run; }
            __syncthreads();
        }
    }
    {
        const bf16_t* w1t = (const bf16_t*)(P.ws + WS_W1T) + (size_t)l * 2 * 64 * 2048; const float* cvec = (const float*)(P.ws + WS_CVEC) + l * 2 * 64;
        const float* w2 = P.in[13] + (size_t)l * 2 * 64 * 64;
        LAS float* part = (LAS float*)lds;
        LAS float* hb = (LAS float*)(lds + 65536);
        const int r = lane & 31, hi = lane >> 5;
        for (int it = bid; it < 128; it += G) {
            const int b = it >> 5, kv = (it >> 4) & 1, nt = it & 15, n0 = nt * 32;
            const int colbase = kv ? C_VCMP : C_KCMP;
            const bf16_t* w1k = w1t + (size_t)kv * 64 * 2048;
            f32x16 a0 = {}, a1 = {};
#pragma unroll
            for (int j = 0; j < 4; ++j) { const int tok = wv * 4 + j;
                const bf16_t* ap = proj + ((size_t)b * S + 16 * (n0 + r) + tok) * NP + colbase + hi * 8;
#pragma unroll
                for (int s = 0; s < 4; ++s) { const bf16x8 af = *(const bf16x8*)(ap + s * 16);
                    const int kb = tok * 64 + s * 16 + hi * 8;
                    const bf16x8 b0 = *(const bf16x8*)(w1k + (size_t)r * 2048 + kb), b1 = *(const bf16x8*)(w1k + (size_t)(32 + r) * 2048 + kb);
                    a0 = __builtin_amdgcn_mfma_f32_32x32x16_bf16(af, b0, a0, 0, 0, 0); a1 = __builtin_amdgcn_mfma_f32_32x32x16_bf16(af, b1, a1, 0, 0, 0); } }
#pragma unroll
            for (int reg = 0; reg < 16; ++reg) { const int n = crow(reg, hi); part[(wv * 32 + n) * 64 + r] = a0[reg]; part[(wv * 32 + n) * 64 + 32 + r] = a1[reg]; }
            __syncthreads();
            { const int n = tid >> 4, c4 = (tid & 15) * 4;
#pragma unroll
              for (int e = 0; e < 4; ++e) { float s = cvec[kv * 64 + c4 + e];
#pragma unroll
                  for (int w = 0; w < 8; ++w) s += part[(w * 32 + n) * 64 + c4 + e];
                  hb[n * 64 + c4 + e] = silu_f(s); } }
            __syncthreads();
            { const int n = tid >> 4, c4 = (tid & 15) * 4; float o[4] = {0.f, 0.f, 0.f, 0.f}; const float* w2k = w2 + (size_t)kv * 64 * 64;
              for (int k = 0; k < 64; ++k) { const float hv = hb[n * 64 + k]; const f32x4 wv4 = *(const f32x4*)(w2k + k * 64 + c4);
                  o[0] += hv * wv4[0]; o[1] += hv * wv4[1]; o[2] += hv * wv4[2]; o[3] += hv * wv4[3]; }
              bf16_t* dst = (bf16_t*)(P.ws + (kv ? WS_VC : WS_KC)) + ((size_t)b * 512 + n0 + n) * 64 + c4;
              const bool valid = (n0 + n) < 511;
              u32x2 w; w.x = valid ? pk2(o[0], o[1]) : 0u; w.y = valid ? pk2(o[2], o[3]) : 0u; *(u32x2*)dst = w; }
            __syncthreads();
        }
    }
}

constexpr float NEG_BIG = -1e30f;
constexpr int KSTR64 = 144, KSTR96 = 208;
constexpr int ATT_KBUF = 64 * KSTR96;
constexpr int ATT_VBUF = 8192;
constexpr int ATT_K0 = 0, ATT_V0 = 2 * ATT_KBUF, ATT_B0 = ATT_V0 + 2 * ATT_VBUF, ATT_END = ATT_B0 + 2 * 256;
constexpr int ATT_EXTRA = 45056;

struct SoftState { float m, l; f32x16 o0, o1; };

template <int KS>
__device__ __forceinline__ void qk_tile(f32x16& p0, f32x16& p1, const LAS unsigned char* kt, int kstride, const bf16x8 (&qf)[KS], int r, int hi) {
    const LAS unsigned char* k0 = kt + r * kstride + hi * 16; const LAS unsigned char* k1 = k0 + 32 * kstride;
#pragma unroll
    for (int s = 0; s < KS; ++s) { const bf16x8 a0 = *(const LAS bf16x8*)(k0 + s * 32), a1 = *(const LAS bf16x8*)(k1 + s * 32);
        p0 = __builtin_amdgcn_mfma_f32_32x32x16_bf16(a0, qf[s], p0, 0, 0, 0); p1 = __builtin_amdgcn_mfma_f32_32x32x16_bf16(a1, qf[s], p1, 0, 0, 0); }
}
__device__ __forceinline__ float max3f(float a, float b, float c);
__device__ __forceinline__ float tile_max(const f32x16& p0, const f32x16& p1) {
    float a = max3f(p0[0], p0[1], p1[0]), b = max3f(p0[2], p0[3], p1[1]); a = max3f(a, p1[2], p1[3]);
#pragma unroll
    for (int i = 4; i < 16; i += 4) { a = max3f(a, p0[i], p0[i + 1]); b = max3f(b, p0[i + 2], p0[i + 3]); a = max3f(a, p1[i], p1[i + 1]); b = max3f(b, p1[i + 2], p1[i + 3]); }
    a = max3f(a, b, b);
    const auto rr = __builtin_amdgcn_permlane32_swap(__float_as_uint(a), __float_as_uint(a), false, false);
    return fmaxf(__uint_as_float(rr[0]), __uint_as_float(rr[1]));
}
__device__ __forceinline__ bf16x8 vfrag(const LAS unsigned char* p) {
    const s16x4 lo = __builtin_bit_cast(s16x4, __builtin_amdgcn_ds_read_tr16_b64_v4i16((LAS s16x4*)p));
    const s16x4 hi = __builtin_bit_cast(s16x4, __builtin_amdgcn_ds_read_tr16_b64_v4i16((LAS s16x4*)(p + 512)));
    return (bf16x8){lo[0], lo[1], lo[2], lo[3], hi[0], hi[1], hi[2], hi[3]};
}
__device__ __forceinline__ bf16x8 pfrag(const f32x16& p, int b) {
    u32x4 w; w.x = pk2(p[b], p[b + 1]); w.y = pk2(p[b + 2], p[b + 3]); w.z = pk2(p[b + 4], p[b + 5]); w.w = pk2(p[b + 6], p[b + 7]);
    return __builtin_bit_cast(bf16x8, w);
}
__device__ __forceinline__ void pv_frag(f32x16& o0, f32x16& o1, bf16x8 pf0, bf16x8 pf1, bf16x8 pf2, bf16x8 pf3, const LAS unsigned char* vt, int vb) {
    const LAS unsigned char* v = vt + vb;
    o0 = __builtin_amdgcn_mfma_f32_32x32x16_bf16(vfrag(v), pf0, o0, 0, 0, 0);            o1 = __builtin_amdgcn_mfma_f32_32x32x16_bf16(vfrag(v + 4096), pf0, o1, 0, 0, 0);
    o0 = __builtin_amdgcn_mfma_f32_32x32x16_bf16(vfrag(v + 1024), pf1, o0, 0, 0, 0);     o1 = __builtin_amdgcn_mfma_f32_32x32x16_bf16(vfrag(v + 4096 + 1024), pf1, o1, 0, 0, 0);
    o0 = __builtin_amdgcn_mfma_f32_32x32x16_bf16(vfrag(v + 2048), pf2, o0, 0, 0, 0);     o1 = __builtin_amdgcn_mfma_f32_32x32x16_bf16(vfrag(v + 4096 + 2048), pf2, o1, 0, 0, 0);
    o0 = __builtin_amdgcn_mfma_f32_32x32x16_bf16(vfrag(v + 3072), pf3, o0, 0, 0, 0);     o1 = __builtin_amdgcn_mfma_f32_32x32x16_bf16(vfrag(v + 4096 + 3072), pf3, o1, 0, 0, 0);
}
__device__ __forceinline__ void pv_tile(f32x16& o0, f32x16& o1, const f32x16& p0, const f32x16& p1, const LAS unsigned char* vt, int vb) {
    pv_frag(o0, o1, pfrag(p0, 0), pfrag(p0, 8), pfrag(p1, 0), pfrag(p1, 8), vt, vb);
}
__device__ __forceinline__ void softmax_step(SoftState& st, f32x16& p0, f32x16& p1, float c2) {
    const float mx = tile_max(p0, p1);
    const float mn = fmaxf(st.m, mx);
    if (__any(mn > st.m)) { const float al = __builtin_amdgcn_exp2f((st.m - mn) * c2); st.l *= al; st.o0 *= al; st.o1 *= al; st.m = mn; }
    const float mc = st.m * c2; float sum = 0.f;
#pragma unroll
    for (int i = 0; i < 16; ++i) { p0[i] = __builtin_amdgcn_exp2f(__builtin_fmaf(p0[i], c2, -mc)); p1[i] = __builtin_amdgcn_exp2f(__builtin_fmaf(p1[i], c2, -mc)); sum += p0[i] + p1[i]; }
    st.l += sum;
}

__device__ __forceinline__ float max3f(float a, float b, float c) { float r; asm("v_max3_f32 %0, %1, %2, %3" : "=v"(r) : "v"(a), "v"(b), "v"(c)); return r; }
__device__ __forceinline__ float swap32_max(float a) { const auto rr = __builtin_amdgcn_permlane32_swap(__float_as_uint(a), __float_as_uint(a), false, false);
    float r; asm("v_max_f32_e32 %0, %1, %2" : "=v"(r) : "v"(__uint_as_float(rr[0])), "v"(__uint_as_float(rr[1]))); return r; }
__device__ __forceinline__ float quad_xor1(float x) { return __builtin_bit_cast(float, __builtin_amdgcn_update_dpp(0, __builtin_bit_cast(int, x), 0xB1, 0xf, 0xf, false)); }
__device__ __forceinline__ float quad_xor2(float x) { return __builtin_bit_cast(float, __builtin_amdgcn_update_dpp(0, __builtin_bit_cast(int, x), 0x4E, 0xf, 0xf, false)); }
__device__ __forceinline__ float swap32_sum(float a) { const auto rr = __builtin_amdgcn_permlane32_swap(__float_as_uint(a), __float_as_uint(a), false, false); return __uint_as_float(rr[0]) + __uint_as_float(rr[1]); }
constexpr float SM_THR = 8.0f;
__device__ __forceinline__ void softmax_pack(SoftState& st, const f32x16& p0, const f32x16& p1, float c2, bf16x8& pf0, bf16x8& pf1, bf16x8& pf2, bf16x8& pf3) {
    float a = max3f(p0[0], p0[1], p1[0]), b = max3f(p0[2], p0[3], p1[1]); a = max3f(a, p1[2], p1[3]);
#pragma unroll
    for (int i = 4; i < 16; i += 4) { a = max3f(a, p0[i], p0[i + 1]); b = max3f(b, p0[i + 2], p0[i + 3]); a = max3f(a, p1[i], p1[i + 1]); b = max3f(b, p1[i + 2], p1[i + 3]); }
    float mx; asm("v_max_f32_e32 %0, %1, %2" : "=v"(mx) : "v"(a), "v"(b));
    mx = swap32_max(mx);
    if (__any((mx - st.m) * c2 > SM_THR)) { const float mn = fmaxf(st.m, mx); const float al = __builtin_amdgcn_exp2f((st.m - mn) * c2); st.l *= al; st.o0 *= al; st.o1 *= al; st.m = mn; }
    const float mc = -st.m * c2; float s0 = 0.f, s1 = 0.f;
    u32x4 w0, w1, w2, w3;
#define SMP(W, E, P, B) do { const float e0_ = __builtin_amdgcn_exp2f(__builtin_fmaf(P[B], c2, mc)), e1_ = __builtin_amdgcn_exp2f(__builtin_fmaf(P[B + 1], c2, mc)); s0 += e0_; s1 += e1_; W[E] = pk2(e0_, e1_); } while (0)
    SMP(w0, 0, p0, 0); SMP(w0, 1, p0, 2); SMP(w0, 2, p0, 4); SMP(w0, 3, p0, 6);
    SMP(w1, 0, p0, 8); SMP(w1, 1, p0, 10); SMP(w1, 2, p0, 12); SMP(w1, 3, p0, 14);
    SMP(w2, 0, p1, 0); SMP(w2, 1, p1, 2); SMP(w2, 2, p1, 4); SMP(w2, 3, p1, 6);
    SMP(w3, 0, p1, 8); SMP(w3, 1, p1, 10); SMP(w3, 2, p1, 12); SMP(w3, 3, p1, 14);
#undef SMP
    st.l += s0 + s1;
    pf0 = __builtin_bit_cast(bf16x8, w0); pf1 = __builtin_bit_cast(bf16x8, w1); pf2 = __builtin_bit_cast(bf16x8, w2); pf3 = __builtin_bit_cast(bf16x8, w3);
}

__device__ __forceinline__ void sm_exp_pack(SoftState& st, const f32x16& p0, const f32x16& p1, float c2, bf16x8& pf0, bf16x8& pf1, bf16x8& pf2, bf16x8& pf3) {
    const float mc = -st.m * c2; float s0 = 0.f, s1 = 0.f;
    u32x4 w0, w1, w2, w3;
#define SMP(W, E, P, B) do { const float e0_ = __builtin_amdgcn_exp2f(__builtin_fmaf(P[B], c2, mc)), e1_ = __builtin_amdgcn_exp2f(__builtin_fmaf(P[B + 1], c2, mc)); s0 += e0_; s1 += e1_; W[E] = pk2(e0_, e1_); } while (0)
    SMP(w0, 0, p0, 0); SMP(w0, 1, p0, 2); SMP(w0, 2, p0, 4); SMP(w0, 3, p0, 6);
    SMP(w1, 0, p0, 8); SMP(w1, 1, p0, 10); SMP(w1, 2, p0, 12); SMP(w1, 3, p0, 14);
    SMP(w2, 0, p1, 0); SMP(w2, 1, p1, 2); SMP(w2, 2, p1, 4); SMP(w2, 3, p1, 6);
    SMP(w3, 0, p1, 8); SMP(w3, 1, p1, 10); SMP(w3, 2, p1, 12); SMP(w3, 3, p1, 14);
#undef SMP
    st.l += s0 + s1;
    pf0 = __builtin_bit_cast(bf16x8, w0); pf1 = __builtin_bit_cast(bf16x8, w1); pf2 = __builtin_bit_cast(bf16x8, w2); pf3 = __builtin_bit_cast(bf16x8, w3);
}

template <int DK> struct StageRegs { u32x4 k0, k1, v; float b; };
template <int DK>
__device__ __forceinline__ void stage_load(StageRegs<DK>& sr, const bf16_t* K, int ldk, const bf16_t* V, int ldv, const float* bias, int kv0, int wid0) {
    const int tid = opaque_tid(wid0); constexpr int CPR = DK / 8;
    { const int row = tid / CPR, cc = tid % CPR; sr.k0 = *(const u32x4*)(K + (size_t)(kv0 + row) * ldk + cc * 8); }
    if (DK == 96 && tid < 256) { const int c = tid + 512, row = c / CPR, cc = c % CPR; sr.k1 = *(const u32x4*)(K + (size_t)(kv0 + row) * ldk + cc * 8); }
    { const int row = tid >> 3, cc = tid & 7; sr.v = *(const u32x4*)(V + (size_t)(kv0 + row) * ldv + cc * 8); }
    if (bias && tid < 64) sr.b = bias[kv0 + tid];
}
template <int DK>
__device__ __forceinline__ void stage_store(const StageRegs<DK>& sr, LAS unsigned char* lds, int buf, bool has_bias, int wid0) {
    const int tid = opaque_tid(wid0); constexpr int CPR = DK / 8; constexpr int KSTR = (DK == 96) ? KSTR96 : KSTR64;
    LAS unsigned char* kb = lds + ATT_K0 + buf * ATT_KBUF; LAS unsigned char* vb = lds + ATT_V0 + buf * ATT_VBUF;
    { const int row = tid / CPR, cc = tid % CPR; *(LAS u32x4*)(kb + row * KSTR + cc * 16) = sr.k0; }
    if (DK == 96 && tid < 256) { const int c = tid + 512, row = c / CPR, cc = c % CPR; *(LAS u32x4*)(kb + row * KSTR + cc * 16) = sr.k1; }
    { const int row = tid >> 3, cc = tid & 7; *(LAS u32x4*)(vb + (cc >> 2) * 4096 + row * 64 + (cc & 3) * 16) = sr.v; }
    if (has_bias && tid < 64) *(LAS float*)(lds + ATT_B0 + buf * 256 + tid * 4) = sr.b;
}

__device__ __forceinline__ void store_out(bf16_t* dst  , const f32x16& o0, const f32x16& o1, float scale, int hi) {
#pragma unroll
    for (int g = 0; g < 4; ++g) {
        u32x2 w; w.x = pk2(o0[4 * g] * scale, o0[4 * g + 1] * scale); w.y = pk2(o0[4 * g + 2] * scale, o0[4 * g + 3] * scale);
        *(u32x2*)(dst + 8 * g + 4 * hi) = w;
        u32x2 w1; w1.x = pk2(o1[4 * g] * scale, o1[4 * g + 1] * scale); w1.y = pk2(o1[4 * g + 2] * scale, o1[4 * g + 3] * scale);
        *(u32x2*)(dst + 32 + 8 * g + 4 * hi) = w1;
    }
}

__device__ __forceinline__ float store_out_fused(bf16_t* dst, const bf16_t* zp, const float* gp, const f32x16& o0, const f32x16& o1, float scale, int hi) {
    float ssq = 0.f;
#pragma unroll
    for (int g = 0; g < 4; ++g) {
#pragma unroll
        for (int d0 = 0; d0 < 2; ++d0) { const int c = 32 * d0 + 8 * g + 4 * hi; const u32x2 zz = *(const u32x2*)(zp + c); const f32x4 gg = *(const f32x4*)(gp + c);
            const float z0 = bflo(zz.x), z1 = bfhi(zz.x), z2 = bflo(zz.y), z3 = bfhi(zz.y);
            const float v0 = (d0 ? o1[4 * g] : o0[4 * g]) * scale, v1 = (d0 ? o1[4 * g + 1] : o0[4 * g + 1]) * scale, v2 = (d0 ? o1[4 * g + 2] : o0[4 * g + 2]) * scale, v3 = (d0 ? o1[4 * g + 3] : o0[4 * g + 3]) * scale;
            ssq += (v0 * v0 + v1 * v1) + (v2 * v2 + v3 * v3);
            u32x2 w; w.x = pk2(v0 * gg[0] * silu_fast(z0), v1 * gg[1] * silu_fast(z1)); w.y = pk2(v2 * gg[2] * silu_fast(z2), v3 * gg[3] * silu_fast(z3));
            *(u32x2*)(dst + c) = w; }
    }
    return ssq;
}

constexpr int DA_K0 = 0, DA_V0 = 3 * ATT_KBUF, DA_B0 = DA_V0 + 2 * ATT_VBUF, DA_END = DA_B0 + 3 * 256;
static_assert(DA_END <= LDS_BYTES, "dense attention LDS map");
template <int DK, int MODE>
__device__ __forceinline__ void dense_unit(LAS unsigned char* lds, const bf16_t* Q, int ldq, const bf16_t* K, int ldk, const bf16_t* V, int ldv,
                                           bf16_t* O  , const float* bias, const unsigned long long* maskbits  ,
                                           float alibiA, float c2, int qb, int wid0, const bf16_t* Zg, const float* Gn, float* ssq  ) {
    constexpr int KS = DK / 16; constexpr int KSTR = (DK == 96) ? KSTR96 : KSTR64; constexpr int CPR = DK / 8;
    const int tid = opaque_tid(wid0), lane = tid & 63, wv = __builtin_amdgcn_readfirstlane(tid >> 6), r = lane & 31, hi = lane >> 5;
    const int q0 = qb * 256, qw0 = q0 + wv * 32, tq = qw0 + r;
    const int NT = (q0 + 256) / 64;
    const int tlast = (qw0 + 31) >> 6;
    bf16x8 qf[KS];
#pragma unroll
    for (int s = 0; s < KS; ++s) qf[s] = *(const bf16x8*)(Q + (size_t)tq * ldq + s * 16 + hi * 8);
    const int vb = ((lane >> 4) & 1) * 32 + (lane & 3) * 8 + (4 * hi + ((lane & 15) >> 2)) * 64;
    const int kb = r * KSTR + hi * 16;
    SoftState st; st.m = NEG_BIG; st.l = 0.f; st.o0 = (f32x16){}; st.o1 = (f32x16){};
    const int krow0 = tid / CPR, kcc0 = tid % CPR, krow1 = (tid + 512) / CPR, kcc1 = (tid + 512) % CPR, vrow = tid >> 3, vcc = tid & 7;
    const bf16_t* kp0 = K + (size_t)krow0 * ldk + kcc0 * 8; const bf16_t* kp1 = K + (size_t)krow1 * ldk + kcc1 * 8; const bf16_t* vp = V + (size_t)vrow * ldv + vcc * 8;
    const int klds0 = krow0 * KSTR + kcc0 * 16, klds1 = krow1 * KSTR + kcc1 * 16, vlds = (vcc >> 2) * 4096 + vrow * 64 + (vcc & 3) * 16;
    u32x4 rk0, rk1, rv; float rbias = 0.f;
#define DA_LOADK(t) do { rk0 = *(const u32x4*)(kp0 + (size_t)(t) * 64 * ldk); if (DK == 96 && tid < 256) rk1 = *(const u32x4*)(kp1 + (size_t)(t) * 64 * ldk); if (MODE == 1 && tid < 64) rbias = bias[(t) * 64 + tid]; } while (0)
#define DA_LOADV(t) do { rv = *(const u32x4*)(vp + (size_t)(t) * 64 * ldv); } while (0)
#define DA_STOREK(slot) do { LAS unsigned char* kb_ = lds + DA_K0 + (slot) * ATT_KBUF; *(LAS u32x4*)(kb_ + klds0) = rk0; if (DK == 96 && tid < 256) *(LAS u32x4*)(kb_ + klds1) = rk1; \
        if (MODE == 1 && tid < 64) *(LAS float*)(lds + DA_B0 + (slot) * 256 + tid * 4) = rbias; } while (0)
#define DA_STOREV(slot) do { *(LAS u32x4*)(lds + DA_V0 + (slot) * ATT_VBUF + vlds) = rv; } while (0)
#define DA_CINIT(P0, P1, t, slot) do { const int kv0_ = (t) * 64; \
        if (MODE == 0) { P0 = (f32x16){}; P1 = (f32x16){}; } \
        else if (MODE == 1) { const LAS float* bl = (const LAS float*)(lds + DA_B0 + (slot) * 256); \
            _Pragma("unroll") for (int g = 0; g < 4; ++g) { const f32x4 b0_ = *(const LAS f32x4*)(bl + 8 * g + 4 * hi), b1_ = *(const LAS f32x4*)(bl + 32 + 8 * g + 4 * hi); \
                _Pragma("unroll") for (int e = 0; e < 4; ++e) { P0[4 * g + e] = b0_[e]; P1[4 * g + e] = b1_[e]; } } } \
        else { const float base_ = alibiA * (float)(kv0_ + 4 * hi); \
            _Pragma("unroll") for (int i = 0; i < 16; ++i) { P0[i] = base_ + alibiA * (float)((i & 3) + 8 * (i >> 2)); P1[i] = P0[i] + alibiA * 32.0f; } } } while (0)
#define DA_MASK(P0, P1, t, mb) do { const int kv0_ = (t) * 64; \
        if (MODE == 2) { const unsigned long long ms_ = (mb) >> (4 * hi); const unsigned lo_ = (unsigned)ms_, hw_ = (unsigned)(ms_ >> 32); \
            _Pragma("unroll") for (int i = 0; i < 16; ++i) { const unsigned bit_ = 1u << ((i & 3) + 8 * (i >> 2)); if (!(lo_ & bit_)) P0[i] = -INFINITY; if (!(hw_ & bit_)) P1[i] = -INFINITY; } } \
        else if (kv0_ + 63 > qw0) { \
            _Pragma("unroll") for (int i = 0; i < 16; ++i) { const int kv_ = kv0_ + crow(i, hi); if (kv_ > tq) P0[i] = -INFINITY; if (kv_ + 32 > tq) P1[i] = -INFINITY; } } } while (0)
#define DA_ROWMAX(MX, P0, P1) do { float a_ = __builtin_fmaxf(__builtin_fmaxf(P0[0], P0[1]), P1[0]), b_ = __builtin_fmaxf(__builtin_fmaxf(P0[2], P0[3]), P1[1]); a_ = __builtin_fmaxf(__builtin_fmaxf(a_, P1[2]), P1[3]); \
        _Pragma("unroll") for (int i = 4; i < 16; i += 4) { a_ = __builtin_fmaxf(__builtin_fmaxf(a_, P0[i]), P0[i + 1]); b_ = __builtin_fmaxf(__builtin_fmaxf(b_, P0[i + 2]), P0[i + 3]); a_ = __builtin_fmaxf(__builtin_fmaxf(a_, P1[i]), P1[i + 1]); b_ = __builtin_fmaxf(__builtin_fmaxf(b_, P1[i + 2]), P1[i + 3]); } \
        a_ = __builtin_fmaxf(a_, b_); const auto rr_ = __builtin_amdgcn_permlane32_swap(__float_as_uint(a_), __float_as_uint(a_), false, false); \
        MX = __builtin_fmaxf(__uint_as_float(rr_[0]), __uint_as_float(rr_[1])); } while (0)
    __syncthreads();
    DA_LOADK(0); DA_LOADV(0); DA_STOREK(0); DA_STOREV(0);
    DA_LOADK(1); DA_STOREK(1);
    DA_LOADK(2); DA_LOADV(1);
    __syncthreads();
    f32x16 pa0, pa1, pb0, pb1;
    unsigned long long mb_nxt = 0ull, mb_nn = 0ull;
    {
        DA_CINIT(pa0, pa1, 0, 0);
        qk_tile<KS>(pa0, pa1, lds + DA_K0, KSTR, qf, r, hi);
        unsigned long long mb0 = 0ull;
        if (MODE == 2) { mb0 = maskbits[(size_t)tq * 128]; if (1 <= tlast) mb_nxt = maskbits[(size_t)tq * 128 + 1]; }
        DA_MASK(pa0, pa1, 0, mb0);
        float mx; DA_ROWMAX(mx, pa0, pa1);
        st.m = __builtin_fmaxf(st.m, mx);
    }
    int ks_next = 1, ks_store = 2, vs_cur = 0;
#define DA_STEP(C0, C1, N0, N1, t) do { \
        if (MODE == 2) { mb_nn = 0ull; if ((t) + 2 <= tlast) mb_nn = maskbits[(size_t)tq * 128 + (t) + 2]; } \
        if ((t) <= tlast) { \
              \
            DA_CINIT(N0, N1, (t) + 1, ks_next); \
            bf16x8 pf0, pf1, pf2, pf3; \
            bf16x8 kf[2 * KS]; { const LAS unsigned char* k_ = lds + DA_K0 + ks_next * ATT_KBUF + kb; \
                _Pragma("unroll") for (int s_ = 0; s_ < KS; ++s_) { kf[2 * s_] = *(const LAS bf16x8*)(k_ + s_ * 32); kf[2 * s_ + 1] = *(const LAS bf16x8*)(k_ + 32 * KSTR + s_ * 32); } } \
            __builtin_amdgcn_sched_barrier(0); \
            _Pragma("unroll") for (int s_ = 0; s_ < KS; ++s_) { N0 = __builtin_amdgcn_mfma_f32_32x32x16_bf16(kf[2 * s_], qf[s_], N0, 0, 0, 0); N1 = __builtin_amdgcn_mfma_f32_32x32x16_bf16(kf[2 * s_ + 1], qf[s_], N1, 0, 0, 0); } \
            sm_exp_pack(st, C0, C1, c2, pf0, pf1, pf2, pf3); \
            _Pragma("unroll") for (int g_ = 0; g_ < 2 * KS; ++g_) { __builtin_amdgcn_sched_group_barrier(0x8, 1, 0); __builtin_amdgcn_sched_group_barrier(0x2, (KS == 6 ? 9 : 14), 0); } \
            __builtin_amdgcn_sched_barrier(0); \
              \
            bf16x8 vf[8]; { const LAS unsigned char* v_ = lds + DA_V0 + vs_cur * ATT_VBUF + vb; \
                _Pragma("unroll") for (int s_ = 0; s_ < 4; ++s_) { vf[2 * s_] = vfrag(v_ + s_ * 1024); vf[2 * s_ + 1] = vfrag(v_ + 4096 + s_ * 1024); } } \
            __builtin_amdgcn_sched_barrier(0); \
            float mx_ = -INFINITY; \
            if ((t) < tlast) { DA_MASK(N0, N1, (t) + 1, mb_nxt); DA_ROWMAX(mx_, N0, N1); } \
            __builtin_amdgcn_sched_barrier(0); \
            st.o0 = __builtin_amdgcn_mfma_f32_32x32x16_bf16(vf[0], pf0, st.o0, 0, 0, 0); st.o1 = __builtin_amdgcn_mfma_f32_32x32x16_bf16(vf[1], pf0, st.o1, 0, 0, 0); \
            st.o0 = __builtin_amdgcn_mfma_f32_32x32x16_bf16(vf[2], pf1, st.o0, 0, 0, 0); st.o1 = __builtin_amdgcn_mfma_f32_32x32x16_bf16(vf[3], pf1, st.o1, 0, 0, 0); \
            st.o0 = __builtin_amdgcn_mfma_f32_32x32x16_bf16(vf[4], pf2, st.o0, 0, 0, 0); st.o1 = __builtin_amdgcn_mfma_f32_32x32x16_bf16(vf[5], pf2, st.o1, 0, 0, 0); \
            st.o0 = __builtin_amdgcn_mfma_f32_32x32x16_bf16(vf[6], pf3, st.o0, 0, 0, 0); st.o1 = __builtin_amdgcn_mfma_f32_32x32x16_bf16(vf[7], pf3, st.o1, 0, 0, 0); \
            __builtin_amdgcn_sched_barrier(0); \
            if (__any((mx_ - st.m) * c2 > SM_THR)) { const float mn_ = __builtin_fmaxf(st.m, mx_); const float al_ = __builtin_amdgcn_exp2f((st.m - mn_) * c2); st.l *= al_; st.o0 *= al_; st.o1 *= al_; st.m = mn_; } \
        } \
        if ((t) + 2 < NT) DA_STOREK(ks_store); \
        if ((t) + 1 < NT) DA_STOREV(vs_cur ^ 1); \
        if ((t) + 3 < NT) DA_LOADK((t) + 3); \
        if ((t) + 2 < NT) DA_LOADV((t) + 2); \
        __syncthreads(); \
        mb_nxt = mb_nn; vs_cur ^= 1; ks_next = (ks_next == 2) ? 0 : ks_next + 1; ks_store = (ks_store == 2) ? 0 : ks_store + 1; } while (0)
    for (int t = 0; t < NT; t += 2) {
        DA_STEP(pa0, pa1, pb0, pb1, t);
        DA_STEP(pb0, pb1, pa0, pa1, t + 1);
    }
#undef DA_LOADK
#undef DA_LOADV
#undef DA_STOREK
#undef DA_STOREV
#undef DA_CINIT
#undef DA_MASK
#undef DA_ROWMAX
#undef DA_STEP
    const float l = swap32_sum(st.l);
    const float inv = l > 0.f ? 1.0f / l : 0.f;
    const float sq = swap32_sum(store_out_fused(O + (size_t)tq * D, Zg + (size_t)tq * NP, Gn, st.o0, st.o1, inv, hi));
    if (hi == 0) ssq[(size_t)tq * 16] = sq;
}

#define A64_SBAR() __builtin_amdgcn_sched_barrier(0)
#define A64_PIN(x) asm volatile("" : "+v"(x))
#define A64_MFMA(a, b, c) __builtin_amdgcn_mfma_f32_32x32x16_bf16(a, b, c, 0, 0, 0)
constexpr int A64_VSLOT = 8192, A64_K = 0, A64_V = 3 * 12288  , A64_WS = A64_V + 3 * A64_VSLOT, A64_OST = A64_WS + 8 * 256, A64_SIDE = A64_OST + 8 * 4096, A64_END = A64_SIDE + 3 * 2048;
static_assert(A64_END <= LDS_BYTES - 16, "attn64 LDS map");
template <int N> __device__ __forceinline__ void a64_wait_bar() { asm volatile("s_waitcnt vmcnt(%0) lgkmcnt(0)\n\ts_barrier" :: "n"(N) : "memory"); }
__device__ __forceinline__ void a64_glds16(const void* g, unsigned lds_base) {
    unsigned sv; asm volatile("s_mov_b32 %0, m0\n\ts_mov_b32 m0, %2\n\ts_nop 0\n\tglobal_load_lds_dwordx4 %1, off\n\ts_mov_b32 m0, %0" : "=&s"(sv) : "v"(g), "s"(lds_base) : "memory"); }
__device__ __forceinline__ void a64_glds4(const void* g, unsigned lds_base) {
    unsigned sv; asm volatile("s_mov_b32 %0, m0\n\ts_mov_b32 m0, %2\n\ts_nop 0\n\tglobal_load_lds_dword %1, off\n\ts_mov_b32 m0, %0" : "=&s"(sv) : "v"(g), "s"(lds_base) : "memory"); }
__device__ __forceinline__ void a64_kload2(bf16x8* kf, const LAS unsigned char* kp, int d0) { kf[2 * d0] = *(const LAS bf16x8*)(kp + d0 * 2048); kf[2 * d0 + 1] = *(const LAS bf16x8*)(kp + d0 * 2048 + 512); }
__device__ __forceinline__ s16x4 a64_vtr(const LAS unsigned char* p) { return __builtin_bit_cast(s16x4, __builtin_amdgcn_ds_read_tr16_b64_v4i16((LAS s16x4*)p)); }
#define A64_MX3(a, b, c) __builtin_fmaxf(__builtin_fmaxf((a), (b)), (c))
__device__ __forceinline__ float a64_max16(const f32x16& p) {
    float a = A64_MX3(p[0], p[1], p[2]), b = A64_MX3(p[3], p[4], p[5]); a = A64_MX3(a, p[6], p[7]); b = A64_MX3(b, p[8], p[9]); a = A64_MX3(a, p[10], p[11]); b = A64_MX3(b, p[12], p[13]);
    return A64_MX3(a, b, __builtin_fmaxf(p[14], p[15])); }
__device__ __forceinline__ float a64_swapmax(float m) { const auto rr = __builtin_amdgcn_permlane32_swap(__float_as_uint(m), __float_as_uint(m), false, false); return __builtin_fmaxf(__uint_as_float(rr[0]), __uint_as_float(rr[1])); }
__device__ __forceinline__ void a64_cmask(f32x16& p0, f32x16& p1, int jb, int qrel, int hi) {
    const int kb = 64 * jb + 4 * hi;
#pragma unroll
    for (int r = 0; r < 16; ++r) { const int kv = kb + (r & 3) + 8 * (r >> 2); if (kv > qrel) p0[r] = -INFINITY; if (kv + 32 > qrel) p1[r] = -INFINITY; } }
__device__ __forceinline__ void a64_dmask(f32x16& p0, f32x16& p1, unsigned long long mw, int hi) {
    const unsigned long long ms = mw >> (4 * hi); const unsigned lo = (unsigned)ms, hw = (unsigned)(ms >> 32);
#pragma unroll
    for (int i = 0; i < 16; ++i) { const unsigned bit = 1u << ((i & 3) + 8 * (i >> 2)); if (!(lo & bit)) p0[i] = -INFINITY; if (!(hw & bit)) p1[i] = -INFINITY; } }

template <int MODE, int DK>
__device__ __forceinline__ void attn64_unit(LAS unsigned char* lds, const bf16_t* Q, int ldq, const bf16_t* K, int ld  , const bf16_t* V, int ldv,
                                            bf16_t* O  , const float* bias  , const unsigned long long* maskbits  ,
                                            float alibiA, float C2  , int qb, int wid0, const bf16_t* Zg, const float* Gn, float* ssq  ) {
    constexpr float THR = 8.0f; constexpr int KS = DK / 16, KSLOT = (DK == 96) ? 12288 : 8192;
    constexpr int KOPS = ((MODE == 0) ? 1 : 2) + ((DK == 96) ? 1 : 0);
    const int tid = opaque_tid(wid0), lane = tid & 63, r32 = lane & 31, hi = lane >> 5; const int wid = __builtin_amdgcn_readfirstlane(tid >> 6);
    const int q0 = qb * 256, NT = (q0 + 256) / 64, qw0 = q0 + wid * 32;
    const bf16_t* Qw = Q + (size_t)qw0 * ldq;
    const unsigned lds0 = (unsigned)(size_t)lds; LAS float* wsf = (LAS float*)(lds + A64_WS) + wid * 64;
    const bf16_t* ksrc = K + (size_t)lane * ld + wid * 8;
    const bf16_t* ksrc2 = K + (size_t)lane * ld + (8 + (wid & 3)) * 8;
    const bf16_t* vsrc = V + (size_t)(16 * (wid & 3) + (lane >> 2)) * ldv + (wid >> 2) * 32 + (lane & 3) * 8;
    const unsigned* ssrc = (MODE == 1) ? (const unsigned*)(bias + lane) : (MODE == 2) ? (const unsigned*)(maskbits + (size_t)(qw0 + (lane >> 1)) * 128) + (lane & 1) : nullptr;
    constexpr int SSTEP = (MODE == 1) ? 64 : 2;
    const unsigned kdst = lds0 + A64_K + wid * 1024, kdst2 = lds0 + A64_K + (8 + (wid & 3)) * 1024, vdst = lds0 + A64_V + wid * 1024, sdst = lds0 + A64_SIDE + wid * 256;
#define A64_DMA_K(t, slot) do { a64_glds16(ksrc + (size_t)(t) * 64 * ld, (unsigned)__builtin_amdgcn_readfirstlane(kdst + (slot) * KSLOT)); \
        if (DK == 96) a64_glds16(ksrc2 + (size_t)(t) * 64 * ld, (unsigned)__builtin_amdgcn_readfirstlane(kdst2 + (slot) * KSLOT)); \
        if (MODE != 0) a64_glds4(ssrc + (size_t)(t) * SSTEP, (unsigned)__builtin_amdgcn_readfirstlane(sdst + (slot) * 2048)); } while (0)
#define A64_DMA_V(t, slot) a64_glds16(vsrc + (size_t)(t) * 64 * ldv, (unsigned)__builtin_amdgcn_readfirstlane(vdst + (slot) * A64_VSLOT))
    const LAS unsigned char* vp0 = lds + A64_V + ((lane >> 4) & 1) * 32 + (lane & 3) * 8 + (4 * hi + ((lane & 15) >> 2)) * 64;
    const LAS unsigned char* kp0 = lds + A64_K + hi * 1024 + r32 * 16;
    const LAS unsigned char* sp0 = lds + A64_SIDE + wid * 256;
    __syncthreads();
    A64_DMA_K(0, 0); A64_DMA_V(0, 0); A64_DMA_K(1, 1);
    bf16x8 qr[KS];
#pragma unroll
    for (int d0 = 0; d0 < KS; ++d0) qr[d0] = *(const bf16x8*)(Qw + (size_t)r32 * ldq + d0 * 16 + hi * 8);
    float mhat = 0.f, l_reg = 0.f; f32x16 o[2]; o[0] = (f32x16){}; o[1] = (f32x16){};
    f32x16 cini = (f32x16){};
    if (MODE == 2) {
#pragma unroll
        for (int i = 0; i < 16; ++i) cini[i] = alibiA * (float)((i & 3) + 8 * (i >> 2) + 4 * hi); }
    if (MODE != 0) A64_PIN(cini);
    const float ea = (MODE == 2) ? alibiA * C2 : 0.f;
    const int qrel = wid * 32 + r32; bool resc = false;
    f32x16 pA0, pA1, pB0, pB1; bf16x8 kf[2 * KS]; s16x4 vlo[8], vhi[8]; u32x4 pw0, pw1, pw2, pw3;
    int sl_prev = 0, sl_cur = 0, sl_next = 1;
#define A64_ROT() do { sl_prev = sl_cur; sl_cur = sl_next; sl_next = (sl_next == 2) ? 0 : sl_next + 1; } while (0)
#define A64_EX(v, NM) __builtin_amdgcn_exp2f(__builtin_fmaf((v), C2, NM))
#define A64_RESC() do { if (resc) { _Pragma("unroll") for (int d_ = 0; d_ < 2; ++d_) _Pragma("unroll") for (int r = 0; r < 16; ++r) o[d_][r] *= wsf[crow(r, hi)]; } } while (0)
#define A64_CINIT(C0, C1, slot) do { if (MODE == 1) { const LAS float* bl_ = (const LAS float*)(sp0 + (slot) * 2048); \
        _Pragma("unroll") for (int g_ = 0; g_ < 4; ++g_) { const f32x4 b0_ = *(const LAS f32x4*)(bl_ + 8 * g_ + 4 * hi), b1_ = *(const LAS f32x4*)(bl_ + 32 + 8 * g_ + 4 * hi); \
            _Pragma("unroll") for (int e_ = 0; e_ < 4; ++e_) { C0[4 * g_ + e_] = b0_[e_]; C1[4 * g_ + e_] = b1_[e_]; } } } \
        else if (MODE == 0) { C0 = (f32x16){}; C1 = (f32x16){}; }     \
        else { C0 = cini; C1 = cini; } } while (0)
#define A64_ROWREF(C0, C1, t) a64_swapmax(__builtin_fmaxf(__builtin_fmaf(a64_max16(C0), C2, ea * (float)(64 * (t))), __builtin_fmaf(a64_max16(C1), C2, ea * (float)(64 * (t) + 32))))
    A64_DMA_K(2, 2);
    a64_wait_bar<2 * KOPS + 1>();
    _Pragma("unroll") for (int d0 = 0; d0 < KS; ++d0) a64_kload2(kf, kp0, d0);
    { unsigned long long mw0 = 0ull; if (MODE == 2) mw0 = *(const LAS unsigned long long*)(sp0 + r32 * 8);
      A64_CINIT(pA0, pA1, 0);
      _Pragma("unroll") for (int d0 = 0; d0 < KS; ++d0) { pA0 = A64_MFMA(kf[2 * d0], qr[d0], pA0); pA1 = A64_MFMA(kf[2 * d0 + 1], qr[d0], pA1); }
      if (MODE == 2) a64_dmask(pA0, pA1, mw0, hi);
      if (NT == 4) a64_cmask(pA0, pA1, 0, qrel, hi); }
    { mhat = __builtin_fmaxf(A64_ROWREF(pA0, pA1, 0), -1e30f); const float nm0 = -mhat, nm1 = ea * 32.0f - mhat;
#pragma unroll
      for (int r = 0; r < 16; ++r) { pA0[r] = A64_EX(pA0[r], nm0); pA1[r] = A64_EX(pA1[r], nm1); } }
    a64_wait_bar<0>();
    A64_DMA_K(3, 0); A64_DMA_V(1, 1); A64_ROT();
    _Pragma("unroll") for (int d0 = 0; d0 < KS; ++d0) a64_kload2(kf, kp0 + sl_cur * KSLOT, d0);
    if (MODE == 1) A64_CINIT(pB0, pB1, sl_cur);
    a64_wait_bar<KOPS + 1>();
#define A64_PKW(P, i) pk2(P[i], P[i + 1])
#define A64_PAF(k) __builtin_bit_cast(bf16x8, pw##k)
#define A64_VFR(i) (bf16x8){vlo[i][0], vlo[i][1], vlo[i][2], vlo[i][3], vhi[i][0], vhi[i][1], vhi[i][2], vhi[i][3]}
#define A64_VRD(i) do { vlo[i] = a64_vtr(vp_ + (((i) >> 2) * 4096 + ((i) & 3) * 1024)); vhi[i] = a64_vtr(vp_ + (((i) >> 2) * 4096 + ((i) & 3) * 1024 + 512)); } while (0)
#define A64_BRD(G, P0, P1, g_) do { if (MODE == 1 && (G)) { const LAS float* bl_ = (const LAS float*)(sp0 + sl_next * 2048); \
        const f32x4 b0_ = *(const LAS f32x4*)(bl_ + 8 * (g_) + 4 * hi), b1_ = *(const LAS f32x4*)(bl_ + 32 + 8 * (g_) + 4 * hi); \
        _Pragma("unroll") for (int e_ = 0; e_ < 4; ++e_) { P0[4 * (g_) + e_] = b0_[e_]; P1[4 * (g_) + e_] = b1_[e_]; } } } while (0)
#define A64_KRD(G, d0) do { if (G) { a64_kload2(kf, kp0 + sl_next * KSLOT, d0); A64_SBAR(); } } while (0)
#define A64_GAPA(MF, a0, a1, a2, a3, W0, W1, PW) do { MF; sacc += a0; sacc += a1; sacc += a2; sacc += a3; W0; W1; A64_PIN(PW); A64_PIN(sacc); A64_SBAR(); } while (0)
#define A64_GAPB(MF, X, i, NM) do { MF; X[i] = A64_EX(X[i], NM); X[i + 1] = A64_EX(X[i + 1], NM); X[i + 2] = A64_EX(X[i + 2], NM); X[i + 3] = A64_EX(X[i + 3], NM); A64_PIN(X); A64_SBAR(); } while (0)
#define A64_STEP(C0, C1, P0, P1, t, MASK, GK, GV, GL) do { A64_SBAR(); \
    unsigned long long mw_ = 0ull; if (MODE == 2) { mw_ = *(const LAS unsigned long long*)(sp0 + sl_cur * 2048 + r32 * 8); } \
    if (MODE != 1) A64_CINIT(C0, C1, sl_cur);     \
    const LAS unsigned char* vp_ = vp0 + sl_prev * A64_VSLOT; \
    A64_VRD(0); A64_SBAR(); float sacc = P0[0] + P0[1]; \
                    A64_GAPA(C0 = A64_MFMA(kf[0], qr[0], C0), P0[2], P0[3], P0[4], P0[5],     pw0[0] = A64_PKW(P0, 0),  pw0[1] = A64_PKW(P0, 2),  pw0); \
    A64_VRD(4); A64_SBAR(); A64_GAPA(C1 = A64_MFMA(kf[1], qr[0], C1), P0[6], P0[7], P0[8], P0[9],     pw0[2] = A64_PKW(P0, 4),  pw0[3] = A64_PKW(P0, 6),  pw0); \
    A64_VRD(1); A64_SBAR(); A64_GAPA(C0 = A64_MFMA(kf[2], qr[1], C0),    P0[10], P0[11], P0[12], P0[13], pw1[0] = A64_PKW(P0, 8),  pw1[1] = A64_PKW(P0, 10), pw1); \
    A64_VRD(5); A64_SBAR(); A64_GAPA(C1 = A64_MFMA(kf[3], qr[1], C1),    P0[14], P0[15], P1[0], P1[1],   pw1[2] = A64_PKW(P0, 12), pw1[3] = A64_PKW(P0, 14), pw1); \
    A64_VRD(2); A64_SBAR(); A64_GAPA(C0 = A64_MFMA(kf[4], qr[2], C0),    P1[2], P1[3], P1[4], P1[5],     pw2[0] = A64_PKW(P1, 0),  pw2[1] = A64_PKW(P1, 2),  pw2); \
    A64_VRD(6); A64_SBAR(); A64_GAPA(C1 = A64_MFMA(kf[5], qr[2], C1),    P1[6], P1[7], P1[8], P1[9],     pw2[2] = A64_PKW(P1, 4),  pw2[3] = A64_PKW(P1, 6),  pw2); \
    A64_VRD(3); A64_SBAR(); A64_GAPA(C0 = A64_MFMA(kf[6], qr[3], C0),    P1[10], P1[11], P1[12], P1[13], pw3[0] = A64_PKW(P1, 8),  pw3[1] = A64_PKW(P1, 10), pw3); \
    A64_VRD(7); A64_SBAR(); A64_GAPA(C1 = A64_MFMA(kf[7], qr[3], C1),    P1[14], P1[15], 0.f, 0.f,       pw3[2] = A64_PKW(P1, 12), pw3[3] = A64_PKW(P1, 14), pw3); \
    if (KS == 6) { C0 = A64_MFMA(kf[8], qr[4], C0); C1 = A64_MFMA(kf[9], qr[4], C1); C0 = A64_MFMA(kf[10], qr[5], C0); C1 = A64_MFMA(kf[11], qr[5], C1); A64_SBAR(); } \
    l_reg += sacc; \
    if (MODE == 2) { unsigned ml_ = (unsigned)mw_, mh_ = (unsigned)(mw_ >> 32); A64_PIN(ml_); A64_PIN(mh_); mw_ = ((unsigned long long)mh_ << 32) | ml_; }     \
    if (GK) A64_DMA_K((t) + 3, sl_cur); if (GV) A64_DMA_V((t) + 1, sl_next); \
    if (MODE == 2) a64_dmask(C0, C1, mw_, hi); \
    if (MASK) a64_cmask(C0, C1, (t) - (NT - 4), qrel, hi); \
    { const float rs_ = A64_ROWREF(C0, C1, t); resc = false; \
      if (__builtin_expect(__any(rs_ - mhat > THR), 0)) { const float mn_ = __builtin_fmaxf(mhat, rs_); const float f_ = __builtin_amdgcn_exp2f(mhat - mn_); mhat = mn_; \
          l_reg *= f_; if (hi == 0) wsf[r32] = f_; resc = true; } } \
    const float nm0_ = ea * (float)(64 * (t)) - mhat, nm1_ = ea * (float)(64 * (t) + 32) - mhat; A64_SBAR(); \
    A64_GAPB(o[0] = A64_MFMA(A64_PAF(0), A64_VFR(0), o[0]), C0, 0, nm0_);              A64_GAPB(o[1] = A64_MFMA(A64_PAF(0), A64_VFR(4), o[1]), C0, 4, nm0_); \
    A64_KRD(GL, 0); A64_BRD(GL, P0, P1, 0); A64_GAPB(o[0] = A64_MFMA(A64_PAF(1), A64_VFR(1), o[0]), C0, 8, nm0_);  A64_KRD(GL, 1); A64_BRD(GL, P0, P1, 1); A64_GAPB(o[1] = A64_MFMA(A64_PAF(1), A64_VFR(5), o[1]), C0, 12, nm0_); \
    A64_KRD(GL, 2); A64_BRD(GL, P0, P1, 2); A64_GAPB(o[0] = A64_MFMA(A64_PAF(2), A64_VFR(2), o[0]), C1, 0, nm1_);  A64_KRD(GL, 3); A64_BRD(GL, P0, P1, 3); A64_GAPB(o[1] = A64_MFMA(A64_PAF(2), A64_VFR(6), o[1]), C1, 4, nm1_); \
    if (KS == 6) A64_KRD(GL, 4); A64_GAPB(o[0] = A64_MFMA(A64_PAF(3), A64_VFR(3), o[0]), C1, 8, nm1_);  if (KS == 6) A64_KRD(GL, 5); A64_GAPB(o[1] = A64_MFMA(A64_PAF(3), A64_VFR(7), o[1]), C1, 12, nm1_); \
    } while (0)
    int t = 1;
    for (; t + 5 < NT; t += 2) {
        A64_STEP(pB0, pB1, pA0, pA1, t, false, true, true, true);     a64_wait_bar<KOPS + 1>(); A64_RESC(); A64_ROT();
        A64_STEP(pA0, pA1, pB0, pB1, t + 1, false, true, true, true); a64_wait_bar<KOPS + 1>(); A64_RESC(); A64_ROT();
    }
#define A64_ENDW(tt) do { if ((tt) + 3 < NT) { a64_wait_bar<KOPS + 1>(); } else if ((tt) + 2 < NT) { a64_wait_bar<1>(); } else { a64_wait_bar<0>(); } } while (0)
    for (; t + 1 < NT; t += 2) {
        A64_STEP(pB0, pB1, pA0, pA1, t, true, (t + 3 < NT), (t + 1 < NT), (t + 1 < NT));         A64_ENDW(t);     A64_RESC(); A64_ROT();
        A64_STEP(pA0, pA1, pB0, pB1, t + 1, true, (t + 4 < NT), (t + 2 < NT), (t + 2 < NT));     A64_ENDW(t + 1); A64_RESC(); A64_ROT();
    }
    A64_STEP(pB0, pB1, pA0, pA1, NT - 1, true, false, false, false); A64_RESC();
    { float sacc = pB0[0] + pB0[1];
#pragma unroll
      for (int r = 2; r < 16; ++r) sacc += pB0[r];
#pragma unroll
      for (int r = 0; r < 16; ++r) sacc += pB1[r];
      l_reg += sacc;
      pw0 = (u32x4){A64_PKW(pB0, 0), A64_PKW(pB0, 2), A64_PKW(pB0, 4), A64_PKW(pB0, 6)}; pw1 = (u32x4){A64_PKW(pB0, 8), A64_PKW(pB0, 10), A64_PKW(pB0, 12), A64_PKW(pB0, 14)};
      pw2 = (u32x4){A64_PKW(pB1, 0), A64_PKW(pB1, 2), A64_PKW(pB1, 4), A64_PKW(pB1, 6)}; pw3 = (u32x4){A64_PKW(pB1, 8), A64_PKW(pB1, 10), A64_PKW(pB1, 12), A64_PKW(pB1, 14)};
      const LAS unsigned char* vp_ = vp0 + sl_cur * A64_VSLOT; _Pragma("unroll") for (int i = 0; i < 8; ++i) A64_VRD(i);
      o[0] = A64_MFMA(A64_PAF(0), A64_VFR(0), o[0]); o[1] = A64_MFMA(A64_PAF(0), A64_VFR(4), o[1]); o[0] = A64_MFMA(A64_PAF(1), A64_VFR(1), o[0]); o[1] = A64_MFMA(A64_PAF(1), A64_VFR(5), o[1]);
      o[0] = A64_MFMA(A64_PAF(2), A64_VFR(2), o[0]); o[1] = A64_MFMA(A64_PAF(2), A64_VFR(6), o[1]); o[0] = A64_MFMA(A64_PAF(3), A64_VFR(3), o[0]); o[1] = A64_MFMA(A64_PAF(3), A64_VFR(7), o[1]); }
    l_reg = swap32_sum(l_reg);
    if (hi == 0) wsf[32 + r32] = l_reg; asm volatile("s_waitcnt lgkmcnt(0)" ::: "memory");
    float rli[16];
#pragma unroll
    for (int r = 0; r < 16; ++r) rli[r] = __builtin_amdgcn_rcpf(wsf[32 + crow(r, hi)]);
    LAS bf16_t* stg = (LAS bf16_t*)(lds + A64_OST) + wid * 2048;
#pragma unroll
    for (int r = 0; r < 16; ++r) { const int orow = crow(r, hi);
#pragma unroll
        for (int d0 = 0; d0 < 2; ++d0) stg[orow * 64 + d0 * 32 + r32] = (bf16_t)pk2(o[d0][r] * rli[r], 0.f); }
    asm volatile("s_waitcnt lgkmcnt(0)" ::: "memory");
#pragma unroll
    for (int i = 0; i < 4; ++i) { const int row = i * 8 + (lane >> 3), ch = lane & 7; const size_t grow = (size_t)(qw0 + row);
        const u32x4 vv = *(const LAS u32x4*)(stg + row * 64 + ch * 8); const u32x4 zz = *(const u32x4*)(Zg + grow * NP + ch * 8);
        const f32x4 g0 = *(const f32x4*)(Gn + ch * 8), g1 = *(const f32x4*)(Gn + ch * 8 + 4);
        float sq = 0.f; u32x4 w;
#pragma unroll
        for (int e = 0; e < 4; ++e) { const float va = bflo(vv[e]), vb_ = bfhi(vv[e]); sq += va * va + vb_ * vb_;
            const float ga = (e < 2) ? g0[2 * e] : g1[2 * e - 4], gb = (e < 2) ? g0[2 * e + 1] : g1[2 * e - 3];
            w[e] = pk2(va * ga * silu_fast(bflo(zz[e])), vb_ * gb * silu_fast(bfhi(zz[e]))); }
        *(u32x4*)(O + grow * D + ch * 8) = w;
        sq += quad_xor1(sq); sq += quad_xor2(sq);
        sq += __builtin_bit_cast(float, __builtin_amdgcn_update_dpp(0, __builtin_bit_cast(int, sq), 0x141, 0xf, 0xf, false));
        if (ch == 0) ssq[grow * 16] = sq; }
    asm volatile("s_waitcnt lgkmcnt(0)\n\ts_barrier" ::: "memory");
#undef A64_DMA_K
#undef A64_DMA_V
#undef A64_ROT
#undef A64_EX
#undef A64_RESC
#undef A64_CINIT
#undef A64_ROWREF
#undef A64_PKW
#undef A64_PAF
#undef A64_VFR
#undef A64_VRD
#undef A64_KRD
#undef A64_BRD
#undef A64_ENDW
#undef A64_GAPA
#undef A64_GAPB
#undef A64_STEP
}

constexpr int DSA_H1 = 0, DSA_H2 = 65536, DSA_INFO = 65536 + 32768;
__device__ __forceinline__ unsigned score_key32(float s) { const unsigned u = __float_as_uint(s); return u ^ ((unsigned)((int)u >> 31) | 0x80000000u); }
__device__ __forceinline__ unsigned score_key16(float s) { return score_key32(s) >> 16; }
__device__ __forceinline__ float key32_to_float(unsigned k) { return __uint_as_float((k & 0x80000000u) ? (k ^ 0x80000000u) : ~k); }
__device__ __forceinline__ float relu_f(float x) { const int b_ = __builtin_bit_cast(int, x); return __builtin_bit_cast(float, b_ > 0 ? b_ : 0); }

struct KFrag { bf16x8 a00, a01, a10, a11; };
__device__ __forceinline__ void dsa_kload(KFrag& f, const bf16_t* kix  , int t, int r, int hi) {
    const bf16_t* p = kix + ((size_t)t * 64 + r) * 32 + hi * 8;
    f.a00 = *(const bf16x8*)p; f.a01 = *(const bf16x8*)(p + 16); f.a10 = *(const bf16x8*)(p + 1024); f.a11 = *(const bf16x8*)(p + 1024 + 16);
}
__device__ __forceinline__ void dsa_scores(f32x16& s0, f32x16& s1, const KFrag& f, const bf16x8 (&qi)[4][2], const float (&w)[4]) {
    s0 = (f32x16){}; s1 = (f32x16){};
#pragma unroll
    for (int ih = 0; ih < 4; ++ih) {
        f32x16 a = __builtin_amdgcn_mfma_f32_32x32x16_bf16(f.a00, qi[ih][0], (f32x16){}, 0, 0, 0); a = __builtin_amdgcn_mfma_f32_32x32x16_bf16(f.a01, qi[ih][1], a, 0, 0, 0);
        f32x16 c = __builtin_amdgcn_mfma_f32_32x32x16_bf16(f.a10, qi[ih][0], (f32x16){}, 0, 0, 0); c = __builtin_amdgcn_mfma_f32_32x32x16_bf16(f.a11, qi[ih][1], c, 0, 0, 0);
#pragma unroll
        for (int i = 0; i < 16; ++i) { s0[i] = __builtin_fmaf(w[ih], relu_f(a[i]), s0[i]); s1[i] = __builtin_fmaf(w[ih], relu_f(c[i]), s1[i]); }
    }
}
__device__ __forceinline__ void hist_add(LAS unsigned* hrow, int r, unsigned bin) { atomicAdd((unsigned*)(hrow + ((bin >> 1) ^ (unsigned)r)), 1u << ((bin & 1u) * 16u)); }

__device__ __forceinline__ void dsa_index_unit(LAS unsigned char* lds, const bf16_t* proj, const bf16_t* kidx, const float* side, unsigned long long* maskbits, int b, int qg, int wid0) {
    const int tid = opaque_tid(wid0), lane = tid & 63, wv = __builtin_amdgcn_readfirstlane(tid >> 6), r = lane & 31, hi = lane >> 5;
    const int tq = qg * 32 + r; const size_t rowq = (size_t)b * S + tq;
    const int nt = (qg >> 1) + 1;
    const int per = (nt + 7) >> 3; const int t_lo = wv * per, t_hi = (t_lo + per < nt) ? t_lo + per : nt;
    bf16x8 qi[4][2]; float w[4];
#pragma unroll
    for (int ih = 0; ih < 4; ++ih) { qi[ih][0] = *(const bf16x8*)(proj + rowq * NP + C_IQ + ih * 32 + hi * 8); qi[ih][1] = *(const bf16x8*)(proj + rowq * NP + C_IQ + ih * 32 + 16 + hi * 8);
        w[ih] = side[rowq * 32 + 4 + ih] * 0.5f; }
    LAS unsigned* h1 = (LAS unsigned*)(lds + DSA_H1) + r * 512; LAS unsigned* h2 = (LAS unsigned*)(lds + DSA_H2) + wv * 1024 + r * 32;
    LAS int* info = (LAS int*)(lds + DSA_INFO);
    const bf16_t* kix = kidx + (size_t)b * S * 32;
    const bool sel_all = (qg < 8);
    __syncthreads();
    if (!sel_all) {
        for (int i = tid; i < (DSA_INFO) / 16; i += NTHREADS) ((LAS u32x4*)lds)[i] = (u32x4){0u, 0u, 0u, 0u};
        __syncthreads();
        if (t_lo < t_hi) {
            KFrag cur, nxt; dsa_kload(cur, kix, t_lo, r, hi);
            for (int t = t_lo; t < t_hi; ++t) {
                if (t + 1 < t_hi) dsa_kload(nxt, kix, t + 1, r, hi);
                f32x16 s0, s1; dsa_scores(s0, s1, cur, qi, w);
                const int kv0 = t * 64;
                if (kv0 + 63 <= qg * 32) {
#pragma unroll
                    for (int i = 0; i < 16; ++i) { hist_add(h1, r, score_key32(s0[i]) >> 22); hist_add(h1, r, score_key32(s1[i]) >> 22); }
                } else {
#pragma unroll
                    for (int i = 0; i < 16; ++i) { const int kv = kv0 + crow(i, hi);
                        if (kv <= tq) hist_add(h1, r, score_key32(s0[i]) >> 22);
                        if (kv + 32 <= tq) hist_add(h1, r, score_key32(s1[i]) >> 22); }
                }
                cur = nxt;
            }
        }
        __syncthreads();
        { const int row = tid >> 4, part = tid & 15; const LAS unsigned* hr = (const LAS unsigned*)(lds + DSA_H1) + row * 512; unsigned cs = 0;
#pragma unroll 8
          for (int j = 0; j < 32; ++j) { const unsigned wd = hr[(part * 32 + j) ^ row]; cs += (wd & 0xffffu) + (wd >> 16); }
          unsigned suf = cs;
#pragma unroll
          for (int o = 1; o < 16; o <<= 1) { const unsigned t = __shfl_down(suf, o, 16); if (part + o < 16) suf += t; }
          const unsigned above = suf - cs;
          if (above < 256u && above + cs >= 256u) { unsigned acc = above; int bsel = part * 64; unsigned ab = above;
              for (int j = 31; j >= 0; --j) { const unsigned wd = hr[(part * 32 + j) ^ row]; const unsigned c1 = wd >> 16, c0 = wd & 0xffffu;
                  if (acc + c1 >= 256u) { bsel = part * 64 + 2 * j + 1; ab = acc; break; } acc += c1;
                  if (acc + c0 >= 256u) { bsel = part * 64 + 2 * j; ab = acc; break; } acc += c0; }
              info[row] = bsel; info[32 + row] = 256 - (int)ab; } }
        __syncthreads();
        const unsigned B1 = (unsigned)info[r];
        const float blo = key32_to_float(B1 << 22), bhi = (B1 >= 1023u) ? INFINITY : key32_to_float((B1 + 1u) << 22);
        if (t_lo < t_hi) {
            KFrag cur, nxt; dsa_kload(cur, kix, t_lo, r, hi);
            for (int t = t_lo; t < t_hi; ++t) {
                if (t + 1 < t_hi) dsa_kload(nxt, kix, t + 1, r, hi);
                f32x16 s0, s1; dsa_scores(s0, s1, cur, qi, w);
                const int kv0 = t * 64;
                if (kv0 + 63 <= qg * 32) {
#pragma unroll
                    for (int i = 0; i < 16; ++i) {
                        if (s0[i] >= blo && s0[i] < bhi) hist_add(h2, r, (score_key32(s0[i]) >> 16) & 63u);
                        if (s1[i] >= blo && s1[i] < bhi) hist_add(h2, r, (score_key32(s1[i]) >> 16) & 63u); }
                } else {
#pragma unroll
                    for (int i = 0; i < 16; ++i) { const int kv = kv0 + crow(i, hi);
                        if (kv <= tq && s0[i] >= blo && s0[i] < bhi) hist_add(h2, r, (score_key32(s0[i]) >> 16) & 63u);
                        if (kv + 32 <= tq && s1[i] >= blo && s1[i] < bhi) hist_add(h2, r, (score_key32(s1[i]) >> 16) & 63u); }
                }
                cur = nxt;
            }
        }
        __syncthreads();
        { const int row = tid >> 4, part = tid & 15; unsigned cnt[4]; unsigned cs = 0; const unsigned need1 = (unsigned)info[32 + row];
          LAS unsigned* h2a = (LAS unsigned*)(lds + DSA_H2);
#pragma unroll
          for (int j = 0; j < 2; ++j) { unsigned c0 = 0, c1 = 0; const int wi = row * 32 + ((part * 2 + j) ^ row);
#pragma unroll
              for (int ww = 0; ww < 8; ++ww) { const unsigned wd = h2a[ww * 1024 + wi]; c0 += wd & 0xffffu; c1 += wd >> 16; }
              cnt[2 * j] = c0; cnt[2 * j + 1] = c1; cs += c0 + c1; }
          unsigned suf = cs;
#pragma unroll
          for (int o = 1; o < 16; o <<= 1) { const unsigned t = __shfl_down(suf, o, 16); if (part + o < 16) suf += t; }
          const unsigned above = suf - cs;
          if (above < need1 && above + cs >= need1) { unsigned acc = above; int bsel = 0; unsigned ab = above; bool found = false;
#pragma unroll
              for (int j = 3; j >= 0; --j) { if (!found) { if (acc + cnt[j] >= need1) { bsel = part * 4 + j; ab = acc; found = true; } else acc += cnt[j]; } }
              info[64 + row] = (int)(((unsigned)info[row] << 6) | (unsigned)bsel); info[96 + row] = (int)(need1 - ab);
              const int wi = row * 32 + ((bsel >> 1) ^ row); unsigned run = 0;
#pragma unroll
              for (int ww = 0; ww < 8; ++ww) { info[128 + row * 8 + ww] = (int)run; const unsigned wd = h2a[ww * 1024 + wi]; run += (bsel & 1) ? (wd >> 16) : (wd & 0xffffu); } } }
        __syncthreads();
    }
    const unsigned T = sel_all ? 0u : (unsigned)info[64 + r];
    const unsigned need2 = sel_all ? 0x7fffffffu : (unsigned)info[96 + r];
    unsigned tc = sel_all ? 0u : (unsigned)info[128 + r * 8 + wv];
    const float f_lo = sel_all ? -INFINITY : key32_to_float(T << 16), f_hi = sel_all ? -INFINITY : ((T >= 0xffffu) ? INFINITY : key32_to_float((T + 1u) << 16));
    if (t_lo < t_hi) {
        KFrag cur, nxt; dsa_kload(cur, kix, t_lo, r, hi);
        for (int t = t_lo; t < t_hi; ++t) {
            if (t + 1 < t_hi) dsa_kload(nxt, kix, t + 1, r, hi);
            f32x16 s0, s1; dsa_scores(s0, s1, cur, qi, w);
            const int kv0 = t * 64; unsigned words[2];
#pragma unroll
            for (int half = 0; half < 2; ++half) {
                unsigned gt = 0, eq = 0;
                if (kv0 + 63 <= qg * 32) {
                    unsigned ge = 0;
#pragma unroll
                    for (int i = 15; i >= 0; --i) { const float sv = half ? s1[i] : s0[i];
                        asm("v_cmp_ge_f32 vcc, %1, %2\n\tv_addc_co_u32 %0, vcc, %0, %0, vcc" : "+v"(gt) : "v"(sv), "v"(f_hi) : "vcc");
                        asm("v_cmp_ge_f32 vcc, %1, %2\n\tv_addc_co_u32 %0, vcc, %0, %0, vcc" : "+v"(ge) : "v"(sv), "v"(f_lo) : "vcc"); }
                    eq = ge & ~gt;
                } else {
#pragma unroll
                    for (int i = 0; i < 16; ++i) { const int kv = kv0 + 32 * half + crow(i, hi); const unsigned k = score_key16(half ? s1[i] : s0[i]);
                        const unsigned v = (kv <= tq) ? 1u : 0u; gt |= ((k > T) ? v : 0u) << i; eq |= ((k == T) ? v : 0u) << i; }
                }
                unsigned sel = gt;
                if (__any(eq != 0u)) {
                    const unsigned a0 = __popc(eq & 0xfu), a1 = __popc(eq & 0xf0u), a2 = __popc(eq & 0xf00u), a3 = __popc(eq & 0xf000u);
                    const unsigned own = a0 | (a1 << 8) | (a2 << 16) | (a3 << 24); unsigned oth; { const auto rr_ = __builtin_amdgcn_permlane32_swap(own, own, false, false); oth = rr_[0] + rr_[1] - own; }
                    const unsigned b0 = oth & 255u, b1 = (oth >> 8) & 255u, b2 = (oth >> 16) & 255u, b3 = oth >> 24;
                    unsigned pre[4]; const unsigned hb = hi ? 1u : 0u;
                    pre[0] = tc + hb * b0; pre[1] = tc + a0 + b0 + hb * b1; pre[2] = tc + a0 + b0 + a1 + b1 + hb * b2; pre[3] = tc + a0 + b0 + a1 + b1 + a2 + b2 + hb * b3;
#pragma unroll
                    for (int g = 0; g < 4; ++g) { unsigned rk = pre[g];
#pragma unroll
                        for (int e = 0; e < 4; ++e) { const unsigned bit = 1u << (4 * g + e); if (eq & bit) { if (rk < need2) sel |= bit; ++rk; } } }
                    tc += a0 + a1 + a2 + a3 + b0 + b1 + b2 + b3;
                }
                unsigned wbits = (sel & 0xfu) | ((sel & 0xf0u) << 4) | ((sel & 0xf00u) << 8) | ((sel & 0xf000u) << 12);
                wbits <<= 4 * hi;
                { const auto rr_ = __builtin_amdgcn_permlane32_swap(wbits, wbits, false, false); wbits = rr_[0] | rr_[1]; }
                words[half] = wbits;
            }
            if (hi == 0) maskbits[(size_t)tq * 128 + t] = (unsigned long long)words[0] | ((unsigned long long)words[1] << 32);
            cur = nxt;
        }
    }
}

constexpr int NSA_IMP = ATT_EXTRA;
constexpr int NSA_SEL = NSA_IMP + 32768;
constexpr int NSA_UNI = NSA_SEL + 1024;
constexpr int NSA_LIST = NSA_UNI + 64;
constexpr int NSA_OT = NSA_LIST + 1024;
static_assert(NSA_OT + 65536 <= LDS_BYTES, "NSA LDS map");

__device__ __forceinline__ void nsa_unit(LAS unsigned char* lds, const bf16_t* proj, const float* side, const bf16_t* kc, const bf16_t* vc, bf16_t* ocat, int b, int q64, int wid0, const float* gn  , float* ssq  ) {
    const int tid = opaque_tid(wid0), lane = tid & 63, wv = __builtin_amdgcn_readfirstlane(tid >> 6), r = lane & 31, hi = lane >> 5;
    const int t0 = q64 * 64, q8 = r >> 2, hd = r & 3, tq = t0 + wv * 8 + q8; const size_t rowq = (size_t)b * S + tq;
    const float c2 = 0.125f * LOG2E;
    const float slope = (hd == 0) ? 0.25f : (hd == 1 ? 0.0625f : (hd == 2 ? 0.015625f : 0.00390625f));
    const float A = 8.0f * slope;
    bf16x8 qf[4];
#pragma unroll
    for (int s = 0; s < 4; ++s) qf[s] = *(const bf16x8*)(proj + rowq * NP + C_NQ + hd * 64 + s * 16 + hi * 8);
    const float g0 = sigmoid_f(side[rowq * 32 + 8 + hd * 3 + 0]), g1 = sigmoid_f(side[rowq * 32 + 8 + hd * 3 + 1]), g2 = sigmoid_f(side[rowq * 32 + 8 + hd * 3 + 2]);
    const int vb = ((lane >> 4) & 1) * 32 + (lane & 3) * 8 + (4 * hi + ((lane & 15) >> 2)) * 64;
    LAS float* imp = (LAS float*)(lds + NSA_IMP) + wv * 1024;
    LAS unsigned* selw = (LAS unsigned*)(lds + NSA_SEL) + wv * 32;
    LAS unsigned* uni = (LAS unsigned*)(lds + NSA_UNI);
    LAS int* list = (LAS int*)(lds + NSA_LIST);
    LAS float* otl = (LAS float*)(lds + NSA_OT) + wv * 2048 + lane;
    StageRegs<64> sr;
    __syncthreads();
    for (int i = lane; i < 1024; i += 64) imp[i] = 0.f;
    if (tid < 4) uni[tid] = 0u;
    const bf16_t* kcb = kc + (size_t)b * 512 * 64; const bf16_t* vcb = vc + (size_t)b * 512 * 64;
    const int ntc = (((t0 + 32) >> 4) >> 6) + 1;
    SoftState st; st.m = NEG_BIG; st.l = 0.f; st.o0 = (f32x16){}; st.o1 = (f32x16){};
    for (int pass = 0; pass < 2; ++pass) {
        stage_load<64>(sr, kcb, 64, vcb, 64, nullptr, 0, wid0);
        __syncthreads();
        stage_store<64>(sr, lds, 0, false, wid0);
        if (1 < ntc) stage_load<64>(sr, kcb, 64, vcb, 64, nullptr, 64, wid0);
        __syncthreads();
        float rl = 0.f;
        if (pass == 1) { const float l = st.l + __shfl_xor(st.l, 32); rl = l > 0.f ? 1.0f / l : 0.f; }
        const float mc = st.m * c2;
        for (int t = 0; t < ntc; ++t) {
            const int buf = t & 1;
            f32x16 p0, p1; const int n0 = t * 64;
            { const float base = A * (float)(16 * (n0 + 4 * hi) + 31);
#pragma unroll
              for (int i = 0; i < 16; ++i) { p0[i] = base + A * 16.0f * (float)((i & 3) + 8 * (i >> 2)); p1[i] = p0[i] + A * 512.0f; } }
            qk_tile<4>(p0, p1, lds + ATT_K0 + buf * ATT_KBUF, KSTR64, qf, r, hi);
#pragma unroll
            for (int i = 0; i < 16; ++i) { const int n = n0 + crow(i, hi); if (16 * n + 31 > tq) p0[i] = -INFINITY; if (16 * (n + 32) + 31 > tq) p1[i] = -INFINITY; }
            if (pass == 0) {
                const float mx = tile_max(p0, p1); const float mn = fmaxf(st.m, mx);
                const float al = __builtin_amdgcn_exp2f((st.m - mn) * c2); st.l *= al; st.m = mn; const float mcc = mn * c2; float sum = 0.f;
#pragma unroll
                for (int i = 0; i < 16; ++i) sum += __builtin_amdgcn_exp2f(__builtin_fmaf(p0[i], c2, -mcc)) + __builtin_amdgcn_exp2f(__builtin_fmaf(p1[i], c2, -mcc));
                st.l += sum;
            } else {
#pragma unroll
                for (int i = 0; i < 16; ++i) { p0[i] = __builtin_amdgcn_exp2f(__builtin_fmaf(p0[i], c2, -mc)) * rl; p1[i] = __builtin_amdgcn_exp2f(__builtin_fmaf(p1[i], c2, -mc)) * rl; }
#pragma unroll
                for (int half = 0; half < 2; ++half)
#pragma unroll
                    for (int g = 0; g < 4; ++g) { const f32x16& pp = half ? p1 : p0;
                        float s4 = (pp[4 * g] + pp[4 * g + 1]) + (pp[4 * g + 2] + pp[4 * g + 3]); float s3 = pp[4 * g + 3];
                        s4 += quad_xor1(s4); s4 += quad_xor2(s4); s3 += quad_xor1(s3); s3 += quad_xor2(s3);
                        const int j1 = 16 * t + 8 * half + 2 * g + hi;
                        if (hd == 0) atomicAdd((float*)(imp + q8 * 128 + j1), s4);
                        if (hd == 0 && j1 + 1 < 128) atomicAdd((float*)(imp + q8 * 128 + j1 + 1), s3); }
                pv_tile(st.o0, st.o1, p0, p1, lds + ATT_V0 + buf * ATT_VBUF, vb);
            }
            if (t + 1 < ntc) stage_store<64>(sr, lds, buf ^ 1, false, wid0);
            if (t + 2 < ntc) stage_load<64>(sr, kcb, 64, vcb, 64, nullptr, (t + 2) * 64, wid0);
            __syncthreads();
        }
    }
#pragma unroll
    for (int i = 0; i < 16; ++i) { otl[i * 64] = st.o0[i] * g0; otl[(16 + i) * 64] = st.o1[i] * g0; }
    {
        const int cur = q64;
        for (int qq = 0; qq < 8; ++qq) {
            float v0 = imp[qq * 128 + lane], v1 = imp[qq * 128 + 64 + lane];
            bool ok0 = true, ok1 = true;
            { const int j0 = lane, j1 = lane + 64;
              if (j0 == 0 || j0 == cur) v0 = INFINITY; else if (j0 > cur) ok0 = false;
              if (j1 == cur) v1 = INFINITY; else if (j1 > cur) ok1 = false; }
            const unsigned k0 = __float_as_uint(v0), k1 = __float_as_uint(v1);
            unsigned T = 0u;
            for (int bit = 30; bit >= 0; --bit) { const unsigned cand = T | (1u << bit);
                const int cnt = __popcll(__ballot(ok0 && k0 >= cand)) + __popcll(__ballot(ok1 && k1 >= cand));
                if (cnt >= 16) T = cand; }
            const unsigned long long gt0 = __ballot(ok0 && k0 > T), gt1 = __ballot(ok1 && k1 > T), eq0 = __ballot(ok0 && k0 == T), eq1 = __ballot(ok1 && k1 == T);
            const int need = 16 - (__popcll(gt0) + __popcll(gt1));
            const int r0 = (int)__builtin_amdgcn_mbcnt_hi((unsigned)(eq0 >> 32), __builtin_amdgcn_mbcnt_lo((unsigned)eq0, 0u));
            const int r1 = __popcll(eq0) + (int)__builtin_amdgcn_mbcnt_hi((unsigned)(eq1 >> 32), __builtin_amdgcn_mbcnt_lo((unsigned)eq1, 0u));
            const unsigned long long slo = __ballot(ok0 && (k0 > T || (k0 == T && r0 < need))), shi = __ballot(ok1 && (k1 > T || (k1 == T && r1 < need)));
            if (lane == 0) { selw[qq * 4 + 0] = (unsigned)slo; selw[qq * 4 + 1] = (unsigned)(slo >> 32); selw[qq * 4 + 2] = (unsigned)shi; selw[qq * 4 + 3] = (unsigned)(shi >> 32);
                atomicOr((unsigned*)(uni + 0), (unsigned)slo); atomicOr((unsigned*)(uni + 1), (unsigned)(slo >> 32)); atomicOr((unsigned*)(uni + 2), (unsigned)shi); atomicOr((unsigned*)(uni + 3), (unsigned)(shi >> 32)); }
        }
    }
    __syncthreads();
    if (tid == 0) { int n = 0; for (int wd = 0; wd < 4; ++wd) { unsigned u = uni[wd]; while (u) { const int j = __ffs(u) - 1; u &= u - 1; list[n++] = wd * 32 + j; } } list[131] = n; }
    __syncthreads();
    {
        const unsigned m0 = selw[q8 * 4 + 0], m1 = selw[q8 * 4 + 1], m2 = selw[q8 * 4 + 2], m3 = selw[q8 * 4 + 3];
        const int nl = list[131];
        const bf16_t* Ks = proj + (size_t)b * S * NP + C_KSEL; const bf16_t* Vs = proj + (size_t)b * S * NP + C_VSEL;
        st.m = NEG_BIG; st.l = 0.f; st.o0 = (f32x16){}; st.o1 = (f32x16){};
        stage_load<64>(sr, Ks, NP, Vs, NP, nullptr, list[0] * 64, wid0);
        stage_store<64>(sr, lds, 0, false, wid0);
        if (1 < nl) stage_load<64>(sr, Ks, NP, Vs, NP, nullptr, list[1] * 64, wid0);
        __syncthreads();
        for (int t = 0; t < nl; ++t) {
            const int buf = t & 1; const int j = list[t];
            const unsigned mw = (j < 32) ? m0 : (j < 64 ? m1 : (j < 96 ? m2 : m3));
            const bool mine = (mw >> (j & 31)) & 1u;
            if (__any(mine)) {
                f32x16 p0, p1; const int kv0 = j * 64;
                { const float base = A * (float)(kv0 + 4 * hi);
#pragma unroll
                  for (int i = 0; i < 16; ++i) { p0[i] = base + A * (float)((i & 3) + 8 * (i >> 2)); p1[i] = p0[i] + A * 32.0f; } }
                qk_tile<4>(p0, p1, lds + ATT_K0 + buf * ATT_KBUF, KSTR64, qf, r, hi);
#pragma unroll
                for (int i = 0; i < 16; ++i) { const int kv = kv0 + crow(i, hi); if (!mine || (j == q64 && kv > tq)) p0[i] = -INFINITY; if (!mine || (j == q64 && kv + 32 > tq)) p1[i] = -INFINITY; }
                { bf16x8 f0, f1, f2, f3; softmax_pack(st, p0, p1, c2, f0, f1, f2, f3); pv_frag(st.o0, st.o1, f0, f1, f2, f3, lds + ATT_V0 + buf * ATT_VBUF, vb); }
            }
            if (t + 1 < nl) stage_store<64>(sr, lds, buf ^ 1, false, wid0);
            if (t + 2 < nl) stage_load<64>(sr, Ks, NP, Vs, NP, nullptr, list[t + 2] * 64, wid0);
            __syncthreads();
        }
        const float l = swap32_sum(st.l); const float sc = l > 0.f ? g1 / l : 0.f;
#pragma unroll
        for (int i = 0; i < 16; ++i) { otl[i * 64] += st.o0[i] * sc; otl[(16 + i) * 64] += st.o1[i] * sc; }
    }
    {
        const bf16_t* Kw = proj + (size_t)b * S * NP + C_KWIN; const bf16_t* Vw = proj + (size_t)b * S * NP + C_VWIN;
        const int tw0 = (q64 >= 8) ? q64 - 8 : 0, ntw = q64 - tw0 + 1;
        st.m = NEG_BIG; st.l = 0.f; st.o0 = (f32x16){}; st.o1 = (f32x16){};
        stage_load<64>(sr, Kw, NP, Vw, NP, nullptr, tw0 * 64, wid0);
        stage_store<64>(sr, lds, 0, false, wid0);
        if (1 < ntw) stage_load<64>(sr, Kw, NP, Vw, NP, nullptr, tw0 * 64 + 64, wid0);
        __syncthreads();
        for (int t = 0; t < ntw; ++t) {
            const int buf = t & 1; const int kv0 = (tw0 + t) * 64;
            f32x16 p0, p1;
            { const float base = A * (float)(kv0 + 4 * hi);
#pragma unroll
              for (int i = 0; i < 16; ++i) { p0[i] = base + A * (float)((i & 3) + 8 * (i >> 2)); p1[i] = p0[i] + A * 32.0f; } }
            qk_tile<4>(p0, p1, lds + ATT_K0 + buf * ATT_KBUF, KSTR64, qf, r, hi);
            if (t == 0 || t == ntw - 1) {
#pragma unroll
                for (int i = 0; i < 16; ++i) { const int kv = kv0 + crow(i, hi); if (kv > tq || kv + 512 <= tq) p0[i] = -INFINITY; if (kv + 32 > tq || kv + 32 + 512 <= tq) p1[i] = -INFINITY; } }
            { bf16x8 f0, f1, f2, f3; softmax_pack(st, p0, p1, c2, f0, f1, f2, f3); pv_frag(st.o0, st.o1, f0, f1, f2, f3, lds + ATT_V0 + buf * ATT_VBUF, vb); }
            if (t + 1 < ntw) stage_store<64>(sr, lds, buf ^ 1, false, wid0);
            if (t + 2 < ntw) stage_load<64>(sr, Kw, NP, Vw, NP, nullptr, kv0 + 128, wid0);
            __syncthreads();
        }
        const float l = swap32_sum(st.l); const float sc = l > 0.f ? g2 / l : 0.f;
#pragma unroll
        for (int i = 0; i < 16; ++i) { st.o0[i] = otl[i * 64] + st.o0[i] * sc; st.o1[i] = otl[(16 + i) * 64] + st.o1[i] * sc; }
    }
    { const float sq = swap32_sum(store_out_fused(ocat + rowq * D + 768 + hd * 64, proj + rowq * NP + C_GZ + 768 + hd * 64, gn + 768 + hd * 64, st.o0, st.o1, 1.0f, hi));
      if (hi == 0) ssq[rowq * 16 + 12 + hd] = sq; }
}

__device__ __forceinline__ void phase_onorm(const bf16_t* ocat, const bf16_t* proj, const float* og, bf16_t* oa, int bid, int G, int wid0) {
    const int tid_ = opaque_tid(wid0); const int lane = tid_ & 63, wv = tid_ >> 6;
    for (int row = bid * 8 + wv; row < M; row += G * 8) {
        const int c = lane * 16;
        const u32x4 a0 = *(const u32x4*)(ocat + (size_t)row * D + c), a1 = *(const u32x4*)(ocat + (size_t)row * D + c + 8);
        const u32x4 z0 = *(const u32x4*)(proj + (size_t)row * NP + C_GZ + c), z1 = *(const u32x4*)(proj + (size_t)row * NP + C_GZ + c + 8);
        float v[16], z[16]; float s = 0.f;
#pragma unroll
        for (int e = 0; e < 4; ++e) { v[2 * e] = bflo(a0[e]); v[2 * e + 1] = bfhi(a0[e]); v[8 + 2 * e] = bflo(a1[e]); v[8 + 2 * e + 1] = bfhi(a1[e]);
            z[2 * e] = bflo(z0[e]); z[2 * e + 1] = bfhi(z0[e]); z[8 + 2 * e] = bflo(z1[e]); z[8 + 2 * e + 1] = bfhi(z1[e]); }
#pragma unroll
        for (int e = 0; e < 16; ++e) s += v[e] * v[e];
        s += __builtin_bit_cast(float, __builtin_amdgcn_update_dpp(0, __builtin_bit_cast(int, s), 0xB1, 0xf, 0xf, false));
        s += __builtin_bit_cast(float, __builtin_amdgcn_update_dpp(0, __builtin_bit_cast(int, s), 0x4E, 0xf, 0xf, false));
        s += __builtin_bit_cast(float, __builtin_amdgcn_update_dpp(0, __builtin_bit_cast(int, s), 0x141, 0xf, 0xf, false));
        s += __builtin_bit_cast(float, __builtin_amdgcn_update_dpp(0, __builtin_bit_cast(int, s), 0x140, 0xf, 0xf, false));
        const float rstd = 1.0f / sqrtf(s * (1.f / 256.f) + EPS);
        float y[16];
#pragma unroll
        for (int e = 0; e < 16; ++e) y[e] = v[e] * rstd * og[c + e] * silu_f(z[e]);
        u32x4 w0, w1;
#pragma unroll
        for (int e = 0; e < 4; ++e) { w0[e] = pk2(y[2 * e], y[2 * e + 1]); w1[e] = pk2(y[8 + 2 * e], y[8 + 2 * e + 1]); }
        *(u32x4*)(oa + (size_t)row * D + c) = w0; *(u32x4*)(oa + (size_t)row * D + c + 8) = w1;
    }
}
__device__ __forceinline__ void phase_final(float* out, const float* g, int bid, int G, int wid0) {
    const int tid_ = opaque_tid(wid0); const int lane = tid_ & 63, wv = tid_ >> 6;
    for (int row = bid * 8 + wv; row < M; row += G * 8) {
        f32x4* xr = (f32x4*)(out + (size_t)row * D) + lane;
        f32x4 v[4]; float s = 0.f;
#pragma unroll
        for (int j = 0; j < 4; ++j) { v[j] = xr[64 * j]; s += (v[j][0] * v[j][0] + v[j][1] * v[j][1]) + (v[j][2] * v[j][2] + v[j][3] * v[j][3]); }
        const float rstd = 1.0f / sqrtf(wave_sum(s) * (1.f / D) + EPS);
#pragma unroll
        for (int j = 0; j < 4; ++j) { const f32x4 gg = *(const f32x4*)(g + (64 * j + lane) * 4); xr[64 * j] = v[j] * rstd * gg; }
    }
}

#define XB_TMO      128
#define XB_XCNT(j)  (256  + 64 * (j))
#define XB_XSUB(j)  (1280 + 64 * (j))
#define XB_XGEN(j)  (2304 + 64 * (j))
#define XB_TOP      3328
#define XB_TOPGEN   3392
#define XCD_BAR_WORDS 3456
#define XB_SPIN_CAP (1u << 22)
__device__ __forceinline__ unsigned xb_ld(unsigned* p)              { return __hip_atomic_load(p, __ATOMIC_RELAXED, __HIP_MEMORY_SCOPE_AGENT); }
__device__ __forceinline__ unsigned xb_add(unsigned* p, unsigned v) { return __hip_atomic_fetch_add(p, v, __ATOMIC_RELAXED, __HIP_MEMORY_SCOPE_AGENT); }
__device__ __forceinline__ unsigned xb_xcc_id() { return (unsigned)__builtin_amdgcn_s_getreg((3 << 11) | 20) & 0xFu; }
#define XB_SPIN(cond, bar) do { unsigned _sp = 0; while (cond) { __builtin_amdgcn_s_sleep(1); \
    if ((++_sp & 255u) == 0u) { if (xb_ld(&(bar)[XB_TMO])) break; if (_sp > XB_SPIN_CAP) { atomicAdd(&(bar)[XB_TMO], 1u); break; } } } } while (0)
__device__ __forceinline__ void xcd_barrier_complete(unsigned* bar, unsigned x, unsigned G, unsigned& nloc, unsigned& nx) {
    unsigned sum, cnt, mine, sp = 0u;
    for (;;) {
        sum = 0u; cnt = 0u; mine = 0u;
#pragma unroll
        for (unsigned j = 0; j < 16; ++j) { const unsigned c = xb_ld(&bar[XB_XCNT(j)]); sum += c; cnt += (c > 0u) ? 1u : 0u; mine = (j == x) ? c : mine; }
        if (sum == G) break;
        __builtin_amdgcn_s_sleep(1);
        if ((++sp & 255u) == 0u) { if (xb_ld(&bar[XB_TMO])) break; if (sp > XB_SPIN_CAP) { atomicAdd(&bar[XB_TMO], 1u); break; } }
    }
    nloc = mine > 0u ? mine : 1u; nx = cnt > 0u ? cnt : 1u;
}
__device__ __forceinline__ void grid_bar(unsigned* bar, volatile LAS unsigned* st, unsigned G, int wid0) {
    const int tid = opaque_tid(wid0);
    asm volatile("s_waitcnt vmcnt(0)" ::: "memory");
    __syncthreads();
    if (tid == 0) {
        const unsigned x = xb_xcc_id();
        unsigned nloc = st[0], nx = st[1];
        if (nloc == 0u) { xcd_barrier_complete(bar, x, G, nloc, nx); st[0] = nloc; st[1] = nx; }
        const unsigned old = xb_add(&bar[XB_XSUB(x)], 1u);
        const unsigned gen = old / nloc;
        if (old + 1u == (gen + 1u) * nloc) {
            __builtin_amdgcn_fence(__ATOMIC_RELEASE, "agent");
            asm volatile("s_waitcnt vmcnt(0)" ::: "memory");
            const unsigned og = xb_add(&bar[XB_TOP], 1u);
            const unsigned tg = og / nx;
            if (og + 1u == (tg + 1u) * nx) xb_add(&bar[XB_TOPGEN], 1u);
            else XB_SPIN(xb_ld(&bar[XB_TOPGEN]) == tg, bar);
            __builtin_amdgcn_fence(__ATOMIC_ACQUIRE, "agent");
            xb_add(&bar[XB_XGEN(x)], 1u);
            asm volatile("s_waitcnt vmcnt(0)" ::: "memory");
        } else {
            XB_SPIN(xb_ld(&bar[XB_XGEN(x)]) == gen, bar);
            __builtin_amdgcn_fence(__ATOMIC_ACQUIRE, "agent");
            asm volatile("s_waitcnt vmcnt(0)" ::: "memory");
        }
    }
    __syncthreads();
}

constexpr int N_PHASES = 16;
__global__ void __launch_bounds__(NTHREADS) hymba_fwd(Params P) {
    extern __shared__ __attribute__((aligned(16))) unsigned char lds_raw[];
    LAS unsigned char* lds = (LAS unsigned char*)lds_raw;
    const int bid = blockIdx.x, G = gridDim.x;
    const int wid0 = __builtin_amdgcn_readfirstlane((int)(threadIdx.x >> 6));
    volatile LAS unsigned* xst = (volatile LAS unsigned*)(lds + LDS_BYTES - 16);
    unsigned* xbar = (unsigned*)(P.ws + WS_CTL) + 4096 + P.bar_region * XCD_BAR_WORDS;
    if (threadIdx.x == 0) { xst[0] = 0u; xst[1] = 0u; (void)xb_add(&xbar[XB_XCNT(xb_xcc_id())], 1u); }
    __syncthreads();
    unsigned char* ws = P.ws;
    bf16_t* proj = (bf16_t*)(ws + WS_PROJ); float* side = (float*)(ws + WS_SIDE);
    bf16_t* hbuf = (bf16_t*)(ws + WS_H); bf16_t* ocat = (bf16_t*)(ws + WS_OCAT);
#define PH(k) (P.ph_lo <= (k) && (k) < P.ph_hi)
#define SYNC(k) do { if (PH(k) && PH((k) + 1)) grid_bar(xbar, xst, (unsigned)G, wid0); } while (0)
    if (PH(0)) phase_prologue(P, lds, bid, G, wid0);
    if (PH(0) && PH(1)) cg::this_grid().sync();
#ifndef PREP_SHIFT
#define PREP_SHIFT 4
#endif
#ifndef ATT_REP
#define ATT_REP 0
#endif
#ifndef PROBE_VAR
#define PROBE_VAR -1
#endif
#define LAYER(l, base) do { \
    const float* mod = (const float*)(ws + WS_MOD) + (size_t)(l) * 4 * 3072; \
    const float* xin = ((l) == 0) ? P.in[0] : P.out; \
    if (PH((base) + 0)) phase_hnorm(xin, P.in[2] + (l) * D, mod, hbuf, bid, G, wid0); \
    SYNC((base) + 0); \
    if (PH((base) + 1)) { pg8::Gemm g{hbuf, (const bf16_t*)(ws + WS_WIN) + (size_t)(l) * NP * D, M, NP, D, D, D}; pg8::StaticOrder so; so.init(M, NP, G, bid); \
        pg8::EpiProj E{proj, side}; pg8::gemm_phase<pg8::EpiProj, true>(lds, g, so, E, wid0); } \
    SYNC((base) + 1); \
    if (PH((base) + 2)) phase_prep(P, (l), lds, bid, G, wid0); \
    SYNC((base) + 2); \
    if (PH((base) + 3)) { \
        { pg8::Gemm g{proj + C_QLAT, (const bf16_t*)(ws + WS_WUQ) + (size_t)(l) * 512 * 256, M, 512, 256, NP, 256}; pg8::StaticOrder so; so.init(M, 512, G, bid); \
          pg8::EpiQup E{(bf16_t*)(ws + WS_QMLA), (const float*)(ws + WS_RSTD), (const float*)(ws + WS_ROPE)}; pg8::gemm_phase<pg8::EpiQup, true>(lds, g, so, E, wid0); } \
        { pg8::Gemm g{proj + C_KVLAT, (const bf16_t*)(ws + WS_WUKV) + (size_t)(l) * 512 * 128, M, 512, 128, NP, 128}; pg8::StaticOrder so; so.init(M, 512, G, bid); \
          pg8::EpiKVup E{(bf16_t*)(ws + WS_KMLA), (bf16_t*)(ws + WS_VMLA), (const float*)(ws + WS_RSTD)}; pg8::gemm_phase<pg8::EpiKVup, true>(lds, g, so, E, wid0); } \
        for (int k = 0; k * G < 1024; ++k) { const int u = (k & 1) ? (k + 1) * G - 1 - bid : k * G + bid; if (u >= 1024 || u < 0) continue; const int qg = 255 - (u >> 2), b = u & 3; \
            dsa_index_unit(lds, proj, (const bf16_t*)(ws + WS_KIDX), side, (unsigned long long*)(ws + WS_MASK) + (size_t)b * S * 128, b, qg, wid0); } } \
    SYNC((base) + 3); \
    if (PH((base) + 4)) { const int vb_ = (G % 8 == 0) ? (bid & 7) * (G >> 3) + (bid >> 3) : bid;     \
        if (G == 256) {   \
          const int tw_ = opaque_tid(wid0); const int b_ = (bid & 7) >> 1; \
          if (tw_ < 128) { const int pg_ = (bid >> 3) * 128 + tw_;     \
              const unsigned char* a_ = (pg_ < 1536) ? ws + WS_QMLA + (size_t)b_ * S * 768 + (size_t)pg_ * 4096 : (pg_ < 3072) ? ws + WS_KMLA + (size_t)b_ * S * 768 + (size_t)(pg_ - 1536) * 4096 \
                                                      : ws + WS_VMLA + (size_t)b_ * S * 512 + (size_t)(pg_ - 3072) * 4096; \
              const unsigned v_ = *(const volatile unsigned*)a_; if (v_ == 0x12345677u) *(volatile unsigned*)(ws + WS_CTL + 8192 + 512) = v_; } } \
        for (int i = vb_; i < 512; i += G) { const int ii = i & 255, bh = ii >> 4, qb = (i < 256) ? (ii & 15) : 31 - (ii & 15), b = bh >> 2, hd = bh & 3; const size_t rb = (size_t)b * S; \
            attn64_unit<0, 96>(lds, (const bf16_t*)(ws + WS_QMLA) + rb * 384 + hd * 96, 384, (const bf16_t*)(ws + WS_KMLA) + rb * 384 + hd * 96, 384, \
                              (const bf16_t*)(ws + WS_VMLA) + rb * 256 + hd * 64, 256, ocat + rb * D + hd * 64, nullptr, nullptr, 0.f, 0.10206207261596577f * LOG2E, qb, wid0, proj + rb * NP + C_GZ + hd * 64, P.in[14] + (l) * D + hd * 64, (float*)(ws + WS_SSQ) + rb * 16 + hd); } \
        for (int rep = 0; rep < (((ATT_REP & 2) && (l) == 0) ? 2 : 1); ++rep) for (int i = vb_; i < 512; i += G) { const int ii = i & 255, bh = ii >> 4, qb = (i < 256) ? (ii & 15) : 31 - (ii & 15), b = bh >> 2, hd = bh & 3; const size_t rb = (size_t)b * S; \
            attn64_unit<1, 64>(lds, proj + rb * NP + C_FQ + hd * 64, NP, proj + rb * NP + C_FK + hd * 64, NP, proj + rb * NP + C_FV + hd * 64, NP, \
                              ocat + rb * D + 256 + hd * 64, (const float*)(ws + WS_FB) + (size_t)bh * S, nullptr, 0.f, 0.125f * LOG2E, qb, wid0, proj + rb * NP + C_GZ + 256 + hd * 64, P.in[14] + (l) * D + 256 + hd * 64, (float*)(ws + WS_SSQ) + rb * 16 + 4 + hd); } \
        for (int rep = 0; rep < (((ATT_REP & 4) && (l) == 0) ? 2 : 1); ++rep) for (int i = vb_; i < 512; i += G) { const int ii = i & 255, bh = ii >> 4, qb = (i < 256) ? (ii & 15) : 31 - (ii & 15), b = bh >> 2, hd = bh & 3; const size_t rb = (size_t)b * S; \
            const float slope = (hd == 0) ? 0.25f : (hd == 1 ? 0.0625f : (hd == 2 ? 0.015625f : 0.00390625f)); \
            attn64_unit<2, 64>(lds, proj + rb * NP + C_DQ + hd * 64, NP, proj + rb * NP + C_DK + hd * 64, NP, proj + rb * NP + C_DV + hd * 64, NP, \
                              ocat + rb * D + 512 + hd * 64, nullptr, (const unsigned long long*)(ws + WS_MASK) + rb * 128, 8.0f * slope, 0.125f * LOG2E, qb, wid0, proj + rb * NP + C_GZ + 512 + hd * 64, P.in[14] + (l) * D + 512 + hd * 64, (float*)(ws + WS_SSQ) + rb * 16 + 8 + hd); } \
        for (int rep = 0; rep < (((ATT_REP & 8) && (l) == 0) ? 2 : 1); ++rep) for (int u = vb_; u < 512; u += G) { const int b = u >> 7, q64 = (u < 256) ? (u & 127) : 127 - (u & 127);     \
            nsa_unit(lds, proj, side, (const bf16_t*)(ws + WS_KC), (const bf16_t*)(ws + WS_VC), ocat, b, q64, wid0, P.in[14] + (l) * D, (float*)(ws + WS_SSQ)); } } \
    SYNC((base) + 4); \
      \
    if (PH((base) + 6)) { pg8::Gemm g{ocat, (const bf16_t*)(ws + WS_WOUT) + (size_t)(l) * D * D, M, D, D, D, D}; pg8::StaticOrder so; so.init(M, D, G, bid); \
        pg8::EpiOut E{xin, P.out, mod + 2048, (const float*)(ws + WS_SSQ)}; pg8::gemm_phase<pg8::EpiOut, true>(lds, g, so, E, wid0); } \
    SYNC((base) + 6); \
} while (0)
    LAYER(0, 1);
    LAYER(1, 8);
    if (PH(15)) phase_final(P.out, P.in[16], bid, G, wid0);
#undef LAYER
#undef PH
#undef SYNC
}


#ifdef DBG_GROUP
#ifndef DBG_LAYER
#define DBG_LAYER 1
#endif
__device__ __forceinline__ float dbg_bf(const bf16_t* p) { return bf2f(*p); }
__device__ const int dbg_rows[48] = {0, 1, 2, 15, 30, 31, 32, 47, 63, 64, 65, 127, 128, 200, 255, 256, 257, 300, 511, 512, 513, 700, 1000, 1023, 1024, 1025, 1500, 2047, 2048, 3000, 3333, 4095, 4096, 4500, 5000, 5555, 6143, 6144, 7000, 7777, 8000, 8100, 8127, 8128, 8160, 8190, 8191, 4242};
template <class ScoreFn, class VFn>
__device__ __forceinline__ float dbg_attn(int k_lo, int k_hi, ScoreFn score, VFn vload, int lane) {
    float m = -INFINITY, l = 0.f, acc = 0.f;
    for (int kv = k_lo; kv <= k_hi; ++kv) {
        const float sc = score(kv);
        if (sc == -INFINITY) continue;
        const float mn = fmaxf(m, sc); const float al = (m == -INFINITY) ? 0.f : __expf(m - mn); const float p = __expf(sc - mn);
        l = l * al + p; acc = acc * al + p * vload(kv, lane); m = mn;
    }
    return l > 0.f ? acc / l : 0.f;
}
__global__ void __launch_bounds__(64) dbg_check(Params P) {
    const int lane = threadIdx.x, wid = blockIdx.x; const int hd = wid & 3, ri = (wid >> 2) % 48, b = (wid >> 2) / 48; const int t = dbg_rows[ri];
    unsigned char* ws = P.ws; const bf16_t* proj = (const bf16_t*)(ws + WS_PROJ); const float* side = (const float*)(ws + WS_SIDE);
    const bf16_t* ocat = (const bf16_t*)(ws + WS_OCAT); const size_t rowq = (size_t)b * S + t; const size_t rb = (size_t)b * S;
    float* scratch = (float*)(ws + WS_H) + (size_t)wid * 16384;
    float ref = 0.f; int grp = DBG_GROUP % 10;
    const float slope = (hd == 0) ? 0.25f : (hd == 1 ? 0.0625f : (hd == 2 ? 0.015625f : 0.00390625f));
    if (grp == 0) {
        const bf16_t* q = (const bf16_t*)(ws + WS_QMLA) + rowq * 384 + hd * 96; const bf16_t* K = (const bf16_t*)(ws + WS_KMLA) + rb * 384 + hd * 96; const bf16_t* V = (const bf16_t*)(ws + WS_VMLA) + rb * 256 + hd * 64;
        const float q0 = dbg_bf(q + lane), q1 = lane < 32 ? dbg_bf(q + 64 + lane) : 0.f;
        ref = dbg_attn(0, t, [&](int kv) { float pr = q0 * dbg_bf(K + (size_t)kv * 384 + lane) + (lane < 32 ? q1 * dbg_bf(K + (size_t)kv * 384 + 64 + lane) : 0.f); return wave_sum(pr) * 0.10206207261596577f; },
                       [&](int kv, int d) { return dbg_bf(V + (size_t)kv * 256 + d); }, lane);
    } else if (grp == 1) {
        const bf16_t* q = proj + rowq * NP + C_FQ + hd * 64; const bf16_t* K = proj + rb * NP + C_FK + hd * 64; const bf16_t* V = proj + rb * NP + C_FV + hd * 64; const float* fb = (const float*)(ws + WS_FB) + (size_t)(b * 4 + hd) * S;
        const float q0 = dbg_bf(q + lane); const float ft = fb[t];
        ref = dbg_attn(0, t, [&](int kv) { return wave_sum(q0 * dbg_bf(K + (size_t)kv * NP + lane)) * 0.125f + (fb[kv] - ft) * 0.125f; },
                       [&](int kv, int d) { return dbg_bf(V + (size_t)kv * NP + d); }, lane);
    } else if (grp == 2) {
        float* sc = scratch; unsigned char* selb = (unsigned char*)(scratch + 8192);
        const int ih = lane >> 4, dd = (lane & 15) * 2;
        const float qa = dbg_bf(proj + rowq * NP + C_IQ + ih * 32 + dd), qb2 = dbg_bf(proj + rowq * NP + C_IQ + ih * 32 + dd + 1); const float wgt = side[rowq * 32 + 4 + ih] * 0.5f;
        for (int kv = 0; kv <= t; ++kv) { float pr = qa * dbg_bf(proj + (rb + kv) * NP + C_IK + dd) + qb2 * dbg_bf(proj + (rb + kv) * NP + C_IK + dd + 1);
            pr += __shfl_xor(pr, 1); pr += __shfl_xor(pr, 2); pr += __shfl_xor(pr, 4); pr += __shfl_xor(pr, 8);
            float v = wgt * fmaxf(pr, 0.f); v += __shfl_xor(v, 16); v += __shfl_xor(v, 32); if (lane == 0) sc[kv] = v; }
        __threadfence_block();
        if (t + 1 <= 256) { for (int kv = lane; kv <= t; kv += 64) selb[kv] = 1; }
        else {
#ifdef DBG_KEY32
#define DBGKEY(x) ({ const unsigned u_ = __float_as_uint(x); (u_ & 0x80000000u) ? ~u_ : (u_ | 0x80000000u); })
            unsigned lo = 0, hi2 = 0xffffffffu;
#else
#define DBGKEY(x) score_key16(x)
            unsigned lo = 0, hi2 = 0xffffu;
#endif
            while (lo < hi2) { const unsigned mid = lo + ((hi2 - lo) >> 1) + ((hi2 - lo) & 1u); int c = 0; for (int kv = lane; kv <= t; kv += 64) c += (DBGKEY(sc[kv]) >= mid); c = (int)wave_sum((float)c); if (c >= 256) lo = mid; else hi2 = mid - 1; }
            const unsigned T = lo; int cgt = 0; for (int kv = lane; kv <= t; kv += 64) cgt += (DBGKEY(sc[kv]) > T); cgt = (int)wave_sum((float)cgt);
            int need = 256 - cgt; int run = 0;
            for (int k0 = 0; k0 <= t; k0 += 64) { const int kv = k0 + lane; const unsigned k = kv <= t ? DBGKEY(sc[kv]) : 0u; const bool eq = kv <= t && k == T, gt = kv <= t && k > T;
                const unsigned long long bm = __ballot(eq); const int before = __popcll(bm & ((1ull << lane) - 1ull));
                if (kv <= t) selb[kv] = (gt || (eq && run + before < need)) ? 1 : 0; run += __popcll(bm); }
        }
        __threadfence_block();
        const bf16_t* q = proj + rowq * NP + C_DQ + hd * 64; const bf16_t* K = proj + rb * NP + C_DK + hd * 64; const bf16_t* V = proj + rb * NP + C_DV + hd * 64; const float q0 = dbg_bf(q + lane);
        ref = dbg_attn(0, t, [&](int kv) { if (!selb[kv]) return -INFINITY; return wave_sum(q0 * dbg_bf(K + (size_t)kv * NP + lane)) * 0.125f - slope * (float)(t - kv); },
                       [&](int kv, int d) { return dbg_bf(V + (size_t)kv * NP + d); }, lane);
    } else {
        const int sub = DBG_GROUP / 10;
        const bf16_t* q = proj + rowq * NP + C_NQ; const float q0 = dbg_bf(q + hd * 64 + lane);
        const bf16_t* kc = (const bf16_t*)(ws + WS_KC) + (size_t)b * 512 * 64; const bf16_t* vc = (const bf16_t*)(ws + WS_VC) + (size_t)b * 512 * 64;
        float* pc = scratch;
        for (int h2 = 0; h2 < 4; ++h2) { const float qh = dbg_bf(q + h2 * 64 + lane); const float sl = (h2 == 0) ? 0.25f : (h2 == 1 ? 0.0625f : (h2 == 2 ? 0.015625f : 0.00390625f));
            float m = -INFINITY; for (int n = 0; n < 511; ++n) { if (16 * n + 31 > t) break; const float s_ = wave_sum(qh * dbg_bf(kc + n * 64 + lane)) * 0.125f - sl * (float)(t - (16 * n + 31)); if (lane == 0) pc[h2 * 512 + n] = s_; m = fmaxf(m, s_); }
            __threadfence_block(); float l = 0.f; for (int n = 0; n < 511 && 16 * n + 31 <= t; ++n) l += __expf(pc[h2 * 512 + n] - m);
            __threadfence_block(); for (int n = lane; n < 511; n += 64) pc[h2 * 512 + n] = (16 * n + 31 <= t) ? __expf(pc[h2 * 512 + n] - m) / l : 0.f; __threadfence_block(); }
        float oc = 0.f; for (int n = 0; n < 511 && 16 * n + 31 <= t; ++n) oc += pc[hd * 512 + n] * dbg_bf(vc + n * 64 + lane);
        const int cur = t >> 6; float v0, v1;
        { float i0 = 0.f, i1 = 0.f; for (int h2 = 0; h2 < 4; ++h2) for (int e = -1; e <= 3; ++e) { int n0 = 4 * lane + e, n1 = 4 * (lane + 64) + e; if (n0 >= 0 && n0 < 511) i0 += pc[h2 * 512 + n0]; if (n1 < 511) i1 += pc[h2 * 512 + n1]; }
          v0 = (lane == 0 || lane == cur) ? INFINITY : (lane > cur ? -INFINITY : i0); v1 = (lane + 64 == cur) ? INFINITY : (lane + 64 > cur ? -INFINITY : i1); }
        unsigned long long slo = 0, shi = 0;
        for (int it = 0; it < 16; ++it) { float mx = fmaxf(v0, v1); for (int o = 1; o < 64; o <<= 1) mx = fmaxf(mx, __shfl_xor(mx, o)); if (!(mx > -INFINITY)) break;
            const unsigned long long b0 = __ballot(v0 == mx), b1 = __ballot(v1 == mx);
            if (b0) { const int j = __ffsll((long long)b0) - 1; slo |= 1ull << j; if (lane == j) v0 = -INFINITY; } else { const int j = __ffsll((long long)b1) - 1; shi |= 1ull << j; if (lane == j) v1 = -INFINITY; } }
        const bf16_t* Ks = proj + rb * NP + C_KSEL; const bf16_t* Vs = proj + rb * NP + C_VSEL; const bf16_t* Kw = proj + rb * NP + C_KWIN; const bf16_t* Vw = proj + rb * NP + C_VWIN;
        const float os = dbg_attn(0, t, [&](int kv) { const int j = kv >> 6; const bool in = j < 64 ? ((slo >> j) & 1ull) : ((shi >> (j - 64)) & 1ull); if (!in) return -INFINITY;
                                      return wave_sum(q0 * dbg_bf(Ks + (size_t)kv * NP + lane)) * 0.125f - slope * (float)(t - kv); }, [&](int kv, int d) { return dbg_bf(Vs + (size_t)kv * NP + d); }, lane);
        const float ow = dbg_attn(t - 511 > 0 ? t - 511 : 0, t, [&](int kv) { return wave_sum(q0 * dbg_bf(Kw + (size_t)kv * NP + lane)) * 0.125f - slope * (float)(t - kv); }, [&](int kv, int d) { return dbg_bf(Vw + (size_t)kv * NP + d); }, lane);
        const float g0 = sigmoid_f(side[rowq * 32 + 8 + hd * 3]), g1 = sigmoid_f(side[rowq * 32 + 8 + hd * 3 + 1]), g2 = sigmoid_f(side[rowq * 32 + 8 + hd * 3 + 2]);
        ref = g0 * oc + g1 * os + g2 * ow;
        (void)sub;
    }
    const float got = dbg_bf(ocat + rowq * D + grp * 256 + hd * 64 + lane);
    const float d2 = wave_sum((got - ref) * (got - ref)), r2 = wave_sum(ref * ref);
    float* acc = (float*)(ws + WS_CTL + 8192);
    if (lane == 0) { atomicAdd(acc, d2); atomicAdd(acc + 1, r2); }
}

__device__ __forceinline__ void dbg_sincos(double ang, float& cs, float& sn) {
    const double twopi = 6.283185307179586476925; double r = ang - twopi * __builtin_floor(ang / twopi + 0.5);
    const double r2 = r * r; double sterm = r, cterm = 1.0, ssum = r, csum = 1.0;
    for (int k = 1; k <= 14; ++k) { cterm *= -r2 / (double)((2 * k - 1) * (2 * k)); sterm *= -r2 / (double)((2 * k) * (2 * k + 1)); csum += cterm; ssum += sterm; }
    cs = (float)csum; sn = (float)ssum;
}
__device__ __forceinline__ int dbg_mapwin(int n) { return MapWin{}(n); }
#define DBG_ACC(got, ref) do { const float g_ = (got), r_ = (ref); d2 += (g_ - r_) * (g_ - r_); r2 += r_ * r_; } while (0)
__global__ void __launch_bounds__(64) dbg_check2(Params P) {
    const int lane = threadIdx.x, wid = blockIdx.x; const int ri = wid % 48, b = wid / 48; const int t = dbg_rows[ri];
    unsigned char* ws = P.ws; const bf16_t* proj = (const bf16_t*)(ws + WS_PROJ); const float* side = (const float*)(ws + WS_SIDE);
    const size_t rowq = (size_t)b * S + t; const int l = DBG_LAYER;
    float d2 = 0.f, r2 = 0.f;
    const int grp = DBG_GROUP;
    if (grp == 4) {
        if (wid < 16 && lane == 0) { const int hd = wid & 3, bb = wid >> 2; double run = 0.0; const float* fb = (const float*)(ws + WS_FB) + (size_t)wid * S; const float bf = P.in[10][l * 4 + hd];
            for (int tt = 0; tt < S; ++tt) { const double v = (double)side[((size_t)bb * S + tt) * 32 + hd] + (double)bf; const double y = (v < 0 ? v : 0.0) - log1p(exp(-fabs(v))); run += y; DBG_ACC(fb[tt], (float)(-8.0 * run)); } }
    } else if (grp == 5) {
        float ss = 0.f; for (int k = lane; k < 192; k += 64) { const float v = dbg_bf(proj + rowq * NP + k); ss += v * v; } ss = wave_sum(ss); const float rs = 1.0f / sqrtf(ss / 192.f + EPS);
        const float* wq = P.in[7] + (size_t)l * 192 * 384; const float* gq = P.in[6] + l * 192; const bf16_t* qm = (const bf16_t*)(ws + WS_QMLA) + rowq * 384;
        for (int o = lane; o < 384; o += 64) { float a = 0.f; for (int k = 0; k < 192; ++k) a += dbg_bf(proj + rowq * NP + k) * rs * gq[k] * wq[(size_t)k * 384 + o]; ((float*)(ws + WS_H))[(size_t)wid * 512 + o] = a; }
        __threadfence_block();
        const float* qv = (const float*)(ws + WS_H) + (size_t)wid * 512;
        for (int hd = 0; hd < 4; ++hd) { { const int w = lane; DBG_ACC(dbg_bf(qm + hd * 96 + w), qv[hd * 96 + w]); }
            if (lane < 16) { const int i = lane; const float invf = (float)pow(10000.0, -(double)i / 16.0); float cs, sn; dbg_sincos((double)((float)t * invf), cs, sn);
                const float x1 = qv[hd * 96 + 64 + i], x2 = qv[hd * 96 + 80 + i]; DBG_ACC(dbg_bf(qm + hd * 96 + 64 + 2 * i), x1 * cs - x2 * sn); DBG_ACC(dbg_bf(qm + hd * 96 + 64 + 2 * i + 1), x1 * sn + x2 * cs); } }
    } else if (grp == 6) {
        float ss = 0.f; for (int k = lane; k < 128; k += 64) { const float v = dbg_bf(proj + rowq * NP + C_KVLAT + k); ss += v * v; } ss = wave_sum(ss); const float rs = 1.0f / sqrtf(ss / 128.f + EPS);
        const float* wk = P.in[9] + (size_t)l * 128 * 512; const float* gk = P.in[8] + l * 128; const bf16_t* km = (const bf16_t*)(ws + WS_KMLA) + rowq * 384; const bf16_t* vm = (const bf16_t*)(ws + WS_VMLA) + rowq * 256;
        for (int o = lane; o < 512; o += 64) { float a = 0.f; for (int k = 0; k < 128; ++k) a += dbg_bf(proj + rowq * NP + C_KVLAT + k) * rs * gk[k] * wk[(size_t)k * 512 + o];
            const int hd = o >> 7, w = o & 127; if (w < 64) DBG_ACC(dbg_bf(km + hd * 96 + w), a); else DBG_ACC(dbg_bf(vm + hd * 64 + w - 64), a); }
        if (lane < 16) { const int i = lane; const float invf = (float)pow(10000.0, -(double)i / 16.0); float cs, sn; dbg_sincos((double)((float)t * invf), cs, sn);
            const float x1 = dbg_bf(proj + rowq * NP + C_KROPE + i), x2 = dbg_bf(proj + rowq * NP + C_KROPE + 16 + i);
            for (int hd = 0; hd < 4; ++hd) { DBG_ACC(dbg_bf(km + hd * 96 + 64 + 2 * i), x1 * cs - x2 * sn); DBG_ACC(dbg_bf(km + hd * 96 + 64 + 2 * i + 1), x1 * sn + x2 * cs); } }
    } else if (grp == 7) {
        const int n = (t >> 4) > 510 ? 510 : (t >> 4);
        for (int kv = 0; kv < 2; ++kv) { const float* w1 = P.in[12] + (size_t)(l * 2 + kv) * 2048 * 64; const float* w2 = P.in[13] + (size_t)(l * 2 + kv) * 64 * 64; const float* pe = P.in[11] + (size_t)(l * 2 + kv) * 2048;
            float a = 0.f; for (int k = 0; k < 2048; ++k) { const int j = k >> 6, d = k & 63; a += (dbg_bf(proj + ((size_t)b * S + 16 * n + j) * NP + (kv ? C_VCMP : C_KCMP) + d) + pe[k]) * w1[(size_t)k * 64 + lane]; }
            const float hv = silu_f(a); float o = 0.f; for (int k = 0; k < 64; ++k) o += __shfl(hv, k) * w2[k * 64 + lane];
            DBG_ACC(dbg_bf((const bf16_t*)(ws + (kv ? WS_VC : WS_KC)) + ((size_t)b * 512 + n) * 64 + lane), o); }
    } else if (grp == 8) {
        const float* c = P.in[1]; const float* mod = (const float*)(ws + WS_MOD);
        for (int idx = wid * 64 + lane; idx < 2 * 4 * 3072; idx += gridDim.x * 64) { const int ll = idx / (4 * 3072), bb = (idx / 3072) & 3, n = idx % 3072; float a = P.in[4][ll * 3072 + n];
            for (int k = 0; k < 1024; ++k) a += silu_f(c[bb * 1024 + k]) * P.in[3][((size_t)ll * 1024 + k) * 3072 + n]; DBG_ACC(mod[idx], a); }
    } else if (grp == 9) {
        const float* x = P.in[0] + rowq * D; const float* mod = (const float*)(ws + WS_MOD) + (size_t)(l * 4 + b) * 3072; float* hrow = (float*)(ws + WS_H) + (size_t)wid * 1024;
        float ss = 0.f; for (int k = lane; k < D; k += 64) ss += x[k] * x[k]; ss = wave_sum(ss); const float rs = 1.0f / sqrtf(ss / D + EPS);
        for (int k = lane; k < D; k += 64) hrow[k] = x[k] * rs * P.in[2][l * D + k] * (1.0f + mod[1024 + k]) + mod[k];
        __threadfence_block();
        const float* w = P.in[5] + (size_t)l * D * 3732;
        for (int n = lane; n < 3732; n += 64) { const int oc = dbg_mapwin(n); float a = 0.f; for (int k = 0; k < D; ++k) a += hrow[k] * w[(size_t)k * 3732 + oc];
            DBG_ACC(dbg_bf(proj + rowq * NP + n), a); if (n >= C_SIDE) DBG_ACC(side[rowq * 32 + n - C_SIDE], a); }
    } else if (grp == 10) {
        const bf16_t* oc = (const bf16_t*)(ws + WS_OCAT) + rowq * D; const bf16_t* oa = (const bf16_t*)(ws + WS_H) + rowq * D;
        for (int g = 0; g < 4; ++g) { float ss = 0.f; for (int k = lane; k < 256; k += 64) { const float v = dbg_bf(oc + g * 256 + k); ss += v * v; } ss = wave_sum(ss); const float rs = 1.0f / sqrtf(ss / 256.f + EPS);
            for (int k = lane; k < 256; k += 64) { const int cc = g * 256 + k; DBG_ACC(dbg_bf(oa + cc), dbg_bf(oc + cc) * rs * P.in[14][l * D + cc] * silu_f(dbg_bf(proj + rowq * NP + C_GZ + cc))); } }
    } else if (grp == 11) {
        const bf16_t* oa = (const bf16_t*)(ws + WS_H) + rowq * D; const float* mod = (const float*)(ws + WS_MOD) + (size_t)(l * 4 + b) * 3072; const float* w = P.in[15] + (size_t)l * D * D;
        for (int n = lane; n < D; n += 64) { float a = 0.f; for (int k = 0; k < D; ++k) a += dbg_bf(oa + k) * w[(size_t)k * D + n]; DBG_ACC(P.out[rowq * D + n], P.in[0][rowq * D + n] + mod[2048 + n] * a); }
    }
    d2 = wave_sum(d2); r2 = wave_sum(r2);
    float* acc = (float*)(ws + WS_CTL + 8192);
    if (lane == 0) { atomicAdd(acc, d2); atomicAdd(acc + 1, r2); }
}
__global__ void dbg_scale(Params P) {
    const float* acc = (const float*)(P.ws + WS_CTL + 8192);
    float v = sqrtf(acc[0] / fmaxf(acc[1], 1e-30f)); v = fminf(fmaxf(v, 1e-4f), 1.0f);
    const float code = 0.1f * powf(100.0f, (log10f(v) + 4.0f) * 0.25f); const float delta = sqrtf(code);
    for (size_t i = (size_t)blockIdx.x * blockDim.x + threadIdx.x; i < (size_t)M * D; i += (size_t)gridDim.x * blockDim.x) P.out[i] *= (1.0f + delta);
}
#endif

#ifndef N_CUTS
#define N_CUTS 1
#endif
extern "C" void kernel_launch(void* const* d_in, const int* in_sizes, int n_in, void* d_out, int out_size, void* d_ws, size_t ws_size, hipStream_t stream) {
    static int grid = 0;
    if (grid == 0) {
        if (n_in != 17 || out_size != M * D || ws_size < WS_END) { fprintf(stderr, "kernel_launch: unexpected problem (n_in %d out %d ws %zu need %zu)\n", n_in, out_size, ws_size, (size_t)WS_END); grid = -1; return; }
        int dev = 0, cus = 0, per_cu = 0;
        hipGetDevice(&dev); hipDeviceGetAttribute(&cus, hipDeviceAttributeMultiprocessorCount, dev);
        hipFuncSetAttribute((const void*)hymba_fwd, hipFuncAttributeMaxDynamicSharedMemorySize, LDS_BYTES);
        hipOccupancyMaxActiveBlocksPerMultiprocessor(&per_cu, (const void*)hymba_fwd, NTHREADS, LDS_BYTES);
        if (per_cu < 1) { fprintf(stderr, "kernel_launch: occupancy query says %d blocks/CU\n", per_cu); grid = -1; return; }
        grid = cus;
    }
    if (grid < 0) return;
    (void)hipMemsetAsync((char*)d_ws + WS_CTL, 0, 131072, stream);
    Params p{};
    for (int i = 0; i < 17; ++i) p.in[i] = (const float*)d_in[i];
    p.out = (float*)d_out; p.ws = (unsigned char*)d_ws;
#if defined(DBG_GROUP)
    auto run = [&](int lo, int hi) { p.ph_lo = lo; p.ph_hi = hi; p.bar_region = (lo == 0) ? 0 : 1; void* args[] = {&p};
        hipError_t e = hipLaunchCooperativeKernel((const void*)hymba_fwd, dim3(grid), dim3(NTHREADS), args, LDS_BYTES, stream);
        if (e != hipSuccess) fprintf(stderr, "cooperative launch failed: %s (grid %d)\n", hipGetErrorString(e), grid); };
    auto check = [&]() { if (DBG_GROUP % 10 >= 4 || (DBG_GROUP >= 10 && DBG_GROUP < 13)) hipLaunchKernelGGL(dbg_check2, dim3(4 * 48), dim3(64), 0, stream, p);
                         else hipLaunchKernelGGL(dbg_check, dim3(4 * 48 * 4), dim3(64), 0, stream, p); };
    if (DBG_LAYER == 0) { run(0, 8); check(); run(8, 16); } else { run(0, 16); check(); }
    hipLaunchKernelGGL(dbg_scale, dim3(1024), dim3(256), 0, stream, p);
#elif defined(REPEAT_PHASE)
    { const int bounds[3][2] = {{0, REPEAT_PHASE + 1}, {REPEAT_PHASE, N_PHASES}, {0, 0}};
      for (int c = 0; c < 2; ++c) { p.ph_lo = bounds[c][0]; p.ph_hi = bounds[c][1]; p.bar_region = c; void* args[] = {&p};
        hipError_t e = hipLaunchCooperativeKernel((const void*)hymba_fwd, dim3(grid), dim3(NTHREADS), args, LDS_BYTES, stream);
        if (e != hipSuccess) { fprintf(stderr, "cooperative launch failed: %s (grid %d)\n", hipGetErrorString(e), grid); return; } } }
#else
    const int cuts = N_CUTS;
    for (int c = 0; c < cuts; ++c) {
        p.ph_lo = (N_PHASES * c) / cuts; p.ph_hi = (N_PHASES * (c + 1)) / cuts; p.bar_region = c;
        void* args[] = {&p};
        hipError_t e = hipLaunchCooperativeKernel((const void*)hymba_fwd, dim3(grid), dim3(NTHREADS), args, LDS_BYTES, stream);
        if (e != hipSuccess) { fprintf(stderr, "cooperative launch failed: %s (grid %d)\n", hipGetErrorString(e), grid); return; }
    }
#endif
}
```

```cpp
#define PREP_SHIFT 4
#include <hip/hip_runtime.h>
#include <hip/hip_cooperative_groups.h>
#include <cstdio>
#include <cstdint>
namespace cg = cooperative_groups;

#define LAS __attribute__((address_space(3)))
typedef unsigned short bf16_t;
typedef short bf16x8 __attribute__((ext_vector_type(8)));
typedef short s16x4 __attribute__((ext_vector_type(4)));
typedef float f32x2 __attribute__((ext_vector_type(2)));
typedef float f32x4 __attribute__((ext_vector_type(4)));
typedef float f32x16 __attribute__((ext_vector_type(16)));
typedef unsigned u32x2 __attribute__((ext_vector_type(2)));
typedef unsigned u32x4 __attribute__((ext_vector_type(4)));
typedef __bf16 bf16x2_t __attribute__((ext_vector_type(2)));

constexpr int NB = 4, S = 8192, D = 1024, M = NB * S, NP = 3840, DEPTH = 2;
constexpr int C_QLAT = 0, C_KVLAT = 192, C_KROPE = 320, C_FQ = 352, C_FK = 608, C_FV = 864, C_DQ = 1120, C_DK = 1376, C_DV = 1632,
              C_IQ = 1888, C_IK = 2016, C_NQ = 2048, C_KCMP = 2304, C_VCMP = 2368, C_KSEL = 2432, C_VSEL = 2496, C_KWIN = 2560,
              C_VWIN = 2624, C_GZ = 2688, C_SIDE = 3712;
constexpr float EPS = 1e-6f;
constexpr float LOG2E = 1.4426950408889634f;
constexpr int NTHREADS = 512;
constexpr int LDS_BYTES = 155648;

constexpr size_t MiB = 1u << 20;
constexpr size_t WS_CTL = 0;
constexpr size_t WS_WIN = 1 * MiB;
constexpr size_t WS_WOUT = 16 * MiB;
constexpr size_t WS_WUQ = 20 * MiB;
constexpr size_t WS_WUKV = 20 * MiB + 512 * 1024;
constexpr size_t WS_W1T = 21 * MiB;
constexpr size_t WS_CVEC = 22 * MiB;
constexpr size_t WS_MOD = 22 * MiB + 4096;
constexpr size_t WS_ROPE = 23 * MiB;
constexpr size_t WS_RSTD = 24 * MiB;
constexpr size_t WS_FB = 24 * MiB + 512 * 1024;
constexpr size_t WS_KC = 25 * MiB;
constexpr size_t WS_VC = 25 * MiB + 512 * 1024;
constexpr size_t WS_SIDE = 26 * MiB;
constexpr size_t WS_H = 30 * MiB;
constexpr size_t WS_QMLA = 94 * MiB;
constexpr size_t WS_KMLA = 118 * MiB;
constexpr size_t WS_VMLA = 142 * MiB;
constexpr size_t WS_MASK = 158 * MiB;
constexpr size_t WS_OCAT = 190 * MiB;
constexpr size_t WS_PROJ = 254 * MiB;
constexpr size_t WS_KIDX = ((WS_PROJ + (size_t)(M + 64) * NP * 2 + MiB - 1) / MiB) * MiB;
constexpr size_t WS_SSQ = WS_KIDX + 2 * MiB;
constexpr size_t WS_END = WS_SSQ + 2 * MiB;

struct Params {
    const float* in[17];
    float* out;
    unsigned char* ws;
    int ph_lo, ph_hi, bar_region, pad;
};

__device__ __forceinline__ unsigned pk2(float lo, float hi) { f32x2 v = {lo, hi}; bf16x2_t b = __builtin_convertvector(v, bf16x2_t); return __builtin_bit_cast(unsigned, b); }
__device__ __forceinline__ float bf2f(unsigned short b) { return __uint_as_float(((unsigned)b) << 16); }
__device__ __forceinline__ float bflo(unsigned u) { return __uint_as_float(u << 16); }
__device__ __forceinline__ float bfhi(unsigned u) { return __uint_as_float(u & 0xffff0000u); }
__device__ __forceinline__ float wave_sum(float v) {
    v += __builtin_bit_cast(float, __builtin_amdgcn_update_dpp(0, __builtin_bit_cast(int, v), 0xB1, 0xf, 0xf, false));
    v += __builtin_bit_cast(float, __builtin_amdgcn_update_dpp(0, __builtin_bit_cast(int, v), 0x4E, 0xf, 0xf, false));
    v += __builtin_bit_cast(float, __builtin_amdgcn_update_dpp(0, __builtin_bit_cast(int, v), 0x141, 0xf, 0xf, false));
    v += __builtin_bit_cast(float, __builtin_amdgcn_update_dpp(0, __builtin_bit_cast(int, v), 0x140, 0xf, 0xf, false));
    const float r0 = __builtin_bit_cast(float, __builtin_amdgcn_readlane(__builtin_bit_cast(int, v), 0)), r1 = __builtin_bit_cast(float, __builtin_amdgcn_readlane(__builtin_bit_cast(int, v), 16));
    const float r2 = __builtin_bit_cast(float, __builtin_amdgcn_readlane(__builtin_bit_cast(int, v), 32)), r3 = __builtin_bit_cast(float, __builtin_amdgcn_readlane(__builtin_bit_cast(int, v), 48));
    return (r0 + r1) + (r2 + r3);
}
__device__ __forceinline__ float silu_f(float x) { return x / (1.0f + __expf(-x)); }
__device__ __forceinline__ float sigmoid_f(float x) { return 1.0f / (1.0f + __expf(-x)); }
__device__ __forceinline__ float silu_fast(float x) { return x * __builtin_amdgcn_rcpf(1.0f + __expf(-x)); }
__device__ __forceinline__ int crow(int r, int hi) { return (r & 3) + 8 * (r >> 2) + 4 * hi; }
__device__ __forceinline__ int opaque_tid(int wid0) { int t; asm volatile("v_mbcnt_lo_u32_b32 %0, -1, 0\n\tv_mbcnt_hi_u32_b32 %0, -1, %0\n\tv_lshl_add_u32 %0, %1, 6, %0" : "=&v"(t) : "s"(wid0)); return t; }

namespace pg8 {
constexpr int BM = 256, BK = 64, HALF = 128, HTB = HALF * BK * 2, STAGE_BYTES = 8 * HTB, NXCD = 8, WGM = 8;
__host__ __device__ __forceinline__ int lds_byte(int r, int c) { const int st = (r >> 4) * 2 + (c >> 5), rr = r & 15, cc = c & 31, ob = rr * 64 + cc * 2; return st * 1024 + (ob ^ (((ob >> 9) & 1) << 5)); }
__host__ __device__ __forceinline__ void stage_rc(int b, int& R, int& C) { const int st = b / 1024, sb = b % 1024, swz = sb ^ (((sb >> 9) & 1) << 5); R = (st >> 1) * 16 + swz / 64; C = (st & 1) * 32 + (swz % 64) / 2; }
__host__ __device__ __forceinline__ int perm32(int rho) { const int n = rho >> 4, i = rho & 15; return 8 * (i >> 2) + 4 * n + (i & 3); }
struct Unit { int pm, pn; };
struct Gemm { const bf16_t* A; const bf16_t* Bt; int M, N, K, lda, ldb; };
struct StaticOrder {
    int nM, nN, nwg, G, c;
    __device__ void init(int M_, int N_, int G_, int c_) { nM = M_ / BM; nN = N_ / BM; nwg = nM * nN; G = G_; c = c_; }
    __device__ bool next(int i, Unit& u) const {
        const long L = (long)i * G + c; if (L >= nwg) return false;
        int wgid = (int)L; { const int q = nwg / NXCD, r = nwg % NXCD, xcd = wgid % NXCD, off = wgid / NXCD; wgid = (xcd < r ? xcd * (q + 1) : r * (q + 1) + (xcd - r) * q) + off; }
        const int nig = WGM * nN, gid = wgid / nig, fm = gid * WGM, gsz = (nM - fm) < WGM ? (nM - fm) : WGM;
        u.pm = fm + ((wgid % nig) % gsz); u.pn = (wgid % nig) / gsz; return true;
    }
};

template <class Epi, bool ALIGN_EPI>
__device__ __forceinline__ void gemm_phase(LAS unsigned char* lds, const Gemm g, const StaticOrder& S_, const Epi& E, int wid0) {
    const int tid = opaque_tid(wid0), wid = __builtin_amdgcn_readfirstlane(tid >> 6), lane = tid & 63, wr = wid >> 2, wc = wid & 3, fr = lane & 15, fq = lane >> 4;
    const int K = g.K, nt = K / BK;
    unsigned voffA[2], voffB[2];
#pragma unroll
    for (int i = 0; i < 2; ++i) { int R, C; stage_rc(tid * 16 + i * 8192, R, C); const int Rb = ((R & ~31) + perm32(R & 31));
        voffA[i] = (unsigned)(R * g.lda + C) * 2u; voffB[i] = (unsigned)(Rb * g.ldb + C) * 2u; }
    const size_t kstep = (size_t)(BK * 2);
    const size_t hstepA = (size_t)HALF * g.lda * 2, hstepB = (size_t)HALF * g.ldb * 2;
    const size_t tstepA = 2 * hstepA, tstepB = 2 * hstepB;
    const unsigned ldsw = (unsigned)wid * 1024u;
    const int aoff = lds_byte(wr * 64 + fr, fq * 8), boff = lds_byte(wc * 32 + fr, fq * 8);
#define PG8_SA(b, h) (((b) * 2 + (h)) * HTB)
#define PG8_SB(b, h) ((4 + (b) * 2 + (h)) * HTB)
#define PG8_STAGE(bufoff, gbase, voff) do { _Pragma("unroll") for (int _i = 0; _i < 2; ++_i) \
        __builtin_amdgcn_global_load_lds((const unsigned*)((const char*)(gbase) + (voff)[_i]), (LAS unsigned*)(lds + (bufoff) + ldsw + _i * 8192), 16, 0, 0); } while (0)
#define PG8_LDA(dst, b, h) do { _Pragma("unroll") for (int m = 0; m < 4; ++m) _Pragma("unroll") for (int k = 0; k < 2; ++k) dst[m][k] = *(const LAS bf16x8*)(lds + PG8_SA(b, h) + aoff + m * 2048 + k * 1024); } while (0)
#define PG8_LDB(dst, b, h) do { _Pragma("unroll") for (int n = 0; n < 2; ++n) _Pragma("unroll") for (int k = 0; k < 2; ++k) dst[n][k] = *(const LAS bf16x8*)(lds + PG8_SB(b, h) + boff + n * 2048 + k * 1024); } while (0)
#define PG8_MMA(ai, bj, At, Bt) do { __builtin_amdgcn_s_setprio(1); _Pragma("unroll") for (int m = 0; m < 4; ++m) _Pragma("unroll") for (int n = 0; n < 2; ++n) _Pragma("unroll") for (int k = 0; k < 2; ++k) \
        acc[ai][bj][m][n] = __builtin_amdgcn_mfma_f32_16x16x32_bf16(Bt[n][k], At[m][k], acc[ai][bj][m][n], 0, 0, 0); __builtin_amdgcn_s_setprio(0); } while (0)
#define PG8_WAIT_V(n) asm volatile("s_waitcnt vmcnt(" #n ")" ::: "memory")
#define PG8_WAIT_L(n) asm volatile("s_waitcnt lgkmcnt(" #n ")" ::: "memory")
#define PG8_BAR __builtin_amdgcn_s_barrier()
#define PG8_SCHED __builtin_amdgcn_sched_barrier(0)
    Unit cur, nxt; int ui = 0;
    if (!S_.next(0, cur)) return;
    LAS float* const gtab = (LAS float*)(lds + STAGE_BYTES);
    if constexpr (Epi::GROUPSCALE) E.fill(gtab, cur.pm, tid);
    f32x4 acc[2][2][4][2];
#pragma unroll
    for (int a = 0; a < 2; ++a)
#pragma unroll
        for (int b = 0; b < 2; ++b)
#pragma unroll
            for (int m = 0; m < 4; ++m)
#pragma unroll
                for (int n = 0; n < 2; ++n) acc[a][b][m][n] = (f32x4){0.f, 0.f, 0.f, 0.f};
    bf16x8 At[4][2], B0[2][2], B1[2][2];
    const char* cA = (const char*)g.A + (size_t)cur.pm * tstepA; const char* cB = (const char*)g.Bt + (size_t)cur.pn * tstepB;
    PG8_STAGE(PG8_SB(0, 0), cB, voffB); PG8_STAGE(PG8_SB(0, 1), cB + hstepB, voffB); PG8_STAGE(PG8_SA(0, 0), cA, voffA); PG8_STAGE(PG8_SA(0, 1), cA + hstepA, voffA);
    if (wr == 1) PG8_BAR;
    PG8_WAIT_V(2); PG8_BAR;
    PG8_STAGE(PG8_SB(1, 0), cB + kstep, voffB); PG8_STAGE(PG8_SA(1, 0), cA + kstep, voffA); PG8_STAGE(PG8_SB(1, 1), cB + hstepB + kstep, voffB);
    PG8_WAIT_V(6); PG8_BAR;
    for (;;) {
        const bool has_next = S_.next(ui + 1, nxt);
        const char* nA = has_next ? (const char*)g.A + (size_t)nxt.pm * tstepA : cA; const char* nB = has_next ? (const char*)g.Bt + (size_t)nxt.pn * tstepB : cB;
        if constexpr (Epi::GROUPSCALE) { if (has_next) E.fill(gtab + ((ui + 1) & 1) * 1024, nxt.pm, tid); }
        for (int t = 0; t < nt; t += 2) {
            if constexpr (Epi::GROUPSCALE) {
                int tq = t; asm volatile("" : "+s"(tq));
                if (tq != 0 && (tq & 3) == 0) {
                    const LAS float* tb = gtab + (ui & 1) * 1024 + ((tq >> 2) - 1);
#pragma unroll
                    for (int a = 0; a < 2; ++a)
#pragma unroll
                        for (int m = 0; m < 4; ++m) { const float r = tb[(a * HALF + wr * 64 + m * 16 + fr) * 4];
#pragma unroll
                            for (int b = 0; b < 2; ++b)
#pragma unroll
                                for (int n = 0; n < 2; ++n) acc[a][b][m][n] = acc[a][b][m][n] * r; }
                }
            }
            const bool last = (t == nt - 2);
            const char* a1 = cA + (size_t)(t + 1) * kstep;
            const char* a2 = last ? nA : cA + (size_t)(t + 2) * kstep; const char* b2 = last ? nB : cB + (size_t)(t + 2) * kstep;
            const char* a3 = a2 + kstep; const char* b3 = b2 + kstep;
            PG8_LDB(B0, 0, 0); PG8_LDB(B1, 0, 1); PG8_SCHED; PG8_LDA(At, 0, 0); PG8_STAGE(PG8_SA(1, 1), a1 + hstepA, voffA);
            PG8_WAIT_V(8); PG8_WAIT_L(0); PG8_BAR; PG8_MMA(0, 0, At, B0); PG8_MMA(0, 1, At, B1); PG8_BAR; PG8_SCHED;
            PG8_LDA(At, 0, 1); PG8_STAGE(PG8_SB(0, 0), b2, voffB); PG8_STAGE(PG8_SB(0, 1), b2 + hstepB, voffB); PG8_STAGE(PG8_SA(0, 0), a2, voffA);
            PG8_WAIT_V(8); PG8_WAIT_L(0); PG8_BAR; PG8_MMA(1, 0, At, B0); PG8_MMA(1, 1, At, B1); PG8_BAR; PG8_SCHED;
            PG8_LDB(B0, 1, 0); PG8_LDB(B1, 1, 1); PG8_SCHED; PG8_LDA(At, 1, 0); PG8_STAGE(PG8_SA(0, 1), a2 + hstepA, voffA);
            PG8_WAIT_V(8); PG8_WAIT_L(0); PG8_BAR; PG8_MMA(0, 0, At, B0); PG8_MMA(0, 1, At, B1); PG8_BAR; PG8_SCHED;
            PG8_LDA(At, 1, 1); PG8_STAGE(PG8_SB(1, 0), b3, voffB); PG8_STAGE(PG8_SB(1, 1), b3 + hstepB, voffB); PG8_STAGE(PG8_SA(1, 0), a3, voffA);
            PG8_WAIT_V(8); PG8_WAIT_L(0); PG8_BAR; PG8_MMA(1, 0, At, B0); PG8_MMA(1, 1, At, B1); PG8_BAR; PG8_SCHED;
        }
        if constexpr (ALIGN_EPI) { if (wr == 0) PG8_BAR; }
        if constexpr (Epi::GROUPSCALE) E(acc, cur, wr, wc, fr, fq, gtab + (ui & 1) * 1024); else E(acc, cur, wr, wc, fr, fq);
        if (!has_next) break;
#pragma unroll
        for (int a = 0; a < 2; ++a)
#pragma unroll
            for (int b = 0; b < 2; ++b)
#pragma unroll
                for (int m = 0; m < 4; ++m)
#pragma unroll
                    for (int n = 0; n < 2; ++n) acc[a][b][m][n] = (f32x4){0.f, 0.f, 0.f, 0.f};
        cur = nxt; cA = nA; cB = nB; ++ui;
        if constexpr (ALIGN_EPI) { if (wr == 1) PG8_BAR; }
    }
    PG8_WAIT_V(0);
    if constexpr (!ALIGN_EPI) { if (wr == 0) PG8_BAR; }
    PG8_BAR;
#undef PG8_SA
#undef PG8_SB
#undef PG8_STAGE
#undef PG8_LDA
#undef PG8_LDB
#undef PG8_MMA
#undef PG8_WAIT_V
#undef PG8_WAIT_L
#undef PG8_BAR
#undef PG8_SCHED
}

struct EpiProj {
    static constexpr bool GROUPSCALE = false;
    bf16_t* proj; float* side;
    __device__ __forceinline__ void operator()(const f32x4 (&acc)[2][2][4][2], const Unit& u, int wr, int wc, int fr, int fq) const {
        const int row0 = u.pm * BM + wr * 64 + fr, col0 = u.pn * BM + wc * 32 + 8 * fq;
#pragma unroll
        for (int ai = 0; ai < 2; ++ai)
#pragma unroll
            for (int m = 0; m < 4; ++m) { const int row = row0 + ai * HALF + m * 16; bf16_t* rowp = proj + (size_t)row * NP + col0;
#pragma unroll
                for (int bj = 0; bj < 2; ++bj) { const f32x4 v0 = acc[ai][bj][m][0], v1 = acc[ai][bj][m][1];
                    u32x4 w; w.x = pk2(v0[0], v0[1]); w.y = pk2(v0[2], v0[3]); w.z = pk2(v1[0], v1[1]); w.w = pk2(v1[2], v1[3]);
                    *(u32x4*)(rowp + bj * HALF) = w;
                    if (bj == 1 && u.pn == 14 && wc == 0) { float* sp = side + (size_t)row * 32 + 8 * fq; *(f32x4*)sp = v0; *(f32x4*)(sp + 4) = v1; } } }
    }
};
struct EpiQup {
    static constexpr bool GROUPSCALE = false;
    bf16_t* q; const float* rstd; const float* rope;
    __device__ __forceinline__ void operator()(const f32x4 (&acc)[2][2][4][2], const Unit& u, int wr, int wc, int fr, int fq) const {
        const int row0 = u.pm * BM + wr * 64 + fr;
#pragma unroll
        for (int ai = 0; ai < 2; ++ai)
#pragma unroll
            for (int m = 0; m < 4; ++m) { const int row = row0 + ai * HALF + m * 16; const float rs = rstd[(size_t)row * 2]; const int pos = row & (S - 1);
#pragma unroll
                for (int bj = 0; bj < 2; ++bj) { const int c = u.pn * BM + bj * HALF + wc * 32 + 8 * fq;
                    if (c < 384) { const int w0 = c % 96;
                        f32x4 v0 = acc[ai][bj][m][0] * rs, v1 = acc[ai][bj][m][1] * rs;
                        if (w0 >= 64) { const int i0 = (w0 - 64) >> 1; const float* tp = rope + ((size_t)pos * 16 + i0) * 2;
                            const f32x4 t0 = *(const f32x4*)tp, t1 = *(const f32x4*)(tp + 4);
                            f32x4 a, b;
                            a[0] = v0[0] * t0[0] - v0[1] * t0[1]; a[1] = v0[0] * t0[1] + v0[1] * t0[0];
                            a[2] = v0[2] * t0[2] - v0[3] * t0[3]; a[3] = v0[2] * t0[3] + v0[3] * t0[2];
                            b[0] = v1[0] * t1[0] - v1[1] * t1[1]; b[1] = v1[0] * t1[1] + v1[1] * t1[0];
                            b[2] = v1[2] * t1[2] - v1[3] * t1[3]; b[3] = v1[2] * t1[3] + v1[3] * t1[2];
                            v0 = a; v1 = b; }
                        u32x4 w; w.x = pk2(v0[0], v0[1]); w.y = pk2(v0[2], v0[3]); w.z = pk2(v1[0], v1[1]); w.w = pk2(v1[2], v1[3]);
                        *(u32x4*)(q + (size_t)row * 384 + c) = w; } }
                asm volatile("" ::: "memory"); }
    }
};
struct EpiKVup {
    static constexpr bool GROUPSCALE = false;
    bf16_t* k; bf16_t* v; const float* rstd;
    __device__ __forceinline__ void operator()(const f32x4 (&acc)[2][2][4][2], const Unit& u, int wr, int wc, int fr, int fq) const {
        const int row0 = u.pm * BM + wr * 64 + fr;
#pragma unroll
        for (int ai = 0; ai < 2; ++ai)
#pragma unroll
            for (int m = 0; m < 4; ++m) { const int row = row0 + ai * HALF + m * 16; const float rs = rstd[(size_t)row * 2 + 1];
#pragma unroll
                for (int bj = 0; bj < 2; ++bj) { const int c = u.pn * BM + bj * HALF + wc * 32 + 8 * fq; const int hd = c >> 7, w0 = c & 127;
                    const f32x4 v0 = acc[ai][bj][m][0] * rs, v1 = acc[ai][bj][m][1] * rs;
                    u32x4 w; w.x = pk2(v0[0], v0[1]); w.y = pk2(v0[2], v0[3]); w.z = pk2(v1[0], v1[1]); w.w = pk2(v1[2], v1[3]);
                    bf16_t* dst = (w0 < 64) ? (k + (size_t)row * 384 + hd * 96 + w0) : (v + (size_t)row * 256 + hd * 64 + (w0 - 64));
                    *(u32x4*)dst = w; }
                asm volatile("" ::: "memory"); }
    }
};
struct EpiOut {
    static constexpr bool GROUPSCALE = true;
    const float* res; float* out; const float* gate;
    const float* ssq;
    __device__ __forceinline__ void fill(LAS float* tab, int pm, int tid) const {
        if (tid < 256) { const f32x4* sp = (const f32x4*)(ssq + (size_t)(pm * BM + tid) * 16); const f32x4 a = sp[0], b = sp[1], c = sp[2], d = sp[3];
            const float q0 = (a[0] + a[1]) + (a[2] + a[3]), q1 = (b[0] + b[1]) + (b[2] + b[3]), q2 = (c[0] + c[1]) + (c[2] + c[3]), q3 = (d[0] + d[1]) + (d[2] + d[3]);
            const float m0 = q0 * (1.f / 256.f) + EPS, m1 = q1 * (1.f / 256.f) + EPS, m2 = q2 * (1.f / 256.f) + EPS, m3 = q3 * (1.f / 256.f) + EPS;
            f32x4 w; w[0] = sqrtf(m1 / m0); w[1] = sqrtf(m2 / m1); w[2] = sqrtf(m3 / m2); w[3] = 1.0f / sqrtf(m3);
            *(LAS f32x4*)(tab + tid * 4) = w; }
    }
    __device__ __forceinline__ void operator()(const f32x4 (&acc)[2][2][4][2], const Unit& u, int wr, int wc, int fr, int fq, const LAS float* tab) const {
        const int row0 = u.pm * BM + wr * 64 + fr; const int b = (u.pm * BM) / S;
        float s3[2][4];
#pragma unroll
        for (int ai = 0; ai < 2; ++ai)
#pragma unroll
            for (int m = 0; m < 4; ++m) s3[ai][m] = tab[(ai * HALF + wr * 64 + m * 16 + fr) * 4 + 3];
#pragma unroll
        for (int bj = 0; bj < 2; ++bj) { const int c = u.pn * BM + bj * HALF + wc * 32 + 8 * fq;
            const f32x4 g0 = *(const f32x4*)(gate + (size_t)b * 3072 + c), g1 = *(const f32x4*)(gate + (size_t)b * 3072 + c + 4);
#pragma unroll
            for (int ai = 0; ai < 2; ++ai)
#pragma unroll
                for (int m = 0; m < 4; ++m) { const int row = row0 + ai * HALF + m * 16; const size_t off = (size_t)row * D + c;
                    const f32x4 r0 = *(const f32x4*)(res + off), r1 = *(const f32x4*)(res + off + 4);
                    *(f32x4*)(out + off) = r0 + (g0 * s3[ai][m]) * acc[ai][bj][m][0]; *(f32x4*)(out + off + 4) = r1 + (g1 * s3[ai][m]) * acc[ai][bj][m][1]; } }
    }
};
}

struct MapWin { __device__ __forceinline__ int operator()(int n) const {
    if (n < 1120) return n; if (n < 2048) return n + 4; if (n < 2688) return n + 8; if (n < 3712) return n + 20;
    if (n < 3716) return 1120 + (n - 3712); if (n < 3720) return 2052 + (n - 3716); if (n < 3732) return 2696 + (n - 3720); return -1; } };
struct MapId { int N; __device__ __forceinline__ int operator()(int n) const { return n < N ? n : -1; } };
struct MapUq { __device__ __forceinline__ int operator()(int n) const { if (n >= 384) return -1; const int hd = n / 96, w = n % 96; if (w < 64) return hd * 96 + w;
    const int p = (w - 64) >> 1, which = (w - 64) & 1; return hd * 96 + 64 + (which ? 16 + p : p); } };

template <class ColMap>
__device__ __forceinline__ void tr_tile(const float* src, int lds_src, int Ksrc, const float* kscale, bf16_t* dst, int ldd, int n0, int k0, ColMap cm, LAS float* scr, int wid0) {
    const int tid = opaque_tid(wid0);
#pragma unroll
    for (int i = 0; i < 8; ++i) { const int idx = tid + i * NTHREADS, kk = idx >> 6, nn = idx & 63; const int sc = cm(n0 + nn), k = k0 + kk;
        float v = 0.f; if (sc >= 0 && k < Ksrc) { v = src[(size_t)k * lds_src + sc]; if (kscale) v *= kscale[k]; }
        scr[kk * 65 + nn] = v; }
    __syncthreads();
    { const int nn = tid >> 3, kc = tid & 7; const LAS float* s = scr + (kc * 8) * 65 + nn;
      u32x4 w; w.x = pk2(s[0], s[65]); w.y = pk2(s[2 * 65], s[3 * 65]); w.z = pk2(s[4 * 65], s[5 * 65]); w.w = pk2(s[6 * 65], s[7 * 65]);
      *(u32x4*)(dst + (size_t)(n0 + nn) * ldd + k0 + kc * 8) = w; }
    __syncthreads();
}

__device__ __forceinline__ void phase_prologue(const Params& P, LAS unsigned char* lds, int bid, int G, int wid0) {
    const int tid = opaque_tid(wid0);
    LAS float* scr = (LAS float*)lds;
    const float* w_in = P.in[5]; const float* w_uq = P.in[7]; const float* w_ukv = P.in[9]; const float* w1 = P.in[12]; const float* w_out = P.in[15];
    constexpr int T_WIN = 60 * 16, T_WOUT = 16 * 16, T_UQ = 8 * 4, T_UKV = 8 * 2, T_W1 = 1 * 32 * 2;
    constexpr int T_L = T_WIN + T_WOUT + T_UQ + T_UKV + T_W1;
    for (int it = bid; it < DEPTH * T_L; it += G) {
        const int l = it / T_L; int r = it % T_L;
        if (r < T_WIN) { tr_tile(w_in + (size_t)l * D * 3732, 3732, D, nullptr, (bf16_t*)(P.ws + WS_WIN) + (size_t)l * NP * D, D, (r / 16) * 64, (r % 16) * 64, MapWin{}, scr, wid0); continue; } r -= T_WIN;
        if (r < T_WOUT) { tr_tile(w_out + (size_t)l * D * D, D, D, nullptr, (bf16_t*)(P.ws + WS_WOUT) + (size_t)l * D * D, D, (r / 16) * 64, (r % 16) * 64, MapId{D}, scr, wid0); continue; } r -= T_WOUT;
        if (r < T_UQ) { tr_tile(w_uq + (size_t)l * 192 * 384, 384, 192, P.in[6] + l * 192, (bf16_t*)(P.ws + WS_WUQ) + (size_t)l * 512 * 256, 256, (r / 4) * 64, (r % 4) * 64, MapUq{}, scr, wid0); continue; } r -= T_UQ;
        if (r < T_UKV) { tr_tile(w_ukv + (size_t)l * 128 * 512, 512, 128, P.in[8] + l * 128, (bf16_t*)(P.ws + WS_WUKV) + (size_t)l * 512 * 128, 128, (r / 2) * 64, (r % 2) * 64, MapId{512}, scr, wid0); continue; } r -= T_UKV;
        { const int kv = r / 32, kt = r % 32; tr_tile(w1 + (size_t)(l * 2 + kv) * 2048 * 64, 64, 2048, nullptr, (bf16_t*)(P.ws + WS_W1T) + (size_t)(l * 2 + kv) * 64 * 2048, 2048, 0, kt * 64, MapId{64}, scr, wid0); }
    }
    {
        LAS float* sc = (LAS float*)lds;
        LAS float* red = (LAS float*)(lds + 16384);
        const float* c = P.in[1]; const float* w_ada = P.in[3]; const float* b_ada = P.in[4]; float* mod = (float*)(P.ws + WS_MOD);
        bool loaded = false;
        for (int it = bid; it < DEPTH * 48; it += G) {
            if (!loaded) { for (int i = tid; i < 4096; i += NTHREADS) sc[i] = silu_f(c[i]); loaded = true; __syncthreads(); }
            const int l = it / 48, cb = it % 48, col = tid & 63, ks = tid >> 6;
            const float* wp = w_ada + (size_t)l * D * 3072 + (size_t)(ks * 128) * 3072 + cb * 64 + col;
            float a0 = 0.f, a1 = 0.f, a2 = 0.f, a3 = 0.f;
#pragma unroll 8
            for (int k = 0; k < 128; ++k) { const float w = wp[(size_t)k * 3072]; const int kk = ks * 128 + k;
                a0 += sc[kk] * w; a1 += sc[1024 + kk] * w; a2 += sc[2048 + kk] * w; a3 += sc[3072 + kk] * w; }
            red[(ks * 64 + col) * 4 + 0] = a0; red[(ks * 64 + col) * 4 + 1] = a1; red[(ks * 64 + col) * 4 + 2] = a2; red[(ks * 64 + col) * 4 + 3] = a3;
            __syncthreads();
            if (tid < 256) { const int cc = tid & 63, b = tid >> 6; float s = b_ada[l * 3072 + cb * 64 + cc];
#pragma unroll
                for (int k8 = 0; k8 < 8; ++k8) s += red[(k8 * 64 + cc) * 4 + b];
                mod[(size_t)(l * 4 + b) * 3072 + cb * 64 + cc] = s; }
            __syncthreads();
        }
    }
    {
        float* tab = (float*)(P.ws + WS_ROPE);
        for (int idx = bid * NTHREADS + tid; idx < S * 16; idx += G * NTHREADS) {
            const int pos = idx >> 4, i = idx & 15;
            const double f4[4] = {1.0, 0.5623413251903491, 0.31622776601683794, 0.1778279410038923};
            double inv = (i & 3) == 0 ? f4[0] : ((i & 3) == 1 ? f4[1] : ((i & 3) == 2 ? f4[2] : f4[3]));
            inv *= ((i >> 2) == 0 ? 1.0 : ((i >> 2) == 1 ? 0.1 : ((i >> 2) == 2 ? 0.01 : 0.001)));
            const float invf = (float)inv; const float angf = (float)pos * invf;
            const double rev = (double)angf * 0.15915494309189535; const double fr = rev - __builtin_floor(rev);
            const float f = (float)fr;
            tab[(size_t)idx * 2] = __builtin_amdgcn_cosf(f); tab[(size_t)idx * 2 + 1] = __builtin_amdgcn_sinf(f);
        }
    }
    {
        const float* pos = P.in[11]; float* cvec = (float*)(P.ws + WS_CVEC);
        LAS float* red = (LAS float*)(lds + 65536);
        for (int it = bid; it < DEPTH * 2; it += G) {
            __syncthreads();
            const int col = tid & 63, ks = tid >> 6; float a = 0.f;
            const float* wp = w1 + (size_t)it * 2048 * 64 + (size_t)(ks * 256) * 64 + col; const float* pp = pos + (size_t)it * 2048 + ks * 256;
            for (int k = 0; k < 256; ++k) a += pp[k] * wp[(size_t)k * 64];
            red[ks * 64 + col] = a; __syncthreads();
            if (tid < 64) { float s = 0.f; for (int k8 = 0; k8 < 8; ++k8) s += red[k8 * 64 + tid]; cvec[it * 64 + tid] = s; }
            __syncthreads();
        }
    }
}

__device__ __forceinline__ void phase_hnorm(const float* x, const float* g, const float* mod  , bf16_t* h, int bid, int G, int wid0) {
    const int tid_ = opaque_tid(wid0); const int lane = tid_ & 63, wv = tid_ >> 6;
    for (int row = bid * 8 + wv; row < M; row += G * 8) {
        const f32x4* xr = (const f32x4*)(x + (size_t)row * D) + lane;
        f32x4 v[4]; float s = 0.f;
#pragma unroll
        for (int j = 0; j < 4; ++j) { v[j] = xr[64 * j]; s += (v[j][0] * v[j][0] + v[j][1] * v[j][1]) + (v[j][2] * v[j][2] + v[j][3] * v[j][3]); }
        const float rstd = 1.0f / sqrtf(wave_sum(s) * (1.f / D) + EPS);
        const int b = row / S; const float* sh = mod + (size_t)b * 3072; const float* scl = sh + 1024;
        unsigned long long* o8 = (unsigned long long*)(h + (size_t)row * D) + lane;
#pragma unroll
        for (int j = 0; j < 4; ++j) { const int c = (64 * j + lane) * 4; const f32x4 gg = *(const f32x4*)(g + c), ss = *(const f32x4*)(scl + c), hh = *(const f32x4*)(sh + c);
            f32x4 y;
#pragma unroll
            for (int e = 0; e < 4; ++e) y[e] = v[j][e] * rstd * gg[e] * (1.0f + ss[e]) + hh[e];
            o8[64 * j] = (unsigned long long)pk2(y[0], y[1]) | ((unsigned long long)pk2(y[2], y[3]) << 32); }
    }
}

__device__ __forceinline__ void phase_prep(const Params& P, int l, LAS unsigned char* lds, int bid, int G, int wid0) {
    const int tid = opaque_tid(wid0), lane = tid & 63, wv = tid >> 6;
    const bf16_t* proj = (const bf16_t*)(P.ws + WS_PROJ); const float* side = (const float*)(P.ws + WS_SIDE);
    {
        float* rstd = (float*)(P.ws + WS_RSTD); bf16_t* kmla = (bf16_t*)(P.ws + WS_KMLA); const float* rope = (const float*)(P.ws + WS_ROPE);
        const bool shift_ = (G == 256 && M == 32768);
        const int nk_ = shift_ ? ((bid < 128) ? 16 - PREP_SHIFT : 16 + PREP_SHIFT) : (M + G * 8 - 1) / (G * 8);
        for (int k_ = 0; k_ < nk_; ++k_) {
            const int row = (shift_ && k_ >= 16) ? (bid - 128) * 8 + wv + (16 - PREP_SHIFT + (k_ - 16)) * G * 8 : bid * 8 + wv + k_ * G * 8;
            if (row >= M) break;
            const bf16_t* pr = proj + (size_t)row * NP;
            float sq = 0.f, skv = 0.f;
            if (lane < 40) { const u32x4 w = *(const u32x4*)(pr + lane * 8); float s = 0.f;
#pragma unroll
                for (int e = 0; e < 4; ++e) { const float a = bflo(w[e]), b = bfhi(w[e]); s += a * a + b * b; }
                if (lane < 24) sq = s; else skv = s; }
            sq = wave_sum(sq); skv = wave_sum(skv);
            if (lane == 0) { rstd[(size_t)row * 2] = 1.0f / sqrtf(sq * (1.f / 192.f) + EPS); rstd[(size_t)row * 2 + 1] = 1.0f / sqrtf(skv * (1.f / 128.f) + EPS); }
            if (lane >= 48 && lane < 52) *(u32x4*)((bf16_t*)(P.ws + WS_KIDX) + (size_t)row * 32 + (lane - 48) * 8) = *(const u32x4*)(pr + C_IK + (lane - 48) * 8);
            if (lane < 16) { const float x1 = bf2f(pr[C_KROPE + lane]), x2 = bf2f(pr[C_KROPE + 16 + lane]); const int pos = row & (S - 1);
                const float cs = rope[((size_t)pos * 16 + lane) * 2], sn = rope[((size_t)pos * 16 + lane) * 2 + 1];
                const unsigned w = pk2(x1 * cs - x2 * sn, x1 * sn + x2 * cs);
#pragma unroll
                for (int hd = 0; hd < 4; ++hd) *(unsigned*)(kmla + (size_t)row * 384 + hd * 96 + 64 + 2 * lane) = w; }
        }
    }
    {
        float* fb = (float*)(P.ws + WS_FB); const float* b_f = P.in[10] + l * 4; LAS float* wtot = (LAS float*)lds;
        for (int it = (G >= 160) ? bid - (G - 16) : bid; it < 16; it += G) {
            if (it < 0) break;
            const int b = it >> 2, hd = it & 3; const float bf = b_f[hd];
            float ls[16]; float s = 0.f;
#pragma unroll
            for (int i = 0; i < 16; ++i) { const int t = tid * 16 + i; const float v = side[((size_t)b * S + t) * 32 + hd] + bf;
                const float y = fminf(v, 0.f) - log1pf(__expf(-fabsf(v))); ls[i] = y; s += y; }
            float inc = s;
#pragma unroll
            for (int o = 1; o < 64; o <<= 1) { const float t = __shfl_up(inc, o); if (lane >= o) inc += t; }
            __syncthreads();
            if (lane == 63) wtot[wv] = inc;
            __syncthreads();
            float base = 0.f;
            for (int w = 0; w < wv; ++w) base += wtot[w];
            float run = base + inc - s;
#pragma unroll
            for (int i = 0; i < 16; ++i) { run += ls[i]; fb[((size_t)it) * S + tid * 16 + i] = -8.0f * run; }
            __syncthreads();
        }
    }
    {
        const bf16_t* w1t = (const bf16_t*)(P.ws + WS_W1T) + (size_t)l * 2 * 64 * 2048; const float* cvec = (const float*)(P.ws + WS_CVEC) + l * 2 * 64;
        const float* w2 = P.in[13] + (size_t)l * 2 * 64 * 64;
        LAS float* part = (LAS float*)lds;
        LAS float* hb = (LAS float*)(lds + 65536);
        const int r = lane & 31, hi = lane >> 5;
        for (int it = bid; it < 128; it += G) {
            const int b = it >> 5, kv = (it >> 4) & 1, nt = it & 15, n0 = nt * 32;
            const int colbase = kv ? C_VCMP : C_KCMP;
            const bf16_t* w1k = w1t + (size_t)kv * 64 * 2048;
            f32x16 a0 = {}, a1 = {};
#pragma unroll
            for (int j = 0; j < 4; ++j) { const int tok = wv * 4 + j;
                const bf16_t* ap = proj + ((size_t)b * S + 16 * (n0 + r) + tok) * NP + colbase + hi * 8;
#pragma unroll
                for (int s = 0; s < 4; ++s) { const bf16x8 af = *(const bf16x8*)(ap + s * 16);
                    const int kb = tok * 64 + s * 16 + hi * 8;
                    const bf16x8 b0 = *(const bf16x8*)(w1k + (size_t)r * 2048 + kb), b1 = *(const bf16x8*)(w1k + (size_t)(32 + r) * 2048 + kb);
                    a0 = __builtin_amdgcn_mfma_f32_32x32x16_bf16(af, b0, a0, 0, 0, 0); a1 = __builtin_amdgcn_mfma_f32_32x32x16_bf16(af, b1, a1, 0, 0, 0); } }
#pragma unroll
            for (int reg = 0; reg < 16; ++reg) { const int n = crow(reg, hi); part[(wv * 32 + n) * 64 + r] = a0[reg]; part[(wv * 32 + n) * 64 + 32 + r] = a1[reg]; }
            __syncthreads();
            { const int n = tid >> 4, c4 = (tid & 15) * 4;
#pragma unroll
              for (int e = 0; e < 4; ++e) { float s = cvec[kv * 64 + c4 + e];
#pragma unroll
                  for (int w = 0; w < 8; ++w) s += part[(w * 32 + n) * 64 + c4 + e];
                  hb[n * 64 + c4 + e] = silu_f(s); } }
            __syncthreads();
            { const int n = tid >> 4, c4 = (tid & 15) * 4; float o[4] = {0.f, 0.f, 0.f, 0.f}; const float* w2k = w2 + (size_t)kv * 64 * 64;
              for (int k = 0; k < 64; ++k) { const float hv = hb[n * 64 + k]; const f32x4 wv4 = *(const f32x4*)(w2k + k * 64 + c4);
                  o[0] += hv * wv4[0]; o[1] += hv * wv4[1]; o[2] += hv * wv4[2]; o[3] += hv * wv4[3]; }
              bf16_t* dst = (bf16_t*)(P.ws + (kv ? WS_VC : WS_KC)) + ((size_t)b * 512 + n0 + n) * 64 + c4;
              const bool valid = (n0 + n) < 511;
              u32x2 w; w.x = valid ? pk2(o[0], o[1]) : 0u; w.y = valid ? pk2(o[2], o[3]) : 0u; *(u32x2*)dst = w; }
            __syncthreads();
        }
    }
}

constexpr float NEG_BIG = -1e30f;
constexpr int KSTR64 = 144, KSTR96 = 208;
constexpr int ATT_KBUF = 64 * KSTR96;
constexpr int ATT_VBUF = 8192;
constexpr int ATT_K0 = 0, ATT_V0 = 2 * ATT_KBUF, ATT_B0 = ATT_V0 + 2 * ATT_VBUF, ATT_END = ATT_B0 + 2 * 256;
constexpr int ATT_EXTRA = 45056;

struct SoftState { float m, l; f32x16 o0, o1; };

template <int KS>
__device__ __forceinline__ void qk_tile(f32x16& p0, f32x16& p1, const LAS unsigned char* kt, int kstride, const bf16x8 (&qf)[KS], int r, int hi) {
    const LAS unsigned char* k0 = kt + r * kstride + hi * 16; const LAS unsigned char* k1 = k0 + 32 * kstride;
#pragma unroll
    for (int s = 0; s < KS; ++s) { const bf16x8 a0 = *(const LAS bf16x8*)(k0 + s * 32), a1 = *(const LAS bf16x8*)(k1 + s * 32);
        p0 = __builtin_amdgcn_mfma_f32_32x32x16_bf16(a0, qf[s], p0, 0, 0, 0); p1 = __builtin_amdgcn_mfma_f32_32x32x16_bf16(a1, qf[s], p1, 0, 0, 0); }
}
__device__ __forceinline__ float max3f(float a, float b, float c);
__device__ __forceinline__ float tile_max(const f32x16& p0, const f32x16& p1) {
    float a = max3f(p0[0], p0[1], p1[0]), b = max3f(p0[2], p0[3], p1[1]); a = max3f(a, p1[2], p1[3]);
#pragma unroll
    for (int i = 4; i < 16; i += 4) { a = max3f(a, p0[i], p0[i + 1]); b = max3f(b, p0[i + 2], p0[i + 3]); a = max3f(a, p1[i], p1[i + 1]); b = max3f(b, p1[i + 2], p1[i + 3]); }
    a = max3f(a, b, b);
    const auto rr = __builtin_amdgcn_permlane32_swap(__float_as_uint(a), __float_as_uint(a), false, false);
    return fmaxf(__uint_as_float(rr[0]), __uint_as_float(rr[1]));
}
__device__ __forceinline__ bf16x8 vfrag(const LAS unsigned char* p) {
    const s16x4 lo = __builtin_bit_cast(s16x4, __builtin_amdgcn_ds_read_tr16_b64_v4i16((LAS s16x4*)p));
    const s16x4 hi = __builtin_bit_cast(s16x4, __builtin_amdgcn_ds_read_tr16_b64_v4i16((LAS s16x4*)(p + 512)));
    return (bf16x8){lo[0], lo[1], lo[2], lo[3], hi[0], hi[1], hi[2], hi[3]};
}
__device__ __forceinline__ bf16x8 pfrag(const f32x16& p, int b) {
    u32x4 w; w.x = pk2(p[b], p[b + 1]); w.y = pk2(p[b + 2], p[b + 3]); w.z = pk2(p[b + 4], p[b + 5]); w.w = pk2(p[b + 6], p[b + 7]);
    return __builtin_bit_cast(bf16x8, w);
}
__device__ __forceinline__ void pv_frag(f32x16& o0, f32x16& o1, bf16x8 pf0, bf16x8 pf1, bf16x8 pf2, bf16x8 pf3, const LAS unsigned char* vt, int vb) {
    const LAS unsigned char* v = vt + vb;
    o0 = __builtin_amdgcn_mfma_f32_32x32x16_bf16(vfrag(v), pf0, o0, 0, 0, 0);            o1 = __builtin_amdgcn_mfma_f32_32x32x16_bf16(vfrag(v + 4096), pf0, o1, 0, 0, 0);
    o0 = __builtin_amdgcn_mfma_f32_32x32x16_bf16(vfrag(v + 1024), pf1, o0, 0, 0, 0);     o1 = __builtin_amdgcn_mfma_f32_32x32x16_bf16(vfrag(v + 4096 + 1024), pf1, o1, 0, 0, 0);
    o0 = __builtin_amdgcn_mfma_f32_32x32x16_bf16(vfrag(v + 2048), pf2, o0, 0, 0, 0);     o1 = __builtin_amdgcn_mfma_f32_32x32x16_bf16(vfrag(v + 4096 + 2048), pf2, o1, 0, 0, 0);
    o0 = __builtin_amdgcn_mfma_f32_32x32x16_bf16(vfrag(v + 3072), pf3, o0, 0, 0, 0);     o1 = __builtin_amdgcn_mfma_f32_32x32x16_bf16(vfrag(v + 4096 + 3072), pf3, o1, 0, 0, 0);
}
__device__ __forceinline__ void pv_tile(f32x16& o0, f32x16& o1, const f32x16& p0, const f32x16& p1, const LAS unsigned char* vt, int vb) {
    pv_frag(o0, o1, pfrag(p0, 0), pfrag(p0, 8), pfrag(p1, 0), pfrag(p1, 8), vt, vb);
}
__device__ __forceinline__ void softmax_step(SoftState& st, f32x16& p0, f32x16& p1, float c2) {
    const float mx = tile_max(p0, p1);
    const float mn = fmaxf(st.m, mx);
    if (__any(mn > st.m)) { const float al = __builtin_amdgcn_exp2f((st.m - mn) * c2); st.l *= al; st.o0 *= al; st.o1 *= al; st.m = mn; }
    const float mc = st.m * c2; float sum = 0.f;
#pragma unroll
    for (int i = 0; i < 16; ++i) { p0[i] = __builtin_amdgcn_exp2f(__builtin_fmaf(p0[i], c2, -mc)); p1[i] = __builtin_amdgcn_exp2f(__builtin_fmaf(p1[i], c2, -mc)); sum += p0[i] + p1[i]; }
    st.l += sum;
}

__device__ __forceinline__ float max3f(float a, float b, float c) { float r; asm("v_max3_f32 %0, %1, %2, %3" : "=v"(r) : "v"(a), "v"(b), "v"(c)); return r; }
__device__ __forceinline__ float swap32_max(float a) { const auto rr = __builtin_amdgcn_permlane32_swap(__float_as_uint(a), __float_as_uint(a), false, false);
    float r; asm("v_max_f32_e32 %0, %1, %2" : "=v"(r) : "v"(__uint_as_float(rr[0])), "v"(__uint_as_float(rr[1]))); return r; }
__device__ __forceinline__ float quad_xor1(float x) { return __builtin_bit_cast(float, __builtin_amdgcn_update_dpp(0, __builtin_bit_cast(int, x), 0xB1, 0xf, 0xf, false)); }
__device__ __forceinline__ float quad_xor2(float x) { return __builtin_bit_cast(float, __builtin_amdgcn_update_dpp(0, __builtin_bit_cast(int, x), 0x4E, 0xf, 0xf, false)); }
__device__ __forceinline__ float swap32_sum(float a) { const auto rr = __builtin_amdgcn_permlane32_swap(__float_as_uint(a), __float_as_uint(a), false, false); return __uint_as_float(rr[0]) + __uint_as_float(rr[1]); }
constexpr float SM_THR = 8.0f;
__device__ __forceinline__ void softmax_pack(SoftState& st, const f32x16& p0, const f32x16& p1, float c2, bf16x8& pf0, bf16x8& pf1, bf16x8& pf2, bf16x8& pf3) {
    float a = max3f(p0[0], p0[1], p1[0]), b = max3f(p0[2], p0[3], p1[1]); a = max3f(a, p1[2], p1[3]);
#pragma unroll
    for (int i = 4; i < 16; i += 4) { a = max3f(a, p0[i], p0[i + 1]); b = max3f(b, p0[i + 2], p0[i + 3]); a = max3f(a, p1[i], p1[i + 1]); b = max3f(b, p1[i + 2], p1[i + 3]); }
    float mx; asm("v_max_f32_e32 %0, %1, %2" : "=v"(mx) : "v"(a), "v"(b));
    mx = swap32_max(mx);
    if (__any((mx - st.m) * c2 > SM_THR)) { const float mn = fmaxf(st.m, mx); const float al = __builtin_amdgcn_exp2f((st.m - mn) * c2); st.l *= al; st.o0 *= al; st.o1 *= al; st.m = mn; }
    const float mc = -st.m * c2; float s0 = 0.f, s1 = 0.f;
    u32x4 w0, w1, w2, w3;
#define SMP(W, E, P, B) do { const float e0_ = __builtin_amdgcn_exp2f(__builtin_fmaf(P[B], c2, mc)), e1_ = __builtin_amdgcn_exp2f(__builtin_fmaf(P[B + 1], c2, mc)); s0 += e0_; s1 += e1_; W[E] = pk2(e0_, e1_); } while (0)
    SMP(w0, 0, p0, 0); SMP(w0, 1, p0, 2); SMP(w0, 2, p0, 4); SMP(w0, 3, p0, 6);
    SMP(w1, 0, p0, 8); SMP(w1, 1, p0, 10); SMP(w1, 2, p0, 12); SMP(w1, 3, p0, 14);
    SMP(w2, 0, p1, 0); SMP(w2, 1, p1, 2); SMP(w2, 2, p1, 4); SMP(w2, 3, p1, 6);
    SMP(w3, 0, p1, 8); SMP(w3, 1, p1, 10); SMP(w3, 2, p1, 12); SMP(w3, 3, p1, 14);
#undef SMP
    st.l += s0 + s1;
    pf0 = __builtin_bit_cast(bf16x8, w0); pf1 = __builtin_bit_cast(bf16x8, w1); pf2 = __builtin_bit_cast(bf16x8, w2); pf3 = __builtin_bit_cast(bf16x8, w3);
}

__device__ __forceinline__ void sm_exp_pack(SoftState& st, const f32x16& p0, const f32x16& p1, float c2, bf16x8& pf0, bf16x8& pf1, bf16x8& pf2, bf16x8& pf3) {
    const float mc = -st.m * c2; float s0 = 0.f, s1 = 0.f;
    u32x4 w0, w1, w2, w3;
#define SMP(W, E, P, B) do { const float e0_ = __builtin_amdgcn_exp2f(__builtin_fmaf(P[B], c2, mc)), e1_ = __builtin_amdgcn_exp2f(__builtin_fmaf(P[B + 1], c2, mc)); s0 += e0_; s1 += e1_; W[E] = pk2(e0_, e1_); } while (0)
    SMP(w0, 0, p0, 0); SMP(w0, 1, p0, 2); SMP(w0, 2, p0, 4); SMP(w0, 3, p0, 6);
    SMP(w1, 0, p0, 8); SMP(w1, 1, p0, 10); SMP(w1, 2, p0, 12); SMP(w1, 3, p0, 14);
    SMP(w2, 0, p1, 0); SMP(w2, 1, p1, 2); SMP(w2, 2, p1, 4); SMP(w2, 3, p1, 6);
    SMP(w3, 0, p1, 8); SMP(w3, 1, p1, 10); SMP(w3, 2, p1, 12); SMP(w3, 3, p1, 14);
#undef SMP
    st.l += s0 + s1;
    pf0 = __builtin_bit_cast(bf16x8, w0); pf1 = __builtin_bit_cast(bf16x8, w1); pf2 = __builtin_bit_cast(bf16x8, w2); pf3 = __builtin_bit_cast(bf16x8, w3);
}

template <int DK> struct StageRegs { u32x4 k0, k1, v; float b; };
template <int DK>
__device__ __forceinline__ void stage_load(StageRegs<DK>& sr, const bf16_t* K, int ldk, const bf16_t* V, int ldv, const float* bias, int kv0, int wid0) {
    const int tid = opaque_tid(wid0); constexpr int CPR = DK / 8;
    { const int row = tid / CPR, cc = tid % CPR; sr.k0 = *(const u32x4*)(K + (size_t)(kv0 + row) * ldk + cc * 8); }
    if (DK == 96 && tid < 256) { const int c = tid + 512, row = c / CPR, cc = c % CPR; sr.k1 = *(const u32x4*)(K + (size_t)(kv0 + row) * ldk + cc * 8); }
    { const int row = tid >> 3, cc = tid & 7; sr.v = *(const u32x4*)(V + (size_t)(kv0 + row) * ldv + cc * 8); }
    if (bias && tid < 64) sr.b = bias[kv0 + tid];
}
template <int DK>
__device__ __forceinline__ void stage_store(const StageRegs<DK>& sr, LAS unsigned char* lds, int buf, bool has_bias, int wid0) {
    const int tid = opaque_tid(wid0); constexpr int CPR = DK / 8; constexpr int KSTR = (DK == 96) ? KSTR96 : KSTR64;
    LAS unsigned char* kb = lds + ATT_K0 + buf * ATT_KBUF; LAS unsigned char* vb = lds + ATT_V0 + buf * ATT_VBUF;
    { const int row = tid / CPR, cc = tid % CPR; *(LAS u32x4*)(kb + row * KSTR + cc * 16) = sr.k0; }
    if (DK == 96 && tid < 256) { const int c = tid + 512, row = c / CPR, cc = c % CPR; *(LAS u32x4*)(kb + row * KSTR + cc * 16) = sr.k1; }
    { const int row = tid >> 3, cc = tid & 7; *(LAS u32x4*)(vb + (cc >> 2) * 4096 + row * 64 + (cc & 3) * 16) = sr.v; }
    if (has_bias && tid < 64) *(LAS float*)(lds + ATT_B0 + buf * 256 + tid * 4) = sr.b;
}

__device__ __forceinline__ void store_out(bf16_t* dst  , const f32x16& o0, const f32x16& o1, float scale, int hi) {
#pragma unroll
    for (int g = 0; g < 4; ++g) {
        u32x2 w; w.x = pk2(o0[4 * g] * scale, o0[4 * g + 1] * scale); w.y = pk2(o0[4 * g + 2] * scale, o0[4 * g + 3] * scale);
        *(u32x2*)(dst + 8 * g + 4 * hi) = w;
        u32x2 w1; w1.x = pk2(o1[4 * g] * scale, o1[4 * g + 1] * scale); w1.y = pk2(o1[4 * g + 2] * scale, o1[4 * g + 3] * scale);
        *(u32x2*)(dst + 32 + 8 * g + 4 * hi) = w1;
    }
}

__device__ __forceinline__ float store_out_fused(bf16_t* dst, const bf16_t* zp, const float* gp, const f32x16& o0, const f32x16& o1, float scale, int hi) {
    float ssq = 0.f;
#pragma unroll
    for (int g = 0; g < 4; ++g) {
#pragma unroll
        for (int d0 = 0; d0 < 2; ++d0) { const int c = 32 * d0 + 8 * g + 4 * hi; const u32x2 zz = *(const u32x2*)(zp + c); const f32x4 gg = *(const f32x4*)(gp + c);
            const float z0 = bflo(zz.x), z1 = bfhi(zz.x), z2 = bflo(zz.y), z3 = bfhi(zz.y);
            const float v0 = (d0 ? o1[4 * g] : o0[4 * g]) * scale, v1 = (d0 ? o1[4 * g + 1] : o0[4 * g + 1]) * scale, v2 = (d0 ? o1[4 * g + 2] : o0[4 * g + 2]) * scale, v3 = (d0 ? o1[4 * g + 3] : o0[4 * g + 3]) * scale;
            ssq += (v0 * v0 + v1 * v1) + (v2 * v2 + v3 * v3);
            u32x2 w; w.x = pk2(v0 * gg[0] * silu_fast(z0), v1 * gg[1] * silu_fast(z1)); w.y = pk2(v2 * gg[2] * silu_fast(z2), v3 * gg[3] * silu_fast(z3));
            *(u32x2*)(dst + c) = w; }
    }
    return ssq;
}

constexpr int DA_K0 = 0, DA_V0 = 3 * ATT_KBUF, DA_B0 = DA_V0 + 2 * ATT_VBUF, DA_END = DA_B0 + 3 * 256;
static_assert(DA_END <= LDS_BYTES, "dense attention LDS map");
template <int DK, int MODE>
__device__ __forceinline__ void dense_unit(LAS unsigned char* lds, const bf16_t* Q, int ldq, const bf16_t* K, int ldk, const bf16_t* V, int ldv,
                                           bf16_t* O  , const float* bias, const unsigned long long* maskbits  ,
                                           float alibiA, float c2, int qb, int wid0, const bf16_t* Zg, const float* Gn, float* ssq  ) {
    constexpr int KS = DK / 16; constexpr int KSTR = (DK == 96) ? KSTR96 : KSTR64; constexpr int CPR = DK / 8;
    const int tid = opaque_tid(wid0), lane = tid & 63, wv = __builtin_amdgcn_readfirstlane(tid >> 6), r = lane & 31, hi = lane >> 5;
    const int q0 = qb * 256, qw0 = q0 + wv * 32, tq = qw0 + r;
    const int NT = (q0 + 256) / 64;
    const int tlast = (qw0 + 31) >> 6;
    bf16x8 qf[KS];
#pragma unroll
    for (int s = 0; s < KS; ++s) qf[s] = *(const bf16x8*)(Q + (size_t)tq * ldq + s * 16 + hi * 8);
    const int vb = ((lane >> 4) & 1) * 32 + (lane & 3) * 8 + (4 * hi + ((lane & 15) >> 2)) * 64;
    const int kb = r * KSTR + hi * 16;
    SoftState st; st.m = NEG_BIG; st.l = 0.f; st.o0 = (f32x16){}; st.o1 = (f32x16){};
    const int krow0 = tid / CPR, kcc0 = tid % CPR, krow1 = (tid + 512) / CPR, kcc1 = (tid + 512) % CPR, vrow = tid >> 3, vcc = tid & 7;
    const bf16_t* kp0 = K + (size_t)krow0 * ldk + kcc0 * 8; const bf16_t* kp1 = K + (size_t)krow1 * ldk + kcc1 * 8; const bf16_t* vp = V + (size_t)vrow * ldv + vcc * 8;
    const int klds0 = krow0 * KSTR + kcc0 * 16, klds1 = krow1 * KSTR + kcc1 * 16, vlds = (vcc >> 2) * 4096 + vrow * 64 + (vcc & 3) * 16;
    u32x4 rk0, rk1, rv; float rbias = 0.f;
#define DA_LOADK(t) do { rk0 = *(const u32x4*)(kp0 + (size_t)(t) * 64 * ldk); if (DK == 96 && tid < 256) rk1 = *(const u32x4*)(kp1 + (size_t)(t) * 64 * ldk); if (MODE == 1 && tid < 64) rbias = bias[(t) * 64 + tid]; } while (0)
#define DA_LOADV(t) do { rv = *(const u32x4*)(vp + (size_t)(t) * 64 * ldv); } while (0)
#define DA_STOREK(slot) do { LAS unsigned char* kb_ = lds + DA_K0 + (slot) * ATT_KBUF; *(LAS u32x4*)(kb_ + klds0) = rk0; if (DK == 96 && tid < 256) *(LAS u32x4*)(kb_ + klds1) = rk1; \
        if (MODE == 1 && tid < 64) *(LAS float*)(lds + DA_B0 + (slot) * 256 + tid * 4) = rbias; } while (0)
#define DA_STOREV(slot) do { *(LAS u32x4*)(lds + DA_V0 + (slot) * ATT_VBUF + vlds) = rv; } while (0)
#define DA_CINIT(P0, P1, t, slot) do { const int kv0_ = (t) * 64; \
        if (MODE == 0) { P0 = (f32x16){}; P1 = (f32x16){}; } \
        else if (MODE == 1) { const LAS float* bl = (const LAS float*)(lds + DA_B0 + (slot) * 256); \
            _Pragma("unroll") for (int g = 0; g < 4; ++g) { const f32x4 b0_ = *(const LAS f32x4*)(bl + 8 * g + 4 * hi), b1_ = *(const LAS f32x4*)(bl + 32 + 8 * g + 4 * hi); \
                _Pragma("unroll") for (int e = 0; e < 4; ++e) { P0[4 * g + e] = b0_[e]; P1[4 * g + e] = b1_[e]; } } } \
        else { const float base_ = alibiA * (float)(kv0_ + 4 * hi); \
            _Pragma("unroll") for (int i = 0; i < 16; ++i) { P0[i] = base_ + alibiA * (float)((i & 3) + 8 * (i >> 2)); P1[i] = P0[i] + alibiA * 32.0f; } } } while (0)
#define DA_MASK(P0, P1, t, mb) do { const int kv0_ = (t) * 64; \
        if (MODE == 2) { const unsigned long long ms_ = (mb) >> (4 * hi); const unsigned lo_ = (unsigned)ms_, hw_ = (unsigned)(ms_ >> 32); \
            _Pragma("unroll") for (int i = 0; i < 16; ++i) { const unsigned bit_ = 1u << ((i & 3) + 8 * (i >> 2)); if (!(lo_ & bit_)) P0[i] = -INFINITY; if (!(hw_ & bit_)) P1[i] = -INFINITY; } } \
        else if (kv0_ + 63 > qw0) { \
            _Pragma("unroll") for (int i = 0; i < 16; ++i) { const int kv_ = kv0_ + crow(i, hi); if (kv_ > tq) P0[i] = -INFINITY; if (kv_ + 32 > tq) P1[i] = -INFINITY; } } } while (0)
#define DA_ROWMAX(MX, P0, P1) do { float a_ = __builtin_fmaxf(__builtin_fmaxf(P0[0], P0[1]), P1[0]), b_ = __builtin_fmaxf(__builtin_fmaxf(P0[2], P0[3]), P1[1]); a_ = __builtin_fmaxf(__builtin_fmaxf(a_, P1[2]), P1[3]); \
        _Pragma("unroll") for (int i = 4; i < 16; i += 4) { a_ = __builtin_fmaxf(__builtin_fmaxf(a_, P0[i]), P0[i + 1]); b_ = __builtin_fmaxf(__builtin_fmaxf(b_, P0[i + 2]), P0[i + 3]); a_ = __builtin_fmaxf(__builtin_fmaxf(a_, P1[i]), P1[i + 1]); b_ = __builtin_fmaxf(__builtin_fmaxf(b_, P1[i + 2]), P1[i + 3]); } \
        a_ = __builtin_fmaxf(a_, b_); const auto rr_ = __builtin_amdgcn_permlane32_swap(__float_as_uint(a_), __float_as_uint(a_), false, false); \
        MX = __builtin_fmaxf(__uint_as_float(rr_[0]), __uint_as_float(rr_[1])); } while (0)
    __syncthreads();
    DA_LOADK(0); DA_LOADV(0); DA_STOREK(0); DA_STOREV(0);
    DA_LOADK(1); DA_STOREK(1);
    DA_LOADK(2); DA_LOADV(1);
    __syncthreads();
    f32x16 pa0, pa1, pb0, pb1;
    unsigned long long mb_nxt = 0ull, mb_nn = 0ull;
    {
        DA_CINIT(pa0, pa1, 0, 0);
        qk_tile<KS>(pa0, pa1, lds + DA_K0, KSTR, qf, r, hi);
        unsigned long long mb0 = 0ull;
        if (MODE == 2) { mb0 = maskbits[(size_t)tq * 128]; if (1 <= tlast) mb_nxt = maskbits[(size_t)tq * 128 + 1]; }
        DA_MASK(pa0, pa1, 0, mb0);
        float mx; DA_ROWMAX(mx, pa0, pa1);
        st.m = __builtin_fmaxf(st.m, mx);
    }
    int ks_next = 1, ks_store = 2, vs_cur = 0;
#define DA_STEP(C0, C1, N0, N1, t) do { \
        if (MODE == 2) { mb_nn = 0ull; if ((t) + 2 <= tlast) mb_nn = maskbits[(size_t)tq * 128 + (t) + 2]; } \
        if ((t) <= tlast) { \
              \
            DA_CINIT(N0, N1, (t) + 1, ks_next); \
            bf16x8 pf0, pf1, pf2, pf3; \
            bf16x8 kf[2 * KS]; { const LAS unsigned char* k_ = lds + DA_K0 + ks_next * ATT_KBUF + kb; \
                _Pragma("unroll") for (int s_ = 0; s_ < KS; ++s_) { kf[2 * s_] = *(const LAS bf16x8*)(k_ + s_ * 32); kf[2 * s_ + 1] = *(const LAS bf16x8*)(k_ + 32 * KSTR + s_ * 32); } } \
            __builtin_amdgcn_sched_barrier(0); \
            _Pragma("unroll") for (int s_ = 0; s_ < KS; ++s_) { N0 = __builtin_amdgcn_mfma_f32_32x32x16_bf16(kf[2 * s_], qf[s_], N0, 0, 0, 0); N1 = __builtin_amdgcn_mfma_f32_32x32x16_bf16(kf[2 * s_ + 1], qf[s_], N1, 0, 0, 0); } \
            sm_exp_pack(st, C0, C1, c2, pf0, pf1, pf2, pf3); \
            _Pragma("unroll") for (int g_ = 0; g_ < 2 * KS; ++g_) { __builtin_amdgcn_sched_group_barrier(0x8, 1, 0); __builtin_amdgcn_sched_group_barrier(0x2, (KS == 6 ? 9 : 14), 0); } \
            __builtin_amdgcn_sched_barrier(0); \
              \
            bf16x8 vf[8]; { const LAS unsigned char* v_ = lds + DA_V0 + vs_cur * ATT_VBUF + vb; \
                _Pragma("unroll") for (int s_ = 0; s_ < 4; ++s_) { vf[2 * s_] = vfrag(v_ + s_ * 1024); vf[2 * s_ + 1] = vfrag(v_ + 4096 + s_ * 1024); } } \
            __builtin_amdgcn_sched_barrier(0); \
            float mx_ = -INFINITY; \
            if ((t) < tlast) { DA_MASK(N0, N1, (t) + 1, mb_nxt); DA_ROWMAX(mx_, N0, N1); } \
            __builtin_amdgcn_sched_barrier(0); \
            st.o0 = __builtin_amdgcn_mfma_f32_32x32x16_bf16(vf[0], pf0, st.o0, 0, 0, 0); st.o1 = __builtin_amdgcn_mfma_f32_32x32x16_bf16(vf[1], pf0, st.o1, 0, 0, 0); \
            st.o0 = __builtin_amdgcn_mfma_f32_32x32x16_bf16(vf[2], pf1, st.o0, 0, 0, 0); st.o1 = __builtin_amdgcn_mfma_f32_32x32x16_bf16(vf[3], pf1, st.o1, 0, 0, 0); \
            st.o0 = __builtin_amdgcn_mfma_f32_32x32x16_bf16(vf[4], pf2, st.o0, 0, 0, 0); st.o1 = __builtin_amdgcn_mfma_f32_32x32x16_bf16(vf[5], pf2, st.o1, 0, 0, 0); \
            st.o0 = __builtin_amdgcn_mfma_f32_32x32x16_bf16(vf[6], pf3, st.o0, 0, 0, 0); st.o1 = __builtin_amdgcn_mfma_f32_32x32x16_bf16(vf[7], pf3, st.o1, 0, 0, 0); \
            __builtin_amdgcn_sched_barrier(0); \
            if (__any((mx_ - st.m) * c2 > SM_THR)) { const float mn_ = __builtin_fmaxf(st.m, mx_); const float al_ = __builtin_amdgcn_exp2f((st.m - mn_) * c2); st.l *= al_; st.o0 *= al_; st.o1 *= al_; st.m = mn_; } \
        } \
        if ((t) + 2 < NT) DA_STOREK(ks_store); \
        if ((t) + 1 < NT) DA_STOREV(vs_cur ^ 1); \
        if ((t) + 3 < NT) DA_LOADK((t) + 3); \
        if ((t) + 2 < NT) DA_LOADV((t) + 2); \
        __syncthreads(); \
        mb_nxt = mb_nn; vs_cur ^= 1; ks_next = (ks_next == 2) ? 0 : ks_next + 1; ks_store = (ks_store == 2) ? 0 : ks_store + 1; } while (0)
    for (int t = 0; t < NT; t += 2) {
        DA_STEP(pa0, pa1, pb0, pb1, t);
        DA_STEP(pb0, pb1, pa0, pa1, t + 1);
    }
#undef DA_LOADK
#undef DA_LOADV
#undef DA_STOREK
#undef DA_STOREV
#undef DA_CINIT
#undef DA_MASK
#undef DA_ROWMAX
#undef DA_STEP
    const float l = swap32_sum(st.l);
    const float inv = l > 0.f ? 1.0f / l : 0.f;
    const float sq = swap32_sum(store_out_fused(O + (size_t)tq * D, Zg + (size_t)tq * NP, Gn, st.o0, st.o1, inv, hi));
    if (hi == 0) ssq[(size_t)tq * 16] = sq;
}

#define A64_SBAR() __builtin_amdgcn_sched_barrier(0)
#define A64_PIN(x) asm volatile("" : "+v"(x))
#define A64_MFMA(a, b, c) __builtin_amdgcn_mfma_f32_32x32x16_bf16(a, b, c, 0, 0, 0)
constexpr int A64_VSLOT = 8192, A64_K = 0, A64_V = 3 * 12288  , A64_WS = A64_V + 3 * A64_VSLOT, A64_OST = A64_WS + 8 * 256, A64_SIDE = A64_OST + 8 * 4096, A64_END = A64_SIDE + 3 * 2048;
static_assert(A64_END <= LDS_BYTES - 16, "attn64 LDS map");
template <int N> __device__ __forceinline__ void a64_wait_bar() { asm volatile("s_waitcnt vmcnt(%0) lgkmcnt(0)\n\ts_barrier" :: "n"(N) : "memory"); }
__device__ __forceinline__ void a64_glds16(const void* g, unsigned lds_base) {
    unsigned sv; asm volatile("s_mov_b32 %0, m0\n\ts_mov_b32 m0, %2\n\ts_nop 0\n\tglobal_load_lds_dwordx4 %1, off\n\ts_mov_b32 m0, %0" : "=&s"(sv) : "v"(g), "s"(lds_base) : "memory"); }
__device__ __forceinline__ void a64_glds4(const void* g, unsigned lds_base) {
    unsigned sv; asm volatile("s_mov_b32 %0, m0\n\ts_mov_b32 m0, %2\n\ts_nop 0\n\tglobal_load_lds_dword %1, off\n\ts_mov_b32 m0, %0" : "=&s"(sv) : "v"(g), "s"(lds_base) : "memory"); }
__device__ __forceinline__ void a64_kload2(bf16x8* kf, const LAS unsigned char* kp, int d0) { kf[2 * d0] = *(const LAS bf16x8*)(kp + d0 * 2048); kf[2 * d0 + 1] = *(const LAS bf16x8*)(kp + d0 * 2048 + 512); }
__device__ __forceinline__ s16x4 a64_vtr(const LAS unsigned char* p) { return __builtin_bit_cast(s16x4, __builtin_amdgcn_ds_read_tr16_b64_v4i16((LAS s16x4*)p)); }
#define A64_MX3(a, b, c) __builtin_fmaxf(__builtin_fmaxf((a), (b)), (c))
__device__ __forceinline__ float a64_max16(const f32x16& p) {
    float a = A64_MX3(p[0], p[1], p[2]), b = A64_MX3(p[3], p[4], p[5]); a = A64_MX3(a, p[6], p[7]); b = A64_MX3(b, p[8], p[9]); a = A64_MX3(a, p[10], p[11]); b = A64_MX3(b, p[12], p[13]);
    return A64_MX3(a, b, __builtin_fmaxf(p[14], p[15])); }
__device__ __forceinline__ float a64_swapmax(float m) { const auto rr = __builtin_amdgcn_permlane32_swap(__float_as_uint(m), __float_as_uint(m), false, false); return __builtin_fmaxf(__uint_as_float(rr[0]), __uint_as_float(rr[1])); }
__device__ __forceinline__ void a64_cmask(f32x16& p0, f32x16& p1, int jb, int qrel, int hi) {
    const int kb = 64 * jb + 4 * hi;
#pragma unroll
    for (int r = 0; r < 16; ++r) { const int kv = kb + (r & 3) + 8 * (r >> 2); if (kv > qrel) p0[r] = -INFINITY; if (kv + 32 > qrel) p1[r] = -INFINITY; } }
__device__ __forceinline__ void a64_dmask(f32x16& p0, f32x16& p1, unsigned long long mw, int hi) {
    const unsigned long long ms = mw >> (4 * hi); const unsigned lo = (unsigned)ms, hw = (unsigned)(ms >> 32);
#pragma unroll
    for (int i = 0; i < 16; ++i) { const unsigned bit = 1u << ((i & 3) + 8 * (i >> 2)); if (!(lo & bit)) p0[i] = -INFINITY; if (!(hw & bit)) p1[i] = -INFINITY; } }

template <int MODE, int DK>
__device__ __forceinline__ void attn64_unit(LAS unsigned char* lds, const bf16_t* Q, int ldq, const bf16_t* K, int ld  , const bf16_t* V, int ldv,
                                            bf16_t* O  , const float* bias  , const unsigned long long* maskbits  ,
                                            float alibiA, float C2  , int qb, int wid0, const bf16_t* Zg, const float* Gn, float* ssq  ) {
    constexpr float THR = 24.0f;     constexpr int KS = DK / 16, KSLOT = (DK == 96) ? 12288 : 8192;
    constexpr int KOPS = ((MODE == 0) ? 1 : 2) + ((DK == 96) ? 1 : 0);
    const int tid = opaque_tid(wid0), lane = tid & 63, r32 = lane & 31, hi = lane >> 5; const int wid = __builtin_amdgcn_readfirstlane(tid >> 6);
    const int q0 = qb * 256, NT = (q0 + 256) / 64, qw0 = q0 + wid * 32;
    const bf16_t* Qw = Q + (size_t)qw0 * ldq;
    const unsigned lds0 = (unsigned)(size_t)lds; LAS float* wsf = (LAS float*)(lds + A64_WS) + wid * 64;
    const bf16_t* ksrc = K + (size_t)lane * ld + wid * 8;
    const bf16_t* ksrc2 = K + (size_t)lane * ld + (8 + (wid & 3)) * 8;
    const bf16_t* vsrc = V + (size_t)(16 * (wid & 3) + (lane >> 2)) * ldv + (wid >> 2) * 32 + (lane & 3) * 8;
    const unsigned* ssrc = (MODE == 1) ? (const unsigned*)(bias + lane) : (MODE == 2) ? (const unsigned*)(maskbits + (size_t)(qw0 + (lane >> 1)) * 128) + (lane & 1) : nullptr;
    constexpr int SSTEP = (MODE == 1) ? 64 : 2;
    const unsigned kdst = lds0 + A64_K + wid * 1024, kdst2 = lds0 + A64_K + (8 + (wid & 3)) * 1024, vdst = lds0 + A64_V + wid * 1024, sdst = lds0 + A64_SIDE + wid * 256;
#define A64_DMA_K(t, slot) do { a64_glds16(ksrc + (size_t)(t) * 64 * ld, (unsigned)__builtin_amdgcn_readfirstlane(kdst + (slot) * KSLOT)); \
        if (DK == 96) a64_glds16(ksrc2 + (size_t)(t) * 64 * ld, (unsigned)__builtin_amdgcn_readfirstlane(kdst2 + (slot) * KSLOT)); \
        if (MODE != 0) a64_glds4(ssrc + (size_t)(t) * SSTEP, (unsigned)__builtin_amdgcn_readfirstlane(sdst + (slot) * 2048)); } while (0)
#define A64_DMA_V(t, slot) a64_glds16(vsrc + (size_t)(t) * 64 * ldv, (unsigned)__builtin_amdgcn_readfirstlane(vdst + (slot) * A64_VSLOT))
    const LAS unsigned char* vp0 = lds + A64_V + ((lane >> 4) & 1) * 32 + (lane & 3) * 8 + (4 * hi + ((lane & 15) >> 2)) * 64;
    const LAS unsigned char* kp0 = lds + A64_K + hi * 1024 + r32 * 16;
    const LAS unsigned char* sp0 = lds + A64_SIDE + wid * 256;
    __syncthreads();
    A64_DMA_K(0, 0); A64_DMA_V(0, 0); A64_DMA_K(1, 1);
    bf16x8 qr[KS];
#pragma unroll
    for (int d0 = 0; d0 < KS; ++d0) qr[d0] = *(const bf16x8*)(Qw + (size_t)r32 * ldq + d0 * 16 + hi * 8);
    float mhat = 0.f, l_reg = 0.f; f32x16 o[2]; o[0] = (f32x16){}; o[1] = (f32x16){};
    f32x16 cini = (f32x16){};
    if (MODE == 2) {
#pragma unroll
        for (int i = 0; i < 16; ++i) cini[i] = alibiA * (float)((i & 3) + 8 * (i >> 2) + 4 * hi); }
    if (MODE != 0) A64_PIN(cini);
    const float ea = (MODE == 2) ? alibiA * C2 : 0.f;
    const int qrel = wid * 32 + r32; bool resc = false;
    f32x16 pA0, pA1, pB0, pB1; bf16x8 kf[2 * KS]; s16x4 vlo[8], vhi[8]; u32x4 pw0, pw1, pw2, pw3;
    int sl_prev = 0, sl_cur = 0, sl_next = 1;
#define A64_ROT() do { sl_prev = sl_cur; sl_cur = sl_next; sl_next = (sl_next == 2) ? 0 : sl_next + 1; } while (0)
#define A64_EX(v, NM) __builtin_amdgcn_exp2f(__builtin_fmaf((v), C2, NM))
#define A64_RESC() do { if (resc) { _Pragma("unroll") for (int d_ = 0; d_ < 2; ++d_) _Pragma("unroll") for (int r = 0; r < 16; ++r) o[d_][r] *= wsf[crow(r, hi)]; } } while (0)
#define A64_CINIT(C0, C1, slot) do { if (MODE == 1) { const LAS float* bl_ = (const LAS float*)(sp0 + (slot) * 2048); \
        _Pragma("unroll") for (int g_ = 0; g_ < 4; ++g_) { const f32x4 b0_ = *(const LAS f32x4*)(bl_ + 8 * g_ + 4 * hi), b1_ = *(const LAS f32x4*)(bl_ + 32 + 8 * g_ + 4 * hi); \
            _Pragma("unroll") for (int e_ = 0; e_ < 4; ++e_) { C0[4 * g_ + e_] = b0_[e_]; C1[4 * g_ + e_] = b1_[e_]; } } } \
        else if (MODE == 0) { C0 = (f32x16){}; C1 = (f32x16){}; }     \
        else { C0 = cini; C1 = cini; } } while (0)
#define A64_ROWREF(C0, C1, t) a64_swapmax(__builtin_fmaxf(__builtin_fmaf(a64_max16(C0), C2, ea * (float)(64 * (t))), __builtin_fmaf(a64_max16(C1), C2, ea * (float)(64 * (t) + 32))))
    A64_DMA_K(2, 2);
    a64_wait_bar<2 * KOPS + 1>();
    _Pragma("unroll") for (int d0 = 0; d0 < KS; ++d0) a64_kload2(kf, kp0, d0);
    { unsigned long long mw0 = 0ull; if (MODE == 2) mw0 = *(const LAS unsigned long long*)(sp0 + r32 * 8);
      A64_CINIT(pA0, pA1, 0);
      _Pragma("unroll") for (int d0 = 0; d0 < KS; ++d0) { pA0 = A64_MFMA(kf[2 * d0], qr[d0], pA0); pA1 = A64_MFMA(kf[2 * d0 + 1], qr[d0], pA1); }
      if (MODE == 2) a64_dmask(pA0, pA1, mw0, hi);
      if (NT == 4) a64_cmask(pA0, pA1, 0, qrel, hi); }
    { mhat = __builtin_fmaxf(A64_ROWREF(pA0, pA1, 0), -1e30f); const float nm0 = -mhat, nm1 = ea * 32.0f - mhat;
#pragma unroll
      for (int r = 0; r < 16; ++r) { pA0[r] = A64_EX(pA0[r], nm0); pA1[r] = A64_EX(pA1[r], nm1); } }
    a64_wait_bar<0>();
    A64_DMA_K(3, 0); A64_DMA_V(1, 1); A64_ROT();
    _Pragma("unroll") for (int d0 = 0; d0 < KS; ++d0) a64_kload2(kf, kp0 + sl_cur * KSLOT, d0);
    if (MODE == 1) A64_CINIT(pB0, pB1, sl_cur);
    a64_wait_bar<KOPS + 1>();
#define A64_PKW(P, i) pk2(P[i], P[i + 1])
#define A64_PAF(k) __builtin_bit_cast(bf16x8, pw##k)
#define A64_VFR(i) (bf16x8){vlo[i][0], vlo[i][1], vlo[i][2], vlo[i][3], vhi[i][0], vhi[i][1], vhi[i][2], vhi[i][3]}
#define A64_VRD(i) do { vlo[i] = a64_vtr(vp_ + (((i) >> 2) * 4096 + ((i) & 3) * 1024)); vhi[i] = a64_vtr(vp_ + (((i) >> 2) * 4096 + ((i) & 3) * 1024 + 512)); } while (0)
#define A64_BRD(G, P0, P1, g_) do { if (MODE == 1 && (G)) { const LAS float* bl_ = (const LAS float*)(sp0 + sl_next * 2048); \
        const f32x4 b0_ = *(const LAS f32x4*)(bl_ + 8 * (g_) + 4 * hi), b1_ = *(const LAS f32x4*)(bl_ + 32 + 8 * (g_) + 4 * hi); \
        _Pragma("unroll") for (int e_ = 0; e_ < 4; ++e_) { P0[4 * (g_) + e_] = b0_[e_]; P1[4 * (g_) + e_] = b1_[e_]; } } } while (0)
#define A64_KRD(G, d0) do { if (G) { a64_kload2(kf, kp0 + sl_next * KSLOT, d0); A64_SBAR(); } } while (0)
#define A64_GAPA(MF, a0, a1, a2, a3, W0, W1, PW) do { MF; sacc += a0; sacc += a1; sacc += a2; sacc += a3; W0; W1; A64_PIN(PW); A64_PIN(sacc); A64_SBAR(); } while (0)
#define A64_GAPB(MF, X, i, NM) do { MF; X[i] = A64_EX(X[i], NM); X[i + 1] = A64_EX(X[i + 1], NM); X[i + 2] = A64_EX(X[i + 2], NM); X[i + 3] = A64_EX(X[i + 3], NM); A64_PIN(X); A64_SBAR(); } while (0)
#define A64_STEP(C0, C1, P0, P1, t, MASK, GK, GV, GL) do { A64_SBAR(); \
    unsigned long long mw_ = 0ull; if (MODE == 2) { mw_ = *(const LAS unsigned long long*)(sp0 + sl_cur * 2048 + r32 * 8); } \
    if (MODE != 1) A64_CINIT(C0, C1, sl_cur);     \
    const LAS unsigned char* vp_ = vp0 + sl_prev * A64_VSLOT; \
    A64_VRD(0); A64_SBAR(); float sacc = P0[0] + P0[1]; \
                    A64_GAPA(C0 = A64_MFMA(kf[0], qr[0], C0), P0[2], P0[3], P0[4], P0[5],     pw0[0] = A64_PKW(P0, 0),  pw0[1] = A64_PKW(P0, 2),  pw0); \
    A64_VRD(4); A64_SBAR(); A64_GAPA(C1 = A64_MFMA(kf[1], qr[0], C1), P0[6], P0[7], P0[8], P0[9],     pw0[2] = A64_PKW(P0, 4),  pw0[3] = A64_PKW(P0, 6),  pw0); \
    A64_VRD(1); A64_SBAR(); A64_GAPA(C0 = A64_MFMA(kf[2], qr[1], C0),    P0[10], P0[11], P0[12], P0[13], pw1[0] = A64_PKW(P0, 8),  pw1[1] = A64_PKW(P0, 10), pw1); \
    A64_VRD(5); A64_SBAR(); A64_GAPA(C1 = A64_MFMA(kf[3], qr[1], C1),    P0[14], P0[15], P1[0], P1[1],   pw1[2] = A64_PKW(P0, 12), pw1[3] = A64_PKW(P0, 14), pw1); \
    A64_VRD(2); A64_SBAR(); A64_GAPA(C0 = A64_MFMA(kf[4], qr[2], C0),    P1[2], P1[3], P1[4], P1[5],     pw2[0] = A64_PKW(P1, 0),  pw2[1] = A64_PKW(P1, 2),  pw2); \
    A64_VRD(6); A64_SBAR(); A64_GAPA(C1 = A64_MFMA(kf[5], qr[2], C1),    P1[6], P1[7], P1[8], P1[9],     pw2[2] = A64_PKW(P1, 4),  pw2[3] = A64_PKW(P1, 6),  pw2); \
    A64_VRD(3); A64_SBAR(); A64_GAPA(C0 = A64_MFMA(kf[6], qr[3], C0),    P1[10], P1[11], P1[12], P1[13], pw3[0] = A64_PKW(P1, 8),  pw3[1] = A64_PKW(P1, 10), pw3); \
    A64_VRD(7); A64_SBAR(); A64_GAPA(C1 = A64_MFMA(kf[7], qr[3], C1),    P1[14], P1[15], 0.f, 0.f,       pw3[2] = A64_PKW(P1, 12), pw3[3] = A64_PKW(P1, 14), pw3); \
    if (KS == 6) { C0 = A64_MFMA(kf[8], qr[4], C0); C1 = A64_MFMA(kf[9], qr[4], C1); C0 = A64_MFMA(kf[10], qr[5], C0); C1 = A64_MFMA(kf[11], qr[5], C1); A64_SBAR(); } \
    l_reg += sacc; \
    if (MODE == 2) { unsigned ml_ = (unsigned)mw_, mh_ = (unsigned)(mw_ >> 32); A64_PIN(ml_); A64_PIN(mh_); mw_ = ((unsigned long long)mh_ << 32) | ml_; }     \
    if (GK) A64_DMA_K((t) + 3, sl_cur); if (GV) A64_DMA_V((t) + 1, sl_next); \
    if (MODE == 2) a64_dmask(C0, C1, mw_, hi); \
    if (MASK) a64_cmask(C0, C1, (t) - (NT - 4), qrel, hi); \
    { const float rs_ = A64_ROWREF(C0, C1, t); resc = false; \
      if (__builtin_expect(__any(rs_ - mhat > THR), 0)) { const float mn_ = __builtin_fmaxf(mhat, rs_); const float f_ = __builtin_amdgcn_exp2f(mhat - mn_); mhat = mn_; \
          l_reg *= f_; if (hi == 0) wsf[r32] = f_; resc = true; } } \
    const float nm0_ = ea * (float)(64 * (t)) - mhat, nm1_ = ea * (float)(64 * (t) + 32) - mhat; A64_SBAR(); \
    A64_GAPB(o[0] = A64_MFMA(A64_PAF(0), A64_VFR(0), o[0]), C0, 0, nm0_);              A64_GAPB(o[1] = A64_MFMA(A64_PAF(0), A64_VFR(4), o[1]), C0, 4, nm0_); \
    A64_KRD(GL, 0); A64_BRD(GL, P0, P1, 0); A64_GAPB(o[0] = A64_MFMA(A64_PAF(1), A64_VFR(1), o[0]), C0, 8, nm0_);  A64_KRD(GL, 1); A64_BRD(GL, P0, P1, 1); A64_GAPB(o[1] = A64_MFMA(A64_PAF(1), A64_VFR(5), o[1]), C0, 12, nm0_); \
    A64_KRD(GL, 2); A64_BRD(GL, P0, P1, 2); A64_GAPB(o[0] = A64_MFMA(A64_PAF(2), A64_VFR(2), o[0]), C1, 0, nm1_);  A64_KRD(GL, 3); A64_BRD(GL, P0, P1, 3); A64_GAPB(o[1] = A64_MFMA(A64_PAF(2), A64_VFR(6), o[1]), C1, 4, nm1_); \
    if (KS == 6) A64_KRD(GL, 4); A64_GAPB(o[0] = A64_MFMA(A64_PAF(3), A64_VFR(3), o[0]), C1, 8, nm1_);  if (KS == 6) A64_KRD(GL, 5); A64_GAPB(o[1] = A64_MFMA(A64_PAF(3), A64_VFR(7), o[1]), C1, 12, nm1_); \
    } while (0)
    int t = 1;
    for (; t + 5 < NT; t += 2) {
        A64_STEP(pB0, pB1, pA0, pA1, t, false, true, true, true);     a64_wait_bar<KOPS + 1>(); A64_RESC(); A64_ROT();
        A64_STEP(pA0, pA1, pB0, pB1, t + 1, false, true, true, true); a64_wait_bar<KOPS + 1>(); A64_RESC(); A64_ROT();
    }
#define A64_ENDW(tt) do { if ((tt) + 3 < NT) { a64_wait_bar<KOPS + 1>(); } else if ((tt) + 2 < NT) { a64_wait_bar<1>(); } else { a64_wait_bar<0>(); } } while (0)
    for (; t + 1 < NT; t += 2) {
        A64_STEP(pB0, pB1, pA0, pA1, t, true, (t + 3 < NT), (t + 1 < NT), (t + 1 < NT));         A64_ENDW(t);     A64_RESC(); A64_ROT();
        A64_STEP(pA0, pA1, pB0, pB1, t + 1, true, (t + 4 < NT), (t + 2 < NT), (t + 2 < NT));     A64_ENDW(t + 1); A64_RESC(); A64_ROT();
    }
    A64_STEP(pB0, pB1, pA0, pA1, NT - 1, true, false, false, false); A64_RESC();
    { float sacc = pB0[0] + pB0[1];
#pragma unroll
      for (int r = 2; r < 16; ++r) sacc += pB0[r];
#pragma unroll
      for (int r = 0; r < 16; ++r) sacc += pB1[r];
      l_reg += sacc;
      pw0 = (u32x4){A64_PKW(pB0, 0), A64_PKW(pB0, 2), A64_PKW(pB0, 4), A64_PKW(pB0, 6)}; pw1 = (u32x4){A64_PKW(pB0, 8), A64_PKW(pB0, 10), A64_PKW(pB0, 12), A64_PKW(pB0, 14)};
      pw2 = (u32x4){A64_PKW(pB1, 0), A64_PKW(pB1, 2), A64_PKW(pB1, 4), A64_PKW(pB1, 6)}; pw3 = (u32x4){A64_PKW(pB1, 8), A64_PKW(pB1, 10), A64_PKW(pB1, 12), A64_PKW(pB1, 14)};
      const LAS unsigned char* vp_ = vp0 + sl_cur * A64_VSLOT; _Pragma("unroll") for (int i = 0; i < 8; ++i) A64_VRD(i);
      o[0] = A64_MFMA(A64_PAF(0), A64_VFR(0), o[0]); o[1] = A64_MFMA(A64_PAF(0), A64_VFR(4), o[1]); o[0] = A64_MFMA(A64_PAF(1), A64_VFR(1), o[0]); o[1] = A64_MFMA(A64_PAF(1), A64_VFR(5), o[1]);
      o[0] = A64_MFMA(A64_PAF(2), A64_VFR(2), o[0]); o[1] = A64_MFMA(A64_PAF(2), A64_VFR(6), o[1]); o[0] = A64_MFMA(A64_PAF(3), A64_VFR(3), o[0]); o[1] = A64_MFMA(A64_PAF(3), A64_VFR(7), o[1]); }
    l_reg = swap32_sum(l_reg);
    if (hi == 0) wsf[32 + r32] = l_reg; asm volatile("s_waitcnt lgkmcnt(0)" ::: "memory");
    float rli[16];
#pragma unroll
    for (int r = 0; r < 16; ++r) rli[r] = __builtin_amdgcn_rcpf(wsf[32 + crow(r, hi)]);
    LAS bf16_t* stg = (LAS bf16_t*)(lds + A64_OST) + wid * 2048;
#pragma unroll
    for (int r = 0; r < 16; ++r) { const int orow = crow(r, hi);
#pragma unroll
        for (int d0 = 0; d0 < 2; ++d0) stg[orow * 64 + d0 * 32 + r32] = (bf16_t)pk2(o[d0][r] * rli[r], 0.f); }
    asm volatile("s_waitcnt lgkmcnt(0)" ::: "memory");
#pragma unroll
    for (int i = 0; i < 4; ++i) { const int row = i * 8 + (lane >> 3), ch = lane & 7; const size_t grow = (size_t)(qw0 + row);
        const u32x4 vv = *(const LAS u32x4*)(stg + row * 64 + ch * 8); const u32x4 zz = *(const u32x4*)(Zg + grow * NP + ch * 8);
        const f32x4 g0 = *(const f32x4*)(Gn + ch * 8), g1 = *(const f32x4*)(Gn + ch * 8 + 4);
        float sq = 0.f; u32x4 w;
#pragma unroll
        for (int e = 0; e < 4; ++e) { const float va = bflo(vv[e]), vb_ = bfhi(vv[e]); sq += va * va + vb_ * vb_;
            const float ga = (e < 2) ? g0[2 * e] : g1[2 * e - 4], gb = (e < 2) ? g0[2 * e + 1] : g1[2 * e - 3];
            w[e] = pk2(va * ga * silu_fast(bflo(zz[e])), vb_ * gb * silu_fast(bfhi(zz[e]))); }
        *(u32x4*)(O + grow * D + ch * 8) = w;
        sq += quad_xor1(sq); sq += quad_xor2(sq);
        sq += __builtin_bit_cast(float, __builtin_amdgcn_update_dpp(0, __builtin_bit_cast(int, sq), 0x141, 0xf, 0xf, false));
        if (ch == 0) ssq[grow * 16] = sq; }
    asm volatile("s_waitcnt lgkmcnt(0)\n\ts_barrier" ::: "memory");
#undef A64_DMA_K
#undef A64_DMA_V
#undef A64_ROT
#undef A64_EX
#undef A64_RESC
#undef A64_CINIT
#undef A64_ROWREF
#undef A64_PKW
#undef A64_PAF
#undef A64_VFR
#undef A64_VRD
#undef A64_KRD
#undef A64_BRD
#undef A64_ENDW
#undef A64_GAPA
#undef A64_GAPB
#undef A64_STEP
}

constexpr int DSA_H1 = 0, DSA_H2 = 65536, DSA_INFO = 65536 + 32768;
__device__ __forceinline__ unsigned score_key32(float s) { const unsigned u = __float_as_uint(s); return u ^ ((unsigned)((int)u >> 31) | 0x80000000u); }
__device__ __forceinline__ unsigned score_key16(float s) { return score_key32(s) >> 16; }
__device__ __forceinline__ float key32_to_float(unsigned k) { return __uint_as_float((k & 0x80000000u) ? (k ^ 0x80000000u) : ~k); }
__device__ __forceinline__ float relu_f(float x) { const int b_ = __builtin_bit_cast(int, x); return __builtin_bit_cast(float, b_ > 0 ? b_ : 0); }

struct KFrag { bf16x8 a00, a01, a10, a11; };
__device__ __forceinline__ void dsa_kload(KFrag& f, const bf16_t* kix  , int t, int r, int hi) {
    const bf16_t* p = kix + ((size_t)t * 64 + r) * 32 + hi * 8;
    f.a00 = *(const bf16x8*)p; f.a01 = *(const bf16x8*)(p + 16); f.a10 = *(const bf16x8*)(p + 1024); f.a11 = *(const bf16x8*)(p + 1024 + 16);
}
__device__ __forceinline__ void dsa_scores(f32x16& s0, f32x16& s1, const KFrag& f, const bf16x8 (&qi)[4][2], const float (&w)[4]) {
    s0 = (f32x16){}; s1 = (f32x16){};
#pragma unroll
    for (int ih = 0; ih < 4; ++ih) {
        f32x16 a = __builtin_amdgcn_mfma_f32_32x32x16_bf16(f.a00, qi[ih][0], (f32x16){}, 0, 0, 0); a = __builtin_amdgcn_mfma_f32_32x32x16_bf16(f.a01, qi[ih][1], a, 0, 0, 0);
        f32x16 c = __builtin_amdgcn_mfma_f32_32x32x16_bf16(f.a10, qi[ih][0], (f32x16){}, 0, 0, 0); c = __builtin_amdgcn_mfma_f32_32x32x16_bf16(f.a11, qi[ih][1], c, 0, 0, 0);
#pragma unroll
        for (int i = 0; i < 16; ++i) { s0[i] = __builtin_fmaf(w[ih], relu_f(a[i]), s0[i]); s1[i] = __builtin_fmaf(w[ih], relu_f(c[i]), s1[i]); }
    }
}
__device__ __forceinline__ void hist_add(LAS unsigned* hrow, int r, unsigned bin) { atomicAdd((unsigned*)(hrow + ((bin >> 1) ^ (unsigned)r)), 1u << ((bin & 1u) * 16u)); }

__device__ __forceinline__ void dsa_index_unit(LAS unsigned char* lds, const bf16_t* proj, const bf16_t* kidx, const float* side, unsigned long long* maskbits, int b, int qg, int wid0) {
    const int tid = opaque_tid(wid0), lane = tid & 63, wv = __builtin_amdgcn_readfirstlane(tid >> 6), r = lane & 31, hi = lane >> 5;
    const int tq = qg * 32 + r; const size_t rowq = (size_t)b * S + tq;
    const int nt = (qg >> 1) + 1;
    const int per = (nt + 7) >> 3; const int t_lo = wv * per, t_hi = (t_lo + per < nt) ? t_lo + per : nt;
    bf16x8 qi[4][2]; float w[4];
#pragma unroll
    for (int ih = 0; ih < 4; ++ih) { qi[ih][0] = *(const bf16x8*)(proj + rowq * NP + C_IQ + ih * 32 + hi * 8); qi[ih][1] = *(const bf16x8*)(proj + rowq * NP + C_IQ + ih * 32 + 16 + hi * 8);
        w[ih] = side[rowq * 32 + 4 + ih] * 0.5f; }
    LAS unsigned* h1 = (LAS unsigned*)(lds + DSA_H1) + r * 512; LAS unsigned* h2 = (LAS unsigned*)(lds + DSA_H2) + wv * 1024 + r * 32;
    LAS int* info = (LAS int*)(lds + DSA_INFO);
    const bf16_t* kix = kidx + (size_t)b * S * 32;
    const bool sel_all = (qg < 8);
    __syncthreads();
    if (!sel_all) {
        for (int i = tid; i < (DSA_INFO) / 16; i += NTHREADS) ((LAS u32x4*)lds)[i] = (u32x4){0u, 0u, 0u, 0u};
        __syncthreads();
        if (t_lo < t_hi) {
            KFrag cur, nxt; dsa_kload(cur, kix, t_lo, r, hi);
            for (int t = t_lo; t < t_hi; ++t) {
                if (t + 1 < t_hi) dsa_kload(nxt, kix, t + 1, r, hi);
                f32x16 s0, s1; dsa_scores(s0, s1, cur, qi, w);
                const int kv0 = t * 64;
                if (kv0 + 63 <= qg * 32) {
#pragma unroll
                    for (int i = 0; i < 16; ++i) { hist_add(h1, r, score_key32(s0[i]) >> 22); hist_add(h1, r, score_key32(s1[i]) >> 22); }
                } else {
#pragma unroll
                    for (int i = 0; i < 16; ++i) { const int kv = kv0 + crow(i, hi);
                        if (kv <= tq) hist_add(h1, r, score_key32(s0[i]) >> 22);
                        if (kv + 32 <= tq) hist_add(h1, r, score_key32(s1[i]) >> 22); }
                }
                cur = nxt;
            }
        }
        __syncthreads();
        { const int row = tid >> 4, part = tid & 15; const LAS unsigned* hr = (const LAS unsigned*)(lds + DSA_H1) + row * 512; unsigned cs = 0;
#pragma unroll 8
          for (int j = 0; j < 32; ++j) { const unsigned wd = hr[(part * 32 + j) ^ row]; cs += (wd & 0xffffu) + (wd >> 16); }
          unsigned suf = cs;
#pragma unroll
          for (int o = 1; o < 16; o <<= 1) { const unsigned t = __shfl_down(suf, o, 16); if (part + o < 16) suf += t; }
          const unsigned above = suf - cs;
          if (above < 256u && above + cs >= 256u) { unsigned acc = above; int bsel = part * 64; unsigned ab = above;
              for (int j = 31; j >= 0; --j) { const unsigned wd = hr[(part * 32 + j) ^ row]; const unsigned c1 = wd >> 16, c0 = wd & 0xffffu;
                  if (acc + c1 >= 256u) { bsel = part * 64 + 2 * j + 1; ab = acc; break; } acc += c1;
                  if (acc + c0 >= 256u) { bsel = part * 64 + 2 * j; ab = acc; break; } acc += c0; }
              info[row] = bsel; info[32 + row] = 256 - (int)ab; } }
        __syncthreads();
        const unsigned B1 = (unsigned)info[r];
        const float blo = key32_to_float(B1 << 22), bhi = (B1 >= 1023u) ? INFINITY : key32_to_float((B1 + 1u) << 22);
        if (t_lo < t_hi) {
            KFrag cur, nxt; dsa_kload(cur, kix, t_lo, r, hi);
            for (int t = t_lo; t < t_hi; ++t) {
                if (t + 1 < t_hi) dsa_kload(nxt, kix, t + 1, r, hi);
                f32x16 s0, s1; dsa_scores(s0, s1, cur, qi, w);
                const int kv0 = t * 64;
                if (kv0 + 63 <= qg * 32) {
#pragma unroll
                    for (int i = 0; i < 16; ++i) {
                        if (s0[i] >= blo && s0[i] < bhi) hist_add(h2, r, (score_key32(s0[i]) >> 16) & 63u);
                        if (s1[i] >= blo && s1[i] < bhi) hist_add(h2, r, (score_key32(s1[i]) >> 16) & 63u); }
                } else {
#pragma unroll
                    for (int i = 0; i < 16; ++i) { const int kv = kv0 + crow(i, hi);
                        if (kv <= tq && s0[i] >= blo && s0[i] < bhi) hist_add(h2, r, (score_key32(s0[i]) >> 16) & 63u);
                        if (kv + 32 <= tq && s1[i] >= blo && s1[i] < bhi) hist_add(h2, r, (score_key32(s1[i]) >> 16) & 63u); }
                }
                cur = nxt;
            }
        }
        __syncthreads();
        { const int row = tid >> 4, part = tid & 15; unsigned cnt[4]; unsigned cs = 0; const unsigned need1 = (unsigned)info[32 + row];
          LAS unsigned* h2a = (LAS unsigned*)(lds + DSA_H2);
#pragma unroll
          for (int j = 0; j < 2; ++j) { unsigned c0 = 0, c1 = 0; const int wi = row * 32 + ((part * 2 + j) ^ row);
#pragma unroll
              for (int ww = 0; ww < 8; ++ww) { const unsigned wd = h2a[ww * 1024 + wi]; c0 += wd & 0xffffu; c1 += wd >> 16; }
              cnt[2 * j] = c0; cnt[2 * j + 1] = c1; cs += c0 + c1; }
          unsigned suf = cs;
#pragma unroll
          for (int o = 1; o < 16; o <<= 1) { const unsigned t = __shfl_down(suf, o, 16); if (part + o < 16) suf += t; }
          const unsigned above = suf - cs;
          if (above < need1 && above + cs >= need1) { unsigned acc = above; int bsel = 0; unsigned ab = above; bool found = false;
#pragma unroll
              for (int j = 3; j >= 0; --j) { if (!found) { if (acc + cnt[j] >= need1) { bsel = part * 4 + j; ab = acc; found = true; } else acc += cnt[j]; } }
              info[64 + row] = (int)(((unsigned)info[row] << 6) | (unsigned)bsel); info[96 + row] = (int)(need1 - ab);
              const int wi = row * 32 + ((bsel >> 1) ^ row); unsigned run = 0;
#pragma unroll
              for (int ww = 0; ww < 8; ++ww) { info[128 + row * 8 + ww] = (int)run; const unsigned wd = h2a[ww * 1024 + wi]; run += (bsel & 1) ? (wd >> 16) : (wd & 0xffffu); } } }
        __syncthreads();
    }
    const unsigned T = sel_all ? 0u : (unsigned)info[64 + r];
    const unsigned need2 = sel_all ? 0x7fffffffu : (unsigned)info[96 + r];
    unsigned tc = sel_all ? 0u : (unsigned)info[128 + r * 8 + wv];
    const float f_lo = sel_all ? -INFINITY : key32_to_float(T << 16), f_hi = sel_all ? -INFINITY : ((T >= 0xffffu) ? INFINITY : key32_to_float((T + 1u) << 16));
    if (t_lo < t_hi) {
        KFrag cur, nxt; dsa_kload(cur, kix, t_lo, r, hi);
        for (int t = t_lo; t < t_hi; ++t) {
            if (t + 1 < t_hi) dsa_kload(nxt, kix, t + 1, r, hi);
            f32x16 s0, s1; dsa_scores(s0, s1, cur, qi, w);
            const int kv0 = t * 64; unsigned words[2];
#pragma unroll
            for (int half = 0; half < 2; ++half) {
                unsigned gt = 0, eq = 0;
                if (kv0 + 63 <= qg * 32) {
                    unsigned ge = 0;
#pragma unroll
                    for (int i = 15; i >= 0; --i) { const float sv = half ? s1[i] : s0[i];
                        asm("v_cmp_ge_f32 vcc, %1, %2\n\tv_addc_co_u32 %0, vcc, %0, %0, vcc" : "+v"(gt) : "v"(sv), "v"(f_hi) : "vcc");
                        asm("v_cmp_ge_f32 vcc, %1, %2\n\tv_addc_co_u32 %0, vcc, %0, %0, vcc" : "+v"(ge) : "v"(sv), "v"(f_lo) : "vcc"); }
                    eq = ge & ~gt;
                } else {
#pragma unroll
                    for (int i = 0; i < 16; ++i) { const int kv = kv0 + 32 * half + crow(i, hi); const unsigned k = score_key16(half ? s1[i] : s0[i]);
                        const unsigned v = (kv <= tq) ? 1u : 0u; gt |= ((k > T) ? v : 0u) << i; eq |= ((k == T) ? v : 0u) << i; }
                }
                unsigned sel = gt;
                if (__any(eq != 0u)) {
                    const unsigned a0 = __popc(eq & 0xfu), a1 = __popc(eq & 0xf0u), a2 = __popc(eq & 0xf00u), a3 = __popc(eq & 0xf000u);
                    const unsigned own = a0 | (a1 << 8) | (a2 << 16) | (a3 << 24); unsigned oth; { const auto rr_ = __builtin_amdgcn_permlane32_swap(own, own, false, false); oth = rr_[0] + rr_[1] - own; }
                    const unsigned b0 = oth & 255u, b1 = (oth >> 8) & 255u, b2 = (oth >> 16) & 255u, b3 = oth >> 24;
                    unsigned pre[4]; const unsigned hb = hi ? 1u : 0u;
                    pre[0] = tc + hb * b0; pre[1] = tc + a0 + b0 + hb * b1; pre[2] = tc + a0 + b0 + a1 + b1 + hb * b2; pre[3] = tc + a0 + b0 + a1 + b1 + a2 + b2 + hb * b3;
#pragma unroll
                    for (int g = 0; g < 4; ++g) { unsigned rk = pre[g];
#pragma unroll
                        for (int e = 0; e < 4; ++e) { const unsigned bit = 1u << (4 * g + e); if (eq & bit) { if (rk < need2) sel |= bit; ++rk; } } }
                    tc += a0 + a1 + a2 + a3 + b0 + b1 + b2 + b3;
                }
                unsigned wbits = (sel & 0xfu) | ((sel & 0xf0u) << 4) | ((sel & 0xf00u) << 8) | ((sel & 0xf000u) << 12);
                wbits <<= 4 * hi;
                { const auto rr_ = __builtin_amdgcn_permlane32_swap(wbits, wbits, false, false); wbits = rr_[0] | rr_[1]; }
                words[half] = wbits;
            }
            if (hi == 0) maskbits[(size_t)tq * 128 + t] = (unsigned long long)words[0] | ((unsigned long long)words[1] << 32);
            cur = nxt;
        }
    }
}

constexpr int NSA_IMP = ATT_EXTRA;
constexpr int NSA_SEL = NSA_IMP + 32768;
constexpr int NSA_UNI = NSA_SEL + 1024;
constexpr int NSA_LIST = NSA_UNI + 64;
constexpr int NSA_OT = NSA_LIST + 1024;
static_assert(NSA_OT + 65536 <= LDS_BYTES, "NSA LDS map");

__device__ __forceinline__ void nsa_unit(LAS unsigned char* lds, const bf16_t* proj, const float* side, const bf16_t* kc, const bf16_t* vc, bf16_t* ocat, int b, int q64, int wid0, const float* gn  , float* ssq  ) {
    const int tid = opaque_tid(wid0), lane = tid & 63, wv = __builtin_amdgcn_readfirstlane(tid >> 6), r = lane & 31, hi = lane >> 5;
    const int t0 = q64 * 64, q8 = r >> 2, hd = r & 3, tq = t0 + wv * 8 + q8; const size_t rowq = (size_t)b * S + tq;
    const float c2 = 0.125f * LOG2E;
    const float slope = (hd == 0) ? 0.25f : (hd == 1 ? 0.0625f : (hd == 2 ? 0.015625f : 0.00390625f));
    const float A = 8.0f * slope;
    bf16x8 qf[4];
#pragma unroll
    for (int s = 0; s < 4; ++s) qf[s] = *(const bf16x8*)(proj + rowq * NP + C_NQ + hd * 64 + s * 16 + hi * 8);
    const float g0 = sigmoid_f(side[rowq * 32 + 8 + hd * 3 + 0]), g1 = sigmoid_f(side[rowq * 32 + 8 + hd * 3 + 1]), g2 = sigmoid_f(side[rowq * 32 + 8 + hd * 3 + 2]);
    const int vb = ((lane >> 4) & 1) * 32 + (lane & 3) * 8 + (4 * hi + ((lane & 15) >> 2)) * 64;
    LAS float* imp = (LAS float*)(lds + NSA_IMP) + wv * 1024;
    LAS unsigned* selw = (LAS unsigned*)(lds + NSA_SEL) + wv * 32;
    LAS unsigned* uni = (LAS unsigned*)(lds + NSA_UNI);
    LAS int* list = (LAS int*)(lds + NSA_LIST);
    LAS float* otl = (LAS float*)(lds + NSA_OT) + wv * 2048 + lane;
    StageRegs<64> sr;
    __syncthreads();
    for (int i = lane; i < 1024; i += 64) imp[i] = 0.f;
    if (tid < 4) uni[tid] = 0u;
    const bf16_t* kcb = kc + (size_t)b * 512 * 64; const bf16_t* vcb = vc + (size_t)b * 512 * 64;
    const int ntc = (((t0 + 32) >> 4) >> 6) + 1;
    SoftState st; st.m = NEG_BIG; st.l = 0.f; st.o0 = (f32x16){}; st.o1 = (f32x16){};
    for (int pass = 0; pass < 2; ++pass) {
        stage_load<64>(sr, kcb, 64, vcb, 64, nullptr, 0, wid0);
        __syncthreads();
        stage_store<64>(sr, lds, 0, false, wid0);
        if (1 < ntc) stage_load<64>(sr, kcb, 64, vcb, 64, nullptr, 64, wid0);
        __syncthreads();
        float rl = 0.f;
        if (pass == 1) { const float l = st.l + __shfl_xor(st.l, 32); rl = l > 0.f ? 1.0f / l : 0.f; }
        const float mc = st.m * c2;
        for (int t = 0; t < ntc; ++t) {
            const int buf = t & 1;
            f32x16 p0, p1; const int n0 = t * 64;
            { const float base = A * (float)(16 * (n0 + 4 * hi) + 31);
#pragma unroll
              for (int i = 0; i < 16; ++i) { p0[i] = base + A * 16.0f * (float)((i & 3) + 8 * (i >> 2)); p1[i] = p0[i] + A * 512.0f; } }
            qk_tile<4>(p0, p1, lds + ATT_K0 + buf * ATT_KBUF, KSTR64, qf, r, hi);
#pragma unroll
            for (int i = 0; i < 16; ++i) { const int n = n0 + crow(i, hi); if (16 * n + 31 > tq) p0[i] = -INFINITY; if (16 * (n + 32) + 31 > tq) p1[i] = -INFINITY; }
            if (pass == 0) {
                const float mx = tile_max(p0, p1); const float mn = fmaxf(st.m, mx);
                const float al = __builtin_amdgcn_exp2f((st.m - mn) * c2); st.l *= al; st.m = mn; const float mcc = mn * c2; float sum = 0.f;
#pragma unroll
                for (int i = 0; i < 16; ++i) sum += __builtin_amdgcn_exp2f(__builtin_fmaf(p0[i], c2, -mcc)) + __builtin_amdgcn_exp2f(__builtin_fmaf(p1[i], c2, -mcc));
                st.l += sum;
            } else {
#pragma unroll
                for (int i = 0; i < 16; ++i) { p0[i] = __builtin_amdgcn_exp2f(__builtin_fmaf(p0[i], c2, -mc)) * rl; p1[i] = __builtin_amdgcn_exp2f(__builtin_fmaf(p1[i], c2, -mc)) * rl; }
#pragma unroll
                for (int half = 0; half < 2; ++half)
#pragma unroll
                    for (int g = 0; g < 4; ++g) { const f32x16& pp = half ? p1 : p0;
                        float s4 = (pp[4 * g] + pp[4 * g + 1]) + (pp[4 * g + 2] + pp[4 * g + 3]); float s3 = pp[4 * g + 3];
                        s4 += quad_xor1(s4); s4 += quad_xor2(s4); s3 += quad_xor1(s3); s3 += quad_xor2(s3);
                        const int j1 = 16 * t + 8 * half + 2 * g + hi;
                        if (hd == 0) atomicAdd((float*)(imp + q8 * 128 + j1), s4);
                        if (hd == 0 && j1 + 1 < 128) atomicAdd((float*)(imp + q8 * 128 + j1 + 1), s3); }
                pv_tile(st.o0, st.o1, p0, p1, lds + ATT_V0 + buf * ATT_VBUF, vb);
            }
            if (t + 1 < ntc) stage_store<64>(sr, lds, buf ^ 1, false, wid0);
            if (t + 2 < ntc) stage_load<64>(sr, kcb, 64, vcb, 64, nullptr, (t + 2) * 64, wid0);
            __syncthreads();
        }
    }
#pragma unroll
    for (int i = 0; i < 16; ++i) { otl[i * 64] = st.o0[i] * g0; otl[(16 + i) * 64] = st.o1[i] * g0; }
    {
        const int cur = q64;
        for (int qq = 0; qq < 8; ++qq) {
            float v0 = imp[qq * 128 + lane], v1 = imp[qq * 128 + 64 + lane];
            bool ok0 = true, ok1 = true;
            { const int j0 = lane, j1 = lane + 64;
              if (j0 == 0 || j0 == cur) v0 = INFINITY; else if (j0 > cur) ok0 = false;
              if (j1 == cur) v1 = INFINITY; else if (j1 > cur) ok1 = false; }
            const unsigned k0 = __float_as_uint(v0), k1 = __float_as_uint(v1);
            unsigned T = 0u;
            for (int bit = 30; bit >= 0; --bit) { const unsigned cand = T | (1u << bit);
                const int cnt = __popcll(__ballot(ok0 && k0 >= cand)) + __popcll(__ballot(ok1 && k1 >= cand));
                if (cnt >= 16) T = cand; }
            const unsigned long long gt0 = __ballot(ok0 && k0 > T), gt1 = __ballot(ok1 && k1 > T), eq0 = __ballot(ok0 && k0 == T), eq1 = __ballot(ok1 && k1 == T);
            const int need = 16 - (__popcll(gt0) + __popcll(gt1));
            const int r0 = (int)__builtin_amdgcn_mbcnt_hi((unsigned)(eq0 >> 32), __builtin_amdgcn_mbcnt_lo((unsigned)eq0, 0u));
            const int r1 = __popcll(eq0) + (int)__builtin_amdgcn_mbcnt_hi((unsigned)(eq1 >> 32), __builtin_amdgcn_mbcnt_lo((unsigned)eq1, 0u));
            const unsigned long long slo = __ballot(ok0 && (k0 > T || (k0 == T && r0 < need))), shi = __ballot(ok1 && (k1 > T || (k1 == T && r1 < need)));
            if (lane == 0) { selw[qq * 4 + 0] = (unsigned)slo; selw[qq * 4 + 1] = (unsigned)(slo >> 32); selw[qq * 4 + 2] = (unsigned)shi; selw[qq * 4 + 3] = (unsigned)(shi >> 32);
                atomicOr((unsigned*)(uni + 0), (unsigned)slo); atomicOr((unsigned*)(uni + 1), (unsigned)(slo >> 32)); atomicOr((unsigned*)(uni + 2), (unsigned)shi); atomicOr((unsigned*)(uni + 3), (unsigned)(shi >> 32)); }
        }
    }
    __syncthreads();
    if (tid == 0) { int n = 0; for (int wd = 0; wd < 4; ++wd) { unsigned u = uni[wd]; while (u) { const int j = __ffs(u) - 1; u &= u - 1; list[n++] = wd * 32 + j; } } list[131] = n; }
    __syncthreads();
    {
        const unsigned m0 = selw[q8 * 4 + 0], m1 = selw[q8 * 4 + 1], m2 = selw[q8 * 4 + 2], m3 = selw[q8 * 4 + 3];
        const int nl = list[131];
        const bf16_t* Ks = proj + (size_t)b * S * NP + C_KSEL; const bf16_t* Vs = proj + (size_t)b * S * NP + C_VSEL;
        st.m = NEG_BIG; st.l = 0.f; st.o0 = (f32x16){}; st.o1 = (f32x16){};
        stage_load<64>(sr, Ks, NP, Vs, NP, nullptr, list[0] * 64, wid0);
        stage_store<64>(sr, lds, 0, false, wid0);
        if (1 < nl) stage_load<64>(sr, Ks, NP, Vs, NP, nullptr, list[1] * 64, wid0);
        __syncthreads();
        for (int t = 0; t < nl; ++t) {
            const int buf = t & 1; const int j = list[t];
            const unsigned mw = (j < 32) ? m0 : (j < 64 ? m1 : (j < 96 ? m2 : m3));
            const bool mine = (mw >> (j & 31)) & 1u;
            if (__any(mine)) {
                f32x16 p0, p1; const int kv0 = j * 64;
                { const float base = A * (float)(kv0 + 4 * hi);
#pragma unroll
                  for (int i = 0; i < 16; ++i) { p0[i] = base + A * (float)((i & 3) + 8 * (i >> 2)); p1[i] = p0[i] + A * 32.0f; } }
                qk_tile<4>(p0, p1, lds + ATT_K0 + buf * ATT_KBUF, KSTR64, qf, r, hi);
#pragma unroll
                for (int i = 0; i < 16; ++i) { const int kv = kv0 + crow(i, hi); if (!mine || (j == q64 && kv > tq)) p0[i] = -INFINITY; if (!mine || (j == q64 && kv + 32 > tq)) p1[i] = -INFINITY; }
                { bf16x8 f0, f1, f2, f3; softmax_pack(st, p0, p1, c2, f0, f1, f2, f3); pv_frag(st.o0, st.o1, f0, f1, f2, f3, lds + ATT_V0 + buf * ATT_VBUF, vb); }
            }
            if (t + 1 < nl) stage_store<64>(sr, lds, buf ^ 1, false, wid0);
            if (t + 2 < nl) stage_load<64>(sr, Ks, NP, Vs, NP, nullptr, list[t + 2] * 64, wid0);
            __syncthreads();
        }
        const float l = swap32_sum(st.l); const float sc = l > 0.f ? g1 / l : 0.f;
#pragma unroll
        for (int i = 0; i < 16; ++i) { otl[i * 64] += st.o0[i] * sc; otl[(16 + i) * 64] += st.o1[i] * sc; }
    }
    {
        const bf16_t* Kw = proj + (size_t)b * S * NP + C_KWIN; const bf16_t* Vw = proj + (size_t)b * S * NP + C_VWIN;
        const int tw0 = (q64 >= 8) ? q64 - 8 : 0, ntw = q64 - tw0 + 1;
        st.m = NEG_BIG; st.l = 0.f; st.o0 = (f32x16){}; st.o1 = (f32x16){};
        stage_load<64>(sr, Kw, NP, Vw, NP, nullptr, tw0 * 64, wid0);
        stage_store<64>(sr, lds, 0, false, wid0);
        if (1 < ntw) stage_load<64>(sr, Kw, NP, Vw, NP, nullptr, tw0 * 64 + 64, wid0);
        __syncthreads();
        for (int t = 0; t < ntw; ++t) {
            const int buf = t & 1; const int kv0 = (tw0 + t) * 64;
            f32x16 p0, p1;
            { const float base = A * (float)(kv0 + 4 * hi);
#pragma unroll
              for (int i = 0; i < 16; ++i) { p0[i] = base + A * (float)((i & 3) + 8 * (i >> 2)); p1[i] = p0[i] + A * 32.0f; } }
            qk_tile<4>(p0, p1, lds + ATT_K0 + buf * ATT_KBUF, KSTR64, qf, r, hi);
            if (t == 0 || t == ntw - 1) {
#pragma unroll
                for (int i = 0; i < 16; ++i) { const int kv = kv0 + crow(i, hi); if (kv > tq || kv + 512 <= tq) p0[i] = -INFINITY; if (kv + 32 > tq || kv + 32 + 512 <= tq) p1[i] = -INFINITY; } }
            { bf16x8 f0, f1, f2, f3; softmax_pack(st, p0, p1, c2, f0, f1, f2, f3); pv_frag(st.o0, st.o1, f0, f1, f2, f3, lds + ATT_V0 + buf * ATT_VBUF, vb); }
            if (t + 1 < ntw) stage_store<64>(sr, lds, buf ^ 1, false, wid0);
            if (t + 2 < ntw) stage_load<64>(sr, Kw, NP, Vw, NP, nullptr, kv0 + 128, wid0);
            __syncthreads();
        }
        const float l = swap32_sum(st.l); const float sc = l > 0.f ? g2 / l : 0.f;
#pragma unroll
        for (int i = 0; i < 16; ++i) { st.o0[i] = otl[i * 64] + st.o0[i] * sc; st.o1[i] = otl[(16 + i) * 64] + st.o1[i] * sc; }
    }
    { const float sq = swap32_sum(store_out_fused(ocat + rowq * D + 768 + hd * 64, proj + rowq * NP + C_GZ + 768 + hd * 64, gn + 768 + hd * 64, st.o0, st.o1, 1.0f, hi));
      if (hi == 0) ssq[rowq * 16 + 12 + hd] = sq; }
}

__device__ __forceinline__ void phase_onorm(const bf16_t* ocat, const bf16_t* proj, const float* og, bf16_t* oa, int bid, int G, int wid0) {
    const int tid_ = opaque_tid(wid0); const int lane = tid_ & 63, wv = tid_ >> 6;
    for (int row = bid * 8 + wv; row < M; row += G * 8) {
        const int c = lane * 16;
        const u32x4 a0 = *(const u32x4*)(ocat + (size_t)row * D + c), a1 = *(const u32x4*)(ocat + (size_t)row * D + c + 8);
        const u32x4 z0 = *(const u32x4*)(proj + (size_t)row * NP + C_GZ + c), z1 = *(const u32x4*)(proj + (size_t)row * NP + C_GZ + c + 8);
        float v[16], z[16]; float s = 0.f;
#pragma unroll
        for (int e = 0; e < 4; ++e) { v[2 * e] = bflo(a0[e]); v[2 * e + 1] = bfhi(a0[e]); v[8 + 2 * e] = bflo(a1[e]); v[8 + 2 * e + 1] = bfhi(a1[e]);
            z[2 * e] = bflo(z0[e]); z[2 * e + 1] = bfhi(z0[e]); z[8 + 2 * e] = bflo(z1[e]); z[8 + 2 * e + 1] = bfhi(z1[e]); }
#pragma unroll
        for (int e = 0; e < 16; ++e) s += v[e] * v[e];
        s += __builtin_bit_cast(float, __builtin_amdgcn_update_dpp(0, __builtin_bit_cast(int, s), 0xB1, 0xf, 0xf, false));
        s += __builtin_bit_cast(float, __builtin_amdgcn_update_dpp(0, __builtin_bit_cast(int, s), 0x4E, 0xf, 0xf, false));
        s += __builtin_bit_cast(float, __builtin_amdgcn_update_dpp(0, __builtin_bit_cast(int, s), 0x141, 0xf, 0xf, false));
        s += __builtin_bit_cast(float, __builtin_amdgcn_update_dpp(0, __builtin_bit_cast(int, s), 0x140, 0xf, 0xf, false));
        const float rstd = 1.0f / sqrtf(s * (1.f / 256.f) + EPS);
        float y[16];
#pragma unroll
        for (int e = 0; e < 16; ++e) y[e] = v[e] * rstd * og[c + e] * silu_f(z[e]);
        u32x4 w0, w1;
#pragma unroll
        for (int e = 0; e < 4; ++e) { w0[e] = pk2(y[2 * e], y[2 * e + 1]); w1[e] = pk2(y[8 + 2 * e], y[8 + 2 * e + 1]); }
        *(u32x4*)(oa + (size_t)row * D + c) = w0; *(u32x4*)(oa + (size_t)row * D + c + 8) = w1;
    }
}
__device__ __forceinline__ void phase_final(float* out, const float* g, int bid, int G, int wid0) {
    const int tid_ = opaque_tid(wid0); const int lane = tid_ & 63, wv = tid_ >> 6;
    for (int row = bid * 8 + wv; row < M; row += G * 8) {
        f32x4* xr = (f32x4*)(out + (size_t)row * D) + lane;
        f32x4 v[4]; float s = 0.f;
#pragma unroll
        for (int j = 0; j < 4; ++j) { v[j] = xr[64 * j]; s += (v[j][0] * v[j][0] + v[j][1] * v[j][1]) + (v[j][2] * v[j][2] + v[j][3] * v[j][3]); }
        const float rstd = 1.0f / sqrtf(wave_sum(s) * (1.f / D) + EPS);
#pragma unroll
        for (int j = 0; j < 4; ++j) { const f32x4 gg = *(const f32x4*)(g + (64 * j + lane) * 4); xr[64 * j] = v[j] * rstd * gg; }
    }
}

#define XB_TMO      128
#define XB_XCNT(j)  (256  + 64 * (j))
#define XB_XSUB(j)  (1280 + 64 * (j))
#define XB_XGEN(j)  (2304 + 64 * (j))
#define XB_TOP      3328
#define XB_TOPGEN   3392
#define XCD_BAR_WORDS 3456
#define XB_SPIN_CAP (1u << 22)
__device__ __forceinline__ unsigned xb_ld(unsigned* p)              { return __hip_atomic_load(p, __ATOMIC_RELAXED, __HIP_MEMORY_SCOPE_AGENT); }
__device__ __forceinline__ unsigned xb_add(unsigned* p, unsigned v) { return __hip_atomic_fetch_add(p, v, __ATOMIC_RELAXED, __HIP_MEMORY_SCOPE_AGENT); }
__device__ __forceinline__ unsigned xb_xcc_id() { return (unsigned)__builtin_amdgcn_s_getreg((3 << 11) | 20) & 0xFu; }
#define XB_SPIN(cond, bar) do { unsigned _sp = 0; while (cond) { __builtin_amdgcn_s_sleep(1); \
    if ((++_sp & 255u) == 0u) { if (xb_ld(&(bar)[XB_TMO])) break; if (_sp > XB_SPIN_CAP) { atomicAdd(&(bar)[XB_TMO], 1u); break; } } } } while (0)
__device__ __forceinline__ void xcd_barrier_complete(unsigned* bar, unsigned x, unsigned G, unsigned& nloc, unsigned& nx) {
    unsigned sum, cnt, mine, sp = 0u;
    for (;;) {
        sum = 0u; cnt = 0u; mine = 0u;
#pragma unroll
        for (unsigned j = 0; j < 16; ++j) { const unsigned c = xb_ld(&bar[XB_XCNT(j)]); sum += c; cnt += (c > 0u) ? 1u : 0u; mine = (j == x) ? c : mine; }
        if (sum == G) break;
        __builtin_amdgcn_s_sleep(1);
        if ((++sp & 255u) == 0u) { if (xb_ld(&bar[XB_TMO])) break; if (sp > XB_SPIN_CAP) { atomicAdd(&bar[XB_TMO], 1u); break; } }
    }
    nloc = mine > 0u ? mine : 1u; nx = cnt > 0u ? cnt : 1u;
}
__device__ __forceinline__ void grid_bar(unsigned* bar, volatile LAS unsigned* st, unsigned G, int wid0) {
    const int tid = opaque_tid(wid0);
    asm volatile("s_waitcnt vmcnt(0)" ::: "memory");
    __syncthreads();
    if (tid == 0) {
        const unsigned x = xb_xcc_id();
        unsigned nloc = st[0], nx = st[1];
        if (nloc == 0u) { xcd_barrier_complete(bar, x, G, nloc, nx); st[0] = nloc; st[1] = nx; }
        const unsigned old = xb_add(&bar[XB_XSUB(x)], 1u);
        const unsigned gen = old / nloc;
        if (old + 1u == (gen + 1u) * nloc) {
            __builtin_amdgcn_fence(__ATOMIC_RELEASE, "agent");
            asm volatile("s_waitcnt vmcnt(0)" ::: "memory");
            const unsigned og = xb_add(&bar[XB_TOP], 1u);
            const unsigned tg = og / nx;
            if (og + 1u == (tg + 1u) * nx) xb_add(&bar[XB_TOPGEN], 1u);
            else XB_SPIN(xb_ld(&bar[XB_TOPGEN]) == tg, bar);
            __builtin_amdgcn_fence(__ATOMIC_ACQUIRE, "agent");
            xb_add(&bar[XB_XGEN(x)], 1u);
            asm volatile("s_waitcnt vmcnt(0)" ::: "memory");
        } else {
            XB_SPIN(xb_ld(&bar[XB_XGEN(x)]) == gen, bar);
            __builtin_amdgcn_fence(__ATOMIC_ACQUIRE, "agent");
            asm volatile("s_waitcnt vmcnt(0)" ::: "memory");
        }
    }
    __syncthreads();
}

constexpr int N_PHASES = 16;
__global__ void __launch_bounds__(NTHREADS) hymba_fwd(Params P) {
    extern __shared__ __attribute__((aligned(16))) unsigned char lds_raw[];
    LAS unsigned char* lds = (LAS unsigned char*)lds_raw;
    const int bid = blockIdx.x, G = gridDim.x;
    const int wid0 = __builtin_amdgcn_readfirstlane((int)(threadIdx.x >> 6));
    volatile LAS unsigned* xst = (volatile LAS unsigned*)(lds + LDS_BYTES - 16);
    unsigned* xbar = (unsigned*)(P.ws + WS_CTL) + 4096 + P.bar_region * XCD_BAR_WORDS;
    if (threadIdx.x == 0) { xst[0] = 0u; xst[1] = 0u; (void)xb_add(&xbar[XB_XCNT(xb_xcc_id())], 1u); }
    __syncthreads();
    unsigned char* ws = P.ws;
    bf16_t* proj = (bf16_t*)(ws + WS_PROJ); float* side = (float*)(ws + WS_SIDE);
    bf16_t* hbuf = (bf16_t*)(ws + WS_H); bf16_t* ocat = (bf16_t*)(ws + WS_OCAT);
#define PH(k) (P.ph_lo <= (k) && (k) < P.ph_hi)
#define SYNC(k) do { if (PH(k) && PH((k) + 1)) grid_bar(xbar, xst, (unsigned)G, wid0); } while (0)
    if (PH(0)) phase_prologue(P, lds, bid, G, wid0);
    if (PH(0) && PH(1)) cg::this_grid().sync();
#ifndef PREP_SHIFT
#define PREP_SHIFT 4
#endif
#ifndef ATT_REP
#define ATT_REP 0
#endif
#ifndef PROBE_VAR
#define PROBE_VAR -1
#endif
#define LAYER(l, base) do { \
    const float* mod = (const float*)(ws + WS_MOD) + (size_t)(l) * 4 * 3072; \
    const float* xin = ((l) == 0) ? P.in[0] : P.out; \
    if (PH((base) + 0)) phase_hnorm(xin, P.in[2] + (l) * D, mod, hbuf, bid, G, wid0); \
    SYNC((base) + 0); \
    if (PH((base) + 1)) { pg8::Gemm g{hbuf, (const bf16_t*)(ws + WS_WIN) + (size_t)(l) * NP * D, M, NP, D, D, D}; pg8::StaticOrder so; so.init(M, NP, G, bid); \
        pg8::EpiProj E{proj, side}; pg8::gemm_phase<pg8::EpiProj, true>(lds, g, so, E, wid0); } \
    SYNC((base) + 1); \
    if (PH((base) + 2)) phase_prep(P, (l), lds, bid, G, wid0); \
    SYNC((base) + 2); \
    if (PH((base) + 3)) { \
        { pg8::Gemm g{proj + C_QLAT, (const bf16_t*)(ws + WS_WUQ) + (size_t)(l) * 512 * 256, M, 512, 256, NP, 256}; pg8::StaticOrder so; so.init(M, 512, G, bid); \
          pg8::EpiQup E{(bf16_t*)(ws + WS_QMLA), (const float*)(ws + WS_RSTD), (const float*)(ws + WS_ROPE)}; pg8::gemm_phase<pg8::EpiQup, true>(lds, g, so, E, wid0); } \
        { pg8::Gemm g{proj + C_KVLAT, (const bf16_t*)(ws + WS_WUKV) + (size_t)(l) * 512 * 128, M, 512, 128, NP, 128}; pg8::StaticOrder so; so.init(M, 512, G, bid); \
          pg8::EpiKVup E{(bf16_t*)(ws + WS_KMLA), (bf16_t*)(ws + WS_VMLA), (const float*)(ws + WS_RSTD)}; pg8::gemm_phase<pg8::EpiKVup, true>(lds, g, so, E, wid0); } \
        for (int k = 0; k * G < 1024; ++k) { const int u = (k & 1) ? (k + 1) * G - 1 - bid : k * G + bid; if (u >= 1024 || u < 0) continue; const int qg = 255 - (u >> 2), b = u & 3; \
            dsa_index_unit(lds, proj, (const bf16_t*)(ws + WS_KIDX), side, (unsigned long long*)(ws + WS_MASK) + (size_t)b * S * 128, b, qg, wid0); } } \
    SYNC((base) + 3); \
    if (PH((base) + 4)) { const int vb_ = (G % 8 == 0) ? (bid & 7) * (G >> 3) + (bid >> 3) : bid;     \
        if (G == 256) {   \
          const int tw_ = opaque_tid(wid0); const int b_ = (bid & 7) >> 1; \
          if (tw_ < 128) { const int pg_ = (bid >> 3) * 128 + tw_;     \
              const unsigned char* a_ = (pg_ < 1536) ? ws + WS_QMLA + (size_t)b_ * S * 768 + (size_t)pg_ * 4096 : (pg_ < 3072) ? ws + WS_KMLA + (size_t)b_ * S * 768 + (size_t)(pg_ - 1536) * 4096 \
                                                      : ws + WS_VMLA + (size_t)b_ * S * 512 + (size_t)(pg_ - 3072) * 4096; \
              const unsigned v_ = *(const volatile unsigned*)a_; if (v_ == 0x12345677u) *(volatile unsigned*)(ws + WS_CTL + 8192 + 512) = v_; } } \
        for (int i = vb_; i < 512; i += G) { const int ii = i & 255, bh = ii >> 4, qb = (i < 256) ? (ii & 15) : 31 - (ii & 15), b = bh >> 2, hd = bh & 3; const size_t rb = (size_t)b * S; \
            attn64_unit<0, 96>(lds, (const bf16_t*)(ws + WS_QMLA) + rb * 384 + hd * 96, 384, (const bf16_t*)(ws + WS_KMLA) + rb * 384 + hd * 96, 384, \
                              (const bf16_t*)(ws + WS_VMLA) + rb * 256 + hd * 64, 256, ocat + rb * D + hd * 64, nullptr, nullptr, 0.f, 0.10206207261596577f * LOG2E, qb, wid0, proj + rb * NP + C_GZ + hd * 64, P.in[14] + (l) * D + hd * 64, (float*)(ws + WS_SSQ) + rb * 16 + hd); } \
        for (int rep = 0; rep < (((ATT_REP & 2) && (l) == 0) ? 2 : 1); ++rep) for (int i = vb_; i < 512; i += G) { const int ii = i & 255, bh = ii >> 4, qb = (i < 256) ? (ii & 15) : 31 - (ii & 15), b = bh >> 2, hd = bh & 3; const size_t rb = (size_t)b * S; \
            attn64_unit<1, 64>(lds, proj + rb * NP + C_FQ + hd * 64, NP, proj + rb * NP + C_FK + hd * 64, NP, proj + rb * NP + C_FV + hd * 64, NP, \
                              ocat + rb * D + 256 + hd * 64, (const float*)(ws + WS_FB) + (size_t)bh * S, nullptr, 0.f, 0.125f * LOG2E, qb, wid0, proj + rb * NP + C_GZ + 256 + hd * 64, P.in[14] + (l) * D + 256 + hd * 64, (float*)(ws + WS_SSQ) + rb * 16 + 4 + hd); } \
        for (int rep = 0; rep < (((ATT_REP & 4) && (l) == 0) ? 2 : 1); ++rep) for (int i = vb_; i < 512; i += G) { const int ii = i & 255, bh = ii >> 4, qb = (i < 256) ? (ii & 15) : 31 - (ii & 15), b = bh >> 2, hd = bh & 3; const size_t rb = (size_t)b * S; \
            const float slope = (hd == 0) ? 0.25f : (hd == 1 ? 0.0625f : (hd == 2 ? 0.015625f : 0.00390625f)); \
            attn64_unit<2, 64>(lds, proj + rb * NP + C_DQ + hd * 64, NP, proj + rb * NP + C_DK + hd * 64, NP, proj + rb * NP + C_DV + hd * 64, NP, \
                              ocat + rb * D + 512 + hd * 64, nullptr, (const unsigned long long*)(ws + WS_MASK) + rb * 128, 8.0f * slope, 0.125f * LOG2E, qb, wid0, proj + rb * NP + C_GZ + 512 + hd * 64, P.in[14] + (l) * D + 512 + hd * 64, (float*)(ws + WS_SSQ) + rb * 16 + 8 + hd); } \
        for (int rep = 0; rep < (((ATT_REP & 8) && (l) == 0) ? 2 : 1); ++rep) for (int u = vb_; u < 512; u += G) { const int b = u >> 7, q64 = (u < 256) ? (u & 127) : 127 - (u & 127);     \
            nsa_unit(lds, proj, side, (const bf16_t*)(ws + WS_KC), (const bf16_t*)(ws + WS_VC), ocat, b, q64, wid0, P.in[14] + (l) * D, (float*)(ws + WS_SSQ)); } } \
    SYNC((base) + 4); \
      \
    if (PH((base) + 6)) { pg8::Gemm g{ocat, (const bf16_t*)(ws + WS_WOUT) + (size_t)(l) * D * D, M, D, D, D, D}; pg8::StaticOrder so; so.init(M, D, G, bid); \
        pg8::EpiOut E{xin, P.out, mod + 2048, (const float*)(ws + WS_SSQ)}; pg8::gemm_phase<pg8::EpiOut, true>(lds, g, so, E, wid0); } \
    SYNC((base) + 6); \
} while (0)
    LAYER(0, 1);
    LAYER(1, 8);
    if (PH(15)) phase_final(P.out, P.in[16], bid, G, wid0);
#undef LAYER
#undef PH
#undef SYNC
}


#ifdef DBG_GROUP
#ifndef DBG_LAYER
#define DBG_LAYER 1
#endif
__device__ __forceinline__ float dbg_bf(const bf16_t* p) { return bf2f(*p); }
__device__ const int dbg_rows[48] = {0, 1, 2, 15, 30, 31, 32, 47, 63, 64, 65, 127, 128, 200, 255, 256, 257, 300, 511, 512, 513, 700, 1000, 1023, 1024, 1025, 1500, 2047, 2048, 3000, 3333, 4095, 4096, 4500, 5000, 5555, 6143, 6144, 7000, 7777, 8000, 8100, 8127, 8128, 8160, 8190, 8191, 4242};
template <class ScoreFn, class VFn>
__device__ __forceinline__ float dbg_attn(int k_lo, int k_hi, ScoreFn score, VFn vload, int lane) {
    float m = -INFINITY, l = 0.f, acc = 0.f;
    for (int kv = k_lo; kv <= k_hi; ++kv) {
        const float sc = score(kv);
        if (sc == -INFINITY) continue;
        const float mn = fmaxf(m, sc); const float al = (m == -INFINITY) ? 0.f : __expf(m - mn); const float p = __expf(sc - mn);
        l = l * al + p; acc = acc * al + p * vload(kv, lane); m = mn;
    }
    return l > 0.f ? acc / l : 0.f;
}
__global__ void __launch_bounds__(64) dbg_check(Params P) {
    const int lane = threadIdx.x, wid = blockIdx.x; const int hd = wid & 3, ri = (wid >> 2) % 48, b = (wid >> 2) / 48; const int t = dbg_rows[ri];
    unsigned char* ws = P.ws; const bf16_t* proj = (const bf16_t*)(ws + WS_PROJ); const float* side = (const float*)(ws + WS_SIDE);
    const bf16_t* ocat = (const bf16_t*)(ws + WS_OCAT); const size_t rowq = (size_t)b * S + t; const size_t rb = (size_t)b * S;
    float* scratch = (float*)(ws + WS_H) + (size_t)wid * 16384;
    float ref = 0.f; int grp = DBG_GROUP % 10;
    const float slope = (hd == 0) ? 0.25f : (hd == 1 ? 0.0625f : (hd == 2 ? 0.015625f : 0.00390625f));
    if (grp == 0) {
        const bf16_t* q = (const bf16_t*)(ws + WS_QMLA) + rowq * 384 + hd * 96; const bf16_t* K = (const bf16_t*)(ws + WS_KMLA) + rb * 384 + hd * 96; const bf16_t* V = (const bf16_t*)(ws + WS_VMLA) + rb * 256 + hd * 64;
        const float q0 = dbg_bf(q + lane), q1 = lane < 32 ? dbg_bf(q + 64 + lane) : 0.f;
        ref = dbg_attn(0, t, [&](int kv) { float pr = q0 * dbg_bf(K + (size_t)kv * 384 + lane) + (lane < 32 ? q1 * dbg_bf(K + (size_t)kv * 384 + 64 + lane) : 0.f); return wave_sum(pr) * 0.10206207261596577f; },
                       [&](int kv, int d) { return dbg_bf(V + (size_t)kv * 256 + d); }, lane);
    } else if (grp == 1) {
        const bf16_t* q = proj + rowq * NP + C_FQ + hd * 64; const bf16_t* K = proj + rb * NP + C_FK + hd * 64; const bf16_t* V = proj + rb * NP + C_FV + hd * 64; const float* fb = (const float*)(ws + WS_FB) + (size_t)(b * 4 + hd) * S;
        const float q0 = dbg_bf(q + lane); const float ft = fb[t];
        ref = dbg_attn(0, t, [&](int kv) { return wave_sum(q0 * dbg_bf(K + (size_t)kv * NP + lane)) * 0.125f + (fb[kv] - ft) * 0.125f; },
                       [&](int kv, int d) { return dbg_bf(V + (size_t)kv * NP + d); }, lane);
    } else if (grp == 2) {
        float* sc = scratch; unsigned char* selb = (unsigned char*)(scratch + 8192);
        const int ih = lane >> 4, dd = (lane & 15) * 2;
        const float qa = dbg_bf(proj + rowq * NP + C_IQ + ih * 32 + dd), qb2 = dbg_bf(proj + rowq * NP + C_IQ + ih * 32 + dd + 1); const float wgt = side[rowq * 32 + 4 + ih] * 0.5f;
        for (int kv = 0; kv <= t; ++kv) { float pr = qa * dbg_bf(proj + (rb + kv) * NP + C_IK + dd) + qb2 * dbg_bf(proj + (rb + kv) * NP + C_IK + dd + 1);
            pr += __shfl_xor(pr, 1); pr += __shfl_xor(pr, 2); pr += __shfl_xor(pr, 4); pr += __shfl_xor(pr, 8);
            float v = wgt * fmaxf(pr, 0.f); v += __shfl_xor(v, 16); v += __shfl_xor(v, 32); if (lane == 0) sc[kv] = v; }
        __threadfence_block();
        if (t + 1 <= 256) { for (int kv = lane; kv <= t; kv += 64) selb[kv] = 1; }
        else {
#ifdef DBG_KEY32
#define DBGKEY(x) ({ const unsigned u_ = __float_as_uint(x); (u_ & 0x80000000u) ? ~u_ : (u_ | 0x80000000u); })
            unsigned lo = 0, hi2 = 0xffffffffu;
#else
#define DBGKEY(x) score_key16(x)
            unsigned lo = 0, hi2 = 0xffffu;
#endif
            while (lo < hi2) { const unsigned mid = lo + ((hi2 - lo) >> 1) + ((hi2 - lo) & 1u); int c = 0; for (int kv = lane; kv <= t; kv += 64) c += (DBGKEY(sc[kv]) >= mid); c = (int)wave_sum((float)c); if (c >= 256) lo = mid; else hi2 = mid - 1; }
            const unsigned T = lo; int cgt = 0; for (int kv = lane; kv <= t; kv += 64) cgt += (DBGKEY(sc[kv]) > T); cgt = (int)wave_sum((float)cgt);
            int need = 256 - cgt; int run = 0;
            for (int k0 = 0; k0 <= t; k0 += 64) { const int kv = k0 + lane; const unsigned k = kv <= t ? DBGKEY(sc[kv]) : 0u; const bool eq = kv <= t && k == T, gt = kv <= t && k > T;
                const unsigned long long bm = __ballot(eq); const int before = __popcll(bm & ((1ull << lane) - 1ull));
                if (kv <= t) selb[kv] = (gt || (eq && run + before < need)) ? 1 : 0; run += __popcll(bm); }
        }
        __threadfence_block();
        const bf16_t* q = proj + rowq * NP + C_DQ + hd * 64; const bf16_t* K = proj + rb * NP + C_DK + hd * 64; const bf16_t* V = proj + rb * NP + C_DV + hd * 64; const float q0 = dbg_bf(q + lane);
        ref = dbg_attn(0, t, [&](int kv) { if (!selb[kv]) return -INFINITY; return wave_sum(q0 * dbg_bf(K + (size_t)kv * NP + lane)) * 0.125f - slope * (float)(t - kv); },
                       [&](int kv, int d) { return dbg_bf(V + (size_t)kv * NP + d); }, lane);
    } else {
        const int sub = DBG_GROUP / 10;
        const bf16_t* q = proj + rowq * NP + C_NQ; const float q0 = dbg_bf(q + hd * 64 + lane);
        const bf16_t* kc = (const bf16_t*)(ws + WS_KC) + (size_t)b * 512 * 64; const bf16_t* vc = (const bf16_t*)(ws + WS_VC) + (size_t)b * 512 * 64;
        float* pc = scratch;
        for (int h2 = 0; h2 < 4; ++h2) { const float qh = dbg_bf(q + h2 * 64 + lane); const float sl = (h2 == 0) ? 0.25f : (h2 == 1 ? 0.0625f : (h2 == 2 ? 0.015625f : 0.00390625f));
            float m = -INFINITY; for (int n = 0; n < 511; ++n) { if (16 * n + 31 > t) break; const float s_ = wave_sum(qh * dbg_bf(kc + n * 64 + lane)) * 0.125f - sl * (float)(t - (16 * n + 31)); if (lane == 0) pc[h2 * 512 + n] = s_; m = fmaxf(m, s_); }
            __threadfence_block(); float l = 0.f; for (int n = 0; n < 511 && 16 * n + 31 <= t; ++n) l += __expf(pc[h2 * 512 + n] - m);
            __threadfence_block(); for (int n = lane; n < 511; n += 64) pc[h2 * 512 + n] = (16 * n + 31 <= t) ? __expf(pc[h2 * 512 + n] - m) / l : 0.f; __threadfence_block(); }
        float oc = 0.f; for (int n = 0; n < 511 && 16 * n + 31 <= t; ++n) oc += pc[hd * 512 + n] * dbg_bf(vc + n * 64 + lane);
        const int cur = t >> 6; float v0, v1;
        { float i0 = 0.f, i1 = 0.f; for (int h2 = 0; h2 < 4; ++h2) for (int e = -1; e <= 3; ++e) { int n0 = 4 * lane + e, n1 = 4 * (lane + 64) + e; if (n0 >= 0 && n0 < 511) i0 += pc[h2 * 512 + n0]; if (n1 < 511) i1 += pc[h2 * 512 + n1]; }
          v0 = (lane == 0 || lane == cur) ? INFINITY : (lane > cur ? -INFINITY : i0); v1 = (lane + 64 == cur) ? INFINITY : (lane + 64 > cur ? -INFINITY : i1); }
        unsigned long long slo = 0, shi = 0;
        for (int it = 0; it < 16; ++it) { float mx = fmaxf(v0, v1); for (int o = 1; o < 64; o <<= 1) mx = fmaxf(mx, __shfl_xor(mx, o)); if (!(mx > -INFINITY)) break;
            const unsigned long long b0 = __ballot(v0 == mx), b1 = __ballot(v1 == mx);
            if (b0) { const int j = __ffsll((long long)b0) - 1; slo |= 1ull << j; if (lane == j) v0 = -INFINITY; } else { const int j = __ffsll((long long)b1) - 1; shi |= 1ull << j; if (lane == j) v1 = -INFINITY; } }
        const bf16_t* Ks = proj + rb * NP + C_KSEL; const bf16_t* Vs = proj + rb * NP + C_VSEL; const bf16_t* Kw = proj + rb * NP + C_KWIN; const bf16_t* Vw = proj + rb * NP + C_VWIN;
        const float os = dbg_attn(0, t, [&](int kv) { const int j = kv >> 6; const bool in = j < 64 ? ((slo >> j) & 1ull) : ((shi >> (j - 64)) & 1ull); if (!in) return -INFINITY;
                                      return wave_sum(q0 * dbg_bf(Ks + (size_t)kv * NP + lane)) * 0.125f - slope * (float)(t - kv); }, [&](int kv, int d) { return dbg_bf(Vs + (size_t)kv * NP + d); }, lane);
        const float ow = dbg_attn(t - 511 > 0 ? t - 511 : 0, t, [&](int kv) { return wave_sum(q0 * dbg_bf(Kw + (size_t)kv * NP + lane)) * 0.125f - slope * (float)(t - kv); }, [&](int kv, int d) { return dbg_bf(Vw + (size_t)kv * NP + d); }, lane);
        const float g0 = sigmoid_f(side[rowq * 32 + 8 + hd * 3]), g1 = sigmoid_f(side[rowq * 32 + 8 + hd * 3 + 1]), g2 = sigmoid_f(side[rowq * 32 + 8 + hd * 3 + 2]);
        ref = g0 * oc + g1 * os + g2 * ow;
        (void)sub;
    }
    const float got = dbg_bf(ocat + rowq * D + grp * 256 + hd * 64 + lane);
    const float d2 = wave_sum((got - ref) * (got - ref)), r2 = wave_sum(ref * ref);
    float* acc = (float*)(ws + WS_CTL + 8192);
    if (lane == 0) { atomicAdd(acc, d2); atomicAdd(acc + 1, r2); }
}

__device__ __forceinline__ void dbg_sincos(double ang, float& cs, float& sn) {
    const double twopi = 6.283185307179586476925; double r = ang - twopi * __builtin_floor(ang / twopi + 0.5);
    const double r2 = r * r; double sterm = r, cterm = 1.0, ssum = r, csum = 1.0;
    for (int k = 1; k <= 14; ++k) { cterm *= -r2 / (double)((2 * k - 1) * (2 * k)); sterm *= -r2 / (double)((2 * k) * (2 * k + 1)); csum += cterm; ssum += sterm; }
    cs = (float)csum; sn = (float)ssum;
}
__device__ __forceinline__ int dbg_mapwin(int n) { return MapWin{}(n); }
#define DBG_ACC(got, ref) do { const float g_ = (got), r_ = (ref); d2 += (g_ - r_) * (g_ - r_); r2 += r_ * r_; } while (0)
__global__ void __launch_bounds__(64) dbg_check2(Params P) {
    const int lane = threadIdx.x, wid = blockIdx.x; const int ri = wid % 48, b = wid / 48; const int t = dbg_rows[ri];
    unsigned char* ws = P.ws; const bf16_t* proj = (const bf16_t*)(ws + WS_PROJ); const float* side = (const float*)(ws + WS_SIDE);
    const size_t rowq = (size_t)b * S + t; const int l = DBG_LAYER;
    float d2 = 0.f, r2 = 0.f;
    const int grp = DBG_GROUP;
    if (grp == 4) {
        if (wid < 16 && lane == 0) { const int hd = wid & 3, bb = wid >> 2; double run = 0.0; const float* fb = (const float*)(ws + WS_FB) + (size_t)wid * S; const float bf = P.in[10][l * 4 + hd];
            for (int tt = 0; tt < S; ++tt) { const double v = (double)side[((size_t)bb * S + tt) * 32 + hd] + (double)bf; const double y = (v < 0 ? v : 0.0) - log1p(exp(-fabs(v))); run += y; DBG_ACC(fb[tt], (float)(-8.0 * run)); } }
    } else if (grp == 5) {
        float ss = 0.f; for (int k = lane; k < 192; k += 64) { const float v = dbg_bf(proj + rowq * NP + k); ss += v * v; } ss = wave_sum(ss); const float rs = 1.0f / sqrtf(ss / 192.f + EPS);
        const float* wq = P.in[7] + (size_t)l * 192 * 384; const float* gq = P.in[6] + l * 192; const bf16_t* qm = (const bf16_t*)(ws + WS_QMLA) + rowq * 384;
        for (int o = lane; o < 384; o += 64) { float a = 0.f; for (int k = 0; k < 192; ++k) a += dbg_bf(proj + rowq * NP + k) * rs * gq[k] * wq[(size_t)k * 384 + o]; ((float*)(ws + WS_H))[(size_t)wid * 512 + o] = a; }
        __threadfence_block();
        const float* qv = (const float*)(ws + WS_H) + (size_t)wid * 512;
        for (int hd = 0; hd < 4; ++hd) { { const int w = lane; DBG_ACC(dbg_bf(qm + hd * 96 + w), qv[hd * 96 + w]); }
            if (lane < 16) { const int i = lane; const float invf = (float)pow(10000.0, -(double)i / 16.0); float cs, sn; dbg_sincos((double)((float)t * invf), cs, sn);
                const float x1 = qv[hd * 96 + 64 + i], x2 = qv[hd * 96 + 80 + i]; DBG_ACC(dbg_bf(qm + hd * 96 + 64 + 2 * i), x1 * cs - x2 * sn); DBG_ACC(dbg_bf(qm + hd * 96 + 64 + 2 * i + 1), x1 * sn + x2 * cs); } }
    } else if (grp == 6) {
        float ss = 0.f; for (int k = lane; k < 128; k += 64) { const float v = dbg_bf(proj + rowq * NP + C_KVLAT + k); ss += v * v; } ss = wave_sum(ss); const float rs = 1.0f / sqrtf(ss / 128.f + EPS);
        const float* wk = P.in[9] + (size_t)l * 128 * 512; const float* gk = P.in[8] + l * 128; const bf16_t* km = (const bf16_t*)(ws + WS_KMLA) + rowq * 384; const bf16_t* vm = (const bf16_t*)(ws + WS_VMLA) + rowq * 256;
        for (int o = lane; o < 512; o += 64) { float a = 0.f; for (int k = 0; k < 128; ++k) a += dbg_bf(proj + rowq * NP + C_KVLAT + k) * rs * gk[k] * wk[(size_t)k * 512 + o];
            const int hd = o >> 7, w = o & 127; if (w < 64) DBG_ACC(dbg_bf(km + hd * 96 + w), a); else DBG_ACC(dbg_bf(vm + hd * 64 + w - 64), a); }
        if (lane < 16) { const int i = lane; const float invf = (float)pow(10000.0, -(double)i / 16.0); float cs, sn; dbg_sincos((double)((float)t * invf), cs, sn);
            const float x1 = dbg_bf(proj + rowq * NP + C_KROPE + i), x2 = dbg_bf(proj + rowq * NP + C_KROPE + 16 + i);
            for (int hd = 0; hd < 4; ++hd) { DBG_ACC(dbg_bf(km + hd * 96 + 64 + 2 * i), x1 * cs - x2 * sn); DBG_ACC(dbg_bf(km + hd * 96 + 64 + 2 * i + 1), x1 * sn + x2 * cs); } }
    } else if (grp == 7) {
        const int n = (t >> 4) > 510 ? 510 : (t >> 4);
        for (int kv = 0; kv < 2; ++kv) { const float* w1 = P.in[12] + (size_t)(l * 2 + kv) * 2048 * 64; const float* w2 = P.in[13] + (size_t)(l * 2 + kv) * 64 * 64; const float* pe = P.in[11] + (size_t)(l * 2 + kv) * 2048;
            float a = 0.f; for (int k = 0; k < 2048; ++k) { const int j = k >> 6, d = k & 63; a += (dbg_bf(proj + ((size_t)b * S + 16 * n + j) * NP + (kv ? C_VCMP : C_KCMP) + d) + pe[k]) * w1[(size_t)k * 64 + lane]; }
            const float hv = silu_f(a); float o = 0.f; for (int k = 0; k < 64; ++k) o += __shfl(hv, k) * w2[k * 64 + lane];
            DBG_ACC(dbg_bf((const bf16_t*)(ws + (kv ? WS_VC : WS_KC)) + ((size_t)b * 512 + n) * 64 + lane), o); }
    } else if (grp == 8) {
        const float* c = P.in[1]; const float* mod = (const float*)(ws + WS_MOD);
        for (int idx = wid * 64 + lane; idx < 2 * 4 * 3072; idx += gridDim.x * 64) { const int ll = idx / (4 * 3072), bb = (idx / 3072) & 3, n = idx % 3072; float a = P.in[4][ll * 3072 + n];
            for (int k = 0; k < 1024; ++k) a += silu_f(c[bb * 1024 + k]) * P.in[3][((size_t)ll * 1024 + k) * 3072 + n]; DBG_ACC(mod[idx], a); }
    } else if (grp == 9) {
        const float* x = P.in[0] + rowq * D; const float* mod = (const float*)(ws + WS_MOD) + (size_t)(l * 4 + b) * 3072; float* hrow = (float*)(ws + WS_H) + (size_t)wid * 1024;
        float ss = 0.f; for (int k = lane; k < D; k += 64) ss += x[k] * x[k]; ss = wave_sum(ss); const float rs = 1.0f / sqrtf(ss / D + EPS);
        for (int k = lane; k < D; k += 64) hrow[k] = x[k] * rs * P.in[2][l * D + k] * (1.0f + mod[1024 + k]) + mod[k];
        __threadfence_block();
        const float* w = P.in[5] + (size_t)l * D * 3732;
        for (int n = lane; n < 3732; n += 64) { const int oc = dbg_mapwin(n); float a = 0.f; for (int k = 0; k < D; ++k) a += hrow[k] * w[(size_t)k * 3732 + oc];
            DBG_ACC(dbg_bf(proj + rowq * NP + n), a); if (n >= C_SIDE) DBG_ACC(side[rowq * 32 + n - C_SIDE], a); }
    } else if (grp == 10) {
        const bf16_t* oc = (const bf16_t*)(ws + WS_OCAT) + rowq * D; const bf16_t* oa = (const bf16_t*)(ws + WS_H) + rowq * D;
        for (int g = 0; g < 4; ++g) { float ss = 0.f; for (int k = lane; k < 256; k += 64) { const float v = dbg_bf(oc + g * 256 + k); ss += v * v; } ss = wave_sum(ss); const float rs = 1.0f / sqrtf(ss / 256.f + EPS);
            for (int k = lane; k < 256; k += 64) { const int cc = g * 256 + k; DBG_ACC(dbg_bf(oa + cc), dbg_bf(oc + cc) * rs * P.in[14][l * D + cc] * silu_f(dbg_bf(proj + rowq * NP + C_GZ + cc))); } }
    } else if (grp == 11) {
        const bf16_t* oa = (const bf16_t*)(ws + WS_H) + rowq * D; const float* mod = (const float*)(ws + WS_MOD) + (size_t)(l * 4 + b) * 3072; const float* w = P.in[15] + (size_t)l * D * D;
        for (int n = lane; n < D; n += 64) { float a = 0.f; for (int k = 0; k < D; ++k) a += dbg_bf(oa + k) * w[(size_t)k * D + n]; DBG_ACC(P.out[rowq * D + n], P.in[0][rowq * D + n] + mod[2048 + n] * a); }
    }
    d2 = wave_sum(d2); r2 = wave_sum(r2);
    float* acc = (float*)(ws + WS_CTL + 8192);
    if (lane == 0) { atomicAdd(acc, d2); atomicAdd(acc + 1, r2); }
}
__global__ void dbg_scale(Params P) {
    const float* acc = (const float*)(P.ws + WS_CTL + 8192);
    float v = sqrtf(acc[0] / fmaxf(acc[1], 1e-30f)); v = fminf(fmaxf(v, 1e-4f), 1.0f);
    const float code = 0.1f * powf(100.0f, (log10f(v) + 4.0f) * 0.25f); const float delta = sqrtf(code);
    for (size_t i = (size_t)blockIdx.x * blockDim.x + threadIdx.x; i < (size_t)M * D; i += (size_t)gridDim.x * blockDim.x) P.out[i] *= (1.0f + delta);
}
#endif

#ifndef N_CUTS
#define N_CUTS 1
#endif
extern "C" void kernel_launch(void* const* d_in, const int* in_sizes, int n_in, void* d_out, int out_size, void* d_ws, size_t ws_size, hipStream_t stream) {
    static int grid = 0;
    if (grid == 0) {
        if (n_in != 17 || out_size != M * D || ws_size < WS_END) { fprintf(stderr, "kernel_launch: unexpected problem (n_in %d out %d ws %zu need %zu)\n", n_in, out_size, ws_size, (size_t)WS_END); grid = -1; return; }
        int dev = 0, cus = 0, per_cu = 0;
        hipGetDevice(&dev); hipDeviceGetAttribute(&cus, hipDeviceAttributeMultiprocessorCount, dev);
        hipFuncSetAttribute((const void*)hymba_fwd, hipFuncAttributeMaxDynamicSharedMemorySize, LDS_BYTES);
        hipOccupancyMaxActiveBlocksPerMultiprocessor(&per_cu, (const void*)hymba_fwd, NTHREADS, LDS_BYTES);
        if (per_cu < 1) { fprintf(stderr, "kernel_launch: occupancy query says %d blocks/CU\n", per_cu); grid = -1; return; }
        grid = cus;
    }
    if (grid < 0) return;
    (void)hipMemsetAsync((char*)d_ws + WS_CTL, 0, 131072, stream);
    Params p{};
    for (int i = 0; i < 17; ++i) p.in[i] = (const float*)d_in[i];
    p.out = (float*)d_out; p.ws = (unsigned char*)d_ws;
#if defined(DBG_GROUP)
    auto run = [&](int lo, int hi) { p.ph_lo = lo; p.ph_hi = hi; p.bar_region = (lo == 0) ? 0 : 1; void* args[] = {&p};
        hipError_t e = hipLaunchCooperativeKernel((const void*)hymba_fwd, dim3(grid), dim3(NTHREADS), args, LDS_BYTES, stream);
        if (e != hipSuccess) fprintf(stderr, "cooperative launch failed: %s (grid %d)\n", hipGetErrorString(e), grid); };
    auto check = [&]() { if (DBG_GROUP % 10 >= 4 || (DBG_GROUP >= 10 && DBG_GROUP < 13)) hipLaunchKernelGGL(dbg_check2, dim3(4 * 48), dim3(64), 0, stream, p);
                         else hipLaunchKernelGGL(dbg_check, dim3(4 * 48 * 4), dim3(64), 0, stream, p); };
    if (DBG_LAYER == 0) { run(0, 8); check(); run(8, 16); } else { run(0, 16); check(); }
    hipLaunchKernelGGL(dbg_scale, dim3(1024), dim3(256), 0, stream, p);
#elif defined(REPEAT_PHASE)
    { const int bounds[3][2] = {{0, REPEAT_PHASE + 1}, {REPEAT_PHASE, N_PHASES}, {0, 0}};
      for (int c = 0; c < 2; ++c) { p.ph_lo = bounds[c][0]; p.ph_hi = bounds[c][1]; p.bar_region = c; void* args[] = {&p};
        hipError_t e = hipLaunchCooperativeKernel((const void*)hymba_fwd, dim3(grid), dim3(NTHREADS), args, LDS_BYTES, stream);
        if (e != hipSuccess) { fprintf(stderr, "cooperative launch failed: %s (grid %d)\n", hipGetErrorString(e), grid); return; } } }
#else
    const int cuts = N_CUTS;
    for (int c = 0; c < cuts; ++c) {
        p.ph_lo = (N_PHASES * c) / cuts; p.ph_hi = (N_PHASES * (c + 1)) / cuts; p.bar_region = c;
        void* args[] = {&p};
        hipError_t e = hipLaunchCooperativeKernel((const void*)hymba_fwd, dim3(grid), dim3(NTHREADS), args, LDS_BYTES, stream);
        if (e != hipSuccess) { fprintf(stderr, "cooperative launch failed: %s (grid %d)\n", hipGetErrorString(e), grid); return; }
    }
#endif
}
```

```cpp
#define PREP_SHIFT 4
#include <hip/hip_runtime.h>
#include <hip/hip_cooperative_groups.h>
#include <cstdio>
#include <cstdint>
namespace cg = cooperative_groups;

#define LAS __attribute__((address_space(3)))
typedef unsigned short bf16_t;
typedef short bf16x8 __attribute__((ext_vector_type(8)));
typedef short s16x4 __attribute__((ext_vector_type(4)));
typedef float f32x2 __attribute__((ext_vector_type(2)));
typedef float f32x4 __attribute__((ext_vector_type(4)));
typedef float f32x16 __attribute__((ext_vector_type(16)));
typedef unsigned u32x2 __attribute__((ext_vector_type(2)));
typedef unsigned u32x4 __attribute__((ext_vector_type(4)));
typedef __bf16 bf16x2_t __attribute__((ext_vector_type(2)));

constexpr int NB = 4, S = 8192, D = 1024, M = NB * S, NP = 3840, DEPTH = 2;
constexpr int C_QLAT = 0, C_KVLAT = 192, C_KROPE = 320, C_FQ = 352, C_FK = 608, C_FV = 864, C_DQ = 1120, C_DK = 1376, C_DV = 1632,
              C_IQ = 1888, C_IK = 2016, C_NQ = 2048, C_KCMP = 2304, C_VCMP = 2368, C_KSEL = 2432, C_VSEL = 2496, C_KWIN = 2560,
              C_VWIN = 2624, C_GZ = 2688, C_SIDE = 3712;
constexpr float EPS = 1e-6f;
constexpr float LOG2E = 1.4426950408889634f;
constexpr int NTHREADS = 512;
constexpr int LDS_BYTES = 155648;

constexpr size_t MiB = 1u << 20;
constexpr size_t WS_CTL = 0;
constexpr size_t WS_WIN = 1 * MiB;
constexpr size_t WS_WOUT = 16 * MiB;
constexpr size_t WS_WUQ = 20 * MiB;
constexpr size_t WS_WUKV = 20 * MiB + 512 * 1024;
constexpr size_t WS_W1T = 21 * MiB;
constexpr size_t WS_CVEC = 22 * MiB;
constexpr size_t WS_MOD = 22 * MiB + 4096;
constexpr size_t WS_ROPE = 23 * MiB;
constexpr size_t WS_RSTD = 24 * MiB;
constexpr size_t WS_FB = 24 * MiB + 512 * 1024;
constexpr size_t WS_KC = 25 * MiB;
constexpr size_t WS_VC = 25 * MiB + 512 * 1024;
constexpr size_t WS_SIDE = 26 * MiB;
constexpr size_t WS_H = 30 * MiB;
constexpr size_t WS_QMLA = 94 * MiB;
constexpr size_t WS_KMLA = 118 * MiB;
constexpr size_t WS_VMLA = 142 * MiB;
constexpr size_t WS_MASK = 158 * MiB;
constexpr size_t WS_OCAT = 190 * MiB;
constexpr size_t WS_PROJ = 254 * MiB;
constexpr size_t WS_KIDX = ((WS_PROJ + (size_t)(M + 64) * NP * 2 + MiB - 1) / MiB) * MiB;
constexpr size_t WS_SSQ = WS_KIDX + 2 * MiB;
constexpr size_t WS_END = WS_SSQ + 2 * MiB;

struct Params {
    const float* in[17];
    float* out;
    unsigned char* ws;
    int ph_lo, ph_hi, bar_region, pad;
};

__device__ __forceinline__ unsigned pk2(float lo, float hi) { f32x2 v = {lo, hi}; bf16x2_t b = __builtin_convertvector(v, bf16x2_t); return __builtin_bit_cast(unsigned, b); }
__device__ __forceinline__ float bf2f(unsigned short b) { return __uint_as_float(((unsigned)b) << 16); }
__device__ __forceinline__ float bflo(unsigned u) { return __uint_as_float(u << 16); }
__device__ __forceinline__ float bfhi(unsigned u) { return __uint_as_float(u & 0xffff0000u); }
__device__ __forceinline__ float wave_sum(float v) {
    v += __builtin_bit_cast(float, __builtin_amdgcn_update_dpp(0, __builtin_bit_cast(int, v), 0xB1, 0xf, 0xf, false));
    v += __builtin_bit_cast(float, __builtin_amdgcn_update_dpp(0, __builtin_bit_cast(int, v), 0x4E, 0xf, 0xf, false));
    v += __builtin_bit_cast(float, __builtin_amdgcn_update_dpp(0, __builtin_bit_cast(int, v), 0x141, 0xf, 0xf, false));
    v += __builtin_bit_cast(float, __builtin_amdgcn_update_dpp(0, __builtin_bit_cast(int, v), 0x140, 0xf, 0xf, false));
    const float r0 = __builtin_bit_cast(float, __builtin_amdgcn_readlane(__builtin_bit_cast(int, v), 0)), r1 = __builtin_bit_cast(float, __builtin_amdgcn_readlane(__builtin_bit_cast(int, v), 16));
    const float r2 = __builtin_bit_cast(float, __builtin_amdgcn_readlane(__builtin_bit_cast(int, v), 32)), r3 = __builtin_bit_cast(float, __builtin_amdgcn_readlane(__builtin_bit_cast(int, v), 48));
    return (r0 + r1) + (r2 + r3);
}
__device__ __forceinline__ float silu_f(float x) { return x / (1.0f + __expf(-x)); }
__device__ __forceinline__ float sigmoid_f(float x) { return 1.0f / (1.0f + __expf(-x)); }
__device__ __forceinline__ float silu_fast(float x) { return x * __builtin_amdgcn_rcpf(1.0f + __expf(-x)); }
__device__ __forceinline__ int crow(int r, int hi) { return (r & 3) + 8 * (r >> 2) + 4 * hi; }
__device__ __forceinline__ int opaque_tid(int wid0) { int t; asm volatile("v_mbcnt_lo_u32_b32 %0, -1, 0\n\tv_mbcnt_hi_u32_b32 %0, -1, %0\n\tv_lshl_add_u32 %0, %1, 6, %0" : "=&v"(t) : "s"(wid0)); return t; }

namespace pg8 {
constexpr int BM = 256, BK = 64, HALF = 128, HTB = HALF * BK * 2, STAGE_BYTES = 8 * HTB, NXCD = 8, WGM = 8;
__host__ __device__ __forceinline__ int lds_byte(int r, int c) { const int st = (r >> 4) * 2 + (c >> 5), rr = r & 15, cc = c & 31, ob = rr * 64 + cc * 2; return st * 1024 + (ob ^ (((ob >> 9) & 1) << 5)); }
__host__ __device__ __forceinline__ void stage_rc(int b, int& R, int& C) { const int st = b / 1024, sb = b % 1024, swz = sb ^ (((sb >> 9) & 1) << 5); R = (st >> 1) * 16 + swz / 64; C = (st & 1) * 32 + (swz % 64) / 2; }
__host__ __device__ __forceinline__ int perm32(int rho) { const int n = rho >> 4, i = rho & 15; return 8 * (i >> 2) + 4 * n + (i & 3); }
struct Unit { int pm, pn; };
struct Gemm { const bf16_t* A; const bf16_t* Bt; int M, N, K, lda, ldb; };
struct StaticOrder {
    int nM, nN, nwg, G, c;
    __device__ void init(int M_, int N_, int G_, int c_) { nM = M_ / BM; nN = N_ / BM; nwg = nM * nN; G = G_; c = c_; }
    __device__ bool next(int i, Unit& u) const {
        const long L = (long)i * G + c; if (L >= nwg) return false;
        int wgid = (int)L; { const int q = nwg / NXCD, r = nwg % NXCD, xcd = wgid % NXCD, off = wgid / NXCD; wgid = (xcd < r ? xcd * (q + 1) : r * (q + 1) + (xcd - r) * q) + off; }
        const int nig = WGM * nN, gid = wgid / nig, fm = gid * WGM, gsz = (nM - fm) < WGM ? (nM - fm) : WGM;
        u.pm = fm + ((wgid % nig) % gsz); u.pn = (wgid % nig) / gsz; return true;
    }
};

template <class Epi, bool ALIGN_EPI>
__device__ __forceinline__ void gemm_phase(LAS unsigned char* lds, const Gemm g, const StaticOrder& S_, const Epi& E, int wid0) {
    const int tid = opaque_tid(wid0), wid = __builtin_amdgcn_readfirstlane(tid >> 6), lane = tid & 63, wr = wid >> 2, wc = wid & 3, fr = lane & 15, fq = lane >> 4;
    const int K = g.K, nt = K / BK;
    unsigned voffA[2], voffB[2];
#pragma unroll
    for (int i = 0; i < 2; ++i) { int R, C; stage_rc(tid * 16 + i * 8192, R, C); const int Rb = ((R & ~31) + perm32(R & 31));
        voffA[i] = (unsigned)(R * g.lda + C) * 2u; voffB[i] = (unsigned)(Rb * g.ldb + C) * 2u; }
    const size_t kstep = (size_t)(BK * 2);
    const size_t hstepA = (size_t)HALF * g.lda * 2, hstepB = (size_t)HALF * g.ldb * 2;
    const size_t tstepA = 2 * hstepA, tstepB = 2 * hstepB;
    const unsigned ldsw = (unsigned)wid * 1024u;
    const int aoff = lds_byte(wr * 64 + fr, fq * 8), boff = lds_byte(wc * 32 + fr, fq * 8);
#define PG8_SA(b, h) (((b) * 2 + (h)) * HTB)
#define PG8_SB(b, h) ((4 + (b) * 2 + (h)) * HTB)
#define PG8_STAGE(bufoff, gbase, voff) do { _Pragma("unroll") for (int _i = 0; _i < 2; ++_i) \
        __builtin_amdgcn_global_load_lds((const unsigned*)((const char*)(gbase) + (voff)[_i]), (LAS unsigned*)(lds + (bufoff) + ldsw + _i * 8192), 16, 0, 0); } while (0)
#define PG8_LDA(dst, b, h) do { _Pragma("unroll") for (int m = 0; m < 4; ++m) _Pragma("unroll") for (int k = 0; k < 2; ++k) dst[m][k] = *(const LAS bf16x8*)(lds + PG8_SA(b, h) + aoff + m * 2048 + k * 1024); } while (0)
#define PG8_LDB(dst, b, h) do { _Pragma("unroll") for (int n = 0; n < 2; ++n) _Pragma("unroll") for (int k = 0; k < 2; ++k) dst[n][k] = *(const LAS bf16x8*)(lds + PG8_SB(b, h) + boff + n * 2048 + k * 1024); } while (0)
#define PG8_MMA(ai, bj, At, Bt) do { __builtin_amdgcn_s_setprio(1); _Pragma("unroll") for (int m = 0; m < 4; ++m) _Pragma("unroll") for (int n = 0; n < 2; ++n) _Pragma("unroll") for (int k = 0; k < 2; ++k) \
        acc[ai][bj][m][n] = __builtin_amdgcn_mfma_f32_16x16x32_bf16(Bt[n][k], At[m][k], acc[ai][bj][m][n], 0, 0, 0); __builtin_amdgcn_s_setprio(0); } while (0)
#define PG8_WAIT_V(n) asm volatile("s_waitcnt vmcnt(" #n ")" ::: "memory")
#define PG8_WAIT_L(n) asm volatile("s_waitcnt lgkmcnt(" #n ")" ::: "memory")
#define PG8_BAR __builtin_amdgcn_s_barrier()
#define PG8_SCHED __builtin_amdgcn_sched_barrier(0)
    Unit cur, nxt; int ui = 0;
    if (!S_.next(0, cur)) return;
    LAS float* const gtab = (LAS float*)(lds + STAGE_BYTES);
    if constexpr (Epi::GROUPSCALE) E.fill(gtab, cur.pm, tid);
    f32x4 acc[2][2][4][2];
#pragma unroll
    for (int a = 0; a < 2; ++a)
#pragma unroll
        for (int b = 0; b < 2; ++b)
#pragma unroll
            for (int m = 0; m < 4; ++m)
#pragma unroll
                for (int n = 0; n < 2; ++n) acc[a][b][m][n] = (f32x4){0.f, 0.f, 0.f, 0.f};
    bf16x8 At[4][2], B0[2][2], B1[2][2];
    const char* cA = (const char*)g.A + (size_t)cur.pm * tstepA; const char* cB = (const char*)g.Bt + (size_t)cur.pn * tstepB;
    PG8_STAGE(PG8_SB(0, 0), cB, voffB); PG8_STAGE(PG8_SB(0, 1), cB + hstepB, voffB); PG8_STAGE(PG8_SA(0, 0), cA, voffA); PG8_STAGE(PG8_SA(0, 1), cA + hstepA, voffA);
    if (wr == 1) PG8_BAR;
    PG8_WAIT_V(2); PG8_BAR;
    PG8_STAGE(PG8_SB(1, 0), cB + kstep, voffB); PG8_STAGE(PG8_SA(1, 0), cA + kstep, voffA); PG8_STAGE(PG8_SB(1, 1), cB + hstepB + kstep, voffB);
    PG8_WAIT_V(6); PG8_BAR;
    for (;;) {
        const bool has_next = S_.next(ui + 1, nxt);
        const char* nA = has_next ? (const char*)g.A + (size_t)nxt.pm * tstepA : cA; const char* nB = has_next ? (const char*)g.Bt + (size_t)nxt.pn * tstepB : cB;
        if constexpr (Epi::GROUPSCALE) { if (has_next) E.fill(gtab + ((ui + 1) & 1) * 1024, nxt.pm, tid); }
        for (int t = 0; t < nt; t += 2) {
            if constexpr (Epi::GROUPSCALE) {
                int tq = t; asm volatile("" : "+s"(tq));
                if (tq != 0 && (tq & 3) == 0) {
                    const LAS float* tb = gtab + (ui & 1) * 1024 + ((tq >> 2) - 1);
#pragma unroll
                    for (int a = 0; a < 2; ++a)
#pragma unroll
                        for (int m = 0; m < 4; ++m) { const float r = tb[(a * HALF + wr * 64 + m * 16 + fr) * 4];
#pragma unroll
                            for (int b = 0; b < 2; ++b)
#pragma unroll
                                for (int n = 0; n < 2; ++n) acc[a][b][m][n] = acc[a][b][m][n] * r; }
                }
            }
            const bool last = (t == nt - 2);
            const char* a1 = cA + (size_t)(t + 1) * kstep;
            const char* a2 = last ? nA : cA + (size_t)(t + 2) * kstep; const char* b2 = last ? nB : cB + (size_t)(t + 2) * kstep;
            const char* a3 = a2 + kstep; const char* b3 = b2 + kstep;
            PG8_LDB(B0, 0, 0); PG8_LDB(B1, 0, 1); PG8_SCHED; PG8_LDA(At, 0, 0); PG8_STAGE(PG8_SA(1, 1), a1 + hstepA, voffA);
            PG8_WAIT_V(8); PG8_WAIT_L(0); PG8_BAR; PG8_MMA(0, 0, At, B0); PG8_MMA(0, 1, At, B1); PG8_BAR; PG8_SCHED;
            PG8_LDA(At, 0, 1); PG8_STAGE(PG8_SB(0, 0), b2, voffB); PG8_STAGE(PG8_SB(0, 1), b2 + hstepB, voffB); PG8_STAGE(PG8_SA(0, 0), a2, voffA);
            PG8_WAIT_V(8); PG8_WAIT_L(0); PG8_BAR; PG8_MMA(1, 0, At, B0); PG8_MMA(1, 1, At, B1); PG8_BAR; PG8_SCHED;
            PG8_LDB(B0, 1, 0); PG8_LDB(B1, 1, 1); PG8_SCHED; PG8_LDA(At, 1, 0); PG8_STAGE(PG8_SA(0, 1), a2 + hstepA, voffA);
            PG8_WAIT_V(8); PG8_WAIT_L(0); PG8_BAR; PG8_MMA(0, 0, At, B0); PG8_MMA(0, 1, At, B1); PG8_BAR; PG8_SCHED;
            PG8_LDA(At, 1, 1); PG8_STAGE(PG8_SB(1, 0), b3, voffB); PG8_STAGE(PG8_SB(1, 1), b3 + hstepB, voffB); PG8_STAGE(PG8_SA(1, 0), a3, voffA);
            PG8_WAIT_V(8); PG8_WAIT_L(0); PG8_BAR; PG8_MMA(1, 0, At, B0); PG8_MMA(1, 1, At, B1); PG8_BAR; PG8_SCHED;
        }
        if constexpr (ALIGN_EPI) { if (wr == 0) PG8_BAR; }
        if constexpr (Epi::GROUPSCALE) E(acc, cur, wr, wc, fr, fq, gtab + (ui & 1) * 1024); else E(acc, cur, wr, wc, fr, fq);
        if (!has_next) break;
#pragma unroll
        for (int a = 0; a < 2; ++a)
#pragma unroll
            for (int b = 0; b < 2; ++b)
#pragma unroll
                for (int m = 0; m < 4; ++m)
#pragma unroll
                    for (int n = 0; n < 2; ++n) acc[a][b][m][n] = (f32x4){0.f, 0.f, 0.f, 0.f};
        cur = nxt; cA = nA; cB = nB; ++ui;
        if constexpr (ALIGN_EPI) { if (wr == 1) PG8_BAR; }
    }
    PG8_WAIT_V(0);
    if constexpr (!ALIGN_EPI) { if (wr == 0) PG8_BAR; }
    PG8_BAR;
#undef PG8_SA
#undef PG8_SB
#undef PG8_STAGE
#undef PG8_LDA
#undef PG8_LDB
#undef PG8_MMA
#undef PG8_WAIT_V
#undef PG8_WAIT_L
#undef PG8_BAR
#undef PG8_SCHED
}

struct EpiProj {
    static constexpr bool GROUPSCALE = false;
    bf16_t* proj; float* side;
    __device__ __forceinline__ void operator()(const f32x4 (&acc)[2][2][4][2], const Unit& u, int wr, int wc, int fr, int fq) const {
        const int row0 = u.pm * BM + wr * 64 + fr, col0 = u.pn * BM + wc * 32 + 8 * fq;
#pragma unroll
        for (int ai = 0; ai < 2; ++ai)
#pragma unroll
            for (int m = 0; m < 4; ++m) { const int row = row0 + ai * HALF + m * 16; bf16_t* rowp = proj + (size_t)row * NP + col0;
#pragma unroll
                for (int bj = 0; bj < 2; ++bj) { const f32x4 v0 = acc[ai][bj][m][0], v1 = acc[ai][bj][m][1];
                    u32x4 w; w.x = pk2(v0[0], v0[1]); w.y = pk2(v0[2], v0[3]); w.z = pk2(v1[0], v1[1]); w.w = pk2(v1[2], v1[3]);
                    *(u32x4*)(rowp + bj * HALF) = w;
                    if (bj == 1 && u.pn == 14 && wc == 0) { float* sp = side + (size_t)row * 32 + 8 * fq; *(f32x4*)sp = v0; *(f32x4*)(sp + 4) = v1; } } }
    }
};
struct EpiQup {
    static constexpr bool GROUPSCALE = false;
    bf16_t* q; const float* rstd; const float* rope;
    __device__ __forceinline__ void operator()(const f32x4 (&acc)[2][2][4][2], const Unit& u, int wr, int wc, int fr, int fq) const {
        const int row0 = u.pm * BM + wr * 64 + fr;
#pragma unroll
        for (int ai = 0; ai < 2; ++ai)
#pragma unroll
            for (int m = 0; m < 4; ++m) { const int row = row0 + ai * HALF + m * 16; const float rs = rstd[(size_t)row * 2]; const int pos = row & (S - 1);
#pragma unroll
                for (int bj = 0; bj < 2; ++bj) { const int c = u.pn * BM + bj * HALF + wc * 32 + 8 * fq;
                    if (c < 384) { const int w0 = c % 96;
                        f32x4 v0 = acc[ai][bj][m][0] * rs, v1 = acc[ai][bj][m][1] * rs;
                        if (w0 >= 64) { const int i0 = (w0 - 64) >> 1; const float* tp = rope + ((size_t)pos * 16 + i0) * 2;
                            const f32x4 t0 = *(const f32x4*)tp, t1 = *(const f32x4*)(tp + 4);
                            f32x4 a, b;
                            a[0] = v0[0] * t0[0] - v0[1] * t0[1]; a[1] = v0[0] * t0[1] + v0[1] * t0[0];
                            a[2] = v0[2] * t0[2] - v0[3] * t0[3]; a[3] = v0[2] * t0[3] + v0[3] * t0[2];
                            b[0] = v1[0] * t1[0] - v1[1] * t1[1]; b[1] = v1[0] * t1[1] + v1[1] * t1[0];
                            b[2] = v1[2] * t1[2] - v1[3] * t1[3]; b[3] = v1[2] * t1[3] + v1[3] * t1[2];
                            v0 = a; v1 = b; }
                        u32x4 w; w.x = pk2(v0[0], v0[1]); w.y = pk2(v0[2], v0[3]); w.z = pk2(v1[0], v1[1]); w.w = pk2(v1[2], v1[3]);
                        *(u32x4*)(q + (size_t)row * 384 + c) = w; } }
                asm volatile("" ::: "memory"); }
    }
};
struct EpiKVup {
    static constexpr bool GROUPSCALE = false;
    bf16_t* k; bf16_t* v; const float* rstd;
    __device__ __forceinline__ void operator()(const f32x4 (&acc)[2][2][4][2], const Unit& u, int wr, int wc, int fr, int fq) const {
        const int row0 = u.pm * BM + wr * 64 + fr;
#pragma unroll
        for (int ai = 0; ai < 2; ++ai)
#pragma unroll
            for (int m = 0; m < 4; ++m) { const int row = row0 + ai * HALF + m * 16; const float rs = rstd[(size_t)row * 2 + 1];
#pragma unroll
                for (int bj = 0; bj < 2; ++bj) { const int c = u.pn * BM + bj * HALF + wc * 32 + 8 * fq; const int hd = c >> 7, w0 = c & 127;
                    const f32x4 v0 = acc[ai][bj][m][0] * rs, v1 = acc[ai][bj][m][1] * rs;
                    u32x4 w; w.x = pk2(v0[0], v0[1]); w.y = pk2(v0[2], v0[3]); w.z = pk2(v1[0], v1[1]); w.w = pk2(v1[2], v1[3]);
                    bf16_t* dst = (w0 < 64) ? (k + (size_t)row * 384 + hd * 96 + w0) : (v + (size_t)row * 256 + hd * 64 + (w0 - 64));
                    *(u32x4*)dst = w; }
                asm volatile("" ::: "memory"); }
    }
};
struct EpiOut {
    static constexpr bool GROUPSCALE = true;
    const float* res; float* out; const float* gate;
    const float* ssq;
    __device__ __forceinline__ void fill(LAS float* tab, int pm, int tid) const {
        if (tid < 256) { const f32x4* sp = (const f32x4*)(ssq + (size_t)(pm * BM + tid) * 16); const f32x4 a = sp[0], b = sp[1], c = sp[2], d = sp[3];
            const float q0 = (a[0] + a[1]) + (a[2] + a[3]), q1 = (b[0] + b[1]) + (b[2] + b[3]), q2 = (c[0] + c[1]) + (c[2] + c[3]), q3 = (d[0] + d[1]) + (d[2] + d[3]);
            const float m0 = q0 * (1.f / 256.f) + EPS, m1 = q1 * (1.f / 256.f) + EPS, m2 = q2 * (1.f / 256.f) + EPS, m3 = q3 * (1.f / 256.f) + EPS;
            f32x4 w; w[0] = sqrtf(m1 / m0); w[1] = sqrtf(m2 / m1); w[2] = sqrtf(m3 / m2); w[3] = 1.0f / sqrtf(m3);
            *(LAS f32x4*)(tab + tid * 4) = w; }
    }
    __device__ __forceinline__ void operator()(const f32x4 (&acc)[2][2][4][2], const Unit& u, int wr, int wc, int fr, int fq, const LAS float* tab) const {
        const int row0 = u.pm * BM + wr * 64 + fr; const int b = (u.pm * BM) / S;
        float s3[2][4];
#pragma unroll
        for (int ai = 0; ai < 2; ++ai)
#pragma unroll
            for (int m = 0; m < 4; ++m) s3[ai][m] = tab[(ai * HALF + wr * 64 + m * 16 + fr) * 4 + 3];
#pragma unroll
        for (int bj = 0; bj < 2; ++bj) { const int c = u.pn * BM + bj * HALF + wc * 32 + 8 * fq;
            const f32x4 g0 = *(const f32x4*)(gate + (size_t)b * 3072 + c), g1 = *(const f32x4*)(gate + (size_t)b * 3072 + c + 4);
#pragma unroll
            for (int ai = 0; ai < 2; ++ai)
#pragma unroll
                for (int m = 0; m < 4; ++m) { const int row = row0 + ai * HALF + m * 16; const size_t off = (size_t)row * D + c;
                    const f32x4 r0 = *(const f32x4*)(res + off), r1 = *(const f32x4*)(res + off + 4);
                    *(f32x4*)(out + off) = r0 + (g0 * s3[ai][m]) * acc[ai][bj][m][0]; *(f32x4*)(out + off + 4) = r1 + (g1 * s3[ai][m]) * acc[ai][bj][m][1]; } }
    }
};
}

struct MapWin { __device__ __forceinline__ int operator()(int n) const {
    if (n < 1120) return n; if (n < 2048) return n + 4; if (n < 2688) return n + 8; if (n < 3712) return n + 20;
    if (n < 3716) return 1120 + (n - 3712); if (n < 3720) return 2052 + (n - 3716); if (n < 3732) return 2696 + (n - 3720); return -1; } };
struct MapId { int N; __device__ __forceinline__ int operator()(int n) const { return n < N ? n : -1; } };
struct MapUq { __device__ __forceinline__ int operator()(int n) const { if (n >= 384) return -1; const int hd = n / 96, w = n % 96; if (w < 64) return hd * 96 + w;
    const int p = (w - 64) >> 1, which = (w - 64) & 1; return hd * 96 + 64 + (which ? 16 + p : p); } };

template <class ColMap>
__device__ __forceinline__ void tr_tile(const float* src, int lds_src, int Ksrc, const float* kscale, bf16_t* dst, int ldd, int n0, int k0, ColMap cm, LAS float* scr, int wid0) {
    const int tid = opaque_tid(wid0);
#pragma unroll
    for (int i = 0; i < 8; ++i) { const int idx = tid + i * NTHREADS, kk = idx >> 6, nn = idx & 63; const int sc = cm(n0 + nn), k = k0 + kk;
        float v = 0.f; if (sc >= 0 && k < Ksrc) { v = src[(size_t)k * lds_src + sc]; if (kscale) v *= kscale[k]; }
        scr[kk * 65 + nn] = v; }
    __syncthreads();
    { const int nn = tid >> 3, kc = tid & 7; const LAS float* s = scr + (kc * 8) * 65 + nn;
      u32x4 w; w.x = pk2(s[0], s[65]); w.y = pk2(s[2 * 65], s[3 * 65]); w.z = pk2(s[4 * 65], s[5 * 65]); w.w = pk2(s[6 * 65], s[7 * 65]);
      *(u32x4*)(dst + (size_t)(n0 + nn) * ldd + k0 + kc * 8) = w; }
    __syncthreads();
}

__device__ __forceinline__ void phase_prologue(const Params& P, LAS unsigned char* lds, int bid, int G, int wid0) {
    const int tid = opaque_tid(wid0);
    LAS float* scr = (LAS float*)lds;
    const float* w_in = P.in[5]; const float* w_uq = P.in[7]; const float* w_ukv = P.in[9]; const float* w1 = P.in[12]; const float* w_out = P.in[15];
    constexpr int T_WIN = 60 * 16, T_WOUT = 16 * 16, T_UQ = 8 * 4, T_UKV = 8 * 2, T_W1 = 1 * 32 * 2;
    constexpr int T_L = T_WIN + T_WOUT + T_UQ + T_UKV + T_W1;
    for (int it = bid; it < DEPTH * T_L; it += G) {
        const int l = it / T_L; int r = it % T_L;
        if (r < T_WIN) { tr_tile(w_in + (size_t)l * D * 3732, 3732, D, nullptr, (bf16_t*)(P.ws + WS_WIN) + (size_t)l * NP * D, D, (r / 16) * 64, (r % 16) * 64, MapWin{}, scr, wid0); continue; } r -= T_WIN;
        if (r < T_WOUT) { tr_tile(w_out + (size_t)l * D * D, D, D, nullptr, (bf16_t*)(P.ws + WS_WOUT) + (size_t)l * D * D, D, (r / 16) * 64, (r % 16) * 64, MapId{D}, scr, wid0); continue; } r -= T_WOUT;
        if (r < T_UQ) { tr_tile(w_uq + (size_t)l * 192 * 384, 384, 192, P.in[6] + l * 192, (bf16_t*)(P.ws + WS_WUQ) + (size_t)l * 512 * 256, 256, (r / 4) * 64, (r % 4) * 64, MapUq{}, scr, wid0); continue; } r -= T_UQ;
        if (r < T_UKV) { tr_tile(w_ukv + (size_t)l * 128 * 512, 512, 128, P.in[8] + l * 128, (bf16_t*)(P.ws + WS_WUKV) + (size_t)l * 512 * 128, 128, (r / 2) * 64, (r % 2) * 64, MapId{512}, scr, wid0); continue; } r -= T_UKV;
        { const int kv = r / 32, kt = r % 32; tr_tile(w1 + (size_t)(l * 2 + kv) * 2048 * 64, 64, 2048, nullptr, (bf16_t*)(P.ws + WS_W1T) + (size_t)(l * 2 + kv) * 64 * 2048, 2048, 0, kt * 64, MapId{64}, scr, wid0); }
    }
    {
        LAS float* sc = (LAS float*)lds;
        LAS float* red = (LAS float*)(lds + 16384);
        const float* c = P.in[1]; const float* w_ada = P.in[3]; const float* b_ada = P.in[4]; float* mod = (float*)(P.ws + WS_MOD);
        bool loaded = false;
        for (int it = bid; it < DEPTH * 48; it += G) {
            if (!loaded) { for (int i = tid; i < 4096; i += NTHREADS) sc[i] = silu_f(c[i]); loaded = true; __syncthreads(); }
            const int l = it / 48, cb = it % 48, col = tid & 63, ks = tid >> 6;
            const float* wp = w_ada + (size_t)l * D * 3072 + (size_t)(ks * 128) * 3072 + cb * 64 + col;
            float a0 = 0.f, a1 = 0.f, a2 = 0.f, a3 = 0.f;
#pragma unroll 8
            for (int k = 0; k < 128; ++k) { const float w = wp[(size_t)k * 3072]; const int kk = ks * 128 + k;
                a0 += sc[kk] * w; a1 += sc[1024 + kk] * w; a2 += sc[2048 + kk] * w; a3 += sc[3072 + kk] * w; }
            red[(ks * 64 + col) * 4 + 0] = a0; red[(ks * 64 + col) * 4 + 1] = a1; red[(ks * 64 + col) * 4 + 2] = a2; red[(ks * 64 + col) * 4 + 3] = a3;
            __syncthreads();
            if (tid < 256) { const int cc = tid & 63, b = tid >> 6; float s = b_ada[l * 3072 + cb * 64 + cc];
#pragma unroll
                for (int k8 = 0; k8 < 8; ++k8) s += red[(k8 * 64 + cc) * 4 + b];
                mod[(size_t)(l * 4 + b) * 3072 + cb * 64 + cc] = s; }
            __syncthreads();
        }
    }
    {
        float* tab = (float*)(P.ws + WS_ROPE);
        for (int idx = bid * NTHREADS + tid; idx < S * 16; idx += G * NTHREADS) {
            const int pos = idx >> 4, i = idx & 15;
            const double f4[4] = {1.0, 0.5623413251903491, 0.31622776601683794, 0.1778279410038923};
            double inv = (i & 3) == 0 ? f4[0] : ((i & 3) == 1 ? f4[1] : ((i & 3) == 2 ? f4[2] : f4[3]));
            inv *= ((i >> 2) == 0 ? 1.0 : ((i >> 2) == 1 ? 0.1 : ((i >> 2) == 2 ? 0.01 : 0.001)));
            const float invf = (float)inv; const float angf = (float)pos * invf;
            const double rev = (double)angf * 0.15915494309189535; const double fr = rev - __builtin_floor(rev);
            const float f = (float)fr;
            tab[(size_t)idx * 2] = __builtin_amdgcn_cosf(f); tab[(size_t)idx * 2 + 1] = __builtin_amdgcn_sinf(f);
        }
    }
    {
        const float* pos = P.in[11]; float* cvec = (float*)(P.ws + WS_CVEC);
        LAS float* red = (LAS float*)(lds + 65536);
        for (int it = bid; it < DEPTH * 2; it += G) {
            __syncthreads();
            const int col = tid & 63, ks = tid >> 6; float a = 0.f;
            const float* wp = w1 + (size_t)it * 2048 * 64 + (size_t)(ks * 256) * 64 + col; const float* pp = pos + (size_t)it * 2048 + ks * 256;
            for (int k = 0; k < 256; ++k) a += pp[k] * wp[(size_t)k * 64];
            red[ks * 64 + col] = a; __syncthreads();
            if (tid < 64) { float s = 0.f; for (int k8 = 0; k8 < 8; ++k8) s += red[k8 * 64 + tid]; cvec[it * 64 + tid] = s; }
            __syncthreads();
        }
    }
}

__device__ __forceinline__ void phase_hnorm(const float* x, const float* g, const float* mod  , bf16_t* h, int bid, int G, int wid0) {
    const int tid_ = opaque_tid(wid0); const int lane = tid_ & 63, wv = tid_ >> 6;
    for (int row = bid * 8 + wv; row < M; row += G * 8) {
        const f32x4* xr = (const f32x4*)(x + (size_t)row * D) + lane;
        f32x4 v[4]; float s = 0.f;
#pragma unroll
        for (int j = 0; j < 4; ++j) { v[j] = xr[64 * j]; s += (v[j][0] * v[j][0] + v[j][1] * v[j][1]) + (v[j][2] * v[j][2] + v[j][3] * v[j][3]); }
        const float rstd = 1.0f / sqrtf(wave_sum(s) * (1.f / D) + EPS);
        const int b = row / S; const float* sh = mod + (size_t)b * 3072; const float* scl = sh + 1024;
        unsigned long long* o8 = (unsigned long long*)(h + (size_t)row * D) + lane;
#pragma unroll
        for (int j = 0; j < 4; ++j) { const int c = (64 * j + lane) * 4; const f32x4 gg = *(const f32x4*)(g + c), ss = *(const f32x4*)(scl + c), hh = *(const f32x4*)(sh + c);
            f32x4 y;
#pragma unroll
            for (int e = 0; e < 4; ++e) y[e] = v[j][e] * rstd * gg[e] * (1.0f + ss[e]) + hh[e];
            o8[64 * j] = (unsigned long long)pk2(y[0], y[1]) | ((unsigned long long)pk2(y[2], y[3]) << 32); }
    }
}

__device__ __forceinline__ void phase_prep(const Params& P, int l, LAS unsigned char* lds, int bid, int G, int wid0) {
    const int tid = opaque_tid(wid0), lane = tid & 63, wv = tid >> 6;
    const bf16_t* proj = (const bf16_t*)(P.ws + WS_PROJ); const float* side = (const float*)(P.ws + WS_SIDE);
    {
        float* rstd = (float*)(P.ws + WS_RSTD); bf16_t* kmla = (bf16_t*)(P.ws + WS_KMLA); const float* rope = (const float*)(P.ws + WS_ROPE);
        const bool shift_ = (G == 256 && M == 32768);
        const int nk_ = shift_ ? ((bid < 128) ? 16 - PREP_SHIFT : 16 + PREP_SHIFT) : (M + G * 8 - 1) / (G * 8);
        for (int k_ = 0; k_ < nk_; ++k_) {
            const int row = (shift_ && k_ >= 16) ? (bid - 128) * 8 + wv + (16 - PREP_SHIFT + (k_ - 16)) * G * 8 : bid * 8 + wv + k_ * G * 8;
            if (row >= M) break;
            const bf16_t* pr = proj + (size_t)row * NP;
            float sq = 0.f, skv = 0.f;
            if (lane < 40) { const u32x4 w = *(const u32x4*)(pr + lane * 8); float s = 0.f;
#pragma unroll
                for (int e = 0; e < 4; ++e) { const float a = bflo(w[e]), b = bfhi(w[e]); s += a * a + b * b; }
                if (lane < 24) sq = s; else skv = s; }
            sq = wave_sum(sq); skv = wave_sum(skv);
            if (lane == 0) { rstd[(size_t)row * 2] = 1.0f / sqrtf(sq * (1.f / 192.f) + EPS); rstd[(size_t)row * 2 + 1] = 1.0f / sqrtf(skv * (1.f / 128.f) + EPS); }
            if (lane >= 48 && lane < 52) *(u32x4*)((bf16_t*)(P.ws + WS_KIDX) + (size_t)row * 32 + (lane - 48) * 8) = *(const u32x4*)(pr + C_IK + (lane - 48) * 8);
            if (lane < 16) { const float x1 = bf2f(pr[C_KROPE + lane]), x2 = bf2f(pr[C_KROPE + 16 + lane]); const int pos = row & (S - 1);
                const float cs = rope[((size_t)pos * 16 + lane) * 2], sn = rope[((size_t)pos * 16 + lane) * 2 + 1];
                const unsigned w = pk2(x1 * cs - x2 * sn, x1 * sn + x2 * cs);
#pragma unroll
                for (int hd = 0; hd < 4; ++hd) *(unsigned*)(kmla + (size_t)row * 384 + hd * 96 + 64 + 2 * lane) = w; }
        }
    }
    {
        float* fb = (float*)(P.ws + WS_FB); const float* b_f = P.in[10] + l * 4; LAS float* wtot = (LAS float*)lds;
        for (int it = (G >= 160) ? bid - (G - 16) : bid; it < 16; it += G) {
            if (it < 0) break;
            const int b = it >> 2, hd = it & 3; const float bf = b_f[hd];
            float ls[16]; float s = 0.f;
#pragma unroll
            for (int i = 0; i < 16; ++i) { const int t = tid * 16 + i; const float v = side[((size_t)b * S + t) * 32 + hd] + bf;
                const float y = fminf(v, 0.f) - log1pf(__expf(-fabsf(v))); ls[i] = y; s += y; }
            float inc = s;
#pragma unroll
            for (int o = 1; o < 64; o <<= 1) { const float t = __shfl_up(inc, o); if (lane >= o) inc += t; }
            __syncthreads();
            if (lane == 63) wtot[wv] = inc;
            __syncthreads();
            float base = 0.f;
            for (int w = 0; w < wv; ++w) base += wtot[w];
            float run = base + inc - s;
#pragma unroll
            for (int i = 0; i < 16; ++i) { run += ls[i]; fb[((size_t)it) * S + tid * 16 + i] = -8.0f * run; }
            __syncthreads();
        }
    }
    {
        const bf16_t* w1t = (const bf16_t*)(P.ws + WS_W1T) + (size_t)l * 2 * 64 * 2048; const float* cvec = (const float*)(P.ws + WS_CVEC) + l * 2 * 64;
        const float* w2 = P.in[13] + (size_t)l * 2 * 64 * 64;
        LAS float* part = (LAS float*)lds;
        LAS float* hb = (LAS float*)(lds + 65536);
        const int r = lane & 31, hi = lane >> 5;
        for (int it = bid; it < 128; it += G) {
            const int b = it >> 5, kv = (it >> 4) & 1, nt = it & 15, n0 = nt * 32;
            const int colbase = kv ? C_VCMP : C_KCMP;
            const bf16_t* w1k = w1t + (size_t)kv * 64 * 2048;
            f32x16 a0 = {}, a1 = {};
#pragma unroll
            for (int j = 0; j < 4; ++j) { const int tok = wv * 4 + j;
                const bf16_t* ap = proj + ((size_t)b * S + 16 * (n0 + r) + tok) * NP + colbase + hi * 8;
#pragma unroll
                for (int s = 0; s < 4; ++s) { const bf16x8 af = *(const bf16x8*)(ap + s * 16);
                    const int kb = tok * 64 + s * 16 + hi * 8;
                    const bf16x8 b0 = *(const bf16x8*)(w1k + (size_t)r * 2048 + kb), b1 = *(const bf16x8*)(w1k + (size_t)(32 + r) * 2048 + kb);
                    a0 = __builtin_amdgcn_mfma_f32_32x32x16_bf16(af, b0, a0, 0, 0, 0); a1 = __builtin_amdgcn_mfma_f32_32x32x16_bf16(af, b1, a1, 0, 0, 0); } }
#pragma unroll
            for (int reg = 0; reg < 16; ++reg) { const int n = crow(reg, hi); part[(wv * 32 + n) * 64 + r] = a0[reg]; part[(wv * 32 + n) * 64 + 32 + r] = a1[reg]; }
            __syncthreads();
            { const int n = tid >> 4, c4 = (tid & 15) * 4;
#pragma unroll
              for (int e = 0; e < 4; ++e) { float s = cvec[kv * 64 + c4 + e];
#pragma unroll
                  for (int w = 0; w < 8; ++w) s += part[(w * 32 + n) * 64 + c4 + e];
                  hb[n * 64 + c4 + e] = silu_f(s); } }
            __syncthreads();
            { const int n = tid >> 4, c4 = (tid & 15) * 4; float o[4] = {0.f, 0.f, 0.f, 0.f}; const float* w2k = w2 + (size_t)kv * 64 * 64;
              for (int k = 0; k < 64; ++k) { const float hv = hb[n * 64 + k]; const f32x4 wv4 = *(const f32x4*)(w2k + k * 64 + c4);
                  o[0] += hv * wv4[0]; o[1] += hv * wv4[1]; o[2] += hv * wv4[2]; o[3] += hv * wv4[3]; }
              bf16_t* dst = (bf16_t*)(P.ws + (kv ? WS_VC : WS_KC)) + ((size_t)b * 512 + n0 + n) * 64 + c4;
              const bool valid = (n0 + n) < 511;
              u32x2 w; w.x = valid ? pk2(o[0], o[1]) : 0u; w.y = valid ? pk2(o[2], o[3]) : 0u; *(u32x2*)dst = w; }
            __syncthreads();
        }
    }
}

constexpr float NEG_BIG = -1e30f;
constexpr int KSTR64 = 144, KSTR96 = 208;
constexpr int ATT_KBUF = 64 * KSTR96;
constexpr int ATT_VBUF = 8192;
constexpr int ATT_K0 = 0, ATT_V0 = 2 * ATT_KBUF, ATT_B0 = ATT_V0 + 2 * ATT_VBUF, ATT_END = ATT_B0 + 2 * 256;
constexpr int ATT_EXTRA = 45056;

struct SoftState { float m, l; f32x16 o0, o1; };

template <int KS>
__device__ __forceinline__ void qk_tile(f32x16& p0, f32x16& p1, const LAS unsigned char* kt, int kstride, const bf16x8 (&qf)[KS], int r, int hi) {
    const LAS unsigned char* k0 = kt + r * kstride + hi * 16; const LAS unsigned char* k1 = k0 + 32 * kstride;
#pragma unroll
    for (int s = 0; s < KS; ++s) { const bf16x8 a0 = *(const LAS bf16x8*)(k0 + s * 32), a1 = *(const LAS bf16x8*)(k1 + s * 32);
        p0 = __builtin_amdgcn_mfma_f32_32x32x16_bf16(a0, qf[s], p0, 0, 0, 0); p1 = __builtin_amdgcn_mfma_f32_32x32x16_bf16(a1, qf[s], p1, 0, 0, 0); }
}
__device__ __forceinline__ float max3f(float a, float b, float c);
__device__ __forceinline__ float tile_max(const f32x16& p0, const f32x16& p1) {
    float a = max3f(p0[0], p0[1], p1[0]), b = max3f(p0[2], p0[3], p1[1]); a = max3f(a, p1[2], p1[3]);
#pragma unroll
    for (int i = 4; i < 16; i += 4) { a = max3f(a, p0[i], p0[i + 1]); b = max3f(b, p0[i + 2], p0[i + 3]); a = max3f(a, p1[i], p1[i + 1]); b = max3f(b, p1[i + 2], p1[i + 3]); }
    a = max3f(a, b, b);
    const auto rr = __builtin_amdgcn_permlane32_swap(__float_as_uint(a), __float_as_uint(a), false, false);
    return fmaxf(__uint_as_float(rr[0]), __uint_as_float(rr[1]));
}
__device__ __forceinline__ bf16x8 vfrag(const LAS unsigned char* p) {
    const s16x4 lo = __builtin_bit_cast(s16x4, __builtin_amdgcn_ds_read_tr16_b64_v4i16((LAS s16x4*)p));
    const s16x4 hi = __builtin_bit_cast(s16x4, __builtin_amdgcn_ds_read_tr16_b64_v4i16((LAS s16x4*)(p + 512)));
    return (bf16x8){lo[0], lo[1], lo[2], lo[3], hi[0], hi[1], hi[2], hi[3]};
}
__device__ __forceinline__ bf16x8 pfrag(const f32x16& p, int b) {
    u32x4 w; w.x = pk2(p[b], p[b + 1]); w.y = pk2(p[b + 2], p[b + 3]); w.z = pk2(p[b + 4], p[b + 5]); w.w = pk2(p[b + 6], p[b + 7]);
    return __builtin_bit_cast(bf16x8, w);
}
__device__ __forceinline__ void pv_frag(f32x16& o0, f32x16& o1, bf16x8 pf0, bf16x8 pf1, bf16x8 pf2, bf16x8 pf3, const LAS unsigned char* vt, int vb) {
    const LAS unsigned char* v = vt + vb;
    o0 = __builtin_amdgcn_mfma_f32_32x32x16_bf16(vfrag(v), pf0, o0, 0, 0, 0);            o1 = __builtin_amdgcn_mfma_f32_32x32x16_bf16(vfrag(v + 4096), pf0, o1, 0, 0, 0);
    o0 = __builtin_amdgcn_mfma_f32_32x32x16_bf16(vfrag(v + 1024), pf1, o0, 0, 0, 0);     o1 = __builtin_amdgcn_mfma_f32_32x32x16_bf16(vfrag(v + 4096 + 1024), pf1, o1, 0, 0, 0);
    o0 = __builtin_amdgcn_mfma_f32_32x32x16_bf16(vfrag(v + 2048), pf2, o0, 0, 0, 0);     o1 = __builtin_amdgcn_mfma_f32_32x32x16_bf16(vfrag(v + 4096 + 2048), pf2, o1, 0, 0, 0);
    o0 = __builtin_amdgcn_mfma_f32_32x32x16_bf16(vfrag(v + 3072), pf3, o0, 0, 0, 0);     o1 = __builtin_amdgcn_mfma_f32_32x32x16_bf16(vfrag(v + 4096 + 3072), pf3, o1, 0, 0, 0);
}
__device__ __forceinline__ void pv_tile(f32x16& o0, f32x16& o1, const f32x16& p0, const f32x16& p1, const LAS unsigned char* vt, int vb) {
    pv_frag(o0, o1, pfrag(p0, 0), pfrag(p0, 8), pfrag(p1, 0), pfrag(p1, 8), vt, vb);
}
__device__ __forceinline__ void softmax_step(SoftState& st, f32x16& p0, f32x16& p1, float c2) {
    const float mx = tile_max(p0, p1);
    const float mn = fmaxf(st.m, mx);
    if (__any(mn > st.m)) { const float al = __builtin_amdgcn_exp2f((st.m - mn) * c2); st.l *= al; st.o0 *= al; st.o1 *= al; st.m = mn; }
    const float mc = st.m * c2; float sum = 0.f;
#pragma unroll
    for (int i = 0; i < 16; ++i) { p0[i] = __builtin_amdgcn_exp2f(__builtin_fmaf(p0[i], c2, -mc)); p1[i] = __builtin_amdgcn_exp2f(__builtin_fmaf(p1[i], c2, -mc)); sum += p0[i] + p1[i]; }
    st.l += sum;
}

__device__ __forceinline__ float max3f(float a, float b, float c) { float r; asm("v_max3_f32 %0, %1, %2, %3" : "=v"(r) : "v"(a), "v"(b), "v"(c)); return r; }
__device__ __forceinline__ float swap32_max(float a) { const auto rr = __builtin_amdgcn_permlane32_swap(__float_as_uint(a), __float_as_uint(a), false, false);
    float r; asm("v_max_f32_e32 %0, %1, %2" : "=v"(r) : "v"(__uint_as_float(rr[0])), "v"(__uint_as_float(rr[1]))); return r; }
__device__ __forceinline__ float quad_xor1(float x) { return __builtin_bit_cast(float, __builtin_amdgcn_update_dpp(0, __builtin_bit_cast(int, x), 0xB1, 0xf, 0xf, false)); }
__device__ __forceinline__ float quad_xor2(float x) { return __builtin_bit_cast(float, __builtin_amdgcn_update_dpp(0, __builtin_bit_cast(int, x), 0x4E, 0xf, 0xf, false)); }
__device__ __forceinline__ float swap32_sum(float a) { const auto rr = __builtin_amdgcn_permlane32_swap(__float_as_uint(a), __float_as_uint(a), false, false); return __uint_as_float(rr[0]) + __uint_as_float(rr[1]); }
constexpr float SM_THR = 24.0f;
__device__ __forceinline__ void softmax_pack(SoftState& st, const f32x16& p0, const f32x16& p1, float c2, bf16x8& pf0, bf16x8& pf1, bf16x8& pf2, bf16x8& pf3) {
    float a = max3f(p0[0], p0[1], p1[0]), b = max3f(p0[2], p0[3], p1[1]); a = max3f(a, p1[2], p1[3]);
#pragma unroll
    for (int i = 4; i < 16; i += 4) { a = max3f(a, p0[i], p0[i + 1]); b = max3f(b, p0[i + 2], p0[i + 3]); a = max3f(a, p1[i], p1[i + 1]); b = max3f(b, p1[i + 2], p1[i + 3]); }
    float mx; asm("v_max_f32_e32 %0, %1, %2" : "=v"(mx) : "v"(a), "v"(b));
    mx = swap32_max(mx);
    if (__any((mx - st.m) * c2 > SM_THR)) { const float mn = fmaxf(st.m, mx); const float al = __builtin_amdgcn_exp2f((st.m - mn) * c2); st.l *= al; st.o0 *= al; st.o1 *= al; st.m = mn; }
    const float mc = -st.m * c2; float s0 = 0.f, s1 = 0.f;
    u32x4 w0, w1, w2, w3;
#define SMP(W, E, P, B) do { const float e0_ = __builtin_amdgcn_exp2f(__builtin_fmaf(P[B], c2, mc)), e1_ = __builtin_amdgcn_exp2f(__builtin_fmaf(P[B + 1], c2, mc)); s0 += e0_; s1 += e1_; W[E] = pk2(e0_, e1_); } while (0)
    SMP(w0, 0, p0, 0); SMP(w0, 1, p0, 2); SMP(w0, 2, p0, 4); SMP(w0, 3, p0, 6);
    SMP(w1, 0, p0, 8); SMP(w1, 1, p0, 10); SMP(w1, 2, p0, 12); SMP(w1, 3, p0, 14);
    SMP(w2, 0, p1, 0); SMP(w2, 1, p1, 2); SMP(w2, 2, p1, 4); SMP(w2, 3, p1, 6);
    SMP(w3, 0, p1, 8); SMP(w3, 1, p1, 10); SMP(w3, 2, p1, 12); SMP(w3, 3, p1, 14);
#undef SMP
    st.l += s0 + s1;
    pf0 = __builtin_bit_cast(bf16x8, w0); pf1 = __builtin_bit_cast(bf16x8, w1); pf2 = __builtin_bit_cast(bf16x8, w2); pf3 = __builtin_bit_cast(bf16x8, w3);
}

__device__ __forceinline__ void sm_exp_pack(SoftState& st, const f32x16& p0, const f32x16& p1, float c2, bf16x8& pf0, bf16x8& pf1, bf16x8& pf2, bf16x8& pf3) {
    const float mc = -st.m * c2; float s0 = 0.f, s1 = 0.f;
    u32x4 w0, w1, w2, w3;
#define SMP(W, E, P, B) do { const float e0_ = __builtin_amdgcn_exp2f(__builtin_fmaf(P[B], c2, mc)), e1_ = __builtin_amdgcn_exp2f(__builtin_fmaf(P[B + 1], c2, mc)); s0 += e0_; s1 += e1_; W[E] = pk2(e0_, e1_); } while (0)
    SMP(w0, 0, p0, 0); SMP(w0, 1, p0, 2); SMP(w0, 2, p0, 4); SMP(w0, 3, p0, 6);
    SMP(w1, 0, p0, 8); SMP(w1, 1, p0, 10); SMP(w1, 2, p0, 12); SMP(w1, 3, p0, 14);
    SMP(w2, 0, p1, 0); SMP(w2, 1, p1, 2); SMP(w2, 2, p1, 4); SMP(w2, 3, p1, 6);
    SMP(w3, 0, p1, 8); SMP(w3, 1, p1, 10); SMP(w3, 2, p1, 12); SMP(w3, 3, p1, 14);
#undef SMP
    st.l += s0 + s1;
    pf0 = __builtin_bit_cast(bf16x8, w0); pf1 = __builtin_bit_cast(bf16x8, w1); pf2 = __builtin_bit_cast(bf16x8, w2); pf3 = __builtin_bit_cast(bf16x8, w3);
}

template <int DK> struct StageRegs { u32x4 k0, k1, v; float b; };
template <int DK>
__device__ __forceinline__ void stage_load(StageRegs<DK>& sr, const bf16_t* K, int ldk, const bf16_t* V, int ldv, const float* bias, int kv0, int wid0) {
    const int tid = opaque_tid(wid0); constexpr int CPR = DK / 8;
    { const int row = tid / CPR, cc = tid % CPR; sr.k0 = *(const u32x4*)(K + (size_t)(kv0 + row) * ldk + cc * 8); }
    if (DK == 96 && tid < 256) { const int c = tid + 512, row = c / CPR, cc = c % CPR; sr.k1 = *(const u32x4*)(K + (size_t)(kv0 + row) * ldk + cc * 8); }
    { const int row = tid >> 3, cc = tid & 7; sr.v = *(const u32x4*)(V + (size_t)(kv0 + row) * ldv + cc * 8); }
    if (bias && tid < 64) sr.b = bias[kv0 + tid];
}
template <int DK>
__device__ __forceinline__ void stage_store(const StageRegs<DK>& sr, LAS unsigned char* lds, int buf, bool has_bias, int wid0) {
    const int tid = opaque_tid(wid0); constexpr int CPR = DK / 8; constexpr int KSTR = (DK == 96) ? KSTR96 : KSTR64;
    LAS unsigned char* kb = lds + ATT_K0 + buf * ATT_KBUF; LAS unsigned char* vb = lds + ATT_V0 + buf * ATT_VBUF;
    { const int row = tid / CPR, cc = tid % CPR; *(LAS u32x4*)(kb + row * KSTR + cc * 16) = sr.k0; }
    if (DK == 96 && tid < 256) { const int c = tid + 512, row = c / CPR, cc = c % CPR; *(LAS u32x4*)(kb + row * KSTR + cc * 16) = sr.k1; }
    { const int row = tid >> 3, cc = tid & 7; *(LAS u32x4*)(vb + (cc >> 2) * 4096 + row * 64 + (cc & 3) * 16) = sr.v; }
    if (has_bias && tid < 64) *(LAS float*)(lds + ATT_B0 + buf * 256 + tid * 4) = sr.b;
}

__device__ __forceinline__ void store_out(bf16_t* dst  , const f32x16& o0, const f32x16& o1, float scale, int hi) {
#pragma unroll
    for (int g = 0; g < 4; ++g) {
        u32x2 w; w.x = pk2(o0[4 * g] * scale, o0[4 * g + 1] * scale); w.y = pk2(o0[4 * g + 2] * scale, o0[4 * g + 3] * scale);
        *(u32x2*)(dst + 8 * g + 4 * hi) = w;
        u32x2 w1; w1.x = pk2(o1[4 * g] * scale, o1[4 * g + 1] * scale); w1.y = pk2(o1[4 * g + 2] * scale, o1[4 * g + 3] * scale);
        *(u32x2*)(dst + 32 + 8 * g + 4 * hi) = w1;
    }
}

__device__ __forceinline__ float store_out_fused(bf16_t* dst, const bf16_t* zp, const float* gp, const f32x16& o0, const f32x16& o1, float scale, int hi) {
    float ssq = 0.f;
#pragma unroll
    for (int g = 0; g < 4; ++g) {
#pragma unroll
        for (int d0 = 0; d0 < 2; ++d0) { const int c = 32 * d0 + 8 * g + 4 * hi; const u32x2 zz = *(const u32x2*)(zp + c); const f32x4 gg = *(const f32x4*)(gp + c);
            const float z0 = bflo(zz.x), z1 = bfhi(zz.x), z2 = bflo(zz.y), z3 = bfhi(zz.y);
            const float v0 = (d0 ? o1[4 * g] : o0[4 * g]) * scale, v1 = (d0 ? o1[4 * g + 1] : o0[4 * g + 1]) * scale, v2 = (d0 ? o1[4 * g + 2] : o0[4 * g + 2]) * scale, v3 = (d0 ? o1[4 * g + 3] : o0[4 * g + 3]) * scale;
            ssq += (v0 * v0 + v1 * v1) + (v2 * v2 + v3 * v3);
            u32x2 w; w.x = pk2(v0 * gg[0] * silu_fast(z0), v1 * gg[1] * silu_fast(z1)); w.y = pk2(v2 * gg[2] * silu_fast(z2), v3 * gg[3] * silu_fast(z3));
            *(u32x2*)(dst + c) = w; }
    }
    return ssq;
}

constexpr int DA_K0 = 0, DA_V0 = 3 * ATT_KBUF, DA_B0 = DA_V0 + 2 * ATT_VBUF, DA_END = DA_B0 + 3 * 256;
static_assert(DA_END <= LDS_BYTES, "dense attention LDS map");
template <int DK, int MODE>
__device__ __forceinline__ void dense_unit(LAS unsigned char* lds, const bf16_t* Q, int ldq, const bf16_t* K, int ldk, const bf16_t* V, int ldv,
                                           bf16_t* O  , const float* bias, const unsigned long long* maskbits  ,
                                           float alibiA, float c2, int qb, int wid0, const bf16_t* Zg, const float* Gn, float* ssq  ) {
    constexpr int KS = DK / 16; constexpr int KSTR = (DK == 96) ? KSTR96 : KSTR64; constexpr int CPR = DK / 8;
    const int tid = opaque_tid(wid0), lane = tid & 63, wv = __builtin_amdgcn_readfirstlane(tid >> 6), r = lane & 31, hi = lane >> 5;
    const int q0 = qb * 256, qw0 = q0 + wv * 32, tq = qw0 + r;
    const int NT = (q0 + 256) / 64;
    const int tlast = (qw0 + 31) >> 6;
    bf16x8 qf[KS];
#pragma unroll
    for (int s = 0; s < KS; ++s) qf[s] = *(const bf16x8*)(Q + (size_t)tq * ldq + s * 16 + hi * 8);
    const int vb = ((lane >> 4) & 1) * 32 + (lane & 3) * 8 + (4 * hi + ((lane & 15) >> 2)) * 64;
    const int kb = r * KSTR + hi * 16;
    SoftState st; st.m = NEG_BIG; st.l = 0.f; st.o0 = (f32x16){}; st.o1 = (f32x16){};
    const int krow0 = tid / CPR, kcc0 = tid % CPR, krow1 = (tid + 512) / CPR, kcc1 = (tid + 512) % CPR, vrow = tid >> 3, vcc = tid & 7;
    const bf16_t* kp0 = K + (size_t)krow0 * ldk + kcc0 * 8; const bf16_t* kp1 = K + (size_t)krow1 * ldk + kcc1 * 8; const bf16_t* vp = V + (size_t)vrow * ldv + vcc * 8;
    const int klds0 = krow0 * KSTR + kcc0 * 16, klds1 = krow1 * KSTR + kcc1 * 16, vlds = (vcc >> 2) * 4096 + vrow * 64 + (vcc & 3) * 16;
    u32x4 rk0, rk1, rv; float rbias = 0.f;
#define DA_LOADK(t) do { rk0 = *(const u32x4*)(kp0 + (size_t)(t) * 64 * ldk); if (DK == 96 && tid < 256) rk1 = *(const u32x4*)(kp1 + (size_t)(t) * 64 * ldk); if (MODE == 1 && tid < 64) rbias = bias[(t) * 64 + tid]; } while (0)
#define DA_LOADV(t) do { rv = *(const u32x4*)(vp + (size_t)(t) * 64 * ldv); } while (0)
#define DA_STOREK(slot) do { LAS unsigned char* kb_ = lds + DA_K0 + (slot) * ATT_KBUF; *(LAS u32x4*)(kb_ + klds0) = rk0; if (DK == 96 && tid < 256) *(LAS u32x4*)(kb_ + klds1) = rk1; \
        if (MODE == 1 && tid < 64) *(LAS float*)(lds + DA_B0 + (slot) * 256 + tid * 4) = rbias; } while (0)
#define DA_STOREV(slot) do { *(LAS u32x4*)(lds + DA_V0 + (slot) * ATT_VBUF + vlds) = rv; } while (0)
#define DA_CINIT(P0, P1, t, slot) do { const int kv0_ = (t) * 64; \
        if (MODE == 0) { P0 = (f32x16){}; P1 = (f32x16){}; } \
        else if (MODE == 1) { const LAS float* bl = (const LAS float*)(lds + DA_B0 + (slot) * 256); \
            _Pragma("unroll") for (int g = 0; g < 4; ++g) { const f32x4 b0_ = *(const LAS f32x4*)(bl + 8 * g + 4 * hi), b1_ = *(const LAS f32x4*)(bl + 32 + 8 * g + 4 * hi); \
                _Pragma("unroll") for (int e = 0; e < 4; ++e) { P0[4 * g + e] = b0_[e]; P1[4 * g + e] = b1_[e]; } } } \
        else { const float base_ = alibiA * (float)(kv0_ + 4 * hi); \
            _Pragma("unroll") for (int i = 0; i < 16; ++i) { P0[i] = base_ + alibiA * (float)((i & 3) + 8 * (i >> 2)); P1[i] = P0[i] + alibiA * 32.0f; } } } while (0)
#define DA_MASK(P0, P1, t, mb) do { const int kv0_ = (t) * 64; \
        if (MODE == 2) { const unsigned long long ms_ = (mb) >> (4 * hi); const unsigned lo_ = (unsigned)ms_, hw_ = (unsigned)(ms_ >> 32); \
            _Pragma("unroll") for (int i = 0; i < 16; ++i) { const unsigned bit_ = 1u << ((i & 3) + 8 * (i >> 2)); if (!(lo_ & bit_)) P0[i] = -INFINITY; if (!(hw_ & bit_)) P1[i] = -INFINITY; } } \
        else if (kv0_ + 63 > qw0) { \
            _Pragma("unroll") for (int i = 0; i < 16; ++i) { const int kv_ = kv0_ + crow(i, hi); if (kv_ > tq) P0[i] = -INFINITY; if (kv_ + 32 > tq) P1[i] = -INFINITY; } } } while (0)
#define DA_ROWMAX(MX, P0, P1) do { float a_ = __builtin_fmaxf(__builtin_fmaxf(P0[0], P0[1]), P1[0]), b_ = __builtin_fmaxf(__builtin_fmaxf(P0[2], P0[3]), P1[1]); a_ = __builtin_fmaxf(__builtin_fmaxf(a_, P1[2]), P1[3]); \
        _Pragma("unroll") for (int i = 4; i < 16; i += 4) { a_ = __builtin_fmaxf(__builtin_fmaxf(a_, P0[i]), P0[i + 1]); b_ = __builtin_fmaxf(__builtin_fmaxf(b_, P0[i + 2]), P0[i + 3]); a_ = __builtin_fmaxf(__builtin_fmaxf(a_, P1[i]), P1[i + 1]); b_ = __builtin_fmaxf(__builtin_fmaxf(b_, P1[i + 2]), P1[i + 3]); } \
        a_ = __builtin_fmaxf(a_, b_); const auto rr_ = __builtin_amdgcn_permlane32_swap(__float_as_uint(a_), __float_as_uint(a_), false, false); \
        MX = __builtin_fmaxf(__uint_as_float(rr_[0]), __uint_as_float(rr_[1])); } while (0)
    __syncthreads();
    DA_LOADK(0); DA_LOADV(0); DA_STOREK(0); DA_STOREV(0);
    DA_LOADK(1); DA_STOREK(1);
    DA_LOADK(2); DA_LOADV(1);
    __syncthreads();
    f32x16 pa0, pa1, pb0, pb1;
    unsigned long long mb_nxt = 0ull, mb_nn = 0ull;
    {
        DA_CINIT(pa0, pa1, 0, 0);
        qk_tile<KS>(pa0, pa1, lds + DA_K0, KSTR, qf, r, hi);
        unsigned long long mb0 = 0ull;
        if (MODE == 2) { mb0 = maskbits[(size_t)tq * 128]; if (1 <= tlast) mb_nxt = maskbits[(size_t)tq * 128 + 1]; }
        DA_MASK(pa0, pa1, 0, mb0);
        float mx; DA_ROWMAX(mx, pa0, pa1);
        st.m = __builtin_fmaxf(st.m, mx);
    }
    int ks_next = 1, ks_store = 2, vs_cur = 0;
#define DA_STEP(C0, C1, N0, N1, t) do { \
        if (MODE == 2) { mb_nn = 0ull; if ((t) + 2 <= tlast) mb_nn = maskbits[(size_t)tq * 128 + (t) + 2]; } \
        if ((t) <= tlast) { \
              \
            DA_CINIT(N0, N1, (t) + 1, ks_next); \
            bf16x8 pf0, pf1, pf2, pf3; \
            bf16x8 kf[2 * KS]; { const LAS unsigned char* k_ = lds + DA_K0 + ks_next * ATT_KBUF + kb; \
                _Pragma("unroll") for (int s_ = 0; s_ < KS; ++s_) { kf[2 * s_] = *(const LAS bf16x8*)(k_ + s_ * 32); kf[2 * s_ + 1] = *(const LAS bf16x8*)(k_ + 32 * KSTR + s_ * 32); } } \
            __builtin_amdgcn_sched_barrier(0); \
            _Pragma("unroll") for (int s_ = 0; s_ < KS; ++s_) { N0 = __builtin_amdgcn_mfma_f32_32x32x16_bf16(kf[2 * s_], qf[s_], N0, 0, 0, 0); N1 = __builtin_amdgcn_mfma_f32_32x32x16_bf16(kf[2 * s_ + 1], qf[s_], N1, 0, 0, 0); } \
            sm_exp_pack(st, C0, C1, c2, pf0, pf1, pf2, pf3); \
            _Pragma("unroll") for (int g_ = 0; g_ < 2 * KS; ++g_) { __builtin_amdgcn_sched_group_barrier(0x8, 1, 0); __builtin_amdgcn_sched_group_barrier(0x2, (KS == 6 ? 9 : 14), 0); } \
            __builtin_amdgcn_sched_barrier(0); \
              \
            bf16x8 vf[8]; { const LAS unsigned char* v_ = lds + DA_V0 + vs_cur * ATT_VBUF + vb; \
                _Pragma("unroll") for (int s_ = 0; s_ < 4; ++s_) { vf[2 * s_] = vfrag(v_ + s_ * 1024); vf[2 * s_ + 1] = vfrag(v_ + 4096 + s_ * 1024); } } \
            __builtin_amdgcn_sched_barrier(0); \
            float mx_ = -INFINITY; \
            if ((t) < tlast) { DA_MASK(N0, N1, (t) + 1, mb_nxt); DA_ROWMAX(mx_, N0, N1); } \
            __builtin_amdgcn_sched_barrier(0); \
            st.o0 = __builtin_amdgcn_mfma_f32_32x32x16_bf16(vf[0], pf0, st.o0, 0, 0, 0); st.o1 = __builtin_amdgcn_mfma_f32_32x32x16_bf16(vf[1], pf0, st.o1, 0, 0, 0); \
            st.o0 = __builtin_amdgcn_mfma_f32_32x32x16_bf16(vf[2], pf1, st.o0, 0, 0, 0); st.o1 = __builtin_amdgcn_mfma_f32_32x32x16_bf16(vf[3], pf1, st.o1, 0, 0, 0); \
            st.o0 = __builtin_amdgcn_mfma_f32_32x32x16_bf16(vf[4], pf2, st.o0, 0, 0, 0); st.o1 = __builtin_amdgcn_mfma_f32_32x32x16_bf16(vf[5], pf2, st.o1, 0, 0, 0); \
            st.o0 = __builtin_amdgcn_mfma_f32_32x32x16_bf16(vf[6], pf3, st.o0, 0, 0, 0); st.o1 = __builtin_amdgcn_mfma_f32_32x32x16_bf16(vf[7], pf3, st.o1, 0, 0, 0); \
            __builtin_amdgcn_sched_barrier(0); \
            if (__any((mx_ - st.m) * c2 > SM_THR)) { const float mn_ = __builtin_fmaxf(st.m, mx_); const float al_ = __builtin_amdgcn_exp2f((st.m - mn_) * c2); st.l *= al_; st.o0 *= al_; st.o1 *= al_; st.m = mn_; } \
        } \
        if ((t) + 2 < NT) DA_STOREK(ks_store); \
        if ((t) + 1 < NT) DA_STOREV(vs_cur ^ 1); \
        if ((t) + 3 < NT) DA_LOADK((t) + 3); \
        if ((t) + 2 < NT) DA_LOADV((t) + 2); \
        __syncthreads(); \
        mb_nxt = mb_nn; vs_cur ^= 1; ks_next = (ks_next == 2) ? 0 : ks_next + 1; ks_store = (ks_store == 2) ? 0 : ks_store + 1; } while (0)
    for (int t = 0; t < NT; t += 2) {
        DA_STEP(pa0, pa1, pb0, pb1, t);
        DA_STEP(pb0, pb1, pa0, pa1, t + 1);
    }
#undef DA_LOADK
#undef DA_LOADV
#undef DA_STOREK
#undef DA_STOREV
#undef DA_CINIT
#undef DA_MASK
#undef DA_ROWMAX
#undef DA_STEP
    const float l = swap32_sum(st.l);
    const float inv = l > 0.f ? 1.0f / l : 0.f;
    const float sq = swap32_sum(store_out_fused(O + (size_t)tq * D, Zg + (size_t)tq * NP, Gn, st.o0, st.o1, inv, hi));
    if (hi == 0) ssq[(size_t)tq * 16] = sq;
}

#define A64_SBAR() __builtin_amdgcn_sched_barrier(0)
#define A64_PIN(x) asm volatile("" : "+v"(x))
#define A64_MFMA(a, b, c) __builtin_amdgcn_mfma_f32_32x32x16_bf16(a, b, c, 0, 0, 0)
constexpr int A64_VSLOT = 8192, A64_K = 0, A64_V = 3 * 12288  , A64_WS = A64_V + 3 * A64_VSLOT, A64_OST = A64_WS + 8 * 256, A64_SIDE = A64_OST + 8 * 4096, A64_END = A64_SIDE + 3 * 2048;
static_assert(A64_END <= LDS_BYTES - 16, "attn64 LDS map");
template <int N> __device__ __forceinline__ void a64_wait_bar() { asm volatile("s_waitcnt vmcnt(%0) lgkmcnt(0)\n\ts_barrier" :: "n"(N) : "memory"); }
__device__ __forceinline__ void a64_glds16(const void* g, unsigned lds_base) {
    unsigned sv; asm volatile("s_mov_b32 %0, m0\n\ts_mov_b32 m0, %2\n\ts_nop 0\n\tglobal_load_lds_dwordx4 %1, off\n\ts_mov_b32 m0, %0" : "=&s"(sv) : "v"(g), "s"(lds_base) : "memory"); }
__device__ __forceinline__ void a64_glds4(const void* g, unsigned lds_base) {
    unsigned sv; asm volatile("s_mov_b32 %0, m0\n\ts_mov_b32 m0, %2\n\ts_nop 0\n\tglobal_load_lds_dword %1, off\n\ts_mov_b32 m0, %0" : "=&s"(sv) : "v"(g), "s"(lds_base) : "memory"); }
__device__ __forceinline__ void a64_kload2(bf16x8* kf, const LAS unsigned char* kp, int d0) { kf[2 * d0] = *(const LAS bf16x8*)(kp + d0 * 2048); kf[2 * d0 + 1] = *(const LAS bf16x8*)(kp + d0 * 2048 + 512); }
__device__ __forceinline__ s16x4 a64_vtr(const LAS unsigned char* p) { return __builtin_bit_cast(s16x4, __builtin_amdgcn_ds_read_tr16_b64_v4i16((LAS s16x4*)p)); }
#define A64_MX3(a, b, c) __builtin_fmaxf(__builtin_fmaxf((a), (b)), (c))
__device__ __forceinline__ float a64_max16(const f32x16& p) {
    float a = A64_MX3(p[0], p[1], p[2]), b = A64_MX3(p[3], p[4], p[5]); a = A64_MX3(a, p[6], p[7]); b = A64_MX3(b, p[8], p[9]); a = A64_MX3(a, p[10], p[11]); b = A64_MX3(b, p[12], p[13]);
    return A64_MX3(a, b, __builtin_fmaxf(p[14], p[15])); }
__device__ __forceinline__ float a64_swapmax(float m) { const auto rr = __builtin_amdgcn_permlane32_swap(__float_as_uint(m), __float_as_uint(m), false, false); return __builtin_fmaxf(__uint_as_float(rr[0]), __uint_as_float(rr[1])); }
__device__ __forceinline__ void a64_cmask(f32x16& p0, f32x16& p1, int jb, int qrel, int hi) {
    const int kb = 64 * jb + 4 * hi;
#pragma unroll
    for (int r = 0; r < 16; ++r) { const int kv = kb + (r & 3) + 8 * (r >> 2); if (kv > qrel) p0[r] = -INFINITY; if (kv + 32 > qrel) p1[r] = -INFINITY; } }
__device__ __forceinline__ void a64_dmask(f32x16& p0, f32x16& p1, unsigned long long mw, int hi) {
    const unsigned long long ms = mw >> (4 * hi); const unsigned lo = (unsigned)ms, hw = (unsigned)(ms >> 32);
#pragma unroll
    for (int i = 0; i < 16; ++i) { const unsigned bit = 1u << ((i & 3) + 8 * (i >> 2)); if (!(lo & bit)) p0[i] = -INFINITY; if (!(hw & bit)) p1[i] = -INFINITY; } }

template <int MODE, int DK>
__device__ __forceinline__ void attn64_unit(LAS unsigned char* lds, const bf16_t* Q, int ldq, const bf16_t* K, int ld  , const bf16_t* V, int ldv,
                                            bf16_t* O  , const float* bias  , const unsigned long long* maskbits  ,
                                            float alibiA, float C2  , int qb, int wid0, const bf16_t* Zg, const float* Gn, float* ssq  ) {
    constexpr float THR = 24.0f;     constexpr int KS = DK / 16, KSLOT = (DK == 96) ? 12288 : 8192;
    constexpr int KOPS = ((MODE == 0) ? 1 : 2) + ((DK == 96) ? 1 : 0);
    const int tid = opaque_tid(wid0), lane = tid & 63, r32 = lane & 31, hi = lane >> 5; const int wid = __builtin_amdgcn_readfirstlane(tid >> 6);
    const int q0 = qb * 256, NT = (q0 + 256) / 64, qw0 = q0 + wid * 32;
    const bf16_t* Qw = Q + (size_t)qw0 * ldq;
    const unsigned lds0 = (unsigned)(size_t)lds; LAS float* wsf = (LAS float*)(lds + A64_WS) + wid * 64;
    const bf16_t* ksrc = K + (size_t)lane * ld + wid * 8;
    const bf16_t* ksrc2 = K + (size_t)lane * ld + (8 + (wid & 3)) * 8;
    const bf16_t* vsrc = V + (size_t)(16 * (wid & 3) + (lane >> 2)) * ldv + (wid >> 2) * 32 + (lane & 3) * 8;
    const unsigned* ssrc = (MODE == 1) ? (const unsigned*)(bias + lane) : (MODE == 2) ? (const unsigned*)(maskbits + (size_t)(qw0 + (lane >> 1)) * 128) + (lane & 1) : nullptr;
    constexpr int SSTEP = (MODE == 1) ? 64 : 2;
    const unsigned kdst = lds0 + A64_K + wid * 1024, kdst2 = lds0 + A64_K + (8 + (wid & 3)) * 1024, vdst = lds0 + A64_V + wid * 1024, sdst = lds0 + A64_SIDE + wid * 256;
#define A64_DMA_K(t, slot) do { a64_glds16(ksrc + (size_t)(t) * 64 * ld, (unsigned)__builtin_amdgcn_readfirstlane(kdst + (slot) * KSLOT)); \
        if (DK == 96) a64_glds16(ksrc2 + (size_t)(t) * 64 * ld, (unsigned)__builtin_amdgcn_readfirstlane(kdst2 + (slot) * KSLOT)); \
        if (MODE != 0) a64_glds4(ssrc + (size_t)(t) * SSTEP, (unsigned)__builtin_amdgcn_readfirstlane(sdst + (slot) * 2048)); } while (0)
#define A64_DMA_V(t, slot) a64_glds16(vsrc + (size_t)(t) * 64 * ldv, (unsigned)__builtin_amdgcn_readfirstlane(vdst + (slot) * A64_VSLOT))
    const LAS unsigned char* vp0 = lds + A64_V + ((lane >> 4) & 1) * 32 + (lane & 3) * 8 + (4 * hi + ((lane & 15) >> 2)) * 64;
    const LAS unsigned char* kp0 = lds + A64_K + hi * 1024 + r32 * 16;
    const LAS unsigned char* sp0 = lds + A64_SIDE + wid * 256;
    __syncthreads();
    A64_DMA_K(0, 0); A64_DMA_V(0, 0); A64_DMA_K(1, 1);
    bf16x8 qr[KS];
#pragma unroll
    for (int d0 = 0; d0 < KS; ++d0) qr[d0] = *(const bf16x8*)(Qw + (size_t)r32 * ldq + d0 * 16 + hi * 8);
    float mhat = 0.f, l_reg = 0.f; f32x16 o[2]; o[0] = (f32x16){}; o[1] = (f32x16){};
    f32x16 cini = (f32x16){};
    if (MODE == 2) {
#pragma unroll
        for (int i = 0; i < 16; ++i) cini[i] = alibiA * (float)((i & 3) + 8 * (i >> 2) + 4 * hi); }
    if (MODE != 0) A64_PIN(cini);
    const float ea = (MODE == 2) ? alibiA * C2 : 0.f;
    const int qrel = wid * 32 + r32; bool resc = false;
    f32x16 pA0, pA1, pB0, pB1; bf16x8 kf[2 * KS]; s16x4 vlo[8], vhi[8]; u32x4 pw0, pw1, pw2, pw3;
    int sl_prev = 0, sl_cur = 0, sl_next = 1;
#define A64_ROT() do { sl_prev = sl_cur; sl_cur = sl_next; sl_next = (sl_next == 2) ? 0 : sl_next + 1; } while (0)
#define A64_EX(v, NM) __builtin_amdgcn_exp2f(__builtin_fmaf((v), C2, NM))
#define A64_RESC() do { if (resc) { _Pragma("unroll") for (int d_ = 0; d_ < 2; ++d_) _Pragma("unroll") for (int r = 0; r < 16; ++r) o[d_][r] *= wsf[crow(r, hi)]; } } while (0)
#define A64_CINIT(C0, C1, slot) do { if (MODE == 1) { const LAS float* bl_ = (const LAS float*)(sp0 + (slot) * 2048); \
        _Pragma("unroll") for (int g_ = 0; g_ < 4; ++g_) { const f32x4 b0_ = *(const LAS f32x4*)(bl_ + 8 * g_ + 4 * hi), b1_ = *(const LAS f32x4*)(bl_ + 32 + 8 * g_ + 4 * hi); \
            _Pragma("unroll") for (int e_ = 0; e_ < 4; ++e_) { C0[4 * g_ + e_] = b0_[e_]; C1[4 * g_ + e_] = b1_[e_]; } } } \
        else if (MODE == 0) { C0 = (f32x16){}; C1 = (f32x16){}; }     \
        else { C0 = cini; C1 = cini; } } while (0)
#define A64_ROWREF(C0, C1, t) a64_swapmax(__builtin_fmaxf(__builtin_fmaf(a64_max16(C0), C2, ea * (float)(64 * (t))), __builtin_fmaf(a64_max16(C1), C2, ea * (float)(64 * (t) + 32))))
    A64_DMA_K(2, 2);
    a64_wait_bar<2 * KOPS + 1>();
    _Pragma("unroll") for (int d0 = 0; d0 < KS; ++d0) a64_kload2(kf, kp0, d0);
    { unsigned long long mw0 = 0ull; if (MODE == 2) mw0 = *(const LAS unsigned long long*)(sp0 + r32 * 8);
      A64_CINIT(pA0, pA1, 0);
      _Pragma("unroll") for (int d0 = 0; d0 < KS; ++d0) { pA0 = A64_MFMA(kf[2 * d0], qr[d0], pA0); pA1 = A64_MFMA(kf[2 * d0 + 1], qr[d0], pA1); }
      if (MODE == 2) a64_dmask(pA0, pA1, mw0, hi);
      if (NT == 4) a64_cmask(pA0, pA1, 0, qrel, hi); }
    { mhat = __builtin_fmaxf(A64_ROWREF(pA0, pA1, 0), -1e30f); const float nm0 = -mhat, nm1 = ea * 32.0f - mhat;
#pragma unroll
      for (int r = 0; r < 16; ++r) { pA0[r] = A64_EX(pA0[r], nm0); pA1[r] = A64_EX(pA1[r], nm1); } }
    a64_wait_bar<0>();
    A64_DMA_K(3, 0); A64_DMA_V(1, 1); A64_ROT();
    _Pragma("unroll") for (int d0 = 0; d0 < KS; ++d0) a64_kload2(kf, kp0 + sl_cur * KSLOT, d0);
    if (MODE == 1) A64_CINIT(pB0, pB1, sl_cur);
    a64_wait_bar<KOPS + 1>();
#define A64_PKW(P, i) pk2(P[i], P[i + 1])
#define A64_PAF(k) __builtin_bit_cast(bf16x8, pw##k)
#define A64_VFR(i) (bf16x8){vlo[i][0], vlo[i][1], vlo[i][2], vlo[i][3], vhi[i][0], vhi[i][1], vhi[i][2], vhi[i][3]}
#define A64_VRD(i) do { vlo[i] = a64_vtr(vp_ + (((i) >> 2) * 4096 + ((i) & 3) * 1024)); vhi[i] = a64_vtr(vp_ + (((i) >> 2) * 4096 + ((i) & 3) * 1024 + 512)); } while (0)
#define A64_BRD(G, P0, P1, g_) do { if (MODE == 1 && (G)) { const LAS float* bl_ = (const LAS float*)(sp0 + sl_next * 2048); \
        const f32x4 b0_ = *(const LAS f32x4*)(bl_ + 8 * (g_) + 4 * hi), b1_ = *(const LAS f32x4*)(bl_ + 32 + 8 * (g_) + 4 * hi); \
        _Pragma("unroll") for (int e_ = 0; e_ < 4; ++e_) { P0[4 * (g_) + e_] = b0_[e_]; P1[4 * (g_) + e_] = b1_[e_]; } } } while (0)
#define A64_KRD(G, d0) do { if (G) { a64_kload2(kf, kp0 + sl_next * KSLOT, d0); A64_SBAR(); } } while (0)
#define A64_GAPA(MF, a0, a1, a2, a3, W0, W1, PW) do { MF; sacc += a0; sacc += a1; sacc += a2; sacc += a3; W0; W1; A64_PIN(PW); A64_PIN(sacc); A64_SBAR(); } while (0)
#define A64_GAPB(MF, X, i, NM) do { MF; X[i] = A64_EX(X[i], NM); X[i + 1] = A64_EX(X[i + 1], NM); X[i + 2] = A64_EX(X[i + 2], NM); X[i + 3] = A64_EX(X[i + 3], NM); A64_PIN(X); A64_SBAR(); } while (0)
#define A64_STEP(C0, C1, P0, P1, t, MASK, GK, GV, GL) do { A64_SBAR(); \
    unsigned long long mw_ = 0ull; if (MODE == 2) { mw_ = *(const LAS unsigned long long*)(sp0 + sl_cur * 2048 + r32 * 8); } \
    if (MODE != 1) A64_CINIT(C0, C1, sl_cur);     \
    const LAS unsigned char* vp_ = vp0 + sl_prev * A64_VSLOT; \
    A64_VRD(0); A64_SBAR(); float sacc = P0[0] + P0[1]; \
                    A64_GAPA(C0 = A64_MFMA(kf[0], qr[0], C0), P0[2], P0[3], P0[4], P0[5],     pw0[0] = A64_PKW(P0, 0),  pw0[1] = A64_PKW(P0, 2),  pw0); \
    A64_VRD(4); A64_SBAR(); A64_GAPA(C1 = A64_MFMA(kf[1], qr[0], C1), P0[6], P0[7], P0[8], P0[9],     pw0[2] = A64_PKW(P0, 4),  pw0[3] = A64_PKW(P0, 6),  pw0); \
    A64_VRD(1); A64_SBAR(); A64_GAPA(C0 = A64_MFMA(kf[2], qr[1], C0),    P0[10], P0[11], P0[12], P0[13], pw1[0] = A64_PKW(P0, 8),  pw1[1] = A64_PKW(P0, 10), pw1); \
    A64_VRD(5); A64_SBAR(); A64_GAPA(C1 = A64_MFMA(kf[3], qr[1], C1),    P0[14], P0[15], P1[0], P1[1],   pw1[2] = A64_PKW(P0, 12), pw1[3] = A64_PKW(P0, 14), pw1); \
    A64_VRD(2); A64_SBAR(); A64_GAPA(C0 = A64_MFMA(kf[4], qr[2], C0),    P1[2], P1[3], P1[4], P1[5],     pw2[0] = A64_PKW(P1, 0),  pw2[1] = A64_PKW(P1, 2),  pw2); \
    A64_VRD(6); A64_SBAR(); A64_GAPA(C1 = A64_MFMA(kf[5], qr[2], C1),    P1[6], P1[7], P1[8], P1[9],     pw2[2] = A64_PKW(P1, 4),  pw2[3] = A64_PKW(P1, 6),  pw2); \
    A64_VRD(3); A64_SBAR(); A64_GAPA(C0 = A64_MFMA(kf[6], qr[3], C0),    P1[10], P1[11], P1[12], P1[13], pw3[0] = A64_PKW(P1, 8),  pw3[1] = A64_PKW(P1, 10), pw3); \
    A64_VRD(7); A64_SBAR(); A64_GAPA(C1 = A64_MFMA(kf[7], qr[3], C1),    P1[14], P1[15], 0.f, 0.f,       pw3[2] = A64_PKW(P1, 12), pw3[3] = A64_PKW(P1, 14), pw3); \
    if (KS == 6) { C0 = A64_MFMA(kf[8], qr[4], C0); C1 = A64_MFMA(kf[9], qr[4], C1); C0 = A64_MFMA(kf[10], qr[5], C0); C1 = A64_MFMA(kf[11], qr[5], C1); A64_SBAR(); } \
    l_reg += sacc; \
    if (MODE == 2) { unsigned ml_ = (unsigned)mw_, mh_ = (unsigned)(mw_ >> 32); A64_PIN(ml_); A64_PIN(mh_); mw_ = ((unsigned long long)mh_ << 32) | ml_; }     \
    if (GK) A64_DMA_K((t) + 3, sl_cur); if (GV) A64_DMA_V((t) + 1, sl_next); \
    if (MODE == 2) a64_dmask(C0, C1, mw_, hi); \
    if (MASK) a64_cmask(C0, C1, (t) - (NT - 4), qrel, hi); \
    { const float rs_ = A64_ROWREF(C0, C1, t); resc = false; \
      if (__builtin_expect(__any(rs_ - mhat > THR), 0)) { const float mn_ = __builtin_fmaxf(mhat, rs_); const float f_ = __builtin_amdgcn_exp2f(mhat - mn_); mhat = mn_; \
          l_reg *= f_; if (hi == 0) wsf[r32] = f_; resc = true; } } \
    const float nm0_ = ea * (float)(64 * (t)) - mhat, nm1_ = ea * (float)(64 * (t) + 32) - mhat; A64_SBAR(); \
    A64_GAPB(o[0] = A64_MFMA(A64_PAF(0), A64_VFR(0), o[0]), C0, 0, nm0_);              A64_GAPB(o[1] = A64_MFMA(A64_PAF(0), A64_VFR(4), o[1]), C0, 4, nm0_); \
    A64_KRD(GL, 0); A64_BRD(GL, P0, P1, 0); A64_GAPB(o[0] = A64_MFMA(A64_PAF(1), A64_VFR(1), o[0]), C0, 8, nm0_);  A64_KRD(GL, 1); A64_BRD(GL, P0, P1, 1); A64_GAPB(o[1] = A64_MFMA(A64_PAF(1), A64_VFR(5), o[1]), C0, 12, nm0_); \
    A64_KRD(GL, 2); A64_BRD(GL, P0, P1, 2); A64_GAPB(o[0] = A64_MFMA(A64_PAF(2), A64_VFR(2), o[0]), C1, 0, nm1_);  A64_KRD(GL, 3); A64_BRD(GL, P0, P1, 3); A64_GAPB(o[1] = A64_MFMA(A64_PAF(2), A64_VFR(6), o[1]), C1, 4, nm1_); \
    if (KS == 6) A64_KRD(GL, 4); A64_GAPB(o[0] = A64_MFMA(A64_PAF(3), A64_VFR(3), o[0]), C1, 8, nm1_);  if (KS == 6) A64_KRD(GL, 5); A64_GAPB(o[1] = A64_MFMA(A64_PAF(3), A64_VFR(7), o[1]), C1, 12, nm1_); \
    } while (0)
    int t = 1;
    for (; t + 5 < NT; t += 2) {
        A64_STEP(pB0, pB1, pA0, pA1, t, false, true, true, true);     a64_wait_bar<KOPS + 1>(); A64_RESC(); A64_ROT();
        A64_STEP(pA0, pA1, pB0, pB1, t + 1, false, true, true, true); a64_wait_bar<KOPS + 1>(); A64_RESC(); A64_ROT();
    }
#define A64_ENDW(tt) do { if ((tt) + 3 < NT) { a64_wait_bar<KOPS + 1>(); } else if ((tt) + 2 < NT) { a64_wait_bar<1>(); } else { a64_wait_bar<0>(); } } while (0)
    for (; t + 1 < NT; t += 2) {
        A64_STEP(pB0, pB1, pA0, pA1, t, true, (t + 3 < NT), (t + 1 < NT), (t + 1 < NT));         A64_ENDW(t);     A64_RESC(); A64_ROT();
        A64_STEP(pA0, pA1, pB0, pB1, t + 1, true, (t + 4 < NT), (t + 2 < NT), (t + 2 < NT));     A64_ENDW(t + 1); A64_RESC(); A64_ROT();
    }
    A64_STEP(pB0, pB1, pA0, pA1, NT - 1, true, false, false, false); A64_RESC();
    { float sacc = pB0[0] + pB0[1];
#pragma unroll
      for (int r = 2; r < 16; ++r) sacc += pB0[r];
#pragma unroll
      for (int r = 0; r < 16; ++r) sacc += pB1[r];
      l_reg += sacc;
      pw0 = (u32x4){A64_PKW(pB0, 0), A64_PKW(pB0, 2), A64_PKW(pB0, 4), A64_PKW(pB0, 6)}; pw1 = (u32x4){A64_PKW(pB0, 8), A64_PKW(pB0, 10), A64_PKW(pB0, 12), A64_PKW(pB0, 14)};
      pw2 = (u32x4){A64_PKW(pB1, 0), A64_PKW(pB1, 2), A64_PKW(pB1, 4), A64_PKW(pB1, 6)}; pw3 = (u32x4){A64_PKW(pB1, 8), A64_PKW(pB1, 10), A64_PKW(pB1, 12), A64_PKW(pB1, 14)};
      const LAS unsigned char* vp_ = vp0 + sl_cur * A64_VSLOT; _Pragma("unroll") for (int i = 0; i < 8; ++i) A64_VRD(i);
      o[0] = A64_MFMA(A64_PAF(0), A64_VFR(0), o[0]); o[1] = A64_MFMA(A64_PAF(0), A64_VFR(4), o[1]); o[0] = A64_MFMA(A64_PAF(1), A64_VFR(1), o[0]); o[1] = A64_MFMA(A64_PAF(1), A64_VFR(5), o[1]);
      o[0] = A64_MFMA(A64_PAF(2), A64_VFR(2), o[0]); o[1] = A64_MFMA(A64_PAF(2), A64_VFR(6), o[1]); o[0] = A64_MFMA(A64_PAF(3), A64_VFR(3), o[0]); o[1] = A64_MFMA(A64_PAF(3), A64_VFR(7), o[1]); }
    l_reg = swap32_sum(l_reg);
    if (hi == 0) wsf[32 + r32] = l_reg; asm volatile("s_waitcnt lgkmcnt(0)" ::: "memory");
    float rli[16];
#pragma unroll
    for (int r = 0; r < 16; ++r) rli[r] = __builtin_amdgcn_rcpf(wsf[32 + crow(r, hi)]);
    LAS bf16_t* stg = (LAS bf16_t*)(lds + A64_OST) + wid * 2048;
#pragma unroll
    for (int r = 0; r < 16; ++r) { const int orow = crow(r, hi);
#pragma unroll
        for (int d0 = 0; d0 < 2; ++d0) stg[orow * 64 + d0 * 32 + r32] = (bf16_t)pk2(o[d0][r] * rli[r], 0.f); }
    asm volatile("s_waitcnt lgkmcnt(0)" ::: "memory");
#pragma unroll
    for (int i = 0; i < 4; ++i) { const int row = i * 8 + (lane >> 3), ch = lane & 7; const size_t grow = (size_t)(qw0 + row);
        const u32x4 vv = *(const LAS u32x4*)(stg + row * 64 + ch * 8); const u32x4 zz = *(const u32x4*)(Zg + grow * NP + ch * 8);
        const f32x4 g0 = *(const f32x4*)(Gn + ch * 8), g1 = *(const f32x4*)(Gn + ch * 8 + 4);
        float sq = 0.f; u32x4 w;
#pragma unroll
        for (int e = 0; e < 4; ++e) { const float va = bflo(vv[e]), vb_ = bfhi(vv[e]); sq += va * va + vb_ * vb_;
            const float ga = (e < 2) ? g0[2 * e] : g1[2 * e - 4], gb = (e < 2) ? g0[2 * e + 1] : g1[2 * e - 3];
            w[e] = pk2(va * ga * silu_fast(bflo(zz[e])), vb_ * gb * silu_fast(bfhi(zz[e]))); }
        *(u32x4*)(O + grow * D + ch * 8) = w;
        sq += quad_xor1(sq); sq += quad_xor2(sq);
        sq += __builtin_bit_cast(float, __builtin_amdgcn_update_dpp(0, __builtin_bit_cast(int, sq), 0x141, 0xf, 0xf, false));
        if (ch == 0) ssq[grow * 16] = sq; }
    asm volatile("s_waitcnt lgkmcnt(0)\n\ts_barrier" ::: "memory");
#undef A64_DMA_K
#undef A64_DMA_V
#undef A64_ROT
#undef A64_EX
#undef A64_RESC
#undef A64_CINIT
#undef A64_ROWREF
#undef A64_PKW
#undef A64_PAF
#undef A64_VFR
#undef A64_VRD
#undef A64_KRD
#undef A64_BRD
#undef A64_ENDW
#undef A64_GAPA
#undef A64_GAPB
#undef A64_STEP
}

constexpr int DSA_H1 = 0, DSA_H2 = 65536, DSA_INFO = 65536 + 32768;
__device__ __forceinline__ unsigned score_key32(float s) { const unsigned u = __float_as_uint(s); return u ^ ((unsigned)((int)u >> 31) | 0x80000000u); }
__device__ __forceinline__ unsigned score_key16(float s) { return score_key32(s) >> 16; }
__device__ __forceinline__ float key32_to_float(unsigned k) { return __uint_as_float((k & 0x80000000u) ? (k ^ 0x80000000u) : ~k); }
__device__ __forceinline__ float relu_f(float x) { const int b_ = __builtin_bit_cast(int, x); return __builtin_bit_cast(float, b_ > 0 ? b_ : 0); }

struct KFrag { bf16x8 a00, a01, a10, a11; };
__device__ __forceinline__ void dsa_kload(KFrag& f, const bf16_t* kix  , int t, int r, int hi) {
    const bf16_t* p = kix + ((size_t)t * 64 + r) * 32 + hi * 8;
    f.a00 = *(const bf16x8*)p; f.a01 = *(const bf16x8*)(p + 16); f.a10 = *(const bf16x8*)(p + 1024); f.a11 = *(const bf16x8*)(p + 1024 + 16);
}
__device__ __forceinline__ void dsa_scores(f32x16& s0, f32x16& s1, const KFrag& f, const bf16x8 (&qi)[4][2], const float (&w)[4]) {
    s0 = (f32x16){}; s1 = (f32x16){};
#pragma unroll
    for (int ih = 0; ih < 4; ++ih) {
        f32x16 a = __builtin_amdgcn_mfma_f32_32x32x16_bf16(f.a00, qi[ih][0], (f32x16){}, 0, 0, 0); a = __builtin_amdgcn_mfma_f32_32x32x16_bf16(f.a01, qi[ih][1], a, 0, 0, 0);
        f32x16 c = __builtin_amdgcn_mfma_f32_32x32x16_bf16(f.a10, qi[ih][0], (f32x16){}, 0, 0, 0); c = __builtin_amdgcn_mfma_f32_32x32x16_bf16(f.a11, qi[ih][1], c, 0, 0, 0);
#pragma unroll
        for (int i = 0; i < 16; ++i) { s0[i] = __builtin_fmaf(w[ih], relu_f(a[i]), s0[i]); s1[i] = __builtin_fmaf(w[ih], relu_f(c[i]), s1[i]); }
    }
}
__device__ __forceinline__ void hist_add(LAS unsigned* hrow, int r, unsigned bin) { atomicAdd((unsigned*)(hrow + ((bin >> 1) ^ (unsigned)r)), 1u << ((bin & 1u) * 16u)); }

__device__ __forceinline__ void dsa_index_unit(LAS unsigned char* lds, const bf16_t* proj, const bf16_t* kidx, const float* side, unsigned long long* maskbits, int b, int qg, int wid0) {
    const int tid = opaque_tid(wid0), lane = tid & 63, wv = __builtin_amdgcn_readfirstlane(tid >> 6), r = lane & 31, hi = lane >> 5;
    const int tq = qg * 32 + r; const size_t rowq = (size_t)b * S + tq;
    const int nt = (qg >> 1) + 1;
    const int per = (nt + 7) >> 3; const int t_lo = wv * per, t_hi = (t_lo + per < nt) ? t_lo + per : nt;
    bf16x8 qi[4][2]; float w[4];
#pragma unroll
    for (int ih = 0; ih < 4; ++ih) { qi[ih][0] = *(const bf16x8*)(proj + rowq * NP + C_IQ + ih * 32 + hi * 8); qi[ih][1] = *(const bf16x8*)(proj + rowq * NP + C_IQ + ih * 32 + 16 + hi * 8);
        w[ih] = side[rowq * 32 + 4 + ih] * 0.5f; }
    LAS unsigned* h1 = (LAS unsigned*)(lds + DSA_H1) + r * 512; LAS unsigned* h2 = (LAS unsigned*)(lds + DSA_H2) + wv * 1024 + r * 32;
    LAS int* info = (LAS int*)(lds + DSA_INFO);
    const bf16_t* kix = kidx + (size_t)b * S * 32;
    const bool sel_all = (qg < 8);
    __syncthreads();
    if (!sel_all) {
        for (int i = tid; i < (DSA_INFO) / 16; i += NTHREADS) ((LAS u32x4*)lds)[i] = (u32x4){0u, 0u, 0u, 0u};
        __syncthreads();
        if (t_lo < t_hi) {
            KFrag cur, nxt; dsa_kload(cur, kix, t_lo, r, hi);
            for (int t = t_lo; t < t_hi; ++t) {
                if (t + 1 < t_hi) dsa_kload(nxt, kix, t + 1, r, hi);
                f32x16 s0, s1; dsa_scores(s0, s1, cur, qi, w);
                const int kv0 = t * 64;
                if (kv0 + 63 <= qg * 32) {
#pragma unroll
                    for (int i = 0; i < 16; ++i) { hist_add(h1, r, score_key32(s0[i]) >> 22); hist_add(h1, r, score_key32(s1[i]) >> 22); }
                } else {
#pragma unroll
                    for (int i = 0; i < 16; ++i) { const int kv = kv0 + crow(i, hi);
                        if (kv <= tq) hist_add(h1, r, score_key32(s0[i]) >> 22);
                        if (kv + 32 <= tq) hist_add(h1, r, score_key32(s1[i]) >> 22); }
                }
                cur = nxt;
            }
        }
        __syncthreads();
        { const int row = tid >> 4, part = tid & 15; const LAS unsigned* hr = (const LAS unsigned*)(lds + DSA_H1) + row * 512; unsigned cs = 0;
#pragma unroll 8
          for (int j = 0; j < 32; ++j) { const unsigned wd = hr[(part * 32 + j) ^ row]; cs += (wd & 0xffffu) + (wd >> 16); }
          unsigned suf = cs;
#pragma unroll
          for (int o = 1; o < 16; o <<= 1) { const unsigned t = __shfl_down(suf, o, 16); if (part + o < 16) suf += t; }
          const unsigned above = suf - cs;
          if (above < 256u && above + cs >= 256u) { unsigned acc = above; int bsel = part * 64; unsigned ab = above;
              for (int j = 31; j >= 0; --j) { const unsigned wd = hr[(part * 32 + j) ^ row]; const unsigned c1 = wd >> 16, c0 = wd & 0xffffu;
                  if (acc + c1 >= 256u) { bsel = part * 64 + 2 * j + 1; ab = acc; break; } acc += c1;
                  if (acc + c0 >= 256u) { bsel = part * 64 + 2 * j; ab = acc; break; } acc += c0; }
              info[row] = bsel; info[32 + row] = 256 - (int)ab; } }
        __syncthreads();
        const unsigned B1 = (unsigned)info[r];
        const float blo = key32_to_float(B1 << 22), bhi = (B1 >= 1023u) ? INFINITY : key32_to_float((B1 + 1u) << 22);
        if (t_lo < t_hi) {
            KFrag cur, nxt; dsa_kload(cur, kix, t_lo, r, hi);
            for (int t = t_lo; t < t_hi; ++t) {
                if (t + 1 < t_hi) dsa_kload(nxt, kix, t + 1, r, hi);
                f32x16 s0, s1; dsa_scores(s0, s1, cur, qi, w);
                const int kv0 = t * 64;
                if (kv0 + 63 <= qg * 32) {
#pragma unroll
                    for (int i = 0; i < 16; ++i) {
                        if (s0[i] >= blo && s0[i] < bhi) hist_add(h2, r, (score_key32(s0[i]) >> 16) & 63u);
                        if (s1[i] >= blo && s1[i] < bhi) hist_add(h2, r, (score_key32(s1[i]) >> 16) & 63u); }
                } else {
#pragma unroll
                    for (int i = 0; i < 16; ++i) { const int kv = kv0 + crow(i, hi);
                        if (kv <= tq && s0[i] >= blo && s0[i] < bhi) hist_add(h2, r, (score_key32(s0[i]) >> 16) & 63u);
                        if (kv + 32 <= tq && s1[i] >= blo && s1[i] < bhi) hist_add(h2, r, (score_key32(s1[i]) >> 16) & 63u); }
                }
                cur = nxt;
            }
        }
        __syncthreads();
        { const int row = tid >> 4, part = tid & 15; unsigned cnt[4]; unsigned cs = 0; const unsigned need1 = (unsigned)info[32 + row];
          LAS unsigned* h2a = (LAS unsigned*)(lds + DSA_H2);
#pragma unroll
          for (int j = 0; j < 2; ++j) { unsigned c0 = 0, c1 = 0; const int wi = row * 32 + ((part * 2 + j) ^ row);
#pragma unroll
              for (int ww = 0; ww < 8; ++ww) { const unsigned wd = h2a[ww * 1024 + wi]; c0 += wd & 0xffffu; c1 += wd >> 16; }
              cnt[2 * j] = c0; cnt[2 * j + 1] = c1; cs += c0 + c1; }
          unsigned suf = cs;
#pragma unroll
          for (int o = 1; o < 16; o <<= 1) { const unsigned t = __shfl_down(suf, o, 16); if (part + o < 16) suf += t; }
          const unsigned above = suf - cs;
          if (above < need1 && above + cs >= need1) { unsigned acc = above; int bsel = 0; unsigned ab = above; bool found = false;
#pragma unroll
              for (int j = 3; j >= 0; --j) { if (!found) { if (acc + cnt[j] >= need1) { bsel = part * 4 + j; ab = acc; found = true; } else acc += cnt[j]; } }
              info[64 + row] = (int)(((unsigned)info[row] << 6) | (unsigned)bsel); info[96 + row] = (int)(need1 - ab);
              const int wi = row * 32 + ((bsel >> 1) ^ row); unsigned run = 0;
#pragma unroll
              for (int ww = 0; ww < 8; ++ww) { info[128 + row * 8 + ww] = (int)run; const unsigned wd = h2a[ww * 1024 + wi]; run += (bsel & 1) ? (wd >> 16) : (wd & 0xffffu); } } }
        __syncthreads();
    }
    const unsigned T = sel_all ? 0u : (unsigned)info[64 + r];
    const unsigned need2 = sel_all ? 0x7fffffffu : (unsigned)info[96 + r];
    unsigned tc = sel_all ? 0u : (unsigned)info[128 + r * 8 + wv];
    const float f_lo = sel_all ? -INFINITY : key32_to_float(T << 16), f_hi = sel_all ? -INFINITY : ((T >= 0xffffu) ? INFINITY : key32_to_float((T + 1u) << 16));
    if (t_lo < t_hi) {
        KFrag cur, nxt; dsa_kload(cur, kix, t_lo, r, hi);
        for (int t = t_lo; t < t_hi; ++t) {
            if (t + 1 < t_hi) dsa_kload(nxt, kix, t + 1, r, hi);
            f32x16 s0, s1; dsa_scores(s0, s1, cur, qi, w);
            const int kv0 = t * 64; unsigned words[2];
#pragma unroll
            for (int half = 0; half < 2; ++half) {
                unsigned gt = 0, eq = 0;
                if (kv0 + 63 <= qg * 32) {
                    unsigned ge = 0;
#pragma unroll
                    for (int i = 15; i >= 0; --i) { const float sv = half ? s1[i] : s0[i];
                        asm("v_cmp_ge_f32 vcc, %1, %2\n\tv_addc_co_u32 %0, vcc, %0, %0, vcc" : "+v"(gt) : "v"(sv), "v"(f_hi) : "vcc");
                        asm("v_cmp_ge_f32 vcc, %1, %2\n\tv_addc_co_u32 %0, vcc, %0, %0, vcc" : "+v"(ge) : "v"(sv), "v"(f_lo) : "vcc"); }
                    eq = ge & ~gt;
                } else {
#pragma unroll
                    for (int i = 0; i < 16; ++i) { const int kv = kv0 + 32 * half + crow(i, hi); const unsigned k = score_key16(half ? s1[i] : s0[i]);
                        const unsigned v = (kv <= tq) ? 1u : 0u; gt |= ((k > T) ? v : 0u) << i; eq |= ((k == T) ? v : 0u) << i; }
                }
                unsigned sel = gt;
                if (__any(eq != 0u)) {
                    const unsigned a0 = __popc(eq & 0xfu), a1 = __popc(eq & 0xf0u), a2 = __popc(eq & 0xf00u), a3 = __popc(eq & 0xf000u);
                    const unsigned own = a0 | (a1 << 8) | (a2 << 16) | (a3 << 24); unsigned oth; { const auto rr_ = __builtin_amdgcn_permlane32_swap(own, own, false, false); oth = rr_[0] + rr_[1] - own; }
                    const unsigned b0 = oth & 255u, b1 = (oth >> 8) & 255u, b2 = (oth >> 16) & 255u, b3 = oth >> 24;
                    unsigned pre[4]; const unsigned hb = hi ? 1u : 0u;
                    pre[0] = tc + hb * b0; pre[1] = tc + a0 + b0 + hb * b1; pre[2] = tc + a0 + b0 + a1 + b1 + hb * b2; pre[3] = tc + a0 + b0 + a1 + b1 + a2 + b2 + hb * b3;
#pragma unroll
                    for (int g = 0; g < 4; ++g) { unsigned rk = pre[g];
#pragma unroll
                        for (int e = 0; e < 4; ++e) { const unsigned bit = 1u << (4 * g + e); if (eq & bit) { if (rk < need2) sel |= bit; ++rk; } } }
                    tc += a0 + a1 + a2 + a3 + b0 + b1 + b2 + b3;
                }
                unsigned wbits = (sel & 0xfu) | ((sel & 0xf0u) << 4) | ((sel & 0xf00u) << 8) | ((sel & 0xf000u) << 12);
                wbits <<= 4 * hi;
                { const auto rr_ = __builtin_amdgcn_permlane32_swap(wbits, wbits, false, false); wbits = rr_[0] | rr_[1]; }
                words[half] = wbits;
            }
            if (hi == 0) maskbits[(size_t)tq * 128 + t] = (unsigned long long)words[0] | ((unsigned long long)words[1] << 32);
            cur = nxt;
        }
    }
}

constexpr int NSA_IMP = ATT_EXTRA;
constexpr int NSA_SEL = NSA_IMP + 32768;
constexpr int NSA_UNI = NSA_SEL + 1024;
constexpr int NSA_LIST = NSA_UNI + 64;
constexpr int NSA_OT = NSA_LIST + 1024;
static_assert(NSA_OT + 65536 <= LDS_BYTES, "NSA LDS map");

__device__ __forceinline__ void nsa_unit(LAS unsigned char* lds, const bf16_t* proj, const float* side, const bf16_t* kc, const bf16_t* vc, bf16_t* ocat, int b, int q64, int wid0, const float* gn  , float* ssq  ) {
    const int tid = opaque_tid(wid0), lane = tid & 63, wv = __builtin_amdgcn_readfirstlane(tid >> 6), r = lane & 31, hi = lane >> 5;
    const int t0 = q64 * 64, q8 = r >> 2, hd = r & 3, tq = t0 + wv * 8 + q8; const size_t rowq = (size_t)b * S + tq;
    const float c2 = 0.125f * LOG2E;
    const float slope = (hd == 0) ? 0.25f : (hd == 1 ? 0.0625f : (hd == 2 ? 0.015625f : 0.00390625f));
    const float A = 8.0f * slope;
    bf16x8 qf[4];
#pragma unroll
    for (int s = 0; s < 4; ++s) qf[s] = *(const bf16x8*)(proj + rowq * NP + C_NQ + hd * 64 + s * 16 + hi * 8);
    const float g0 = sigmoid_f(side[rowq * 32 + 8 + hd * 3 + 0]), g1 = sigmoid_f(side[rowq * 32 + 8 + hd * 3 + 1]), g2 = sigmoid_f(side[rowq * 32 + 8 + hd * 3 + 2]);
    const int vb = ((lane >> 4) & 1) * 32 + (lane & 3) * 8 + (4 * hi + ((lane & 15) >> 2)) * 64;
    LAS float* imp = (LAS float*)(lds + NSA_IMP) + wv * 1024;
    LAS unsigned* selw = (LAS unsigned*)(lds + NSA_SEL) + wv * 32;
    LAS unsigned* uni = (LAS unsigned*)(lds + NSA_UNI);
    LAS int* list = (LAS int*)(lds + NSA_LIST);
    LAS float* otl = (LAS float*)(lds + NSA_OT) + wv * 2048 + lane;
    StageRegs<64> sr;
    __syncthreads();
    for (int i = lane; i < 1024; i += 64) imp[i] = 0.f;
    if (tid < 4) uni[tid] = 0u;
    const bf16_t* kcb = kc + (size_t)b * 512 * 64; const bf16_t* vcb = vc + (size_t)b * 512 * 64;
    const int ntc = (((t0 + 32) >> 4) >> 6) + 1;
    SoftState st; st.m = NEG_BIG; st.l = 0.f; st.o0 = (f32x16){}; st.o1 = (f32x16){};
    for (int pass = 0; pass < 2; ++pass) {
        stage_load<64>(sr, kcb, 64, vcb, 64, nullptr, 0, wid0);
        __syncthreads();
        stage_store<64>(sr, lds, 0, false, wid0);
        if (1 < ntc) stage_load<64>(sr, kcb, 64, vcb, 64, nullptr, 64, wid0);
        __syncthreads();
        float rl = 0.f;
        if (pass == 1) { const float l = st.l + __shfl_xor(st.l, 32); rl = l > 0.f ? 1.0f / l : 0.f; }
        const float mc = st.m * c2;
        for (int t = 0; t < ntc; ++t) {
            const int buf = t & 1;
            f32x16 p0, p1; const int n0 = t * 64;
            { const float base = A * (float)(16 * (n0 + 4 * hi) + 31);
#pragma unroll
              for (int i = 0; i < 16; ++i) { p0[i] = base + A * 16.0f * (float)((i & 3) + 8 * (i >> 2)); p1[i] = p0[i] + A * 512.0f; } }
            qk_tile<4>(p0, p1, lds + ATT_K0 + buf * ATT_KBUF, KSTR64, qf, r, hi);
#pragma unroll
            for (int i = 0; i < 16; ++i) { const int n = n0 + crow(i, hi); if (16 * n + 31 > tq) p0[i] = -INFINITY; if (16 * (n + 32) + 31 > tq) p1[i] = -INFINITY; }
            if (pass == 0) {
                const float mx = tile_max(p0, p1); const float mn = fmaxf(st.m, mx);
                const float al = __builtin_amdgcn_exp2f((st.m - mn) * c2); st.l *= al; st.m = mn; const float mcc = mn * c2; float sum = 0.f;
#pragma unroll
                for (int i = 0; i < 16; ++i) sum += __builtin_amdgcn_exp2f(__builtin_fmaf(p0[i], c2, -mcc)) + __builtin_amdgcn_exp2f(__builtin_fmaf(p1[i], c2, -mcc));
                st.l += sum;
            } else {
#pragma unroll
                for (int i = 0; i < 16; ++i) { p0[i] = __builtin_amdgcn_exp2f(__builtin_fmaf(p0[i], c2, -mc)) * rl; p1[i] = __builtin_amdgcn_exp2f(__builtin_fmaf(p1[i], c2, -mc)) * rl; }
#pragma unroll
                for (int half = 0; half < 2; ++half)
#pragma unroll
                    for (int g = 0; g < 4; ++g) { const f32x16& pp = half ? p1 : p0;
                        float s4 = (pp[4 * g] + pp[4 * g + 1]) + (pp[4 * g + 2] + pp[4 * g + 3]); float s3 = pp[4 * g + 3];
                        s4 += quad_xor1(s4); s4 += quad_xor2(s4); s3 += quad_xor1(s3); s3 += quad_xor2(s3);
                        const int j1 = 16 * t + 8 * half + 2 * g + hi;
                        if (hd == 0) atomicAdd((float*)(imp + q8 * 128 + j1), s4);
                        if (hd == 0 && j1 + 1 < 128) atomicAdd((float*)(imp + q8 * 128 + j1 + 1), s3); }
                pv_tile(st.o0, st.o1, p0, p1, lds + ATT_V0 + buf * ATT_VBUF, vb);
            }
            if (t + 1 < ntc) stage_store<64>(sr, lds, buf ^ 1, false, wid0);
            if (t + 2 < ntc) stage_load<64>(sr, kcb, 64, vcb, 64, nullptr, (t + 2) * 64, wid0);
            __syncthreads();
        }
    }
#pragma unroll
    for (int i = 0; i < 16; ++i) { otl[i * 64] = st.o0[i] * g0; otl[(16 + i) * 64] = st.o1[i] * g0; }
    {
        const int cur = q64;
        for (int qq = 0; qq < 8; ++qq) {
            float v0 = imp[qq * 128 + lane], v1 = imp[qq * 128 + 64 + lane];
            bool ok0 = true, ok1 = true;
            { const int j0 = lane, j1 = lane + 64;
              if (j0 == 0 || j0 == cur) v0 = INFINITY; else if (j0 > cur) ok0 = false;
              if (j1 == cur) v1 = INFINITY; else if (j1 > cur) ok1 = false; }
            const unsigned k0 = __float_as_uint(v0), k1 = __float_as_uint(v1);
            unsigned T = 0u;
            for (int bit = 30; bit >= 0; --bit) { const unsigned cand = T | (1u << bit);
                const int cnt = __popcll(__ballot(ok0 && k0 >= cand)) + __popcll(__ballot(ok1 && k1 >= cand));
                if (cnt >= 16) T = cand; }
            const unsigned long long gt0 = __ballot(ok0 && k0 > T), gt1 = __ballot(ok1 && k1 > T), eq0 = __ballot(ok0 && k0 == T), eq1 = __ballot(ok1 && k1 == T);
            const int need = 16 - (__popcll(gt0) + __popcll(gt1));
            const int r0 = (int)__builtin_amdgcn_mbcnt_hi((unsigned)(eq0 >> 32), __builtin_amdgcn_mbcnt_lo((unsigned)eq0, 0u));
            const int r1 = __popcll(eq0) + (int)__builtin_amdgcn_mbcnt_hi((unsigned)(eq1 >> 32), __builtin_amdgcn_mbcnt_lo((unsigned)eq1, 0u));
            const unsigned long long slo = __ballot(ok0 && (k0 > T || (k0 == T && r0 < need))), shi = __ballot(ok1 && (k1 > T || (k1 == T && r1 < need)));
            if (lane == 0) { selw[qq * 4 + 0] = (unsigned)slo; selw[qq * 4 + 1] = (unsigned)(slo >> 32); selw[qq * 4 + 2] = (unsigned)shi; selw[qq * 4 + 3] = (unsigned)(shi >> 32);
                atomicOr((unsigned*)(uni + 0), (unsigned)slo); atomicOr((unsigned*)(uni + 1), (unsigned)(slo >> 32)); atomicOr((unsigned*)(uni + 2), (unsigned)shi); atomicOr((unsigned*)(uni + 3), (unsigned)(shi >> 32)); }
        }
    }
    __syncthreads();
    if (tid == 0) { int n = 0; for (int wd = 0; wd < 4; ++wd) { unsigned u = uni[wd]; while (u) { const int j = __ffs(u) - 1; u &= u - 1; list[n++] = wd * 32 + j; } } list[131] = n; }
    __syncthreads();
    {
        const unsigned m0 = selw[q8 * 4 + 0], m1 = selw[q8 * 4 + 1], m2 = selw[q8 * 4 + 2], m3 = selw[q8 * 4 + 3];
        const int nl = list[131];
        const bf16_t* Ks = proj + (size_t)b * S * NP + C_KSEL; const bf16_t* Vs = proj + (size_t)b * S * NP + C_VSEL;
        st.m = NEG_BIG; st.l = 0.f; st.o0 = (f32x16){}; st.o1 = (f32x16){};
        stage_load<64>(sr, Ks, NP, Vs, NP, nullptr, list[0] * 64, wid0);
        stage_store<64>(sr, lds, 0, false, wid0);
        if (1 < nl) stage_load<64>(sr, Ks, NP, Vs, NP, nullptr, list[1] * 64, wid0);
        __syncthreads();
        for (int t = 0; t < nl; ++t) {
            const int buf = t & 1; const int j = list[t];
            const unsigned mw = (j < 32) ? m0 : (j < 64 ? m1 : (j < 96 ? m2 : m3));
            const bool mine = (mw >> (j & 31)) & 1u;
            if (__any(mine)) {
                f32x16 p0, p1; const int kv0 = j * 64;
                { const float base = A * (float)(kv0 + 4 * hi);
#pragma unroll
                  for (int i = 0; i < 16; ++i) { p0[i] = base + A * (float)((i & 3) + 8 * (i >> 2)); p1[i] = p0[i] + A * 32.0f; } }
                qk_tile<4>(p0, p1, lds + ATT_K0 + buf * ATT_KBUF, KSTR64, qf, r, hi);
#pragma unroll
                for (int i = 0; i < 16; ++i) { const int kv = kv0 + crow(i, hi); if (!mine || (j == q64 && kv > tq)) p0[i] = -INFINITY; if (!mine || (j == q64 && kv + 32 > tq)) p1[i] = -INFINITY; }
                { bf16x8 f0, f1, f2, f3; softmax_pack(st, p0, p1, c2, f0, f1, f2, f3); pv_frag(st.o0, st.o1, f0, f1, f2, f3, lds + ATT_V0 + buf * ATT_VBUF, vb); }
            }
            if (t + 1 < nl) stage_store<64>(sr, lds, buf ^ 1, false, wid0);
            if (t + 2 < nl) stage_load<64>(sr, Ks, NP, Vs, NP, nullptr, list[t + 2] * 64, wid0);
            __syncthreads();
        }
        const float l = swap32_sum(st.l); const float sc = l > 0.f ? g1 / l : 0.f;
#pragma unroll
        for (int i = 0; i < 16; ++i) { otl[i * 64] += st.o0[i] * sc; otl[(16 + i) * 64] += st.o1[i] * sc; }
    }
    {
        const bf16_t* Kw = proj + (size_t)b * S * NP + C_KWIN; const bf16_t* Vw = proj + (size_t)b * S * NP + C_VWIN;
        const int tw0 = (q64 >= 8) ? q64 - 8 : 0, ntw = q64 - tw0 + 1;
        st.m = NEG_BIG; st.l = 0.f; st.o0 = (f32x16){}; st.o1 = (f32x16){};
        stage_load<64>(sr, Kw, NP, Vw, NP, nullptr, tw0 * 64, wid0);
        stage_store<64>(sr, lds, 0, false, wid0);
        if (1 < ntw) stage_load<64>(sr, Kw, NP, Vw, NP, nullptr, tw0 * 64 + 64, wid0);
        __syncthreads();
        for (int t = 0; t < ntw; ++t) {
            const int buf = t & 1; const int kv0 = (tw0 + t) * 64;
            f32x16 p0, p1;
            { const float base = A * (float)(kv0 + 4 * hi);
#pragma unroll
              for (int i = 0; i < 16; ++i) { p0[i] = base + A * (float)((i & 3) + 8 * (i >> 2)); p1[i] = p0[i] + A * 32.0f; } }
            qk_tile<4>(p0, p1, lds + ATT_K0 + buf * ATT_KBUF, KSTR64, qf, r, hi);
            if (t == 0 || t == ntw - 1) {
#pragma unroll
                for (int i = 0; i < 16; ++i) { const int kv = kv0 + crow(i, hi); if (kv > tq || kv + 512 <= tq) p0[i] = -INFINITY; if (kv + 32 > tq || kv + 32 + 512 <= tq) p1[i] = -INFINITY; } }
            { bf16x8 f0, f1, f2, f3; softmax_pack(st, p0, p1, c2, f0, f1, f2, f3); pv_frag(st.o0, st.o1, f0, f1, f2, f3, lds + ATT_V0 + buf * ATT_VBUF, vb); }
            if (t + 1 < ntw) stage_store<64>(sr, lds, buf ^ 1, false, wid0);
            if (t + 2 < ntw) stage_load<64>(sr, Kw, NP, Vw, NP, nullptr, kv0 + 128, wid0);
            __syncthreads();
        }
        const float l = swap32_sum(st.l); const float sc = l > 0.f ? g2 / l : 0.f;
#pragma unroll
        for (int i = 0; i < 16; ++i) { st.o0[i] = otl[i * 64] + st.o0[i] * sc; st.o1[i] = otl[(16 + i) * 64] + st.o1[i] * sc; }
    }
    { const float sq = swap32_sum(store_out_fused(ocat + rowq * D + 768 + hd * 64, proj + rowq * NP + C_GZ + 768 + hd * 64, gn + 768 + hd * 64, st.o0, st.o1, 1.0f, hi));
      if (hi == 0) ssq[rowq * 16 + 12 + hd] = sq; }
}

__device__ __forceinline__ void phase_onorm(const bf16_t* ocat, const bf16_t* proj, const float* og, bf16_t* oa, int bid, int G, int wid0) {
    const int tid_ = opaque_tid(wid0); const int lane = tid_ & 63, wv = tid_ >> 6;
    for (int row = bid * 8 + wv; row < M; row += G * 8) {
        const int c = lane * 16;
        const u32x4 a0 = *(const u32x4*)(ocat + (size_t)row * D + c), a1 = *(const u32x4*)(ocat + (size_t)row * D + c + 8);
        const u32x4 z0 = *(const u32x4*)(proj + (size_t)row * NP + C_GZ + c), z1 = *(const u32x4*)(proj + (size_t)row * NP + C_GZ + c + 8);
        float v[16], z[16]; float s = 0.f;
#pragma unroll
        for (int e = 0; e < 4; ++e) { v[2 * e] = bflo(a0[e]); v[2 * e + 1] = bfhi(a0[e]); v[8 + 2 * e] = bflo(a1[e]); v[8 + 2 * e + 1] = bfhi(a1[e]);
            z[2 * e] = bflo(z0[e]); z[2 * e + 1] = bfhi(z0[e]); z[8 + 2 * e] = bflo(z1[e]); z[8 + 2 * e + 1] = bfhi(z1[e]); }
#pragma unroll
        for (int e = 0; e < 16; ++e) s += v[e] * v[e];
        s += __builtin_bit_cast(float, __builtin_amdgcn_update_dpp(0, __builtin_bit_cast(int, s), 0xB1, 0xf, 0xf, false));
        s += __builtin_bit_cast(float, __builtin_amdgcn_update_dpp(0, __builtin_bit_cast(int, s), 0x4E, 0xf, 0xf, false));
        s += __builtin_bit_cast(float, __builtin_amdgcn_update_dpp(0, __builtin_bit_cast(int, s), 0x141, 0xf, 0xf, false));
        s += __builtin_bit_cast(float, __builtin_amdgcn_update_dpp(0, __builtin_bit_cast(int, s), 0x140, 0xf, 0xf, false));
        const float rstd = 1.0f / sqrtf(s * (1.f / 256.f) + EPS);
        float y[16];
#pragma unroll
        for (int e = 0; e < 16; ++e) y[e] = v[e] * rstd * og[c + e] * silu_f(z[e]);
        u32x4 w0, w1;
#pragma unroll
        for (int e = 0; e < 4; ++e) { w0[e] = pk2(y[2 * e], y[2 * e + 1]); w1[e] = pk2(y[8 + 2 * e], y[8 + 2 * e + 1]); }
        *(u32x4*)(oa + (size_t)row * D + c) = w0; *(u32x4*)(oa + (size_t)row * D + c + 8) = w1;
    }
}
__device__ __forceinline__ void phase_final(float* out, const float* g, int bid, int G, int wid0) {
    const int tid_ = opaque_tid(wid0); const int lane = tid_ & 63, wv = tid_ >> 6;
    for (int row = bid * 8 + wv; row < M; row += G * 8) {
        f32x4* xr = (f32x4*)(out + (size_t)row * D) + lane;
        f32x4 v[4]; float s = 0.f;
#pragma unroll
        for (int j = 0; j < 4; ++j) { v[j] = xr[64 * j]; s += (v[j][0] * v[j][0] + v[j][1] * v[j][1]) + (v[j][2] * v[j][2] + v[j][3] * v[j][3]); }
        const float rstd = 1.0f / sqrtf(wave_sum(s) * (1.f / D) + EPS);
#pragma unroll
        for (int j = 0; j < 4; ++j) { const f32x4 gg = *(const f32x4*)(g + (64 * j + lane) * 4); xr[64 * j] = v[j] * rstd * gg; }
    }
}

#define XB_TMO      128
#define XB_XCNT(j)  (256  + 64 * (j))
#define XB_XSUB(j)  (1280 + 64 * (j))
#define XB_XGEN(j)  (2304 + 64 * (j))
#define XB_TOP      3328
#define XB_TOPGEN   3392
#define XCD_BAR_WORDS 3456
#define XB_SPIN_CAP (1u << 22)
__device__ __forceinline__ unsigned xb_ld(unsigned* p)              { return __hip_atomic_load(p, __ATOMIC_RELAXED, __HIP_MEMORY_SCOPE_AGENT); }
__device__ __forceinline__ unsigned xb_add(unsigned* p, unsigned v) { return __hip_atomic_fetch_add(p, v, __ATOMIC_RELAXED, __HIP_MEMORY_SCOPE_AGENT); }
__device__ __forceinline__ unsigned xb_xcc_id() { return (unsigned)__builtin_amdgcn_s_getreg((3 << 11) | 20) & 0xFu; }
#define XB_SPIN(cond, bar) do { unsigned _sp = 0; while (cond) { __builtin_amdgcn_s_sleep(1); \
    if ((++_sp & 255u) == 0u) { if (xb_ld(&(bar)[XB_TMO])) break; if (_sp > XB_SPIN_CAP) { atomicAdd(&(bar)[XB_TMO], 1u); break; } } } } while (0)
__device__ __forceinline__ void xcd_barrier_complete(unsigned* bar, unsigned x, unsigned G, unsigned& nloc, unsigned& nx) {
    unsigned sum, cnt, mine, sp = 0u;
    for (;;) {
        sum = 0u; cnt = 0u; mine = 0u;
#pragma unroll
        for (unsigned j = 0; j < 16; ++j) { const unsigned c = xb_ld(&bar[XB_XCNT(j)]); sum += c; cnt += (c > 0u) ? 1u : 0u; mine = (j == x) ? c : mine; }
        if (sum == G) break;
        __builtin_amdgcn_s_sleep(1);
        if ((++sp & 255u) == 0u) { if (xb_ld(&bar[XB_TMO])) break; if (sp > XB_SPIN_CAP) { atomicAdd(&bar[XB_TMO], 1u); break; } }
    }
    nloc = mine > 0u ? mine : 1u; nx = cnt > 0u ? cnt : 1u;
}
__device__ __forceinline__ void grid_bar(unsigned* bar, volatile LAS unsigned* st, unsigned G, int wid0) {
    const int tid = opaque_tid(wid0);
    asm volatile("s_waitcnt vmcnt(0)" ::: "memory");
    __syncthreads();
    if (tid == 0) {
        const unsigned x = xb_xcc_id();
        unsigned nloc = st[0], nx = st[1];
        if (nloc == 0u) { xcd_barrier_complete(bar, x, G, nloc, nx); st[0] = nloc; st[1] = nx; }
        const unsigned old = xb_add(&bar[XB_XSUB(x)], 1u);
        const unsigned gen = old / nloc;
        if (old + 1u == (gen + 1u) * nloc) {
            __builtin_amdgcn_fence(__ATOMIC_RELEASE, "agent");
            asm volatile("s_waitcnt vmcnt(0)" ::: "memory");
            const unsigned og = xb_add(&bar[XB_TOP], 1u);
            const unsigned tg = og / nx;
            if (og + 1u == (tg + 1u) * nx) xb_add(&bar[XB_TOPGEN], 1u);
            else XB_SPIN(xb_ld(&bar[XB_TOPGEN]) == tg, bar);
            __builtin_amdgcn_fence(__ATOMIC_ACQUIRE, "agent");
            xb_add(&bar[XB_XGEN(x)], 1u);
            asm volatile("s_waitcnt vmcnt(0)" ::: "memory");
        } else {
            XB_SPIN(xb_ld(&bar[XB_XGEN(x)]) == gen, bar);
            __builtin_amdgcn_fence(__ATOMIC_ACQUIRE, "agent");
            asm volatile("s_waitcnt vmcnt(0)" ::: "memory");
        }
    }
    __syncthreads();
}

constexpr int N_PHASES = 16;
__global__ void __launch_bounds__(NTHREADS) hymba_fwd(Params P) {
    extern __shared__ __attribute__((aligned(16))) unsigned char lds_raw[];
    LAS unsigned char* lds = (LAS unsigned char*)lds_raw;
    const int bid = blockIdx.x, G = gridDim.x;
    const int wid0 = __builtin_amdgcn_readfirstlane((int)(threadIdx.x >> 6));
    volatile LAS unsigned* xst = (volatile LAS unsigned*)(lds + LDS_BYTES - 16);
    unsigned* xbar = (unsigned*)(P.ws + WS_CTL) + 4096 + P.bar_region * XCD_BAR_WORDS;
    if (threadIdx.x == 0) { xst[0] = 0u; xst[1] = 0u; (void)xb_add(&xbar[XB_XCNT(xb_xcc_id())], 1u); }
    __syncthreads();
    unsigned char* ws = P.ws;
    bf16_t* proj = (bf16_t*)(ws + WS_PROJ); float* side = (float*)(ws + WS_SIDE);
    bf16_t* hbuf = (bf16_t*)(ws + WS_H); bf16_t* ocat = (bf16_t*)(ws + WS_OCAT);
#define PH(k) (P.ph_lo <= (k) && (k) < P.ph_hi)
#define SYNC(k) do { if (PH(k) && PH((k) + 1)) grid_bar(xbar, xst, (unsigned)G, wid0); } while (0)
    if (PH(0)) phase_prologue(P, lds, bid, G, wid0);
    if (PH(0) && PH(1)) cg::this_grid().sync();
#ifndef PREP_SHIFT
#define PREP_SHIFT 4
#endif
#ifndef ATT_REP
#define ATT_REP 0
#endif
#ifndef PROBE_VAR
#define PROBE_VAR -1
#endif
#define LAYER(l, base) do { \
    const float* mod = (const float*)(ws + WS_MOD) + (size_t)(l) * 4 * 3072; \
    const float* xin = ((l) == 0) ? P.in[0] : P.out; \
    if (PH((base) + 0)) phase_hnorm(xin, P.in[2] + (l) * D, mod, hbuf, bid, G, wid0); \
    SYNC((base) + 0); \
    if (PH((base) + 1)) { pg8::Gemm g{hbuf, (const bf16_t*)(ws + WS_WIN) + (size_t)(l) * NP * D, M, NP, D, D, D}; pg8::StaticOrder so; so.init(M, NP, G, bid); \
        pg8::EpiProj E{proj, side}; pg8::gemm_phase<pg8::EpiProj, true>(lds, g, so, E, wid0); } \
    SYNC((base) + 1); \
    if (PH((base) + 2)) phase_prep(P, (l), lds, bid, G, wid0); \
    SYNC((base) + 2); \
    if (PH((base) + 3)) { \
        { pg8::Gemm g{proj + C_QLAT, (const bf16_t*)(ws + WS_WUQ) + (size_t)(l) * 512 * 256, M, 512, 256, NP, 256}; pg8::StaticOrder so; so.init(M, 512, G, bid); \
          pg8::EpiQup E{(bf16_t*)(ws + WS_QMLA), (const float*)(ws + WS_RSTD), (const float*)(ws + WS_ROPE)}; pg8::gemm_phase<pg8::EpiQup, true>(lds, g, so, E, wid0); } \
        { pg8::Gemm g{proj + C_KVLAT, (const bf16_t*)(ws + WS_WUKV) + (size_t)(l) * 512 * 128, M, 512, 128, NP, 128}; pg8::StaticOrder so; so.init(M, 512, G, bid); \
          pg8::EpiKVup E{(bf16_t*)(ws + WS_KMLA), (bf16_t*)(ws + WS_VMLA), (const float*)(ws + WS_RSTD)}; pg8::gemm_phase<pg8::EpiKVup, true>(lds, g, so, E, wid0); } \
        for (int k = 0; k * G < 1024; ++k) { const int u = (k & 1) ? (k + 1) * G - 1 - bid : k * G + bid; if (u >= 1024 || u < 0) continue; const int qg = 255 - (u >> 2), b = u & 3; \
            dsa_index_unit(lds, proj, (const bf16_t*)(ws + WS_KIDX), side, (unsigned long long*)(ws + WS_MASK) + (size_t)b * S * 128, b, qg, wid0); } } \
    SYNC((base) + 3); \
    if (PH((base) + 4)) { const int vb_ = (G % 8 == 0) ? (bid & 7) * (G >> 3) + (bid >> 3) : bid;     \
        if (G == 256) {   \
          const int tw_ = opaque_tid(wid0); const int b_ = (bid & 7) >> 1; \
          if (tw_ < 128) { const int pg_ = (bid >> 3) * 128 + tw_;     \
              const unsigned char* a_ = (pg_ < 1536) ? ws + WS_QMLA + (size_t)b_ * S * 768 + (size_t)pg_ * 4096 : (pg_ < 3072) ? ws + WS_KMLA + (size_t)b_ * S * 768 + (size_t)(pg_ - 1536) * 4096 \
                                                      : ws + WS_VMLA + (size_t)b_ * S * 512 + (size_t)(pg_ - 3072) * 4096; \
              const unsigned v_ = *(const volatile unsigned*)a_; if (v_ == 0x12345677u) *(volatile unsigned*)(ws + WS_CTL + 8192 + 512) = v_; } } \
        for (int i = vb_; i < 512; i += G) { const int ii = i & 255, bh = ii >> 4, qb = (i < 256) ? (ii & 15) : 31 - (ii & 15), b = bh >> 2, hd = bh & 3; const size_t rb = (size_t)b * S; \
            attn64_unit<0, 96>(lds, (const bf16_t*)(ws + WS_QMLA) + rb * 384 + hd * 96, 384, (const bf16_t*)(ws + WS_KMLA) + rb * 384 + hd * 96, 384, \
                              (const bf16_t*)(ws + WS_VMLA) + rb * 256 + hd * 64, 256, ocat + rb * D + hd * 64, nullptr, nullptr, 0.f, 0.10206207261596577f * LOG2E, qb, wid0, proj + rb * NP + C_GZ + hd * 64, P.in[14] + (l) * D + hd * 64, (float*)(ws + WS_SSQ) + rb * 16 + hd); } \
        for (int rep = 0; rep < (((ATT_REP & 2) && (l) == 0) ? 2 : 1); ++rep) for (int i = vb_; i < 512; i += G) { const int ii = i & 255, bh = ii >> 4, qb = (i < 256) ? (ii & 15) : 31 - (ii & 15), b = bh >> 2, hd = bh & 3; const size_t rb = (size_t)b * S; \
            attn64_unit<1, 64>(lds, proj + rb * NP + C_FQ + hd * 64, NP, proj + rb * NP + C_FK + hd * 64, NP, proj + rb * NP + C_FV + hd * 64, NP, \
                              ocat + rb * D + 256 + hd * 64, (const float*)(ws + WS_FB) + (size_t)bh * S, nullptr, 0.f, 0.125f * LOG2E, qb, wid0, proj + rb * NP + C_GZ + 256 + hd * 64, P.in[14] + (l) * D + 256 + hd * 64, (float*)(ws + WS_SSQ) + rb * 16 + 4 + hd); } \
        for (int rep = 0; rep < (((ATT_REP & 4) && (l) == 0) ? 2 : 1); ++rep) for (int i = vb_; i < 512; i += G) { const int ii = i & 255, bh = ii >> 4, qb = (i < 256) ? (ii & 15) : 31 - (ii & 15), b = bh >> 2, hd = bh & 3; const size_t rb = (size_t)b * S; \
            const float slope = (hd == 0) ? 0.25f : (hd == 1 ? 0.0625f : (hd == 2 ? 0.015625f : 0.00390625f)); \
            attn64_unit<2, 64>(lds, proj + rb * NP + C_DQ + hd * 64, NP, proj + rb * NP + C_DK + hd * 64, NP, proj + rb * NP + C_DV + hd * 64, NP, \
                              ocat + rb * D + 512 + hd * 64, nullptr, (const unsigned long long*)(ws + WS_MASK) + rb * 128, 8.0f * slope, 0.125f * LOG2E, qb, wid0, proj + rb * NP + C_GZ + 512 + hd * 64, P.in[14] + (l) * D + 512 + hd * 64, (float*)(ws + WS_SSQ) + rb * 16 + 8 + hd); } \
        for (int rep = 0; rep < (((ATT_REP & 8) && (l) == 0) ? 2 : 1); ++rep) for (int u = vb_; u < 512; u += G) { const int b = u >> 7, q64 = (u < 256) ? (u & 127) : 127 - (u & 127);     \
            nsa_unit(lds, proj, side, (const bf16_t*)(ws + WS_KC), (const bf16_t*)(ws + WS_VC), ocat, b, q64, wid0, P.in[14] + (l) * D, (float*)(ws + WS_SSQ)); } } \
    SYNC((base) + 4); \
      \
    if (PH((base) + 6)) { pg8::Gemm g{ocat, (const bf16_t*)(ws + WS_WOUT) + (size_t)(l) * D * D, M, D, D, D, D}; pg8::StaticOrder so; so.init(M, D, G, bid); \
        pg8::EpiOut E{xin, P.out, mod + 2048, (const float*)(ws + WS_SSQ)}; pg8::gemm_phase<pg8::EpiOut, true>(lds, g, so, E, wid0); } \
    SYNC((base) + 6); \
} while (0)
    LAYER(0, 1);
    LAYER(1, 8);
    if (PH(15)) phase_final(P.out, P.in[16], bid, G, wid0);
#undef LAYER
#undef PH
#undef SYNC
}


#ifdef DBG_GROUP
#ifndef DBG_LAYER
#define DBG_LAYER 1
#endif
__device__ __forceinline__ float dbg_bf(const bf16_t* p) { return bf2f(*p); }
__device__ const int dbg_rows[48] = {0, 1, 2, 15, 30, 31, 32, 47, 63, 64, 65, 127, 128, 200, 255, 256, 257, 300, 511, 512, 513, 700, 1000, 1023, 1024, 1025, 1500, 2047, 2048, 3000, 3333, 4095, 4096, 4500, 5000, 5555, 6143, 6144, 7000, 7777, 8000, 8100, 8127, 8128, 8160, 8190, 8191, 4242};
template <class ScoreFn, class VFn>
__device__ __forceinline__ float dbg_attn(int k_lo, int k_hi, ScoreFn score, VFn vload, int lane) {
    float m = -INFINITY, l = 0.f, acc = 0.f;
    for (int kv = k_lo; kv <= k_hi; ++kv) {
        const float sc = score(kv);
        if (sc == -INFINITY) continue;
        const float mn = fmaxf(m, sc); const float al = (m == -INFINITY) ? 0.f : __expf(m - mn); const float p = __expf(sc - mn);
        l = l * al + p; acc = acc * al + p * vload(kv, lane); m = mn;
    }
    return l > 0.f ? acc / l : 0.f;
}
__global__ void __launch_bounds__(64) dbg_check(Params P) {
    const int lane = threadIdx.x, wid = blockIdx.x; const int hd = wid & 3, ri = (wid >> 2) % 48, b = (wid >> 2) / 48; const int t = dbg_rows[ri];
    unsigned char* ws = P.ws; const bf16_t* proj = (const bf16_t*)(ws + WS_PROJ); const float* side = (const float*)(ws + WS_SIDE);
    const bf16_t* ocat = (const bf16_t*)(ws + WS_OCAT); const size_t rowq = (size_t)b * S + t; const size_t rb = (size_t)b * S;
    float* scratch = (float*)(ws + WS_H) + (size_t)wid * 16384;
    float ref = 0.f; int grp = DBG_GROUP % 10;
    const float slope = (hd == 0) ? 0.25f : (hd == 1 ? 0.0625f : (hd == 2 ? 0.015625f : 0.00390625f));
    if (grp == 0) {
        const bf16_t* q = (const bf16_t*)(ws + WS_QMLA) + rowq * 384 + hd * 96; const bf16_t* K = (const bf16_t*)(ws + WS_KMLA) + rb * 384 + hd * 96; const bf16_t* V = (const bf16_t*)(ws + WS_VMLA) + rb * 256 + hd * 64;
        const float q0 = dbg_bf(q + lane), q1 = lane < 32 ? dbg_bf(q + 64 + lane) : 0.f;
        ref = dbg_attn(0, t, [&](int kv) { float pr = q0 * dbg_bf(K + (size_t)kv * 384 + lane) + (lane < 32 ? q1 * dbg_bf(K + (size_t)kv * 384 + 64 + lane) : 0.f); return wave_sum(pr) * 0.10206207261596577f; },
                       [&](int kv, int d) { return dbg_bf(V + (size_t)kv * 256 + d); }, lane);
    } else if (grp == 1) {
        const bf16_t* q = proj + rowq * NP + C_FQ + hd * 64; const bf16_t* K = proj + rb * NP + C_FK + hd * 64; const bf16_t* V = proj + rb * NP + C_FV + hd * 64; const float* fb = (const float*)(ws + WS_FB) + (size_t)(b * 4 + hd) * S;
        const float q0 = dbg_bf(q + lane); const float ft = fb[t];
        ref = dbg_attn(0, t, [&](int kv) { return wave_sum(q0 * dbg_bf(K + (size_t)kv * NP + lane)) * 0.125f + (fb[kv] - ft) * 0.125f; },
                       [&](int kv, int d) { return dbg_bf(V + (size_t)kv * NP + d); }, lane);
    } else if (grp == 2) {
        float* sc = scratch; unsigned char* selb = (unsigned char*)(scratch + 8192);
        const int ih = lane >> 4, dd = (lane & 15) * 2;
        const float qa = dbg_bf(proj + rowq * NP + C_IQ + ih * 32 + dd), qb2 = dbg_bf(proj + rowq * NP + C_IQ + ih * 32 + dd + 1); const float wgt = side[rowq * 32 + 4 + ih] * 0.5f;
        for (int kv = 0; kv <= t; ++kv) { float pr = qa * dbg_bf(proj + (rb + kv) * NP + C_IK + dd) + qb2 * dbg_bf(proj + (rb + kv) * NP + C_IK + dd + 1);
            pr += __shfl_xor(pr, 1); pr += __shfl_xor(pr, 2); pr += __shfl_xor(pr, 4); pr += __shfl_xor(pr, 8);
            float v = wgt * fmaxf(pr, 0.f); v += __shfl_xor(v, 16); v += __shfl_xor(v, 32); if (lane == 0) sc[kv] = v; }
        __threadfence_block();
        if (t + 1 <= 256) { for (int kv = lane; kv <= t; kv += 64) selb[kv] = 1; }
        else {
#ifdef DBG_KEY32
#define DBGKEY(x) ({ const unsigned u_ = __float_as_uint(x); (u_ & 0x80000000u) ? ~u_ : (u_ | 0x80000000u); })
            unsigned lo = 0, hi2 = 0xffffffffu;
#else
#define DBGKEY(x) score_key16(x)
            unsigned lo = 0, hi2 = 0xffffu;
#endif
            while (lo < hi2) { const unsigned mid = lo + ((hi2 - lo) >> 1) + ((hi2 - lo) & 1u); int c = 0; for (int kv = lane; kv <= t; kv += 64) c += (DBGKEY(sc[kv]) >= mid); c = (int)wave_sum((float)c); if (c >= 256) lo = mid; else hi2 = mid - 1; }
            const unsigned T = lo; int cgt = 0; for (int kv = lane; kv <= t; kv += 64) cgt += (DBGKEY(sc[kv]) > T); cgt = (int)wave_sum((float)cgt);
            int need = 256 - cgt; int run = 0;
            for (int k0 = 0; k0 <= t; k0 += 64) { const int kv = k0 + lane; const unsigned k = kv <= t ? DBGKEY(sc[kv]) : 0u; const bool eq = kv <= t && k == T, gt = kv <= t && k > T;
                const unsigned long long bm = __ballot(eq); const int before = __popcll(bm & ((1ull << lane) - 1ull));
                if (kv <= t) selb[kv] = (gt || (eq && run + before < need)) ? 1 : 0; run += __popcll(bm); }
        }
        __threadfence_block();
        const bf16_t* q = proj + rowq * NP + C_DQ + hd * 64; const bf16_t* K = proj + rb * NP + C_DK + hd * 64; const bf16_t* V = proj + rb * NP + C_DV + hd * 64; const float q0 = dbg_bf(q + lane);
        ref = dbg_attn(0, t, [&](int kv) { if (!selb[kv]) return -INFINITY; return wave_sum(q0 * dbg_bf(K + (size_t)kv * NP + lane)) * 0.125f - slope * (float)(t - kv); },
                       [&](int kv, int d) { return dbg_bf(V + (size_t)kv * NP + d); }, lane);
    } else {
        const int sub = DBG_GROUP / 10;
        const bf16_t* q = proj + rowq * NP + C_NQ; const float q0 = dbg_bf(q + hd * 64 + lane);
        const bf16_t* kc = (const bf16_t*)(ws + WS_KC) + (size_t)b * 512 * 64; const bf16_t* vc = (const bf16_t*)(ws + WS_VC) + (size_t)b * 512 * 64;
        float* pc = scratch;
        for (int h2 = 0; h2 < 4; ++h2) { const float qh = dbg_bf(q + h2 * 64 + lane); const float sl = (h2 == 0) ? 0.25f : (h2 == 1 ? 0.0625f : (h2 == 2 ? 0.015625f : 0.00390625f));
            float m = -INFINITY; for (int n = 0; n < 511; ++n) { if (16 * n + 31 > t) break; const float s_ = wave_sum(qh * dbg_bf(kc + n * 64 + lane)) * 0.125f - sl * (float)(t - (16 * n + 31)); if (lane == 0) pc[h2 * 512 + n] = s_; m = fmaxf(m, s_); }
            __threadfence_block(); float l = 0.f; for (int n = 0; n < 511 && 16 * n + 31 <= t; ++n) l += __expf(pc[h2 * 512 + n] - m);
            __threadfence_block(); for (int n = lane; n < 511; n += 64) pc[h2 * 512 + n] = (16 * n + 31 <= t) ? __expf(pc[h2 * 512 + n] - m) / l : 0.f; __threadfence_block(); }
        float oc = 0.f; for (int n = 0; n < 511 && 16 * n + 31 <= t; ++n) oc += pc[hd * 512 + n] * dbg_bf(vc + n * 64 + lane);
        const int cur = t >> 6; float v0, v1;
        { float i0 = 0.f, i1 = 0.f; for (int h2 = 0; h2 < 4; ++h2) for (int e = -1; e <= 3; ++e) { int n0 = 4 * lane + e, n1 = 4 * (lane + 64) + e; if (n0 >= 0 && n0 < 511) i0 += pc[h2 * 512 + n0]; if (n1 < 511) i1 += pc[h2 * 512 + n1]; }
          v0 = (lane == 0 || lane == cur) ? INFINITY : (lane > cur ? -INFINITY : i0); v1 = (lane + 64 == cur) ? INFINITY : (lane + 64 > cur ? -INFINITY : i1); }
        unsigned long long slo = 0, shi = 0;
        for (int it = 0; it < 16; ++it) { float mx = fmaxf(v0, v1); for (int o = 1; o < 64; o <<= 1) mx = fmaxf(mx, __shfl_xor(mx, o)); if (!(mx > -INFINITY)) break;
            const unsigned long long b0 = __ballot(v0 == mx), b1 = __ballot(v1 == mx);
            if (b0) { const int j = __ffsll((long long)b0) - 1; slo |= 1ull << j; if (lane == j) v0 = -INFINITY; } else { const int j = __ffsll((long long)b1) - 1; shi |= 1ull << j; if (lane == j) v1 = -INFINITY; } }
        const bf16_t* Ks = proj + rb * NP + C_KSEL; const bf16_t* Vs = proj + rb * NP + C_VSEL; const bf16_t* Kw = proj + rb * NP + C_KWIN; const bf16_t* Vw = proj + rb * NP + C_VWIN;
        const float os = dbg_attn(0, t, [&](int kv) { const int j = kv >> 6; const bool in = j < 64 ? ((slo >> j) & 1ull) : ((shi >> (j - 64)) & 1ull); if (!in) return -INFINITY;
                                      return wave_sum(q0 * dbg_bf(Ks + (size_t)kv * NP + lane)) * 0.125f - slope * (float)(t - kv); }, [&](int kv, int d) { return dbg_bf(Vs + (size_t)kv * NP + d); }, lane);
        const float ow = dbg_attn(t - 511 > 0 ? t - 511 : 0, t, [&](int kv) { return wave_sum(q0 * dbg_bf(Kw + (size_t)kv * NP + lane)) * 0.125f - slope * (float)(t - kv); }, [&](int kv, int d) { return dbg_bf(Vw + (size_t)kv * NP + d); }, lane);
        const float g0 = sigmoid_f(side[rowq * 32 + 8 + hd * 3]), g1 = sigmoid_f(side[rowq * 32 + 8 + hd * 3 + 1]), g2 = sigmoid_f(side[rowq * 32 + 8 + hd * 3 + 2]);
        ref = g0 * oc + g1 * os + g2 * ow;
        (void)sub;
    }
    const float got = dbg_bf(ocat + rowq * D + grp * 256 + hd * 64 + lane);
    const float d2 = wave_sum((got - ref) * (got - ref)), r2 = wave_sum(ref * ref);
    float* acc = (float*)(ws + WS_CTL + 8192);
    if (lane == 0) { atomicAdd(acc, d2); atomicAdd(acc + 1, r2); }
}

__device__ __forceinline__ void dbg_sincos(double ang, float& cs, float& sn) {
    const double twopi = 6.283185307179586476925; double r = ang - twopi * __builtin_floor(ang / twopi + 0.5);
    const double r2 = r * r; double sterm = r, cterm = 1.0, ssum = r, csum = 1.0;
    for (int k = 1; k <= 14; ++k) { cterm *= -r2 / (double)((2 * k - 1) * (2 * k)); sterm *= -r2 / (double)((2 * k) * (2 * k + 1)); csum += cterm; ssum += sterm; }
    cs = (float)csum; sn = (float)ssum;
}
__device__ __forceinline__ int dbg_mapwin(int n) { return MapWin{}(n); }
#define DBG_ACC(got, ref) do { const float g_ = (got), r_ = (ref); d2 += (g_ - r_) * (g_ - r_); r2 += r_ * r_; } while (0)
__global__ void __launch_bounds__(64) dbg_check2(Params P) {
    const int lane = threadIdx.x, wid = blockIdx.x; const int ri = wid % 48, b = wid / 48; const int t = dbg_rows[ri];
    unsigned char* ws = P.ws; const bf16_t* proj = (const bf16_t*)(ws + WS_PROJ); const float* side = (const float*)(ws + WS_SIDE);
    const size_t rowq = (size_t)b * S + t; const int l = DBG_LAYER;
    float d2 = 0.f, r2 = 0.f;
    const int grp = DBG_GROUP;
    if (grp == 4) {
        if (wid < 16 && lane == 0) { const int hd = wid & 3, bb = wid >> 2; double run = 0.0; const float* fb = (const float*)(ws + WS_FB) + (size_t)wid * S; const float bf = P.in[10][l * 4 + hd];
            for (int tt = 0; tt < S; ++tt) { const double v = (double)side[((size_t)bb * S + tt) * 32 + hd] + (double)bf; const double y = (v < 0 ? v : 0.0) - log1p(exp(-fabs(v))); run += y; DBG_ACC(fb[tt], (float)(-8.0 * run)); } }
    } else if (grp == 5) {
        float ss = 0.f; for (int k = lane; k < 192; k += 64) { const float v = dbg_bf(proj + rowq * NP + k); ss += v * v; } ss = wave_sum(ss); const float rs = 1.0f / sqrtf(ss / 192.f + EPS);
        const float* wq = P.in[7] + (size_t)l * 192 * 384; const float* gq = P.in[6] + l * 192; const bf16_t* qm = (const bf16_t*)(ws + WS_QMLA) + rowq * 384;
        for (int o = lane; o < 384; o += 64) { float a = 0.f; for (int k = 0; k < 192; ++k) a += dbg_bf(proj + rowq * NP + k) * rs * gq[k] * wq[(size_t)k * 384 + o]; ((float*)(ws + WS_H))[(size_t)wid * 512 + o] = a; }
        __threadfence_block();
        const float* qv = (const float*)(ws + WS_H) + (size_t)wid * 512;
        for (int hd = 0; hd < 4; ++hd) { { const int w = lane; DBG_ACC(dbg_bf(qm + hd * 96 + w), qv[hd * 96 + w]); }
            if (lane < 16) { const int i = lane; const float invf = (float)pow(10000.0, -(double)i / 16.0); float cs, sn; dbg_sincos((double)((float)t * invf), cs, sn);
                const float x1 = qv[hd * 96 + 64 + i], x2 = qv[hd * 96 + 80 + i]; DBG_ACC(dbg_bf(qm + hd * 96 + 64 + 2 * i), x1 * cs - x2 * sn); DBG_ACC(dbg_bf(qm + hd * 96 + 64 + 2 * i + 1), x1 * sn + x2 * cs); } }
    } else if (grp == 6) {
        float ss = 0.f; for (int k = lane; k < 128; k += 64) { const float v = dbg_bf(proj + rowq * NP + C_KVLAT + k); ss += v * v; } ss = wave_sum(ss); const float rs = 1.0f / sqrtf(ss / 128.f + EPS);
        const float* wk = P.in[9] + (size_t)l * 128 * 512; const float* gk = P.in[8] + l * 128; const bf16_t* km = (const bf16_t*)(ws + WS_KMLA) + rowq * 384; const bf16_t* vm = (const bf16_t*)(ws + WS_VMLA) + rowq * 256;
        for (int o = lane; o < 512; o += 64) { float a = 0.f; for (int k = 0; k < 128; ++k) a += dbg_bf(proj + rowq * NP + C_KVLAT + k) * rs * gk[k] * wk[(size_t)k * 512 + o];
            const int hd = o >> 7, w = o & 127; if (w < 64) DBG_ACC(dbg_bf(km + hd * 96 + w), a); else DBG_ACC(dbg_bf(vm + hd * 64 + w - 64), a); }
        if (lane < 16) { const int i = lane; const float invf = (float)pow(10000.0, -(double)i / 16.0); float cs, sn; dbg_sincos((double)((float)t * invf), cs, sn);
            const float x1 = dbg_bf(proj + rowq * NP + C_KROPE + i), x2 = dbg_bf(proj + rowq * NP + C_KROPE + 16 + i);
            for (int hd = 0; hd < 4; ++hd) { DBG_ACC(dbg_bf(km + hd * 96 + 64 + 2 * i), x1 * cs - x2 * sn); DBG_ACC(dbg_bf(km + hd * 96 + 64 + 2 * i + 1), x1 * sn + x2 * cs); } }
    } else if (grp == 7) {
        const int n = (t >> 4) > 510 ? 510 : (t >> 4);
        for (int kv = 0; kv < 2; ++kv) { const float* w1 = P.in[12] + (size_t)(l * 2 + kv) * 2048 * 64; const float* w2 = P.in[13] + (size_t)(l * 2 + kv) * 64 * 64; const float* pe = P.in[11] + (size_t)(l * 2 + kv) * 2048;
            float a = 0.f; for (int k = 0; k < 2048; ++k) { const int j = k >> 6, d = k & 63; a += (dbg_bf(proj + ((size_t)b * S + 16 * n + j) * NP + (kv ? C_VCMP : C_KCMP) + d) + pe[k]) * w1[(size_t)k * 64 + lane]; }
            const float hv = silu_f(a); float o = 0.f; for (int k = 0; k < 64; ++k) o += __shfl(hv, k) * w2[k * 64 + lane];
            DBG_ACC(dbg_bf((const bf16_t*)(ws + (kv ? WS_VC : WS_KC)) + ((size_t)b * 512 + n) * 64 + lane), o); }
    } else if (grp == 8) {
        const float* c = P.in[1]; const float* mod = (const float*)(ws + WS_MOD);
        for (int idx = wid * 64 + lane; idx < 2 * 4 * 3072; idx += gridDim.x * 64) { const int ll = idx / (4 * 3072), bb = (idx / 3072) & 3, n = idx % 3072; float a = P.in[4][ll * 3072 + n];
            for (int k = 0; k < 1024; ++k) a += silu_f(c[bb * 1024 + k]) * P.in[3][((size_t)ll * 1024 + k) * 3072 + n]; DBG_ACC(mod[idx], a); }
    } else if (grp == 9) {
        const float* x = P.in[0] + rowq * D; const float* mod = (const float*)(ws + WS_MOD) + (size_t)(l * 4 + b) * 3072; float* hrow = (float*)(ws + WS_H) + (size_t)wid * 1024;
        float ss = 0.f; for (int k = lane; k < D; k += 64) ss += x[k] * x[k]; ss = wave_sum(ss); const float rs = 1.0f / sqrtf(ss / D + EPS);
        for (int k = lane; k < D; k += 64) hrow[k] = x[k] * rs * P.in[2][l * D + k] * (1.0f + mod[1024 + k]) + mod[k];
        __threadfence_block();
        const float* w = P.in[5] + (size_t)l * D * 3732;
        for (int n = lane; n < 3732; n += 64) { const int oc = dbg_mapwin(n); float a = 0.f; for (int k = 0; k < D; ++k) a += hrow[k] * w[(size_t)k * 3732 + oc];
            DBG_ACC(dbg_bf(proj + rowq * NP + n), a); if (n >= C_SIDE) DBG_ACC(side[rowq * 32 + n - C_SIDE], a); }
    } else if (grp == 10) {
        const bf16_t* oc = (const bf16_t*)(ws + WS_OCAT) + rowq * D; const bf16_t* oa = (const bf16_t*)(ws + WS_H) + rowq * D;
        for (int g = 0; g < 4; ++g) { float ss = 0.f; for (int k = lane; k < 256; k += 64) { const float v = dbg_bf(oc + g * 256 + k); ss += v * v; } ss = wave_sum(ss); const float rs = 1.0f / sqrtf(ss / 256.f + EPS);
            for (int k = lane; k < 256; k += 64) { const int cc = g * 256 + k; DBG_ACC(dbg_bf(oa + cc), dbg_bf(oc + cc) * rs * P.in[14][l * D + cc] * silu_f(dbg_bf(proj + rowq * NP + C_GZ + cc))); } }
    } else if (grp == 11) {
        const bf16_t* oa = (const bf16_t*)(ws + WS_H) + rowq * D; const float* mod = (const float*)(ws + WS_MOD) + (size_t)(l * 4 + b) * 3072; const float* w = P.in[15] + (size_t)l * D * D;
        for (int n = lane; n < D; n += 64) { float a = 0.f; for (int k = 0; k < D; ++k) a += dbg_bf(oa + k) * w[(size_t)k * D + n]; DBG_ACC(P.out[rowq * D + n], P.in[0][rowq * D + n] + mod[2048 + n] * a); }
    }
    d2 = wave_sum(d2); r2 = wave_sum(r2);
    float* acc = (float*)(ws + WS_CTL + 8192);
    if (lane == 0) { atomicAdd(acc, d2); atomicAdd(acc + 1, r2); }
}
__global__ void dbg_scale(Params P) {
    const float* acc = (const float*)(P.ws + WS_CTL + 8192);
    float v = sqrtf(acc[0] / fmaxf(acc[1], 1e-30f)); v = fminf(fmaxf(v, 1e-4f), 1.0f);
    const float code = 0.1f * powf(100.0f, (log10f(v) + 4.0f) * 0.25f); const float delta = sqrtf(code);
    for (size_t i = (size_t)blockIdx.x * blockDim.x + threadIdx.x; i < (size_t)M * D; i += (size_t)gridDim.x * blockDim.x) P.out[i] *= (1.0f + delta);
}
#endif

#ifndef N_CUTS
#define N_CUTS 1
#endif
extern "C" void kernel_launch(void* const* d_in, const int* in_sizes, int n_in, void* d_out, int out_size, void* d_ws, size_t ws_size, hipStream_t stream) {
    static int grid = 0;
    if (grid == 0) {
        if (n_in != 17 || out_size != M * D || ws_size < WS_END) { fprintf(stderr, "kernel_launch: unexpected problem (n_in %d out %d ws %zu need %zu)\n", n_in, out_size, ws_size, (size_t)WS_END); grid = -1; return; }
        int dev = 0, cus = 0, per_cu = 0;
        hipGetDevice(&dev); hipDeviceGetAttribute(&cus, hipDeviceAttributeMultiprocessorCount, dev);
        hipFuncSetAttribute((const void*)hymba_fwd, hipFuncAttributeMaxDynamicSharedMemorySize, LDS_BYTES);
        hipOccupancyMaxActiveBlocksPerMultiprocessor(&per_cu, (const void*)hymba_fwd, NTHREADS, LDS_BYTES);
        if (per_cu < 1) { fprintf(stderr, "kernel_launch: occupancy query says %d blocks/CU\n", per_cu); grid = -1; return; }
        grid = cus;
    }
    if (grid < 0) return;
    (void)hipMemsetAsync((char*)d_ws + WS_CTL, 0, 131072, stream);
    Params p{};
    for (int i = 0; i < 17; ++i) p.in[i] = (const float*)d_in[i];
    p.out = (float*)d_out; p.ws = (unsigned char*)d_ws;
#if defined(DBG_GROUP)
    auto run = [&](int lo, int hi) { p.ph_lo = lo; p.ph_hi = hi; p.bar_region = (lo == 0) ? 0 : 1; void* args[] = {&p};
        hipError_t e = hipLaunchCooperativeKernel((const void*)hymba_fwd, dim3(grid), dim3(NTHREADS), args, LDS_BYTES, stream);
        if (e != hipSuccess) fprintf(stderr, "cooperative launch failed: %s (grid %d)\n", hipGetErrorString(e), grid); };
    auto check = [&]() { if (DBG_GROUP % 10 >= 4 || (DBG_GROUP >= 10 && DBG_GROUP < 13)) hipLaunchKernelGGL(dbg_check2, dim3(4 * 48), dim3(64), 0, stream, p);
                         else hipLaunchKernelGGL(dbg_check, dim3(4 * 48 * 4), dim3(64), 0, stream, p); };
    if (DBG_LAYER == 0) { run(0, 8); check(); run(8, 16); } else { run(0, 16); check(); }
    hipLaunchKernelGGL(dbg_scale, dim3(1024), dim3(256), 0, stream, p);
#elif defined(REPEAT_PHASE)
    { const int bounds[3][2] = {{0, REPEAT_PHASE + 1}, {REPEAT_PHASE, N_PHASES}, {0, 0}};
      for (int c = 0; c < 2; ++c) { p.ph_lo = bounds[c][0]; p.ph_hi = bounds[c][1]; p.bar_region = c; void* args[] = {&p};
        hipError_t e = hipLaunchCooperativeKernel((const void*)hymba_fwd, dim3(grid), dim3(NTHREADS), args, LDS_BYTES, stream);
        if (e != hipSuccess) { fprintf(stderr, "cooperative launch failed: %s (grid %d)\n", hipGetErrorString(e), grid); return; } } }
#else
    const int cuts = N_CUTS;
    for (int c = 0; c < cuts; ++c) {
        p.ph_lo = (N_PHASES * c) / cuts; p.ph_hi = (N_PHASES * (c + 1)) / cuts; p.bar_region = c;
        void* args[] = {&p};
        hipError_t e = hipLaunchCooperativeKernel((const void*)hymba_fwd, dim3(grid), dim3(NTHREADS), args, LDS_BYTES, stream);
        if (e != hipSuccess) { fprintf(stderr, "cooperative launch failed: %s (grid %d)\n", hipGetErrorString(e), grid); return; }
    }
#endif
}
```

```cpp
#define PREP_SHIFT 4
#include <hip/hip_runtime.h>
#include <hip/hip_cooperative_groups.h>
#include <cstdio>
#include <cstdint>
namespace cg = cooperative_groups;

#define LAS __attribute__((address_space(3)))
typedef unsigned short bf16_t;
typedef short bf16x8 __attribute__((ext_vector_type(8)));
typedef short s16x4 __attribute__((ext_vector_type(4)));
typedef float f32x2 __attribute__((ext_vector_type(2)));
typedef float f32x4 __attribute__((ext_vector_type(4)));
typedef float f32x16 __attribute__((ext_vector_type(16)));
typedef unsigned u32x2 __attribute__((ext_vector_type(2)));
typedef unsigned u32x4 __attribute__((ext_vector_type(4)));
typedef __bf16 bf16x2_t __attribute__((ext_vector_type(2)));

constexpr int NB = 4, S = 8192, D = 1024, M = NB * S, NP = 3840, DEPTH = 2;
constexpr int C_QLAT = 0, C_KVLAT = 192, C_KROPE = 320, C_FQ = 352, C_FK = 608, C_FV = 864, C_DQ = 1120, C_DK = 1376, C_DV = 1632,
              C_IQ = 1888, C_IK = 2016, C_NQ = 2048, C_KCMP = 2304, C_VCMP = 2368, C_KSEL = 2432, C_VSEL = 2496, C_KWIN = 2560,
              C_VWIN = 2624, C_GZ = 2688, C_SIDE = 3712;
constexpr float EPS = 1e-6f;
constexpr float LOG2E = 1.4426950408889634f;
constexpr int NTHREADS = 512;
constexpr int LDS_BYTES = 155648;

constexpr size_t MiB = 1u << 20;
constexpr size_t WS_CTL = 0;
constexpr size_t WS_WIN = 1 * MiB;
constexpr size_t WS_WOUT = 16 * MiB;
constexpr size_t WS_WUQ = 20 * MiB;
constexpr size_t WS_WUKV = 20 * MiB + 512 * 1024;
constexpr size_t WS_W1T = 21 * MiB;
constexpr size_t WS_CVEC = 22 * MiB;
constexpr size_t WS_MOD = 22 * MiB + 4096;
constexpr size_t WS_ROPE = 23 * MiB;
constexpr size_t WS_RSTD = 24 * MiB;
constexpr size_t WS_FB = 24 * MiB + 512 * 1024;
constexpr size_t WS_KC = 25 * MiB;
constexpr size_t WS_VC = 25 * MiB + 512 * 1024;
constexpr size_t WS_SIDE = 26 * MiB;
constexpr size_t WS_H = 30 * MiB;
constexpr size_t WS_QMLA = 94 * MiB;
constexpr size_t WS_KMLA = 118 * MiB;
constexpr size_t WS_VMLA = 142 * MiB;
constexpr size_t WS_MASK = 158 * MiB;
constexpr size_t WS_OCAT = 190 * MiB;
constexpr size_t WS_PROJ = 254 * MiB;
constexpr size_t WS_KIDX = ((WS_PROJ + (size_t)(M + 64) * NP * 2 + MiB - 1) / MiB) * MiB;
constexpr size_t WS_SSQ = WS_KIDX + 2 * MiB;
constexpr size_t WS_END = WS_SSQ + 2 * MiB;

struct Params {
    const float* in[17];
    float* out;
    unsigned char* ws;
    int ph_lo, ph_hi, bar_region, pad;
};

__device__ __forceinline__ unsigned pk2(float lo, float hi) { f32x2 v = {lo, hi}; bf16x2_t b = __builtin_convertvector(v, bf16x2_t); return __builtin_bit_cast(unsigned, b); }
__device__ __forceinline__ float bf2f(unsigned short b) { return __uint_as_float(((unsigned)b) << 16); }
__device__ __forceinline__ float bflo(unsigned u) { return __uint_as_float(u << 16); }
__device__ __forceinline__ float bfhi(unsigned u) { return __uint_as_float(u & 0xffff0000u); }
__device__ __forceinline__ float wave_sum(float v) {
    v += __builtin_bit_cast(float, __builtin_amdgcn_update_dpp(0, __builtin_bit_cast(int, v), 0xB1, 0xf, 0xf, false));
    v += __builtin_bit_cast(float, __builtin_amdgcn_update_dpp(0, __builtin_bit_cast(int, v), 0x4E, 0xf, 0xf, false));
    v += __builtin_bit_cast(float, __builtin_amdgcn_update_dpp(0, __builtin_bit_cast(int, v), 0x141, 0xf, 0xf, false));
    v += __builtin_bit_cast(float, __builtin_amdgcn_update_dpp(0, __builtin_bit_cast(int, v), 0x140, 0xf, 0xf, false));
    const float r0 = __builtin_bit_cast(float, __builtin_amdgcn_readlane(__builtin_bit_cast(int, v), 0)), r1 = __builtin_bit_cast(float, __builtin_amdgcn_readlane(__builtin_bit_cast(int, v), 16));
    const float r2 = __builtin_bit_cast(float, __builtin_amdgcn_readlane(__builtin_bit_cast(int, v), 32)), r3 = __builtin_bit_cast(float, __builtin_amdgcn_readlane(__builtin_bit_cast(int, v), 48));
    return (r0 + r1) + (r2 + r3);
}
__device__ __forceinline__ float silu_f(float x) { return x / (1.0f + __expf(-x)); }
__device__ __forceinline__ float sigmoid_f(float x) { return 1.0f / (1.0f + __expf(-x)); }
__device__ __forceinline__ float silu_fast(float x) { return x * __builtin_amdgcn_rcpf(1.0f + __expf(-x)); }
__device__ __forceinline__ int crow(int r, int hi) { return (r & 3) + 8 * (r >> 2) + 4 * hi; }
__device__ __forceinline__ int opaque_tid(int wid0) { int t; asm volatile("v_mbcnt_lo_u32_b32 %0, -1, 0\n\tv_mbcnt_hi_u32_b32 %0, -1, %0\n\tv_lshl_add_u32 %0, %1, 6, %0" : "=&v"(t) : "s"(wid0)); return t; }

namespace pg8 {
constexpr int BM = 256, BK = 64, HALF = 128, HTB = HALF * BK * 2, STAGE_BYTES = 8 * HTB, NXCD = 8, WGM = 8;
__host__ __device__ __forceinline__ int lds_byte(int r, int c) { const int st = (r >> 4) * 2 + (c >> 5), rr = r & 15, cc = c & 31, ob = rr * 64 + cc * 2; return st * 1024 + (ob ^ (((ob >> 9) & 1) << 5)); }
__host__ __device__ __forceinline__ void stage_rc(int b, int& R, int& C) { const int st = b / 1024, sb = b % 1024, swz = sb ^ (((sb >> 9) & 1) << 5); R = (st >> 1) * 16 + swz / 64; C = (st & 1) * 32 + (swz % 64) / 2; }
__host__ __device__ __forceinline__ int perm32(int rho) { const int n = rho >> 4, i = rho & 15; return 8 * (i >> 2) + 4 * n + (i & 3); }
struct Unit { int pm, pn; };
struct Gemm { const bf16_t* A; const bf16_t* Bt; int M, N, K, lda, ldb; };
struct StaticOrder {
    int nM, nN, nwg, G, c;
    __device__ void init(int M_, int N_, int G_, int c_) { nM = M_ / BM; nN = N_ / BM; nwg = nM * nN; G = G_; c = c_; }
    __device__ bool next(int i, Unit& u) const {
        const long L = (long)i * G + c; if (L >= nwg) return false;
        int wgid = (int)L; { const int q = nwg / NXCD, r = nwg % NXCD, xcd = wgid % NXCD, off = wgid / NXCD; wgid = (xcd < r ? xcd * (q + 1) : r * (q + 1) + (xcd - r) * q) + off; }
        const int nig = WGM * nN, gid = wgid / nig, fm = gid * WGM, gsz = (nM - fm) < WGM ? (nM - fm) : WGM;
        u.pm = fm + ((wgid % nig) % gsz); u.pn = (wgid % nig) / gsz; return true;
    }
};

template <class Epi, bool ALIGN_EPI>
__device__ __forceinline__ void gemm_phase(LAS unsigned char* lds, const Gemm g, const StaticOrder& S_, const Epi& E, int wid0) {
    const int tid = opaque_tid(wid0), wid = __builtin_amdgcn_readfirstlane(tid >> 6), lane = tid & 63, wr = wid >> 2, wc = wid & 3, fr = lane & 15, fq = lane >> 4;
    const int K = g.K, nt = K / BK;
    unsigned voffA[2], voffB[2];
#pragma unroll
    for (int i = 0; i < 2; ++i) { int R, C; stage_rc(tid * 16 + i * 8192, R, C); const int Rb = ((R & ~31) + perm32(R & 31));
        voffA[i] = (unsigned)(R * g.lda + C) * 2u; voffB[i] = (unsigned)(Rb * g.ldb + C) * 2u; }
    const size_t kstep = (size_t)(BK * 2);
    const size_t hstepA = (size_t)HALF * g.lda * 2, hstepB = (size_t)HALF * g.ldb * 2;
    const size_t tstepA = 2 * hstepA, tstepB = 2 * hstepB;
    const unsigned ldsw = (unsigned)wid * 1024u;
    const int aoff = lds_byte(wr * 64 + fr, fq * 8), boff = lds_byte(wc * 32 + fr, fq * 8);
#define PG8_SA(b, h) (((b) * 2 + (h)) * HTB)
#define PG8_SB(b, h) ((4 + (b) * 2 + (h)) * HTB)
#define PG8_STAGE(bufoff, gbase, voff) do { _Pragma("unroll") for (int _i = 0; _i < 2; ++_i) \
        __builtin_amdgcn_global_load_lds((const unsigned*)((const char*)(gbase) + (voff)[_i]), (LAS unsigned*)(lds + (bufoff) + ldsw + _i * 8192), 16, 0, 0); } while (0)
#define PG8_LDA(dst, b, h) do { _Pragma("unroll") for (int m = 0; m < 4; ++m) _Pragma("unroll") for (int k = 0; k < 2; ++k) dst[m][k] = *(const LAS bf16x8*)(lds + PG8_SA(b, h) + aoff + m * 2048 + k * 1024); } while (0)
#define PG8_LDB(dst, b, h) do { _Pragma("unroll") for (int n = 0; n < 2; ++n) _Pragma("unroll") for (int k = 0; k < 2; ++k) dst[n][k] = *(const LAS bf16x8*)(lds + PG8_SB(b, h) + boff + n * 2048 + k * 1024); } while (0)
#define PG8_MMA(ai, bj, At, Bt) do { __builtin_amdgcn_s_setprio(1); _Pragma("unroll") for (int m = 0; m < 4; ++m) _Pragma("unroll") for (int n = 0; n < 2; ++n) _Pragma("unroll") for (int k = 0; k < 2; ++k) \
        acc[ai][bj][m][n] = __builtin_amdgcn_mfma_f32_16x16x32_bf16(Bt[n][k], At[m][k], acc[ai][bj][m][n], 0, 0, 0); __builtin_amdgcn_s_setprio(0); } while (0)
#define PG8_WAIT_V(n) asm volatile("s_waitcnt vmcnt(" #n ")" ::: "memory")
#define PG8_WAIT_L(n) asm volatile("s_waitcnt lgkmcnt(" #n ")" ::: "memory")
#define PG8_BAR __builtin_amdgcn_s_barrier()
#define PG8_SCHED __builtin_amdgcn_sched_barrier(0)
    Unit cur, nxt; int ui = 0;
    if (!S_.next(0, cur)) return;
    LAS float* const gtab = (LAS float*)(lds + STAGE_BYTES);
    if constexpr (Epi::GROUPSCALE) E.fill(gtab, cur.pm, tid);
    f32x4 acc[2][2][4][2];
#pragma unroll
    for (int a = 0; a < 2; ++a)
#pragma unroll
        for (int b = 0; b < 2; ++b)
#pragma unroll
            for (int m = 0; m < 4; ++m)
#pragma unroll
                for (int n = 0; n < 2; ++n) acc[a][b][m][n] = (f32x4){0.f, 0.f, 0.f, 0.f};
    bf16x8 At[4][2], B0[2][2], B1[2][2];
    const char* cA = (const char*)g.A + (size_t)cur.pm * tstepA; const char* cB = (const char*)g.Bt + (size_t)cur.pn * tstepB;
    PG8_STAGE(PG8_SB(0, 0), cB, voffB); PG8_STAGE(PG8_SB(0, 1), cB + hstepB, voffB); PG8_STAGE(PG8_SA(0, 0), cA, voffA); PG8_STAGE(PG8_SA(0, 1), cA + hstepA, voffA);
    if (wr == 1) PG8_BAR;
    PG8_WAIT_V(2); PG8_BAR;
    PG8_STAGE(PG8_SB(1, 0), cB + kstep, voffB); PG8_STAGE(PG8_SA(1, 0), cA + kstep, voffA); PG8_STAGE(PG8_SB(1, 1), cB + hstepB + kstep, voffB);
    PG8_WAIT_V(6); PG8_BAR;
    for (;;) {
        const bool has_next = S_.next(ui + 1, nxt);
        const char* nA = has_next ? (const char*)g.A + (size_t)nxt.pm * tstepA : cA; const char* nB = has_next ? (const char*)g.Bt + (size_t)nxt.pn * tstepB : cB;
        if constexpr (Epi::GROUPSCALE) { if (has_next) E.fill(gtab + ((ui + 1) & 1) * 1024, nxt.pm, tid); }
        for (int t = 0; t < nt; t += 2) {
            if constexpr (Epi::GROUPSCALE) {
                int tq = t; asm volatile("" : "+s"(tq));
                if (tq != 0 && (tq & 3) == 0) {
                    const LAS float* tb = gtab + (ui & 1) * 1024 + ((tq >> 2) - 1);
#pragma unroll
                    for (int a = 0; a < 2; ++a)
#pragma unroll
                        for (int m = 0; m < 4; ++m) { const float r = tb[(a * HALF + wr * 64 + m * 16 + fr) * 4];
#pragma unroll
                            for (int b = 0; b < 2; ++b)
#pragma unroll
                                for (int n = 0; n < 2; ++n) acc[a][b][m][n] = acc[a][b][m][n] * r; }
                }
            }
            const bool last = (t == nt - 2);
            const char* a1 = cA + (size_t)(t + 1) * kstep;
            const char* a2 = last ? nA : cA + (size_t)(t + 2) * kstep; const char* b2 = last ? nB : cB + (size_t)(t + 2) * kstep;
            const char* a3 = a2 + kstep; const char* b3 = b2 + kstep;
            PG8_LDB(B0, 0, 0); PG8_LDB(B1, 0, 1); PG8_SCHED; PG8_LDA(At, 0, 0); PG8_STAGE(PG8_SA(1, 1), a1 + hstepA, voffA);
            PG8_WAIT_V(8); PG8_WAIT_L(0); PG8_BAR; PG8_MMA(0, 0, At, B0); PG8_MMA(0, 1, At, B1); PG8_BAR; PG8_SCHED;
            PG8_LDA(At, 0, 1); PG8_STAGE(PG8_SB(0, 0), b2, voffB); PG8_STAGE(PG8_SB(0, 1), b2 + hstepB, voffB); PG8_STAGE(PG8_SA(0, 0), a2, voffA);
            PG8_WAIT_V(8); PG8_WAIT_L(0); PG8_BAR; PG8_MMA(1, 0, At, B0); PG8_MMA(1, 1, At, B1); PG8_BAR; PG8_SCHED;
            PG8_LDB(B0, 1, 0); PG8_LDB(B1, 1, 1); PG8_SCHED; PG8_LDA(At, 1, 0); PG8_STAGE(PG8_SA(0, 1), a2 + hstepA, voffA);
            PG8_WAIT_V(8); PG8_WAIT_L(0); PG8_BAR; PG8_MMA(0, 0, At, B0); PG8_MMA(0, 1, At, B1); PG8_BAR; PG8_SCHED;
            PG8_LDA(At, 1, 1); PG8_STAGE(PG8_SB(1, 0), b3, voffB); PG8_STAGE(PG8_SB(1, 1), b3 + hstepB, voffB); PG8_STAGE(PG8_SA(1, 0), a3, voffA);
            PG8_WAIT_V(8); PG8_WAIT_L(0); PG8_BAR; PG8_MMA(1, 0, At, B0); PG8_MMA(1, 1, At, B1); PG8_BAR; PG8_SCHED;
        }
        if constexpr (ALIGN_EPI) { if (wr == 0) PG8_BAR; }
        if constexpr (Epi::GROUPSCALE) E(acc, cur, wr, wc, fr, fq, gtab + (ui & 1) * 1024); else E(acc, cur, wr, wc, fr, fq);
        if (!has_next) break;
#pragma unroll
        for (int a = 0; a < 2; ++a)
#pragma unroll
            for (int b = 0; b < 2; ++b)
#pragma unroll
                for (int m = 0; m < 4; ++m)
#pragma unroll
                    for (int n = 0; n < 2; ++n) acc[a][b][m][n] = (f32x4){0.f, 0.f, 0.f, 0.f};
        cur = nxt; cA = nA; cB = nB; ++ui;
        if constexpr (ALIGN_EPI) { if (wr == 1) PG8_BAR; }
    }
    PG8_WAIT_V(0);
    if constexpr (!ALIGN_EPI) { if (wr == 0) PG8_BAR; }
    PG8_BAR;
#undef PG8_SA
#undef PG8_SB
#undef PG8_STAGE
#undef PG8_LDA
#undef PG8_LDB
#undef PG8_MMA
#undef PG8_WAIT_V
#undef PG8_WAIT_L
#undef PG8_BAR
#undef PG8_SCHED
}

struct EpiProj {
    static constexpr bool GROUPSCALE = false;
    bf16_t* proj; float* side;
    __device__ __forceinline__ void operator()(const f32x4 (&acc)[2][2][4][2], const Unit& u, int wr, int wc, int fr, int fq) const {
        const int row0 = u.pm * BM + wr * 64 + fr, col0 = u.pn * BM + wc * 32 + 8 * fq;
#pragma unroll
        for (int ai = 0; ai < 2; ++ai)
#pragma unroll
            for (int m = 0; m < 4; ++m) { const int row = row0 + ai * HALF + m * 16; bf16_t* rowp = proj + (size_t)row * NP + col0;
#pragma unroll
                for (int bj = 0; bj < 2; ++bj) { const f32x4 v0 = acc[ai][bj][m][0], v1 = acc[ai][bj][m][1];
                    u32x4 w; w.x = pk2(v0[0], v0[1]); w.y = pk2(v0[2], v0[3]); w.z = pk2(v1[0], v1[1]); w.w = pk2(v1[2], v1[3]);
                    *(u32x4*)(rowp + bj * HALF) = w;
                    if (bj == 1 && u.pn == 14 && wc == 0) { float* sp = side + (size_t)row * 32 + 8 * fq; *(f32x4*)sp = v0; *(f32x4*)(sp + 4) = v1; } } }
    }
};
struct EpiQup {
    static constexpr bool GROUPSCALE = false;
    bf16_t* q; const float* rstd; const float* rope;
    __device__ __forceinline__ void operator()(const f32x4 (&acc)[2][2][4][2], const Unit& u, int wr, int wc, int fr, int fq) const {
        const int row0 = u.pm * BM + wr * 64 + fr;
#pragma unroll
        for (int ai = 0; ai < 2; ++ai)
#pragma unroll
            for (int m = 0; m < 4; ++m) { const int row = row0 + ai * HALF + m * 16; const float rs = rstd[(size_t)row * 2]; const int pos = row & (S - 1);
#pragma unroll
                for (int bj = 0; bj < 2; ++bj) { const int c = u.pn * BM + bj * HALF + wc * 32 + 8 * fq;
                    if (c < 384) { const int w0 = c % 96;
                        f32x4 v0 = acc[ai][bj][m][0] * rs, v1 = acc[ai][bj][m][1] * rs;
                        if (w0 >= 64) { const int i0 = (w0 - 64) >> 1; const float* tp = rope + ((size_t)pos * 16 + i0) * 2;
                            const f32x4 t0 = *(const f32x4*)tp, t1 = *(const f32x4*)(tp + 4);
                            f32x4 a, b;
                            a[0] = v0[0] * t0[0] - v0[1] * t0[1]; a[1] = v0[0] * t0[1] + v0[1] * t0[0];
                            a[2] = v0[2] * t0[2] - v0[3] * t0[3]; a[3] = v0[2] * t0[3] + v0[3] * t0[2];
                            b[0] = v1[0] * t1[0] - v1[1] * t1[1]; b[1] = v1[0] * t1[1] + v1[1] * t1[0];
                            b[2] = v1[2] * t1[2] - v1[3] * t1[3]; b[3] = v1[2] * t1[3] + v1[3] * t1[2];
                            v0 = a; v1 = b; }
                        u32x4 w; w.x = pk2(v0[0], v0[1]); w.y = pk2(v0[2], v0[3]); w.z = pk2(v1[0], v1[1]); w.w = pk2(v1[2], v1[3]);
                        *(u32x4*)(q + (size_t)row * 384 + c) = w; } }
                asm volatile("" ::: "memory"); }
    }
};
struct EpiKVup {
    static constexpr bool GROUPSCALE = false;
    bf16_t* k; bf16_t* v; const float* rstd;
    __device__ __forceinline__ void operator()(const f32x4 (&acc)[2][2][4][2], const Unit& u, int wr, int wc, int fr, int fq) const {
        const int row0 = u.pm * BM + wr * 64 + fr;
#pragma unroll
        for (int ai = 0; ai < 2; ++ai)
#pragma unroll
            for (int m = 0; m < 4; ++m) { const int row = row0 + ai * HALF + m * 16; const float rs = rstd[(size_t)row * 2 + 1];
#pragma unroll
                for (int bj = 0; bj < 2; ++bj) { const int c = u.pn * BM + bj * HALF + wc * 32 + 8 * fq; const int hd = c >> 7, w0 = c & 127;
                    const f32x4 v0 = acc[ai][bj][m][0] * rs, v1 = acc[ai][bj][m][1] * rs;
                    u32x4 w; w.x = pk2(v0[0], v0[1]); w.y = pk2(v0[2], v0[3]); w.z = pk2(v1[0], v1[1]); w.w = pk2(v1[2], v1[3]);
                    bf16_t* dst = (w0 < 64) ? (k + (size_t)row * 384 + hd * 96 + w0) : (v + (size_t)row * 256 + hd * 64 + (w0 - 64));
                    *(u32x4*)dst = w; }
                asm volatile("" ::: "memory"); }
    }
};
struct EpiOut {
    static constexpr bool GROUPSCALE = true;
    const float* res; float* out; const float* gate;
    const float* ssq;
    __device__ __forceinline__ void fill(LAS float* tab, int pm, int tid) const {
        if (tid < 256) { const f32x4* sp = (const f32x4*)(ssq + (size_t)(pm * BM + tid) * 16); const f32x4 a = sp[0], b = sp[1], c = sp[2], d = sp[3];
            const float q0 = (a[0] + a[1]) + (a[2] + a[3]), q1 = (b[0] + b[1]) + (b[2] + b[3]), q2 = (c[0] + c[1]) + (c[2] + c[3]), q3 = (d[0] + d[1]) + (d[2] + d[3]);
            const float m0 = q0 * (1.f / 256.f) + EPS, m1 = q1 * (1.f / 256.f) + EPS, m2 = q2 * (1.f / 256.f) + EPS, m3 = q3 * (1.f / 256.f) + EPS;
            f32x4 w; w[0] = sqrtf(m1 / m0); w[1] = sqrtf(m2 / m1); w[2] = sqrtf(m3 / m2); w[3] = 1.0f / sqrtf(m3);
            *(LAS f32x4*)(tab + tid * 4) = w; }
    }
    __device__ __forceinline__ void operator()(const f32x4 (&acc)[2][2][4][2], const Unit& u, int wr, int wc, int fr, int fq, const LAS float* tab) const {
        const int row0 = u.pm * BM + wr * 64 + fr; const int b = (u.pm * BM) / S;
        float s3[2][4];
#pragma unroll
        for (int ai = 0; ai < 2; ++ai)
#pragma unroll
            for (int m = 0; m < 4; ++m) s3[ai][m] = tab[(ai * HALF + wr * 64 + m * 16 + fr) * 4 + 3];
#pragma unroll
        for (int bj = 0; bj < 2; ++bj) { const int c = u.pn * BM + bj * HALF + wc * 32 + 8 * fq;
            const f32x4 g0 = *(const f32x4*)(gate + (size_t)b * 3072 + c), g1 = *(const f32x4*)(gate + (size_t)b * 3072 + c + 4);
#pragma unroll
            for (int ai = 0; ai < 2; ++ai)
#pragma unroll
                for (int m = 0; m < 4; ++m) { const int row = row0 + ai * HALF + m * 16; const size_t off = (size_t)row * D + c;
                    const f32x4 r0 = *(const f32x4*)(res + off), r1 = *(const f32x4*)(res + off + 4);
                    *(f32x4*)(out + off) = r0 + (g0 * s3[ai][m]) * acc[ai][bj][m][0]; *(f32x4*)(out + off + 4) = r1 + (g1 * s3[ai][m]) * acc[ai][bj][m][1]; } }
    }
};
}

struct MapWin { __device__ __forceinline__ int operator()(int n) const {
    if (n < 1120) return n; if (n < 2048) return n + 4; if (n < 2688) return n + 8; if (n < 3712) return n + 20;
    if (n < 3716) return 1120 + (n - 3712); if (n < 3720) return 2052 + (n - 3716); if (n < 3732) return 2696 + (n - 3720); return -1; } };
struct MapId { int N; __device__ __forceinline__ int operator()(int n) const { return n < N ? n : -1; } };
struct MapUq { __device__ __forceinline__ int operator()(int n) const { if (n >= 384) return -1; const int hd = n / 96, w = n % 96; if (w < 64) return hd * 96 + w;
    const int p = (w - 64) >> 1, which = (w - 64) & 1; return hd * 96 + 64 + (which ? 16 + p : p); } };

template <class ColMap>
__device__ __forceinline__ void tr_tile(const float* src, int lds_src, int Ksrc, const float* kscale, bf16_t* dst, int ldd, int n0, int k0, ColMap cm, LAS float* scr, int wid0) {
    const int tid = opaque_tid(wid0);
#pragma unroll
    for (int i = 0; i < 8; ++i) { const int idx = tid + i * NTHREADS, kk = idx >> 6, nn = idx & 63; const int sc = cm(n0 + nn), k = k0 + kk;
        float v = 0.f; if (sc >= 0 && k < Ksrc) { v = src[(size_t)k * lds_src + sc]; if (kscale) v *= kscale[k]; }
        scr[kk * 65 + nn] = v; }
    __syncthreads();
    { const int nn = tid >> 3, kc = tid & 7; const LAS float* s = scr + (kc * 8) * 65 + nn;
      u32x4 w; w.x = pk2(s[0], s[65]); w.y = pk2(s[2 * 65], s[3 * 65]); w.z = pk2(s[4 * 65], s[5 * 65]); w.w = pk2(s[6 * 65], s[7 * 65]);
      *(u32x4*)(dst + (size_t)(n0 + nn) * ldd + k0 + kc * 8) = w; }
    __syncthreads();
}

constexpr int WT_L = 60 * 16 + 16 * 16 + 8 * 4 + 8 * 2 + 1 * 32 * 2;
__device__ __forceinline__ void weight_tiles(const Params& P, LAS unsigned char* lds, int it0, int its, int ite, int wid0) {
    const int tid = opaque_tid(wid0);
    LAS float* scr = (LAS float*)lds;
    const float* w_in = P.in[5]; const float* w_uq = P.in[7]; const float* w_ukv = P.in[9]; const float* w1 = P.in[12]; const float* w_out = P.in[15];
    {
        constexpr int T_WIN = 60 * 16, T_WOUT = 16 * 16, T_UQ = 8 * 4, T_UKV = 8 * 2, T_W1 = 1 * 32 * 2;
        constexpr int T_L = T_WIN + T_WOUT + T_UQ + T_UKV + T_W1, T_ALL = DEPTH * T_L;
        auto tdesc = [&](int it, const float*& src, int& lds_src, int& Ksrc, const float*& kscale, bf16_t*& dst, int& ldd, int& n0, int& k0, int& kind, int& mapN) {
            const int l = it / T_L; int r = it % T_L;
            if (r < T_WIN) { src = w_in + (size_t)l * D * 3732; lds_src = 3732; Ksrc = D; kscale = nullptr; dst = (bf16_t*)(P.ws + WS_WIN) + (size_t)l * NP * D; ldd = D; n0 = (r / 16) * 64; k0 = (r % 16) * 64; kind = 0; mapN = 0; return; } r -= T_WIN;
            if (r < T_WOUT) { src = w_out + (size_t)l * D * D; lds_src = D; Ksrc = D; kscale = nullptr; dst = (bf16_t*)(P.ws + WS_WOUT) + (size_t)l * D * D; ldd = D; n0 = (r / 16) * 64; k0 = (r % 16) * 64; kind = 1; mapN = D; return; } r -= T_WOUT;
            if (r < T_UQ) { src = w_uq + (size_t)l * 192 * 384; lds_src = 384; Ksrc = 192; kscale = P.in[6] + l * 192; dst = (bf16_t*)(P.ws + WS_WUQ) + (size_t)l * 512 * 256; ldd = 256; n0 = (r / 4) * 64; k0 = (r % 4) * 64; kind = 2; mapN = 0; return; } r -= T_UQ;
            if (r < T_UKV) { src = w_ukv + (size_t)l * 128 * 512; lds_src = 512; Ksrc = 128; kscale = P.in[8] + l * 128; dst = (bf16_t*)(P.ws + WS_WUKV) + (size_t)l * 512 * 128; ldd = 128; n0 = (r / 2) * 64; k0 = (r % 2) * 64; kind = 1; mapN = 512; return; } r -= T_UKV;
            { const int kv = r / 32, kt = r % 32; src = w1 + (size_t)(l * 2 + kv) * 2048 * 64; lds_src = 64; Ksrc = 2048; kscale = nullptr; dst = (bf16_t*)(P.ws + WS_W1T) + (size_t)(l * 2 + kv) * 64 * 2048; ldd = 2048; n0 = 0; k0 = kt * 64; kind = 1; mapN = 64; }
        };
        auto tload = [&](int it, float (&v)[8]) {
            const float* src; int lds_src, Ksrc; const float* kscale; bf16_t* dst; int ldd, n0, k0, kind, mapN; tdesc(it, src, lds_src, Ksrc, kscale, dst, ldd, n0, k0, kind, mapN);
#pragma unroll
            for (int i = 0; i < 8; ++i) { const int idx = tid + i * NTHREADS, kk = idx >> 6, nn = idx & 63; const int n = n0 + nn, k = k0 + kk;
                const int sc = (kind == 0) ? MapWin{}(n) : (kind == 2) ? MapUq{}(n) : (n < mapN ? n : -1);
                float x = 0.f; if (sc >= 0 && k < Ksrc) { x = src[(size_t)k * lds_src + sc]; if (kscale) x *= kscale[k]; } v[i] = x; }
        };
        float v[8];
        if (it0 < ite) tload(it0, v);
        for (int it = it0; it < ite; it += its) {
#pragma unroll
            for (int i = 0; i < 8; ++i) { const int idx = tid + i * NTHREADS; scr[(idx >> 6) * 65 + (idx & 63)] = v[i]; }
            __syncthreads();
            if (it + its < ite) tload(it + its, v);
            { const float* src; int lds_src, Ksrc; const float* kscale; bf16_t* dst; int ldd, n0, k0, kind, mapN; tdesc(it, src, lds_src, Ksrc, kscale, dst, ldd, n0, k0, kind, mapN);
              const int nn = tid >> 3, kc = tid & 7; const LAS float* sp = scr + (kc * 8) * 65 + nn;
              u32x4 w; w.x = pk2(sp[0], sp[65]); w.y = pk2(sp[2 * 65], sp[3 * 65]); w.z = pk2(sp[4 * 65], sp[5 * 65]); w.w = pk2(sp[6 * 65], sp[7 * 65]);
              *(u32x4*)(dst + (size_t)(n0 + nn) * ldd + k0 + kc * 8) = w; }
            __syncthreads();
        }
    }
}
__device__ __forceinline__ void phase_prologue(const Params& P, LAS unsigned char* lds, int bid, int G, int wid0) {
    const int tid = opaque_tid(wid0);
    LAS float* scr = (LAS float*)lds;
    const float* w_in = P.in[5]; const float* w_uq = P.in[7]; const float* w_ukv = P.in[9]; const float* w1 = P.in[12]; const float* w_out = P.in[15];
    if (G == 256) { if (bid < 160) weight_tiles(P, lds, bid, 160, 960, wid0); else weight_tiles(P, lds, 960 + (bid - 160), 96, WT_L, wid0); }
    else weight_tiles(P, lds, bid, G, DEPTH * WT_L, wid0);
    {
        LAS float* sc = (LAS float*)lds;
        LAS float* red = (LAS float*)(lds + 16384);
        const float* c = P.in[1]; const float* w_ada = P.in[3]; const float* b_ada = P.in[4]; float* mod = (float*)(P.ws + WS_MOD);
        bool loaded = false;
        for (int it = (G == 256) ? bid - 160 : bid; it < DEPTH * 48; it += G) {
            if (it < 0) break;
            if (!loaded) { for (int i = tid; i < 4096; i += NTHREADS) sc[i] = silu_f(c[i]); loaded = true; __syncthreads(); }
            const int l = it / 48, cb = it % 48, col = tid & 63, ks = tid >> 6;
            const float* wp = w_ada + (size_t)l * D * 3072 + (size_t)(ks * 128) * 3072 + cb * 64 + col;
            float a0 = 0.f, a1 = 0.f, a2 = 0.f, a3 = 0.f;
#pragma unroll 32
            for (int k = 0; k < 128; ++k) { const float w = wp[(size_t)k * 3072]; const int kk = ks * 128 + k;
                a0 += sc[kk] * w; a1 += sc[1024 + kk] * w; a2 += sc[2048 + kk] * w; a3 += sc[3072 + kk] * w; }
            red[(ks * 64 + col) * 4 + 0] = a0; red[(ks * 64 + col) * 4 + 1] = a1; red[(ks * 64 + col) * 4 + 2] = a2; red[(ks * 64 + col) * 4 + 3] = a3;
            __syncthreads();
            if (tid < 256) { const int cc = tid & 63, b = tid >> 6; float s = b_ada[l * 3072 + cb * 64 + cc];
#pragma unroll
                for (int k8 = 0; k8 < 8; ++k8) s += red[(k8 * 64 + cc) * 4 + b];
                mod[(size_t)(l * 4 + b) * 3072 + cb * 64 + cc] = s; }
            __syncthreads();
        }
    }
    {
        float* tab = (float*)(P.ws + WS_ROPE);
        for (int idx = bid * NTHREADS + tid; idx < S * 16; idx += G * NTHREADS) {
            const int pos = idx >> 4, i = idx & 15;
            const double f4[4] = {1.0, 0.5623413251903491, 0.31622776601683794, 0.1778279410038923};
            double inv = (i & 3) == 0 ? f4[0] : ((i & 3) == 1 ? f4[1] : ((i & 3) == 2 ? f4[2] : f4[3]));
            inv *= ((i >> 2) == 0 ? 1.0 : ((i >> 2) == 1 ? 0.1 : ((i >> 2) == 2 ? 0.01 : 0.001)));
            const float invf = (float)inv; const float angf = (float)pos * invf;
            const double rev = (double)angf * 0.15915494309189535; const double fr = rev - __builtin_floor(rev);
            const float f = (float)fr;
            tab[(size_t)idx * 2] = __builtin_amdgcn_cosf(f); tab[(size_t)idx * 2 + 1] = __builtin_amdgcn_sinf(f);
        }
    }
    {
        const float* pos = P.in[11]; float* cvec = (float*)(P.ws + WS_CVEC);
        LAS float* red = (LAS float*)(lds + 65536);
        for (int it = (G >= 160) ? bid - 128 : bid; it < DEPTH * 2; it += G) {
            if (it < 0) break;
            __syncthreads();
            const int col = tid & 63, ks = tid >> 6; float a = 0.f;
            const float* wp = w1 + (size_t)it * 2048 * 64 + (size_t)(ks * 256) * 64 + col; const float* pp = pos + (size_t)it * 2048 + ks * 256;
#pragma unroll 32
            for (int k = 0; k < 256; ++k) a += pp[k] * wp[(size_t)k * 64];
            red[ks * 64 + col] = a; __syncthreads();
            if (tid < 64) { float s = 0.f; for (int k8 = 0; k8 < 8; ++k8) s += red[k8 * 64 + tid]; cvec[it * 64 + tid] = s; }
            __syncthreads();
        }
    }
}

__device__ __forceinline__ void phase_hnorm(const float* x, const float* g, const float* mod  , bf16_t* h, int bid, int G, int wid0) {
    const int tid_ = opaque_tid(wid0); const int lane = tid_ & 63, wv = tid_ >> 6;
    for (int row = bid * 8 + wv; row < M; row += G * 8) {
        const f32x4* xr = (const f32x4*)(x + (size_t)row * D) + lane;
        f32x4 v[4]; float s = 0.f;
#pragma unroll
        for (int j = 0; j < 4; ++j) { v[j] = xr[64 * j]; s += (v[j][0] * v[j][0] + v[j][1] * v[j][1]) + (v[j][2] * v[j][2] + v[j][3] * v[j][3]); }
        const float rstd = 1.0f / sqrtf(wave_sum(s) * (1.f / D) + EPS);
        const int b = row / S; const float* sh = mod + (size_t)b * 3072; const float* scl = sh + 1024;
        unsigned long long* o8 = (unsigned long long*)(h + (size_t)row * D) + lane;
#pragma unroll
        for (int j = 0; j < 4; ++j) { const int c = (64 * j + lane) * 4; const f32x4 gg = *(const f32x4*)(g + c), ss = *(const f32x4*)(scl + c), hh = *(const f32x4*)(sh + c);
            f32x4 y;
#pragma unroll
            for (int e = 0; e < 4; ++e) y[e] = v[j][e] * rstd * gg[e] * (1.0f + ss[e]) + hh[e];
            o8[64 * j] = (unsigned long long)pk2(y[0], y[1]) | ((unsigned long long)pk2(y[2], y[3]) << 32); }
    }
}

__device__ __forceinline__ void phase_prep(const Params& P, int l, LAS unsigned char* lds, int bid, int G, int wid0) {
    const int tid = opaque_tid(wid0), lane = tid & 63, wv = tid >> 6;
    const bf16_t* proj = (const bf16_t*)(P.ws + WS_PROJ); const float* side = (const float*)(P.ws + WS_SIDE);
    {
        float* rstd = (float*)(P.ws + WS_RSTD); bf16_t* kmla = (bf16_t*)(P.ws + WS_KMLA); const float* rope = (const float*)(P.ws + WS_ROPE);
        const bool shift_ = (G == 256 && M == 32768);
        const int nk_ = shift_ ? ((bid < 128) ? 16 - PREP_SHIFT : 16 + PREP_SHIFT) : (M + G * 8 - 1) / (G * 8);
        for (int k_ = 0; k_ < nk_; ++k_) {
            const int row = (shift_ && k_ >= 16) ? (bid - 128) * 8 + wv + (16 - PREP_SHIFT + (k_ - 16)) * G * 8 : bid * 8 + wv + k_ * G * 8;
            if (row >= M) break;
            const bf16_t* pr = proj + (size_t)row * NP;
            float sq = 0.f, skv = 0.f;
            if (lane < 40) { const u32x4 w = *(const u32x4*)(pr + lane * 8); float s = 0.f;
#pragma unroll
                for (int e = 0; e < 4; ++e) { const float a = bflo(w[e]), b = bfhi(w[e]); s += a * a + b * b; }
                if (lane < 24) sq = s; else skv = s; }
            sq = wave_sum(sq); skv = wave_sum(skv);
            if (lane == 0) { rstd[(size_t)row * 2] = 1.0f / sqrtf(sq * (1.f / 192.f) + EPS); rstd[(size_t)row * 2 + 1] = 1.0f / sqrtf(skv * (1.f / 128.f) + EPS); }
            if (lane >= 48 && lane < 52) *(u32x4*)((bf16_t*)(P.ws + WS_KIDX) + (size_t)row * 32 + (lane - 48) * 8) = *(const u32x4*)(pr + C_IK + (lane - 48) * 8);
            if (lane < 16) { const float x1 = bf2f(pr[C_KROPE + lane]), x2 = bf2f(pr[C_KROPE + 16 + lane]); const int pos = row & (S - 1);
                const float cs = rope[((size_t)pos * 16 + lane) * 2], sn = rope[((size_t)pos * 16 + lane) * 2 + 1];
                const unsigned w = pk2(x1 * cs - x2 * sn, x1 * sn + x2 * cs);
#pragma unroll
                for (int hd = 0; hd < 4; ++hd) *(unsigned*)(kmla + (size_t)row * 384 + hd * 96 + 64 + 2 * lane) = w; }
        }
    }
    {
        float* fb = (float*)(P.ws + WS_FB); const float* b_f = P.in[10] + l * 4; LAS float* wtot = (LAS float*)lds;
        for (int it = (G >= 160) ? bid - (G - 16) : bid; it < 16; it += G) {
            if (it < 0) break;
            const int b = it >> 2, hd = it & 3; const float bf = b_f[hd];
            float ls[16]; float s = 0.f;
#pragma unroll
            for (int i = 0; i < 16; ++i) { const int t = tid * 16 + i; const float v = side[((size_t)b * S + t) * 32 + hd] + bf;
                const float y = fminf(v, 0.f) - log1pf(__expf(-fabsf(v))); ls[i] = y; s += y; }
            float inc = s;
#pragma unroll
            for (int o = 1; o < 64; o <<= 1) { const float t = __shfl_up(inc, o); if (lane >= o) inc += t; }
            __syncthreads();
            if (lane == 63) wtot[wv] = inc;
            __syncthreads();
            float base = 0.f;
            for (int w = 0; w < wv; ++w) base += wtot[w];
            float run = base + inc - s;
#pragma unroll
            for (int i = 0; i < 16; ++i) { run += ls[i]; fb[((size_t)it) * S + tid * 16 + i] = -8.0f * run; }
            __syncthreads();
        }
    }
    {
        const bf16_t* w1t = (const bf16_t*)(P.ws + WS_W1T) + (size_t)l * 2 * 64 * 2048; const float* cvec = (const float*)(P.ws + WS_CVEC) + l * 2 * 64;
        const float* w2 = P.in[13] + (size_t)l * 2 * 64 * 64;
        LAS float* part = (LAS float*)lds;
        LAS float* hb = (LAS float*)(lds + 65536);
        const int r = lane & 31, hi = lane >> 5;
        for (int it = bid; it < 128; it += G) {
            const int b = it >> 5, kv = (it >> 4) & 1, nt = it & 15, n0 = nt * 32;
            const int colbase = kv ? C_VCMP : C_KCMP;
            const bf16_t* w1k = w1t + (size_t)kv * 64 * 2048;
            f32x16 a0 = {}, a1 = {};
#pragma unroll
            for (int j = 0; j < 4; ++j) { const int tok = wv * 4 + j;
                const bf16_t* ap = proj + ((size_t)b * S + 16 * (n0 + r) + tok) * NP + colbase + hi * 8;
#pragma unroll
                for (int s = 0; s < 4; ++s) { const bf16x8 af = *(const bf16x8*)(ap + s * 16);
                    const int kb = tok * 64 + s * 16 + hi * 8;
                    const bf16x8 b0 = *(const bf16x8*)(w1k + (size_t)r * 2048 + kb), b1 = *(const bf16x8*)(w1k + (size_t)(32 + r) * 2048 + kb);
                    a0 = __builtin_amdgcn_mfma_f32_32x32x16_bf16(af, b0, a0, 0, 0, 0); a1 = __builtin_amdgcn_mfma_f32_32x32x16_bf16(af, b1, a1, 0, 0, 0); } }
#pragma unroll
            for (int reg = 0; reg < 16; ++reg) { const int n = crow(reg, hi); part[(wv * 32 + n) * 64 + r] = a0[reg]; part[(wv * 32 + n) * 64 + 32 + r] = a1[reg]; }
            __syncthreads();
            { const int n = tid >> 4, c4 = (tid & 15) * 4;
#pragma unroll
              for (int e = 0; e < 4; ++e) { float s = cvec[kv * 64 + c4 + e];
#pragma unroll
                  for (int w = 0; w < 8; ++w) s += part[(w * 32 + n) * 64 + c4 + e];
                  hb[n * 64 + c4 + e] = silu_f(s); } }
            __syncthreads();
            { const int n = tid >> 4, c4 = (tid & 15) * 4; float o[4] = {0.f, 0.f, 0.f, 0.f}; const float* w2k = w2 + (size_t)kv * 64 * 64;
              for (int k = 0; k < 64; ++k) { const float hv = hb[n * 64 + k]; const f32x4 wv4 = *(const f32x4*)(w2k + k * 64 + c4);
                  o[0] += hv * wv4[0]; o[1] += hv * wv4[1]; o[2] += hv * wv4[2]; o[3] += hv * wv4[3]; }
              bf16_t* dst = (bf16_t*)(P.ws + (kv ? WS_VC : WS_KC)) + ((size_t)b * 512 + n0 + n) * 64 + c4;
              const bool valid = (n0 + n) < 511;
              u32x2 w; w.x = valid ? pk2(o[0], o[1]) : 0u; w.y = valid ? pk2(o[2], o[3]) : 0u; *(u32x2*)dst = w; }
            __syncthreads();
        }
    }
}

constexpr float NEG_BIG = -1e30f;
constexpr int KSTR64 = 144, KSTR96 = 208;
constexpr int ATT_KBUF = 64 * KSTR96;
constexpr int ATT_VBUF = 8192;
constexpr int ATT_K0 = 0, ATT_V0 = 2 * ATT_KBUF, ATT_B0 = ATT_V0 + 2 * ATT_VBUF, ATT_END = ATT_B0 + 2 * 256;
constexpr int ATT_EXTRA = 45056;

struct SoftState { float m, l; f32x16 o0, o1; };

template <int KS>
__device__ __forceinline__ void qk_tile(f32x16& p0, f32x16& p1, const LAS unsigned char* kt, int kstride, const bf16x8 (&qf)[KS], int r, int hi) {
    const LAS unsigned char* k0 = kt + r * kstride + hi * 16; const LAS unsigned char* k1 = k0 + 32 * kstride;
#pragma unroll
    for (int s = 0; s < KS; ++s) { const bf16x8 a0 = *(const LAS bf16x8*)(k0 + s * 32), a1 = *(const LAS bf16x8*)(k1 + s * 32);
        p0 = __builtin_amdgcn_mfma_f32_32x32x16_bf16(a0, qf[s], p0, 0, 0, 0); p1 = __builtin_amdgcn_mfma_f32_32x32x16_bf16(a1, qf[s], p1, 0, 0, 0); }
}
__device__ __forceinline__ float max3f(float a, float b, float c);
__device__ __forceinline__ float tile_max(const f32x16& p0, const f32x16& p1) {
    float a = max3f(p0[0], p0[1], p1[0]), b = max3f(p0[2], p0[3], p1[1]); a = max3f(a, p1[2], p1[3]);
#pragma unroll
    for (int i = 4; i < 16; i += 4) { a = max3f(a, p0[i], p0[i + 1]); b = max3f(b, p0[i + 2], p0[i + 3]); a = max3f(a, p1[i], p1[i + 1]); b = max3f(b, p1[i + 2], p1[i + 3]); }
    a = max3f(a, b, b);
    const auto rr = __builtin_amdgcn_permlane32_swap(__float_as_uint(a), __float_as_uint(a), false, false);
    return fmaxf(__uint_as_float(rr[0]), __uint_as_float(rr[1]));
}
__device__ __forceinline__ bf16x8 vfrag(const LAS unsigned char* p) {
    const s16x4 lo = __builtin_bit_cast(s16x4, __builtin_amdgcn_ds_read_tr16_b64_v4i16((LAS s16x4*)p));
    const s16x4 hi = __builtin_bit_cast(s16x4, __builtin_amdgcn_ds_read_tr16_b64_v4i16((LAS s16x4*)(p + 512)));
    return (bf16x8){lo[0], lo[1], lo[2], lo[3], hi[0], hi[1], hi[2], hi[3]};
}
__device__ __forceinline__ bf16x8 pfrag(const f32x16& p, int b) {
    u32x4 w; w.x = pk2(p[b], p[b + 1]); w.y = pk2(p[b + 2], p[b + 3]); w.z = pk2(p[b + 4], p[b + 5]); w.w = pk2(p[b + 6], p[b + 7]);
    return __builtin_bit_cast(bf16x8, w);
}
__device__ __forceinline__ void pv_frag(f32x16& o0, f32x16& o1, bf16x8 pf0, bf16x8 pf1, bf16x8 pf2, bf16x8 pf3, const LAS unsigned char* vt, int vb) {
    const LAS unsigned char* v = vt + vb;
    o0 = __builtin_amdgcn_mfma_f32_32x32x16_bf16(vfrag(v), pf0, o0, 0, 0, 0);            o1 = __builtin_amdgcn_mfma_f32_32x32x16_bf16(vfrag(v + 4096), pf0, o1, 0, 0, 0);
    o0 = __builtin_amdgcn_mfma_f32_32x32x16_bf16(vfrag(v + 1024), pf1, o0, 0, 0, 0);     o1 = __builtin_amdgcn_mfma_f32_32x32x16_bf16(vfrag(v + 4096 + 1024), pf1, o1, 0, 0, 0);
    o0 = __builtin_amdgcn_mfma_f32_32x32x16_bf16(vfrag(v + 2048), pf2, o0, 0, 0, 0);     o1 = __builtin_amdgcn_mfma_f32_32x32x16_bf16(vfrag(v + 4096 + 2048), pf2, o1, 0, 0, 0);
    o0 = __builtin_amdgcn_mfma_f32_32x32x16_bf16(vfrag(v + 3072), pf3, o0, 0, 0, 0);     o1 = __builtin_amdgcn_mfma_f32_32x32x16_bf16(vfrag(v + 4096 + 3072), pf3, o1, 0, 0, 0);
}
__device__ __forceinline__ void pv_tile(f32x16& o0, f32x16& o1, const f32x16& p0, const f32x16& p1, const LAS unsigned char* vt, int vb) {
    pv_frag(o0, o1, pfrag(p0, 0), pfrag(p0, 8), pfrag(p1, 0), pfrag(p1, 8), vt, vb);
}
__device__ __forceinline__ void softmax_step(SoftState& st, f32x16& p0, f32x16& p1, float c2) {
    const float mx = tile_max(p0, p1);
    const float mn = fmaxf(st.m, mx);
    if (__any(mn > st.m)) { const float al = __builtin_amdgcn_exp2f((st.m - mn) * c2); st.l *= al; st.o0 *= al; st.o1 *= al; st.m = mn; }
    const float mc = st.m * c2; float sum = 0.f;
#pragma unroll
    for (int i = 0; i < 16; ++i) { p0[i] = __builtin_amdgcn_exp2f(__builtin_fmaf(p0[i], c2, -mc)); p1[i] = __builtin_amdgcn_exp2f(__builtin_fmaf(p1[i], c2, -mc)); sum += p0[i] + p1[i]; }
    st.l += sum;
}

__device__ __forceinline__ float max3f(float a, float b, float c) { float r; asm("v_max3_f32 %0, %1, %2, %3" : "=v"(r) : "v"(a), "v"(b), "v"(c)); return r; }
__device__ __forceinline__ float swap32_max(float a) { const auto rr = __builtin_amdgcn_permlane32_swap(__float_as_uint(a), __float_as_uint(a), false, false);
    float r; asm("v_max_f32_e32 %0, %1, %2" : "=v"(r) : "v"(__uint_as_float(rr[0])), "v"(__uint_as_float(rr[1]))); return r; }
__device__ __forceinline__ float quad_xor1(float x) { return __builtin_bit_cast(float, __builtin_amdgcn_update_dpp(0, __builtin_bit_cast(int, x), 0xB1, 0xf, 0xf, false)); }
__device__ __forceinline__ float quad_xor2(float x) { return __builtin_bit_cast(float, __builtin_amdgcn_update_dpp(0, __builtin_bit_cast(int, x), 0x4E, 0xf, 0xf, false)); }
__device__ __forceinline__ float swap32_sum(float a) { const auto rr = __builtin_amdgcn_permlane32_swap(__float_as_uint(a), __float_as_uint(a), false, false); return __uint_as_float(rr[0]) + __uint_as_float(rr[1]); }
constexpr float SM_THR = 40.0f;
__device__ __forceinline__ void softmax_pack(SoftState& st, const f32x16& p0, const f32x16& p1, float c2, bf16x8& pf0, bf16x8& pf1, bf16x8& pf2, bf16x8& pf3) {
    float a = max3f(p0[0], p0[1], p1[0]), b = max3f(p0[2], p0[3], p1[1]); a = max3f(a, p1[2], p1[3]);
#pragma unroll
    for (int i = 4; i < 16; i += 4) { a = max3f(a, p0[i], p0[i + 1]); b = max3f(b, p0[i + 2], p0[i + 3]); a = max3f(a, p1[i], p1[i + 1]); b = max3f(b, p1[i + 2], p1[i + 3]); }
    float mx; asm("v_max_f32_e32 %0, %1, %2" : "=v"(mx) : "v"(a), "v"(b));
    mx = swap32_max(mx);
    if (__any((mx - st.m) * c2 > SM_THR)) { const float mn = fmaxf(st.m, mx); const float al = __builtin_amdgcn_exp2f((st.m - mn) * c2); st.l *= al; st.o0 *= al; st.o1 *= al; st.m = mn; }
    const float mc = -st.m * c2; float s0 = 0.f, s1 = 0.f;
    u32x4 w0, w1, w2, w3;
#define SMP(W, E, P, B) do { const float e0_ = __builtin_amdgcn_exp2f(__builtin_fmaf(P[B], c2, mc)), e1_ = __builtin_amdgcn_exp2f(__builtin_fmaf(P[B + 1], c2, mc)); s0 += e0_; s1 += e1_; W[E] = pk2(e0_, e1_); } while (0)
    SMP(w0, 0, p0, 0); SMP(w0, 1, p0, 2); SMP(w0, 2, p0, 4); SMP(w0, 3, p0, 6);
    SMP(w1, 0, p0, 8); SMP(w1, 1, p0, 10); SMP(w1, 2, p0, 12); SMP(w1, 3, p0, 14);
    SMP(w2, 0, p1, 0); SMP(w2, 1, p1, 2); SMP(w2, 2, p1, 4); SMP(w2, 3, p1, 6);
    SMP(w3, 0, p1, 8); SMP(w3, 1, p1, 10); SMP(w3, 2, p1, 12); SMP(w3, 3, p1, 14);
#undef SMP
    st.l += s0 + s1;
    pf0 = __builtin_bit_cast(bf16x8, w0); pf1 = __builtin_bit_cast(bf16x8, w1); pf2 = __builtin_bit_cast(bf16x8, w2); pf3 = __builtin_bit_cast(bf16x8, w3);
}

__device__ __forceinline__ void sm_exp_pack(SoftState& st, const f32x16& p0, const f32x16& p1, float c2, bf16x8& pf0, bf16x8& pf1, bf16x8& pf2, bf16x8& pf3) {
    const float mc = -st.m * c2; float s0 = 0.f, s1 = 0.f;
    u32x4 w0, w1, w2, w3;
#define SMP(W, E, P, B) do { const float e0_ = __builtin_amdgcn_exp2f(__builtin_fmaf(P[B], c2, mc)), e1_ = __builtin_amdgcn_exp2f(__builtin_fmaf(P[B + 1], c2, mc)); s0 += e0_; s1 += e1_; W[E] = pk2(e0_, e1_); } while (0)
    SMP(w0, 0, p0, 0); SMP(w0, 1, p0, 2); SMP(w0, 2, p0, 4); SMP(w0, 3, p0, 6);
    SMP(w1, 0, p0, 8); SMP(w1, 1, p0, 10); SMP(w1, 2, p0, 12); SMP(w1, 3, p0, 14);
    SMP(w2, 0, p1, 0); SMP(w2, 1, p1, 2); SMP(w2, 2, p1, 4); SMP(w2, 3, p1, 6);
    SMP(w3, 0, p1, 8); SMP(w3, 1, p1, 10); SMP(w3, 2, p1, 12); SMP(w3, 3, p1, 14);
#undef SMP
    st.l += s0 + s1;
    pf0 = __builtin_bit_cast(bf16x8, w0); pf1 = __builtin_bit_cast(bf16x8, w1); pf2 = __builtin_bit_cast(bf16x8, w2); pf3 = __builtin_bit_cast(bf16x8, w3);
}

template <int DK> struct StageRegs { u32x4 k0, k1, v; float b; };
template <int DK>
__device__ __forceinline__ void stage_load(StageRegs<DK>& sr, const bf16_t* K, int ldk, const bf16_t* V, int ldv, const float* bias, int kv0, int wid0) {
    const int tid = opaque_tid(wid0); constexpr int CPR = DK / 8;
    { const int row = tid / CPR, cc = tid % CPR; sr.k0 = *(const u32x4*)(K + (size_t)(kv0 + row) * ldk + cc * 8); }
    if (DK == 96 && tid < 256) { const int c = tid + 512, row = c / CPR, cc = c % CPR; sr.k1 = *(const u32x4*)(K + (size_t)(kv0 + row) * ldk + cc * 8); }
    { const int row = tid >> 3, cc = tid & 7; sr.v = *(const u32x4*)(V + (size_t)(kv0 + row) * ldv + cc * 8); }
    if (bias && tid < 64) sr.b = bias[kv0 + tid];
}
template <int DK>
__device__ __forceinline__ void stage_store(const StageRegs<DK>& sr, LAS unsigned char* lds, int buf, bool has_bias, int wid0) {
    const int tid = opaque_tid(wid0); constexpr int CPR = DK / 8; constexpr int KSTR = (DK == 96) ? KSTR96 : KSTR64;
    LAS unsigned char* kb = lds + ATT_K0 + buf * ATT_KBUF; LAS unsigned char* vb = lds + ATT_V0 + buf * ATT_VBUF;
    { const int row = tid / CPR, cc = tid % CPR; *(LAS u32x4*)(kb + row * KSTR + cc * 16) = sr.k0; }
    if (DK == 96 && tid < 256) { const int c = tid + 512, row = c / CPR, cc = c % CPR; *(LAS u32x4*)(kb + row * KSTR + cc * 16) = sr.k1; }
    { const int row = tid >> 3, cc = tid & 7; *(LAS u32x4*)(vb + (cc >> 2) * 4096 + row * 64 + (cc & 3) * 16) = sr.v; }
    if (has_bias && tid < 64) *(LAS float*)(lds + ATT_B0 + buf * 256 + tid * 4) = sr.b;
}

__device__ __forceinline__ void store_out(bf16_t* dst  , const f32x16& o0, const f32x16& o1, float scale, int hi) {
#pragma unroll
    for (int g = 0; g < 4; ++g) {
        u32x2 w; w.x = pk2(o0[4 * g] * scale, o0[4 * g + 1] * scale); w.y = pk2(o0[4 * g + 2] * scale, o0[4 * g + 3] * scale);
        *(u32x2*)(dst + 8 * g + 4 * hi) = w;
        u32x2 w1; w1.x = pk2(o1[4 * g] * scale, o1[4 * g + 1] * scale); w1.y = pk2(o1[4 * g + 2] * scale, o1[4 * g + 3] * scale);
        *(u32x2*)(dst + 32 + 8 * g + 4 * hi) = w1;
    }
}

__device__ __forceinline__ float store_out_fused(bf16_t* dst, const bf16_t* zp, const float* gp, const f32x16& o0, const f32x16& o1, float scale, int hi) {
    float ssq = 0.f;
#pragma unroll
    for (int g = 0; g < 4; ++g) {
#pragma unroll
        for (int d0 = 0; d0 < 2; ++d0) { const int c = 32 * d0 + 8 * g + 4 * hi; const u32x2 zz = *(const u32x2*)(zp + c); const f32x4 gg = *(const f32x4*)(gp + c);
            const float z0 = bflo(zz.x), z1 = bfhi(zz.x), z2 = bflo(zz.y), z3 = bfhi(zz.y);
            const float v0 = (d0 ? o1[4 * g] : o0[4 * g]) * scale, v1 = (d0 ? o1[4 * g + 1] : o0[4 * g + 1]) * scale, v2 = (d0 ? o1[4 * g + 2] : o0[4 * g + 2]) * scale, v3 = (d0 ? o1[4 * g + 3] : o0[4 * g + 3]) * scale;
            ssq += (v0 * v0 + v1 * v1) + (v2 * v2 + v3 * v3);
            u32x2 w; w.x = pk2(v0 * gg[0] * silu_fast(z0), v1 * gg[1] * silu_fast(z1)); w.y = pk2(v2 * gg[2] * silu_fast(z2), v3 * gg[3] * silu_fast(z3));
            *(u32x2*)(dst + c) = w; }
    }
    return ssq;
}

constexpr int DA_K0 = 0, DA_V0 = 3 * ATT_KBUF, DA_B0 = DA_V0 + 2 * ATT_VBUF, DA_END = DA_B0 + 3 * 256;
static_assert(DA_END <= LDS_BYTES, "dense attention LDS map");
template <int DK, int MODE>
__device__ __forceinline__ void dense_unit(LAS unsigned char* lds, const bf16_t* Q, int ldq, const bf16_t* K, int ldk, const bf16_t* V, int ldv,
                                           bf16_t* O  , const float* bias, const unsigned long long* maskbits  ,
                                           float alibiA, float c2, int qb, int wid0, const bf16_t* Zg, const float* Gn, float* ssq  ) {
    constexpr int KS = DK / 16; constexpr int KSTR = (DK == 96) ? KSTR96 : KSTR64; constexpr int CPR = DK / 8;
    const int tid = opaque_tid(wid0), lane = tid & 63, wv = __builtin_amdgcn_readfirstlane(tid >> 6), r = lane & 31, hi = lane >> 5;
    const int q0 = qb * 256, qw0 = q0 + wv * 32, tq = qw0 + r;
    const int NT = (q0 + 256) / 64;
    const int tlast = (qw0 + 31) >> 6;
    bf16x8 qf[KS];
#pragma unroll
    for (int s = 0; s < KS; ++s) qf[s] = *(const bf16x8*)(Q + (size_t)tq * ldq + s * 16 + hi * 8);
    const int vb = ((lane >> 4) & 1) * 32 + (lane & 3) * 8 + (4 * hi + ((lane & 15) >> 2)) * 64;
    const int kb = r * KSTR + hi * 16;
    SoftState st; st.m = NEG_BIG; st.l = 0.f; st.o0 = (f32x16){}; st.o1 = (f32x16){};
    const int krow0 = tid / CPR, kcc0 = tid % CPR, krow1 = (tid + 512) / CPR, kcc1 = (tid + 512) % CPR, vrow = tid >> 3, vcc = tid & 7;
    const bf16_t* kp0 = K + (size_t)krow0 * ldk + kcc0 * 8; const bf16_t* kp1 = K + (size_t)krow1 * ldk + kcc1 * 8; const bf16_t* vp = V + (size_t)vrow * ldv + vcc * 8;
    const int klds0 = krow0 * KSTR + kcc0 * 16, klds1 = krow1 * KSTR + kcc1 * 16, vlds = (vcc >> 2) * 4096 + vrow * 64 + (vcc & 3) * 16;
    u32x4 rk0, rk1, rv; float rbias = 0.f;
#define DA_LOADK(t) do { rk0 = *(const u32x4*)(kp0 + (size_t)(t) * 64 * ldk); if (DK == 96 && tid < 256) rk1 = *(const u32x4*)(kp1 + (size_t)(t) * 64 * ldk); if (MODE == 1 && tid < 64) rbias = bias[(t) * 64 + tid]; } while (0)
#define DA_LOADV(t) do { rv = *(const u32x4*)(vp + (size_t)(t) * 64 * ldv); } while (0)
#define DA_STOREK(slot) do { LAS unsigned char* kb_ = lds + DA_K0 + (slot) * ATT_KBUF; *(LAS u32x4*)(kb_ + klds0) = rk0; if (DK == 96 && tid < 256) *(LAS u32x4*)(kb_ + klds1) = rk1; \
        if (MODE == 1 && tid < 64) *(LAS float*)(lds + DA_B0 + (slot) * 256 + tid * 4) = rbias; } while (0)
#define DA_STOREV(slot) do { *(LAS u32x4*)(lds + DA_V0 + (slot) * ATT_VBUF + vlds) = rv; } while (0)
#define DA_CINIT(P0, P1, t, slot) do { const int kv0_ = (t) * 64; \
        if (MODE == 0) { P0 = (f32x16){}; P1 = (f32x16){}; } \
        else if (MODE == 1) { const LAS float* bl = (const LAS float*)(lds + DA_B0 + (slot) * 256); \
            _Pragma("unroll") for (int g = 0; g < 4; ++g) { const f32x4 b0_ = *(const LAS f32x4*)(bl + 8 * g + 4 * hi), b1_ = *(const LAS f32x4*)(bl + 32 + 8 * g + 4 * hi); \
                _Pragma("unroll") for (int e = 0; e < 4; ++e) { P0[4 * g + e] = b0_[e]; P1[4 * g + e] = b1_[e]; } } } \
        else { const float base_ = alibiA * (float)(kv0_ + 4 * hi); \
            _Pragma("unroll") for (int i = 0; i < 16; ++i) { P0[i] = base_ + alibiA * (float)((i & 3) + 8 * (i >> 2)); P1[i] = P0[i] + alibiA * 32.0f; } } } while (0)
#define DA_MASK(P0, P1, t, mb) do { const int kv0_ = (t) * 64; \
        if (MODE == 2) { const unsigned long long ms_ = (mb) >> (4 * hi); const unsigned lo_ = (unsigned)ms_, hw_ = (unsigned)(ms_ >> 32); \
            _Pragma("unroll") for (int i = 0; i < 16; ++i) { const unsigned bit_ = 1u << ((i & 3) + 8 * (i >> 2)); if (!(lo_ & bit_)) P0[i] = -INFINITY; if (!(hw_ & bit_)) P1[i] = -INFINITY; } } \
        else if (kv0_ + 63 > qw0) { \
            _Pragma("unroll") for (int i = 0; i < 16; ++i) { const int kv_ = kv0_ + crow(i, hi); if (kv_ > tq) P0[i] = -INFINITY; if (kv_ + 32 > tq) P1[i] = -INFINITY; } } } while (0)
#define DA_ROWMAX(MX, P0, P1) do { float a_ = __builtin_fmaxf(__builtin_fmaxf(P0[0], P0[1]), P1[0]), b_ = __builtin_fmaxf(__builtin_fmaxf(P0[2], P0[3]), P1[1]); a_ = __builtin_fmaxf(__builtin_fmaxf(a_, P1[2]), P1[3]); \
        _Pragma("unroll") for (int i = 4; i < 16; i += 4) { a_ = __builtin_fmaxf(__builtin_fmaxf(a_, P0[i]), P0[i + 1]); b_ = __builtin_fmaxf(__builtin_fmaxf(b_, P0[i + 2]), P0[i + 3]); a_ = __builtin_fmaxf(__builtin_fmaxf(a_, P1[i]), P1[i + 1]); b_ = __builtin_fmaxf(__builtin_fmaxf(b_, P1[i + 2]), P1[i + 3]); } \
        a_ = __builtin_fmaxf(a_, b_); const auto rr_ = __builtin_amdgcn_permlane32_swap(__float_as_uint(a_), __float_as_uint(a_), false, false); \
        MX = __builtin_fmaxf(__uint_as_float(rr_[0]), __uint_as_float(rr_[1])); } while (0)
    __syncthreads();
    DA_LOADK(0); DA_LOADV(0); DA_STOREK(0); DA_STOREV(0);
    DA_LOADK(1); DA_STOREK(1);
    DA_LOADK(2); DA_LOADV(1);
    __syncthreads();
    f32x16 pa0, pa1, pb0, pb1;
    unsigned long long mb_nxt = 0ull, mb_nn = 0ull;
    {
        DA_CINIT(pa0, pa1, 0, 0);
        qk_tile<KS>(pa0, pa1, lds + DA_K0, KSTR, qf, r, hi);
        unsigned long long mb0 = 0ull;
        if (MODE == 2) { mb0 = maskbits[(size_t)tq * 128]; if (1 <= tlast) mb_nxt = maskbits[(size_t)tq * 128 + 1]; }
        DA_MASK(pa0, pa1, 0, mb0);
        float mx; DA_ROWMAX(mx, pa0, pa1);
        st.m = __builtin_fmaxf(st.m, mx);
    }
    int ks_next = 1, ks_store = 2, vs_cur = 0;
#define DA_STEP(C0, C1, N0, N1, t) do { \
        if (MODE == 2) { mb_nn = 0ull; if ((t) + 2 <= tlast) mb_nn = maskbits[(size_t)tq * 128 + (t) + 2]; } \
        if ((t) <= tlast) { \
              \
            DA_CINIT(N0, N1, (t) + 1, ks_next); \
            bf16x8 pf0, pf1, pf2, pf3; \
            bf16x8 kf[2 * KS]; { const LAS unsigned char* k_ = lds + DA_K0 + ks_next * ATT_KBUF + kb; \
                _Pragma("unroll") for (int s_ = 0; s_ < KS; ++s_) { kf[2 * s_] = *(const LAS bf16x8*)(k_ + s_ * 32); kf[2 * s_ + 1] = *(const LAS bf16x8*)(k_ + 32 * KSTR + s_ * 32); } } \
            __builtin_amdgcn_sched_barrier(0); \
            _Pragma("unroll") for (int s_ = 0; s_ < KS; ++s_) { N0 = __builtin_amdgcn_mfma_f32_32x32x16_bf16(kf[2 * s_], qf[s_], N0, 0, 0, 0); N1 = __builtin_amdgcn_mfma_f32_32x32x16_bf16(kf[2 * s_ + 1], qf[s_], N1, 0, 0, 0); } \
            sm_exp_pack(st, C0, C1, c2, pf0, pf1, pf2, pf3); \
            _Pragma("unroll") for (int g_ = 0; g_ < 2 * KS; ++g_) { __builtin_amdgcn_sched_group_barrier(0x8, 1, 0); __builtin_amdgcn_sched_group_barrier(0x2, (KS == 6 ? 9 : 14), 0); } \
            __builtin_amdgcn_sched_barrier(0); \
              \
            bf16x8 vf[8]; { const LAS unsigned char* v_ = lds + DA_V0 + vs_cur * ATT_VBUF + vb; \
                _Pragma("unroll") for (int s_ = 0; s_ < 4; ++s_) { vf[2 * s_] = vfrag(v_ + s_ * 1024); vf[2 * s_ + 1] = vfrag(v_ + 4096 + s_ * 1024); } } \
            __builtin_amdgcn_sched_barrier(0); \
            float mx_ = -INFINITY; \
            if ((t) < tlast) { DA_MASK(N0, N1, (t) + 1, mb_nxt); DA_ROWMAX(mx_, N0, N1); } \
            __builtin_amdgcn_sched_barrier(0); \
            st.o0 = __builtin_amdgcn_mfma_f32_32x32x16_bf16(vf[0], pf0, st.o0, 0, 0, 0); st.o1 = __builtin_amdgcn_mfma_f32_32x32x16_bf16(vf[1], pf0, st.o1, 0, 0, 0); \
            st.o0 = __builtin_amdgcn_mfma_f32_32x32x16_bf16(vf[2], pf1, st.o0, 0, 0, 0); st.o1 = __builtin_amdgcn_mfma_f32_32x32x16_bf16(vf[3], pf1, st.o1, 0, 0, 0); \
            st.o0 = __builtin_amdgcn_mfma_f32_32x32x16_bf16(vf[4], pf2, st.o0, 0, 0, 0); st.o1 = __builtin_amdgcn_mfma_f32_32x32x16_bf16(vf[5], pf2, st.o1, 0, 0, 0); \
            st.o0 = __builtin_amdgcn_mfma_f32_32x32x16_bf16(vf[6], pf3, st.o0, 0, 0, 0); st.o1 = __builtin_amdgcn_mfma_f32_32x32x16_bf16(vf[7], pf3, st.o1, 0, 0, 0); \
            __builtin_amdgcn_sched_barrier(0); \
            if (__any((mx_ - st.m) * c2 > SM_THR)) { const float mn_ = __builtin_fmaxf(st.m, mx_); const float al_ = __builtin_amdgcn_exp2f((st.m - mn_) * c2); st.l *= al_; st.o0 *= al_; st.o1 *= al_; st.m = mn_; } \
        } \
        if ((t) + 2 < NT) DA_STOREK(ks_store); \
        if ((t) + 1 < NT) DA_STOREV(vs_cur ^ 1); \
        if ((t) + 3 < NT) DA_LOADK((t) + 3); \
        if ((t) + 2 < NT) DA_LOADV((t) + 2); \
        __syncthreads(); \
        mb_nxt = mb_nn; vs_cur ^= 1; ks_next = (ks_next == 2) ? 0 : ks_next + 1; ks_store = (ks_store == 2) ? 0 : ks_store + 1; } while (0)
    for (int t = 0; t < NT; t += 2) {
        DA_STEP(pa0, pa1, pb0, pb1, t);
        DA_STEP(pb0, pb1, pa0, pa1, t + 1);
    }
#undef DA_LOADK
#undef DA_LOADV
#undef DA_STOREK
#undef DA_STOREV
#undef DA_CINIT
#undef DA_MASK
#undef DA_ROWMAX
#undef DA_STEP
    const float l = swap32_sum(st.l);
    const float inv = l > 0.f ? 1.0f / l : 0.f;
    const float sq = swap32_sum(store_out_fused(O + (size_t)tq * D, Zg + (size_t)tq * NP, Gn, st.o0, st.o1, inv, hi));
    if (hi == 0) ssq[(size_t)tq * 16] = sq;
}

#define A64_SBAR() __builtin_amdgcn_sched_barrier(0)
#define A64_PIN(x) asm volatile("" : "+v"(x))
#define A64_MFMA(a, b, c) __builtin_amdgcn_mfma_f32_32x32x16_bf16(a, b, c, 0, 0, 0)
constexpr int A64_VSLOT = 8192, A64_K = 0, A64_V = 3 * 12288  , A64_WS = A64_V + 3 * A64_VSLOT, A64_OST = A64_WS + 8 * 256, A64_SIDE = A64_OST + 8 * 4096, A64_END = A64_SIDE + 3 * 2048;
static_assert(A64_END <= LDS_BYTES - 16, "attn64 LDS map");
template <int N> __device__ __forceinline__ void a64_wait_bar() { asm volatile("s_waitcnt vmcnt(%0) lgkmcnt(0)\n\ts_barrier" :: "n"(N) : "memory"); }
__device__ __forceinline__ void a64_glds16(const void* g, unsigned lds_base) {
    unsigned sv; asm volatile("s_mov_b32 %0, m0\n\ts_mov_b32 m0, %2\n\ts_nop 0\n\tglobal_load_lds_dwordx4 %1, off\n\ts_mov_b32 m0, %0" : "=&s"(sv) : "v"(g), "s"(lds_base) : "memory"); }
__device__ __forceinline__ void a64_glds4(const void* g, unsigned lds_base) {
    unsigned sv; asm volatile("s_mov_b32 %0, m0\n\ts_mov_b32 m0, %2\n\ts_nop 0\n\tglobal_load_lds_dword %1, off\n\ts_mov_b32 m0, %0" : "=&s"(sv) : "v"(g), "s"(lds_base) : "memory"); }
__device__ __forceinline__ void a64_kload2(bf16x8* kf, const LAS unsigned char* kp, int d0) { kf[2 * d0] = *(const LAS bf16x8*)(kp + d0 * 2048); kf[2 * d0 + 1] = *(const LAS bf16x8*)(kp + d0 * 2048 + 512); }
__device__ __forceinline__ s16x4 a64_vtr(const LAS unsigned char* p) { return __builtin_bit_cast(s16x4, __builtin_amdgcn_ds_read_tr16_b64_v4i16((LAS s16x4*)p)); }
#define A64_MX3(a, b, c) __builtin_fmaxf(__builtin_fmaxf((a), (b)), (c))
__device__ __forceinline__ float a64_max16(const f32x16& p) {
    float a = A64_MX3(p[0], p[1], p[2]), b = A64_MX3(p[3], p[4], p[5]); a = A64_MX3(a, p[6], p[7]); b = A64_MX3(b, p[8], p[9]); a = A64_MX3(a, p[10], p[11]); b = A64_MX3(b, p[12], p[13]);
    return A64_MX3(a, b, __builtin_fmaxf(p[14], p[15])); }
__device__ __forceinline__ float a64_swapmax(float m) { const auto rr = __builtin_amdgcn_permlane32_swap(__float_as_uint(m), __float_as_uint(m), false, false); return __builtin_fmaxf(__uint_as_float(rr[0]), __uint_as_float(rr[1])); }
__device__ __forceinline__ void a64_cmask(f32x16& p0, f32x16& p1, int jb, int qrel, int hi) {
    const int kb = 64 * jb + 4 * hi;
#pragma unroll
    for (int r = 0; r < 16; ++r) { const int kv = kb + (r & 3) + 8 * (r >> 2); if (kv > qrel) p0[r] = -INFINITY; if (kv + 32 > qrel) p1[r] = -INFINITY; } }
__device__ __forceinline__ void a64_dmask(f32x16& p0, f32x16& p1, unsigned long long mw, int hi) {
    const unsigned long long ms = mw >> (4 * hi); const unsigned lo = (unsigned)ms, hw = (unsigned)(ms >> 32);
#pragma unroll
    for (int i = 0; i < 16; ++i) { const unsigned bit = 1u << ((i & 3) + 8 * (i >> 2)); if (!(lo & bit)) p0[i] = -INFINITY; if (!(hw & bit)) p1[i] = -INFINITY; } }

template <int MODE, int DK>
__device__ __forceinline__ void attn64_unit(LAS unsigned char* lds, const bf16_t* Q, int ldq, const bf16_t* K, int ld  , const bf16_t* V, int ldv,
                                            bf16_t* O  , const float* bias  , const unsigned long long* maskbits  ,
                                            float alibiA, float C2  , int qb, int wid0, const bf16_t* Zg, const float* Gn, float* ssq  ) {
    constexpr float THR = 40.0f;     constexpr int KS = DK / 16, KSLOT = (DK == 96) ? 12288 : 8192;
    constexpr int KOPS = ((MODE == 0) ? 1 : 2) + ((DK == 96) ? 1 : 0);
    const int tid = opaque_tid(wid0), lane = tid & 63, r32 = lane & 31, hi = lane >> 5; const int wid = __builtin_amdgcn_readfirstlane(tid >> 6);
    const int q0 = qb * 256, NT = (q0 + 256) / 64, qw0 = q0 + wid * 32;
    const bf16_t* Qw = Q + (size_t)qw0 * ldq;
    const unsigned lds0 = (unsigned)(size_t)lds; LAS float* wsf = (LAS float*)(lds + A64_WS) + wid * 64;
    const bf16_t* ksrc = K + (size_t)lane * ld + wid * 8;
    const bf16_t* ksrc2 = K + (size_t)lane * ld + (8 + (wid & 3)) * 8;
    const bf16_t* vsrc = V + (size_t)(16 * (wid & 3) + (lane >> 2)) * ldv + (wid >> 2) * 32 + (lane & 3) * 8;
    const unsigned* ssrc = (MODE == 1) ? (const unsigned*)(bias + lane) : (MODE == 2) ? (const unsigned*)(maskbits + (size_t)(qw0 + (lane >> 1)) * 128) + (lane & 1) : nullptr;
    constexpr int SSTEP = (MODE == 1) ? 64 : 2;
    const unsigned kdst = lds0 + A64_K + wid * 1024, kdst2 = lds0 + A64_K + (8 + (wid & 3)) * 1024, vdst = lds0 + A64_V + wid * 1024, sdst = lds0 + A64_SIDE + wid * 256;
#define A64_DMA_K(t, slot) do { a64_glds16(ksrc + (size_t)(t) * 64 * ld, (unsigned)__builtin_amdgcn_readfirstlane(kdst + (slot) * KSLOT)); \
        if (DK == 96) a64_glds16(ksrc2 + (size_t)(t) * 64 * ld, (unsigned)__builtin_amdgcn_readfirstlane(kdst2 + (slot) * KSLOT)); \
        if (MODE != 0) a64_glds4(ssrc + (size_t)(t) * SSTEP, (unsigned)__builtin_amdgcn_readfirstlane(sdst + (slot) * 2048)); } while (0)
#define A64_DMA_V(t, slot) a64_glds16(vsrc + (size_t)(t) * 64 * ldv, (unsigned)__builtin_amdgcn_readfirstlane(vdst + (slot) * A64_VSLOT))
    const LAS unsigned char* vp0 = lds + A64_V + ((lane >> 4) & 1) * 32 + (lane & 3) * 8 + (4 * hi + ((lane & 15) >> 2)) * 64;
    const LAS unsigned char* kp0 = lds + A64_K + hi * 1024 + r32 * 16;
    const LAS unsigned char* sp0 = lds + A64_SIDE + wid * 256;
    __syncthreads();
    A64_DMA_K(0, 0); A64_DMA_V(0, 0); A64_DMA_K(1, 1);
    bf16x8 qr[KS];
#pragma unroll
    for (int d0 = 0; d0 < KS; ++d0) qr[d0] = *(const bf16x8*)(Qw + (size_t)r32 * ldq + d0 * 16 + hi * 8);
    float mhat = 0.f, l_reg = 0.f; f32x16 o[2]; o[0] = (f32x16){}; o[1] = (f32x16){};
    f32x16 cini = (f32x16){};
    if (MODE == 2) {
#pragma unroll
        for (int i = 0; i < 16; ++i) cini[i] = alibiA * (float)((i & 3) + 8 * (i >> 2) + 4 * hi); }
    if (MODE != 0) A64_PIN(cini);
    const float ea = (MODE == 2) ? alibiA * C2 : 0.f;
    const int qrel = wid * 32 + r32; bool resc = false;
    f32x16 pA0, pA1, pB0, pB1; bf16x8 kf[2 * KS]; s16x4 vlo[8], vhi[8]; u32x4 pw0, pw1, pw2, pw3;
    int sl_prev = 0, sl_cur = 0, sl_next = 1;
#define A64_ROT() do { sl_prev = sl_cur; sl_cur = sl_next; sl_next = (sl_next == 2) ? 0 : sl_next + 1; } while (0)
#define A64_EX(v, NM) __builtin_amdgcn_exp2f(__builtin_fmaf((v), C2, NM))
#define A64_RESC() do { if (resc) { _Pragma("unroll") for (int d_ = 0; d_ < 2; ++d_) _Pragma("unroll") for (int r = 0; r < 16; ++r) o[d_][r] *= wsf[crow(r, hi)]; } } while (0)
#define A64_CINIT(C0, C1, slot) do { if (MODE == 1) { const LAS float* bl_ = (const LAS float*)(sp0 + (slot) * 2048); \
        _Pragma("unroll") for (int g_ = 0; g_ < 4; ++g_) { const f32x4 b0_ = *(const LAS f32x4*)(bl_ + 8 * g_ + 4 * hi), b1_ = *(const LAS f32x4*)(bl_ + 32 + 8 * g_ + 4 * hi); \
            _Pragma("unroll") for (int e_ = 0; e_ < 4; ++e_) { C0[4 * g_ + e_] = b0_[e_]; C1[4 * g_ + e_] = b1_[e_]; } } } \
        else if (MODE == 0) { C0 = (f32x16){}; C1 = (f32x16){}; }     \
        else { C0 = cini; C1 = cini; } } while (0)
#define A64_MRD(G, P0, P1, g_) do { if (MODE == 2 && (G)) { _Pragma("unroll") for (int e_ = 0; e_ < 4; ++e_) { const int i_ = 4 * (g_) + e_; const int pos_ = (i_ & 3) + 8 * (i_ >> 2); \
        const unsigned m0_ = (unsigned)__builtin_amdgcn_sbfe((int)mlo_, pos_, 1), m1_ = (unsigned)__builtin_amdgcn_sbfe((int)mhw_, pos_, 1); const unsigned cb_ = __float_as_uint(cini[i_]); \
        P0[i_] = __uint_as_float((cb_ & m0_) | (0xff800000u & ~m0_)); P1[i_] = __uint_as_float((cb_ & m1_) | (0xff800000u & ~m1_)); } } } while (0)
#define A64_ROWREF(C0, C1, t) a64_swapmax(__builtin_fmaxf(__builtin_fmaf(a64_max16(C0), C2, ea * (float)(64 * (t))), __builtin_fmaf(a64_max16(C1), C2, ea * (float)(64 * (t) + 32))))
    A64_DMA_K(2, 2);
    a64_wait_bar<2 * KOPS + 1>();
    _Pragma("unroll") for (int d0 = 0; d0 < KS; ++d0) a64_kload2(kf, kp0, d0);
    { unsigned long long mw0 = 0ull; if (MODE == 2) mw0 = *(const LAS unsigned long long*)(sp0 + r32 * 8);
      A64_CINIT(pA0, pA1, 0);
      _Pragma("unroll") for (int d0 = 0; d0 < KS; ++d0) { pA0 = A64_MFMA(kf[2 * d0], qr[d0], pA0); pA1 = A64_MFMA(kf[2 * d0 + 1], qr[d0], pA1); }
      if (MODE == 2) a64_dmask(pA0, pA1, mw0, hi);
      if (NT == 4) a64_cmask(pA0, pA1, 0, qrel, hi); }
    { mhat = __builtin_fmaxf(A64_ROWREF(pA0, pA1, 0), -1e30f); const float nm0 = -mhat, nm1 = ea * 32.0f - mhat;
#pragma unroll
      for (int r = 0; r < 16; ++r) { pA0[r] = A64_EX(pA0[r], nm0); pA1[r] = A64_EX(pA1[r], nm1); } }
    a64_wait_bar<0>();
    A64_DMA_K(3, 0); A64_DMA_V(1, 1); A64_ROT();
    _Pragma("unroll") for (int d0 = 0; d0 < KS; ++d0) a64_kload2(kf, kp0 + sl_cur * KSLOT, d0);
    if (MODE == 1) A64_CINIT(pB0, pB1, sl_cur);
    if (MODE == 2) { const unsigned long long mq_ = *(const LAS unsigned long long*)(sp0 + sl_cur * 2048 + r32 * 8) >> (4 * hi); const unsigned mlo_ = (unsigned)mq_, mhw_ = (unsigned)(mq_ >> 32);
        A64_MRD(true, pB0, pB1, 0); A64_MRD(true, pB0, pB1, 1); A64_MRD(true, pB0, pB1, 2); A64_MRD(true, pB0, pB1, 3); }
    a64_wait_bar<KOPS + 1>();
#define A64_PKW(P, i) pk2(P[i], P[i + 1])
#define A64_PAF(k) __builtin_bit_cast(bf16x8, pw##k)
#define A64_VFR(i) (bf16x8){vlo[i][0], vlo[i][1], vlo[i][2], vlo[i][3], vhi[i][0], vhi[i][1], vhi[i][2], vhi[i][3]}
#define A64_VRD(i) do { vlo[i] = a64_vtr(vp_ + (((i) >> 2) * 4096 + ((i) & 3) * 1024)); vhi[i] = a64_vtr(vp_ + (((i) >> 2) * 4096 + ((i) & 3) * 1024 + 512)); } while (0)
#define A64_BRD(G, P0, P1, g_) do { if (MODE == 1 && (G)) { const LAS float* bl_ = (const LAS float*)(sp0 + sl_next * 2048); \
        const f32x4 b0_ = *(const LAS f32x4*)(bl_ + 8 * (g_) + 4 * hi), b1_ = *(const LAS f32x4*)(bl_ + 32 + 8 * (g_) + 4 * hi); \
        _Pragma("unroll") for (int e_ = 0; e_ < 4; ++e_) { P0[4 * (g_) + e_] = b0_[e_]; P1[4 * (g_) + e_] = b1_[e_]; } } } while (0)
#define A64_CS(C) ((MODE == 0) ? (f32x16){} : C)
#define A64_KRD(G, d0) do { if (G) { a64_kload2(kf, kp0 + sl_next * KSLOT, d0); A64_SBAR(); } } while (0)
#define A64_GAPA(MF, a0, a1, a2, a3, W0, W1, PW) do { MF; sacc += a0; sacc += a1; sacc += a2; sacc += a3; W0; W1; A64_PIN(PW); A64_PIN(sacc); A64_SBAR(); } while (0)
#define A64_GAPB(MF, X, i, NM) do { MF; X[i] = A64_EX(X[i], NM); X[i + 1] = A64_EX(X[i + 1], NM); X[i + 2] = A64_EX(X[i + 2], NM); X[i + 3] = A64_EX(X[i + 3], NM); A64_PIN(X); A64_SBAR(); } while (0)
#define A64_STEP(C0, C1, P0, P1, t, MASK, GK, GV, GL) do { A64_SBAR(); \
      \
    const LAS unsigned char* vp_ = vp0 + sl_prev * A64_VSLOT; \
    A64_VRD(0); A64_SBAR(); float sacc = P0[0] + P0[1]; \
                    A64_GAPA(C0 = A64_MFMA(kf[0], qr[0], A64_CS(C0)), P0[2], P0[3], P0[4], P0[5],     pw0[0] = A64_PKW(P0, 0),  pw0[1] = A64_PKW(P0, 2),  pw0); \
    A64_VRD(4); A64_SBAR(); A64_GAPA(C1 = A64_MFMA(kf[1], qr[0], A64_CS(C1)), P0[6], P0[7], P0[8], P0[9],     pw0[2] = A64_PKW(P0, 4),  pw0[3] = A64_PKW(P0, 6),  pw0); \
    A64_VRD(1); A64_SBAR(); A64_GAPA(C0 = A64_MFMA(kf[2], qr[1], C0),    P0[10], P0[11], P0[12], P0[13], pw1[0] = A64_PKW(P0, 8),  pw1[1] = A64_PKW(P0, 10), pw1); \
    A64_VRD(5); A64_SBAR(); A64_GAPA(C1 = A64_MFMA(kf[3], qr[1], C1),    P0[14], P0[15], P1[0], P1[1],   pw1[2] = A64_PKW(P0, 12), pw1[3] = A64_PKW(P0, 14), pw1); \
    A64_VRD(2); A64_SBAR(); A64_GAPA(C0 = A64_MFMA(kf[4], qr[2], C0),    P1[2], P1[3], P1[4], P1[5],     pw2[0] = A64_PKW(P1, 0),  pw2[1] = A64_PKW(P1, 2),  pw2); \
    A64_VRD(6); A64_SBAR(); A64_GAPA(C1 = A64_MFMA(kf[5], qr[2], C1),    P1[6], P1[7], P1[8], P1[9],     pw2[2] = A64_PKW(P1, 4),  pw2[3] = A64_PKW(P1, 6),  pw2); \
    A64_VRD(3); A64_SBAR(); A64_GAPA(C0 = A64_MFMA(kf[6], qr[3], C0),    P1[10], P1[11], P1[12], P1[13], pw3[0] = A64_PKW(P1, 8),  pw3[1] = A64_PKW(P1, 10), pw3); \
    A64_VRD(7); A64_SBAR(); A64_GAPA(C1 = A64_MFMA(kf[7], qr[3], C1),    P1[14], P1[15], 0.f, 0.f,       pw3[2] = A64_PKW(P1, 12), pw3[3] = A64_PKW(P1, 14), pw3); \
    if (KS == 6) { C0 = A64_MFMA(kf[8], qr[4], C0); C1 = A64_MFMA(kf[9], qr[4], C1); C0 = A64_MFMA(kf[10], qr[5], C0); C1 = A64_MFMA(kf[11], qr[5], C1); A64_SBAR(); } \
    l_reg += sacc; \
    if (GK) A64_DMA_K((t) + 3, sl_cur); if (GV) A64_DMA_V((t) + 1, sl_next); \
    if (MASK) a64_cmask(C0, C1, (t) - (NT - 4), qrel, hi); \
    { const float rs_ = A64_ROWREF(C0, C1, t); resc = false; \
      if (__builtin_expect(__any(rs_ - mhat > THR), 0)) { const float mn_ = __builtin_fmaxf(mhat, rs_); const float f_ = __builtin_amdgcn_exp2f(mhat - mn_); mhat = mn_; \
          l_reg *= f_; if (hi == 0) wsf[r32] = f_; resc = true; } } \
    const float nm0_ = ea * (float)(64 * (t)) - mhat, nm1_ = ea * (float)(64 * (t) + 32) - mhat; A64_SBAR(); \
    A64_GAPB(o[0] = A64_MFMA(A64_PAF(0), A64_VFR(0), o[0]), C0, 0, nm0_);              A64_GAPB(o[1] = A64_MFMA(A64_PAF(0), A64_VFR(4), o[1]), C0, 4, nm0_); \
    unsigned mlo_ = 0u, mhw_ = 0u; if (MODE == 2 && (GL)) { const unsigned long long mq_ = *(const LAS unsigned long long*)(sp0 + sl_next * 2048 + r32 * 8) >> (4 * hi); mlo_ = (unsigned)mq_; mhw_ = (unsigned)(mq_ >> 32); } \
    A64_KRD(GL, 0); A64_BRD(GL, P0, P1, 0); A64_MRD(GL, P0, P1, 0); A64_GAPB(o[0] = A64_MFMA(A64_PAF(1), A64_VFR(1), o[0]), C0, 8, nm0_);  A64_KRD(GL, 1); A64_BRD(GL, P0, P1, 1); A64_MRD(GL, P0, P1, 1); A64_GAPB(o[1] = A64_MFMA(A64_PAF(1), A64_VFR(5), o[1]), C0, 12, nm0_); \
    A64_KRD(GL, 2); A64_BRD(GL, P0, P1, 2); A64_MRD(GL, P0, P1, 2); A64_GAPB(o[0] = A64_MFMA(A64_PAF(2), A64_VFR(2), o[0]), C1, 0, nm1_);  A64_KRD(GL, 3); A64_BRD(GL, P0, P1, 3); A64_MRD(GL, P0, P1, 3); A64_GAPB(o[1] = A64_MFMA(A64_PAF(2), A64_VFR(6), o[1]), C1, 4, nm1_); \
    if (KS == 6) A64_KRD(GL, 4); A64_GAPB(o[0] = A64_MFMA(A64_PAF(3), A64_VFR(3), o[0]), C1, 8, nm1_);  if (KS == 6) A64_KRD(GL, 5); A64_GAPB(o[1] = A64_MFMA(A64_PAF(3), A64_VFR(7), o[1]), C1, 12, nm1_); \
    } while (0)
    int t = 1;
    for (; t + 5 < NT; t += 2) {
        A64_STEP(pB0, pB1, pA0, pA1, t, false, true, true, true);     a64_wait_bar<KOPS + 1>(); A64_RESC(); A64_ROT();
        A64_STEP(pA0, pA1, pB0, pB1, t + 1, false, true, true, true); a64_wait_bar<KOPS + 1>(); A64_RESC(); A64_ROT();
    }
#define A64_ENDW(tt) do { if ((tt) + 3 < NT) { a64_wait_bar<KOPS + 1>(); } else if ((tt) + 2 < NT) { a64_wait_bar<1>(); } else { a64_wait_bar<0>(); } } while (0)
    for (; t + 1 < NT; t += 2) {
        A64_STEP(pB0, pB1, pA0, pA1, t, true, (t + 3 < NT), (t + 1 < NT), (t + 1 < NT));         A64_ENDW(t);     A64_RESC(); A64_ROT();
        A64_STEP(pA0, pA1, pB0, pB1, t + 1, true, (t + 4 < NT), (t + 2 < NT), (t + 2 < NT));     A64_ENDW(t + 1); A64_RESC(); A64_ROT();
    }
    A64_STEP(pB0, pB1, pA0, pA1, NT - 1, true, false, false, false); A64_RESC();
    { float sacc = pB0[0] + pB0[1];
#pragma unroll
      for (int r = 2; r < 16; ++r) sacc += pB0[r];
#pragma unroll
      for (int r = 0; r < 16; ++r) sacc += pB1[r];
      l_reg += sacc;
      pw0 = (u32x4){A64_PKW(pB0, 0), A64_PKW(pB0, 2), A64_PKW(pB0, 4), A64_PKW(pB0, 6)}; pw1 = (u32x4){A64_PKW(pB0, 8), A64_PKW(pB0, 10), A64_PKW(pB0, 12), A64_PKW(pB0, 14)};
      pw2 = (u32x4){A64_PKW(pB1, 0), A64_PKW(pB1, 2), A64_PKW(pB1, 4), A64_PKW(pB1, 6)}; pw3 = (u32x4){A64_PKW(pB1, 8), A64_PKW(pB1, 10), A64_PKW(pB1, 12), A64_PKW(pB1, 14)};
      const LAS unsigned char* vp_ = vp0 + sl_cur * A64_VSLOT; _Pragma("unroll") for (int i = 0; i < 8; ++i) A64_VRD(i);
      o[0] = A64_MFMA(A64_PAF(0), A64_VFR(0), o[0]); o[1] = A64_MFMA(A64_PAF(0), A64_VFR(4), o[1]); o[0] = A64_MFMA(A64_PAF(1), A64_VFR(1), o[0]); o[1] = A64_MFMA(A64_PAF(1), A64_VFR(5), o[1]);
      o[0] = A64_MFMA(A64_PAF(2), A64_VFR(2), o[0]); o[1] = A64_MFMA(A64_PAF(2), A64_VFR(6), o[1]); o[0] = A64_MFMA(A64_PAF(3), A64_VFR(3), o[0]); o[1] = A64_MFMA(A64_PAF(3), A64_VFR(7), o[1]); }
    l_reg = swap32_sum(l_reg);
    if (hi == 0) wsf[32 + r32] = l_reg; asm volatile("s_waitcnt lgkmcnt(0)" ::: "memory");
    float rli[16];
#pragma unroll
    for (int r = 0; r < 16; ++r) rli[r] = __builtin_amdgcn_rcpf(wsf[32 + crow(r, hi)]);
    LAS bf16_t* stg = (LAS bf16_t*)(lds + A64_OST) + wid * 2048;
#pragma unroll
    for (int r = 0; r < 16; ++r) { const int orow = crow(r, hi);
#pragma unroll
        for (int d0 = 0; d0 < 2; ++d0) stg[orow * 64 + d0 * 32 + r32] = (bf16_t)pk2(o[d0][r] * rli[r], 0.f); }
    asm volatile("s_waitcnt lgkmcnt(0)" ::: "memory");
#pragma unroll
    for (int i = 0; i < 4; ++i) { const int row = i * 8 + (lane >> 3), ch = lane & 7; const size_t grow = (size_t)(qw0 + row);
        const u32x4 vv = *(const LAS u32x4*)(stg + row * 64 + ch * 8); const u32x4 zz = *(const u32x4*)(Zg + grow * NP + ch * 8);
        const f32x4 g0 = *(const f32x4*)(Gn + ch * 8), g1 = *(const f32x4*)(Gn + ch * 8 + 4);
        float sq = 0.f; u32x4 w;
#pragma unroll
        for (int e = 0; e < 4; ++e) { const float va = bflo(vv[e]), vb_ = bfhi(vv[e]); sq += va * va + vb_ * vb_;
            const float ga = (e < 2) ? g0[2 * e] : g1[2 * e - 4], gb = (e < 2) ? g0[2 * e + 1] : g1[2 * e - 3];
            w[e] = pk2(va * ga * silu_fast(bflo(zz[e])), vb_ * gb * silu_fast(bfhi(zz[e]))); }
        *(u32x4*)(O + grow * D + ch * 8) = w;
        sq += quad_xor1(sq); sq += quad_xor2(sq);
        sq += __builtin_bit_cast(float, __builtin_amdgcn_update_dpp(0, __builtin_bit_cast(int, sq), 0x141, 0xf, 0xf, false));
        if (ch == 0) ssq[grow * 16] = sq; }
    asm volatile("s_waitcnt lgkmcnt(0)\n\ts_barrier" ::: "memory");
#undef A64_DMA_K
#undef A64_DMA_V
#undef A64_ROT
#undef A64_EX
#undef A64_RESC
#undef A64_CINIT
#undef A64_ROWREF
#undef A64_PKW
#undef A64_PAF
#undef A64_VFR
#undef A64_VRD
#undef A64_KRD
#undef A64_MRD
#undef A64_BRD
#undef A64_CS
#undef A64_ENDW
#undef A64_GAPA
#undef A64_GAPB
#undef A64_STEP
}

constexpr int DSA_H1 = 0, DSA_H2 = 65536, DSA_INFO = 65536 + 32768;
__device__ __forceinline__ unsigned score_key32(float s) { const unsigned u = __float_as_uint(s); return u ^ ((unsigned)((int)u >> 31) | 0x80000000u); }
__device__ __forceinline__ unsigned score_key16(float s) { return score_key32(s) >> 16; }
__device__ __forceinline__ float key32_to_float(unsigned k) { return __uint_as_float((k & 0x80000000u) ? (k ^ 0x80000000u) : ~k); }
__device__ __forceinline__ float relu_f(float x) { const int b_ = __builtin_bit_cast(int, x); return __builtin_bit_cast(float, b_ > 0 ? b_ : 0); }

struct KFrag { bf16x8 a00, a01, a10, a11; };
__device__ __forceinline__ void dsa_kload(KFrag& f, const bf16_t* kix  , int t, int r, int hi) {
    const bf16_t* p = kix + ((size_t)t * 64 + r) * 32 + hi * 8;
    f.a00 = *(const bf16x8*)p; f.a01 = *(const bf16x8*)(p + 16); f.a10 = *(const bf16x8*)(p + 1024); f.a11 = *(const bf16x8*)(p + 1024 + 16);
}
__device__ __forceinline__ void dsa_scores(f32x16& s0, f32x16& s1, const KFrag& f, const bf16x8 (&qi)[4][2], const float (&w)[4]) {
    s0 = (f32x16){}; s1 = (f32x16){};
#pragma unroll
    for (int ih = 0; ih < 4; ++ih) {
        f32x16 a = __builtin_amdgcn_mfma_f32_32x32x16_bf16(f.a00, qi[ih][0], (f32x16){}, 0, 0, 0); a = __builtin_amdgcn_mfma_f32_32x32x16_bf16(f.a01, qi[ih][1], a, 0, 0, 0);
        f32x16 c = __builtin_amdgcn_mfma_f32_32x32x16_bf16(f.a10, qi[ih][0], (f32x16){}, 0, 0, 0); c = __builtin_amdgcn_mfma_f32_32x32x16_bf16(f.a11, qi[ih][1], c, 0, 0, 0);
#pragma unroll
        for (int i = 0; i < 16; ++i) { s0[i] = __builtin_fmaf(w[ih], relu_f(a[i]), s0[i]); s1[i] = __builtin_fmaf(w[ih], relu_f(c[i]), s1[i]); }
    }
}
__device__ __forceinline__ void hist_add(LAS unsigned* hrow, int r, unsigned bin) { atomicAdd((unsigned*)(hrow + ((bin >> 1) ^ (unsigned)r)), 1u << ((bin & 1u) * 16u)); }

__device__ __forceinline__ void dsa_index_unit(LAS unsigned char* lds, const bf16_t* proj, const bf16_t* kidx, const float* side, unsigned long long* maskbits, int b, int qg, int wid0) {
    const int tid = opaque_tid(wid0), lane = tid & 63, wv = __builtin_amdgcn_readfirstlane(tid >> 6), r = lane & 31, hi = lane >> 5;
    const int tq = qg * 32 + r; const size_t rowq = (size_t)b * S + tq;
    const int nt = (qg >> 1) + 1;
    const int per_ = nt >> 3, rem_ = nt & 7; const int t_lo = wv * per_ + (wv < rem_ ? wv : rem_), t_hi = t_lo + per_ + (wv < rem_ ? 1 : 0);
    bf16x8 qi[4][2]; float w[4];
#pragma unroll
    for (int ih = 0; ih < 4; ++ih) { qi[ih][0] = *(const bf16x8*)(proj + rowq * NP + C_IQ + ih * 32 + hi * 8); qi[ih][1] = *(const bf16x8*)(proj + rowq * NP + C_IQ + ih * 32 + 16 + hi * 8);
        w[ih] = side[rowq * 32 + 4 + ih] * 0.5f; }
    LAS unsigned* h1 = (LAS unsigned*)(lds + DSA_H1) + r * 512; LAS unsigned* h2 = (LAS unsigned*)(lds + DSA_H2) + wv * 1024 + r * 32;
    LAS int* info = (LAS int*)(lds + DSA_INFO);
    const bf16_t* kix = kidx + (size_t)b * S * 32;
    const bool sel_all = (qg < 8);
    __syncthreads();
    if (!sel_all) {
        for (int i = tid; i < (DSA_INFO) / 16; i += NTHREADS) ((LAS u32x4*)lds)[i] = (u32x4){0u, 0u, 0u, 0u};
        __syncthreads();
        if (t_lo < t_hi) {
            KFrag cur, nxt; dsa_kload(cur, kix, t_lo, r, hi);
            for (int t = t_lo; t < t_hi; ++t) {
                if (t + 1 < t_hi) dsa_kload(nxt, kix, t + 1, r, hi);
                f32x16 s0, s1; dsa_scores(s0, s1, cur, qi, w);
                const int kv0 = t * 64;
                if (kv0 + 63 <= qg * 32) {
#pragma unroll
                    for (int i = 0; i < 16; ++i) { hist_add(h1, r, score_key32(s0[i]) >> 22); hist_add(h1, r, score_key32(s1[i]) >> 22); }
                } else {
#pragma unroll
                    for (int i = 0; i < 16; ++i) { const int kv = kv0 + crow(i, hi);
                        if (kv <= tq) hist_add(h1, r, score_key32(s0[i]) >> 22);
                        if (kv + 32 <= tq) hist_add(h1, r, score_key32(s1[i]) >> 22); }
                }
                cur = nxt;
            }
        }
        __syncthreads();
        { const int row = tid >> 4, part = tid & 15; const LAS unsigned* hr = (const LAS unsigned*)(lds + DSA_H1) + row * 512; unsigned cs = 0;
#pragma unroll 8
          for (int j = 0; j < 32; ++j) { const unsigned wd = hr[(part * 32 + j) ^ row]; cs += (wd & 0xffffu) + (wd >> 16); }
          unsigned suf = cs;
#pragma unroll
          for (int o = 1; o < 16; o <<= 1) { const unsigned t = __shfl_down(suf, o, 16); if (part + o < 16) suf += t; }
          const unsigned above = suf - cs;
          if (above < 256u && above + cs >= 256u) { unsigned acc = above; int bsel = part * 64; unsigned ab = above;
              for (int j = 31; j >= 0; --j) { const unsigned wd = hr[(part * 32 + j) ^ row]; const unsigned c1 = wd >> 16, c0 = wd & 0xffffu;
                  if (acc + c1 >= 256u) { bsel = part * 64 + 2 * j + 1; ab = acc; break; } acc += c1;
                  if (acc + c0 >= 256u) { bsel = part * 64 + 2 * j; ab = acc; break; } acc += c0; }
              info[row] = bsel; info[32 + row] = 256 - (int)ab; } }
        __syncthreads();
        const unsigned B1 = (unsigned)info[r];
        const float blo = key32_to_float(B1 << 22), bhi = (B1 >= 1023u) ? INFINITY : key32_to_float((B1 + 1u) << 22);
        if (t_lo < t_hi) {
            KFrag cur, nxt; dsa_kload(cur, kix, t_lo, r, hi);
            for (int t = t_lo; t < t_hi; ++t) {
                if (t + 1 < t_hi) dsa_kload(nxt, kix, t + 1, r, hi);
                f32x16 s0, s1; dsa_scores(s0, s1, cur, qi, w);
                const int kv0 = t * 64;
                if (kv0 + 63 <= qg * 32) {
#pragma unroll
                    for (int i = 0; i < 16; ++i) {
                        if (s0[i] >= blo && s0[i] < bhi) hist_add(h2, r, (score_key32(s0[i]) >> 16) & 63u);
                        if (s1[i] >= blo && s1[i] < bhi) hist_add(h2, r, (score_key32(s1[i]) >> 16) & 63u); }
                } else {
#pragma unroll
                    for (int i = 0; i < 16; ++i) { const int kv = kv0 + crow(i, hi);
                        if (kv <= tq && s0[i] >= blo && s0[i] < bhi) hist_add(h2, r, (score_key32(s0[i]) >> 16) & 63u);
                        if (kv + 32 <= tq && s1[i] >= blo && s1[i] < bhi) hist_add(h2, r, (score_key32(s1[i]) >> 16) & 63u); }
                }
                cur = nxt;
            }
        }
        __syncthreads();
        { const int row = tid >> 4, part = tid & 15; unsigned cnt[4]; unsigned cs = 0; const unsigned need1 = (unsigned)info[32 + row];
          LAS unsigned* h2a = (LAS unsigned*)(lds + DSA_H2);
#pragma unroll
          for (int j = 0; j < 2; ++j) { unsigned c0 = 0, c1 = 0; const int wi = row * 32 + ((part * 2 + j) ^ row);
#pragma unroll
              for (int ww = 0; ww < 8; ++ww) { const unsigned wd = h2a[ww * 1024 + wi]; c0 += wd & 0xffffu; c1 += wd >> 16; }
              cnt[2 * j] = c0; cnt[2 * j + 1] = c1; cs += c0 + c1; }
          unsigned suf = cs;
#pragma unroll
          for (int o = 1; o < 16; o <<= 1) { const unsigned t = __shfl_down(suf, o, 16); if (part + o < 16) suf += t; }
          const unsigned above = suf - cs;
          if (above < need1 && above + cs >= need1) { unsigned acc = above; int bsel = 0; unsigned ab = above; bool found = false;
#pragma unroll
              for (int j = 3; j >= 0; --j) { if (!found) { if (acc + cnt[j] >= need1) { bsel = part * 4 + j; ab = acc; found = true; } else acc += cnt[j]; } }
              info[64 + row] = (int)(((unsigned)info[row] << 6) | (unsigned)bsel); info[96 + row] = (int)(need1 - ab);
              const int wi = row * 32 + ((bsel >> 1) ^ row); unsigned run = 0;
#pragma unroll
              for (int ww = 0; ww < 8; ++ww) { info[128 + row * 8 + ww] = (int)run; const unsigned wd = h2a[ww * 1024 + wi]; run += (bsel & 1) ? (wd >> 16) : (wd & 0xffffu); } } }
        __syncthreads();
    }
    const unsigned T = sel_all ? 0u : (unsigned)info[64 + r];
    const unsigned need2 = sel_all ? 0x7fffffffu : (unsigned)info[96 + r];
    unsigned tc = sel_all ? 0u : (unsigned)info[128 + r * 8 + wv];
    const float f_lo = sel_all ? -INFINITY : key32_to_float(T << 16), f_hi = sel_all ? -INFINITY : ((T >= 0xffffu) ? INFINITY : key32_to_float((T + 1u) << 16));
    if (t_lo < t_hi) {
        KFrag cur, nxt; dsa_kload(cur, kix, t_lo, r, hi);
        for (int t = t_lo; t < t_hi; ++t) {
            if (t + 1 < t_hi) dsa_kload(nxt, kix, t + 1, r, hi);
            f32x16 s0, s1; dsa_scores(s0, s1, cur, qi, w);
            const int kv0 = t * 64; unsigned words[2];
#pragma unroll
            for (int half = 0; half < 2; ++half) {
                unsigned gt = 0, eq = 0;
                if (kv0 + 63 <= qg * 32) {
                    unsigned ge = 0;
#pragma unroll
                    for (int i = 15; i >= 0; --i) { const float sv = half ? s1[i] : s0[i];
                        asm("v_cmp_ge_f32 vcc, %1, %2\n\tv_addc_co_u32 %0, vcc, %0, %0, vcc" : "+v"(gt) : "v"(sv), "v"(f_hi) : "vcc");
                        asm("v_cmp_ge_f32 vcc, %1, %2\n\tv_addc_co_u32 %0, vcc, %0, %0, vcc" : "+v"(ge) : "v"(sv), "v"(f_lo) : "vcc"); }
                    eq = ge & ~gt;
                } else {
#pragma unroll
                    for (int i = 0; i < 16; ++i) { const int kv = kv0 + 32 * half + crow(i, hi); const unsigned k = score_key16(half ? s1[i] : s0[i]);
                        const unsigned v = (kv <= tq) ? 1u : 0u; gt |= ((k > T) ? v : 0u) << i; eq |= ((k == T) ? v : 0u) << i; }
                }
                unsigned sel = gt;
                if (__any(eq != 0u)) {
                    const unsigned a0 = __popc(eq & 0xfu), a1 = __popc(eq & 0xf0u), a2 = __popc(eq & 0xf00u), a3 = __popc(eq & 0xf000u);
                    const unsigned own = a0 | (a1 << 8) | (a2 << 16) | (a3 << 24); unsigned oth; { const auto rr_ = __builtin_amdgcn_permlane32_swap(own, own, false, false); oth = rr_[0] + rr_[1] - own; }
                    const unsigned b0 = oth & 255u, b1 = (oth >> 8) & 255u, b2 = (oth >> 16) & 255u, b3 = oth >> 24;
                    unsigned pre[4]; const unsigned hb = hi ? 1u : 0u;
                    pre[0] = tc + hb * b0; pre[1] = tc + a0 + b0 + hb * b1; pre[2] = tc + a0 + b0 + a1 + b1 + hb * b2; pre[3] = tc + a0 + b0 + a1 + b1 + a2 + b2 + hb * b3;
#pragma unroll
                    for (int g = 0; g < 4; ++g) { unsigned rk = pre[g];
#pragma unroll
                        for (int e = 0; e < 4; ++e) { const unsigned bit = 1u << (4 * g + e); if (eq & bit) { if (rk < need2) sel |= bit; ++rk; } } }
                    tc += a0 + a1 + a2 + a3 + b0 + b1 + b2 + b3;
                }
                unsigned wbits = (sel & 0xfu) | ((sel & 0xf0u) << 4) | ((sel & 0xf00u) << 8) | ((sel & 0xf000u) << 12);
                wbits <<= 4 * hi;
                { const auto rr_ = __builtin_amdgcn_permlane32_swap(wbits, wbits, false, false); wbits = rr_[0] | rr_[1]; }
                words[half] = wbits;
            }
            if (hi == 0) maskbits[(size_t)tq * 128 + t] = (unsigned long long)words[0] | ((unsigned long long)words[1] << 32);
            cur = nxt;
        }
    }
}

template <int KIND>
__device__ __forceinline__ void nsa64_branch(LAS unsigned char* lds, const bf16_t* K, const bf16_t* V  , const bf16x8 (&qr)[4], float alibiA  ,
                                             int tq  , int q64, const LAS int* tlist, int NTreal, int tile0, const LAS unsigned* selq  ,
                                             LAS float* accw  , int wid0) {
    constexpr float THR = 40.0f; constexpr int KS = 4, KSLOT = 8192, KOPS = 1, DK = 64, MODE = 3; constexpr float C2 = 0.125f * LOG2E; constexpr int ld = NP, ldv = NP;
    const int tid = opaque_tid(wid0), lane = tid & 63, r32 = lane & 31, hi = lane >> 5; const int wid = __builtin_amdgcn_readfirstlane(tid >> 6);
    const int NT = NTreal < 4 ? 4 : NTreal;
#define N64_TJ(t) ((KIND == 1) ? tile0 + ((t) < NTreal ? (t) : NTreal - 1) : __builtin_amdgcn_readfirstlane(tlist[(t) < NTreal ? (t) : NTreal - 1]))
    const unsigned lds0 = (unsigned)(size_t)lds; LAS float* wsf = (LAS float*)(lds + A64_WS) + wid * 64;
    const bf16_t* ksrc = K + (size_t)lane * ld + wid * 8;
    const bf16_t* vsrc = V + (size_t)(16 * (wid & 3) + (lane >> 2)) * ldv + (wid >> 2) * 32 + (lane & 3) * 8;
    const unsigned kdst = lds0 + A64_K + wid * 1024, vdst = lds0 + A64_V + wid * 1024;
#define A64_DMA_K(t, slot) a64_glds16(ksrc + (size_t)N64_TJ(t) * 64 * ld, (unsigned)__builtin_amdgcn_readfirstlane(kdst + (slot) * KSLOT))
#define A64_DMA_V(t, slot) a64_glds16(vsrc + (size_t)N64_TJ(t) * 64 * ldv, (unsigned)__builtin_amdgcn_readfirstlane(vdst + (slot) * A64_VSLOT))
    const LAS unsigned char* vp0 = lds + A64_V + ((lane >> 4) & 1) * 32 + (lane & 3) * 8 + (4 * hi + ((lane & 15) >> 2)) * 64;
    const LAS unsigned char* kp0 = lds + A64_K + hi * 1024 + r32 * 16;
    __syncthreads();
    A64_DMA_K(0, 0); A64_DMA_V(0, 0); A64_DMA_K(1, 1);
    float mhat = 0.f, l_reg = 0.f; f32x16 o[2]; o[0] = (f32x16){}; o[1] = (f32x16){};
    const float ea = alibiA * C2;
    bool resc = false;
#define N64_MASK(C0, C1, t, jt) do { const bool dummy_ = (t) >= NTreal; const int kvb_ = 64 * (jt) + 4 * hi; \
        if (KIND == 1) { if (dummy_ || (t) == 0 || (t) == NTreal - 1) { \
            _Pragma("unroll") for (int i = 0; i < 16; ++i) { const int kv = kvb_ + (i & 3) + 8 * (i >> 2); if (dummy_ || kv > tq || kv + 512 <= tq) C0[i] = -INFINITY; if (dummy_ || kv + 32 > tq || kv + 32 + 512 <= tq) C1[i] = -INFINITY; } } } \
        else { const unsigned mw_ = selq[(jt) >> 5]; const bool mine_ = !dummy_ && ((mw_ >> ((jt) & 31)) & 1u); \
            if ((jt) == q64) { _Pragma("unroll") for (int i = 0; i < 16; ++i) { const int kv = kvb_ + (i & 3) + 8 * (i >> 2); if (!mine_ || kv > tq) C0[i] = -INFINITY; if (!mine_ || kv + 32 > tq) C1[i] = -INFINITY; } } \
            else if (__any(!mine_)) { _Pragma("unroll") for (int i = 0; i < 16; ++i) { if (!mine_) { C0[i] = -INFINITY; C1[i] = -INFINITY; } } } } } while (0)
    f32x16 pA0, pA1, pB0, pB1; bf16x8 kf[2 * KS]; s16x4 vlo[8], vhi[8]; u32x4 pw0, pw1, pw2, pw3;
    int sl_prev = 0, sl_cur = 0, sl_next = 1;
#define A64_ROT() do { sl_prev = sl_cur; sl_cur = sl_next; sl_next = (sl_next == 2) ? 0 : sl_next + 1; } while (0)
#define A64_EX(v, NM) __builtin_amdgcn_exp2f(__builtin_fmaf((v), C2, NM))
#define A64_RESC() do { if (resc) { _Pragma("unroll") for (int d_ = 0; d_ < 2; ++d_) _Pragma("unroll") for (int r = 0; r < 16; ++r) o[d_][r] *= wsf[crow(r, hi)]; } } while (0)
#define A64_CINIT(C0, C1, slot) do { float a_ = alibiA; asm volatile("" : "+v"(a_));     \
        _Pragma("unroll") for (int i_ = 0; i_ < 16; ++i_) { C1[i_] = a_ * (float)((i_ & 3) + 8 * (i_ >> 2) + 4 * hi); } } while (0)
#define A64_ROWREF(C0, C1, kb) a64_swapmax(__builtin_fmaxf(__builtin_fmaf(a64_max16(C0), C2, ea * (kb)), __builtin_fmaf(a64_max16(C1), C2, ea * ((kb) + 32.0f))))
    A64_DMA_K(2, 2);
    a64_wait_bar<2 * KOPS + 1>();
    _Pragma("unroll") for (int d0 = 0; d0 < KS; ++d0) a64_kload2(kf, kp0, d0);
    const int j0_ = N64_TJ(0); const float kb0_ = (float)(64 * j0_);
    { A64_CINIT(pA0, pA1, 0);
      pA0 = A64_MFMA(kf[0], qr[0], pA1); pA1 = A64_MFMA(kf[1], qr[0], pA1);
      _Pragma("unroll") for (int d0 = 1; d0 < KS; ++d0) { pA0 = A64_MFMA(kf[2 * d0], qr[d0], pA0); pA1 = A64_MFMA(kf[2 * d0 + 1], qr[d0], pA1); }
      N64_MASK(pA0, pA1, 0, j0_); }
    { mhat = __builtin_fmaxf(A64_ROWREF(pA0, pA1, kb0_), -1e30f); const float nm0 = ea * kb0_ - mhat, nm1 = ea * (kb0_ + 32.0f) - mhat;
#pragma unroll
      for (int r = 0; r < 16; ++r) { pA0[r] = A64_EX(pA0[r], nm0); pA1[r] = A64_EX(pA1[r], nm1); } }
    a64_wait_bar<0>();
    A64_DMA_K(3, 0); A64_DMA_V(1, 1); A64_ROT();
    _Pragma("unroll") for (int d0 = 0; d0 < KS; ++d0) a64_kload2(kf, kp0 + sl_cur * KSLOT, d0);
    a64_wait_bar<KOPS + 1>();
#define A64_PKW(P, i) pk2(P[i], P[i + 1])
#define A64_PAF(k) __builtin_bit_cast(bf16x8, pw##k)
#define A64_VFR(i) (bf16x8){vlo[i][0], vlo[i][1], vlo[i][2], vlo[i][3], vhi[i][0], vhi[i][1], vhi[i][2], vhi[i][3]}
#define A64_VRD(i) do { vlo[i] = a64_vtr(vp_ + (((i) >> 2) * 4096 + ((i) & 3) * 1024)); vhi[i] = a64_vtr(vp_ + (((i) >> 2) * 4096 + ((i) & 3) * 1024 + 512)); } while (0)
#define A64_BRD(G, P0, P1, g_) do { } while (0)
#define A64_KRD(G, d0) do { if (G) { a64_kload2(kf, kp0 + sl_next * KSLOT, d0); A64_SBAR(); } } while (0)
#define A64_GAPA(MF, a0, a1, a2, a3, W0, W1, PW) do { MF; sacc += a0; sacc += a1; sacc += a2; sacc += a3; W0; W1; A64_PIN(PW); A64_PIN(sacc); A64_SBAR(); } while (0)
#define A64_GAPB(MF, X, i, NM) do { MF; X[i] = A64_EX(X[i], NM); X[i + 1] = A64_EX(X[i + 1], NM); X[i + 2] = A64_EX(X[i + 2], NM); X[i + 3] = A64_EX(X[i + 3], NM); A64_PIN(X); A64_SBAR(); } while (0)
#define A64_STEP(C0, C1, P0, P1, t, MASK, GK, GV, GL) do { A64_SBAR(); \
    const int jt_ = N64_TJ(t); const float kb_ = (float)(64 * jt_); \
    A64_CINIT(C0, C1, sl_cur); \
    const LAS unsigned char* vp_ = vp0 + sl_prev * A64_VSLOT; \
    A64_VRD(0); A64_SBAR(); float sacc = P0[0] + P0[1]; \
                    A64_GAPA(C0 = A64_MFMA(kf[0], qr[0], C1), P0[2], P0[3], P0[4], P0[5],     pw0[0] = A64_PKW(P0, 0),  pw0[1] = A64_PKW(P0, 2),  pw0); \
    A64_VRD(4); A64_SBAR(); A64_GAPA(C1 = A64_MFMA(kf[1], qr[0], C1), P0[6], P0[7], P0[8], P0[9],     pw0[2] = A64_PKW(P0, 4),  pw0[3] = A64_PKW(P0, 6),  pw0); \
    A64_VRD(1); A64_SBAR(); A64_GAPA(C0 = A64_MFMA(kf[2], qr[1], C0),    P0[10], P0[11], P0[12], P0[13], pw1[0] = A64_PKW(P0, 8),  pw1[1] = A64_PKW(P0, 10), pw1); \
    A64_VRD(5); A64_SBAR(); A64_GAPA(C1 = A64_MFMA(kf[3], qr[1], C1),    P0[14], P0[15], P1[0], P1[1],   pw1[2] = A64_PKW(P0, 12), pw1[3] = A64_PKW(P0, 14), pw1); \
    A64_VRD(2); A64_SBAR(); A64_GAPA(C0 = A64_MFMA(kf[4], qr[2], C0),    P1[2], P1[3], P1[4], P1[5],     pw2[0] = A64_PKW(P1, 0),  pw2[1] = A64_PKW(P1, 2),  pw2); \
    A64_VRD(6); A64_SBAR(); A64_GAPA(C1 = A64_MFMA(kf[5], qr[2], C1),    P1[6], P1[7], P1[8], P1[9],     pw2[2] = A64_PKW(P1, 4),  pw2[3] = A64_PKW(P1, 6),  pw2); \
    A64_VRD(3); A64_SBAR(); A64_GAPA(C0 = A64_MFMA(kf[6], qr[3], C0),    P1[10], P1[11], P1[12], P1[13], pw3[0] = A64_PKW(P1, 8),  pw3[1] = A64_PKW(P1, 10), pw3); \
    A64_VRD(7); A64_SBAR(); A64_GAPA(C1 = A64_MFMA(kf[7], qr[3], C1),    P1[14], P1[15], 0.f, 0.f,       pw3[2] = A64_PKW(P1, 12), pw3[3] = A64_PKW(P1, 14), pw3); \
    if (KS == 6) { C0 = A64_MFMA(kf[8], qr[4], C0); C1 = A64_MFMA(kf[9], qr[4], C1); C0 = A64_MFMA(kf[10], qr[5], C0); C1 = A64_MFMA(kf[11], qr[5], C1); A64_SBAR(); } \
    l_reg += sacc; \
    if (GK) A64_DMA_K((t) + 3, sl_cur); if (GV) A64_DMA_V((t) + 1, sl_next); \
    N64_MASK(C0, C1, t, jt_); \
    { const float rs_ = A64_ROWREF(C0, C1, kb_); resc = false; \
      if (__builtin_expect(__any(rs_ - mhat > THR), 0)) { const float mn_ = __builtin_fmaxf(mhat, rs_); const float f_ = __builtin_amdgcn_exp2f(mhat - mn_); mhat = mn_; \
          l_reg *= f_; if (hi == 0) wsf[r32] = f_; resc = true; } } \
    const float nm0_ = ea * kb_ - mhat, nm1_ = ea * (kb_ + 32.0f) - mhat; A64_SBAR(); \
    A64_GAPB(o[0] = A64_MFMA(A64_PAF(0), A64_VFR(0), o[0]), C0, 0, nm0_);              A64_GAPB(o[1] = A64_MFMA(A64_PAF(0), A64_VFR(4), o[1]), C0, 4, nm0_); \
    A64_KRD(GL, 0); A64_BRD(GL, P0, P1, 0); A64_GAPB(o[0] = A64_MFMA(A64_PAF(1), A64_VFR(1), o[0]), C0, 8, nm0_);  A64_KRD(GL, 1); A64_BRD(GL, P0, P1, 1); A64_GAPB(o[1] = A64_MFMA(A64_PAF(1), A64_VFR(5), o[1]), C0, 12, nm0_); \
    A64_KRD(GL, 2); A64_BRD(GL, P0, P1, 2); A64_GAPB(o[0] = A64_MFMA(A64_PAF(2), A64_VFR(2), o[0]), C1, 0, nm1_);  A64_KRD(GL, 3); A64_BRD(GL, P0, P1, 3); A64_GAPB(o[1] = A64_MFMA(A64_PAF(2), A64_VFR(6), o[1]), C1, 4, nm1_); \
    if (KS == 6) A64_KRD(GL, 4); A64_GAPB(o[0] = A64_MFMA(A64_PAF(3), A64_VFR(3), o[0]), C1, 8, nm1_);  if (KS == 6) A64_KRD(GL, 5); A64_GAPB(o[1] = A64_MFMA(A64_PAF(3), A64_VFR(7), o[1]), C1, 12, nm1_); \
    } while (0)
    int t = 1;
    for (; t + 5 < NT; t += 2) {
        A64_STEP(pB0, pB1, pA0, pA1, t, false, true, true, true);     a64_wait_bar<KOPS + 1>(); A64_RESC(); A64_ROT();
        A64_STEP(pA0, pA1, pB0, pB1, t + 1, false, true, true, true); a64_wait_bar<KOPS + 1>(); A64_RESC(); A64_ROT();
    }
#define A64_ENDW(tt) do { if ((tt) + 3 < NT) { a64_wait_bar<KOPS + 1>(); } else if ((tt) + 2 < NT) { a64_wait_bar<1>(); } else { a64_wait_bar<0>(); } } while (0)
    for (; t + 1 < NT; t += 2) {
        A64_STEP(pB0, pB1, pA0, pA1, t, true, (t + 3 < NT), (t + 1 < NT), (t + 1 < NT));         A64_ENDW(t);     A64_RESC(); A64_ROT();
        A64_STEP(pA0, pA1, pB0, pB1, t + 1, true, (t + 4 < NT), (t + 2 < NT), (t + 2 < NT));     A64_ENDW(t + 1); A64_RESC(); A64_ROT();
    }
    if (NT & 1) { pB0 = pA0; pB1 = pA1; sl_cur = sl_prev; }
    else { A64_STEP(pB0, pB1, pA0, pA1, NT - 1, true, false, false, false); A64_RESC(); }
    { float sacc = pB0[0] + pB0[1];
#pragma unroll
      for (int r = 2; r < 16; ++r) sacc += pB0[r];
#pragma unroll
      for (int r = 0; r < 16; ++r) sacc += pB1[r];
      l_reg += sacc;
      pw0 = (u32x4){A64_PKW(pB0, 0), A64_PKW(pB0, 2), A64_PKW(pB0, 4), A64_PKW(pB0, 6)}; pw1 = (u32x4){A64_PKW(pB0, 8), A64_PKW(pB0, 10), A64_PKW(pB0, 12), A64_PKW(pB0, 14)};
      pw2 = (u32x4){A64_PKW(pB1, 0), A64_PKW(pB1, 2), A64_PKW(pB1, 4), A64_PKW(pB1, 6)}; pw3 = (u32x4){A64_PKW(pB1, 8), A64_PKW(pB1, 10), A64_PKW(pB1, 12), A64_PKW(pB1, 14)};
      const LAS unsigned char* vp_ = vp0 + sl_cur * A64_VSLOT; _Pragma("unroll") for (int i = 0; i < 8; ++i) A64_VRD(i);
      o[0] = A64_MFMA(A64_PAF(0), A64_VFR(0), o[0]); o[1] = A64_MFMA(A64_PAF(0), A64_VFR(4), o[1]); o[0] = A64_MFMA(A64_PAF(1), A64_VFR(1), o[0]); o[1] = A64_MFMA(A64_PAF(1), A64_VFR(5), o[1]);
      o[0] = A64_MFMA(A64_PAF(2), A64_VFR(2), o[0]); o[1] = A64_MFMA(A64_PAF(2), A64_VFR(6), o[1]); o[0] = A64_MFMA(A64_PAF(3), A64_VFR(3), o[0]); o[1] = A64_MFMA(A64_PAF(3), A64_VFR(7), o[1]); }
    l_reg = swap32_sum(l_reg);
    if (hi == 0) wsf[32 + r32] = l_reg > 0.f ? 1.0f / l_reg : 0.f;
    asm volatile("s_waitcnt lgkmcnt(0)" ::: "memory");
#pragma unroll
    for (int r = 0; r < 16; ++r) { const int col = crow(r, hi); const float fc = wsf[32 + col] * accw[col * 68 + 64 + KIND];
        accw[col * 68 + r32] += o[0][r] * fc; accw[col * 68 + 32 + r32] += o[1][r] * fc; }
    asm volatile("s_waitcnt lgkmcnt(0)\n\ts_barrier" ::: "memory");
#undef A64_DMA_K
#undef A64_DMA_V
#undef A64_ROT
#undef A64_EX
#undef A64_RESC
#undef A64_CINIT
#undef A64_ROWREF
#undef A64_PKW
#undef A64_PAF
#undef A64_VFR
#undef A64_VRD
#undef A64_KRD
#undef A64_BRD
#undef A64_ENDW
#undef A64_GAPA
#undef A64_GAPB
#undef A64_STEP
#undef N64_TJ
#undef N64_MASK
}

constexpr int NSA_IMP = ATT_EXTRA;
constexpr int NSA_SEL = NSA_IMP + 32768;
constexpr int NSA_UNI = NSA_SEL + 1024;
constexpr int NSA_LIST = NSA_UNI + 64;
constexpr int NSA_OT = NSA_LIST + 1024;
static_assert(NSA_OT + 8 * 32 * 68 * 4 <= LDS_BYTES - 16, "NSA LDS map");
static_assert(A64_WS + 8 * 256 <= NSA_SEL, "the branch rings may overlap only the (dead) importance table");

__device__ __forceinline__ void nsa_unit(LAS unsigned char* lds, const bf16_t* proj, const float* side, const bf16_t* kc, const bf16_t* vc, bf16_t* ocat, int b, int q64, int wid0, const float* gn  , float* ssq  ) {
    const int tid = opaque_tid(wid0), lane = tid & 63, wv = __builtin_amdgcn_readfirstlane(tid >> 6), r = lane & 31, hi = lane >> 5;
    const int t0 = q64 * 64, q8 = r >> 2, hd = r & 3, tq = t0 + wv * 8 + q8; const size_t rowq = (size_t)b * S + tq;
    const float c2 = 0.125f * LOG2E;
    const float slope = (hd == 0) ? 0.25f : (hd == 1 ? 0.0625f : (hd == 2 ? 0.015625f : 0.00390625f));
    const float A = 8.0f * slope;
    bf16x8 qf[4];
#pragma unroll
    for (int s = 0; s < 4; ++s) qf[s] = *(const bf16x8*)(proj + rowq * NP + C_NQ + hd * 64 + s * 16 + hi * 8);
    const float g0 = sigmoid_f(side[rowq * 32 + 8 + hd * 3 + 0]);
    const int vb = ((lane >> 4) & 1) * 32 + (lane & 3) * 8 + (4 * hi + ((lane & 15) >> 2)) * 64;
    LAS float* imp = (LAS float*)(lds + NSA_IMP) + wv * 1024;
    LAS unsigned* selw = (LAS unsigned*)(lds + NSA_SEL) + wv * 32;
    LAS unsigned* uni = (LAS unsigned*)(lds + NSA_UNI);
    LAS int* list = (LAS int*)(lds + NSA_LIST);
    LAS float* accw = (LAS float*)(lds + NSA_OT) + wv * (32 * 68);
    __syncthreads();
    for (int i = lane; i < 1024; i += 64) imp[i] = 0.f;
    if (tid < 4) uni[tid] = 0u;
    const bf16_t* kcb = kc + (size_t)b * 512 * 64; const bf16_t* vcb = vc + (size_t)b * 512 * 64;
    const int ntc = (((t0 + 32) >> 4) >> 6) + 1;
    const unsigned lds0n = (unsigned)(size_t)lds;
    const bf16_t* kcs = kcb + (size_t)lane * 64 + wv * 8;
    const bf16_t* vcs = vcb + (size_t)(16 * (wv & 3) + (lane >> 2)) * 64 + (wv >> 2) * 32 + (lane & 3) * 8;
    for (int t = 0; t < ntc; ++t) a64_glds16(kcs + (size_t)t * 4096, (unsigned)__builtin_amdgcn_readfirstlane(lds0n + NSA_OT + t * 8192 + wv * 1024));
    a64_glds16(vcs, (unsigned)__builtin_amdgcn_readfirstlane(lds0n + wv * 1024));
    if (1 < ntc) a64_glds16(vcs + 4096, (unsigned)__builtin_amdgcn_readfirstlane(lds0n + 8192 + wv * 1024));
    asm volatile("s_waitcnt vmcnt(0) lgkmcnt(0)\n\ts_barrier" ::: "memory");
    SoftState st; st.m = NEG_BIG; st.l = 0.f; st.o0 = (f32x16){}; st.o1 = (f32x16){};
    const LAS unsigned char* kres = lds + NSA_OT + hi * 1024 + r * 16;
#define NSA_CMP_SCORES(p0, p1, t) do { const int n0 = (t) * 64; \
        { const float base = A * (float)(16 * (n0 + 4 * hi) + 31); \
          _Pragma("unroll") for (int i = 0; i < 16; ++i) { p0[i] = base + A * 16.0f * (float)((i & 3) + 8 * (i >> 2)); p1[i] = p0[i] + A * 512.0f; } } \
        { const LAS unsigned char* kp = kres + (t) * 8192; \
          _Pragma("unroll") for (int d0 = 0; d0 < 4; ++d0) { const bf16x8 a0 = *(const LAS bf16x8*)(kp + d0 * 2048), a1 = *(const LAS bf16x8*)(kp + d0 * 2048 + 512); \
              p0 = __builtin_amdgcn_mfma_f32_32x32x16_bf16(a0, qf[d0], p0, 0, 0, 0); p1 = __builtin_amdgcn_mfma_f32_32x32x16_bf16(a1, qf[d0], p1, 0, 0, 0); } } \
        _Pragma("unroll") for (int i = 0; i < 16; ++i) { const int n = n0 + crow(i, hi); if (16 * n + 31 > tq) p0[i] = -INFINITY; if (16 * (n + 32) + 31 > tq) p1[i] = -INFINITY; } } while (0)
    for (int t = 0; t < ntc; ++t) {
        f32x16 p0, p1; NSA_CMP_SCORES(p0, p1, t);
        const float mx = tile_max(p0, p1); const float mn = fmaxf(st.m, mx);
        const float al = __builtin_amdgcn_exp2f((st.m - mn) * c2); st.l *= al; st.m = mn; const float mcc = mn * c2; float sum = 0.f;
#pragma unroll
        for (int i = 0; i < 16; ++i) sum += __builtin_amdgcn_exp2f(__builtin_fmaf(p0[i], c2, -mcc)) + __builtin_amdgcn_exp2f(__builtin_fmaf(p1[i], c2, -mcc));
        st.l += sum;
    }
    {
        const float l = swap32_sum(st.l); const float rl = l > 0.f ? 1.0f / l : 0.f; const float mc = st.m * c2;
        int slot = 0;
        for (int t = 0; t < ntc; ++t) {
            if (t + 1 < ntc) asm volatile("s_waitcnt vmcnt(1) lgkmcnt(0)\n\ts_barrier" ::: "memory"); else asm volatile("s_waitcnt vmcnt(0) lgkmcnt(0)\n\ts_barrier" ::: "memory");
            if (t + 2 < ntc) { const int s2 = (slot == 0) ? 2 : slot - 1;
                a64_glds16(vcs + (size_t)(t + 2) * 4096, (unsigned)__builtin_amdgcn_readfirstlane(lds0n + s2 * 8192 + wv * 1024)); }
            f32x16 p0, p1; NSA_CMP_SCORES(p0, p1, t);
#pragma unroll
            for (int i = 0; i < 16; ++i) { p0[i] = __builtin_amdgcn_exp2f(__builtin_fmaf(p0[i], c2, -mc)) * rl; p1[i] = __builtin_amdgcn_exp2f(__builtin_fmaf(p1[i], c2, -mc)) * rl; }
#pragma unroll
            for (int half = 0; half < 2; ++half)
#pragma unroll
                for (int g = 0; g < 4; ++g) { const f32x16& pp = half ? p1 : p0;
                    float s4 = (pp[4 * g] + pp[4 * g + 1]) + (pp[4 * g + 2] + pp[4 * g + 3]); float s3 = pp[4 * g + 3];
                    s4 += quad_xor1(s4); s4 += quad_xor2(s4); s3 += quad_xor1(s3); s3 += quad_xor2(s3);
                    const int j1 = 16 * t + 8 * half + 2 * g + hi;
                    if (hd == 0) atomicAdd((float*)(imp + q8 * 128 + j1), s4);
                    if (hd == 0 && j1 + 1 < 128) atomicAdd((float*)(imp + q8 * 128 + j1 + 1), s3); }
            pv_tile(st.o0, st.o1, p0, p1, lds + slot * 8192, vb);
            slot = (slot == 2) ? 0 : slot + 1;
        }
    }
#undef NSA_CMP_SCORES
    __syncthreads();
#pragma unroll
    for (int i = 0; i < 16; ++i) { accw[r * 68 + crow(i, hi)] = st.o0[i] * g0; accw[r * 68 + 32 + crow(i, hi)] = st.o1[i] * g0; }
    if (hi == 0) { accw[r * 68 + 64] = sigmoid_f(side[rowq * 32 + 8 + hd * 3 + 1]); accw[r * 68 + 65] = sigmoid_f(side[rowq * 32 + 8 + hd * 3 + 2]); }
    {
        const int cur = q64;
        for (int qq = 0; qq < 8; ++qq) {
            float v0 = imp[qq * 128 + lane], v1 = imp[qq * 128 + 64 + lane];
            bool ok0 = true, ok1 = true;
            { const int j0 = lane, j1 = lane + 64;
              if (j0 == 0 || j0 == cur) v0 = INFINITY; else if (j0 > cur) ok0 = false;
              if (j1 == cur) v1 = INFINITY; else if (j1 > cur) ok1 = false; }
            const unsigned k0 = __float_as_uint(v0), k1 = __float_as_uint(v1);
            unsigned T = 0u;
            for (int bit = 30; bit >= 0; --bit) { const unsigned cand = T | (1u << bit);
                const int cnt = __popcll(__ballot(ok0 && k0 >= cand)) + __popcll(__ballot(ok1 && k1 >= cand));
                if (cnt >= 16) T = cand;
                if (cnt == 16) break; }
            const unsigned long long gt0 = __ballot(ok0 && k0 > T), gt1 = __ballot(ok1 && k1 > T), eq0 = __ballot(ok0 && k0 == T), eq1 = __ballot(ok1 && k1 == T);
            const int need = 16 - (__popcll(gt0) + __popcll(gt1));
            const int r0 = (int)__builtin_amdgcn_mbcnt_hi((unsigned)(eq0 >> 32), __builtin_amdgcn_mbcnt_lo((unsigned)eq0, 0u));
            const int r1 = __popcll(eq0) + (int)__builtin_amdgcn_mbcnt_hi((unsigned)(eq1 >> 32), __builtin_amdgcn_mbcnt_lo((unsigned)eq1, 0u));
            const unsigned long long slo = __ballot(ok0 && (k0 > T || (k0 == T && r0 < need))), shi = __ballot(ok1 && (k1 > T || (k1 == T && r1 < need)));
            if (lane == 0) { selw[qq * 4 + 0] = (unsigned)slo; selw[qq * 4 + 1] = (unsigned)(slo >> 32); selw[qq * 4 + 2] = (unsigned)shi; selw[qq * 4 + 3] = (unsigned)(shi >> 32);
                atomicOr((unsigned*)(uni + 0), (unsigned)slo); atomicOr((unsigned*)(uni + 1), (unsigned)(slo >> 32)); atomicOr((unsigned*)(uni + 2), (unsigned)shi); atomicOr((unsigned*)(uni + 3), (unsigned)(shi >> 32)); }
        }
    }
    __syncthreads();
    if (tid == 0) { int n = 0; for (int wd = 0; wd < 4; ++wd) { unsigned u = uni[wd]; while (u) { const int j = __ffs(u) - 1; u &= u - 1; list[n++] = wd * 32 + j; } } list[131] = n; }
    __syncthreads();
    {
        const int nl = list[131];
        nsa64_branch<0>(lds, proj + (size_t)b * S * NP + C_KSEL, proj + (size_t)b * S * NP + C_VSEL, qf, A, tq, q64, list, nl, 0, selw + q8 * 4, accw, wid0);
        const int tw0 = (q64 >= 8) ? q64 - 8 : 0, ntw = q64 - tw0 + 1;
        nsa64_branch<1>(lds, proj + (size_t)b * S * NP + C_KWIN, proj + (size_t)b * S * NP + C_VWIN, qf, A, tq, q64, list, ntw, tw0, selw, accw, wid0);
    }
#pragma unroll
    for (int i = 0; i < 4; ++i) { const int col = i * 8 + (lane >> 3), ch = lane & 7, q8c = col >> 2, hdc = col & 3; const size_t rq = (size_t)b * S + t0 + wv * 8 + q8c;
        const f32x4 a0 = *(const LAS f32x4*)(accw + col * 68 + ch * 8), a1 = *(const LAS f32x4*)(accw + col * 68 + ch * 8 + 4);
        const u32x4 zz = *(const u32x4*)(proj + rq * NP + C_GZ + 768 + hdc * 64 + ch * 8);
        const f32x4 ga = *(const f32x4*)(gn + 768 + hdc * 64 + ch * 8), gb = *(const f32x4*)(gn + 768 + hdc * 64 + ch * 8 + 4);
        float sq = ((a0[0] * a0[0] + a0[1] * a0[1]) + (a0[2] * a0[2] + a0[3] * a0[3])) + ((a1[0] * a1[0] + a1[1] * a1[1]) + (a1[2] * a1[2] + a1[3] * a1[3]));
        u32x4 w; w[0] = pk2(a0[0] * ga[0] * silu_fast(bflo(zz[0])), a0[1] * ga[1] * silu_fast(bfhi(zz[0]))); w[1] = pk2(a0[2] * ga[2] * silu_fast(bflo(zz[1])), a0[3] * ga[3] * silu_fast(bfhi(zz[1])));
        w[2] = pk2(a1[0] * gb[0] * silu_fast(bflo(zz[2])), a1[1] * gb[1] * silu_fast(bfhi(zz[2]))); w[3] = pk2(a1[2] * gb[2] * silu_fast(bflo(zz[3])), a1[3] * gb[3] * silu_fast(bfhi(zz[3])));
        *(u32x4*)(ocat + rq * D + 768 + hdc * 64 + ch * 8) = w;
        sq += quad_xor1(sq); sq += quad_xor2(sq);
        sq += __builtin_bit_cast(float, __builtin_amdgcn_update_dpp(0, __builtin_bit_cast(int, sq), 0x141, 0xf, 0xf, false));
        if (ch == 0) ssq[rq * 16 + 12 + hdc] = sq; }
}

__device__ __forceinline__ void phase_onorm(const bf16_t* ocat, const bf16_t* proj, const float* og, bf16_t* oa, int bid, int G, int wid0) {
    const int tid_ = opaque_tid(wid0); const int lane = tid_ & 63, wv = tid_ >> 6;
    for (int row = bid * 8 + wv; row < M; row += G * 8) {
        const int c = lane * 16;
        const u32x4 a0 = *(const u32x4*)(ocat + (size_t)row * D + c), a1 = *(const u32x4*)(ocat + (size_t)row * D + c + 8);
        const u32x4 z0 = *(const u32x4*)(proj + (size_t)row * NP + C_GZ + c), z1 = *(const u32x4*)(proj + (size_t)row * NP + C_GZ + c + 8);
        float v[16], z[16]; float s = 0.f;
#pragma unroll
        for (int e = 0; e < 4; ++e) { v[2 * e] = bflo(a0[e]); v[2 * e + 1] = bfhi(a0[e]); v[8 + 2 * e] = bflo(a1[e]); v[8 + 2 * e + 1] = bfhi(a1[e]);
            z[2 * e] = bflo(z0[e]); z[2 * e + 1] = bfhi(z0[e]); z[8 + 2 * e] = bflo(z1[e]); z[8 + 2 * e + 1] = bfhi(z1[e]); }
#pragma unroll
        for (int e = 0; e < 16; ++e) s += v[e] * v[e];
        s += __builtin_bit_cast(float, __builtin_amdgcn_update_dpp(0, __builtin_bit_cast(int, s), 0xB1, 0xf, 0xf, false));
        s += __builtin_bit_cast(float, __builtin_amdgcn_update_dpp(0, __builtin_bit_cast(int, s), 0x4E, 0xf, 0xf, false));
        s += __builtin_bit_cast(float, __builtin_amdgcn_update_dpp(0, __builtin_bit_cast(int, s), 0x141, 0xf, 0xf, false));
        s += __builtin_bit_cast(float, __builtin_amdgcn_update_dpp(0, __builtin_bit_cast(int, s), 0x140, 0xf, 0xf, false));
        const float rstd = 1.0f / sqrtf(s * (1.f / 256.f) + EPS);
        float y[16];
#pragma unroll
        for (int e = 0; e < 16; ++e) y[e] = v[e] * rstd * og[c + e] * silu_f(z[e]);
        u32x4 w0, w1;
#pragma unroll
        for (int e = 0; e < 4; ++e) { w0[e] = pk2(y[2 * e], y[2 * e + 1]); w1[e] = pk2(y[8 + 2 * e], y[8 + 2 * e + 1]); }
        *(u32x4*)(oa + (size_t)row * D + c) = w0; *(u32x4*)(oa + (size_t)row * D + c + 8) = w1;
    }
}
__device__ __forceinline__ void phase_final(float* out, const float* g, int bid, int G, int wid0) {
    const int tid_ = opaque_tid(wid0); const int lane = tid_ & 63, wv = tid_ >> 6;
    for (int row = bid * 8 + wv; row < M; row += G * 8) {
        f32x4* xr = (f32x4*)(out + (size_t)row * D) + lane;
        f32x4 v[4]; float s = 0.f;
#pragma unroll
        for (int j = 0; j < 4; ++j) { v[j] = xr[64 * j]; s += (v[j][0] * v[j][0] + v[j][1] * v[j][1]) + (v[j][2] * v[j][2] + v[j][3] * v[j][3]); }
        const float rstd = 1.0f / sqrtf(wave_sum(s) * (1.f / D) + EPS);
#pragma unroll
        for (int j = 0; j < 4; ++j) { const f32x4 gg = *(const f32x4*)(g + (64 * j + lane) * 4); xr[64 * j] = v[j] * rstd * gg; }
    }
}

#define XB_TMO      128
#define XB_XCNT(j)  (256  + 64 * (j))
#define XB_XSUB(j)  (1280 + 64 * (j))
#define XB_XGEN(j)  (2304 + 64 * (j))
#define XB_TOP      3328
#define XB_TOPGEN   3392
#define XCD_BAR_WORDS 3456
#define XB_SPIN_CAP (1u << 22)
__device__ __forceinline__ unsigned xb_ld(unsigned* p)              { return __hip_atomic_load(p, __ATOMIC_RELAXED, __HIP_MEMORY_SCOPE_AGENT); }
__device__ __forceinline__ unsigned xb_add(unsigned* p, unsigned v) { return __hip_atomic_fetch_add(p, v, __ATOMIC_RELAXED, __HIP_MEMORY_SCOPE_AGENT); }
__device__ __forceinline__ unsigned xb_xcc_id() { return (unsigned)__builtin_amdgcn_s_getreg((3 << 11) | 20) & 0xFu; }
#define XB_SPIN(cond, bar) do { unsigned _sp = 0; while (cond) { __builtin_amdgcn_s_sleep(1); \
    if ((++_sp & 255u) == 0u) { if (xb_ld(&(bar)[XB_TMO])) break; if (_sp > XB_SPIN_CAP) { atomicAdd(&(bar)[XB_TMO], 1u); break; } } } } while (0)
__device__ __forceinline__ void xcd_barrier_complete(unsigned* bar, unsigned x, unsigned G, unsigned& nloc, unsigned& nx) {
    unsigned sum, cnt, mine, sp = 0u;
    for (;;) {
        sum = 0u; cnt = 0u; mine = 0u;
#pragma unroll
        for (unsigned j = 0; j < 16; ++j) { const unsigned c = xb_ld(&bar[XB_XCNT(j)]); sum += c; cnt += (c > 0u) ? 1u : 0u; mine = (j == x) ? c : mine; }
        if (sum == G) break;
        __builtin_amdgcn_s_sleep(1);
        if ((++sp & 255u) == 0u) { if (xb_ld(&bar[XB_TMO])) break; if (sp > XB_SPIN_CAP) { atomicAdd(&bar[XB_TMO], 1u); break; } }
    }
    nloc = mine > 0u ? mine : 1u; nx = cnt > 0u ? cnt : 1u;
}
__device__ __forceinline__ void grid_bar(unsigned* bar, volatile LAS unsigned* st, unsigned G, int wid0) {
    const int tid = opaque_tid(wid0);
    asm volatile("s_waitcnt vmcnt(0)" ::: "memory");
    __syncthreads();
    if (tid == 0) {
        const unsigned x = xb_xcc_id();
        unsigned nloc = st[0], nx = st[1];
        if (nloc == 0u) { xcd_barrier_complete(bar, x, G, nloc, nx); st[0] = nloc; st[1] = nx; }
        const unsigned old = xb_add(&bar[XB_XSUB(x)], 1u);
        const unsigned gen = old / nloc;
        if (old + 1u == (gen + 1u) * nloc) {
            __builtin_amdgcn_fence(__ATOMIC_RELEASE, "agent");
            asm volatile("s_waitcnt vmcnt(0)" ::: "memory");
            const unsigned og = xb_add(&bar[XB_TOP], 1u);
            const unsigned tg = og / nx;
            if (og + 1u == (tg + 1u) * nx) xb_add(&bar[XB_TOPGEN], 1u);
            else XB_SPIN(xb_ld(&bar[XB_TOPGEN]) == tg, bar);
            __builtin_amdgcn_fence(__ATOMIC_ACQUIRE, "agent");
            xb_add(&bar[XB_XGEN(x)], 1u);
            asm volatile("s_waitcnt vmcnt(0)" ::: "memory");
        } else {
            XB_SPIN(xb_ld(&bar[XB_XGEN(x)]) == gen, bar);
            __builtin_amdgcn_fence(__ATOMIC_ACQUIRE, "agent");
            asm volatile("s_waitcnt vmcnt(0)" ::: "memory");
        }
    }
    __syncthreads();
}

constexpr int N_PHASES = 16;
__global__ void __launch_bounds__(NTHREADS) hymba_fwd(Params P) {
    extern __shared__ __attribute__((aligned(16))) unsigned char lds_raw[];
    LAS unsigned char* lds = (LAS unsigned char*)lds_raw;
    const int bid = blockIdx.x, G = gridDim.x;
    const int wid0 = __builtin_amdgcn_readfirstlane((int)(threadIdx.x >> 6));
    volatile LAS unsigned* xst = (volatile LAS unsigned*)(lds + LDS_BYTES - 16);
    unsigned* xbar = (unsigned*)(P.ws + WS_CTL) + 4096 + P.bar_region * XCD_BAR_WORDS;
    if (threadIdx.x == 0) { xst[0] = 0u; xst[1] = 0u; }
    __syncthreads();
    unsigned char* ws = P.ws;
    bf16_t* proj = (bf16_t*)(ws + WS_PROJ); float* side = (float*)(ws + WS_SIDE);
    bf16_t* hbuf = (bf16_t*)(ws + WS_H); bf16_t* ocat = (bf16_t*)(ws + WS_OCAT);
#define PH(k) (P.ph_lo <= (k) && (k) < P.ph_hi)
#define SYNC(k) do { if (PH(k) && PH((k) + 1)) grid_bar(xbar, xst, (unsigned)G, wid0); } while (0)
    if (PH(0)) { const int i = bid * NTHREADS + (int)threadIdx.x; if (i < XCD_BAR_WORDS) { __hip_atomic_store(xbar + i, 0u, __ATOMIC_RELAXED, __HIP_MEMORY_SCOPE_AGENT); __threadfence(); } }
    if (PH(0)) phase_prologue(P, lds, bid, G, wid0);
    if (PH(0) && PH(1)) cg::this_grid().sync();
    if (opaque_tid(wid0) == 0) (void)xb_add(&xbar[XB_XCNT(xb_xcc_id())], 1u);
#ifndef PREP_SHIFT
#define PREP_SHIFT 4
#endif
#ifndef ATT_REP
#define ATT_REP 0
#endif
#ifndef PROBE_VAR
#define PROBE_VAR -1
#endif
#define LAYER(l, base) do { \
    const float* mod = (const float*)(ws + WS_MOD) + (size_t)(l) * 4 * 3072; \
    const float* xin = ((l) == 0) ? P.in[0] : P.out; \
    if (PH((base) + 0)) phase_hnorm(xin, P.in[2] + (l) * D, mod, hbuf, bid, G, wid0); \
    SYNC((base) + 0); \
    if (PH((base) + 1)) { pg8::Gemm g{hbuf, (const bf16_t*)(ws + WS_WIN) + (size_t)(l) * NP * D, M, NP, D, D, D}; pg8::StaticOrder so; so.init(M, NP, G, bid); \
        pg8::EpiProj E{proj, side}; pg8::gemm_phase<pg8::EpiProj, true>(lds, g, so, E, wid0); \
        if ((l) == 0 && DEPTH == 2 && G == 256 && bid >= 128) weight_tiles(P, lds, WT_L + (bid - 128), 128, 2 * WT_L, wid0);     } \
    SYNC((base) + 1); \
    if (PH((base) + 2)) phase_prep(P, (l), lds, bid, G, wid0); \
    SYNC((base) + 2); \
    if (PH((base) + 3)) { \
        { pg8::Gemm g{proj + C_QLAT, (const bf16_t*)(ws + WS_WUQ) + (size_t)(l) * 512 * 256, M, 512, 256, NP, 256}; pg8::StaticOrder so; so.init(M, 512, G, bid); \
          pg8::EpiQup E{(bf16_t*)(ws + WS_QMLA), (const float*)(ws + WS_RSTD), (const float*)(ws + WS_ROPE)}; pg8::gemm_phase<pg8::EpiQup, true>(lds, g, so, E, wid0); } \
        { pg8::Gemm g{proj + C_KVLAT, (const bf16_t*)(ws + WS_WUKV) + (size_t)(l) * 512 * 128, M, 512, 128, NP, 128}; pg8::StaticOrder so; so.init(M, 512, G, bid); \
          pg8::EpiKVup E{(bf16_t*)(ws + WS_KMLA), (bf16_t*)(ws + WS_VMLA), (const float*)(ws + WS_RSTD)}; pg8::gemm_phase<pg8::EpiKVup, true>(lds, g, so, E, wid0); } \
        for (int k = 0; k * G < 1024; ++k) { const int u = (k & 1) ? (k + 1) * G - 1 - bid : k * G + bid; if (u >= 1024 || u < 0) continue; const int qg = 255 - (u >> 2), b = u & 3; \
            dsa_index_unit(lds, proj, (const bf16_t*)(ws + WS_KIDX), side, (unsigned long long*)(ws + WS_MASK) + (size_t)b * S * 128, b, qg, wid0); } } \
    SYNC((base) + 3); \
    if (PH((base) + 4)) { const int vb_ = (G % 8 == 0) ? (bid & 7) * (G >> 3) + (bid >> 3) : bid;     \
        if (G == 256) {   \
          const int tw_ = opaque_tid(wid0); const int b_ = (bid & 7) >> 1; \
          if (tw_ < 128) { const int pg_ = (bid >> 3) * 128 + tw_;     \
              const unsigned char* a_ = (pg_ < 1536) ? ws + WS_QMLA + (size_t)b_ * S * 768 + (size_t)pg_ * 4096 : (pg_ < 3072) ? ws + WS_KMLA + (size_t)b_ * S * 768 + (size_t)(pg_ - 1536) * 4096 \
                                                      : ws + WS_VMLA + (size_t)b_ * S * 512 + (size_t)(pg_ - 3072) * 4096; \
              const unsigned v_ = *(const volatile unsigned*)a_; if (v_ == 0x12345677u) *(volatile unsigned*)(ws + WS_CTL + 8192 + 512) = v_; } } \
        for (int i = vb_; i < 512; i += G) { const int ii = i & 255, bh = ii >> 4, qb = (i < 256) ? (ii & 15) : 31 - (ii & 15), b = bh >> 2, hd = bh & 3; const size_t rb = (size_t)b * S; \
            attn64_unit<0, 96>(lds, (const bf16_t*)(ws + WS_QMLA) + rb * 384 + hd * 96, 384, (const bf16_t*)(ws + WS_KMLA) + rb * 384 + hd * 96, 384, \
                              (const bf16_t*)(ws + WS_VMLA) + rb * 256 + hd * 64, 256, ocat + rb * D + hd * 64, nullptr, nullptr, 0.f, 0.10206207261596577f * LOG2E, qb, wid0, proj + rb * NP + C_GZ + hd * 64, P.in[14] + (l) * D + hd * 64, (float*)(ws + WS_SSQ) + rb * 16 + hd); } \
        for (int rep = 0; rep < (((ATT_REP & 2) && (l) == 0) ? 2 : 1); ++rep) for (int i = vb_; i < 512; i += G) { const int ii = i & 255, bh = ii >> 4, qb = (i < 256) ? (ii & 15) : 31 - (ii & 15), b = bh >> 2, hd = bh & 3; const size_t rb = (size_t)b * S; \
            attn64_unit<1, 64>(lds, proj + rb * NP + C_FQ + hd * 64, NP, proj + rb * NP + C_FK + hd * 64, NP, proj + rb * NP + C_FV + hd * 64, NP, \
                              ocat + rb * D + 256 + hd * 64, (const float*)(ws + WS_FB) + (size_t)bh * S, nullptr, 0.f, 0.125f * LOG2E, qb, wid0, proj + rb * NP + C_GZ + 256 + hd * 64, P.in[14] + (l) * D + 256 + hd * 64, (float*)(ws + WS_SSQ) + rb * 16 + 4 + hd); } \
        for (int rep = 0; rep < (((ATT_REP & 4) && (l) == 0) ? 2 : 1); ++rep) for (int i = vb_; i < 512; i += G) { const int ii = i & 255, bh = ii >> 4, qb = (i < 256) ? (ii & 15) : 31 - (ii & 15), b = bh >> 2, hd = bh & 3; const size_t rb = (size_t)b * S; \
            const float slope = (hd == 0) ? 0.25f : (hd == 1 ? 0.0625f : (hd == 2 ? 0.015625f : 0.00390625f)); \
            attn64_unit<2, 64>(lds, proj + rb * NP + C_DQ + hd * 64, NP, proj + rb * NP + C_DK + hd * 64, NP, proj + rb * NP + C_DV + hd * 64, NP, \
                              ocat + rb * D + 512 + hd * 64, nullptr, (const unsigned long long*)(ws + WS_MASK) + rb * 128, 8.0f * slope, 0.125f * LOG2E, qb, wid0, proj + rb * NP + C_GZ + 512 + hd * 64, P.in[14] + (l) * D + 512 + hd * 64, (float*)(ws + WS_SSQ) + rb * 16 + 8 + hd); } \
        for (int rep = 0; rep < (((ATT_REP & 8) && (l) == 0) ? 2 : 1); ++rep) for (int u = vb_; u < 512; u += G) { const int b = u >> 7, q64 = (u < 256) ? (u & 127) : 127 - (u & 127);     \
            nsa_unit(lds, proj, side, (const bf16_t*)(ws + WS_KC), (const bf16_t*)(ws + WS_VC), ocat, b, q64, wid0, P.in[14] + (l) * D, (float*)(ws + WS_SSQ)); } } \
    SYNC((base) + 4); \
      \
    if (PH((base) + 6)) { pg8::Gemm g{ocat, (const bf16_t*)(ws + WS_WOUT) + (size_t)(l) * D * D, M, D, D, D, D}; pg8::StaticOrder so; so.init(M, D, G, bid); \
        pg8::EpiOut E{xin, P.out, mod + 2048, (const float*)(ws + WS_SSQ)}; pg8::gemm_phase<pg8::EpiOut, true>(lds, g, so, E, wid0); } \
    SYNC((base) + 6); \
} while (0)
    LAYER(0, 1);
    LAYER(1, 8);
    if (PH(15)) phase_final(P.out, P.in[16], bid, G, wid0);
#undef LAYER
#undef PH
#undef SYNC
}


#ifdef DBG_GROUP
#ifndef DBG_LAYER
#define DBG_LAYER 1
#endif
__device__ __forceinline__ float dbg_bf(const bf16_t* p) { return bf2f(*p); }
__device__ const int dbg_rows[48] = {0, 1, 2, 15, 30, 31, 32, 47, 63, 64, 65, 127, 128, 200, 255, 256, 257, 300, 511, 512, 513, 700, 1000, 1023, 1024, 1025, 1500, 2047, 2048, 3000, 3333, 4095, 4096, 4500, 5000, 5555, 6143, 6144, 7000, 7777, 8000, 8100, 8127, 8128, 8160, 8190, 8191, 4242};
template <class ScoreFn, class VFn>
__device__ __forceinline__ float dbg_attn(int k_lo, int k_hi, ScoreFn score, VFn vload, int lane) {
    float m = -INFINITY, l = 0.f, acc = 0.f;
    for (int kv = k_lo; kv <= k_hi; ++kv) {
        const float sc = score(kv);
        if (sc == -INFINITY) continue;
        const float mn = fmaxf(m, sc); const float al = (m == -INFINITY) ? 0.f : __expf(m - mn); const float p = __expf(sc - mn);
        l = l * al + p; acc = acc * al + p * vload(kv, lane); m = mn;
    }
    return l > 0.f ? acc / l : 0.f;
}
__global__ void __launch_bounds__(64) dbg_check(Params P) {
    const int lane = threadIdx.x, wid = blockIdx.x; const int hd = wid & 3, ri = (wid >> 2) % 48, b = (wid >> 2) / 48; const int t = dbg_rows[ri];
    unsigned char* ws = P.ws; const bf16_t* proj = (const bf16_t*)(ws + WS_PROJ); const float* side = (const float*)(ws + WS_SIDE);
    const bf16_t* ocat = (const bf16_t*)(ws + WS_OCAT); const size_t rowq = (size_t)b * S + t; const size_t rb = (size_t)b * S;
    float* scratch = (float*)(ws + WS_H) + (size_t)wid * 16384;
    float ref = 0.f; int grp = DBG_GROUP % 10;
    const float slope = (hd == 0) ? 0.25f : (hd == 1 ? 0.0625f : (hd == 2 ? 0.015625f : 0.00390625f));
    if (grp == 0) {
        const bf16_t* q = (const bf16_t*)(ws + WS_QMLA) + rowq * 384 + hd * 96; const bf16_t* K = (const bf16_t*)(ws + WS_KMLA) + rb * 384 + hd * 96; const bf16_t* V = (const bf16_t*)(ws + WS_VMLA) + rb * 256 + hd * 64;
        const float q0 = dbg_bf(q + lane), q1 = lane < 32 ? dbg_bf(q + 64 + lane) : 0.f;
        ref = dbg_attn(0, t, [&](int kv) { float pr = q0 * dbg_bf(K + (size_t)kv * 384 + lane) + (lane < 32 ? q1 * dbg_bf(K + (size_t)kv * 384 + 64 + lane) : 0.f); return wave_sum(pr) * 0.10206207261596577f; },
                       [&](int kv, int d) { return dbg_bf(V + (size_t)kv * 256 + d); }, lane);
    } else if (grp == 1) {
        const bf16_t* q = proj + rowq * NP + C_FQ + hd * 64; const bf16_t* K = proj + rb * NP + C_FK + hd * 64; const bf16_t* V = proj + rb * NP + C_FV + hd * 64; const float* fb = (const float*)(ws + WS_FB) + (size_t)(b * 4 + hd) * S;
        const float q0 = dbg_bf(q + lane); const float ft = fb[t];
        ref = dbg_attn(0, t, [&](int kv) { return wave_sum(q0 * dbg_bf(K + (size_t)kv * NP + lane)) * 0.125f + (fb[kv] - ft) * 0.125f; },
                       [&](int kv, int d) { return dbg_bf(V + (size_t)kv * NP + d); }, lane);
    } else if (grp == 2) {
        float* sc = scratch; unsigned char* selb = (unsigned char*)(scratch + 8192);
        const int ih = lane >> 4, dd = (lane & 15) * 2;
        const float qa = dbg_bf(proj + rowq * NP + C_IQ + ih * 32 + dd), qb2 = dbg_bf(proj + rowq * NP + C_IQ + ih * 32 + dd + 1); const float wgt = side[rowq * 32 + 4 + ih] * 0.5f;
        for (int kv = 0; kv <= t; ++kv) { float pr = qa * dbg_bf(proj + (rb + kv) * NP + C_IK + dd) + qb2 * dbg_bf(proj + (rb + kv) * NP + C_IK + dd + 1);
            pr += __shfl_xor(pr, 1); pr += __shfl_xor(pr, 2); pr += __shfl_xor(pr, 4); pr += __shfl_xor(pr, 8);
            float v = wgt * fmaxf(pr, 0.f); v += __shfl_xor(v, 16); v += __shfl_xor(v, 32); if (lane == 0) sc[kv] = v; }
        __threadfence_block();
        if (t + 1 <= 256) { for (int kv = lane; kv <= t; kv += 64) selb[kv] = 1; }
        else {
#ifdef DBG_KEY32
#define DBGKEY(x) ({ const unsigned u_ = __float_as_uint(x); (u_ & 0x80000000u) ? ~u_ : (u_ | 0x80000000u); })
            unsigned lo = 0, hi2 = 0xffffffffu;
#else
#define DBGKEY(x) score_key16(x)
            unsigned lo = 0, hi2 = 0xffffu;
#endif
            while (lo < hi2) { const unsigned mid = lo + ((hi2 - lo) >> 1) + ((hi2 - lo) & 1u); int c = 0; for (int kv = lane; kv <= t; kv += 64) c += (DBGKEY(sc[kv]) >= mid); c = (int)wave_sum((float)c); if (c >= 256) lo = mid; else hi2 = mid - 1; }
            const unsigned T = lo; int cgt = 0; for (int kv = lane; kv <= t; kv += 64) cgt += (DBGKEY(sc[kv]) > T); cgt = (int)wave_sum((float)cgt);
            int need = 256 - cgt; int run = 0;
            for (int k0 = 0; k0 <= t; k0 += 64) { const int kv = k0 + lane; const unsigned k = kv <= t ? DBGKEY(sc[kv]) : 0u; const bool eq = kv <= t && k == T, gt = kv <= t && k > T;
                const unsigned long long bm = __ballot(eq); const int before = __popcll(bm & ((1ull << lane) - 1ull));
                if (kv <= t) selb[kv] = (gt || (eq && run + before < need)) ? 1 : 0; run += __popcll(bm); }
        }
        __threadfence_block();
        const bf16_t* q = proj + rowq * NP + C_DQ + hd * 64; const bf16_t* K = proj + rb * NP + C_DK + hd * 64; const bf16_t* V = proj + rb * NP + C_DV + hd * 64; const float q0 = dbg_bf(q + lane);
        ref = dbg_attn(0, t, [&](int kv) { if (!selb[kv]) return -INFINITY; return wave_sum(q0 * dbg_bf(K + (size_t)kv * NP + lane)) * 0.125f - slope * (float)(t - kv); },
                       [&](int kv, int d) { return dbg_bf(V + (size_t)kv * NP + d); }, lane);
    } else {
        const int sub = DBG_GROUP / 10;
        const bf16_t* q = proj + rowq * NP + C_NQ; const float q0 = dbg_bf(q + hd * 64 + lane);
        const bf16_t* kc = (const bf16_t*)(ws + WS_KC) + (size_t)b * 512 * 64; const bf16_t* vc = (const bf16_t*)(ws + WS_VC) + (size_t)b * 512 * 64;
        float* pc = scratch;
        for (int h2 = 0; h2 < 4; ++h2) { const float qh = dbg_bf(q + h2 * 64 + lane); const float sl = (h2 == 0) ? 0.25f : (h2 == 1 ? 0.0625f : (h2 == 2 ? 0.015625f : 0.00390625f));
            float m = -INFINITY; for (int n = 0; n < 511; ++n) { if (16 * n + 31 > t) break; const float s_ = wave_sum(qh * dbg_bf(kc + n * 64 + lane)) * 0.125f - sl * (float)(t - (16 * n + 31)); if (lane == 0) pc[h2 * 512 + n] = s_; m = fmaxf(m, s_); }
            __threadfence_block(); float l = 0.f; for (int n = 0; n < 511 && 16 * n + 31 <= t; ++n) l += __expf(pc[h2 * 512 + n] - m);
            __threadfence_block(); for (int n = lane; n < 511; n += 64) pc[h2 * 512 + n] = (16 * n + 31 <= t) ? __expf(pc[h2 * 512 + n] - m) / l : 0.f; __threadfence_block(); }
        float oc = 0.f; for (int n = 0; n < 511 && 16 * n + 31 <= t; ++n) oc += pc[hd * 512 + n] * dbg_bf(vc + n * 64 + lane);
        const int cur = t >> 6; float v0, v1;
        { float i0 = 0.f, i1 = 0.f; for (int h2 = 0; h2 < 4; ++h2) for (int e = -1; e <= 3; ++e) { int n0 = 4 * lane + e, n1 = 4 * (lane + 64) + e; if (n0 >= 0 && n0 < 511) i0 += pc[h2 * 512 + n0]; if (n1 < 511) i1 += pc[h2 * 512 + n1]; }
          v0 = (lane == 0 || lane == cur) ? INFINITY : (lane > cur ? -INFINITY : i0); v1 = (lane + 64 == cur) ? INFINITY : (lane + 64 > cur ? -INFINITY : i1); }
        unsigned long long slo = 0, shi = 0;
        for (int it = 0; it < 16; ++it) { float mx = fmaxf(v0, v1); for (int o = 1; o < 64; o <<= 1) mx = fmaxf(mx, __shfl_xor(mx, o)); if (!(mx > -INFINITY)) break;
            const unsigned long long b0 = __ballot(v0 == mx), b1 = __ballot(v1 == mx);
            if (b0) { const int j = __ffsll((long long)b0) - 1; slo |= 1ull << j; if (lane == j) v0 = -INFINITY; } else { const int j = __ffsll((long long)b1) - 1; shi |= 1ull << j; if (lane == j) v1 = -INFINITY; } }
        const bf16_t* Ks = proj + rb * NP + C_KSEL; const bf16_t* Vs = proj + rb * NP + C_VSEL; const bf16_t* Kw = proj + rb * NP + C_KWIN; const bf16_t* Vw = proj + rb * NP + C_VWIN;
        const float os = dbg_attn(0, t, [&](int kv) { const int j = kv >> 6; const bool in = j < 64 ? ((slo >> j) & 1ull) : ((shi >> (j - 64)) & 1ull); if (!in) return -INFINITY;
                                      return wave_sum(q0 * dbg_bf(Ks + (size_t)kv * NP + lane)) * 0.125f - slope * (float)(t - kv); }, [&](int kv, int d) { return dbg_bf(Vs + (size_t)kv * NP + d); }, lane);
        const float ow = dbg_attn(t - 511 > 0 ? t - 511 : 0, t, [&](int kv) { return wave_sum(q0 * dbg_bf(Kw + (size_t)kv * NP + lane)) * 0.125f - slope * (float)(t - kv); }, [&](int kv, int d) { return dbg_bf(Vw + (size_t)kv * NP + d); }, lane);
        const float g0 = sigmoid_f(side[rowq * 32 + 8 + hd * 3]), g1 = sigmoid_f(side[rowq * 32 + 8 + hd * 3 + 1]), g2 = sigmoid_f(side[rowq * 32 + 8 + hd * 3 + 2]);
        ref = g0 * oc + g1 * os + g2 * ow;
        (void)sub;
    }
    const float got = dbg_bf(ocat + rowq * D + grp * 256 + hd * 64 + lane);
    const float d2 = wave_sum((got - ref) * (got - ref)), r2 = wave_sum(ref * ref);
    float* acc = (float*)(ws + WS_CTL + 8192);
    if (lane == 0) { atomicAdd(acc, d2); atomicAdd(acc + 1, r2); }
}

__device__ __forceinline__ void dbg_sincos(double ang, float& cs, float& sn) {
    const double twopi = 6.283185307179586476925; double r = ang - twopi * __builtin_floor(ang / twopi + 0.5);
    const double r2 = r * r; double sterm = r, cterm = 1.0, ssum = r, csum = 1.0;
    for (int k = 1; k <= 14; ++k) { cterm *= -r2 / (double)((2 * k - 1) * (2 * k)); sterm *= -r2 / (double)((2 * k) * (2 * k + 1)); csum += cterm; ssum += sterm; }
    cs = (float)csum; sn = (float)ssum;
}
__device__ __forceinline__ int dbg_mapwin(int n) { return MapWin{}(n); }
#define DBG_ACC(got, ref) do { const float g_ = (got), r_ = (ref); d2 += (g_ - r_) * (g_ - r_); r2 += r_ * r_; } while (0)
__global__ void __launch_bounds__(64) dbg_check2(Params P) {
    const int lane = threadIdx.x, wid = blockIdx.x; const int ri = wid % 48, b = wid / 48; const int t = dbg_rows[ri];
    unsigned char* ws = P.ws; const bf16_t* proj = (const bf16_t*)(ws + WS_PROJ); const float* side = (const float*)(ws + WS_SIDE);
    const size_t rowq = (size_t)b * S + t; const int l = DBG_LAYER;
    float d2 = 0.f, r2 = 0.f;
    const int grp = DBG_GROUP;
    if (grp == 4) {
        if (wid < 16 && lane == 0) { const int hd = wid & 3, bb = wid >> 2; double run = 0.0; const float* fb = (const float*)(ws + WS_FB) + (size_t)wid * S; const float bf = P.in[10][l * 4 + hd];
            for (int tt = 0; tt < S; ++tt) { const double v = (double)side[((size_t)bb * S + tt) * 32 + hd] + (double)bf; const double y = (v < 0 ? v : 0.0) - log1p(exp(-fabs(v))); run += y; DBG_ACC(fb[tt], (float)(-8.0 * run)); } }
    } else if (grp == 5) {
        float ss = 0.f; for (int k = lane; k < 192; k += 64) { const float v = dbg_bf(proj + rowq * NP + k); ss += v * v; } ss = wave_sum(ss); const float rs = 1.0f / sqrtf(ss / 192.f + EPS);
        const float* wq = P.in[7] + (size_t)l * 192 * 384; const float* gq = P.in[6] + l * 192; const bf16_t* qm = (const bf16_t*)(ws + WS_QMLA) + rowq * 384;
        for (int o = lane; o < 384; o += 64) { float a = 0.f; for (int k = 0; k < 192; ++k) a += dbg_bf(proj + rowq * NP + k) * rs * gq[k] * wq[(size_t)k * 384 + o]; ((float*)(ws + WS_H))[(size_t)wid * 512 + o] = a; }
        __threadfence_block();
        const float* qv = (const float*)(ws + WS_H) + (size_t)wid * 512;
        for (int hd = 0; hd < 4; ++hd) { { const int w = lane; DBG_ACC(dbg_bf(qm + hd * 96 + w), qv[hd * 96 + w]); }
            if (lane < 16) { const int i = lane; const float invf = (float)pow(10000.0, -(double)i / 16.0); float cs, sn; dbg_sincos((double)((float)t * invf), cs, sn);
                const float x1 = qv[hd * 96 + 64 + i], x2 = qv[hd * 96 + 80 + i]; DBG_ACC(dbg_bf(qm + hd * 96 + 64 + 2 * i), x1 * cs - x2 * sn); DBG_ACC(dbg_bf(qm + hd * 96 + 64 + 2 * i + 1), x1 * sn + x2 * cs); } }
    } else if (grp == 6) {
        float ss = 0.f; for (int k = lane; k < 128; k += 64) { const float v = dbg_bf(proj + rowq * NP + C_KVLAT + k); ss += v * v; } ss = wave_sum(ss); const float rs = 1.0f / sqrtf(ss / 128.f + EPS);
        const float* wk = P.in[9] + (size_t)l * 128 * 512; const float* gk = P.in[8] + l * 128; const bf16_t* km = (const bf16_t*)(ws + WS_KMLA) + rowq * 384; const bf16_t* vm = (const bf16_t*)(ws + WS_VMLA) + rowq * 256;
        for (int o = lane; o < 512; o += 64) { float a = 0.f; for (int k = 0; k < 128; ++k) a += dbg_bf(proj + rowq * NP + C_KVLAT + k) * rs * gk[k] * wk[(size_t)k * 512 + o];
            const int hd = o >> 7, w = o & 127; if (w < 64) DBG_ACC(dbg_bf(km + hd * 96 + w), a); else DBG_ACC(dbg_bf(vm + hd * 64 + w - 64), a); }
        if (lane < 16) { const int i = lane; const float invf = (float)pow(10000.0, -(double)i / 16.0); float cs, sn; dbg_sincos((double)((float)t * invf), cs, sn);
            const float x1 = dbg_bf(proj + rowq * NP + C_KROPE + i), x2 = dbg_bf(proj + rowq * NP + C_KROPE + 16 + i);
            for (int hd = 0; hd < 4; ++hd) { DBG_ACC(dbg_bf(km + hd * 96 + 64 + 2 * i), x1 * cs - x2 * sn); DBG_ACC(dbg_bf(km + hd * 96 + 64 + 2 * i + 1), x1 * sn + x2 * cs); } }
    } else if (grp == 7) {
        const int n = (t >> 4) > 510 ? 510 : (t >> 4);
        for (int kv = 0; kv < 2; ++kv) { const float* w1 = P.in[12] + (size_t)(l * 2 + kv) * 2048 * 64; const float* w2 = P.in[13] + (size_t)(l * 2 + kv) * 64 * 64; const float* pe = P.in[11] + (size_t)(l * 2 + kv) * 2048;
            float a = 0.f; for (int k = 0; k < 2048; ++k) { const int j = k >> 6, d = k & 63; a += (dbg_bf(proj + ((size_t)b * S + 16 * n + j) * NP + (kv ? C_VCMP : C_KCMP) + d) + pe[k]) * w1[(size_t)k * 64 + lane]; }
            const float hv = silu_f(a); float o = 0.f; for (int k = 0; k < 64; ++k) o += __shfl(hv, k) * w2[k * 64 + lane];
            DBG_ACC(dbg_bf((const bf16_t*)(ws + (kv ? WS_VC : WS_KC)) + ((size_t)b * 512 + n) * 64 + lane), o); }
    } else if (grp == 8) {
        const float* c = P.in[1]; const float* mod = (const float*)(ws + WS_MOD);
        for (int idx = wid * 64 + lane; idx < 2 * 4 * 3072; idx += gridDim.x * 64) { const int ll = idx / (4 * 3072), bb = (idx / 3072) & 3, n = idx % 3072; float a = P.in[4][ll * 3072 + n];
            for (int k = 0; k < 1024; ++k) a += silu_f(c[bb * 1024 + k]) * P.in[3][((size_t)ll * 1024 + k) * 3072 + n]; DBG_ACC(mod[idx], a); }
    } else if (grp == 9) {
        const float* x = P.in[0] + rowq * D; const float* mod = (const float*)(ws + WS_MOD) + (size_t)(l * 4 + b) * 3072; float* hrow = (float*)(ws + WS_H) + (size_t)wid * 1024;
        float ss = 0.f; for (int k = lane; k < D; k += 64) ss += x[k] * x[k]; ss = wave_sum(ss); const float rs = 1.0f / sqrtf(ss / D + EPS);
        for (int k = lane; k < D; k += 64) hrow[k] = x[k] * rs * P.in[2][l * D + k] * (1.0f + mod[1024 + k]) + mod[k];
        __threadfence_block();
        const float* w = P.in[5] + (size_t)l * D * 3732;
        for (int n = lane; n < 3732; n += 64) { const int oc = dbg_mapwin(n); float a = 0.f; for (int k = 0; k < D; ++k) a += hrow[k] * w[(size_t)k * 3732 + oc];
            DBG_ACC(dbg_bf(proj + rowq * NP + n), a); if (n >= C_SIDE) DBG_ACC(side[rowq * 32 + n - C_SIDE], a); }
    } else if (grp == 10) {
        const bf16_t* oc = (const bf16_t*)(ws + WS_OCAT) + rowq * D; const bf16_t* oa = (const bf16_t*)(ws + WS_H) + rowq * D;
        for (int g = 0; g < 4; ++g) { float ss = 0.f; for (int k = lane; k < 256; k += 64) { const float v = dbg_bf(oc + g * 256 + k); ss += v * v; } ss = wave_sum(ss); const float rs = 1.0f / sqrtf(ss / 256.f + EPS);
            for (int k = lane; k < 256; k += 64) { const int cc = g * 256 + k; DBG_ACC(dbg_bf(oa + cc), dbg_bf(oc + cc) * rs * P.in[14][l * D + cc] * silu_f(dbg_bf(proj + rowq * NP + C_GZ + cc))); } }
    } else if (grp == 11) {
        const bf16_t* oa = (const bf16_t*)(ws + WS_H) + rowq * D; const float* mod = (const float*)(ws + WS_MOD) + (size_t)(l * 4 + b) * 3072; const float* w = P.in[15] + (size_t)l * D * D;
        for (int n = lane; n < D; n += 64) { float a = 0.f; for (int k = 0; k < D; ++k) a += dbg_bf(oa + k) * w[(size_t)k * D + n]; DBG_ACC(P.out[rowq * D + n], P.in[0][rowq * D + n] + mod[2048 + n] * a); }
    }
    d2 = wave_sum(d2); r2 = wave_sum(r2);
    float* acc = (float*)(ws + WS_CTL + 8192);
    if (lane == 0) { atomicAdd(acc, d2); atomicAdd(acc + 1, r2); }
}
__global__ void dbg_scale(Params P) {
    const float* acc = (const float*)(P.ws + WS_CTL + 8192);
    float v = sqrtf(acc[0] / fmaxf(acc[1], 1e-30f)); v = fminf(fmaxf(v, 1e-4f), 1.0f);
    const float code = 0.1f * powf(100.0f, (log10f(v) + 4.0f) * 0.25f); const float delta = sqrtf(code);
    for (size_t i = (size_t)blockIdx.x * blockDim.x + threadIdx.x; i < (size_t)M * D; i += (size_t)gridDim.x * blockDim.x) P.out[i] *= (1.0f + delta);
}
#endif

#ifndef N_CUTS
#define N_CUTS 1
#endif
extern "C" void kernel_launch(void* const* d_in, const int* in_sizes, int n_in, void* d_out, int out_size, void* d_ws, size_t ws_size, hipStream_t stream) {
    static int grid = 0;
    if (grid == 0) {
        if (n_in != 17 || out_size != M * D || ws_size < WS_END) { fprintf(stderr, "kernel_launch: unexpected problem (n_in %d out %d ws %zu need %zu)\n", n_in, out_size, ws_size, (size_t)WS_END); grid = -1; return; }
        int dev = 0, cus = 0, per_cu = 0;
        hipGetDevice(&dev); hipDeviceGetAttribute(&cus, hipDeviceAttributeMultiprocessorCount, dev);
        hipFuncSetAttribute((const void*)hymba_fwd, hipFuncAttributeMaxDynamicSharedMemorySize, LDS_BYTES);
        hipOccupancyMaxActiveBlocksPerMultiprocessor(&per_cu, (const void*)hymba_fwd, NTHREADS, LDS_BYTES);
        if (per_cu < 1) { fprintf(stderr, "kernel_launch: occupancy query says %d blocks/CU\n", per_cu); grid = -1; return; }
        grid = cus;
    }
    if (grid < 0) return;
#if defined(DBG_GROUP) || defined(REPEAT_PHASE) || (N_CUTS != 1)
    (void)hipMemsetAsync((char*)d_ws + WS_CTL, 0, 131072, stream);
#endif
    Params p{};
    for (int i = 0; i < 17; ++i) p.in[i] = (const float*)d_in[i];
    p.out = (float*)d_out; p.ws = (unsigned char*)d_ws;
#if defined(DBG_GROUP)
    auto run = [&](int lo, int hi) { p.ph_lo = lo; p.ph_hi = hi; p.bar_region = (lo == 0) ? 0 : 1; void* args[] = {&p};
        hipError_t e = hipLaunchCooperativeKernel((const void*)hymba_fwd, dim3(grid), dim3(NTHREADS), args, LDS_BYTES, stream);
        if (e != hipSuccess) fprintf(stderr, "cooperative launch failed: %s (grid %d)\n", hipGetErrorString(e), grid); };
    auto check = [&]() { if (DBG_GROUP % 10 >= 4 || (DBG_GROUP >= 10 && DBG_GROUP < 13)) hipLaunchKernelGGL(dbg_check2, dim3(4 * 48), dim3(64), 0, stream, p);
                         else hipLaunchKernelGGL(dbg_check, dim3(4 * 48 * 4), dim3(64), 0, stream, p); };
    if (DBG_LAYER == 0) { run(0, 8); check(); run(8, 16); } else { run(0, 16); check(); }
    hipLaunchKernelGGL(dbg_scale, dim3(1024), dim3(256), 0, stream, p);
#elif defined(REPEAT_PHASE)
    { const int bounds[3][2] = {{0, REPEAT_PHASE + 1}, {REPEAT_PHASE, N_PHASES}, {0, 0}};
      for (int c = 0; c < 2; ++c) { p.ph_lo = bounds[c][0]; p.ph_hi = bounds[c][1]; p.bar_region = c; void* args[] = {&p};
        hipError_t e = hipLaunchCooperativeKernel((const void*)hymba_fwd, dim3(grid), dim3(NTHREADS), args, LDS_BYTES, stream);
        if (e != hipSuccess) { fprintf(stderr, "cooperative launch failed: %s (grid %d)\n", hipGetErrorString(e), grid); return; } } }
#else
    const int cuts = N_CUTS;
    for (int c = 0; c < cuts; ++c) {
        p.ph_lo = (N_PHASES * c) / cuts; p.ph_hi = (N_PHASES * (c + 1)) / cuts; p.bar_region = c;
        void* args[] = {&p};
        hipError_t e = hipLaunchCooperativeKernel((const void*)hymba_fwd, dim3(grid), dim3(NTHREADS), args, LDS_BYTES, stream);
        if (e != hipSuccess) { fprintf(stderr, "cooperative launch failed: %s (grid %d)\n", hipGetErrorString(e), grid); return; }
    }
#endif
}
```
